# Optimizing an MI355X kernel written in HIP

```python
import functools
import jax, jax.numpy as jnp
from jax import lax
import numpy as np

D_MODEL = 2048
BATCH = 2
SEQ = 4096
DEPTH = 2
DEC_BATCH = 32
DEC_SEQ = 1
PAST_LEN = 16384
PAGE_SIZE = 128

ATT_WIDTH = D_MODEL // 2
RWKV_WIDTH = D_MODEL - ATT_WIDTH
HEAD_DIM = 64
N_Q_HEADS = ATT_WIDTH // HEAD_DIM
N_KV_HEADS = 4
GQA_GROUP = N_Q_HEADS // N_KV_HEADS
KV_WIDTH = N_KV_HEADS * HEAD_DIM
WINDOW = 128
BLOCK = WINDOW
ROT_DIM = HEAD_DIM // 4
ROPE_THETA = 500000.0
RW_HEAD = 64
RW_HEADS = RWKV_WIDTH // RW_HEAD
DECAY_LORA = 64
ICLR_LORA = 64
NORM_EPS = 1e-5
GN_EPS = 64e-5
NEG_BIG = -1e30

Q_OFF = 0
KA_OFF = Q_OFF + ATT_WIDTH
VA_OFF = KA_OFF + KV_WIDTH
R_OFF = VA_OFF + KV_WIDTH
KR_OFF = R_OFF + RWKV_WIDTH
VR_OFF = KR_OFF + RWKV_WIDTH
WD_OFF = VR_OFF + RWKV_WIDTH
AD_OFF = WD_OFF + DECAY_LORA
GA_OFF = AD_OFF + ICLR_LORA
GR_OFF = GA_OFF + ATT_WIDTH
IN_WIDTH = GR_OFF + RWKV_WIDTH
SHIFT_DIM = GA_OFF - R_OFF

kernel_name = "hymba_swa_sink_rwkv7_adaln_step"


def rms_norm(x, g):
    xf = x.astype(jnp.float32)
    y = xf * lax.rsqrt(jnp.mean(xf * xf, axis=-1, keepdims=True) + NORM_EPS)
    return (y * g.astype(jnp.float32)).astype(x.dtype)


def apply_partial_rope(x, pos):
    half = ROT_DIM // 2
    inv_freq = ROPE_THETA ** (-jnp.arange(half, dtype=jnp.float32) * (2.0 / ROT_DIM))
    ang = pos.astype(jnp.float32)[:, None] * inv_freq[None, :]
    cos = jnp.cos(ang)[:, None, :]
    sin = jnp.sin(ang)[:, None, :]
    xf = x.astype(jnp.float32)
    x1 = xf[..., :half]
    x2 = xf[..., half:ROT_DIM]
    out = jnp.concatenate([x1 * cos - x2 * sin, x2 * cos + x1 * sin, xf[..., ROT_DIM:]], axis=-1)
    return out.astype(x.dtype)


def sink_softmax(scores, mask, sink):
    s = jnp.where(mask, scores.astype(jnp.float32), NEG_BIG)
    m = jnp.maximum(jnp.max(s, axis=-1, keepdims=True), sink)
    p = jnp.exp(s - m)
    return p / (jnp.sum(p, axis=-1, keepdims=True) + jnp.exp(sink - m))


def attention_prompt(q, k, v, sinks):
    Bn, T = q.shape[0], q.shape[1]
    nb = T // BLOCK
    qb = q.reshape(Bn, nb, BLOCK, N_KV_HEADS, GQA_GROUP, HEAD_DIM)

    def band(t):
        tb = t.reshape(Bn, nb, BLOCK, N_KV_HEADS, HEAD_DIM)
        prev = jnp.concatenate([jnp.zeros_like(tb[:, :1]), tb[:, :-1]], axis=1)
        return jnp.concatenate([prev, tb], axis=2)

    kb, vb = band(k), band(v)
    scores = jnp.einsum('bnqkgd,bnskd->bnkgqs', qb, kb) * (HEAD_DIM ** -0.5)
    qi = jnp.arange(BLOCK)[:, None]
    kj = jnp.arange(2 * BLOCK)[None, :]
    rel = BLOCK + qi - kj
    blk = jnp.arange(nb)[:, None, None]
    mask = (rel >= 0) & (rel <= WINDOW) & ((blk > 0) | (kj >= BLOCK))
    sink = sinks.astype(jnp.float32).reshape(1, 1, N_KV_HEADS, GQA_GROUP, 1, 1)
    p = sink_softmax(scores, mask[None, :, None, None], sink).astype(v.dtype)
    out = jnp.einsum('bnkgqs,bnskd->bnqkgd', p, vb).reshape(Bn, T, ATT_WIDTH)
    return out, k[:, -WINDOW:], v[:, -WINDOW:]


def attention_sample(q, k, v, sinks, ck, cv, pos):
    Bd, S = q.shape[0], q.shape[1]
    kall = jnp.concatenate([ck.astype(k.dtype), k], axis=1)
    vall = jnp.concatenate([cv.astype(v.dtype), v], axis=1)
    kpos = jnp.concatenate([PAST_LEN - WINDOW + jnp.arange(WINDOW, dtype=jnp.int32), pos])
    rel = pos[:, None] - kpos[None, :]
    mask = (rel >= 0) & (rel <= WINDOW)
    qg = q.reshape(Bd, S, N_KV_HEADS, GQA_GROUP, HEAD_DIM)
    scores = jnp.einsum('bqkgd,bskd->bkgqs', qg, kall) * (HEAD_DIM ** -0.5)
    sink = sinks.astype(jnp.float32).reshape(1, N_KV_HEADS, GQA_GROUP, 1, 1)
    p = sink_softmax(scores, mask[None, None, None], sink).astype(v.dtype)
    out = jnp.einsum('bkgqs,bskd->bqkgd', p, vall).reshape(Bd, S, ATT_WIDTH)
    return out, kall[:, -WINDOW:], vall[:, -WINDOW:]


def wkv_recurrence(r, decay, k, v, kk, a, S0):
    def step(S, inp):
        r_t, w_t, k_t, v_t, kk_t, a_t = inp
        sa = jnp.einsum('bhij,bhj->bhi', S, -kk_t)
        S = (S * w_t[:, :, None, :] + sa[..., None] * (kk_t * a_t)[:, :, None, :]
             + v_t[..., None] * k_t[:, :, None, :])
        return S, jnp.einsum('bhij,bhj->bhi', S, r_t)

    xs = tuple(jnp.moveaxis(t, 1, 0) for t in (r, decay, k, v, kk, a))
    S_T, ys = lax.scan(step, S0, xs)
    return jnp.moveaxis(ys, 0, 1), S_T


def hybrid_layer(x, c, pos, attend, S0, shift_prev, norm_g, w_ada, b_ada, w_in, mu_shift,
                 w0, w_decay, a0, w_iclr, k_k, k_a, r_k, ln_w, ln_b, sinks, w_out):
    f32 = jnp.float32
    Bn, T = x.shape[0], x.shape[1]
    mod = jax.nn.silu(c) @ w_ada + b_ada
    shift, scale, gate = jnp.split(mod, 3, axis=-1)
    h = rms_norm(x, norm_g) * (1 + scale[:, None, :]) + shift[:, None, :]
    proj = h @ w_in

    q = apply_partial_rope(proj[..., Q_OFF:KA_OFF].reshape(Bn, T, N_Q_HEADS, HEAD_DIM), pos)
    k = apply_partial_rope(proj[..., KA_OFF:VA_OFF].reshape(Bn, T, N_KV_HEADS, HEAD_DIM), pos)
    v = proj[..., VA_OFF:R_OFF].reshape(Bn, T, N_KV_HEADS, HEAD_DIM)
    att, k_buf, v_buf = attend(q, k, v, sinks)

    cur = proj[..., R_OFF:GA_OFF]
    prev = jnp.concatenate([shift_prev[:, None, :].astype(cur.dtype), cur[:, :-1]], axis=1)
    mixed = (cur + (prev - cur) * mu_shift).astype(f32)
    r = mixed[..., 0:KR_OFF - R_OFF]
    kr = mixed[..., KR_OFF - R_OFF:VR_OFF - R_OFF]
    vr = mixed[..., VR_OFF - R_OFF:WD_OFF - R_OFF]
    wd = mixed[..., WD_OFF - R_OFF:AD_OFF - R_OFF]
    ad = mixed[..., AD_OFF - R_OFF:]
    w_log = -jax.nn.softplus(-(w0.astype(f32) + jnp.tanh(wd) @ w_decay.astype(f32))) - 0.5
    decay = jnp.exp(-jnp.exp(w_log))
    a = jax.nn.sigmoid(a0.astype(f32) + ad @ w_iclr.astype(f32))
    heads = lambda t: t.reshape(Bn, T, RW_HEADS, RW_HEAD)
    kk = heads(kr * k_k.astype(f32))
    kk = kk / jnp.maximum(jnp.sqrt(jnp.sum(kk * kk, axis=-1, keepdims=True)), 1e-12)
    k_eff = kr * (1 + (a - 1) * k_a.astype(f32))
    r_h, k_h, v_h = heads(r), heads(k_eff), heads(vr)
    ys, S_T = wkv_recurrence(r_h, heads(decay), k_h, v_h, kk, heads(a), S0.astype(f32))
    mu = jnp.mean(ys, axis=-1, keepdims=True)
    var = jnp.mean(jnp.square(ys - mu), axis=-1, keepdims=True)
    yn = ((ys - mu) * lax.rsqrt(var + GN_EPS)).reshape(Bn, T, RWKV_WIDTH)
    yn = yn * ln_w.astype(f32) + ln_b.astype(f32)
    bonus = jnp.sum(r_h * k_h * r_k.astype(f32), axis=-1, keepdims=True) * v_h
    y_rw = (yn + bonus.reshape(Bn, T, RWKV_WIDTH)).astype(x.dtype)

    g_att = jax.nn.silu(proj[..., GA_OFF:GR_OFF])
    g_rw = jax.nn.silu(proj[..., GR_OFF:IN_WIDTH])
    out = jnp.concatenate([att * g_att, y_rw * g_rw], axis=-1) @ w_out
    x = x + gate[:, None, :] * out
    return x, k_buf, v_buf, S_T, cur[:, -1]


def setup_inputs(seed: int = 0) -> dict:
    key = jax.random.key(seed)
    ks = jax.random.split(key, 25)
    f32 = jnp.float32

    def nrm(k, shape, s):
        return jax.random.normal(k, shape, f32) * s

    return {
        "x_prompt": nrm(ks[0], (BATCH, SEQ, D_MODEL), 1.0),
        "x_sample": nrm(ks[1], (DEC_BATCH, DEC_SEQ, D_MODEL), 1.0),
        "cache_k": nrm(ks[2], (DEPTH, DEC_BATCH, WINDOW, N_KV_HEADS, HEAD_DIM), 1.0),
        "cache_v": nrm(ks[3], (DEPTH, DEC_BATCH, WINDOW, N_KV_HEADS, HEAD_DIM), 1.0),
        "state_wkv": nrm(ks[4], (DEPTH, DEC_BATCH, RW_HEADS, RW_HEAD, RW_HEAD), 1.0),
        "state_shift": nrm(ks[5], (DEPTH, DEC_BATCH, SHIFT_DIM), 1.0),
        "c_prompt": nrm(ks[6], (BATCH, D_MODEL), 1.0),
        "c_sample": nrm(ks[7], (DEC_BATCH, D_MODEL), 1.0),
        "norm_g": 1.0 + nrm(ks[8], (DEPTH, D_MODEL), 0.01),
        "w_ada": nrm(ks[9], (DEPTH, D_MODEL, 3 * D_MODEL), 0.5 * D_MODEL ** -0.5),
        "b_ada": nrm(ks[10], (DEPTH, 3 * D_MODEL), 0.01),
        "w_in": nrm(ks[11], (DEPTH, D_MODEL, IN_WIDTH), D_MODEL ** -0.5),
        "mu_shift": jax.random.uniform(ks[12], (DEPTH, SHIFT_DIM), f32),
        "w0": nrm(ks[13], (DEPTH, RWKV_WIDTH), 0.5),
        "w_decay": nrm(ks[14], (DEPTH, DECAY_LORA, RWKV_WIDTH), 0.1),
        "a0": nrm(ks[15], (DEPTH, RWKV_WIDTH), 0.1),
        "w_iclr": nrm(ks[16], (DEPTH, ICLR_LORA, RWKV_WIDTH), 0.1),
        "k_k": 1.0 + nrm(ks[17], (DEPTH, RWKV_WIDTH), 0.1),
        "k_a": 1.0 + nrm(ks[18], (DEPTH, RWKV_WIDTH), 0.1),
        "r_k": nrm(ks[19], (DEPTH, RW_HEADS, RW_HEAD), 0.1),
        "ln_w": 1.0 + nrm(ks[20], (DEPTH, RWKV_WIDTH), 0.1),
        "ln_b": nrm(ks[21], (DEPTH, RWKV_WIDTH), 0.01),
        "sinks": nrm(ks[22], (DEPTH, N_Q_HEADS), 0.5),
        "w_out": nrm(ks[23], (DEPTH, D_MODEL, D_MODEL), D_MODEL ** -0.5),
        "final_g": 1.0 + nrm(ks[24], (D_MODEL,), 0.01),
    }


def reference(x_prompt, x_sample, cache_k, cache_v, state_wkv, state_shift, c_prompt, c_sample,
              norm_g, w_ada, b_ada, w_in, mu_shift, w0, w_decay, a0, w_iclr, k_k, k_a, r_k,
              ln_w, ln_b, sinks, w_out, final_g):
    Bp, Tp = x_prompt.shape[0], x_prompt.shape[1]
    Ts = x_sample.shape[1]
    pos_p = jnp.arange(Tp, dtype=jnp.int32)
    pos_s = PAST_LEN + jnp.arange(Ts, dtype=jnp.int32)
    S0_p = jnp.zeros((Bp, RW_HEADS, RW_HEAD, RW_HEAD), jnp.float32)
    shift0_p = jnp.zeros((Bp, SHIFT_DIM), x_prompt.dtype)

    hp, hs = x_prompt, x_sample
    kp_l, vp_l, sp_l, shp_l = [], [], [], []
    ks_l, vs_l, ss_l, shs_l = [], [], [], []
    for l in range(DEPTH):
        lw = (norm_g[l], w_ada[l], b_ada[l], w_in[l], mu_shift[l], w0[l], w_decay[l], a0[l],
              w_iclr[l], k_k[l], k_a[l], r_k[l], ln_w[l], ln_b[l], sinks[l], w_out[l])
        hp, kb, vb, S_T, sh = hybrid_layer(hp, c_prompt, pos_p, attention_prompt, S0_p, shift0_p, *lw)
        kp_l.append(kb); vp_l.append(vb); sp_l.append(S_T); shp_l.append(sh)
        attend_s = functools.partial(attention_sample, ck=cache_k[l], cv=cache_v[l], pos=pos_s)
        hs, kb, vb, S_T, sh = hybrid_layer(hs, c_sample, pos_s, attend_s, state_wkv[l], state_shift[l], *lw)
        ks_l.append(kb); vs_l.append(vb); ss_l.append(S_T); shs_l.append(sh)

    y_prompt = rms_norm(hp, final_g)
    y_sample = rms_norm(hs, final_g)
    new_cache_k_prompt = jnp.stack(kp_l)
    new_cache_v_prompt = jnp.stack(vp_l)
    new_state_wkv_prompt = jnp.stack(sp_l)
    new_state_shift_prompt = jnp.stack(shp_l)
    new_cache_k_sample = jnp.stack(ks_l)
    new_cache_v_sample = jnp.stack(vs_l)
    new_state_wkv_sample = jnp.stack(ss_l)
    new_state_shift_sample = jnp.stack(shs_l)
    return (y_prompt, y_sample, new_cache_k_prompt, new_cache_v_prompt, new_state_wkv_prompt,
            new_state_shift_prompt, new_cache_k_sample, new_cache_v_sample, new_state_wkv_sample,
            new_state_shift_sample)
```

```cpp
#include <hip/hip_runtime.h>
#include <hip/hip_cooperative_groups.h>
#include <cstdio>
namespace cg = cooperative_groups;
__device__ __forceinline__ int opq_tid() { int t = threadIdx.x; asm volatile("" : "+v"(t)); return t; }
__device__ __forceinline__ int opq_s(int x) { asm volatile("" : "+s"(x)); return x; }
namespace pg8 {
#define PG8_LAS __attribute__((address_space(3)))
typedef unsigned short bf16_t;
typedef short bf16x8 __attribute__((ext_vector_type(8)));
typedef float f32x4 __attribute__((ext_vector_type(4)));
typedef unsigned u32x4 __attribute__((ext_vector_type(4)));
constexpr int BM = 256, BK = 64, HALF = 128, HTB = HALF * BK * 2  , STAGE_BYTES = 8 * HTB, NXCD = 8, WGM = 8;

__host__ __device__ __forceinline__ int lds_byte(int r, int c) { const int st = (r >> 4) * 2 + (c >> 5), rr = r & 15, cc = c & 31, ob = rr * 64 + cc * 2; return st * 1024 + (ob ^ (((ob >> 9) & 1) << 5)); }
__host__ __device__ __forceinline__ void stage_rc(int b, int& R, int& C) { const int st = b / 1024, sb = b % 1024, swz = sb ^ (((sb >> 9) & 1) << 5); R = (st >> 1) * 16 + swz / 64; C = (st & 1) * 32 + (swz % 64) / 2; }
__host__ __device__ __forceinline__ int perm32(int rho) { const int n = rho >> 4, i = rho & 15; return 8 * (i >> 2) + 4 * n + (i & 3); }

struct Unit { int pm, pn; };
struct Gemm { const bf16_t* A; const bf16_t* Bt; int M, N, K; };

struct StaticOrder {
    int nM, nN, nwg, G, c;
    __host__ __device__ void init(int M, int N, int G_, int c_) { nM = M / BM; nN = N / BM; nwg = nM * nN; G = G_; c = c_; }
    __host__ __device__ bool next(int i, Unit& u) const {
        const long L = (long)i * G + c; if (L >= nwg) return false;
        int wgid = (int)L; { const int q = nwg / NXCD, r = nwg % NXCD, xcd = wgid % NXCD, off = wgid / NXCD; wgid = (xcd < r ? xcd * (q + 1) : r * (q + 1) + (xcd - r) * q) + off; }
        const int nig = WGM * nN, gid = wgid / nig, fm = gid * WGM, gsz = (nM - fm) < WGM ? (nM - fm) : WGM;
        u.pm = fm + ((wgid % nig) % gsz); u.pn = (wgid % nig) / gsz; return true;
    }
    __device__ __forceinline__ void a_ready(const Unit&) const {}
    __device__ __forceinline__ void done(const Unit&) const {}
};
template <class Epi, class Sched, bool STAMP = false>
__device__ __forceinline__ void gemm_phase(PG8_LAS unsigned char* lds, const Gemm g, const Sched& S, const Epi& E, unsigned long long* stamps) {
    const int tid = opq_tid(), wid = __builtin_amdgcn_readfirstlane(tid >> 6), lane = tid & 63, wr = wid >> 2, wc = wid & 3, fr = lane & 15, fq = lane >> 4;
    const int K = g.K, nt = K / BK;
    int ts_lo = 0, ts_hi = 0, nts = 0; const unsigned long long rt_entry = STAMP ? (unsigned long long)wall_clock64() : 0ull;
#define PG8_STAMP() do { if (STAMP && wid == 0 && nts < 64) { const unsigned long long _c = (unsigned long long)clock64(); \
        ts_lo = (lane == nts) ? (int)(unsigned)_c : ts_lo; ts_hi = (lane == nts) ? (int)(unsigned)(_c >> 32) : ts_hi; ++nts; } } while (0)
    PG8_STAMP();
    unsigned voffA[2], voffB[2];
#pragma unroll
    for (int i = 0; i < 2; ++i) { int R, C; stage_rc(tid * 16 + i * 8192, R, C); const int Rb = Epi::PERM ? ((R & ~31) + perm32(R & 31)) : R;
        voffA[i] = (unsigned)(R * K + C) * 2u; voffB[i] = (unsigned)(Rb * K + C) * 2u; }
    const size_t kstep = (size_t)(BK * 2);
    const size_t hstep = (size_t)HALF * K * 2;
    const size_t tstep = 2 * hstep;
    const unsigned ldsw = (unsigned)wid * 1024u;
    const int aoff = lds_byte(wr * 64 + fr, fq * 8), boff = lds_byte(wc * 32 + fr, fq * 8);
#define PG8_SA(b, h) (((b) * 2 + (h)) * HTB)
#define PG8_SB(b, h) ((4 + (b) * 2 + (h)) * HTB)
#define PG8_STAGE(bufoff, gbase, voff) do { _Pragma("unroll") for (int _i = 0; _i < 2; ++_i) \
        __builtin_amdgcn_global_load_lds((const unsigned*)((const char*)(gbase) + (voff)[_i]), (PG8_LAS unsigned*)(lds + (bufoff) + ldsw + _i * 8192), 16, 0, 0); } while (0)
#define PG8_LDA(dst, b, h) do { _Pragma("unroll") for (int m = 0; m < 4; ++m) _Pragma("unroll") for (int k = 0; k < 2; ++k) dst[m][k] = *(const PG8_LAS bf16x8*)(lds + PG8_SA(b, h) + aoff + m * 2048 + k * 1024); } while (0)
#define PG8_LDB(dst, b, h) do { _Pragma("unroll") for (int n = 0; n < 2; ++n) _Pragma("unroll") for (int k = 0; k < 2; ++k) dst[n][k] = *(const PG8_LAS bf16x8*)(lds + PG8_SB(b, h) + boff + n * 2048 + k * 1024); } while (0)
#define PG8_MMA(ai, bj, At, Bt) do { __builtin_amdgcn_s_setprio(1); _Pragma("unroll") for (int m = 0; m < 4; ++m) _Pragma("unroll") for (int n = 0; n < 2; ++n) _Pragma("unroll") for (int k = 0; k < 2; ++k) \
        acc[ai][bj][m][n] = __builtin_amdgcn_mfma_f32_16x16x32_bf16(Bt[n][k], At[m][k], acc[ai][bj][m][n], 0, 0, 0); __builtin_amdgcn_s_setprio(0); } while (0)
#define PG8_WAIT_V(n) asm volatile("s_waitcnt vmcnt(" #n ")" ::: "memory")
#define PG8_WAIT_L(n) asm volatile("s_waitcnt lgkmcnt(" #n ")" ::: "memory")
#define PG8_BAR __builtin_amdgcn_s_barrier()
#define PG8_SCHED __builtin_amdgcn_sched_barrier(0)
    Unit cur, nxt; int ui = 0;
    if (!S.next(0, cur)) return;
    f32x4 acc[2][2][4][2];
#pragma unroll
    for (int a = 0; a < 2; ++a)
#pragma unroll
        for (int b = 0; b < 2; ++b)
#pragma unroll
            for (int m = 0; m < 4; ++m)
#pragma unroll
                for (int n = 0; n < 2; ++n) acc[a][b][m][n] = (f32x4){0.f, 0.f, 0.f, 0.f};
    bf16x8 At[4][2], B0[2][2], B1[2][2];
    const char* cA = (const char*)g.A + (size_t)cur.pm * tstep; const char* cB = (const char*)g.Bt + (size_t)cur.pn * tstep;
    S.a_ready(cur);
    PG8_STAGE(PG8_SB(0, 0), cB, voffB); PG8_STAGE(PG8_SA(0, 0), cA, voffA); PG8_STAGE(PG8_SB(0, 1), cB + hstep, voffB); PG8_STAGE(PG8_SA(0, 1), cA + hstep, voffA);
    if (wr == 1) PG8_BAR;
    PG8_WAIT_V(4); PG8_BAR;
    PG8_STAGE(PG8_SB(1, 0), cB + kstep, voffB); PG8_STAGE(PG8_SA(1, 0), cA + kstep, voffA); PG8_STAGE(PG8_SB(1, 1), cB + hstep + kstep, voffB);
    PG8_WAIT_V(6); PG8_BAR;
    PG8_STAMP();
    for (;;) {
        const bool has_next = S.next(ui + 1, nxt);
        const char* nA = has_next ? (const char*)g.A + (size_t)nxt.pm * tstep : cA; const char* nB = has_next ? (const char*)g.Bt + (size_t)nxt.pn * tstep : cB;
        for (int t = 0; t < nt; t += 2) {
            const bool last = (t == nt - 2);
            const char* a1 = cA + (size_t)(t + 1) * kstep;
            const char* a2 = last ? nA : cA + (size_t)(t + 2) * kstep; const char* b2 = last ? nB : cB + (size_t)(t + 2) * kstep;
            const char* a3 = a2 + kstep; const char* b3 = b2 + kstep;
            if (last && has_next) S.a_ready(nxt);
            PG8_LDB(B0, 0, 0); PG8_SCHED; PG8_LDA(At, 0, 0); PG8_STAGE(PG8_SA(1, 1), a1 + hstep, voffA);
            PG8_WAIT_L(8); PG8_BAR; PG8_WAIT_L(0); PG8_MMA(0, 0, At, B0); PG8_BAR; PG8_SCHED;
            PG8_LDB(B1, 0, 1); PG8_STAGE(PG8_SB(0, 0), b2, voffB);
            PG8_BAR; PG8_WAIT_L(0); PG8_MMA(0, 1, At, B1); PG8_BAR;
            PG8_LDA(At, 0, 1); PG8_STAGE(PG8_SA(0, 0), a2, voffA);
            PG8_BAR; PG8_WAIT_L(0); PG8_MMA(1, 0, At, B0); PG8_BAR; PG8_SCHED;
            PG8_STAGE(PG8_SB(0, 1), b2 + hstep, voffB);
            PG8_WAIT_V(6); PG8_BAR; PG8_MMA(1, 1, At, B1); PG8_BAR;
            PG8_LDB(B0, 1, 0); PG8_SCHED; PG8_LDA(At, 1, 0); PG8_STAGE(PG8_SA(0, 1), a2 + hstep, voffA);
            PG8_WAIT_L(8); PG8_BAR; PG8_WAIT_L(0); PG8_MMA(0, 0, At, B0); PG8_BAR; PG8_SCHED;
            PG8_LDB(B1, 1, 1); PG8_STAGE(PG8_SB(1, 0), b3, voffB);
            PG8_BAR; PG8_WAIT_L(0); PG8_MMA(0, 1, At, B1); PG8_BAR;
            PG8_LDA(At, 1, 1); PG8_STAGE(PG8_SA(1, 0), a3, voffA);
            PG8_BAR; PG8_WAIT_L(0); PG8_MMA(1, 0, At, B0); PG8_BAR; PG8_SCHED;
            PG8_STAGE(PG8_SB(1, 1), b3 + hstep, voffB);
            PG8_WAIT_V(6); PG8_BAR; PG8_MMA(1, 1, At, B1); PG8_BAR;
        }
        PG8_STAMP();
        if constexpr (!Epi::AFTER_DRAIN) { E(acc, cur, wr, wc, fr, fq); S.done(cur); }
        PG8_STAMP();
        if (!has_next) break;
#pragma unroll
        for (int a = 0; a < 2; ++a)
#pragma unroll
            for (int b = 0; b < 2; ++b)
#pragma unroll
                for (int m = 0; m < 4; ++m)
#pragma unroll
                    for (int n = 0; n < 2; ++n) acc[a][b][m][n] = (f32x4){0.f, 0.f, 0.f, 0.f};
        cur = nxt; cA = nA; cB = nB; ++ui;
    }
    PG8_WAIT_V(0);
    if (wr == 0) PG8_BAR;
    PG8_BAR;
    if constexpr (Epi::AFTER_DRAIN) { E.fused(acc, cur, wr, wc, fr, fq, lds, wid, lane); S.done(cur); }
    PG8_STAMP();
    if (STAMP && wid == 0) { stamps[lane] = lane < nts ? (((unsigned long long)(unsigned)ts_hi << 32) | (unsigned)ts_lo) : 0ull;
        if (lane == 62) stamps[62] = rt_entry; if (lane == 63) stamps[63] = (unsigned long long)wall_clock64(); }
#undef PG8_STAMP
#undef PG8_SA
#undef PG8_SB
#undef PG8_STAGE
#undef PG8_LDA
#undef PG8_LDB
#undef PG8_MMA
#undef PG8_WAIT_V
#undef PG8_WAIT_L
#undef PG8_BAR
#undef PG8_SCHED
}
}

typedef unsigned short bf16_t;
typedef short bf16x8 __attribute__((ext_vector_type(8)));
typedef float f32x4 __attribute__((ext_vector_type(4)));
typedef float f32x16 __attribute__((ext_vector_type(16)));

constexpr int DM = 2048, SEQ = 4096, NBP = 2, NBS = 32, TP = NBP * SEQ, MT = TP + NBS, MP = 8448;
constexpr int INW = 6784, INWP = 6912, SHD = 3200, DEPTH = 2;
constexpr size_t NRI = (size_t)MT * 1024;
constexpr int LDS_BYTES = 131072;
constexpr size_t O_CKP = (size_t)MT * DM;
constexpr size_t O_CVP = O_CKP + (size_t)DEPTH * NBP * 128 * 256;
constexpr size_t O_WKVP = O_CVP + (size_t)DEPTH * NBP * 128 * 256;
constexpr size_t O_SHP = O_WKVP + (size_t)DEPTH * NBP * 16 * 4096;
constexpr size_t O_CKS = O_SHP + (size_t)DEPTH * NBP * SHD;
constexpr size_t O_CVS = O_CKS + (size_t)DEPTH * NBS * 128 * 256;
constexpr size_t O_WKVS = O_CVS + (size_t)DEPTH * NBS * 128 * 256;
constexpr size_t O_SHS = O_WKVS + (size_t)DEPTH * NBS * 16 * 4096;
constexpr size_t O_END = O_SHS + (size_t)DEPTH * NBS * SHD;
constexpr size_t al256(size_t x) { return (x + 255) & ~(size_t)255; }
constexpr size_t WS_WTIN = 0;
constexpr size_t WS_WTOUT = WS_WTIN + (size_t)DEPTH * INWP * DM * 2;
constexpr size_t WS_MOD = WS_WTOUT + (size_t)DEPTH * DM * DM * 2;
constexpr size_t WS_ROPE = WS_MOD + al256((size_t)DEPTH * 34 * 6144 * 4);
constexpr size_t WS_HB = WS_ROPE + al256((size_t)4097 * 16 * 4);
constexpr size_t WS_QB = WS_HB + (size_t)MP * DM * 2;
constexpr size_t WS_KB = WS_QB + (size_t)MP * 1024 * 2;
constexpr size_t WS_VB = WS_KB + (size_t)MP * 256 * 2;
constexpr size_t WS_RW = WS_VB + (size_t)MP * 256 * 2;
constexpr size_t WS_GT = WS_RW + (size_t)MP * SHD * 2;
constexpr size_t WS_RI = WS_GT + (size_t)MP * DM * 2;
constexpr size_t WS_COEF = WS_RI + 6 * NRI * 4;
constexpr size_t WS_END = WS_COEF + al256((size_t)MT * 16 * 4);

struct Params {
    const float *x_prompt, *x_sample, *cache_k, *cache_v, *state_wkv, *state_shift, *c_prompt, *c_sample, *norm_g, *w_ada, *b_ada, *w_in, *mu_shift, *w0, *w_decay, *a0,
        *w_iclr, *k_k, *k_a, *r_k, *ln_w, *ln_b, *sinks, *w_out, *final_g;
    float* out;
    unsigned char* ws;
};
typedef const __attribute__((address_space(4))) Params* KParamsPtr;
__device__ __forceinline__ const Params& kparams() {
    KParamsPtr k = (KParamsPtr)__builtin_amdgcn_kernarg_segment_ptr();
    asm volatile("" : "+s"(k));
    return *(const Params*)k;
}

__device__ __forceinline__ unsigned short f2bf(float f) { unsigned u = __float_as_uint(f); u += 0x7FFFu + ((u >> 16) & 1u); return (unsigned short)(u >> 16); }
__device__ __forceinline__ float bf2f(unsigned short b) { return __uint_as_float(((unsigned)b) << 16); }
__device__ __forceinline__ unsigned pack2(float lo, float hi) { return (unsigned)f2bf(lo) | ((unsigned)f2bf(hi) << 16); }
__device__ __forceinline__ float bflo(unsigned w) { return __uint_as_float(w << 16); }
__device__ __forceinline__ float bfhi(unsigned w) { return __uint_as_float(w & 0xffff0000u); }
__device__ __forceinline__ float silu_f(float x) { return x / (1.f + __expf(-x)); }
__device__ __forceinline__ float wave_sum(float x) {
#pragma unroll
    for (int o = 32; o >= 1; o >>= 1) x += __shfl_xor(x, o);
    return x;
}
__device__ __forceinline__ float wave_max(float x) {
#pragma unroll
    for (int o = 32; o >= 1; o >>= 1) x = fmaxf(x, __shfl_xor(x, o));
    return x;
}
template <int CTRL> __device__ __forceinline__ float dpp_f(float x) {
    return __builtin_bit_cast(float, __builtin_amdgcn_update_dpp(0, __builtin_bit_cast(int, x), CTRL, 0xF, 0xF, false));
}
__device__ __forceinline__ float allreduce16(float x) {
    x += dpp_f<0x128>(x);
    x += dpp_f<0x124>(x);
    x += dpp_f<0x122>(x);
    x += dpp_f<0x121>(x);
    return x;
}

__device__ void p0_mod_item(const Params& p, float* red, int l, int nc) {
    const int tid = opq_tid(), wv = tid >> 6, lane = tid & 63, n = lane & 31, kh = lane >> 5;
    f32x16 acc0, acc1;
#pragma unroll
    for (int i = 0; i < 16; ++i) { acc0[i] = 0.f; acc1[i] = 0.f; }
    const float* W = p.w_ada + (size_t)l * DM * 6144 + nc * 32 + n;
#pragma unroll 2
    for (int ks = 0; ks < 16; ++ks) {
        const int k0 = wv * 256 + ks * 16 + kh * 8;
        bf16x8 bfr, a0, a1;
#pragma unroll
        for (int j = 0; j < 8; ++j) bfr[j] = (short)f2bf(W[(size_t)(k0 + j) * 6144]);
        const float4* cs = (const float4*)(p.c_sample + (size_t)n * DM + k0);
        const float4 u0 = cs[0], u1 = cs[1];
        a0[0] = (short)f2bf(silu_f(u0.x)); a0[1] = (short)f2bf(silu_f(u0.y)); a0[2] = (short)f2bf(silu_f(u0.z)); a0[3] = (short)f2bf(silu_f(u0.w));
        a0[4] = (short)f2bf(silu_f(u1.x)); a0[5] = (short)f2bf(silu_f(u1.y)); a0[6] = (short)f2bf(silu_f(u1.z)); a0[7] = (short)f2bf(silu_f(u1.w));
        float4 q0 = make_float4(0.f, 0.f, 0.f, 0.f), q1 = q0;
        if (n < 2) { const float4* cp = (const float4*)(p.c_prompt + (size_t)n * DM + k0); q0 = cp[0]; q1 = cp[1]; }
        a1[0] = (short)f2bf(silu_f(q0.x)); a1[1] = (short)f2bf(silu_f(q0.y)); a1[2] = (short)f2bf(silu_f(q0.z)); a1[3] = (short)f2bf(silu_f(q0.w));
        a1[4] = (short)f2bf(silu_f(q1.x)); a1[5] = (short)f2bf(silu_f(q1.y)); a1[6] = (short)f2bf(silu_f(q1.z)); a1[7] = (short)f2bf(silu_f(q1.w));
        acc0 = __builtin_amdgcn_mfma_f32_32x32x16_bf16(a0, bfr, acc0, 0, 0, 0);
        acc1 = __builtin_amdgcn_mfma_f32_32x32x16_bf16(a1, bfr, acc1, 0, 0, 0);
    }
#pragma unroll
    for (int i = 0; i < 16; ++i) red[(wv * 18 + i) * 64 + lane] = acc0[i];
    red[(wv * 18 + 16) * 64 + lane] = acc1[0];
    red[(wv * 18 + 17) * 64 + lane] = acc1[1];
    __syncthreads();
    float* mod = (float*)(p.ws + WS_MOD);
    for (int o = tid; o < 34 * 32; o += 512) {
        const int row = o >> 5, col = o & 31;
        int ri, ln, mrow;
        if (row < 32) { const int khh = (row >> 2) & 1; ri = (row & 3) + 4 * (row >> 3); ln = col + 32 * khh; mrow = 2 + row; }
        else { ri = 16 + (row - 32); ln = col; mrow = row - 32; }
        float s = 0.f;
#pragma unroll
        for (int w = 0; w < 8; ++w) s += red[(w * 18 + ri) * 64 + ln];
        mod[((size_t)l * 34 + mrow) * 6144 + nc * 32 + col] = s + p.b_ada[l * 6144 + nc * 32 + col];
    }
    __syncthreads();
}

__device__ void p0_conv_item(const Params& p, float* s, int cidx) {
    const int tid = opq_tid();
    const int l = cidx / 2240;
    int rem = cidx - l * 2240;
    const float* src; bf16_t* dst; int N, kt, nt;
    if (rem < 1728) { kt = rem & 15; nt = rem >> 4; N = INW; src = p.w_in + (size_t)l * DM * INW; dst = (bf16_t*)(p.ws + WS_WTIN) + (size_t)l * INWP * DM; }
    else { rem -= 1728; kt = rem & 15; nt = rem >> 4; N = DM; src = p.w_out + (size_t)l * DM * DM; dst = (bf16_t*)(p.ws + WS_WTOUT) + (size_t)l * DM * DM; }
    const int k0 = kt * 128, n0 = nt * 64;
    const bool valid = n0 < N;
#pragma unroll
    for (int p4 = 0; p4 < 4; ++p4) {
        const int row = (tid >> 4) + 32 * p4, c4 = tid & 15;
        float4 v = make_float4(0.f, 0.f, 0.f, 0.f);
        if (valid) v = *(const float4*)(src + (size_t)(k0 + row) * N + n0 + 4 * c4);
        float* d = s + row * 65 + 4 * c4;
        d[0] = v.x; d[1] = v.y; d[2] = v.z; d[3] = v.w;
    }
    __syncthreads();
    const int n = tid >> 3, kg = tid & 7;
    unsigned w[8];
#pragma unroll
    for (int j = 0; j < 8; ++j) w[j] = pack2(s[(kg * 16 + 2 * j) * 65 + n], s[(kg * 16 + 2 * j + 1) * 65 + n]);
    uint4* o = (uint4*)(dst + (size_t)(n0 + n) * DM + k0 + kg * 16);
    o[0] = make_uint4(w[0], w[1], w[2], w[3]);
    o[1] = make_uint4(w[4], w[5], w[6], w[7]);
    __syncthreads();
}

__device__ void p0_rope_item(const Params& p, int it) {
    float* rope = (float*)(p.ws + WS_ROPE);
#pragma unroll
    for (int q = 0; q < 4; ++q) {
        const int e = it * 2048 + q * 512 + opq_tid();
        if (e < 4097 * 8) {
            const int idx = e >> 3, i = e & 7;
            const double invf = i == 0 ? 1.0 : i == 1 ? 0.19392274474868576 : i == 2 ? 0.03760603093086393 : i == 3 ? 0.007292664737217109 : i == 4 ? 0.001414213562373095
                              : i == 5 ? 0.0002742481756762073 : i == 6 ? 5.318295896944988e-05 : 1.031338537721246e-05;
            const double pos = idx < 4096 ? (double)idx : 16384.0;
            const double rev = pos * invf * 0.15915494309189535;
            const float f = (float)(rev - floor(rev));
            rope[idx * 16 + i] = __builtin_amdgcn_cosf(f);
            rope[idx * 16 + 8 + i] = __builtin_amdgcn_sinf(f);
        }
    }
}

__device__ void p1_norm(const Params& p, int l, int bid, int G) {
    const int tid = opq_tid(), wv = tid >> 6, lane = tid & 63;
    bf16_t* hb = (bf16_t*)(p.ws + WS_HB);
    const float* mod = (const float*)(p.ws + WS_MOD);
    const float4* g4 = (const float4*)(p.norm_g + l * DM);
    for (int r = bid * 8 + wv; r < MT; r += G * 8) {
        const float* xr = l == 0 ? (r < TP ? p.x_prompt + (size_t)r * DM : p.x_sample + (size_t)(r - TP) * DM) : p.out + (size_t)r * DM;
        const int mrow = r < TP ? (r >> 12) : 2 + (r - TP);
        const float* md = mod + ((size_t)l * 34 + mrow) * 6144;
        float4 v[8]; float ss = 0.f;
#pragma unroll
        for (int i = 0; i < 8; ++i) { v[i] = ((const float4*)xr)[lane + 64 * i]; ss += v[i].x * v[i].x + v[i].y * v[i].y + v[i].z * v[i].z + v[i].w * v[i].w; }
        ss = wave_sum(ss);
        const float rinv = rsqrtf(ss * (1.f / 2048.f) + 1e-5f);
#pragma unroll
        for (int i = 0; i < 8; ++i) {
            const int c4 = lane + 64 * i;
            const float4 g = g4[c4], sc = ((const float4*)(md + 2048))[c4], sh = ((const float4*)md)[c4];
            const float y0 = v[i].x * rinv * g.x * (1.f + sc.x) + sh.x, y1 = v[i].y * rinv * g.y * (1.f + sc.y) + sh.y;
            const float y2 = v[i].z * rinv * g.z * (1.f + sc.z) + sh.z, y3 = v[i].w * rinv * g.w * (1.f + sc.w) + sh.w;
            *(uint2*)(hb + (size_t)r * DM + 4 * c4) = make_uint2(pack2(y0, y1), pack2(y2, y3));
        }
    }
}

struct Epi1 {
    static constexpr bool PERM = false, AFTER_DRAIN = false;
    int l;
    __device__ __forceinline__ void operator()(const f32x4 (&acc)[2][2][4][2], const pg8::Unit& u, int wr, int wc, int fr, int fq) const {
        const Params& p = kparams();
        bf16_t* const qb = (bf16_t*)(p.ws + WS_QB); bf16_t* const kb = (bf16_t*)(p.ws + WS_KB); bf16_t* const vb = (bf16_t*)(p.ws + WS_VB);
        bf16_t* const rw = (bf16_t*)(p.ws + WS_RW); bf16_t* const gt = (bf16_t*)(p.ws + WS_GT); const float* const rope = (const float*)(p.ws + WS_ROPE); float* const out = p.out;
#pragma unroll
        for (int bj = 0; bj < 2; ++bj)
#pragma unroll
            for (int n = 0; n < 2; ++n) {
                const int cb = u.pn * 256 + bj * 128 + wc * 32 + n * 16;
                if (cb >= INW) continue;
                const int c = cb + 4 * fq;
                const bool do_rope = (cb < 1280) && ((cb & 63) == 0);
#pragma unroll
                for (int ai = 0; ai < 2; ++ai)
#pragma unroll
                    for (int m = 0; m < 4; ++m) {
                        const int rb = u.pm * 256 + ai * 128 + wr * 64 + m * 16;
                        if (rb >= MT) continue;
                        const int r = rb + fr;
                        f32x4 v = acc[ai][bj][m][n];
                        if (do_rope) {
                            const int idx = r < TP ? (r & 4095) : 4096;
                            const float4 cs = *(const float4*)(rope + idx * 16 + 4 * (fq & 1));
                            const float4 sn = *(const float4*)(rope + idx * 16 + 8 + 4 * (fq & 1));
                            const float p0 = __shfl_xor(v[0], 32), p1 = __shfl_xor(v[1], 32), p2 = __shfl_xor(v[2], 32), p3 = __shfl_xor(v[3], 32);
                            const float sg = fq < 2 ? -1.f : 1.f;
                            v[0] = v[0] * cs.x + sg * p0 * sn.x; v[1] = v[1] * cs.y + sg * p1 * sn.y; v[2] = v[2] * cs.z + sg * p2 * sn.z; v[3] = v[3] * cs.w + sg * p3 * sn.w;
                        }
                        if (cb < 1024) {
                            *(uint2*)(qb + (size_t)r * 1024 + c) = make_uint2(pack2(v[0] * 0.125f, v[1] * 0.125f), pack2(v[2] * 0.125f, v[3] * 0.125f));
                        } else if (cb < 1536) {
                            const bool isk = cb < 1280;
                            const int cc = c - (isk ? 1024 : 1280);
                            *(uint2*)((isk ? kb : vb) + (size_t)r * 256 + cc) = make_uint2(pack2(v[0], v[1]), pack2(v[2], v[3]));
                            if (r >= TP) {
                                *(f32x4*)(out + (isk ? O_CKS : O_CVS) + ((size_t)(l * NBS + (r - TP)) * 128 + 127) * 256 + cc) = v;
                            } else if ((r & 4095) >= SEQ - 128) {
                                *(f32x4*)(out + (isk ? O_CKP : O_CVP) + ((size_t)(l * NBP + (r >> 12)) * 128 + ((r & 4095) - (SEQ - 128))) * 256 + cc) = v;
                            }
                        } else if (cb < 4736) {
                            const int cc = c - 1536;
                            *(uint2*)(rw + (size_t)r * SHD + cc) = make_uint2(pack2(v[0], v[1]), pack2(v[2], v[3]));
                            if (r >= TP) *(f32x4*)(out + O_SHS + (size_t)(l * NBS + (r - TP)) * SHD + cc) = v;
                            else if ((r & 4095) == SEQ - 1) *(f32x4*)(out + O_SHP + (size_t)(l * NBP + (r >> 12)) * SHD + cc) = v;
                        } else {
                            const int cc = c - 4736;
                            *(uint2*)(gt + (size_t)r * DM + cc) = make_uint2(pack2(silu_f(v[0]), silu_f(v[1])), pack2(silu_f(v[2]), silu_f(v[3])));
                        }
                    }
            }
    }
};

struct Epi2 {
    static constexpr bool PERM = false, AFTER_DRAIN = false;
    int l;
    __device__ __forceinline__ void operator()(const f32x4 (&acc)[2][2][4][2], const pg8::Unit& u, int wr, int wc, int fr, int fq) const {
        const Params& p = kparams();
        const float* const xp = p.x_prompt; const float* const xs = p.x_sample; const float* const modl = (const float*)(p.ws + WS_MOD) + (size_t)l * 34 * 6144; float* const out = p.out;
#pragma unroll
        for (int ai = 0; ai < 2; ++ai)
#pragma unroll
            for (int m = 0; m < 4; ++m) {
                const int rb = u.pm * 256 + ai * 128 + wr * 64 + m * 16;
                if (rb >= MT) continue;
                const int r = rb + fr;
                const int mrow = r < TP ? (r >> 12) : 2 + (r - TP);
                const float* xo = l == 0 ? (r < TP ? xp + (size_t)r * DM : xs + (size_t)(r - TP) * DM) : out + (size_t)r * DM;
                const float* gr = modl + (size_t)mrow * 6144 + 4096;
#pragma unroll
                for (int bj = 0; bj < 2; ++bj)
#pragma unroll
                    for (int n = 0; n < 2; ++n) {
                        const int c = u.pn * 256 + bj * 128 + wc * 32 + n * 16 + 4 * fq;
                        const f32x4 x4 = *(const f32x4*)(xo + c), g4 = *(const f32x4*)(gr + c);
                        *(f32x4*)(out + (size_t)r * DM + c) = x4 + g4 * acc[ai][bj][m][n];
                    }
            }
    }
};

__device__ void p3_attn_unit(const Params& p, unsigned char* lds, int l, int unit) {
    const int tid = opq_tid(), wv = tid >> 6, lane = tid & 63;
    const int b = unit >> 7, n = (unit >> 2) & 31, g = unit & 3;
    bf16_t* Ks = (bf16_t*)lds;
    bf16_t* Vt = (bf16_t*)(lds + 36864);
    const bf16_t* qb = (const bf16_t*)(p.ws + WS_QB);
    const bf16_t* kb = (const bf16_t*)(p.ws + WS_KB);
    const bf16_t* vb = (const bf16_t*)(p.ws + WS_VB);
    const bf16_t* gt = (const bf16_t*)(p.ws + WS_GT);
    bf16_t* cc = (bf16_t*)(p.ws + WS_HB);
#pragma unroll
    for (int i = 0; i < 4; ++i) {
        const int chunk = tid + 512 * i, kl = chunk >> 3, dc = chunk & 7, kp = 128 * (n - 1) + kl;
        uint4 kv4 = make_uint4(0u, 0u, 0u, 0u), vv4 = kv4;
        if (kp >= 0) { const size_t row = (size_t)b * SEQ + kp; kv4 = *(const uint4*)(kb + row * 256 + g * 64 + dc * 8); vv4 = *(const uint4*)(vb + row * 256 + g * 64 + dc * 8); }
        *(uint4*)(Ks + kl * 72 + dc * 8) = kv4;
        bf16_t* vd = Vt + (dc * 8) * 264 + kl;
        vd[0 * 264] = (bf16_t)(vv4.x & 0xffffu); vd[1 * 264] = (bf16_t)(vv4.x >> 16);
        vd[2 * 264] = (bf16_t)(vv4.y & 0xffffu); vd[3 * 264] = (bf16_t)(vv4.y >> 16);
        vd[4 * 264] = (bf16_t)(vv4.z & 0xffffu); vd[5 * 264] = (bf16_t)(vv4.z >> 16);
        vd[6 * 264] = (bf16_t)(vv4.w & 0xffffu); vd[7 * 264] = (bf16_t)(vv4.w >> 16);
    }
    __syncthreads();
    const int hq = 4 * g + (wv >> 1), qh = wv & 1, q32 = lane & 31, h = lane >> 5;
    const float sink = p.sinks[l * 16 + hq];
#pragma unroll 1
    for (int s = 0; s < 2; ++s) {
        const int qp = 128 * n + 64 * qh + 32 * s + q32;
        const size_t qrow = (size_t)b * SEQ + qp;
        const int klb0 = 64 * qh + 32 * s;
        bf16x8 qf[4];
#pragma unroll
        for (int ks = 0; ks < 4; ++ks) qf[ks] = *(const bf16x8*)(qb + qrow * 1024 + hq * 64 + ks * 16 + 8 * h);
        f32x16 S[5];
#pragma unroll
        for (int kt = 0; kt < 5; ++kt) {
#pragma unroll
            for (int i = 0; i < 16; ++i) S[kt][i] = 0.f;
#pragma unroll
            for (int ks = 0; ks < 4; ++ks) {
                const bf16x8 a = *(const bf16x8*)(Ks + (klb0 + 32 * kt + q32) * 72 + ks * 16 + 8 * h);
                S[kt] = __builtin_amdgcn_mfma_f32_32x32x16_bf16(a, qf[ks], S[kt], 0, 0, 0);
            }
        }
        float mx = -1e30f;
#pragma unroll
        for (int kt = 0; kt < 5; ++kt)
#pragma unroll
            for (int i = 0; i < 16; ++i) {
                const int m = 8 * (i >> 2) + 4 * h + (i & 3);
                const int kp = 128 * (n - 1) + klb0 + 32 * kt + m;
                const int rel = qp - kp;
                const bool ok = (rel >= 0) && (rel <= 128) && (kp >= 0);
                const float sv = ok ? S[kt][i] : -1e30f;
                S[kt][i] = sv; mx = fmaxf(mx, sv);
            }
        mx = fmaxf(mx, __shfl_xor(mx, 32));
        mx = fmaxf(mx, sink);
        float sum = 0.f;
#pragma unroll
        for (int kt = 0; kt < 5; ++kt)
#pragma unroll
            for (int i = 0; i < 16; ++i) { const float e = __expf(S[kt][i] - mx); S[kt][i] = e; sum += e; }
        sum += __shfl_xor(sum, 32);
        const float inv = 1.f / (sum + __expf(sink - mx));
        f32x16 O[2];
#pragma unroll
        for (int i = 0; i < 16; ++i) { O[0][i] = 0.f; O[1][i] = 0.f; }
#pragma unroll
        for (int kt = 0; kt < 5; ++kt)
#pragma unroll
            for (int sp = 0; sp < 2; ++sp) {
                bf16x8 pf;
#pragma unroll
                for (int j = 0; j < 8; ++j) pf[j] = (short)f2bf(S[kt][8 * sp + j]);
#pragma unroll
                for (int dt = 0; dt < 2; ++dt) {
                    const bf16_t* vp = Vt + (32 * dt + q32) * 264 + klb0 + 32 * kt + 16 * sp + 4 * h;
                    const uint2 lo = *(const uint2*)vp, hi = *(const uint2*)(vp + 8);
                    const uint4 av = make_uint4(lo.x, lo.y, hi.x, hi.y);
                    O[dt] = __builtin_amdgcn_mfma_f32_32x32x16_bf16(__builtin_bit_cast(bf16x8, av), pf, O[dt], 0, 0, 0);
                }
            }
#pragma unroll
        for (int dt = 0; dt < 2; ++dt)
#pragma unroll
            for (int ig = 0; ig < 4; ++ig) {
                const int col = hq * 64 + 32 * dt + 8 * ig + 4 * h;
                const uint2 gg = *(const uint2*)(gt + qrow * DM + col);
                const float o0 = O[dt][4 * ig + 0] * inv * bflo(gg.x), o1 = O[dt][4 * ig + 1] * inv * bfhi(gg.x);
                const float o2 = O[dt][4 * ig + 2] * inv * bflo(gg.y), o3 = O[dt][4 * ig + 3] * inv * bfhi(gg.y);
                *(uint2*)(cc + qrow * DM + col) = make_uint2(pack2(o0, o1), pack2(o2, o3));
            }
    }
    __syncthreads();
}

__device__ void p3_sattn_item(const Params& p, float* lds, int l, int item) {
    const int tid = opq_tid(), wv = tid >> 6, lane = tid & 63;
    float* pl = lds + wv * 128;
    const int w = item * 8 + wv, bd = w >> 4, hq = w & 15, g = hq >> 2;
    const size_t row = (size_t)TP + bd;
    const bf16_t* qb = (const bf16_t*)(p.ws + WS_QB);
    const bf16_t* gt = (const bf16_t*)(p.ws + WS_GT);
    bf16_t* cc = (bf16_t*)(p.ws + WS_HB);
    float q[64];
#pragma unroll
    for (int c = 0; c < 8; ++c) {
        const uint4 u = *(const uint4*)(qb + row * 1024 + hq * 64 + c * 8);
        q[c * 8 + 0] = bflo(u.x); q[c * 8 + 1] = bfhi(u.x); q[c * 8 + 2] = bflo(u.y); q[c * 8 + 3] = bfhi(u.y);
        q[c * 8 + 4] = bflo(u.z); q[c * 8 + 5] = bfhi(u.z); q[c * 8 + 6] = bflo(u.w); q[c * 8 + 7] = bfhi(u.w);
    }
    const size_t cbase = ((size_t)(l * NBS + bd) * 128) * 256 + g * 64;
    const float* ck = p.cache_k + cbase;
    const float* cv = p.cache_v + cbase;
    float* nk = p.out + O_CKS + cbase;
    float* nv = p.out + O_CVS + cbase;
    float s0 = 0.f, s1 = 0.f, s2 = 0.f;
#pragma unroll
    for (int c = 0; c < 16; ++c) {
        const float4 a = ((const float4*)(ck + (size_t)lane * 256))[c];
        const float4 bq = ((const float4*)(ck + (size_t)(lane + 64) * 256))[c];
        const float4 e = ((const float4*)(nk + (size_t)127 * 256))[c];
        s0 += a.x * q[4 * c] + a.y * q[4 * c + 1] + a.z * q[4 * c + 2] + a.w * q[4 * c + 3];
        s1 += bq.x * q[4 * c] + bq.y * q[4 * c + 1] + bq.z * q[4 * c + 2] + bq.w * q[4 * c + 3];
        s2 += e.x * q[4 * c] + e.y * q[4 * c + 1] + e.z * q[4 * c + 2] + e.w * q[4 * c + 3];
    }
    const float sink = p.sinks[l * 16 + hq];
    const float mx = fmaxf(wave_max(fmaxf(s0, s1)), fmaxf(s2, sink));
    const float p0 = __expf(s0 - mx), p1 = __expf(s1 - mx), p2 = __expf(s2 - mx);
    const float sum = wave_sum(p0 + p1) + p2 + __expf(sink - mx);
    pl[lane] = p0; pl[lane + 64] = p1;
    __builtin_amdgcn_fence(__ATOMIC_RELEASE, "wavefront");
    __builtin_amdgcn_wave_barrier();
    __builtin_amdgcn_fence(__ATOMIC_ACQUIRE, "wavefront");
    float o = 0.f;
#pragma unroll 8
    for (int key = 0; key < 128; ++key) o += pl[key] * cv[(size_t)key * 256 + lane];
    o += p2 * nv[(size_t)127 * 256 + lane];
    o /= sum;
    const float gate = bf2f(gt[row * DM + hq * 64 + lane]);
    cc[row * DM + hq * 64 + lane] = f2bf(o * gate);
    for (int i = 0; i < 32; ++i) {
        const int ww = (hq & 3) + 4 * i;
        if (ww < 127) { nk[(size_t)ww * 256 + lane] = ck[(size_t)(ww + 1) * 256 + lane]; nv[(size_t)ww * 256 + lane] = cv[(size_t)(ww + 1) * 256 + lane]; }
    }
    __builtin_amdgcn_wave_barrier();
}

__device__ __forceinline__ float mix_val(const bf16_t* rw, const float* sshift, const float* mu, int r, int c) {
    const float cur = bf2f(rw[(size_t)r * SHD + c]);
    float prev;
    if (r >= TP) prev = sshift[(size_t)(r - TP) * SHD + c];
    else if ((r & 4095) == 0) prev = 0.f;
    else prev = bf2f(rw[(size_t)(r - 1) * SHD + c]);
    return cur + (prev - cur) * mu[c];
}

__device__ void p3_prep_tile(const Params& p, float* lds, int l, int tile) {
    const int tid = opq_tid(), wv = tid >> 6, lane = tid & 63;
    float* tw = lds;
    float* adl = lds + 1024;
    const bf16_t* rw = (const bf16_t*)(p.ws + WS_RW);
    const float* sshift = p.state_shift + (size_t)l * NBS * SHD;
    const float* mu = p.mu_shift + l * SHD;
    float* RI = (float*)(p.ws + WS_RI);
    float* coef = (float*)(p.ws + WS_COEF);
    const int r0 = tile * 16;
#pragma unroll
    for (int i = 0; i < 4; ++i) {
        const int idx = tid + 512 * i, tt = idx >> 7, c2 = idx & 127;
        const float m = mix_val(rw, sshift, mu, r0 + tt, 3072 + c2);
        if (c2 < 64) { const float e = __expf(2.f * m); tw[tt * 64 + c2] = 1.f - 2.f / (e + 1.f); }
        else adl[tt * 64 + (c2 - 64)] = m;
    }
    __syncthreads();
    float aw[16][2], aa[16][2];
#pragma unroll
    for (int tt = 0; tt < 16; ++tt) { aw[tt][0] = 0.f; aw[tt][1] = 0.f; aa[tt][0] = 0.f; aa[tt][1] = 0.f; }
    const float* wdp = p.w_decay + (size_t)l * 64 * 1024 + tid;
    const float* wip = p.w_iclr + (size_t)l * 64 * 1024 + tid;
#pragma unroll 1
    for (int j4 = 0; j4 < 16; ++j4) {
        float wd[4][2], wi[4][2];
#pragma unroll
        for (int jj = 0; jj < 4; ++jj)
#pragma unroll
            for (int ci = 0; ci < 2; ++ci) { wd[jj][ci] = wdp[(4 * j4 + jj) * 1024 + 512 * ci]; wi[jj][ci] = wip[(4 * j4 + jj) * 1024 + 512 * ci]; }
#pragma unroll
        for (int tt = 0; tt < 16; ++tt) {
            const float4 t4 = *(const float4*)(tw + tt * 64 + 4 * j4);
            const float4 a4 = *(const float4*)(adl + tt * 64 + 4 * j4);
#pragma unroll
            for (int ci = 0; ci < 2; ++ci) {
                aw[tt][ci] += t4.x * wd[0][ci] + t4.y * wd[1][ci] + t4.z * wd[2][ci] + t4.w * wd[3][ci];
                aa[tt][ci] += a4.x * wi[0][ci] + a4.y * wi[1][ci] + a4.z * wi[2][ci] + a4.w * wi[3][ci];
            }
        }
    }
#pragma unroll
    for (int ci = 0; ci < 2; ++ci) {
        const int c = tid + 512 * ci, head = wv + 8 * ci;
        const float w0c = p.w0[l * 1024 + c], a0c = p.a0[l * 1024 + c], kkc = p.k_k[l * 1024 + c], kac = p.k_a[l * 1024 + c], rkc = p.r_k[l * 1024 + c];
#pragma unroll
        for (int tt = 0; tt < 16; ++tt) {
            const int r = r0 + tt;
            const float z = -(w0c + aw[tt][ci]);
            const float sp = fmaxf(z, 0.f) + __logf(1.f + __expf(-fabsf(z)));
            const float decay = __expf(-__expf(-sp - 0.5f));
            const float a = 1.f / (1.f + __expf(-(a0c + aa[tt][ci])));
            const float rr = mix_val(rw, sshift, mu, r, c), kr = mix_val(rw, sshift, mu, r, 1024 + c), vr = mix_val(rw, sshift, mu, r, 2048 + c);
            const float kkr = kr * kkc;
            const float ss = wave_sum(kkr * kkr);
            const float kk = kkr / fmaxf(sqrtf(ss), 1e-12f);
            const float ke = kr * (1.f + (a - 1.f) * kac);
            const float cf = wave_sum(rr * ke * rkc);
            if (lane == 0) coef[(size_t)r * 16 + head] = cf;
            const size_t o = (size_t)r * 1024 + c;
            RI[o] = rr; RI[NRI + o] = decay; RI[2 * NRI + o] = ke; RI[3 * NRI + o] = kk; RI[4 * NRI + o] = kk * a; RI[5 * NRI + o] = vr;
        }
    }
    __syncthreads();
}

struct Step4 { float4 r, w, k, kk, b; float v; };
__device__ __forceinline__ float wkv_step(float4& s, const Step4& x) {
    float pa = s.x * x.kk.x + s.y * x.kk.y + s.z * x.kk.z + s.w * x.kk.w;
    pa = allreduce16(pa);
    const float sa = -pa;
    s.x = fmaf(sa, x.b.x, fmaf(s.x, x.w.x, x.v * x.k.x));
    s.y = fmaf(sa, x.b.y, fmaf(s.y, x.w.y, x.v * x.k.y));
    s.z = fmaf(sa, x.b.z, fmaf(s.z, x.w.z, x.v * x.k.z));
    s.w = fmaf(sa, x.b.w, fmaf(s.w, x.w.w, x.v * x.k.w));
    float py = s.x * x.r.x + s.y * x.r.y + s.z * x.r.z + s.w * x.r.w;
    return allreduce16(py);
}

__device__ void p3_recur(const Params& p, float* lds, int l, int bid, int G) {
    const int tid = opq_tid(), wv = tid >> 6, lane = tid & 63;
    const float* RI = (const float*)(p.ws + WS_RI);
    float* ys = (float*)(p.ws + WS_RW);
    if (bid < 128) {
        const int hh = bid >> 2, qd = bid & 3, b = hh >> 4, h = hh & 15;
        const size_t rowbase = (size_t)b * SEQ;
        constexpr int CH = 32, STEPF = 336, BUFF = CH * STEPF;
        const bool prod = wv >= 4;
        const int ptid = tid - 256;
        float4 pr[10]; float2 pv;
#define RC_PLOAD(c) do { _Pragma("unroll") for (int i_ = 0; i_ < 10; ++i_) { const int idx_ = ptid + 256 * i_, st_ = idx_ / 80, rem_ = idx_ - st_ * 80, arr_ = rem_ >> 4, q4_ = rem_ & 15; \
            pr[i_] = *(const float4*)(RI + (size_t)arr_ * NRI + (rowbase + (size_t)(c) * CH + st_) * 1024 + h * 64 + 4 * q4_); } \
        { const int idx2_ = ptid * 2, st_ = idx2_ >> 4, ii_ = idx2_ & 15; pv = *(const float2*)(RI + 5 * NRI + (rowbase + (size_t)(c) * CH + st_) * 1024 + h * 64 + 16 * qd + ii_); } } while (0)
#define RC_PSTORE(bufp) do { _Pragma("unroll") for (int i_ = 0; i_ < 10; ++i_) { const int idx_ = ptid + 256 * i_, st_ = idx_ / 80, rem_ = idx_ - st_ * 80, arr_ = rem_ >> 4, q4_ = rem_ & 15; \
            *(float4*)((bufp) + st_ * STEPF + arr_ * 64 + 4 * q4_) = pr[i_]; } \
        { const int idx2_ = ptid * 2, st_ = idx2_ >> 4, ii_ = idx2_ & 15; *(float2*)((bufp) + st_ * STEPF + 320 + ii_) = pv; } } while (0)
        if (prod) { RC_PLOAD(0); RC_PSTORE(lds); }
        asm volatile("s_waitcnt lgkmcnt(0)" ::: "memory");
        __builtin_amdgcn_s_barrier();
        float4 s = make_float4(0.f, 0.f, 0.f, 0.f);
        const int irow = 16 * qd + 4 * wv + (lane >> 4), jq = lane & 15;
#pragma unroll 1
        for (int c = 0; c < SEQ / CH; ++c) {
            float* bcur = lds + (c & 1) * BUFF;
            float* bnxt = lds + ((c + 1) & 1) * BUFF;
            if (prod) {
                if (c + 1 < SEQ / CH) { RC_PLOAD(c + 1); RC_PSTORE(bnxt); }
            } else {
                const float* sp = bcur + 4 * jq;
                const float* vp = bcur + 320 + 4 * wv + (lane >> 4);
                Step4 nx;
                nx.r = *(const float4*)(sp); nx.w = *(const float4*)(sp + 64); nx.k = *(const float4*)(sp + 128); nx.kk = *(const float4*)(sp + 192); nx.b = *(const float4*)(sp + 256); nx.v = *vp;
                float* yp = ys + (rowbase + (size_t)c * CH) * 1024 + h * 64 + irow;
#pragma unroll 4
                for (int st = 0; st < CH; ++st) {
                    const Step4 cu = nx;
                    if (st + 1 < CH) {
                        const float* sq = sp + (st + 1) * STEPF;
                        nx.r = *(const float4*)(sq); nx.w = *(const float4*)(sq + 64); nx.k = *(const float4*)(sq + 128); nx.kk = *(const float4*)(sq + 192); nx.b = *(const float4*)(sq + 256);
                        nx.v = vp[(st + 1) * STEPF];
                    }
                    const float y = wkv_step(s, cu);
                    if (jq == 0) yp[(size_t)st * 1024] = y;
                }
            }
            asm volatile("s_waitcnt lgkmcnt(0)" ::: "memory");
            __builtin_amdgcn_s_barrier();
        }
#undef RC_PLOAD
#undef RC_PSTORE
        if (!prod) *(float4*)(p.out + O_WKVP + (((size_t)(l * NBP + b) * 16 + h) * 64 + irow) * 64 + 4 * jq) = s;
    } else {
        const int nw = (G - 128) * 8;
        for (int task = (bid - 128) * 8 + wv; task < NBS * 16 * 16; task += nw) {
            const int bd = task >> 8, h = (task >> 4) & 15, wq = task & 15;
            const int irow = 4 * wq + (lane >> 4), jq = lane & 15;
            const size_t row = (size_t)TP + bd;
            const size_t so = (((size_t)(l * NBS + bd) * 16 + h) * 64 + irow) * 64 + 4 * jq;
            float4 s = *(const float4*)(p.state_wkv + so);
            const size_t o = row * 1024 + h * 64 + 4 * jq;
            Step4 x;
            x.r = *(const float4*)(RI + o); x.w = *(const float4*)(RI + NRI + o); x.k = *(const float4*)(RI + 2 * NRI + o); x.kk = *(const float4*)(RI + 3 * NRI + o); x.b = *(const float4*)(RI + 4 * NRI + o);
            x.v = RI[5 * NRI + row * 1024 + h * 64 + irow];
            const float y = wkv_step(s, x);
            *(float4*)(p.out + O_WKVS + so) = s;
            if (jq == 0) ys[row * 1024 + h * 64 + irow] = y;
        }
    }
}

__device__ void p3_post(const Params& p, int l, int bid, int G) {
    const int tid = opq_tid(), wv = tid >> 6, lane = tid & 63;
    const float* ys = (const float*)(p.ws + WS_RW);
    const float* V = (const float*)(p.ws + WS_RI) + 5 * NRI;
    const float* coef = (const float*)(p.ws + WS_COEF);
    const bf16_t* gt = (const bf16_t*)(p.ws + WS_GT);
    bf16_t* cc = (bf16_t*)(p.ws + WS_HB);
    for (int r = bid * 8 + wv; r < MT; r += G * 8) {
#pragma unroll
        for (int hg = 0; hg < 4; ++hg) {
            const int head = 4 * hg + (lane >> 4), c = head * 64 + 4 * (lane & 15);
            const float4 y = *(const float4*)(ys + (size_t)r * 1024 + c);
            const float mu = allreduce16(y.x + y.y + y.z + y.w) * (1.f / 64.f);
            const float d0 = y.x - mu, d1 = y.y - mu, d2 = y.z - mu, d3 = y.w - mu;
            const float var = allreduce16(d0 * d0 + d1 * d1 + d2 * d2 + d3 * d3) * (1.f / 64.f);
            const float rs = rsqrtf(var + 64e-5f);
            const float4 lw = *(const float4*)(p.ln_w + l * 1024 + c), lb = *(const float4*)(p.ln_b + l * 1024 + c), v4 = *(const float4*)(V + (size_t)r * 1024 + c);
            const float cf = coef[(size_t)r * 16 + head];
            const uint2 gg = *(const uint2*)(gt + (size_t)r * DM + 1024 + c);
            const float o0 = (d0 * rs * lw.x + lb.x + cf * v4.x) * bflo(gg.x), o1 = (d1 * rs * lw.y + lb.y + cf * v4.y) * bfhi(gg.x);
            const float o2 = (d2 * rs * lw.z + lb.z + cf * v4.z) * bflo(gg.y), o3 = (d3 * rs * lw.w + lb.w + cf * v4.w) * bfhi(gg.y);
            *(uint2*)(cc + (size_t)r * DM + 1024 + c) = make_uint2(pack2(o0, o1), pack2(o2, o3));
        }
    }
}

__device__ void p_final(const Params& p, int bid, int G) {
    const int tid = opq_tid(), wv = tid >> 6, lane = tid & 63;
    const float4* g4 = (const float4*)p.final_g;
    for (int r = bid * 8 + wv; r < MT; r += G * 8) {
        float4* xr = (float4*)(p.out + (size_t)r * DM);
        float4 v[8]; float ss = 0.f;
#pragma unroll
        for (int i = 0; i < 8; ++i) { v[i] = xr[lane + 64 * i]; ss += v[i].x * v[i].x + v[i].y * v[i].y + v[i].z * v[i].z + v[i].w * v[i].w; }
        ss = wave_sum(ss);
        const float rinv = rsqrtf(ss * (1.f / 2048.f) + 1e-5f);
#pragma unroll
        for (int i = 0; i < 8; ++i) { const float4 g = g4[lane + 64 * i]; xr[lane + 64 * i] = make_float4(v[i].x * rinv * g.x, v[i].y * rinv * g.y, v[i].z * rinv * g.z, v[i].w * rinv * g.w); }
    }
}

__global__ void __launch_bounds__(512, 2) fwd_kernel(Params p_unused) {
    extern __shared__ __attribute__((aligned(16))) unsigned char shm[];
    cg::grid_group grid = cg::this_grid();
    const int bid = blockIdx.x, G = gridDim.x;
    float* shf = (float*)shm;

    for (int it = bid; it < 384 + 4480 + 17; it += G) {
        if (it < 384) p0_mod_item(kparams(), shf, it / 192, it % 192);
        else if (it < 384 + 4480) p0_conv_item(kparams(), shf, it - 384);
        else p0_rope_item(kparams(), it - (384 + 4480));
    }
    grid.sync();

#pragma unroll 1
    for (int l = 0; l < DEPTH; ++l) {
        p1_norm(kparams(), l, bid, G);
        grid.sync();
        {
            pg8::StaticOrder S; S.init(MP, INWP, G, bid);
            pg8::Gemm g{(const bf16_t*)(kparams().ws + WS_HB), (const bf16_t*)(kparams().ws + WS_WTIN) + (size_t)l * INWP * DM, MP, INWP, DM};
            Epi1 E{l};
            pg8::gemm_phase<Epi1, pg8::StaticOrder, false>((PG8_LAS unsigned char*)shm, g, S, E, nullptr);
        }
        grid.sync();
        for (int it = bid; it < 256 + 64 + 514; it += G) {
            if (it < 256) p3_attn_unit(kparams(), shm, l, it);
            else if (it < 320) p3_sattn_item(kparams(), shf, l, it - 256);
            else p3_prep_tile(kparams(), shf, l, it - 320);
        }
        grid.sync();
        p3_recur(kparams(), shf, l, bid, G);
        grid.sync();
        p3_post(kparams(), l, bid, G);
        grid.sync();
        {
            pg8::StaticOrder S; S.init(MP, DM, G, bid);
            pg8::Gemm g{(const bf16_t*)(kparams().ws + WS_HB), (const bf16_t*)(kparams().ws + WS_WTOUT) + (size_t)l * DM * DM, MP, DM, DM};
            Epi2 E{l};
            pg8::gemm_phase<Epi2, pg8::StaticOrder, false>((PG8_LAS unsigned char*)shm, g, S, E, nullptr);
        }
        grid.sync();
    }
    p_final(kparams(), bid, G);
}

extern "C" void kernel_launch(void* const* d_in, const int* in_sizes, int n_in, void* d_out, int out_size, void* d_ws, size_t ws_size, hipStream_t stream) {
    static int grid_blocks = 0;
    if (grid_blocks == 0) {
        if (n_in != 25 || (size_t)out_size != O_END || ws_size < WS_END) {
            fprintf(stderr, "kernel_launch: unexpected shapes: n_in %d out_size %d ws_size %zu (need %zu)\n", n_in, out_size, ws_size, (size_t)WS_END);
            grid_blocks = -1; return;
        }
        if (hipFuncSetAttribute((const void*)fwd_kernel, hipFuncAttributeMaxDynamicSharedMemorySize, LDS_BYTES) != hipSuccess) { fprintf(stderr, "kernel_launch: hipFuncSetAttribute failed\n"); grid_blocks = -1; return; }
        int dev = 0, cus = 0, per_cu = 0;
        hipGetDevice(&dev);
        hipDeviceGetAttribute(&cus, hipDeviceAttributeMultiprocessorCount, dev);
        hipOccupancyMaxActiveBlocksPerMultiprocessor(&per_cu, (const void*)fwd_kernel, 512, LDS_BYTES);
        if (per_cu < 1) { fprintf(stderr, "kernel_launch: occupancy query gives %d blocks per CU\n", per_cu); per_cu = 1; }
        (void)hipGetLastError();
        grid_blocks = cus;
        if (grid_blocks < 192) { fprintf(stderr, "kernel_launch: only %d CUs\n", grid_blocks); grid_blocks = -1; return; }
    }
    if (grid_blocks < 0) return;
    Params p{};
    const float** pp = (const float**)&p;
    for (int i = 0; i < 25; ++i) pp[i] = (const float*)d_in[i];
    p.out = (float*)d_out; p.ws = (unsigned char*)d_ws;
    void* args[] = {&p};
    hipError_t e = hipLaunchCooperativeKernel((const void*)fwd_kernel, dim3(grid_blocks), dim3(512), args, LDS_BYTES, stream);
    if (e != hipSuccess) fprintf(stderr, "cooperative launch failed: %s (grid %d)\n", hipGetErrorString(e), grid_blocks);
}
```

```cpp
#include <hip/hip_runtime.h>
#include <hip/hip_cooperative_groups.h>
#include <cstdio>
namespace cg = cooperative_groups;
__device__ __forceinline__ int opq_tid() { int t = threadIdx.x; asm volatile("" : "+v"(t)); return t; }
__device__ __forceinline__ int opq_s(int x) { asm volatile("" : "+s"(x)); return x; }
namespace pg8 {
#define PG8_LAS __attribute__((address_space(3)))
typedef unsigned short bf16_t;
typedef short bf16x8 __attribute__((ext_vector_type(8)));
typedef float f32x4 __attribute__((ext_vector_type(4)));
typedef unsigned u32x4 __attribute__((ext_vector_type(4)));
constexpr int BM = 256, BK = 64, HALF = 128, HTB = HALF * BK * 2  , STAGE_BYTES = 8 * HTB, NXCD = 8, WGM = 8;

__host__ __device__ __forceinline__ int lds_byte(int r, int c) { const int st = (r >> 4) * 2 + (c >> 5), rr = r & 15, cc = c & 31, ob = rr * 64 + cc * 2; return st * 1024 + (ob ^ (((ob >> 9) & 1) << 5)); }
__host__ __device__ __forceinline__ void stage_rc(int b, int& R, int& C) { const int st = b / 1024, sb = b % 1024, swz = sb ^ (((sb >> 9) & 1) << 5); R = (st >> 1) * 16 + swz / 64; C = (st & 1) * 32 + (swz % 64) / 2; }
__host__ __device__ __forceinline__ int perm32(int rho) { const int n = rho >> 4, i = rho & 15; return 8 * (i >> 2) + 4 * n + (i & 3); }

struct Unit { int pm, pn; };
struct Gemm { const bf16_t* A; const bf16_t* Bt; int M, N, K; };

struct StaticOrder {
    int nM, nN, nwg, G, c;
    __host__ __device__ void init(int M, int N, int G_, int c_) { nM = M / BM; nN = N / BM; nwg = nM * nN; G = G_; c = c_; }
    __host__ __device__ bool next(int i, Unit& u) const {
        const long L = (long)i * G + c; if (L >= nwg) return false;
        int wgid = (int)L; { const int q = nwg / NXCD, r = nwg % NXCD, xcd = wgid % NXCD, off = wgid / NXCD; wgid = (xcd < r ? xcd * (q + 1) : r * (q + 1) + (xcd - r) * q) + off; }
        const int nig = WGM * nN, gid = wgid / nig, fm = gid * WGM, gsz = (nM - fm) < WGM ? (nM - fm) : WGM;
        u.pm = fm + ((wgid % nig) % gsz); u.pn = (wgid % nig) / gsz; return true;
    }
    __device__ __forceinline__ void a_ready(const Unit&) const {}
    __device__ __forceinline__ void done(const Unit&) const {}
};
template <class Epi, class Sched, bool STAMP = false>
__device__ __forceinline__ void gemm_phase(PG8_LAS unsigned char* lds, const Gemm g, const Sched& S, const Epi& E, unsigned long long* stamps) {
    const int tid = opq_tid(), wid = __builtin_amdgcn_readfirstlane(tid >> 6), lane = tid & 63, wr = wid >> 2, wc = wid & 3, fr = lane & 15, fq = lane >> 4;
    const int K = g.K, nt = K / BK;
    int ts_lo = 0, ts_hi = 0, nts = 0; const unsigned long long rt_entry = STAMP ? (unsigned long long)wall_clock64() : 0ull;
#define PG8_STAMP() do { if (STAMP && wid == 0 && nts < 64) { const unsigned long long _c = (unsigned long long)clock64(); \
        ts_lo = (lane == nts) ? (int)(unsigned)_c : ts_lo; ts_hi = (lane == nts) ? (int)(unsigned)(_c >> 32) : ts_hi; ++nts; } } while (0)
    PG8_STAMP();
    unsigned voffA[2], voffB[2];
#pragma unroll
    for (int i = 0; i < 2; ++i) { int R, C; stage_rc(tid * 16 + i * 8192, R, C); const int Rb = Epi::PERM ? ((R & ~31) + perm32(R & 31)) : R;
        voffA[i] = (unsigned)(R * K + C) * 2u; voffB[i] = (unsigned)(Rb * K + C) * 2u; }
    const size_t kstep = (size_t)(BK * 2);
    const size_t hstep = (size_t)HALF * K * 2;
    const size_t tstep = 2 * hstep;
    const unsigned ldsw = (unsigned)wid * 1024u;
    const int aoff = lds_byte(wr * 64 + fr, fq * 8), boff = lds_byte(wc * 32 + fr, fq * 8);
#define PG8_SA(b, h) (((b) * 2 + (h)) * HTB)
#define PG8_SB(b, h) ((4 + (b) * 2 + (h)) * HTB)
#define PG8_STAGE(bufoff, gbase, voff) do { _Pragma("unroll") for (int _i = 0; _i < 2; ++_i) \
        __builtin_amdgcn_global_load_lds((const unsigned*)((const char*)(gbase) + (voff)[_i]), (PG8_LAS unsigned*)(lds + (bufoff) + ldsw + _i * 8192), 16, 0, 0); } while (0)
#define PG8_LDA(dst, b, h) do { _Pragma("unroll") for (int m = 0; m < 4; ++m) _Pragma("unroll") for (int k = 0; k < 2; ++k) dst[m][k] = *(const PG8_LAS bf16x8*)(lds + PG8_SA(b, h) + aoff + m * 2048 + k * 1024); } while (0)
#define PG8_LDB(dst, b, h) do { _Pragma("unroll") for (int n = 0; n < 2; ++n) _Pragma("unroll") for (int k = 0; k < 2; ++k) dst[n][k] = *(const PG8_LAS bf16x8*)(lds + PG8_SB(b, h) + boff + n * 2048 + k * 1024); } while (0)
#define PG8_MMA(ai, bj, At, Bt) do { __builtin_amdgcn_s_setprio(1); _Pragma("unroll") for (int m = 0; m < 4; ++m) _Pragma("unroll") for (int n = 0; n < 2; ++n) _Pragma("unroll") for (int k = 0; k < 2; ++k) \
        acc[ai][bj][m][n] = __builtin_amdgcn_mfma_f32_16x16x32_bf16(Bt[n][k], At[m][k], acc[ai][bj][m][n], 0, 0, 0); __builtin_amdgcn_s_setprio(0); } while (0)
#define PG8_WAIT_V(n) asm volatile("s_waitcnt vmcnt(" #n ")" ::: "memory")
#define PG8_WAIT_L(n) asm volatile("s_waitcnt lgkmcnt(" #n ")" ::: "memory")
#define PG8_BAR __builtin_amdgcn_s_barrier()
#define PG8_SCHED __builtin_amdgcn_sched_barrier(0)
    Unit cur, nxt; int ui = 0;
    if (!S.next(0, cur)) return;
    f32x4 acc[2][2][4][2];
#pragma unroll
    for (int a = 0; a < 2; ++a)
#pragma unroll
        for (int b = 0; b < 2; ++b)
#pragma unroll
            for (int m = 0; m < 4; ++m)
#pragma unroll
                for (int n = 0; n < 2; ++n) acc[a][b][m][n] = (f32x4){0.f, 0.f, 0.f, 0.f};
    bf16x8 At[4][2], B0[2][2], B1[2][2];
    const char* cA = (const char*)g.A + (size_t)cur.pm * tstep; const char* cB = (const char*)g.Bt + (size_t)cur.pn * tstep;
    S.a_ready(cur);
    PG8_STAGE(PG8_SB(0, 0), cB, voffB); PG8_STAGE(PG8_SA(0, 0), cA, voffA); PG8_STAGE(PG8_SB(0, 1), cB + hstep, voffB); PG8_STAGE(PG8_SA(0, 1), cA + hstep, voffA);
    if (wr == 1) PG8_BAR;
    PG8_WAIT_V(4); PG8_BAR;
    PG8_STAGE(PG8_SB(1, 0), cB + kstep, voffB); PG8_STAGE(PG8_SA(1, 0), cA + kstep, voffA); PG8_STAGE(PG8_SB(1, 1), cB + hstep + kstep, voffB);
    PG8_WAIT_V(6); PG8_BAR;
    PG8_STAMP();
    for (;;) {
        const bool has_next = S.next(ui + 1, nxt);
        const char* nA = has_next ? (const char*)g.A + (size_t)nxt.pm * tstep : cA; const char* nB = has_next ? (const char*)g.Bt + (size_t)nxt.pn * tstep : cB;
        for (int t = 0; t < nt; t += 2) {
            const bool last = (t == nt - 2);
            const char* a1 = cA + (size_t)(t + 1) * kstep;
            const char* a2 = last ? nA : cA + (size_t)(t + 2) * kstep; const char* b2 = last ? nB : cB + (size_t)(t + 2) * kstep;
            const char* a3 = a2 + kstep; const char* b3 = b2 + kstep;
            if (last && has_next) S.a_ready(nxt);
            PG8_LDB(B0, 0, 0); PG8_SCHED; PG8_LDA(At, 0, 0); PG8_STAGE(PG8_SA(1, 1), a1 + hstep, voffA);
            PG8_WAIT_L(8); PG8_BAR; PG8_WAIT_L(0); PG8_MMA(0, 0, At, B0); PG8_BAR; PG8_SCHED;
            PG8_LDB(B1, 0, 1); PG8_STAGE(PG8_SB(0, 0), b2, voffB);
            PG8_BAR; PG8_WAIT_L(0); PG8_MMA(0, 1, At, B1); PG8_BAR;
            PG8_LDA(At, 0, 1); PG8_STAGE(PG8_SA(0, 0), a2, voffA);
            PG8_BAR; PG8_WAIT_L(0); PG8_MMA(1, 0, At, B0); PG8_BAR; PG8_SCHED;
            PG8_STAGE(PG8_SB(0, 1), b2 + hstep, voffB);
            PG8_WAIT_V(6); PG8_BAR; PG8_MMA(1, 1, At, B1); PG8_BAR;
            PG8_LDB(B0, 1, 0); PG8_SCHED; PG8_LDA(At, 1, 0); PG8_STAGE(PG8_SA(0, 1), a2 + hstep, voffA);
            PG8_WAIT_L(8); PG8_BAR; PG8_WAIT_L(0); PG8_MMA(0, 0, At, B0); PG8_BAR; PG8_SCHED;
            PG8_LDB(B1, 1, 1); PG8_STAGE(PG8_SB(1, 0), b3, voffB);
            PG8_BAR; PG8_WAIT_L(0); PG8_MMA(0, 1, At, B1); PG8_BAR;
            PG8_LDA(At, 1, 1); PG8_STAGE(PG8_SA(1, 0), a3, voffA);
            PG8_BAR; PG8_WAIT_L(0); PG8_MMA(1, 0, At, B0); PG8_BAR; PG8_SCHED;
            PG8_STAGE(PG8_SB(1, 1), b3 + hstep, voffB);
            PG8_WAIT_V(6); PG8_BAR; PG8_MMA(1, 1, At, B1); PG8_BAR;
        }
        PG8_STAMP();
        if constexpr (!Epi::AFTER_DRAIN) { E(acc, cur, wr, wc, fr, fq); S.done(cur); }
        PG8_STAMP();
        if (!has_next) break;
#pragma unroll
        for (int a = 0; a < 2; ++a)
#pragma unroll
            for (int b = 0; b < 2; ++b)
#pragma unroll
                for (int m = 0; m < 4; ++m)
#pragma unroll
                    for (int n = 0; n < 2; ++n) acc[a][b][m][n] = (f32x4){0.f, 0.f, 0.f, 0.f};
        cur = nxt; cA = nA; cB = nB; ++ui;
    }
    PG8_WAIT_V(0);
    if (wr == 0) PG8_BAR;
    PG8_BAR;
    if constexpr (Epi::AFTER_DRAIN) { E.fused(acc, cur, wr, wc, fr, fq, lds, wid, lane); S.done(cur); }
    PG8_STAMP();
    if (STAMP && wid == 0) { stamps[lane] = lane < nts ? (((unsigned long long)(unsigned)ts_hi << 32) | (unsigned)ts_lo) : 0ull;
        if (lane == 62) stamps[62] = rt_entry; if (lane == 63) stamps[63] = (unsigned long long)wall_clock64(); }
#undef PG8_STAMP
#undef PG8_SA
#undef PG8_SB
#undef PG8_STAGE
#undef PG8_LDA
#undef PG8_LDB
#undef PG8_MMA
#undef PG8_WAIT_V
#undef PG8_WAIT_L
#undef PG8_BAR
#undef PG8_SCHED
}
}

#define XB_TMO      128
#define XB_XCNT(j)  (256  + 64 * (j))
#define XB_XSUB(j)  (1280 + 64 * (j))
#define XB_XGEN(j)  (2304 + 64 * (j))
#define XB_TOP      3328
#define XB_TOPGEN   3392
#define XCD_BAR_WORDS 3456
#define XB_SPIN_CAP (1u << 18)
#define LAS __attribute__((address_space(3)))

__device__ __forceinline__ unsigned xb_ld(unsigned* p)              { return __hip_atomic_load(p, __ATOMIC_RELAXED, __HIP_MEMORY_SCOPE_AGENT); }
__device__ __forceinline__ unsigned xb_add(unsigned* p, unsigned v) { return __hip_atomic_fetch_add(p, v, __ATOMIC_RELAXED, __HIP_MEMORY_SCOPE_AGENT); }
__device__ __forceinline__ unsigned xb_xcc_id() { return (unsigned)__builtin_amdgcn_s_getreg((3 << 11) | 20) & 0xFu; }
#define XB_SPIN(cond, bar) do { unsigned _sp = 0; while (cond) { __builtin_amdgcn_s_sleep(1); \
    if ((++_sp & 255u) == 0u) { if (xb_ld(&(bar)[XB_TMO])) break; if (_sp > XB_SPIN_CAP) { atomicAdd(&(bar)[XB_TMO], 1u); break; } } } } while (0)

struct XcdBarrier {
    unsigned* bar; unsigned x;
    volatile LAS unsigned* st;
};

__device__ __forceinline__ XcdBarrier xcd_barrier_post(unsigned* bar, volatile LAS unsigned* st) {
    XcdBarrier b; b.bar = bar; b.x = xb_xcc_id(); b.st = st;
    if (threadIdx.x == 0) (void)xb_add(&bar[XB_XCNT(b.x)], 1u);
    return b;
}
__device__ __forceinline__ void xcd_barrier_complete(unsigned* bar, unsigned x, unsigned& nloc, unsigned& nx) {
    const unsigned G = gridDim.x * gridDim.y * gridDim.z;
    unsigned sum, cnt, mine, sp = 0u;
    for (;;) {
        sum = 0u; cnt = 0u; mine = 0u;
#pragma unroll
        for (unsigned j = 0; j < 16; ++j) { const unsigned c = xb_ld(&bar[XB_XCNT(j)]); sum += c; cnt += (c > 0u) ? 1u : 0u; mine = (j == x) ? c : mine; }
        if (sum == G) break;
        __builtin_amdgcn_s_sleep(1);
        if ((++sp & 255u) == 0u) { if (xb_ld(&bar[XB_TMO])) break; if (sp > XB_SPIN_CAP) { atomicAdd(&bar[XB_TMO], 1u); break; } }
    }
    nloc = mine > 0u ? mine : 1u; nx = cnt > 0u ? cnt : 1u;
}

__device__ __forceinline__ void xcd_barrier(const XcdBarrier& b) {
    asm volatile("s_waitcnt vmcnt(0)" ::: "memory");
    __syncthreads();
    if (threadIdx.x == 0) {
        unsigned* bar = b.bar;
        __builtin_amdgcn_s_waitcnt(0);
        unsigned nloc = b.st[0], nx = b.st[1];
        if (nloc == 0u) { xcd_barrier_complete(bar, b.x, nloc, nx); b.st[0] = nloc; b.st[1] = nx; }
        const unsigned old = xb_add(&bar[XB_XSUB(b.x)], 1u);
        const unsigned gen = old / nloc;
        if (old + 1u == (gen + 1u) * nloc) {
            __builtin_amdgcn_fence(__ATOMIC_RELEASE, "agent");
            asm volatile("s_waitcnt vmcnt(0)" ::: "memory");
            const unsigned og = xb_add(&bar[XB_TOP], 1u);
            const unsigned tg = og / nx;
            if (og + 1u == (tg + 1u) * nx) xb_add(&bar[XB_TOPGEN], 1u);
            else XB_SPIN(xb_ld(&bar[XB_TOPGEN]) == tg, bar);
            __builtin_amdgcn_fence(__ATOMIC_ACQUIRE, "agent");
            xb_add(&bar[XB_XGEN(b.x)], 1u);
            asm volatile("s_waitcnt vmcnt(0)" ::: "memory");
        } else {
            XB_SPIN(xb_ld(&bar[XB_XGEN(b.x)]) == gen, bar);
            __builtin_amdgcn_fence(__ATOMIC_ACQUIRE, "agent");
            asm volatile("s_waitcnt vmcnt(0)" ::: "memory");
        }
    }
    __syncthreads();
}

typedef unsigned short bf16_t;
typedef short bf16x8 __attribute__((ext_vector_type(8)));
typedef float f32x4 __attribute__((ext_vector_type(4)));
typedef float f32x16 __attribute__((ext_vector_type(16)));

constexpr int DM = 2048, SEQ = 4096, NBP = 2, NBS = 32, TP = NBP * SEQ, MT = TP + NBS, MP = 8448;
constexpr int INW = 6784, INWP = 6912, SHD = 3200, DEPTH = 2;
constexpr size_t NRI = (size_t)MT * 1024;
constexpr int LDS_BYTES = 131072 + 16;
constexpr size_t O_CKP = (size_t)MT * DM;
constexpr size_t O_CVP = O_CKP + (size_t)DEPTH * NBP * 128 * 256;
constexpr size_t O_WKVP = O_CVP + (size_t)DEPTH * NBP * 128 * 256;
constexpr size_t O_SHP = O_WKVP + (size_t)DEPTH * NBP * 16 * 4096;
constexpr size_t O_CKS = O_SHP + (size_t)DEPTH * NBP * SHD;
constexpr size_t O_CVS = O_CKS + (size_t)DEPTH * NBS * 128 * 256;
constexpr size_t O_WKVS = O_CVS + (size_t)DEPTH * NBS * 128 * 256;
constexpr size_t O_SHS = O_WKVS + (size_t)DEPTH * NBS * 16 * 4096;
constexpr size_t O_END = O_SHS + (size_t)DEPTH * NBS * SHD;
constexpr size_t al256(size_t x) { return (x + 255) & ~(size_t)255; }
constexpr size_t WS_WTIN = 0;
constexpr size_t WS_WTOUT = WS_WTIN + (size_t)DEPTH * INWP * DM * 2;
constexpr size_t WS_MOD = WS_WTOUT + (size_t)DEPTH * DM * DM * 2;
constexpr size_t WS_ROPE = WS_MOD + al256((size_t)DEPTH * 34 * 6144 * 4);
constexpr size_t WS_HB = WS_ROPE + al256((size_t)4097 * 16 * 4);
constexpr size_t WS_QB = WS_HB + (size_t)MP * DM * 2;
constexpr size_t WS_KB = WS_QB + (size_t)MP * 1024 * 2;
constexpr size_t WS_VB = WS_KB + (size_t)MP * 256 * 2;
constexpr size_t WS_RW = WS_VB + (size_t)MP * 256 * 2;
constexpr size_t WS_GT = WS_RW + (size_t)MP * SHD * 2;
constexpr size_t WS_RI = WS_GT + (size_t)MP * DM * 2;
constexpr size_t WS_COEF = WS_RI + 6 * NRI * 4;
constexpr size_t WS_BAR = WS_COEF + al256((size_t)MT * 16 * 4);
constexpr size_t WS_END = WS_BAR + 16384;

struct Params {
    const float *x_prompt, *x_sample, *cache_k, *cache_v, *state_wkv, *state_shift, *c_prompt, *c_sample, *norm_g, *w_ada, *b_ada, *w_in, *mu_shift, *w0, *w_decay, *a0,
        *w_iclr, *k_k, *k_a, *r_k, *ln_w, *ln_b, *sinks, *w_out, *final_g;
    float* out;
    unsigned char* ws;
};
typedef const __attribute__((address_space(4))) Params* KParamsPtr;
__device__ __forceinline__ const Params& kparams() {
    KParamsPtr k = (KParamsPtr)__builtin_amdgcn_kernarg_segment_ptr();
    asm volatile("" : "+s"(k));
    return *(const Params*)k;
}

__device__ __forceinline__ unsigned short f2bf(float f) { unsigned u = __float_as_uint(f); u += 0x7FFFu + ((u >> 16) & 1u); return (unsigned short)(u >> 16); }
__device__ __forceinline__ float bf2f(unsigned short b) { return __uint_as_float(((unsigned)b) << 16); }
__device__ __forceinline__ unsigned pack2(float lo, float hi) { return (unsigned)f2bf(lo) | ((unsigned)f2bf(hi) << 16); }
__device__ __forceinline__ float bflo(unsigned w) { return __uint_as_float(w << 16); }
__device__ __forceinline__ float bfhi(unsigned w) { return __uint_as_float(w & 0xffff0000u); }
__device__ __forceinline__ float silu_f(float x) { return x / (1.f + __expf(-x)); }
__device__ __forceinline__ float wave_sum(float x) {
#pragma unroll
    for (int o = 32; o >= 1; o >>= 1) x += __shfl_xor(x, o);
    return x;
}
__device__ __forceinline__ float wave_max(float x) {
#pragma unroll
    for (int o = 32; o >= 1; o >>= 1) x = fmaxf(x, __shfl_xor(x, o));
    return x;
}
template <int CTRL> __device__ __forceinline__ float dpp_f(float x) {
    return __builtin_bit_cast(float, __builtin_amdgcn_update_dpp(0, __builtin_bit_cast(int, x), CTRL, 0xF, 0xF, false));
}
__device__ __forceinline__ float allreduce16(float x) {
    x += dpp_f<0x128>(x);
    x += dpp_f<0x124>(x);
    x += dpp_f<0x122>(x);
    x += dpp_f<0x121>(x);
    return x;
}

__device__ void p0_mod_item(const Params& p, float* red, int l, int nc) {
    const int tid = opq_tid(), wv = tid >> 6, lane = tid & 63, n = lane & 31, kh = lane >> 5;
    f32x16 acc0, acc1;
#pragma unroll
    for (int i = 0; i < 16; ++i) { acc0[i] = 0.f; acc1[i] = 0.f; }
    const float* W = p.w_ada + (size_t)l * DM * 6144 + nc * 32 + n;
#pragma unroll 4
    for (int ks = 0; ks < 16; ++ks) {
        const int k0 = wv * 256 + ks * 16 + kh * 8;
        bf16x8 bfr, a0, a1;
#pragma unroll
        for (int j = 0; j < 8; ++j) bfr[j] = (short)f2bf(W[(size_t)(k0 + j) * 6144]);
        const float4* cs = (const float4*)(p.c_sample + (size_t)n * DM + k0);
        const float4 u0 = cs[0], u1 = cs[1];
        a0[0] = (short)f2bf(silu_f(u0.x)); a0[1] = (short)f2bf(silu_f(u0.y)); a0[2] = (short)f2bf(silu_f(u0.z)); a0[3] = (short)f2bf(silu_f(u0.w));
        a0[4] = (short)f2bf(silu_f(u1.x)); a0[5] = (short)f2bf(silu_f(u1.y)); a0[6] = (short)f2bf(silu_f(u1.z)); a0[7] = (short)f2bf(silu_f(u1.w));
        float4 q0 = make_float4(0.f, 0.f, 0.f, 0.f), q1 = q0;
        if (n < 2) { const float4* cp = (const float4*)(p.c_prompt + (size_t)n * DM + k0); q0 = cp[0]; q1 = cp[1]; }
        a1[0] = (short)f2bf(silu_f(q0.x)); a1[1] = (short)f2bf(silu_f(q0.y)); a1[2] = (short)f2bf(silu_f(q0.z)); a1[3] = (short)f2bf(silu_f(q0.w));
        a1[4] = (short)f2bf(silu_f(q1.x)); a1[5] = (short)f2bf(silu_f(q1.y)); a1[6] = (short)f2bf(silu_f(q1.z)); a1[7] = (short)f2bf(silu_f(q1.w));
        acc0 = __builtin_amdgcn_mfma_f32_32x32x16_bf16(a0, bfr, acc0, 0, 0, 0);
        acc1 = __builtin_amdgcn_mfma_f32_32x32x16_bf16(a1, bfr, acc1, 0, 0, 0);
    }
#pragma unroll
    for (int i = 0; i < 16; ++i) red[(wv * 18 + i) * 64 + lane] = acc0[i];
    red[(wv * 18 + 16) * 64 + lane] = acc1[0];
    red[(wv * 18 + 17) * 64 + lane] = acc1[1];
    __syncthreads();
    float* mod = (float*)(p.ws + WS_MOD);
    for (int o = tid; o < 34 * 32; o += 512) {
        const int row = o >> 5, col = o & 31;
        int ri, ln, mrow;
        if (row < 32) { const int khh = (row >> 2) & 1; ri = (row & 3) + 4 * (row >> 3); ln = col + 32 * khh; mrow = 2 + row; }
        else { ri = 16 + (row - 32); ln = col; mrow = row - 32; }
        float s = 0.f;
#pragma unroll
        for (int w = 0; w < 8; ++w) s += red[(w * 18 + ri) * 64 + ln];
        mod[((size_t)l * 34 + mrow) * 6144 + nc * 32 + col] = s + p.b_ada[l * 6144 + nc * 32 + col];
    }
    __syncthreads();
}

struct ConvIt { const float* src; bf16_t* dst; int N, k0, n0; };
__device__ __forceinline__ ConvIt conv_decode(const Params& p, int cidx) {
    ConvIt c;
    const int l = cidx / 2240;
    int rem = cidx - l * 2240, kt, nt;
    if (rem < 1728) { kt = rem & 15; nt = rem >> 4; c.N = INW; c.src = p.w_in + (size_t)l * DM * INW; c.dst = (bf16_t*)(p.ws + WS_WTIN) + (size_t)l * INWP * DM; }
    else { rem -= 1728; kt = rem & 15; nt = rem >> 4; c.N = DM; c.src = p.w_out + (size_t)l * DM * DM; c.dst = (bf16_t*)(p.ws + WS_WTOUT) + (size_t)l * DM * DM; }
    c.k0 = kt * 128; c.n0 = nt * 64;
    return c;
}
__device__ void p0_conv_all(const Params& p, float* s, int bid, int G) {
    const int tid = opq_tid();
    const int lrow = tid >> 4, c4 = tid & 15, n = tid >> 3, kg = tid & 7;
    float4 v[4];
    int cidx = bid;
    ConvIt cur = conv_decode(p, cidx < 4480 ? cidx : 0);
    if (cidx < 4480) {
#pragma unroll
        for (int p4 = 0; p4 < 4; ++p4) { v[p4] = make_float4(0.f, 0.f, 0.f, 0.f); if (cur.n0 < cur.N) v[p4] = *(const float4*)(cur.src + (size_t)(cur.k0 + lrow + 32 * p4) * cur.N + cur.n0 + 4 * c4); }
    }
#pragma unroll 1
    while (cidx < 4480) {
#pragma unroll
        for (int p4 = 0; p4 < 4; ++p4) { float* d = s + (lrow + 32 * p4) * 65 + 4 * c4; d[0] = v[p4].x; d[1] = v[p4].y; d[2] = v[p4].z; d[3] = v[p4].w; }
        __syncthreads();
        const int nxt = cidx + G;
        const ConvIt nx = conv_decode(p, nxt < 4480 ? nxt : 0);
        if (nxt < 4480) {
#pragma unroll
            for (int p4 = 0; p4 < 4; ++p4) { v[p4] = make_float4(0.f, 0.f, 0.f, 0.f); if (nx.n0 < nx.N) v[p4] = *(const float4*)(nx.src + (size_t)(nx.k0 + lrow + 32 * p4) * nx.N + nx.n0 + 4 * c4); }
        }
        unsigned w[8];
#pragma unroll
        for (int j = 0; j < 8; ++j) w[j] = pack2(s[(kg * 16 + 2 * j) * 65 + n], s[(kg * 16 + 2 * j + 1) * 65 + n]);
        uint4* o = (uint4*)(cur.dst + (size_t)(cur.n0 + n) * DM + cur.k0 + kg * 16);
        o[0] = make_uint4(w[0], w[1], w[2], w[3]);
        o[1] = make_uint4(w[4], w[5], w[6], w[7]);
        __syncthreads();
        cur = nx; cidx = nxt;
    }
}

__device__ void p0_rope_item(const Params& p, int it) {
    float* rope = (float*)(p.ws + WS_ROPE);
#pragma unroll
    for (int q = 0; q < 4; ++q) {
        const int e = it * 2048 + q * 512 + opq_tid();
        if (e < 4097 * 8) {
            const int idx = e >> 3, i = e & 7;
            double invf = 1.0;
            for (int q = 0; q < i; ++q) invf *= 0.19392274474868576;
            const double pos = idx < 4096 ? (double)idx : 16384.0;
            const double rev = pos * invf * 0.15915494309189535;
            const float f = (float)(rev - floor(rev));
            rope[idx * 16 + i] = __builtin_amdgcn_cosf(f);
            rope[idx * 16 + 8 + i] = __builtin_amdgcn_sinf(f);
        }
    }
}

__device__ void p1_norm(const Params& p, int l, int bid, int G) {
    const int tid = opq_tid(), wv = tid >> 6, lane = tid & 63;
    bf16_t* hb = (bf16_t*)(p.ws + WS_HB);
    const float* mod = (const float*)(p.ws + WS_MOD);
    const float4* g4 = (const float4*)(p.norm_g + l * DM);
    for (int r = bid * 8 + wv; r < MT; r += G * 8) {
        const float* xr = l == 0 ? (r < TP ? p.x_prompt + (size_t)r * DM : p.x_sample + (size_t)(r - TP) * DM) : p.out + (size_t)r * DM;
        const int mrow = r < TP ? (r >> 12) : 2 + (r - TP);
        const float* md = mod + ((size_t)l * 34 + mrow) * 6144;
        float4 v[8]; float ss = 0.f;
#pragma unroll
        for (int i = 0; i < 8; ++i) { v[i] = ((const float4*)xr)[lane + 64 * i]; ss += v[i].x * v[i].x + v[i].y * v[i].y + v[i].z * v[i].z + v[i].w * v[i].w; }
        ss = wave_sum(ss);
        const float rinv = rsqrtf(ss * (1.f / 2048.f) + 1e-5f);
#pragma unroll
        for (int i = 0; i < 8; ++i) {
            const int c4 = lane + 64 * i;
            const float4 g = g4[c4], sc = ((const float4*)(md + 2048))[c4], sh = ((const float4*)md)[c4];
            const float y0 = v[i].x * rinv * g.x * (1.f + sc.x) + sh.x, y1 = v[i].y * rinv * g.y * (1.f + sc.y) + sh.y;
            const float y2 = v[i].z * rinv * g.z * (1.f + sc.z) + sh.z, y3 = v[i].w * rinv * g.w * (1.f + sc.w) + sh.w;
            *(uint2*)(hb + (size_t)r * DM + 4 * c4) = make_uint2(pack2(y0, y1), pack2(y2, y3));
        }
    }
}

struct Epi1 {
    static constexpr bool PERM = false, AFTER_DRAIN = false;
    int l;
    __device__ __forceinline__ void operator()(const f32x4 (&acc)[2][2][4][2], const pg8::Unit& u, int wr, int wc, int fr, int fq) const {
        const Params& p = kparams();
        bf16_t* const qb = (bf16_t*)(p.ws + WS_QB); bf16_t* const kb = (bf16_t*)(p.ws + WS_KB); bf16_t* const vb = (bf16_t*)(p.ws + WS_VB);
        bf16_t* const rw = (bf16_t*)(p.ws + WS_RW); bf16_t* const gt = (bf16_t*)(p.ws + WS_GT); const float* const rope = (const float*)(p.ws + WS_ROPE); float* const out = p.out;
#pragma unroll
        for (int bj = 0; bj < 2; ++bj)
#pragma unroll
            for (int n = 0; n < 2; ++n) {
                const int cb = u.pn * 256 + bj * 128 + wc * 32 + n * 16;
                if (cb >= INW) continue;
                const int c = cb + 4 * fq;
                const bool do_rope = (cb < 1280) && ((cb & 63) == 0);
#pragma unroll
                for (int ai = 0; ai < 2; ++ai)
#pragma unroll
                    for (int m = 0; m < 4; ++m) {
                        const int rb = u.pm * 256 + ai * 128 + wr * 64 + m * 16;
                        if (rb >= MT) continue;
                        const int r = rb + fr;
                        f32x4 v = acc[ai][bj][m][n];
                        if (do_rope) {
                            const int idx = r < TP ? (r & 4095) : 4096;
                            const float4 cs = *(const float4*)(rope + idx * 16 + 4 * (fq & 1));
                            const float4 sn = *(const float4*)(rope + idx * 16 + 8 + 4 * (fq & 1));
                            const float p0 = __shfl_xor(v[0], 32), p1 = __shfl_xor(v[1], 32), p2 = __shfl_xor(v[2], 32), p3 = __shfl_xor(v[3], 32);
                            const float sg = fq < 2 ? -1.f : 1.f;
                            v[0] = v[0] * cs.x + sg * p0 * sn.x; v[1] = v[1] * cs.y + sg * p1 * sn.y; v[2] = v[2] * cs.z + sg * p2 * sn.z; v[3] = v[3] * cs.w + sg * p3 * sn.w;
                        }
                        if (cb < 1024) {
                            *(uint2*)(qb + (size_t)r * 1024 + c) = make_uint2(pack2(v[0] * 0.125f, v[1] * 0.125f), pack2(v[2] * 0.125f, v[3] * 0.125f));
                        } else if (cb < 1536) {
                            const bool isk = cb < 1280;
                            const int cc = c - (isk ? 1024 : 1280);
                            *(uint2*)((isk ? kb : vb) + (size_t)r * 256 + cc) = make_uint2(pack2(v[0], v[1]), pack2(v[2], v[3]));
                            if (r >= TP) {
                                *(f32x4*)(out + (isk ? O_CKS : O_CVS) + ((size_t)(l * NBS + (r - TP)) * 128 + 127) * 256 + cc) = v;
                            } else if ((r & 4095) >= SEQ - 128) {
                                *(f32x4*)(out + (isk ? O_CKP : O_CVP) + ((size_t)(l * NBP + (r >> 12)) * 128 + ((r & 4095) - (SEQ - 128))) * 256 + cc) = v;
                            }
                        } else if (cb < 4736) {
                            const int cc = c - 1536;
                            *(uint2*)(rw + (size_t)r * SHD + cc) = make_uint2(pack2(v[0], v[1]), pack2(v[2], v[3]));
                            if (r >= TP) *(f32x4*)(out + O_SHS + (size_t)(l * NBS + (r - TP)) * SHD + cc) = v;
                            else if ((r & 4095) == SEQ - 1) *(f32x4*)(out + O_SHP + (size_t)(l * NBP + (r >> 12)) * SHD + cc) = v;
                        } else {
                            const int cc = c - 4736;
                            *(uint2*)(gt + (size_t)r * DM + cc) = make_uint2(pack2(silu_f(v[0]), silu_f(v[1])), pack2(silu_f(v[2]), silu_f(v[3])));
                        }
                    }
            }
    }
};

struct Epi2 {
    static constexpr bool PERM = false, AFTER_DRAIN = false;
    int l;
    __device__ __forceinline__ void operator()(const f32x4 (&acc)[2][2][4][2], const pg8::Unit& u, int wr, int wc, int fr, int fq) const {
        const Params& p = kparams();
        const float* const xp = p.x_prompt; const float* const xs = p.x_sample; const float* const modl = (const float*)(p.ws + WS_MOD) + (size_t)l * 34 * 6144; float* const out = p.out;
#pragma unroll
        for (int ai = 0; ai < 2; ++ai)
#pragma unroll
            for (int m = 0; m < 4; ++m) {
                const int rb = u.pm * 256 + ai * 128 + wr * 64 + m * 16;
                if (rb >= MT) continue;
                const int r = rb + fr;
                const int mrow = r < TP ? (r >> 12) : 2 + (r - TP);
                const float* xo = l == 0 ? (r < TP ? xp + (size_t)r * DM : xs + (size_t)(r - TP) * DM) : out + (size_t)r * DM;
                const float* gr = modl + (size_t)mrow * 6144 + 4096;
#pragma unroll
                for (int bj = 0; bj < 2; ++bj)
#pragma unroll
                    for (int n = 0; n < 2; ++n) {
                        const int c = u.pn * 256 + bj * 128 + wc * 32 + n * 16 + 4 * fq;
                        const f32x4 x4 = *(const f32x4*)(xo + c), g4 = *(const f32x4*)(gr + c);
                        *(f32x4*)(out + (size_t)r * DM + c) = x4 + g4 * acc[ai][bj][m][n];
                    }
            }
    }
};

__device__ void g2_sample_item(const Params& p, float* red, int l, int nb) {
    const int tid = opq_tid(), wv = tid >> 6, lane = tid & 63, n = lane & 31, h = lane >> 5;
    const bf16_t* A = (const bf16_t*)(p.ws + WS_HB) + (size_t)TP * DM;
    const bf16_t* Bt = (const bf16_t*)(p.ws + WS_WTOUT) + (size_t)l * DM * DM + (size_t)(nb * 32) * DM;
    f32x16 acc;
#pragma unroll
    for (int i = 0; i < 16; ++i) acc[i] = 0.f;
#pragma unroll 4
    for (int ks = 0; ks < 16; ++ks) {
        const int k0 = wv * 256 + ks * 16 + 8 * h;
        const bf16x8 a = *(const bf16x8*)(A + (size_t)n * DM + k0);
        const bf16x8 bq = *(const bf16x8*)(Bt + (size_t)n * DM + k0);
        acc = __builtin_amdgcn_mfma_f32_32x32x16_bf16(a, bq, acc, 0, 0, 0);
    }
#pragma unroll
    for (int i = 0; i < 16; ++i) red[(wv * 16 + i) * 64 + lane] = acc[i];
    __syncthreads();
    const float* mod = (const float*)(p.ws + WS_MOD) + (size_t)l * 34 * 6144;
    for (int o = tid; o < 1024; o += 512) {
        const int row = o >> 5, col = o & 31, hh = (row >> 2) & 1, ri = (row & 3) + 4 * (row >> 3), ln = col + 32 * hh;
        float s = 0.f;
#pragma unroll
        for (int w = 0; w < 8; ++w) s += red[(w * 16 + ri) * 64 + ln];
        const int c = nb * 32 + col;
        const float gate = mod[(size_t)(2 + row) * 6144 + 4096 + c];
        const float xo = l == 0 ? p.x_sample[(size_t)row * DM + c] : p.out[(size_t)(TP + row) * DM + c];
        p.out[(size_t)(TP + row) * DM + c] = xo + gate * s;
    }
    __syncthreads();
}

__device__ void p3_attn_unit(const Params& p, unsigned char* lds, int l, int unit) {
    const int tid = opq_tid(), wv = tid >> 6, lane = tid & 63;
    const int b = unit >> 7, n = (unit >> 2) & 31, g = unit & 3;
    bf16_t* Ks = (bf16_t*)lds;
    bf16_t* Vt = (bf16_t*)(lds + 36864);
    const bf16_t* qb = (const bf16_t*)(p.ws + WS_QB);
    const bf16_t* kb = (const bf16_t*)(p.ws + WS_KB);
    const bf16_t* vb = (const bf16_t*)(p.ws + WS_VB);
    const bf16_t* gt = (const bf16_t*)(p.ws + WS_GT);
    bf16_t* cc = (bf16_t*)(p.ws + WS_HB);
#pragma unroll
    for (int i = 0; i < 4; ++i) {
        const int chunk = tid + 512 * i, kl = chunk >> 3, dc = chunk & 7, kp = 128 * (n - 1) + kl;
        uint4 kv4 = make_uint4(0u, 0u, 0u, 0u), vv4 = kv4;
        if (kp >= 0) { const size_t row = (size_t)b * SEQ + kp; kv4 = *(const uint4*)(kb + row * 256 + g * 64 + dc * 8); vv4 = *(const uint4*)(vb + row * 256 + g * 64 + dc * 8); }
        *(uint4*)(Ks + kl * 72 + dc * 8) = kv4;
        bf16_t* vd = Vt + (dc * 8) * 264 + kl;
        vd[0 * 264] = (bf16_t)(vv4.x & 0xffffu); vd[1 * 264] = (bf16_t)(vv4.x >> 16);
        vd[2 * 264] = (bf16_t)(vv4.y & 0xffffu); vd[3 * 264] = (bf16_t)(vv4.y >> 16);
        vd[4 * 264] = (bf16_t)(vv4.z & 0xffffu); vd[5 * 264] = (bf16_t)(vv4.z >> 16);
        vd[6 * 264] = (bf16_t)(vv4.w & 0xffffu); vd[7 * 264] = (bf16_t)(vv4.w >> 16);
    }
    __syncthreads();
    const int hq = 4 * g + (wv >> 1), qh = wv & 1, q32 = lane & 31, h = lane >> 5;
    const float sink = p.sinks[l * 16 + hq];
#pragma unroll 1
    for (int s = 0; s < 2; ++s) {
        const int qp = 128 * n + 64 * qh + 32 * s + q32;
        const size_t qrow = (size_t)b * SEQ + qp;
        const int klb0 = 64 * qh + 32 * s;
        bf16x8 qf[4];
#pragma unroll
        for (int ks = 0; ks < 4; ++ks) qf[ks] = *(const bf16x8*)(qb + qrow * 1024 + hq * 64 + ks * 16 + 8 * h);
        f32x16 S[5];
#pragma unroll
        for (int kt = 0; kt < 5; ++kt) {
#pragma unroll
            for (int i = 0; i < 16; ++i) S[kt][i] = 0.f;
#pragma unroll
            for (int ks = 0; ks < 4; ++ks) {
                const bf16x8 a = *(const bf16x8*)(Ks + (klb0 + 32 * kt + q32) * 72 + ks * 16 + 8 * h);
                S[kt] = __builtin_amdgcn_mfma_f32_32x32x16_bf16(a, qf[ks], S[kt], 0, 0, 0);
            }
        }
        float mx = -1e30f;
#pragma unroll
        for (int kt = 0; kt < 5; ++kt)
#pragma unroll
            for (int i = 0; i < 16; ++i) {
                const int m = 8 * (i >> 2) + 4 * h + (i & 3);
                const int kp = 128 * (n - 1) + klb0 + 32 * kt + m;
                const int rel = qp - kp;
                const bool ok = (rel >= 0) && (rel <= 128) && (kp >= 0);
                const float sv = ok ? S[kt][i] : -1e30f;
                S[kt][i] = sv; mx = fmaxf(mx, sv);
            }
        mx = fmaxf(mx, __shfl_xor(mx, 32));
        mx = fmaxf(mx, sink);
        float sum = 0.f;
#pragma unroll
        for (int kt = 0; kt < 5; ++kt)
#pragma unroll
            for (int i = 0; i < 16; ++i) { const float e = __expf(S[kt][i] - mx); S[kt][i] = e; sum += e; }
        sum += __shfl_xor(sum, 32);
        const float inv = 1.f / (sum + __expf(sink - mx));
        f32x16 O[2];
#pragma unroll
        for (int i = 0; i < 16; ++i) { O[0][i] = 0.f; O[1][i] = 0.f; }
#pragma unroll
        for (int kt = 0; kt < 5; ++kt)
#pragma unroll
            for (int sp = 0; sp < 2; ++sp) {
                bf16x8 pf;
#pragma unroll
                for (int j = 0; j < 8; ++j) pf[j] = (short)f2bf(S[kt][8 * sp + j]);
#pragma unroll
                for (int dt = 0; dt < 2; ++dt) {
                    const bf16_t* vp = Vt + (32 * dt + q32) * 264 + klb0 + 32 * kt + 16 * sp + 4 * h;
                    const uint2 lo = *(const uint2*)vp, hi = *(const uint2*)(vp + 8);
                    const uint4 av = make_uint4(lo.x, lo.y, hi.x, hi.y);
                    O[dt] = __builtin_amdgcn_mfma_f32_32x32x16_bf16(__builtin_bit_cast(bf16x8, av), pf, O[dt], 0, 0, 0);
                }
            }
#pragma unroll
        for (int dt = 0; dt < 2; ++dt)
#pragma unroll
            for (int ig = 0; ig < 4; ++ig) {
                const int col = hq * 64 + 32 * dt + 8 * ig + 4 * h;
                const uint2 gg = *(const uint2*)(gt + qrow * DM + col);
                const float o0 = O[dt][4 * ig + 0] * inv * bflo(gg.x), o1 = O[dt][4 * ig + 1] * inv * bfhi(gg.x);
                const float o2 = O[dt][4 * ig + 2] * inv * bflo(gg.y), o3 = O[dt][4 * ig + 3] * inv * bfhi(gg.y);
                *(uint2*)(cc + qrow * DM + col) = make_uint2(pack2(o0, o1), pack2(o2, o3));
            }
    }
    __syncthreads();
}

__device__ void p3_sattn_item(const Params& p, float* lds, int l, int item) {
    const int tid = opq_tid(), wv = tid >> 6, lane = tid & 63;
    float* pl = lds + wv * 128;
    const int w = item * 8 + wv, bd = w >> 4, hq = w & 15, g = hq >> 2;
    const size_t row = (size_t)TP + bd;
    const bf16_t* qb = (const bf16_t*)(p.ws + WS_QB);
    const bf16_t* gt = (const bf16_t*)(p.ws + WS_GT);
    bf16_t* cc = (bf16_t*)(p.ws + WS_HB);
    float q[64];
#pragma unroll
    for (int c = 0; c < 8; ++c) {
        const uint4 u = *(const uint4*)(qb + row * 1024 + hq * 64 + c * 8);
        q[c * 8 + 0] = bflo(u.x); q[c * 8 + 1] = bfhi(u.x); q[c * 8 + 2] = bflo(u.y); q[c * 8 + 3] = bfhi(u.y);
        q[c * 8 + 4] = bflo(u.z); q[c * 8 + 5] = bfhi(u.z); q[c * 8 + 6] = bflo(u.w); q[c * 8 + 7] = bfhi(u.w);
    }
    const size_t cbase = ((size_t)(l * NBS + bd) * 128) * 256 + g * 64;
    const float* ck = p.cache_k + cbase;
    const float* cv = p.cache_v + cbase;
    float* nk = p.out + O_CKS + cbase;
    float* nv = p.out + O_CVS + cbase;
    float s0 = 0.f, s1 = 0.f, s2 = 0.f;
#pragma unroll
    for (int c = 0; c < 16; ++c) {
        const float4 a = ((const float4*)(ck + (size_t)lane * 256))[c];
        const float4 bq = ((const float4*)(ck + (size_t)(lane + 64) * 256))[c];
        const float4 e = ((const float4*)(nk + (size_t)127 * 256))[c];
        s0 += a.x * q[4 * c] + a.y * q[4 * c + 1] + a.z * q[4 * c + 2] + a.w * q[4 * c + 3];
        s1 += bq.x * q[4 * c] + bq.y * q[4 * c + 1] + bq.z * q[4 * c + 2] + bq.w * q[4 * c + 3];
        s2 += e.x * q[4 * c] + e.y * q[4 * c + 1] + e.z * q[4 * c + 2] + e.w * q[4 * c + 3];
    }
    const float sink = p.sinks[l * 16 + hq];
    const float mx = fmaxf(wave_max(fmaxf(s0, s1)), fmaxf(s2, sink));
    const float p0 = __expf(s0 - mx), p1 = __expf(s1 - mx), p2 = __expf(s2 - mx);
    const float sum = wave_sum(p0 + p1) + p2 + __expf(sink - mx);
    pl[lane] = p0; pl[lane + 64] = p1;
    __builtin_amdgcn_fence(__ATOMIC_RELEASE, "wavefront");
    __builtin_amdgcn_wave_barrier();
    __builtin_amdgcn_fence(__ATOMIC_ACQUIRE, "wavefront");
    float o = 0.f;
#pragma unroll 32
    for (int key = 0; key < 128; ++key) o += pl[key] * cv[(size_t)key * 256 + lane];
    o += p2 * nv[(size_t)127 * 256 + lane];
    o /= sum;
    const float gate = bf2f(gt[row * DM + hq * 64 + lane]);
    cc[row * DM + hq * 64 + lane] = f2bf(o * gate);
    {
        float tk[32], tv[32];
#pragma unroll
        for (int i = 0; i < 32; ++i) {
            const int ww = (hq & 3) + 4 * i;
            tk[i] = ck[(size_t)(ww + 1 < 128 ? ww + 1 : 127) * 256 + lane]; tv[i] = cv[(size_t)(ww + 1 < 128 ? ww + 1 : 127) * 256 + lane];
        }
#pragma unroll
        for (int i = 0; i < 32; ++i) {
            const int ww = (hq & 3) + 4 * i;
            if (ww < 127) { nk[(size_t)ww * 256 + lane] = tk[i]; nv[(size_t)ww * 256 + lane] = tv[i]; }
        }
    }
    __builtin_amdgcn_wave_barrier();
}

__device__ __forceinline__ float mix_val(const bf16_t* rw, const float* sshift, const float* mu, int r, int c) {
    const float cur = bf2f(rw[(size_t)r * SHD + c]);
    float prev;
    if (r >= TP) prev = sshift[(size_t)(r - TP) * SHD + c];
    else if ((r & 4095) == 0) prev = 0.f;
    else prev = bf2f(rw[(size_t)(r - 1) * SHD + c]);
    return cur + (prev - cur) * mu[c];
}

__device__ __forceinline__ float4 mix4(const bf16_t* rw, const float* sshift, int r, int c, float4 mu4) {
    const uint2 cu = *(const uint2*)(rw + (size_t)r * SHD + c);
    const float4 cur = make_float4(bflo(cu.x), bfhi(cu.x), bflo(cu.y), bfhi(cu.y));
    float4 prev = make_float4(0.f, 0.f, 0.f, 0.f);
    if (r >= TP) prev = *(const float4*)(sshift + (size_t)(r - TP) * SHD + c);
    else if ((r & 4095) != 0) { const uint2 pu = *(const uint2*)(rw + (size_t)(r - 1) * SHD + c); prev = make_float4(bflo(pu.x), bfhi(pu.x), bflo(pu.y), bfhi(pu.y)); }
    return make_float4(cur.x + (prev.x - cur.x) * mu4.x, cur.y + (prev.y - cur.y) * mu4.y, cur.z + (prev.z - cur.z) * mu4.z, cur.w + (prev.w - cur.w) * mu4.w);
}
__device__ __forceinline__ float decay_of(float x) {
    const float z = -x;
    const float sp = fmaxf(z, 0.f) + __logf(1.f + __expf(-fabsf(z)));
    return __expf(-__expf(-sp - 0.5f));
}

__device__ void p3_prep_tile(const Params& p, unsigned char* lds, int l, int tile) {
    const int tid = opq_tid(), wv = tid >> 6, lane = tid & 63, n = lane & 31, h = lane >> 5;
    bf16_t* TW = (bf16_t*)lds;
    bf16_t* AD = TW + 32 * 72;
    const bf16_t* rw = (const bf16_t*)(p.ws + WS_RW);
    const float* sshift = p.state_shift + (size_t)l * NBS * SHD;
    const float* mu = p.mu_shift + l * SHD;
    float* RI = (float*)(p.ws + WS_RI);
    float* coef = (float*)(p.ws + WS_COEF);
    const int r0 = tile * 32;
#pragma unroll
    for (int i = 0; i < 8; ++i) {
        const int idx = tid + 512 * i, tt = idx >> 7, c2 = idx & 127;
        const float m = mix_val(rw, sshift, mu, r0 + tt, 3072 + c2);
        if (c2 < 64) { const float e = __expf(2.f * m); TW[tt * 72 + c2] = f2bf(1.f - 2.f / (e + 1.f)); }
        else AD[tt * 72 + (c2 - 64)] = f2bf(m);
    }
    __syncthreads();
    const int col0 = wv * 128 + 4 * n;
    f32x16 acc[4];
    {
        const float* wp = p.w_decay + (size_t)l * 64 * 1024 + col0;
#pragma unroll
        for (int nt = 0; nt < 4; ++nt)
#pragma unroll
            for (int i = 0; i < 16; ++i) acc[nt][i] = 0.f;
#pragma unroll
        for (int ks = 0; ks < 4; ++ks) {
            const bf16x8 a = *(const bf16x8*)(TW + n * 72 + 16 * ks + 8 * h);
            float4 w4[8];
#pragma unroll
            for (int e = 0; e < 8; ++e) w4[e] = *(const float4*)(wp + (size_t)(16 * ks + 8 * h + e) * 1024);
            bf16x8 b0, b1, b2, b3;
#pragma unroll
            for (int e = 0; e < 8; ++e) { b0[e] = (short)f2bf(w4[e].x); b1[e] = (short)f2bf(w4[e].y); b2[e] = (short)f2bf(w4[e].z); b3[e] = (short)f2bf(w4[e].w); }
            acc[0] = __builtin_amdgcn_mfma_f32_32x32x16_bf16(a, b0, acc[0], 0, 0, 0);
            acc[1] = __builtin_amdgcn_mfma_f32_32x32x16_bf16(a, b1, acc[1], 0, 0, 0);
            acc[2] = __builtin_amdgcn_mfma_f32_32x32x16_bf16(a, b2, acc[2], 0, 0, 0);
            acc[3] = __builtin_amdgcn_mfma_f32_32x32x16_bf16(a, b3, acc[3], 0, 0, 0);
        }
        const float4 w0c = *(const float4*)(p.w0 + l * 1024 + col0);
#pragma unroll
        for (int r = 0; r < 16; ++r) {
            const int row = r0 + 8 * (r >> 2) + 4 * h + (r & 3);
            *(float4*)(RI + NRI + (size_t)row * 1024 + col0) =
                make_float4(decay_of(w0c.x + acc[0][r]), decay_of(w0c.y + acc[1][r]), decay_of(w0c.z + acc[2][r]), decay_of(w0c.w + acc[3][r]));
        }
    }
    {
        const float* wp = p.w_iclr + (size_t)l * 64 * 1024 + col0;
#pragma unroll
        for (int nt = 0; nt < 4; ++nt)
#pragma unroll
            for (int i = 0; i < 16; ++i) acc[nt][i] = 0.f;
#pragma unroll
        for (int ks = 0; ks < 4; ++ks) {
            const bf16x8 a = *(const bf16x8*)(AD + n * 72 + 16 * ks + 8 * h);
            float4 w4[8];
#pragma unroll
            for (int e = 0; e < 8; ++e) w4[e] = *(const float4*)(wp + (size_t)(16 * ks + 8 * h + e) * 1024);
            bf16x8 b0, b1, b2, b3;
#pragma unroll
            for (int e = 0; e < 8; ++e) { b0[e] = (short)f2bf(w4[e].x); b1[e] = (short)f2bf(w4[e].y); b2[e] = (short)f2bf(w4[e].z); b3[e] = (short)f2bf(w4[e].w); }
            acc[0] = __builtin_amdgcn_mfma_f32_32x32x16_bf16(a, b0, acc[0], 0, 0, 0);
            acc[1] = __builtin_amdgcn_mfma_f32_32x32x16_bf16(a, b1, acc[1], 0, 0, 0);
            acc[2] = __builtin_amdgcn_mfma_f32_32x32x16_bf16(a, b2, acc[2], 0, 0, 0);
            acc[3] = __builtin_amdgcn_mfma_f32_32x32x16_bf16(a, b3, acc[3], 0, 0, 0);
        }
    }
    const float4 a0c = *(const float4*)(p.a0 + l * 1024 + col0), kkc = *(const float4*)(p.k_k + l * 1024 + col0), kac = *(const float4*)(p.k_a + l * 1024 + col0), rkc = *(const float4*)(p.r_k + l * 1024 + col0);
    const float4 mur = *(const float4*)(mu + col0), muk = *(const float4*)(mu + 1024 + col0), muv = *(const float4*)(mu + 2048 + col0);
    const int head = 2 * wv + (n >> 4);
#pragma unroll
    for (int r = 0; r < 16; ++r) {
        const int row = r0 + 8 * (r >> 2) + 4 * h + (r & 3);
        const float4 rr = mix4(rw, sshift, row, col0, mur), kr = mix4(rw, sshift, row, 1024 + col0, muk), vr = mix4(rw, sshift, row, 2048 + col0, muv);
        const float ax = 1.f / (1.f + __expf(-(a0c.x + acc[0][r]))), ay = 1.f / (1.f + __expf(-(a0c.y + acc[1][r])));
        const float az = 1.f / (1.f + __expf(-(a0c.z + acc[2][r]))), aw = 1.f / (1.f + __expf(-(a0c.w + acc[3][r])));
        const float k0 = kr.x * kkc.x, k1 = kr.y * kkc.y, k2 = kr.z * kkc.z, k3 = kr.w * kkc.w;
        const float ss = allreduce16(k0 * k0 + k1 * k1 + k2 * k2 + k3 * k3);
        const float inv = 1.f / fmaxf(sqrtf(ss), 1e-12f);
        const float4 kk = make_float4(k0 * inv, k1 * inv, k2 * inv, k3 * inv);
        const float4 ke = make_float4(kr.x * (1.f + (ax - 1.f) * kac.x), kr.y * (1.f + (ay - 1.f) * kac.y), kr.z * (1.f + (az - 1.f) * kac.z), kr.w * (1.f + (aw - 1.f) * kac.w));
        const float cf = allreduce16(rr.x * ke.x * rkc.x + rr.y * ke.y * rkc.y + rr.z * ke.z * rkc.z + rr.w * ke.w * rkc.w);
        if ((n & 15) == 0) coef[(size_t)row * 16 + head] = cf;
        const size_t o = (size_t)row * 1024 + col0;
        *(float4*)(RI + o) = rr;
        *(float4*)(RI + 2 * NRI + o) = ke;
        *(float4*)(RI + 3 * NRI + o) = kk;
        *(float4*)(RI + 4 * NRI + o) = make_float4(kk.x * ax, kk.y * ay, kk.z * az, kk.w * aw);
        *(float4*)(RI + 5 * NRI + o) = vr;
    }
    __syncthreads();
}

struct Step4 { float4 r, w, k, kk, b; float v; };
__device__ __forceinline__ float wkv_step(float4& s, const Step4& x) {
    float pa = s.x * x.kk.x + s.y * x.kk.y + s.z * x.kk.z + s.w * x.kk.w;
    pa = allreduce16(pa);
    const float sa = -pa;
    s.x = fmaf(sa, x.b.x, fmaf(s.x, x.w.x, x.v * x.k.x));
    s.y = fmaf(sa, x.b.y, fmaf(s.y, x.w.y, x.v * x.k.y));
    s.z = fmaf(sa, x.b.z, fmaf(s.z, x.w.z, x.v * x.k.z));
    s.w = fmaf(sa, x.b.w, fmaf(s.w, x.w.w, x.v * x.k.w));
    float py = s.x * x.r.x + s.y * x.r.y + s.z * x.r.z + s.w * x.r.w;
    return allreduce16(py);
}

__device__ void p3_recur(const Params& p, float* lds, int l, int bid, int G) {
    const int tid = opq_tid(), wv = tid >> 6, lane = tid & 63;
    const float* RI = (const float*)(p.ws + WS_RI);
    float* ys = (float*)(p.ws + WS_RW);
    if (bid < 128) {
        const int hh = bid >> 2, qd = bid & 3, b = hh >> 4, h = hh & 15;
        const size_t rowbase = (size_t)b * SEQ;
        constexpr int CH = 32, STEPF = 336, BUFF = CH * STEPF;
        const bool prod = wv >= 4;
        const int ptid = tid - 256;
        float4 pr[10]; float2 pv;
#define RC_PLOAD(c) do { _Pragma("unroll") for (int i_ = 0; i_ < 10; ++i_) { const int idx_ = ptid + 256 * i_, st_ = idx_ / 80, rem_ = idx_ - st_ * 80, arr_ = rem_ >> 4, q4_ = rem_ & 15; \
            pr[i_] = *(const float4*)(RI + (size_t)arr_ * NRI + (rowbase + (size_t)(c) * CH + st_) * 1024 + h * 64 + 4 * q4_); } \
        { const int idx2_ = ptid * 2, st_ = idx2_ >> 4, ii_ = idx2_ & 15; pv = *(const float2*)(RI + 5 * NRI + (rowbase + (size_t)(c) * CH + st_) * 1024 + h * 64 + 16 * qd + ii_); } } while (0)
#define RC_PSTORE(bufp) do { _Pragma("unroll") for (int i_ = 0; i_ < 10; ++i_) { const int idx_ = ptid + 256 * i_, st_ = idx_ / 80, rem_ = idx_ - st_ * 80, arr_ = rem_ >> 4, q4_ = rem_ & 15; \
            *(float4*)((bufp) + st_ * STEPF + arr_ * 64 + 4 * q4_) = pr[i_]; } \
        { const int idx2_ = ptid * 2, st_ = idx2_ >> 4, ii_ = idx2_ & 15; *(float2*)((bufp) + st_ * STEPF + 320 + ii_) = pv; } } while (0)
        if (prod) { RC_PLOAD(0); RC_PSTORE(lds); }
        asm volatile("s_waitcnt lgkmcnt(0)" ::: "memory");
        __builtin_amdgcn_s_barrier();
        float4 s = make_float4(0.f, 0.f, 0.f, 0.f);
        const int irow = 16 * qd + 4 * wv + (lane >> 4), jq = lane & 15;
#pragma unroll 1
        for (int c = 0; c < SEQ / CH; ++c) {
            float* bcur = lds + (c & 1) * BUFF;
            float* bnxt = lds + ((c + 1) & 1) * BUFF;
            if (prod) {
                if (c + 1 < SEQ / CH) { RC_PLOAD(c + 1); RC_PSTORE(bnxt); }
            } else {
                const float* sp = bcur + 4 * jq;
                const float* vp = bcur + 320 + 4 * wv + (lane >> 4);
                Step4 x0, x1;
#define RC_LD(x, st_) do { const float* sq_ = sp + (st_) * STEPF; x.r = *(const float4*)(sq_); x.w = *(const float4*)(sq_ + 64); x.k = *(const float4*)(sq_ + 128); x.kk = *(const float4*)(sq_ + 192); \
        x.b = *(const float4*)(sq_ + 256); x.v = vp[(st_) * STEPF]; } while (0)
                RC_LD(x0, 0); RC_LD(x1, 1);
                float* yp = ys + (rowbase + (size_t)c * CH + jq) * 1024 + h * 64 + irow;
                float ykeep = 0.f;
#pragma unroll 8
                for (int st = 0; st < CH; ++st) {
                    const Step4 cu = x0;
                    x0 = x1;
                    if (st + 2 < CH) RC_LD(x1, st + 2);
                    const float y = wkv_step(s, cu);
                    ykeep = (jq == (st & 15)) ? y : ykeep;
                    if ((st & 15) == 15) yp[(size_t)(st - 15) * 1024] = ykeep;
                }
#undef RC_LD
            }
            asm volatile("s_waitcnt lgkmcnt(0)" ::: "memory");
            __builtin_amdgcn_s_barrier();
        }
#undef RC_PLOAD
#undef RC_PSTORE
        if (!prod) *(float4*)(p.out + O_WKVP + (((size_t)(l * NBP + b) * 16 + h) * 64 + irow) * 64 + 4 * jq) = s;
    } else {
        const int nw = (G - 128) * 8;
        for (int task = (bid - 128) * 8 + wv; task < NBS * 16 * 16; task += nw) {
            const int bd = task >> 8, h = (task >> 4) & 15, wq = task & 15;
            const int irow = 4 * wq + (lane >> 4), jq = lane & 15;
            const size_t row = (size_t)TP + bd;
            const size_t so = (((size_t)(l * NBS + bd) * 16 + h) * 64 + irow) * 64 + 4 * jq;
            float4 s = *(const float4*)(p.state_wkv + so);
            const size_t o = row * 1024 + h * 64 + 4 * jq;
            Step4 x;
            x.r = *(const float4*)(RI + o); x.w = *(const float4*)(RI + NRI + o); x.k = *(const float4*)(RI + 2 * NRI + o); x.kk = *(const float4*)(RI + 3 * NRI + o); x.b = *(const float4*)(RI + 4 * NRI + o);
            x.v = RI[5 * NRI + row * 1024 + h * 64 + irow];
            const float y = wkv_step(s, x);
            *(float4*)(p.out + O_WKVS + so) = s;
            if (jq == 0) ys[row * 1024 + h * 64 + irow] = y;
        }
    }
}

__device__ void p3_post(const Params& p, int l, int bid, int G) {
    const int tid = opq_tid(), wv = tid >> 6, lane = tid & 63;
    const float* ys = (const float*)(p.ws + WS_RW);
    const float* V = (const float*)(p.ws + WS_RI) + 5 * NRI;
    const float* coef = (const float*)(p.ws + WS_COEF);
    const bf16_t* gt = (const bf16_t*)(p.ws + WS_GT);
    bf16_t* cc = (bf16_t*)(p.ws + WS_HB);
    for (int r = bid * 8 + wv; r < MT; r += G * 8) {
#pragma unroll
        for (int hg = 0; hg < 4; ++hg) {
            const int head = 4 * hg + (lane >> 4), c = head * 64 + 4 * (lane & 15);
            const float4 y = *(const float4*)(ys + (size_t)r * 1024 + c);
            const float mu = allreduce16(y.x + y.y + y.z + y.w) * (1.f / 64.f);
            const float d0 = y.x - mu, d1 = y.y - mu, d2 = y.z - mu, d3 = y.w - mu;
            const float var = allreduce16(d0 * d0 + d1 * d1 + d2 * d2 + d3 * d3) * (1.f / 64.f);
            const float rs = rsqrtf(var + 64e-5f);
            const float4 lw = *(const float4*)(p.ln_w + l * 1024 + c), lb = *(const float4*)(p.ln_b + l * 1024 + c), v4 = *(const float4*)(V + (size_t)r * 1024 + c);
            const float cf = coef[(size_t)r * 16 + head];
            const uint2 gg = *(const uint2*)(gt + (size_t)r * DM + 1024 + c);
            const float o0 = (d0 * rs * lw.x + lb.x + cf * v4.x) * bflo(gg.x), o1 = (d1 * rs * lw.y + lb.y + cf * v4.y) * bfhi(gg.x);
            const float o2 = (d2 * rs * lw.z + lb.z + cf * v4.z) * bflo(gg.y), o3 = (d3 * rs * lw.w + lb.w + cf * v4.w) * bfhi(gg.y);
            *(uint2*)(cc + (size_t)r * DM + 1024 + c) = make_uint2(pack2(o0, o1), pack2(o2, o3));
        }
    }
}

__device__ void p_final(const Params& p, int bid, int G) {
    const int tid = opq_tid(), wv = tid >> 6, lane = tid & 63;
    const float4* g4 = (const float4*)p.final_g;
    for (int r = bid * 8 + wv; r < MT; r += G * 8) {
        float4* xr = (float4*)(p.out + (size_t)r * DM);
        float4 v[8]; float ss = 0.f;
#pragma unroll
        for (int i = 0; i < 8; ++i) { v[i] = xr[lane + 64 * i]; ss += v[i].x * v[i].x + v[i].y * v[i].y + v[i].z * v[i].z + v[i].w * v[i].w; }
        ss = wave_sum(ss);
        const float rinv = rsqrtf(ss * (1.f / 2048.f) + 1e-5f);
#pragma unroll
        for (int i = 0; i < 8; ++i) { const float4 g = g4[lane + 64 * i]; xr[lane + 64 * i] = make_float4(v[i].x * rinv * g.x, v[i].y * rinv * g.y, v[i].z * rinv * g.z, v[i].w * rinv * g.w); }
    }
}

__global__ void __launch_bounds__(512, 2) fwd_kernel(Params p_unused) {
    extern __shared__ __attribute__((aligned(16))) unsigned char shm[];
    cg::grid_group grid = cg::this_grid();
    const int bid = blockIdx.x, G = gridDim.x;
    float* shf = (float*)shm;
    volatile LAS unsigned* xst = (volatile LAS unsigned*)((LAS unsigned char*)shm + 131072);
    if (threadIdx.x == 0) { xst[0] = 0u; xst[1] = 0u; }
    __syncthreads();
    const XcdBarrier xb = xcd_barrier_post((unsigned*)(kparams().ws + WS_BAR), xst);
    if (G == 0x7fffffff) grid.sync();

#pragma unroll 1
    for (int ph = 0; ph < 14; ++ph) {
        const int l = ph >= 7 ? 1 : 0, k = ph == 0 ? -1 : (ph == 13 ? 6 : (ph - 1) - 6 * l);
        if (k == -1) {
            for (int it = bid; it < 384; it += G) p0_mod_item(kparams(), shf, it / 192, it % 192);
            for (int it = bid; it < 17; it += G) p0_rope_item(kparams(), it);
            p0_conv_all(kparams(), shf, bid, G);
        } else if (k == 0) {
            p1_norm(kparams(), l, bid, G);
        } else if (k == 1) {
            pg8::StaticOrder S; S.init(MP, INWP, G, bid);
            pg8::Gemm g{(const bf16_t*)(kparams().ws + WS_HB), (const bf16_t*)(kparams().ws + WS_WTIN) + (size_t)l * INWP * DM, MP, INWP, DM};
            Epi1 E{l};
            pg8::gemm_phase<Epi1, pg8::StaticOrder, false>((PG8_LAS unsigned char*)shm, g, S, E, nullptr);
        } else if (k == 2) {
            for (int it = bid; it < 256 + 64 + 257; it += G) {
                if (it < 256) p3_attn_unit(kparams(), shm, l, it);
                else if (it < 320) p3_sattn_item(kparams(), shf, l, it - 256);
                else p3_prep_tile(kparams(), shm, l, it - 320);
            }
        } else if (k == 3) {
            p3_recur(kparams(), shf, l, bid, G);
        } else if (k == 4) {
            p3_post(kparams(), l, bid, G);
        } else if (k == 5) {
            pg8::StaticOrder S; S.init(TP, DM, G, bid);
            pg8::Gemm g{(const bf16_t*)(kparams().ws + WS_HB), (const bf16_t*)(kparams().ws + WS_WTOUT) + (size_t)l * DM * DM, TP, DM, DM};
            Epi2 E{l};
            pg8::gemm_phase<Epi2, pg8::StaticOrder, false>((PG8_LAS unsigned char*)shm, g, S, E, nullptr);
            for (int nb = bid; nb < 64; nb += G) g2_sample_item(kparams(), shf, l, nb);
        } else {
            p_final(kparams(), bid, G);
        }
        if (ph < 13) xcd_barrier(xb);
    }
}

extern "C" void kernel_launch(void* const* d_in, const int* in_sizes, int n_in, void* d_out, int out_size, void* d_ws, size_t ws_size, hipStream_t stream) {
    static int grid_blocks = 0;
    if (grid_blocks == 0) {
        if (n_in != 25 || (size_t)out_size != O_END || ws_size < WS_END) {
            fprintf(stderr, "kernel_launch: unexpected shapes: n_in %d out_size %d ws_size %zu (need %zu)\n", n_in, out_size, ws_size, (size_t)WS_END);
            grid_blocks = -1; return;
        }
        if (hipFuncSetAttribute((const void*)fwd_kernel, hipFuncAttributeMaxDynamicSharedMemorySize, LDS_BYTES) != hipSuccess) { fprintf(stderr, "kernel_launch: hipFuncSetAttribute failed\n"); grid_blocks = -1; return; }
        int dev = 0, cus = 0, per_cu = 0;
        hipGetDevice(&dev);
        hipDeviceGetAttribute(&cus, hipDeviceAttributeMultiprocessorCount, dev);
        hipOccupancyMaxActiveBlocksPerMultiprocessor(&per_cu, (const void*)fwd_kernel, 512, LDS_BYTES);
        if (per_cu < 1) { fprintf(stderr, "kernel_launch: occupancy query gives %d blocks per CU\n", per_cu); per_cu = 1; }
        (void)hipGetLastError();
        grid_blocks = cus;
        if (grid_blocks < 192) { fprintf(stderr, "kernel_launch: only %d CUs\n", grid_blocks); grid_blocks = -1; return; }
    }
    if (grid_blocks < 0) return;
    if (hipMemsetAsync((unsigned char*)d_ws + WS_BAR, 0, 16384, stream) != hipSuccess) { fprintf(stderr, "kernel_launch: memset of the barrier words failed\n"); return; }
    Params p{};
    const float** pp = (const float**)&p;
    for (int i = 0; i < 25; ++i) pp[i] = (const float*)d_in[i];
    p.out = (float*)d_out; p.ws = (unsigned char*)d_ws;
    void* args[] = {&p};
    hipError_t e = hipLaunchCooperativeKernel((const void*)fwd_kernel, dim3(grid_blocks), dim3(512), args, LDS_BYTES, stream);
    if (e != hipSuccess) fprintf(stderr, "cooperative launch failed: %s (grid %d)\n", hipGetErrorString(e), grid_blocks);
}
```

```cpp
#include <hip/hip_runtime.h>
#include <hip/hip_cooperative_groups.h>
#include <cstdio>
namespace cg = cooperative_groups;
__device__ __forceinline__ int opq_tid() { int t = threadIdx.x; asm volatile("" : "+v"(t)); return t; }
__device__ __forceinline__ int opq_s(int x) { asm volatile("" : "+s"(x)); return x; }
namespace pg8 {
#define PG8_LAS __attribute__((address_space(3)))
typedef unsigned short bf16_t;
typedef short bf16x8 __attribute__((ext_vector_type(8)));
typedef float f32x4 __attribute__((ext_vector_type(4)));
typedef unsigned u32x4 __attribute__((ext_vector_type(4)));
constexpr int BM = 256, BK = 64, HALF = 128, HTB = HALF * BK * 2  , STAGE_BYTES = 8 * HTB, NXCD = 8, WGM = 8;

__host__ __device__ __forceinline__ int lds_byte(int r, int c) { const int st = (r >> 4) * 2 + (c >> 5), rr = r & 15, cc = c & 31, ob = rr * 64 + cc * 2; return st * 1024 + (ob ^ (((ob >> 9) & 1) << 5)); }
__host__ __device__ __forceinline__ void stage_rc(int b, int& R, int& C) { const int st = b / 1024, sb = b % 1024, swz = sb ^ (((sb >> 9) & 1) << 5); R = (st >> 1) * 16 + swz / 64; C = (st & 1) * 32 + (swz % 64) / 2; }
__host__ __device__ __forceinline__ int perm32(int rho) { const int n = rho >> 4, i = rho & 15; return 8 * (i >> 2) + 4 * n + (i & 3); }

struct Unit { int pm, pn; };
struct Gemm { const bf16_t* A; const bf16_t* Bt; int M, N, K; };

struct StaticOrder {
    int nM, nN, nwg, G, c;
    __host__ __device__ void init(int M, int N, int G_, int c_) { nM = M / BM; nN = N / BM; nwg = nM * nN; G = G_; c = c_; }
    __host__ __device__ bool next(int i, Unit& u) const {
        const long L = (long)i * G + c; if (L >= nwg) return false;
        int wgid = (int)L; { const int q = nwg / NXCD, r = nwg % NXCD, xcd = wgid % NXCD, off = wgid / NXCD; wgid = (xcd < r ? xcd * (q + 1) : r * (q + 1) + (xcd - r) * q) + off; }
        const int nig = WGM * nN, gid = wgid / nig, fm = gid * WGM, gsz = (nM - fm) < WGM ? (nM - fm) : WGM;
        u.pm = fm + ((wgid % nig) % gsz); u.pn = (wgid % nig) / gsz; return true;
    }
    __device__ __forceinline__ void a_ready(const Unit&) const {}
    __device__ __forceinline__ void done(const Unit&) const {}
};
template <class Epi, class Sched, bool STAMP = false>
__device__ __forceinline__ void gemm_phase(PG8_LAS unsigned char* lds, const Gemm g, const Sched& S, const Epi& E, unsigned long long* stamps) {
    const int tid = opq_tid(), wid = __builtin_amdgcn_readfirstlane(tid >> 6), lane = tid & 63, wr = wid >> 2, wc = wid & 3, fr = lane & 15, fq = lane >> 4;
    const int K = g.K, nt = K / BK;
    int ts_lo = 0, ts_hi = 0, nts = 0; const unsigned long long rt_entry = STAMP ? (unsigned long long)wall_clock64() : 0ull;
#define PG8_STAMP() do { if (STAMP && wid == 0 && nts < 64) { const unsigned long long _c = (unsigned long long)clock64(); \
        ts_lo = (lane == nts) ? (int)(unsigned)_c : ts_lo; ts_hi = (lane == nts) ? (int)(unsigned)(_c >> 32) : ts_hi; ++nts; } } while (0)
    PG8_STAMP();
    unsigned voffA[2], voffB[2];
#pragma unroll
    for (int i = 0; i < 2; ++i) { int R, C; stage_rc(tid * 16 + i * 8192, R, C); const int Rb = Epi::PERM ? ((R & ~31) + perm32(R & 31)) : R;
        voffA[i] = (unsigned)(R * K + C) * 2u; voffB[i] = (unsigned)(Rb * K + C) * 2u; }
    const size_t kstep = (size_t)(BK * 2);
    const size_t hstep = (size_t)HALF * K * 2;
    const size_t tstep = 2 * hstep;
    const unsigned ldsw = (unsigned)wid * 1024u;
    const int aoff = lds_byte(wr * 64 + fr, fq * 8), boff = lds_byte(wc * 32 + fr, fq * 8);
#define PG8_SA(b, h) (((b) * 2 + (h)) * HTB)
#define PG8_SB(b, h) ((4 + (b) * 2 + (h)) * HTB)
#define PG8_STAGE(bufoff, gbase, voff) do { _Pragma("unroll") for (int _i = 0; _i < 2; ++_i) \
        __builtin_amdgcn_global_load_lds((const unsigned*)((const char*)(gbase) + (voff)[_i]), (PG8_LAS unsigned*)(lds + (bufoff) + ldsw + _i * 8192), 16, 0, 0); } while (0)
#define PG8_LDA(dst, b, h) do { _Pragma("unroll") for (int m = 0; m < 4; ++m) _Pragma("unroll") for (int k = 0; k < 2; ++k) dst[m][k] = *(const PG8_LAS bf16x8*)(lds + PG8_SA(b, h) + aoff + m * 2048 + k * 1024); } while (0)
#define PG8_LDB(dst, b, h) do { _Pragma("unroll") for (int n = 0; n < 2; ++n) _Pragma("unroll") for (int k = 0; k < 2; ++k) dst[n][k] = *(const PG8_LAS bf16x8*)(lds + PG8_SB(b, h) + boff + n * 2048 + k * 1024); } while (0)
#define PG8_MMA(ai, bj, At, Bt) do { __builtin_amdgcn_s_setprio(1); _Pragma("unroll") for (int m = 0; m < 4; ++m) _Pragma("unroll") for (int n = 0; n < 2; ++n) _Pragma("unroll") for (int k = 0; k < 2; ++k) \
        acc[ai][bj][m][n] = __builtin_amdgcn_mfma_f32_16x16x32_bf16(Bt[n][k], At[m][k], acc[ai][bj][m][n], 0, 0, 0); __builtin_amdgcn_s_setprio(0); } while (0)
#define PG8_WAIT_V(n) asm volatile("s_waitcnt vmcnt(" #n ")" ::: "memory")
#define PG8_WAIT_L(n) asm volatile("s_waitcnt lgkmcnt(" #n ")" ::: "memory")
#define PG8_BAR __builtin_amdgcn_s_barrier()
#define PG8_SCHED __builtin_amdgcn_sched_barrier(0)
    Unit cur, nxt; int ui = 0;
    if (!S.next(0, cur)) return;
    f32x4 acc[2][2][4][2];
#pragma unroll
    for (int a = 0; a < 2; ++a)
#pragma unroll
        for (int b = 0; b < 2; ++b)
#pragma unroll
            for (int m = 0; m < 4; ++m)
#pragma unroll
                for (int n = 0; n < 2; ++n) acc[a][b][m][n] = (f32x4){0.f, 0.f, 0.f, 0.f};
    bf16x8 At[4][2], B0[2][2], B1[2][2];
    const char* cA = (const char*)g.A + (size_t)cur.pm * tstep; const char* cB = (const char*)g.Bt + (size_t)cur.pn * tstep;
    S.a_ready(cur);
    PG8_STAGE(PG8_SB(0, 0), cB, voffB); PG8_STAGE(PG8_SA(0, 0), cA, voffA); PG8_STAGE(PG8_SB(0, 1), cB + hstep, voffB); PG8_STAGE(PG8_SA(0, 1), cA + hstep, voffA);
    if (wr == 1) PG8_BAR;
    PG8_WAIT_V(4); PG8_BAR;
    PG8_STAGE(PG8_SB(1, 0), cB + kstep, voffB); PG8_STAGE(PG8_SA(1, 0), cA + kstep, voffA); PG8_STAGE(PG8_SB(1, 1), cB + hstep + kstep, voffB);
    PG8_WAIT_V(6); PG8_BAR;
    PG8_STAMP();
    for (;;) {
        const bool has_next = S.next(ui + 1, nxt);
        const char* nA = has_next ? (const char*)g.A + (size_t)nxt.pm * tstep : cA; const char* nB = has_next ? (const char*)g.Bt + (size_t)nxt.pn * tstep : cB;
        for (int t = 0; t < nt; t += 2) {
            const bool last = (t == nt - 2);
            const char* a1 = cA + (size_t)(t + 1) * kstep;
            const char* a2 = last ? nA : cA + (size_t)(t + 2) * kstep; const char* b2 = last ? nB : cB + (size_t)(t + 2) * kstep;
            const char* a3 = a2 + kstep; const char* b3 = b2 + kstep;
            if (last && has_next) S.a_ready(nxt);
            PG8_LDB(B0, 0, 0); PG8_SCHED; PG8_LDA(At, 0, 0); PG8_STAGE(PG8_SA(1, 1), a1 + hstep, voffA);
            PG8_WAIT_L(8); PG8_BAR; PG8_WAIT_L(0); PG8_MMA(0, 0, At, B0); PG8_BAR; PG8_SCHED;
            PG8_LDB(B1, 0, 1); PG8_STAGE(PG8_SB(0, 0), b2, voffB);
            PG8_BAR; PG8_WAIT_L(0); PG8_MMA(0, 1, At, B1); PG8_BAR;
            PG8_LDA(At, 0, 1); PG8_STAGE(PG8_SA(0, 0), a2, voffA);
            PG8_BAR; PG8_WAIT_L(0); PG8_MMA(1, 0, At, B0); PG8_BAR; PG8_SCHED;
            PG8_STAGE(PG8_SB(0, 1), b2 + hstep, voffB);
            PG8_WAIT_V(6); PG8_BAR; PG8_MMA(1, 1, At, B1); PG8_BAR;
            PG8_LDB(B0, 1, 0); PG8_SCHED; PG8_LDA(At, 1, 0); PG8_STAGE(PG8_SA(0, 1), a2 + hstep, voffA);
            PG8_WAIT_L(8); PG8_BAR; PG8_WAIT_L(0); PG8_MMA(0, 0, At, B0); PG8_BAR; PG8_SCHED;
            PG8_LDB(B1, 1, 1); PG8_STAGE(PG8_SB(1, 0), b3, voffB);
            PG8_BAR; PG8_WAIT_L(0); PG8_MMA(0, 1, At, B1); PG8_BAR;
            PG8_LDA(At, 1, 1); PG8_STAGE(PG8_SA(1, 0), a3, voffA);
            PG8_BAR; PG8_WAIT_L(0); PG8_MMA(1, 0, At, B0); PG8_BAR; PG8_SCHED;
            PG8_STAGE(PG8_SB(1, 1), b3 + hstep, voffB);
            PG8_WAIT_V(6); PG8_BAR; PG8_MMA(1, 1, At, B1); PG8_BAR;
        }
        PG8_STAMP();
        if constexpr (!Epi::AFTER_DRAIN) { E(acc, cur, wr, wc, fr, fq); S.done(cur); }
        PG8_STAMP();
        if (!has_next) break;
#pragma unroll
        for (int a = 0; a < 2; ++a)
#pragma unroll
            for (int b = 0; b < 2; ++b)
#pragma unroll
                for (int m = 0; m < 4; ++m)
#pragma unroll
                    for (int n = 0; n < 2; ++n) acc[a][b][m][n] = (f32x4){0.f, 0.f, 0.f, 0.f};
        cur = nxt; cA = nA; cB = nB; ++ui;
    }
    PG8_WAIT_V(0);
    if (wr == 0) PG8_BAR;
    PG8_BAR;
    if constexpr (Epi::AFTER_DRAIN) { E.fused(acc, cur, wr, wc, fr, fq, lds, wid, lane); S.done(cur); }
    PG8_STAMP();
    if (STAMP && wid == 0) { stamps[lane] = lane < nts ? (((unsigned long long)(unsigned)ts_hi << 32) | (unsigned)ts_lo) : 0ull;
        if (lane == 62) stamps[62] = rt_entry; if (lane == 63) stamps[63] = (unsigned long long)wall_clock64(); }
#undef PG8_STAMP
#undef PG8_SA
#undef PG8_SB
#undef PG8_STAGE
#undef PG8_LDA
#undef PG8_LDB
#undef PG8_MMA
#undef PG8_WAIT_V
#undef PG8_WAIT_L
#undef PG8_BAR
#undef PG8_SCHED
}
}

#define XB_TMO      128
#define XB_XCNT(j)  (256  + 64 * (j))
#define XB_XSUB(j)  (1280 + 64 * (j))
#define XB_XGEN(j)  (2304 + 64 * (j))
#define XB_TOP      3328
#define XB_TOPGEN   3392
#define XCD_BAR_WORDS 3456
#define XB_SPIN_CAP (1u << 18)
#define LAS __attribute__((address_space(3)))

__device__ __forceinline__ unsigned xb_ld(unsigned* p)              { return __hip_atomic_load(p, __ATOMIC_RELAXED, __HIP_MEMORY_SCOPE_AGENT); }
__device__ __forceinline__ unsigned xb_add(unsigned* p, unsigned v) { return __hip_atomic_fetch_add(p, v, __ATOMIC_RELAXED, __HIP_MEMORY_SCOPE_AGENT); }
__device__ __forceinline__ unsigned xb_xcc_id() { return (unsigned)__builtin_amdgcn_s_getreg((3 << 11) | 20) & 0xFu; }
#define XB_SPIN(cond, bar) do { unsigned _sp = 0; while (cond) { __builtin_amdgcn_s_sleep(1); \
    if ((++_sp & 255u) == 0u) { if (xb_ld(&(bar)[XB_TMO])) break; if (_sp > XB_SPIN_CAP) { atomicAdd(&(bar)[XB_TMO], 1u); break; } } } } while (0)

struct XcdBarrier {
    unsigned* bar; unsigned x;
    volatile LAS unsigned* st;
};

__device__ __forceinline__ XcdBarrier xcd_barrier_post(unsigned* bar, volatile LAS unsigned* st) {
    XcdBarrier b; b.bar = bar; b.x = xb_xcc_id(); b.st = st;
    if (threadIdx.x == 0) (void)xb_add(&bar[XB_XCNT(b.x)], 1u);
    return b;
}
__device__ __forceinline__ void xcd_barrier_complete(unsigned* bar, unsigned x, unsigned& nloc, unsigned& nx) {
    const unsigned G = gridDim.x * gridDim.y * gridDim.z;
    unsigned sum, cnt, mine, sp = 0u;
    for (;;) {
        sum = 0u; cnt = 0u; mine = 0u;
#pragma unroll
        for (unsigned j = 0; j < 16; ++j) { const unsigned c = xb_ld(&bar[XB_XCNT(j)]); sum += c; cnt += (c > 0u) ? 1u : 0u; mine = (j == x) ? c : mine; }
        if (sum == G) break;
        __builtin_amdgcn_s_sleep(1);
        if ((++sp & 255u) == 0u) { if (xb_ld(&bar[XB_TMO])) break; if (sp > XB_SPIN_CAP) { atomicAdd(&bar[XB_TMO], 1u); break; } }
    }
    nloc = mine > 0u ? mine : 1u; nx = cnt > 0u ? cnt : 1u;
}

__device__ __forceinline__ void xcd_barrier(const XcdBarrier& b) {
    asm volatile("s_waitcnt vmcnt(0)" ::: "memory");
    __syncthreads();
    if (threadIdx.x == 0) {
        unsigned* bar = b.bar;
        __builtin_amdgcn_s_waitcnt(0);
        unsigned nloc = b.st[0], nx = b.st[1];
        if (nloc == 0u) { xcd_barrier_complete(bar, b.x, nloc, nx); b.st[0] = nloc; b.st[1] = nx; }
        const unsigned old = xb_add(&bar[XB_XSUB(b.x)], 1u);
        const unsigned gen = old / nloc;
        if (old + 1u == (gen + 1u) * nloc) {
            __builtin_amdgcn_fence(__ATOMIC_RELEASE, "agent");
            asm volatile("s_waitcnt vmcnt(0)" ::: "memory");
            const unsigned og = xb_add(&bar[XB_TOP], 1u);
            const unsigned tg = og / nx;
            if (og + 1u == (tg + 1u) * nx) xb_add(&bar[XB_TOPGEN], 1u);
            else XB_SPIN(xb_ld(&bar[XB_TOPGEN]) == tg, bar);
            __builtin_amdgcn_fence(__ATOMIC_ACQUIRE, "agent");
            xb_add(&bar[XB_XGEN(b.x)], 1u);
            asm volatile("s_waitcnt vmcnt(0)" ::: "memory");
        } else {
            XB_SPIN(xb_ld(&bar[XB_XGEN(b.x)]) == gen, bar);
            __builtin_amdgcn_fence(__ATOMIC_ACQUIRE, "agent");
            asm volatile("s_waitcnt vmcnt(0)" ::: "memory");
        }
    }
    __syncthreads();
}

typedef unsigned short bf16_t;
typedef short bf16x8 __attribute__((ext_vector_type(8)));
typedef float f32x4 __attribute__((ext_vector_type(4)));
typedef float f32x16 __attribute__((ext_vector_type(16)));

constexpr int DM = 2048, SEQ = 4096, NBP = 2, NBS = 32, TP = NBP * SEQ, MT = TP + NBS, MP = 8448;
constexpr int INW = 6784, INWP = 6912, SHD = 3200, DEPTH = 2;
constexpr size_t NRI = (size_t)MT * 1024;
constexpr int LDS_BYTES = 131072 + 16;
constexpr size_t O_CKP = (size_t)MT * DM;
constexpr size_t O_CVP = O_CKP + (size_t)DEPTH * NBP * 128 * 256;
constexpr size_t O_WKVP = O_CVP + (size_t)DEPTH * NBP * 128 * 256;
constexpr size_t O_SHP = O_WKVP + (size_t)DEPTH * NBP * 16 * 4096;
constexpr size_t O_CKS = O_SHP + (size_t)DEPTH * NBP * SHD;
constexpr size_t O_CVS = O_CKS + (size_t)DEPTH * NBS * 128 * 256;
constexpr size_t O_WKVS = O_CVS + (size_t)DEPTH * NBS * 128 * 256;
constexpr size_t O_SHS = O_WKVS + (size_t)DEPTH * NBS * 16 * 4096;
constexpr size_t O_END = O_SHS + (size_t)DEPTH * NBS * SHD;
constexpr size_t al256(size_t x) { return (x + 255) & ~(size_t)255; }
constexpr size_t WS_WTIN = 0;
constexpr size_t WS_WTOUT = WS_WTIN + (size_t)INWP * DM * 2;
constexpr size_t WS_MOD = WS_WTOUT + (size_t)DEPTH * DM * DM * 2;
constexpr size_t WS_ROPE = WS_MOD + al256((size_t)DEPTH * 34 * 6144 * 4);
constexpr size_t WS_HB = WS_ROPE + al256((size_t)4097 * 16 * 4);
constexpr size_t WS_QB = WS_HB + (size_t)MP * DM * 2;
constexpr size_t WS_KB = WS_QB + (size_t)MP * 1024 * 2;
constexpr size_t WS_VB = WS_KB + (size_t)MP * 256 * 2;
constexpr size_t WS_RW = WS_VB + (size_t)MP * 256 * 2;
constexpr size_t WS_GT = WS_RW + (size_t)MP * SHD * 2;
constexpr size_t WS_RIB = WS_GT + (size_t)MP * DM * 2;
constexpr size_t WS_RIW = WS_RIB + 5 * NRI * 2;
constexpr size_t WS_REC = WS_RIW + NRI * 4;
constexpr size_t WS_COEF = WS_REC + (size_t)32 * 256 * 14592;
constexpr size_t WS_BAR = WS_COEF + al256((size_t)MT * 16 * 4);
constexpr size_t WS_END = WS_BAR + 16384;

struct Params {
    const float *x_prompt, *x_sample, *cache_k, *cache_v, *state_wkv, *state_shift, *c_prompt, *c_sample, *norm_g, *w_ada, *b_ada, *w_in, *mu_shift, *w0, *w_decay, *a0,
        *w_iclr, *k_k, *k_a, *r_k, *ln_w, *ln_b, *sinks, *w_out, *final_g;
    float* out;
    unsigned char* ws;
    int repk, repl;
};
typedef const __attribute__((address_space(4))) Params* KParamsPtr;
__device__ __forceinline__ const Params& kparams() {
    KParamsPtr k = (KParamsPtr)__builtin_amdgcn_kernarg_segment_ptr();
    asm volatile("" : "+s"(k));
    return *(const Params*)k;
}

__device__ __forceinline__ unsigned short f2bf(float f) { unsigned u = __float_as_uint(f); u += 0x7FFFu + ((u >> 16) & 1u); return (unsigned short)(u >> 16); }
__device__ __forceinline__ float bf2f(unsigned short b) { return __uint_as_float(((unsigned)b) << 16); }
__device__ __forceinline__ unsigned pack2(float lo, float hi) { return (unsigned)f2bf(lo) | ((unsigned)f2bf(hi) << 16); }
__device__ __forceinline__ float bflo(unsigned w) { return __uint_as_float(w << 16); }
__device__ __forceinline__ float bfhi(unsigned w) { return __uint_as_float(w & 0xffff0000u); }
__device__ __forceinline__ float silu_f(float x) { return x / (1.f + __expf(-x)); }
__device__ __forceinline__ float wave_sum(float x) {
#pragma unroll
    for (int o = 32; o >= 1; o >>= 1) x += __shfl_xor(x, o);
    return x;
}
__device__ __forceinline__ float wave_max(float x) {
#pragma unroll
    for (int o = 32; o >= 1; o >>= 1) x = fmaxf(x, __shfl_xor(x, o));
    return x;
}
template <int CTRL> __device__ __forceinline__ float dpp_f(float x) {
    return __builtin_bit_cast(float, __builtin_amdgcn_update_dpp(0, __builtin_bit_cast(int, x), CTRL, 0xF, 0xF, false));
}
__device__ __forceinline__ float allreduce16(float x) {
    x += dpp_f<0x128>(x);
    x += dpp_f<0x124>(x);
    x += dpp_f<0x122>(x);
    x += dpp_f<0x121>(x);
    return x;
}

__device__ void p0_mod_item(const Params& p, float* red, int l, int nc) {
    const int tid = opq_tid(), wv = tid >> 6, lane = tid & 63, n = lane & 31, kh = lane >> 5;
    f32x16 acc0, acc1;
#pragma unroll
    for (int i = 0; i < 16; ++i) { acc0[i] = 0.f; acc1[i] = 0.f; }
    const float* W = p.w_ada + (size_t)l * DM * 6144 + nc * 32 + n;
#pragma unroll 4
    for (int ks = 0; ks < 16; ++ks) {
        const int k0 = wv * 256 + ks * 16 + kh * 8;
        bf16x8 bfr, a0, a1;
#pragma unroll
        for (int j = 0; j < 8; ++j) bfr[j] = (short)f2bf(W[(size_t)(k0 + j) * 6144]);
        const float4* cs = (const float4*)(p.c_sample + (size_t)n * DM + k0);
        const float4 u0 = cs[0], u1 = cs[1];
        a0[0] = (short)f2bf(silu_f(u0.x)); a0[1] = (short)f2bf(silu_f(u0.y)); a0[2] = (short)f2bf(silu_f(u0.z)); a0[3] = (short)f2bf(silu_f(u0.w));
        a0[4] = (short)f2bf(silu_f(u1.x)); a0[5] = (short)f2bf(silu_f(u1.y)); a0[6] = (short)f2bf(silu_f(u1.z)); a0[7] = (short)f2bf(silu_f(u1.w));
        float4 q0 = make_float4(0.f, 0.f, 0.f, 0.f), q1 = q0;
        if (n < 2) { const float4* cp = (const float4*)(p.c_prompt + (size_t)n * DM + k0); q0 = cp[0]; q1 = cp[1]; }
        a1[0] = (short)f2bf(silu_f(q0.x)); a1[1] = (short)f2bf(silu_f(q0.y)); a1[2] = (short)f2bf(silu_f(q0.z)); a1[3] = (short)f2bf(silu_f(q0.w));
        a1[4] = (short)f2bf(silu_f(q1.x)); a1[5] = (short)f2bf(silu_f(q1.y)); a1[6] = (short)f2bf(silu_f(q1.z)); a1[7] = (short)f2bf(silu_f(q1.w));
        acc0 = __builtin_amdgcn_mfma_f32_32x32x16_bf16(a0, bfr, acc0, 0, 0, 0);
        acc1 = __builtin_amdgcn_mfma_f32_32x32x16_bf16(a1, bfr, acc1, 0, 0, 0);
    }
#pragma unroll
    for (int i = 0; i < 16; ++i) red[(wv * 18 + i) * 64 + lane] = acc0[i];
    red[(wv * 18 + 16) * 64 + lane] = acc1[0];
    red[(wv * 18 + 17) * 64 + lane] = acc1[1];
    __syncthreads();
    float* mod = (float*)(p.ws + WS_MOD);
    for (int o = tid; o < 34 * 32; o += 512) {
        const int row = o >> 5, col = o & 31;
        int ri, ln, mrow;
        if (row < 32) { const int khh = (row >> 2) & 1; ri = (row & 3) + 4 * (row >> 3); ln = col + 32 * khh; mrow = 2 + row; }
        else { ri = 16 + (row - 32); ln = col; mrow = row - 32; }
        float s = 0.f;
#pragma unroll
        for (int w = 0; w < 8; ++w) s += red[(w * 18 + ri) * 64 + ln];
        mod[((size_t)l * 34 + mrow) * 6144 + nc * 32 + col] = s + p.b_ada[l * 6144 + nc * 32 + col];
    }
    __syncthreads();
}

struct ConvIt { const float* src; bf16_t* dst; int N, k0, n0; };
__device__ __forceinline__ ConvIt conv_decode(const Params& p, int cidx, int lw) {
    ConvIt c;
    int kt, nt;
    if (cidx < 1728) { kt = cidx & 15; nt = cidx >> 4; c.N = INW; c.src = p.w_in + (size_t)lw * DM * INW; c.dst = (bf16_t*)(p.ws + WS_WTIN); }
    else { int rem = cidx - 1728; const int l2 = rem >> 9; rem &= 511; kt = rem & 15; nt = rem >> 4; c.N = DM; c.src = p.w_out + (size_t)l2 * DM * DM; c.dst = (bf16_t*)(p.ws + WS_WTOUT) + (size_t)l2 * DM * DM; }
    c.k0 = kt * 128; c.n0 = nt * 64;
    return c;
}
__device__ void p0_conv_all(const Params& p, float* s, int bid, int G, int total, int lw) {
    const int tid = opq_tid();
    const int lrow = tid >> 4, c4 = tid & 15, n = tid >> 3, kg = tid & 7;
    float4 v[4];
    int cidx = bid;
    ConvIt cur = conv_decode(p, cidx < total ? cidx : 0, lw);
    if (cidx < total) {
#pragma unroll
        for (int p4 = 0; p4 < 4; ++p4) { v[p4] = make_float4(0.f, 0.f, 0.f, 0.f); if (cur.n0 < cur.N) v[p4] = *(const float4*)(cur.src + (size_t)(cur.k0 + lrow + 32 * p4) * cur.N + cur.n0 + 4 * c4); }
    }
#pragma unroll 1
    while (cidx < total) {
#pragma unroll
        for (int p4 = 0; p4 < 4; ++p4) { float* d = s + (lrow + 32 * p4) * 65 + 4 * c4; d[0] = v[p4].x; d[1] = v[p4].y; d[2] = v[p4].z; d[3] = v[p4].w; }
        __syncthreads();
        const int nxt = cidx + G;
        const ConvIt nx = conv_decode(p, nxt < total ? nxt : 0, lw);
        if (nxt < total) {
#pragma unroll
            for (int p4 = 0; p4 < 4; ++p4) { v[p4] = make_float4(0.f, 0.f, 0.f, 0.f); if (nx.n0 < nx.N) v[p4] = *(const float4*)(nx.src + (size_t)(nx.k0 + lrow + 32 * p4) * nx.N + nx.n0 + 4 * c4); }
        }
        unsigned w[8];
#pragma unroll
        for (int j = 0; j < 8; ++j) w[j] = pack2(s[(kg * 16 + 2 * j) * 65 + n], s[(kg * 16 + 2 * j + 1) * 65 + n]);
        uint4* o = (uint4*)(cur.dst + (size_t)(cur.n0 + n) * DM + cur.k0 + kg * 16);
        o[0] = make_uint4(w[0], w[1], w[2], w[3]);
        o[1] = make_uint4(w[4], w[5], w[6], w[7]);
        __syncthreads();
        cur = nx; cidx = nxt;
    }
}

__device__ void p0_rope_item(const Params& p, int it) {
    float* rope = (float*)(p.ws + WS_ROPE);
#pragma unroll
    for (int q = 0; q < 4; ++q) {
        const int e = it * 2048 + q * 512 + opq_tid();
        if (e < 4097 * 8) {
            const int idx = e >> 3, i = e & 7;
            double invf = 1.0;
            for (int q = 0; q < i; ++q) invf *= 0.19392274474868576;
            const double pos = idx < 4096 ? (double)idx : 16384.0;
            const double rev = pos * invf * 0.15915494309189535;
            const float f = (float)(rev - floor(rev));
            rope[idx * 16 + i] = __builtin_amdgcn_cosf(f);
            rope[idx * 16 + 8 + i] = __builtin_amdgcn_sinf(f);
        }
    }
}

__device__ void p1_norm(const Params& p, int l, int bid, int G) {
    const int tid = opq_tid(), wv = tid >> 6, lane = tid & 63;
    bf16_t* hb = (bf16_t*)(p.ws + WS_HB);
    const float* mod = (const float*)(p.ws + WS_MOD);
    const float4* g4 = (const float4*)(p.norm_g + l * DM);
    for (int r = bid * 8 + wv; r < MT; r += G * 8) {
        const float* xr = l == 0 ? (r < TP ? p.x_prompt + (size_t)r * DM : p.x_sample + (size_t)(r - TP) * DM) : p.out + (size_t)r * DM;
        const int mrow = r < TP ? (r >> 12) : 2 + (r - TP);
        const float* md = mod + ((size_t)l * 34 + mrow) * 6144;
        float4 v[8]; float ss = 0.f;
#pragma unroll
        for (int i = 0; i < 8; ++i) { v[i] = ((const float4*)xr)[lane + 64 * i]; ss += v[i].x * v[i].x + v[i].y * v[i].y + v[i].z * v[i].z + v[i].w * v[i].w; }
        ss = wave_sum(ss);
        const float rinv = rsqrtf(ss * (1.f / 2048.f) + 1e-5f);
#pragma unroll
        for (int i = 0; i < 8; ++i) {
            const int c4 = lane + 64 * i;
            const float4 g = g4[c4], sc = ((const float4*)(md + 2048))[c4], sh = ((const float4*)md)[c4];
            const float y0 = v[i].x * rinv * g.x * (1.f + sc.x) + sh.x, y1 = v[i].y * rinv * g.y * (1.f + sc.y) + sh.y;
            const float y2 = v[i].z * rinv * g.z * (1.f + sc.z) + sh.z, y3 = v[i].w * rinv * g.w * (1.f + sc.w) + sh.w;
            *(uint2*)(hb + (size_t)r * DM + 4 * c4) = make_uint2(pack2(y0, y1), pack2(y2, y3));
        }
    }
}

struct Epi1 {
    static constexpr bool PERM = false, AFTER_DRAIN = false;
    int l;
    __device__ __forceinline__ void operator()(const f32x4 (&acc)[2][2][4][2], const pg8::Unit& u, int wr, int wc, int fr, int fq) const {
        const Params& p = kparams();
        bf16_t* const qb = (bf16_t*)(p.ws + WS_QB); bf16_t* const kb = (bf16_t*)(p.ws + WS_KB); bf16_t* const vb = (bf16_t*)(p.ws + WS_VB);
        bf16_t* const rw = (bf16_t*)(p.ws + WS_RW); bf16_t* const gt = (bf16_t*)(p.ws + WS_GT); const float* const rope = (const float*)(p.ws + WS_ROPE); float* const out = p.out;
#pragma unroll
        for (int bj = 0; bj < 2; ++bj)
#pragma unroll
            for (int n = 0; n < 2; ++n) {
                const int cb = u.pn * 256 + bj * 128 + wc * 32 + n * 16;
                if (cb >= INW) continue;
                const int c = cb + 4 * fq;
                const bool do_rope = (cb < 1280) && ((cb & 63) == 0);
#pragma unroll
                for (int ai = 0; ai < 2; ++ai)
#pragma unroll
                    for (int m = 0; m < 4; ++m) {
                        const int rb = u.pm * 256 + ai * 128 + wr * 64 + m * 16;
                        if (rb >= MT) continue;
                        const int r = rb + fr;
                        f32x4 v = acc[ai][bj][m][n];
                        if (do_rope) {
                            const int idx = r < TP ? (r & 4095) : 4096;
                            const float4 cs = *(const float4*)(rope + idx * 16 + 4 * (fq & 1));
                            const float4 sn = *(const float4*)(rope + idx * 16 + 8 + 4 * (fq & 1));
                            const float p0 = __shfl_xor(v[0], 32), p1 = __shfl_xor(v[1], 32), p2 = __shfl_xor(v[2], 32), p3 = __shfl_xor(v[3], 32);
                            const float sg = fq < 2 ? -1.f : 1.f;
                            v[0] = v[0] * cs.x + sg * p0 * sn.x; v[1] = v[1] * cs.y + sg * p1 * sn.y; v[2] = v[2] * cs.z + sg * p2 * sn.z; v[3] = v[3] * cs.w + sg * p3 * sn.w;
                        }
                        if (cb < 1024) {
                            *(uint2*)(qb + (size_t)r * 1024 + c) = make_uint2(pack2(v[0] * 0.125f, v[1] * 0.125f), pack2(v[2] * 0.125f, v[3] * 0.125f));
                        } else if (cb < 1536) {
                            const bool isk = cb < 1280;
                            const int cc = c - (isk ? 1024 : 1280);
                            *(uint2*)((isk ? kb : vb) + (size_t)r * 256 + cc) = make_uint2(pack2(v[0], v[1]), pack2(v[2], v[3]));
                            if (r >= TP) {
                                *(f32x4*)(out + (isk ? O_CKS : O_CVS) + ((size_t)(l * NBS + (r - TP)) * 128 + 127) * 256 + cc) = v;
                            } else if ((r & 4095) >= SEQ - 128) {
                                *(f32x4*)(out + (isk ? O_CKP : O_CVP) + ((size_t)(l * NBP + (r >> 12)) * 128 + ((r & 4095) - (SEQ - 128))) * 256 + cc) = v;
                            }
                        } else if (cb < 4736) {
                            const int cc = c - 1536;
                            *(uint2*)(rw + (size_t)r * SHD + cc) = make_uint2(pack2(v[0], v[1]), pack2(v[2], v[3]));
                            if (r >= TP) *(f32x4*)(out + O_SHS + (size_t)(l * NBS + (r - TP)) * SHD + cc) = v;
                            else if ((r & 4095) == SEQ - 1) *(f32x4*)(out + O_SHP + (size_t)(l * NBP + (r >> 12)) * SHD + cc) = v;
                        } else {
                            const int cc = c - 4736;
                            *(uint2*)(gt + (size_t)r * DM + cc) = make_uint2(pack2(silu_f(v[0]), silu_f(v[1])), pack2(silu_f(v[2]), silu_f(v[3])));
                        }
                    }
            }
    }
};

struct Epi2 {
    static constexpr bool PERM = false, AFTER_DRAIN = false;
    int l;
    __device__ __forceinline__ void operator()(const f32x4 (&acc)[2][2][4][2], const pg8::Unit& u, int wr, int wc, int fr, int fq) const {
        const Params& p = kparams();
        const float* const xp = p.x_prompt; const float* const xs = p.x_sample; const float* const modl = (const float*)(p.ws + WS_MOD) + (size_t)l * 34 * 6144; float* const out = p.out;
#pragma unroll
        for (int ai = 0; ai < 2; ++ai)
#pragma unroll
            for (int m = 0; m < 4; ++m) {
                const int rb = u.pm * 256 + ai * 128 + wr * 64 + m * 16;
                if (rb >= MT) continue;
                const int r = rb + fr;
                const int mrow = r < TP ? (r >> 12) : 2 + (r - TP);
                const float* xo = l == 0 ? (r < TP ? xp + (size_t)r * DM : xs + (size_t)(r - TP) * DM) : out + (size_t)r * DM;
                const float* gr = modl + (size_t)mrow * 6144 + 4096;
#pragma unroll
                for (int bj = 0; bj < 2; ++bj)
#pragma unroll
                    for (int n = 0; n < 2; ++n) {
                        const int c = u.pn * 256 + bj * 128 + wc * 32 + n * 16 + 4 * fq;
                        const f32x4 x4 = *(const f32x4*)(xo + c), g4 = *(const f32x4*)(gr + c);
                        *(f32x4*)(out + (size_t)r * DM + c) = x4 + g4 * acc[ai][bj][m][n];
                    }
            }
    }
};

__device__ void g2_sample_item(const Params& p, float* red, int l, int nb) {
    const int tid = opq_tid(), wv = tid >> 6, lane = tid & 63, n = lane & 31, h = lane >> 5;
    const bf16_t* A = (const bf16_t*)(p.ws + WS_HB) + (size_t)TP * DM;
    const bf16_t* Bt = (const bf16_t*)(p.ws + WS_WTOUT) + (size_t)l * DM * DM + (size_t)(nb * 32) * DM;
    f32x16 acc;
#pragma unroll
    for (int i = 0; i < 16; ++i) acc[i] = 0.f;
#pragma unroll 4
    for (int ks = 0; ks < 16; ++ks) {
        const int k0 = wv * 256 + ks * 16 + 8 * h;
        const bf16x8 a = *(const bf16x8*)(A + (size_t)n * DM + k0);
        const bf16x8 bq = *(const bf16x8*)(Bt + (size_t)n * DM + k0);
        acc = __builtin_amdgcn_mfma_f32_32x32x16_bf16(a, bq, acc, 0, 0, 0);
    }
#pragma unroll
    for (int i = 0; i < 16; ++i) red[(wv * 16 + i) * 64 + lane] = acc[i];
    __syncthreads();
    const float* mod = (const float*)(p.ws + WS_MOD) + (size_t)l * 34 * 6144;
    for (int o = tid; o < 1024; o += 512) {
        const int row = o >> 5, col = o & 31, hh = (row >> 2) & 1, ri = (row & 3) + 4 * (row >> 3), ln = col + 32 * hh;
        float s = 0.f;
#pragma unroll
        for (int w = 0; w < 8; ++w) s += red[(w * 16 + ri) * 64 + ln];
        const int c = nb * 32 + col;
        const float gate = mod[(size_t)(2 + row) * 6144 + 4096 + c];
        const float xo = l == 0 ? p.x_sample[(size_t)row * DM + c] : p.out[(size_t)(TP + row) * DM + c];
        p.out[(size_t)(TP + row) * DM + c] = xo + gate * s;
    }
    __syncthreads();
}

__device__ void p3_attn_unit(const Params& p, unsigned char* lds, int l, int unit) {
    const int tid = opq_tid(), wv = tid >> 6, lane = tid & 63;
    const int b = unit >> 7, n = (unit >> 2) & 31, g = unit & 3;
    bf16_t* Ks = (bf16_t*)lds;
    bf16_t* Vt = (bf16_t*)(lds + 36864);
    const bf16_t* qb = (const bf16_t*)(p.ws + WS_QB);
    const bf16_t* kb = (const bf16_t*)(p.ws + WS_KB);
    const bf16_t* vb = (const bf16_t*)(p.ws + WS_VB);
    const bf16_t* gt = (const bf16_t*)(p.ws + WS_GT);
    bf16_t* cc = (bf16_t*)(p.ws + WS_HB);
#pragma unroll
    for (int i = 0; i < 4; ++i) {
        const int chunk = tid + 512 * i, kl = chunk >> 3, dc = chunk & 7, kp = 128 * (n - 1) + kl;
        uint4 kv4 = make_uint4(0u, 0u, 0u, 0u), vv4 = kv4;
        if (kp >= 0) { const size_t row = (size_t)b * SEQ + kp; kv4 = *(const uint4*)(kb + row * 256 + g * 64 + dc * 8); vv4 = *(const uint4*)(vb + row * 256 + g * 64 + dc * 8); }
        *(uint4*)(Ks + kl * 72 + dc * 8) = kv4;
        bf16_t* vd = Vt + (dc * 8) * 264 + kl;
        vd[0 * 264] = (bf16_t)(vv4.x & 0xffffu); vd[1 * 264] = (bf16_t)(vv4.x >> 16);
        vd[2 * 264] = (bf16_t)(vv4.y & 0xffffu); vd[3 * 264] = (bf16_t)(vv4.y >> 16);
        vd[4 * 264] = (bf16_t)(vv4.z & 0xffffu); vd[5 * 264] = (bf16_t)(vv4.z >> 16);
        vd[6 * 264] = (bf16_t)(vv4.w & 0xffffu); vd[7 * 264] = (bf16_t)(vv4.w >> 16);
    }
    __syncthreads();
    const int hq = 4 * g + (wv >> 1), qh = wv & 1, q32 = lane & 31, h = lane >> 5;
    const float sink = p.sinks[l * 16 + hq];
#pragma unroll 1
    for (int s = 0; s < 2; ++s) {
        const int qp = 128 * n + 64 * qh + 32 * s + q32;
        const size_t qrow = (size_t)b * SEQ + qp;
        const int klb0 = 64 * qh + 32 * s;
        bf16x8 qf[4];
#pragma unroll
        for (int ks = 0; ks < 4; ++ks) qf[ks] = *(const bf16x8*)(qb + qrow * 1024 + hq * 64 + ks * 16 + 8 * h);
        f32x16 S[5];
#pragma unroll
        for (int kt = 0; kt < 5; ++kt) {
#pragma unroll
            for (int i = 0; i < 16; ++i) S[kt][i] = 0.f;
#pragma unroll
            for (int ks = 0; ks < 4; ++ks) {
                const bf16x8 a = *(const bf16x8*)(Ks + (klb0 + 32 * kt + q32) * 72 + ks * 16 + 8 * h);
                S[kt] = __builtin_amdgcn_mfma_f32_32x32x16_bf16(a, qf[ks], S[kt], 0, 0, 0);
            }
        }
        float mx = -1e30f;
#pragma unroll
        for (int kt = 0; kt < 5; ++kt)
#pragma unroll
            for (int i = 0; i < 16; ++i) {
                const int m = 8 * (i >> 2) + 4 * h + (i & 3);
                const int kp = 128 * (n - 1) + klb0 + 32 * kt + m;
                const int rel = qp - kp;
                const bool ok = (rel >= 0) && (rel <= 128) && (kp >= 0);
                const float sv = ok ? S[kt][i] : -1e30f;
                S[kt][i] = sv; mx = fmaxf(mx, sv);
            }
        mx = fmaxf(mx, __shfl_xor(mx, 32));
        mx = fmaxf(mx, sink);
        float sum = 0.f;
#pragma unroll
        for (int kt = 0; kt < 5; ++kt)
#pragma unroll
            for (int i = 0; i < 16; ++i) { const float e = __expf(S[kt][i] - mx); S[kt][i] = e; sum += e; }
        sum += __shfl_xor(sum, 32);
        const float inv = 1.f / (sum + __expf(sink - mx));
        f32x16 O[2];
#pragma unroll
        for (int i = 0; i < 16; ++i) { O[0][i] = 0.f; O[1][i] = 0.f; }
#pragma unroll
        for (int kt = 0; kt < 5; ++kt)
#pragma unroll
            for (int sp = 0; sp < 2; ++sp) {
                bf16x8 pf;
#pragma unroll
                for (int j = 0; j < 8; ++j) pf[j] = (short)f2bf(S[kt][8 * sp + j]);
#pragma unroll
                for (int dt = 0; dt < 2; ++dt) {
                    const bf16_t* vp = Vt + (32 * dt + q32) * 264 + klb0 + 32 * kt + 16 * sp + 4 * h;
                    const uint2 lo = *(const uint2*)vp, hi = *(const uint2*)(vp + 8);
                    const uint4 av = make_uint4(lo.x, lo.y, hi.x, hi.y);
                    O[dt] = __builtin_amdgcn_mfma_f32_32x32x16_bf16(__builtin_bit_cast(bf16x8, av), pf, O[dt], 0, 0, 0);
                }
            }
#pragma unroll
        for (int dt = 0; dt < 2; ++dt)
#pragma unroll
            for (int ig = 0; ig < 4; ++ig) {
                const int col = hq * 64 + 32 * dt + 8 * ig + 4 * h;
                const uint2 gg = *(const uint2*)(gt + qrow * DM + col);
                const float o0 = O[dt][4 * ig + 0] * inv * bflo(gg.x), o1 = O[dt][4 * ig + 1] * inv * bfhi(gg.x);
                const float o2 = O[dt][4 * ig + 2] * inv * bflo(gg.y), o3 = O[dt][4 * ig + 3] * inv * bfhi(gg.y);
                *(uint2*)(cc + qrow * DM + col) = make_uint2(pack2(o0, o1), pack2(o2, o3));
            }
    }
    __syncthreads();
}

__device__ void p3_sattn_item(const Params& p, float* lds, int l, int item) {
    const int tid = opq_tid(), wv = tid >> 6, lane = tid & 63;
    float* pl = lds + wv * 128;
    const int w = item * 8 + wv, bd = w >> 4, hq = w & 15, g = hq >> 2;
    const size_t row = (size_t)TP + bd;
    const bf16_t* qb = (const bf16_t*)(p.ws + WS_QB);
    const bf16_t* gt = (const bf16_t*)(p.ws + WS_GT);
    bf16_t* cc = (bf16_t*)(p.ws + WS_HB);
    float q[64];
#pragma unroll
    for (int c = 0; c < 8; ++c) {
        const uint4 u = *(const uint4*)(qb + row * 1024 + hq * 64 + c * 8);
        q[c * 8 + 0] = bflo(u.x); q[c * 8 + 1] = bfhi(u.x); q[c * 8 + 2] = bflo(u.y); q[c * 8 + 3] = bfhi(u.y);
        q[c * 8 + 4] = bflo(u.z); q[c * 8 + 5] = bfhi(u.z); q[c * 8 + 6] = bflo(u.w); q[c * 8 + 7] = bfhi(u.w);
    }
    const size_t cbase = ((size_t)(l * NBS + bd) * 128) * 256 + g * 64;
    const float* ck = p.cache_k + cbase;
    const float* cv = p.cache_v + cbase;
    float* nk = p.out + O_CKS + cbase;
    float* nv = p.out + O_CVS + cbase;
    float s0 = 0.f, s1 = 0.f, s2 = 0.f;
#pragma unroll
    for (int c = 0; c < 16; ++c) {
        const float4 a = ((const float4*)(ck + (size_t)lane * 256))[c];
        const float4 bq = ((const float4*)(ck + (size_t)(lane + 64) * 256))[c];
        const float4 e = ((const float4*)(nk + (size_t)127 * 256))[c];
        s0 += a.x * q[4 * c] + a.y * q[4 * c + 1] + a.z * q[4 * c + 2] + a.w * q[4 * c + 3];
        s1 += bq.x * q[4 * c] + bq.y * q[4 * c + 1] + bq.z * q[4 * c + 2] + bq.w * q[4 * c + 3];
        s2 += e.x * q[4 * c] + e.y * q[4 * c + 1] + e.z * q[4 * c + 2] + e.w * q[4 * c + 3];
    }
    const float sink = p.sinks[l * 16 + hq];
    const float mx = fmaxf(wave_max(fmaxf(s0, s1)), fmaxf(s2, sink));
    const float p0 = __expf(s0 - mx), p1 = __expf(s1 - mx), p2 = __expf(s2 - mx);
    const float sum = wave_sum(p0 + p1) + p2 + __expf(sink - mx);
    pl[lane] = p0; pl[lane + 64] = p1;
    __builtin_amdgcn_fence(__ATOMIC_RELEASE, "wavefront");
    __builtin_amdgcn_wave_barrier();
    __builtin_amdgcn_fence(__ATOMIC_ACQUIRE, "wavefront");
    float o = 0.f;
#pragma unroll 32
    for (int key = 0; key < 128; ++key) o += pl[key] * cv[(size_t)key * 256 + lane];
    o += p2 * nv[(size_t)127 * 256 + lane];
    o /= sum;
    const float gate = bf2f(gt[row * DM + hq * 64 + lane]);
    cc[row * DM + hq * 64 + lane] = f2bf(o * gate);
    {
        float tk[32], tv[32];
#pragma unroll
        for (int i = 0; i < 32; ++i) {
            const int ww = (hq & 3) + 4 * i;
            tk[i] = ck[(size_t)(ww + 1 < 128 ? ww + 1 : 127) * 256 + lane]; tv[i] = cv[(size_t)(ww + 1 < 128 ? ww + 1 : 127) * 256 + lane];
        }
#pragma unroll
        for (int i = 0; i < 32; ++i) {
            const int ww = (hq & 3) + 4 * i;
            if (ww < 127) { nk[(size_t)ww * 256 + lane] = tk[i]; nv[(size_t)ww * 256 + lane] = tv[i]; }
        }
    }
    __builtin_amdgcn_wave_barrier();
}

__device__ __forceinline__ float mix_val(const bf16_t* rw, const float* sshift, const float* mu, int r, int c) {
    const float cur = bf2f(rw[(size_t)r * SHD + c]);
    float prev;
    if (r >= TP) prev = sshift[(size_t)(r - TP) * SHD + c];
    else if ((r & 4095) == 0) prev = 0.f;
    else prev = bf2f(rw[(size_t)(r - 1) * SHD + c]);
    return cur + (prev - cur) * mu[c];
}

__device__ __forceinline__ float4 mix4(const bf16_t* rw, const float* sshift, int r, int c, float4 mu4) {
    const uint2 cu = *(const uint2*)(rw + (size_t)r * SHD + c);
    const float4 cur = make_float4(bflo(cu.x), bfhi(cu.x), bflo(cu.y), bfhi(cu.y));
    float4 prev = make_float4(0.f, 0.f, 0.f, 0.f);
    if (r >= TP) prev = *(const float4*)(sshift + (size_t)(r - TP) * SHD + c);
    else if ((r & 4095) != 0) { const uint2 pu = *(const uint2*)(rw + (size_t)(r - 1) * SHD + c); prev = make_float4(bflo(pu.x), bfhi(pu.x), bflo(pu.y), bfhi(pu.y)); }
    return make_float4(cur.x + (prev.x - cur.x) * mu4.x, cur.y + (prev.y - cur.y) * mu4.y, cur.z + (prev.z - cur.z) * mu4.z, cur.w + (prev.w - cur.w) * mu4.w);
}
__device__ __forceinline__ float decay_of(float x) {
    const float z = -x;
    const float sp = fmaxf(z, 0.f) + __logf(1.f + __expf(-fabsf(z)));
    return __expf(-__expf(-sp - 0.5f));
}

__device__ void p3_prep_tile(const Params& p, unsigned char* lds, int l, int tile) {
    const int tid = opq_tid(), wv = tid >> 6, lane = tid & 63, n = lane & 31, h = lane >> 5;
    bf16_t* TW = (bf16_t*)lds;
    bf16_t* AD = TW + 32 * 72;
    const bf16_t* rw = (const bf16_t*)(p.ws + WS_RW);
    const float* sshift = p.state_shift + (size_t)l * NBS * SHD;
    const float* mu = p.mu_shift + l * SHD;
    bf16_t* RIB = (bf16_t*)(p.ws + WS_RIB);
    float* RIW = (float*)(p.ws + WS_RIW);
    float* coef = (float*)(p.ws + WS_COEF);
    const int r0 = tile * 32;
#pragma unroll
    for (int i = 0; i < 8; ++i) {
        const int idx = tid + 512 * i, tt = idx >> 7, c2 = idx & 127;
        const float m = mix_val(rw, sshift, mu, r0 + tt, 3072 + c2);
        if (c2 < 64) { const float e = __expf(2.f * m); TW[tt * 72 + c2] = f2bf(1.f - 2.f / (e + 1.f)); }
        else AD[tt * 72 + (c2 - 64)] = f2bf(m);
    }
    __syncthreads();
    const int col0 = wv * 128 + 4 * n;
    f32x16 acc[4];
    {
        const float* wp = p.w_decay + (size_t)l * 64 * 1024 + col0;
#pragma unroll
        for (int nt = 0; nt < 4; ++nt)
#pragma unroll
            for (int i = 0; i < 16; ++i) acc[nt][i] = 0.f;
#pragma unroll
        for (int ks = 0; ks < 4; ++ks) {
            const bf16x8 a = *(const bf16x8*)(TW + n * 72 + 16 * ks + 8 * h);
            float4 w4[8];
#pragma unroll
            for (int e = 0; e < 8; ++e) w4[e] = *(const float4*)(wp + (size_t)(16 * ks + 8 * h + e) * 1024);
            bf16x8 b0, b1, b2, b3;
#pragma unroll
            for (int e = 0; e < 8; ++e) { b0[e] = (short)f2bf(w4[e].x); b1[e] = (short)f2bf(w4[e].y); b2[e] = (short)f2bf(w4[e].z); b3[e] = (short)f2bf(w4[e].w); }
            acc[0] = __builtin_amdgcn_mfma_f32_32x32x16_bf16(a, b0, acc[0], 0, 0, 0);
            acc[1] = __builtin_amdgcn_mfma_f32_32x32x16_bf16(a, b1, acc[1], 0, 0, 0);
            acc[2] = __builtin_amdgcn_mfma_f32_32x32x16_bf16(a, b2, acc[2], 0, 0, 0);
            acc[3] = __builtin_amdgcn_mfma_f32_32x32x16_bf16(a, b3, acc[3], 0, 0, 0);
        }
        const float4 w0c = *(const float4*)(p.w0 + l * 1024 + col0);
#pragma unroll
        for (int r = 0; r < 16; ++r) {
            const int row = r0 + 8 * (r >> 2) + 4 * h + (r & 3);
            *(float4*)(RIW + (size_t)row * 1024 + col0) =
                make_float4(decay_of(w0c.x + acc[0][r]), decay_of(w0c.y + acc[1][r]), decay_of(w0c.z + acc[2][r]), decay_of(w0c.w + acc[3][r]));
        }
    }
    {
        const float* wp = p.w_iclr + (size_t)l * 64 * 1024 + col0;
#pragma unroll
        for (int nt = 0; nt < 4; ++nt)
#pragma unroll
            for (int i = 0; i < 16; ++i) acc[nt][i] = 0.f;
#pragma unroll
        for (int ks = 0; ks < 4; ++ks) {
            const bf16x8 a = *(const bf16x8*)(AD + n * 72 + 16 * ks + 8 * h);
            float4 w4[8];
#pragma unroll
            for (int e = 0; e < 8; ++e) w4[e] = *(const float4*)(wp + (size_t)(16 * ks + 8 * h + e) * 1024);
            bf16x8 b0, b1, b2, b3;
#pragma unroll
            for (int e = 0; e < 8; ++e) { b0[e] = (short)f2bf(w4[e].x); b1[e] = (short)f2bf(w4[e].y); b2[e] = (short)f2bf(w4[e].z); b3[e] = (short)f2bf(w4[e].w); }
            acc[0] = __builtin_amdgcn_mfma_f32_32x32x16_bf16(a, b0, acc[0], 0, 0, 0);
            acc[1] = __builtin_amdgcn_mfma_f32_32x32x16_bf16(a, b1, acc[1], 0, 0, 0);
            acc[2] = __builtin_amdgcn_mfma_f32_32x32x16_bf16(a, b2, acc[2], 0, 0, 0);
            acc[3] = __builtin_amdgcn_mfma_f32_32x32x16_bf16(a, b3, acc[3], 0, 0, 0);
        }
    }
    const float4 a0c = *(const float4*)(p.a0 + l * 1024 + col0), kkc = *(const float4*)(p.k_k + l * 1024 + col0), kac = *(const float4*)(p.k_a + l * 1024 + col0), rkc = *(const float4*)(p.r_k + l * 1024 + col0);
    const float4 mur = *(const float4*)(mu + col0), muk = *(const float4*)(mu + 1024 + col0), muv = *(const float4*)(mu + 2048 + col0);
    const int head = 2 * wv + (n >> 4);
#pragma unroll
    for (int r = 0; r < 16; ++r) {
        const int row = r0 + 8 * (r >> 2) + 4 * h + (r & 3);
        const float4 rr = mix4(rw, sshift, row, col0, mur), kr = mix4(rw, sshift, row, 1024 + col0, muk), vr = mix4(rw, sshift, row, 2048 + col0, muv);
        const float ax = 1.f / (1.f + __expf(-(a0c.x + acc[0][r]))), ay = 1.f / (1.f + __expf(-(a0c.y + acc[1][r])));
        const float az = 1.f / (1.f + __expf(-(a0c.z + acc[2][r]))), aw = 1.f / (1.f + __expf(-(a0c.w + acc[3][r])));
        const float k0 = kr.x * kkc.x, k1 = kr.y * kkc.y, k2 = kr.z * kkc.z, k3 = kr.w * kkc.w;
        const float ss = allreduce16(k0 * k0 + k1 * k1 + k2 * k2 + k3 * k3);
        const float inv = 1.f / fmaxf(sqrtf(ss), 1e-12f);
        const float4 kk = make_float4(k0 * inv, k1 * inv, k2 * inv, k3 * inv);
        const float4 ke = make_float4(kr.x * (1.f + (ax - 1.f) * kac.x), kr.y * (1.f + (ay - 1.f) * kac.y), kr.z * (1.f + (az - 1.f) * kac.z), kr.w * (1.f + (aw - 1.f) * kac.w));
        const float cf = allreduce16(rr.x * ke.x * rkc.x + rr.y * ke.y * rkc.y + rr.z * ke.z * rkc.z + rr.w * ke.w * rkc.w);
        if ((n & 15) == 0) coef[(size_t)row * 16 + head] = cf;
        const size_t o = (size_t)row * 1024 + col0;
        *(uint2*)(RIB + o) = make_uint2(pack2(rr.x, rr.y), pack2(rr.z, rr.w));
        *(uint2*)(RIB + NRI + o) = make_uint2(pack2(ke.x, ke.y), pack2(ke.z, ke.w));
        *(uint2*)(RIB + 2 * NRI + o) = make_uint2(pack2(kk.x, kk.y), pack2(kk.z, kk.w));
        *(uint2*)(RIB + 3 * NRI + o) = make_uint2(pack2(kk.x * ax, kk.y * ay), pack2(kk.z * az, kk.w * aw));
        *(uint2*)(RIB + 4 * NRI + o) = make_uint2(pack2(vr.x, vr.y), pack2(vr.z, vr.w));
    }
    __syncthreads();
}

constexpr int REC_BYTES = 14592;
constexpr int PA_WLDS = 16384;
typedef float f32x4v __attribute__((ext_vector_type(4)));

__device__ void pa_chunk(const Params& p, unsigned char* wl, int l, int ct) {
    const int lane = opq_tid() & 63;
    const int hh = ct >> 8, c = ct & 255, b = hh >> 4, h = hh & 15;
    const size_t row0 = (size_t)b * SEQ + 16 * c;
    const int col = h * 64 + lane;
    const bf16_t* RIB = (const bf16_t*)(p.ws + WS_RIB);
    const float* RIW = (const float*)(p.ws + WS_RIW);
    float vv[16];
    float gC;
    bf16_t* S_AB = (bf16_t*)wl; bf16_t* S_BB = S_AB + 16 * 72; bf16_t* S_KB = S_BB + 16 * 72; bf16_t* S_RT = S_KB + 16 * 72;
    {
        float g = 1.f;
#pragma unroll
        for (int t = 0; t < 16; ++t) {
            const size_t idx = (row0 + t) * 1024 + col;
            const float r_ = bf2f(RIB[idx]), k_ = bf2f(RIB[NRI + idx]), kk_ = bf2f(RIB[2 * NRI + idx]), b_ = bf2f(RIB[3 * NRI + idx]);
            vv[t] = bf2f(RIB[4 * NRI + idx]);
            const float w_ = RIW[idx];
            S_AB[t * 72 + lane] = f2bf(-g * kk_);
            g *= w_;
            const float ig = 1.f / g;
            S_BB[t * 72 + lane] = f2bf(b_ * ig); S_KB[t * 72 + lane] = f2bf(k_ * ig); S_RT[t * 72 + lane] = f2bf(g * r_);
        }
        gC = g;
    }
    __builtin_amdgcn_fence(__ATOMIC_RELEASE, "wavefront"); __builtin_amdgcn_wave_barrier(); __builtin_amdgcn_fence(__ATOMIC_ACQUIRE, "wavefront");
    f32x4v Gab = {0.f, 0.f, 0.f, 0.f}, Gak = Gab, Grb = Gab, Grk = Gab;
    {
        const int rr = lane & 15, kg = lane >> 4;
#pragma unroll
        for (int ks = 0; ks < 2; ++ks) {
            const int o = rr * 72 + 32 * ks + 8 * kg;
            const bf16x8 fA = *(const bf16x8*)(S_AB + o), fB = *(const bf16x8*)(S_BB + o), fK = *(const bf16x8*)(S_KB + o), fR = *(const bf16x8*)(S_RT + o);
            Gab = __builtin_amdgcn_mfma_f32_16x16x32_bf16(fB, fA, Gab, 0, 0, 0);
            Gak = __builtin_amdgcn_mfma_f32_16x16x32_bf16(fK, fA, Gak, 0, 0, 0);
            Grb = __builtin_amdgcn_mfma_f32_16x16x32_bf16(fB, fR, Grb, 0, 0, 0);
            Grk = __builtin_amdgcn_mfma_f32_16x16x32_bf16(fK, fR, Grk, 0, 0, 0);
        }
    }
    __builtin_amdgcn_fence(__ATOMIC_RELEASE, "wavefront"); __builtin_amdgcn_wave_barrier(); __builtin_amdgcn_fence(__ATOMIC_ACQUIRE, "wavefront");
    float* M_AB = (float*)(wl + 9216); float* M_AK = M_AB + 256; float* M_RB = M_AK + 256; float* M_RK = M_RB + 256; float* T_ = M_RK + 256; float* Q_ = T_ + 256; float* W2_ = Q_ + 256;
    {
        const int t = lane & 15, kg = lane >> 4;
#pragma unroll
        for (int rg = 0; rg < 4; ++rg) {
            const int s = 4 * kg + rg;
            M_AB[s * 16 + t] = s < t ? Gab[rg] : 0.f; M_AK[s * 16 + t] = s < t ? Gak[rg] : 0.f;
            M_RB[s * 16 + t] = s <= t ? Grb[rg] : 0.f; M_RK[s * 16 + t] = s <= t ? Grk[rg] : 0.f;
        }
    }
    __builtin_amdgcn_fence(__ATOMIC_RELEASE, "wavefront"); __builtin_amdgcn_wave_barrier(); __builtin_amdgcn_fence(__ATOMIC_ACQUIRE, "wavefront");
    {
        const int rr = lane & 15;
        float Tr[16];
#pragma unroll
        for (int t = 0; t < 16; ++t) {
            float acc = (rr == t) ? 1.f : 0.f;
#pragma unroll
            for (int s = 0; s < t; ++s) acc += Tr[s] * M_AB[s * 16 + t];
            Tr[t] = acc;
        }
#pragma unroll
        for (int t = 0; t < 16; ++t) T_[rr * 16 + t] = Tr[t];
    }
    __builtin_amdgcn_fence(__ATOMIC_RELEASE, "wavefront"); __builtin_amdgcn_wave_barrier(); __builtin_amdgcn_fence(__ATOMIC_ACQUIRE, "wavefront");
    {
        const int s = lane & 15, tq = lane >> 4;
        float4 q = make_float4(0.f, 0.f, 0.f, 0.f);
#pragma unroll
        for (int u = 0; u < 16; ++u) { const float a = M_AK[s * 16 + u]; const float4 t4 = *(const float4*)(T_ + u * 16 + 4 * tq); q.x += a * t4.x; q.y += a * t4.y; q.z += a * t4.z; q.w += a * t4.w; }
        *(float4*)(Q_ + s * 16 + 4 * tq) = q;
        __builtin_amdgcn_fence(__ATOMIC_RELEASE, "wavefront"); __builtin_amdgcn_wave_barrier(); __builtin_amdgcn_fence(__ATOMIC_ACQUIRE, "wavefront");
        float4 w2 = *(const float4*)(M_RK + s * 16 + 4 * tq);
#pragma unroll
        for (int u = 0; u < 16; ++u) { const float a = Q_[s * 16 + u]; const float4 m4 = *(const float4*)(M_RB + u * 16 + 4 * tq); w2.x += a * m4.x; w2.y += a * m4.y; w2.z += a * m4.z; w2.w += a * m4.w; }
        *(float4*)(W2_ + s * 16 + 4 * tq) = w2;
    }
    __builtin_amdgcn_fence(__ATOMIC_RELEASE, "wavefront"); __builtin_amdgcn_wave_barrier(); __builtin_amdgcn_fence(__ATOMIC_ACQUIRE, "wavefront");
    float pt[16], r2[16], ul[16], yl[16];
#pragma unroll
    for (int t = 0; t < 16; ++t) { pt[t] = 0.f; r2[t] = bf2f(S_RT[t * 72 + lane]); ul[t] = 0.f; yl[t] = 0.f; }
#pragma unroll
    for (int s = 0; s < 16; ++s) {
        const float as_ = bf2f(S_AB[s * 72 + lane]), vs_ = vv[s];
#pragma unroll
        for (int tq = 0; tq < 4; ++tq) {
            const float4 t4 = *(const float4*)(T_ + s * 16 + 4 * tq), q4 = *(const float4*)(Q_ + s * 16 + 4 * tq), w4 = *(const float4*)(W2_ + s * 16 + 4 * tq);
            pt[4 * tq + 0] += t4.x * as_; pt[4 * tq + 1] += t4.y * as_; pt[4 * tq + 2] += t4.z * as_; pt[4 * tq + 3] += t4.w * as_;
            ul[4 * tq + 0] += q4.x * vs_; ul[4 * tq + 1] += q4.y * vs_; ul[4 * tq + 2] += q4.z * vs_; ul[4 * tq + 3] += q4.w * vs_;
            yl[4 * tq + 0] += w4.x * vs_; yl[4 * tq + 1] += w4.y * vs_; yl[4 * tq + 2] += w4.z * vs_; yl[4 * tq + 3] += w4.w * vs_;
        }
        __builtin_amdgcn_sched_barrier(0);
    }
#pragma unroll
    for (int s = 0; s < 16; ++s) {
#pragma unroll
        for (int tq = 0; tq < 4; ++tq) {
            const float4 m4 = *(const float4*)(M_RB + s * 16 + 4 * tq);
            r2[4 * tq + 0] += m4.x * pt[s]; r2[4 * tq + 1] += m4.y * pt[s]; r2[4 * tq + 2] += m4.z * pt[s]; r2[4 * tq + 3] += m4.w * pt[s];
        }
        __builtin_amdgcn_sched_barrier(0);
    }
    unsigned char* rec = p.ws + WS_REC + (size_t)ct * REC_BYTES;
    float* ys = (float*)(p.ws + WS_RW);
#pragma unroll
    for (int t = 0; t < 16; ++t) {
        *(bf16_t*)(rec + t * 128 + lane * 2) = f2bf(pt[t]);
        *(bf16_t*)(rec + 2048 + t * 128 + lane * 2) = f2bf(r2[t]);
        ys[(row0 + t) * 1024 + col] = yl[t];
    }
    {
        unsigned w[8];
#pragma unroll
        for (int e = 0; e < 8; ++e) w[e] = pack2(gC * bf2f(S_BB[(2 * e) * 72 + lane]), gC * bf2f(S_BB[(2 * e + 1) * 72 + lane]));
        *(uint4*)(rec + 4096 + lane * 32) = make_uint4(w[0], w[1], w[2], w[3]); *(uint4*)(rec + 4096 + lane * 32 + 16) = make_uint4(w[4], w[5], w[6], w[7]);
#pragma unroll
        for (int e = 0; e < 8; ++e) w[e] = pack2(gC * bf2f(S_KB[(2 * e) * 72 + lane]), gC * bf2f(S_KB[(2 * e + 1) * 72 + lane]));
        *(uint4*)(rec + 6144 + lane * 32) = make_uint4(w[0], w[1], w[2], w[3]); *(uint4*)(rec + 6144 + lane * 32 + 16) = make_uint4(w[4], w[5], w[6], w[7]);
        *(float*)(rec + 8192 + lane * 4) = gC;
        unsigned char* ip = rec + 8448 + (lane >> 5) * 3072;
#pragma unroll
        for (int e = 0; e < 8; ++e) w[e] = pack2(vv[2 * e], vv[2 * e + 1]);
        *(uint4*)(ip + (lane & 31) * 32) = make_uint4(w[0], w[1], w[2], w[3]); *(uint4*)(ip + (lane & 31) * 32 + 16) = make_uint4(w[4], w[5], w[6], w[7]);
#pragma unroll
        for (int t = 0; t < 16; ++t) *(float*)(ip + 1024 + t * 128 + (lane & 31) * 4) = ul[t];
    }
    __builtin_amdgcn_fence(__ATOMIC_RELEASE, "wavefront"); __builtin_amdgcn_wave_barrier();
}

__device__ void pa_sample_task(const Params& p, int l, int task) {
    const int lane = opq_tid() & 63;
    const int bd = task >> 8, h = (task >> 4) & 15, wq = task & 15;
    const int irow = 4 * wq + (lane >> 4), jq = lane & 15;
    const size_t row = (size_t)TP + bd;
    const bf16_t* RIB = (const bf16_t*)(p.ws + WS_RIB);
    const float* RIW = (const float*)(p.ws + WS_RIW);
    float* ys = (float*)(p.ws + WS_RW);
    const size_t so = (((size_t)(l * NBS + bd) * 16 + h) * 64 + irow) * 64 + 4 * jq;
    float4 s = *(const float4*)(p.state_wkv + so);
    const size_t o = row * 1024 + h * 64 + 4 * jq;
    const uint2 ur = *(const uint2*)(RIB + o), uk = *(const uint2*)(RIB + NRI + o), ukk = *(const uint2*)(RIB + 2 * NRI + o), ub = *(const uint2*)(RIB + 3 * NRI + o);
    const float4 w4 = *(const float4*)(RIW + o);
    const float v = bf2f(RIB[4 * NRI + row * 1024 + h * 64 + irow]);
    float pa = s.x * bflo(ukk.x) + s.y * bfhi(ukk.x) + s.z * bflo(ukk.y) + s.w * bfhi(ukk.y);
    pa = allreduce16(pa);
    const float sa = -pa;
    s.x = fmaf(sa, bflo(ub.x), fmaf(s.x, w4.x, v * bflo(uk.x)));
    s.y = fmaf(sa, bfhi(ub.x), fmaf(s.y, w4.y, v * bfhi(uk.x)));
    s.z = fmaf(sa, bflo(ub.y), fmaf(s.z, w4.z, v * bflo(uk.y)));
    s.w = fmaf(sa, bfhi(ub.y), fmaf(s.w, w4.w, v * bfhi(uk.y)));
    float py = s.x * bflo(ur.x) + s.y * bfhi(ur.x) + s.z * bflo(ur.y) + s.w * bfhi(ur.y);
    py = allreduce16(py);
    *(float4*)(p.out + O_WKVS + so) = s;
    if (jq == 0) ys[row * 1024 + h * 64 + irow] = py;
}

constexpr int PB_NB = 8, PB_SLOT = 13568, PB_NCH = SEQ / 16;
__device__ void pb_head(const Params& p, unsigned char* lds, int l, int blk) {
    const int tid = opq_tid(), wv = tid >> 6, lane = tid & 63;
    const int hh = blk >> 1, it = blk & 1, b = hh >> 4, h = hh & 15;
    volatile unsigned* flags = (volatile unsigned*)(lds + PB_NB * PB_SLOT);
    if (tid <= PB_NB) flags[tid] = 0u;
    __syncthreads();
    const unsigned char* rec0 = p.ws + WS_REC + (size_t)(hh * 256) * REC_BYTES;
    float* ys = (float*)(p.ws + WS_RW) + ((size_t)b * SEQ) * 1024 + h * 64 + 32 * it;
    if (wv >= 1) {
#pragma unroll 1
        for (int c = wv - 1; c < PB_NCH; c += 7) {
            while (c - (int)flags[PB_NB] >= PB_NB) __builtin_amdgcn_s_sleep(1);
            asm volatile("" ::: "memory");
            const unsigned char* rec = rec0 + (size_t)c * REC_BYTES;
            unsigned char* sl = lds + (c % PB_NB) * PB_SLOT;
            uint4 d[14];
#pragma unroll
            for (int q = 0; q < 8; ++q) d[q] = *(const uint4*)(rec + (q * 64 + lane) * 16);
            d[8] = *(const uint4*)(rec + 8192 + (lane & 15) * 16);
#pragma unroll
            for (int q = 0; q < 3; ++q) d[9 + q] = *(const uint4*)(rec + 8448 + it * 3072 + (q * 64 + lane) * 16);
#pragma unroll
            for (int q = 0; q < 2; ++q) { const int x = q * 64 + lane, t = x >> 3, cc = x & 7; d[12 + q] = *(const uint4*)(ys + (size_t)(16 * c + t) * 1024 + cc * 4); }
#pragma unroll
            for (int q = 0; q < 8; ++q) *(uint4*)(sl + (q * 64 + lane) * 16) = d[q];
            if (lane < 16) *(uint4*)(sl + 8192 + lane * 16) = d[8];
#pragma unroll
            for (int q = 0; q < 3; ++q) *(uint4*)(sl + 8448 + (q * 64 + lane) * 16) = d[9 + q];
#pragma unroll
            for (int q = 0; q < 2; ++q) *(uint4*)(sl + 11520 + (q * 64 + lane) * 16) = d[12 + q];
            asm volatile("s_waitcnt lgkmcnt(0)" ::: "memory");
            if (lane == 0) flags[c % PB_NB] = (unsigned)(c + 1);
        }
    } else {
        const int q32 = lane & 31, hf = lane >> 5;
        f32x16 X0, X1;
#pragma unroll
        for (int i = 0; i < 16; ++i) { X0[i] = 0.f; X1[i] = 0.f; }
#pragma unroll 1
        for (int c = 0; c < PB_NCH; ++c) {
            const unsigned char* sl = lds + (c % PB_NB) * PB_SLOT;
            while (flags[c % PB_NB] != (unsigned)(c + 1)) __builtin_amdgcn_s_sleep(0);
            asm volatile("" ::: "memory");
            bf16x8 xb[4];
#pragma unroll
            for (int e = 0; e < 8; ++e) { xb[0][e] = (short)f2bf(X0[e]); xb[1][e] = (short)f2bf(X0[8 + e]); xb[2][e] = (short)f2bf(X1[e]); xb[3][e] = (short)f2bf(X1[8 + e]); }
            f32x16 Ua, Ub, Ya, Yb;
#pragma unroll
            for (int r = 0; r < 8; ++r) {
                const int t = 8 * (r >> 2) + 4 * hf + (r & 3);
                Ua[r] = *(const float*)(sl + 9472 + t * 128 + q32 * 4); Ya[r] = *(const float*)(sl + 11520 + t * 128 + q32 * 4);
            }
#pragma unroll
            for (int r = 8; r < 16; ++r) { Ua[r] = 0.f; Ya[r] = 0.f; }
#pragma unroll
            for (int r = 0; r < 16; ++r) { Ub[r] = 0.f; Yb[r] = 0.f; }
#pragma unroll
            for (int f = 0; f < 4; ++f) {
                const int jo = 16 * f + 4 * hf;
                const unsigned char* pr = sl + (q32 & 15) * 128 + jo * 2;
                const uint2 p0 = *(const uint2*)pr, p1 = *(const uint2*)(pr + 16);
                const uint2 r0 = *(const uint2*)(pr + 2048), r1 = *(const uint2*)(pr + 2048 + 16);
                const bf16x8 pa = __builtin_bit_cast(bf16x8, make_uint4(p0.x, p0.y, p1.x, p1.y));
                const bf16x8 ra = __builtin_bit_cast(bf16x8, make_uint4(r0.x, r0.y, r1.x, r1.y));
                if (f & 1) { Ub = __builtin_amdgcn_mfma_f32_32x32x16_bf16(pa, xb[f], Ub, 0, 0, 0); Yb = __builtin_amdgcn_mfma_f32_32x32x16_bf16(ra, xb[f], Yb, 0, 0, 0); }
                else { Ua = __builtin_amdgcn_mfma_f32_32x32x16_bf16(pa, xb[f], Ua, 0, 0, 0); Ya = __builtin_amdgcn_mfma_f32_32x32x16_bf16(ra, xb[f], Ya, 0, 0, 0); }
            }
            bf16x8 ub;
#pragma unroll
            for (int e = 0; e < 8; ++e) ub[e] = (short)f2bf(Ua[e] + Ub[e]);
#pragma unroll
            for (int r = 0; r < 8; ++r) {
                const int t = 8 * (r >> 2) + 4 * hf + (r & 3);
                ys[(size_t)(16 * c + t) * 1024 + q32] = Ya[r] + Yb[r];
            }
            const bf16x8 vf = *(const bf16x8*)(sl + 8448 + q32 * 32 + 16 * hf);
#pragma unroll
            for (int jt = 0; jt < 2; ++jt) {
                f32x16 Xn;
#pragma unroll
                for (int g = 0; g < 4; ++g) {
                    const float4 gm = *(const float4*)(sl + 8192 + (32 * jt + 8 * g + 4 * hf) * 4);
                    if (jt == 0) { Xn[4 * g + 0] = X0[4 * g + 0] * gm.x; Xn[4 * g + 1] = X0[4 * g + 1] * gm.y; Xn[4 * g + 2] = X0[4 * g + 2] * gm.z; Xn[4 * g + 3] = X0[4 * g + 3] * gm.w; }
                    else { Xn[4 * g + 0] = X1[4 * g + 0] * gm.x; Xn[4 * g + 1] = X1[4 * g + 1] * gm.y; Xn[4 * g + 2] = X1[4 * g + 2] * gm.z; Xn[4 * g + 3] = X1[4 * g + 3] * gm.w; }
                }
                const int j = 32 * jt + q32;
                const bf16x8 gk = *(const bf16x8*)(sl + 6144 + j * 32 + 16 * hf);
                const uint2 b0 = *(const uint2*)(sl + 4096 + j * 32 + 8 * hf), b1 = *(const uint2*)(sl + 4096 + j * 32 + 16 + 8 * hf);
                const bf16x8 gb = __builtin_bit_cast(bf16x8, make_uint4(b0.x, b0.y, b1.x, b1.y));
                Xn = __builtin_amdgcn_mfma_f32_32x32x16_bf16(gk, vf, Xn, 0, 0, 0);
                Xn = __builtin_amdgcn_mfma_f32_32x32x16_bf16(gb, ub, Xn, 0, 0, 0);
                if (jt == 0) X0 = Xn; else X1 = Xn;
            }
            asm volatile("s_waitcnt lgkmcnt(0)" ::: "memory");
            if (lane == 0) flags[PB_NB] = (unsigned)(c + 1);
        }
        float* so = p.out + O_WKVP + ((size_t)(l * NBP + b) * 16 + h) * 4096 + (size_t)(32 * it + q32) * 64;
#pragma unroll
        for (int g = 0; g < 4; ++g) {
            *(float4*)(so + 8 * g + 4 * hf) = make_float4(X0[4 * g], X0[4 * g + 1], X0[4 * g + 2], X0[4 * g + 3]);
            *(float4*)(so + 32 + 8 * g + 4 * hf) = make_float4(X1[4 * g], X1[4 * g + 1], X1[4 * g + 2], X1[4 * g + 3]);
        }
    }
    __syncthreads();
}

__device__ void p3_post(const Params& p, int l, int bid, int G) {
    const int tid = opq_tid(), wv = tid >> 6, lane = tid & 63;
    const float* ys = (const float*)(p.ws + WS_RW);
    const bf16_t* V = (const bf16_t*)(p.ws + WS_RIB) + 4 * NRI;
    const float* coef = (const float*)(p.ws + WS_COEF);
    const bf16_t* gt = (const bf16_t*)(p.ws + WS_GT);
    bf16_t* cc = (bf16_t*)(p.ws + WS_HB);
    for (int r = bid * 8 + wv; r < MT; r += G * 8) {
#pragma unroll
        for (int hg = 0; hg < 4; ++hg) {
            const int head = 4 * hg + (lane >> 4), c = head * 64 + 4 * (lane & 15);
            const float4 y = *(const float4*)(ys + (size_t)r * 1024 + c);
            const float mu = allreduce16(y.x + y.y + y.z + y.w) * (1.f / 64.f);
            const float d0 = y.x - mu, d1 = y.y - mu, d2 = y.z - mu, d3 = y.w - mu;
            const float var = allreduce16(d0 * d0 + d1 * d1 + d2 * d2 + d3 * d3) * (1.f / 64.f);
            const float rs = rsqrtf(var + 64e-5f);
            const float4 lw = *(const float4*)(p.ln_w + l * 1024 + c), lb = *(const float4*)(p.ln_b + l * 1024 + c);
            const uint2 vu = *(const uint2*)(V + (size_t)r * 1024 + c);
            const float4 v4 = make_float4(bflo(vu.x), bfhi(vu.x), bflo(vu.y), bfhi(vu.y));
            const float cf = coef[(size_t)r * 16 + head];
            const uint2 gg = *(const uint2*)(gt + (size_t)r * DM + 1024 + c);
            const float o0 = (d0 * rs * lw.x + lb.x + cf * v4.x) * bflo(gg.x), o1 = (d1 * rs * lw.y + lb.y + cf * v4.y) * bfhi(gg.x);
            const float o2 = (d2 * rs * lw.z + lb.z + cf * v4.z) * bflo(gg.y), o3 = (d3 * rs * lw.w + lb.w + cf * v4.w) * bfhi(gg.y);
            *(uint2*)(cc + (size_t)r * DM + 1024 + c) = make_uint2(pack2(o0, o1), pack2(o2, o3));
        }
    }
}

__device__ void p_final(const Params& p, int bid, int G) {
    const int tid = opq_tid(), wv = tid >> 6, lane = tid & 63;
    const float4* g4 = (const float4*)p.final_g;
    for (int r = bid * 8 + wv; r < MT; r += G * 8) {
        float4* xr = (float4*)(p.out + (size_t)r * DM);
        float4 v[8]; float ss = 0.f;
#pragma unroll
        for (int i = 0; i < 8; ++i) { v[i] = xr[lane + 64 * i]; ss += v[i].x * v[i].x + v[i].y * v[i].y + v[i].z * v[i].z + v[i].w * v[i].w; }
        ss = wave_sum(ss);
        const float rinv = rsqrtf(ss * (1.f / 2048.f) + 1e-5f);
#pragma unroll
        for (int i = 0; i < 8; ++i) { const float4 g = g4[lane + 64 * i]; xr[lane + 64 * i] = make_float4(v[i].x * rinv * g.x, v[i].y * rinv * g.y, v[i].z * rinv * g.z, v[i].w * rinv * g.w); }
    }
}

#ifndef REPL
#define REPL -1
#endif
#ifndef REPK
#define REPK -100
#endif
__global__ void __launch_bounds__(512, 2) fwd_kernel(Params p_unused) {
    extern __shared__ __attribute__((aligned(16))) unsigned char shm[];
    cg::grid_group grid = cg::this_grid();
    const int bid0 = blockIdx.x, G0 = gridDim.x;
    float* shf = (float*)shm;
    volatile LAS unsigned* xst = (volatile LAS unsigned*)((LAS unsigned char*)shm + 131072);
    if (threadIdx.x == 0) { xst[0] = 0u; xst[1] = 0u; }
    __syncthreads();
    const XcdBarrier xb = xcd_barrier_post((unsigned*)(kparams().ws + WS_BAR), xst);
    if (G0 == 0x7fffffff) grid.sync();

#pragma unroll 1
    for (int ph = 0; ph < 16; ++ph) {
        const int bid = opq_s(bid0), G = opq_s(G0);
        const int l = ph >= 8 ? 1 : 0, k = ph == 0 ? -1 : (ph == 15 ? 7 : (ph - 1) - 7 * l);
#pragma unroll 1
        for (int rep = 0; rep < ((k == kparams().repk && (kparams().repl < 0 || kparams().repl == l)) ? 2 : 1); ++rep) {
        if (k == -1) {
            for (int it = bid; it < 384; it += G) p0_mod_item(kparams(), shf, it / 192, it % 192);
            for (int it = bid; it < 17; it += G) p0_rope_item(kparams(), it);
            p0_conv_all(kparams(), shf, bid, G, 2752, 0);
        } else if (k == 0) {
            p1_norm(kparams(), l, bid, G);
        } else if (k == 1) {
            pg8::StaticOrder S; S.init(MP, INWP, G, bid);
            pg8::Gemm g{(const bf16_t*)(kparams().ws + WS_HB), (const bf16_t*)(kparams().ws + WS_WTIN), MP, INWP, DM};
            Epi1 E{l};
            pg8::gemm_phase<Epi1, pg8::StaticOrder, false>((PG8_LAS unsigned char*)shm, g, S, E, nullptr);
        } else if (k == 2) {
            for (int it = bid; it < 256 + 64 + 257; it += G) {
                if (it < 256) p3_attn_unit(kparams(), shm, l, it);
                else if (it < 320) p3_sattn_item(kparams(), shf, l, it - 256);
                else p3_prep_tile(kparams(), shm, l, it - 320);
            }
        } else if (k == 3) {
            const int wvq = opq_tid() >> 6, gw = bid * 8 + wvq, nw = G * 8;
            for (int ct = gw; ct < 32 * 256; ct += nw) pa_chunk(kparams(), shm + wvq * PA_WLDS, l, ct);
            for (int task = gw; task < NBS * 256; task += nw) pa_sample_task(kparams(), l, task);
        } else if (k == 4) {
            if (bid < 64) pb_head(kparams(), shm, l, bid);
            else if (l == 0) p0_conv_all(kparams(), shf, bid - 64, G - 64, 1728, 1);
        } else if (k == 5) {
            p3_post(kparams(), l, bid, G);
        } else if (k == 6) {
            pg8::StaticOrder S; S.init(TP, DM, G, bid);
            pg8::Gemm g{(const bf16_t*)(kparams().ws + WS_HB), (const bf16_t*)(kparams().ws + WS_WTOUT) + (size_t)l * DM * DM, TP, DM, DM};
            Epi2 E{l};
            pg8::gemm_phase<Epi2, pg8::StaticOrder, false>((PG8_LAS unsigned char*)shm, g, S, E, nullptr);
            for (int nb = bid; nb < 64; nb += G) g2_sample_item(kparams(), shf, l, nb);
        } else {
            p_final(kparams(), bid, G);
        }
        if (ph < 15) xcd_barrier(xb);
        }
    }
}

extern "C" void kernel_launch(void* const* d_in, const int* in_sizes, int n_in, void* d_out, int out_size, void* d_ws, size_t ws_size, hipStream_t stream) {
    static int grid_blocks = 0;
    if (grid_blocks == 0) {
        if (n_in != 25 || (size_t)out_size != O_END || ws_size < WS_END) {
            fprintf(stderr, "kernel_launch: unexpected shapes: n_in %d out_size %d ws_size %zu (need %zu)\n", n_in, out_size, ws_size, (size_t)WS_END);
            grid_blocks = -1; return;
        }
        if (hipFuncSetAttribute((const void*)fwd_kernel, hipFuncAttributeMaxDynamicSharedMemorySize, LDS_BYTES) != hipSuccess) { fprintf(stderr, "kernel_launch: hipFuncSetAttribute failed\n"); grid_blocks = -1; return; }
        int dev = 0, cus = 0, per_cu = 0;
        hipGetDevice(&dev);
        hipDeviceGetAttribute(&cus, hipDeviceAttributeMultiprocessorCount, dev);
        hipOccupancyMaxActiveBlocksPerMultiprocessor(&per_cu, (const void*)fwd_kernel, 512, LDS_BYTES);
        if (per_cu < 1) { fprintf(stderr, "kernel_launch: occupancy query gives %d blocks per CU\n", per_cu); per_cu = 1; }
        (void)hipGetLastError();
        grid_blocks = cus;
        if (grid_blocks < 192) { fprintf(stderr, "kernel_launch: only %d CUs\n", grid_blocks); grid_blocks = -1; return; }
    }
    if (grid_blocks < 0) return;
    if (hipMemsetAsync((unsigned char*)d_ws + WS_BAR, 0, 16384, stream) != hipSuccess) { fprintf(stderr, "kernel_launch: memset of the barrier words failed\n"); return; }
    Params p{};
    const float** pp = (const float**)&p;
    for (int i = 0; i < 25; ++i) pp[i] = (const float*)d_in[i];
    p.out = (float*)d_out; p.ws = (unsigned char*)d_ws; p.repk = REPK; p.repl = REPL;
    void* args[] = {&p};
    hipError_t e = hipLaunchCooperativeKernel((const void*)fwd_kernel, dim3(grid_blocks), dim3(512), args, LDS_BYTES, stream);
    if (e != hipSuccess) fprintf(stderr, "cooperative launch failed: %s (grid %d)\n", hipGetErrorString(e), grid_blocks);
}
```

```cpp
#include <hip/hip_runtime.h>
#include <hip/hip_cooperative_groups.h>
#include <cstdio>
namespace cg = cooperative_groups;
__device__ __forceinline__ int opq_tid() { int t = threadIdx.x; asm volatile("" : "+v"(t)); return t; }
__device__ __forceinline__ int opq_s(int x) { asm volatile("" : "+s"(x)); return x; }
typedef float cvt_f32x2 __attribute__((ext_vector_type(2)));
typedef __bf16 cvt_bf16x2 __attribute__((ext_vector_type(2)));
__device__ __forceinline__ unsigned hw_cvt_pk_bf16(float lo, float hi) { const cvt_f32x2 v = {lo, hi}; return __builtin_bit_cast(unsigned, __builtin_convertvector(v, cvt_bf16x2)); }
namespace pg8 {
#define PG8_LAS __attribute__((address_space(3)))
typedef unsigned short bf16_t;
typedef short bf16x8 __attribute__((ext_vector_type(8)));
typedef float f32x4 __attribute__((ext_vector_type(4)));
typedef unsigned u32x4 __attribute__((ext_vector_type(4)));
constexpr int BM = 256, BK = 64, HALF = 128, HTB = HALF * BK * 2  , STAGE_BYTES = 8 * HTB, NXCD = 8, WGM = 8;

__host__ __device__ __forceinline__ int lds_byte(int r, int c) { const int st = (r >> 4) * 2 + (c >> 5), rr = r & 15, cc = c & 31, ob = rr * 64 + cc * 2; return st * 1024 + (ob ^ (((ob >> 9) & 1) << 5)); }
__host__ __device__ __forceinline__ void stage_rc(int b, int& R, int& C) { const int st = b / 1024, sb = b % 1024, swz = sb ^ (((sb >> 9) & 1) << 5); R = (st >> 1) * 16 + swz / 64; C = (st & 1) * 32 + (swz % 64) / 2; }
__host__ __device__ __forceinline__ int perm32(int rho) { const int n = rho >> 4, i = rho & 15; return 8 * (i >> 2) + 4 * n + (i & 3); }

struct Unit { int pm, pn; };
struct Gemm { const bf16_t* A; const bf16_t* Bt; int M, N, K; };

struct StaticOrder {
    int nM, nN, nwg, G, c;
    __host__ __device__ void init(int M, int N, int G_, int c_) { nM = M / BM; nN = N / BM; nwg = nM * nN; G = G_; c = c_; }
    __host__ __device__ bool next(int i, Unit& u) const {
        const long L = (long)i * G + c; if (L >= nwg) return false;
        int wgid = (int)L; { const int q = nwg / NXCD, r = nwg % NXCD, xcd = wgid % NXCD, off = wgid / NXCD; wgid = (xcd < r ? xcd * (q + 1) : r * (q + 1) + (xcd - r) * q) + off; }
        const int nig = WGM * nN, gid = wgid / nig, fm = gid * WGM, gsz = (nM - fm) < WGM ? (nM - fm) : WGM;
        u.pm = fm + ((wgid % nig) % gsz); u.pn = (wgid % nig) / gsz; return true;
    }
    __device__ __forceinline__ void a_ready(const Unit&) const {}
    __device__ __forceinline__ void done(const Unit&) const {}
};
template <class Epi, class Sched, bool STAMP = false>
__device__ __forceinline__ void gemm_phase(PG8_LAS unsigned char* lds, const Gemm g, const Sched& S, const Epi& E, unsigned long long* stamps) {
    const int tid = opq_tid(), wid = __builtin_amdgcn_readfirstlane(tid >> 6), lane = tid & 63, wr = wid >> 2, wc = wid & 3, fr = lane & 15, fq = lane >> 4;
    const int K = g.K, nt = K / BK;
    int ts_lo = 0, ts_hi = 0, nts = 0; const unsigned long long rt_entry = STAMP ? (unsigned long long)wall_clock64() : 0ull;
#define PG8_STAMP() do { if (STAMP && wid == 0 && nts < 64) { const unsigned long long _c = (unsigned long long)clock64(); \
        ts_lo = (lane == nts) ? (int)(unsigned)_c : ts_lo; ts_hi = (lane == nts) ? (int)(unsigned)(_c >> 32) : ts_hi; ++nts; } } while (0)
    PG8_STAMP();
    unsigned voffA[2], voffB[2];
#pragma unroll
    for (int i = 0; i < 2; ++i) { int R, C; stage_rc(tid * 16 + i * 8192, R, C); const int Rb = Epi::PERM ? ((R & ~31) + perm32(R & 31)) : R;
        voffA[i] = (unsigned)(R * K + C) * 2u; voffB[i] = (unsigned)(Rb * K + C) * 2u; }
    const size_t kstep = (size_t)(BK * 2);
    const size_t hstep = (size_t)HALF * K * 2;
    const size_t tstep = 2 * hstep;
    const unsigned ldsw = (unsigned)wid * 1024u;
    const int aoff = lds_byte(wr * 64 + fr, fq * 8), boff = lds_byte(wc * 32 + fr, fq * 8);
#define PG8_SA(b, h) (((b) * 2 + (h)) * HTB)
#define PG8_SB(b, h) ((4 + (b) * 2 + (h)) * HTB)
#define PG8_STAGE(bufoff, gbase, voff) do { _Pragma("unroll") for (int _i = 0; _i < 2; ++_i) \
        __builtin_amdgcn_global_load_lds((const unsigned*)((const char*)(gbase) + (voff)[_i]), (PG8_LAS unsigned*)(lds + (bufoff) + ldsw + _i * 8192), 16, 0, 0); } while (0)
#define PG8_LDA(dst, b, h) do { _Pragma("unroll") for (int m = 0; m < 4; ++m) _Pragma("unroll") for (int k = 0; k < 2; ++k) dst[m][k] = *(const PG8_LAS bf16x8*)(lds + PG8_SA(b, h) + aoff + m * 2048 + k * 1024); } while (0)
#define PG8_LDB(dst, b, h) do { _Pragma("unroll") for (int n = 0; n < 2; ++n) _Pragma("unroll") for (int k = 0; k < 2; ++k) dst[n][k] = *(const PG8_LAS bf16x8*)(lds + PG8_SB(b, h) + boff + n * 2048 + k * 1024); } while (0)
#define PG8_MMA(ai, bj, At, Bt) do { __builtin_amdgcn_s_setprio(1); _Pragma("unroll") for (int m = 0; m < 4; ++m) _Pragma("unroll") for (int n = 0; n < 2; ++n) _Pragma("unroll") for (int k = 0; k < 2; ++k) \
        acc[ai][bj][m][n] = __builtin_amdgcn_mfma_f32_16x16x32_bf16(Bt[n][k], At[m][k], acc[ai][bj][m][n], 0, 0, 0); __builtin_amdgcn_s_setprio(0); } while (0)
#define PG8_WAIT_V(n) asm volatile("s_waitcnt vmcnt(" #n ")" ::: "memory")
#define PG8_WAIT_L(n) asm volatile("s_waitcnt lgkmcnt(" #n ")" ::: "memory")
#define PG8_BAR __builtin_amdgcn_s_barrier()
#define PG8_SCHED __builtin_amdgcn_sched_barrier(0)
    Unit cur, nxt; int ui = 0;
    if (!S.next(0, cur)) return;
    f32x4 acc[2][2][4][2];
#pragma unroll
    for (int a = 0; a < 2; ++a)
#pragma unroll
        for (int b = 0; b < 2; ++b)
#pragma unroll
            for (int m = 0; m < 4; ++m)
#pragma unroll
                for (int n = 0; n < 2; ++n) acc[a][b][m][n] = (f32x4){0.f, 0.f, 0.f, 0.f};
    bf16x8 At[4][2], B0[2][2], B1[2][2];
    const char* cA = (const char*)g.A + (size_t)cur.pm * tstep; const char* cB = (const char*)g.Bt + (size_t)cur.pn * tstep;
    S.a_ready(cur);
    PG8_STAGE(PG8_SB(0, 0), cB, voffB); PG8_STAGE(PG8_SA(0, 0), cA, voffA); PG8_STAGE(PG8_SB(0, 1), cB + hstep, voffB); PG8_STAGE(PG8_SA(0, 1), cA + hstep, voffA);
    if (wr == 1) PG8_BAR;
    PG8_WAIT_V(4); PG8_BAR;
    PG8_STAGE(PG8_SB(1, 0), cB + kstep, voffB); PG8_STAGE(PG8_SA(1, 0), cA + kstep, voffA); PG8_STAGE(PG8_SB(1, 1), cB + hstep + kstep, voffB);
    PG8_WAIT_V(6); PG8_BAR;
    PG8_STAMP();
    for (;;) {
        const bool has_next = S.next(ui + 1, nxt);
        const char* nA = has_next ? (const char*)g.A + (size_t)nxt.pm * tstep : cA; const char* nB = has_next ? (const char*)g.Bt + (size_t)nxt.pn * tstep : cB;
        for (int t = 0; t < nt; t += 2) {
            const bool last = (t == nt - 2);
            const char* a1 = cA + (size_t)(t + 1) * kstep;
            const char* a2 = last ? nA : cA + (size_t)(t + 2) * kstep; const char* b2 = last ? nB : cB + (size_t)(t + 2) * kstep;
            const char* a3 = a2 + kstep; const char* b3 = b2 + kstep;
            if (last && has_next) S.a_ready(nxt);
            PG8_LDB(B0, 0, 0); PG8_SCHED; PG8_LDA(At, 0, 0); PG8_STAGE(PG8_SA(1, 1), a1 + hstep, voffA);
            PG8_WAIT_L(8); PG8_BAR; PG8_WAIT_L(0); PG8_MMA(0, 0, At, B0); PG8_BAR; PG8_SCHED;
            PG8_LDB(B1, 0, 1); PG8_STAGE(PG8_SB(0, 0), b2, voffB);
            PG8_BAR; PG8_WAIT_L(0); PG8_MMA(0, 1, At, B1); PG8_BAR;
            PG8_LDA(At, 0, 1); PG8_STAGE(PG8_SA(0, 0), a2, voffA);
            PG8_BAR; PG8_WAIT_L(0); PG8_MMA(1, 0, At, B0); PG8_BAR; PG8_SCHED;
            PG8_STAGE(PG8_SB(0, 1), b2 + hstep, voffB);
            PG8_WAIT_V(6); PG8_BAR; PG8_MMA(1, 1, At, B1); PG8_BAR;
            PG8_LDB(B0, 1, 0); PG8_SCHED; PG8_LDA(At, 1, 0); PG8_STAGE(PG8_SA(0, 1), a2 + hstep, voffA);
            PG8_WAIT_L(8); PG8_BAR; PG8_WAIT_L(0); PG8_MMA(0, 0, At, B0); PG8_BAR; PG8_SCHED;
            PG8_LDB(B1, 1, 1); PG8_STAGE(PG8_SB(1, 0), b3, voffB);
            PG8_BAR; PG8_WAIT_L(0); PG8_MMA(0, 1, At, B1); PG8_BAR;
            PG8_LDA(At, 1, 1); PG8_STAGE(PG8_SA(1, 0), a3, voffA);
            PG8_BAR; PG8_WAIT_L(0); PG8_MMA(1, 0, At, B0); PG8_BAR; PG8_SCHED;
            PG8_STAGE(PG8_SB(1, 1), b3 + hstep, voffB);
            PG8_WAIT_V(6); PG8_BAR; PG8_MMA(1, 1, At, B1); PG8_BAR;
        }
        PG8_STAMP();
        if constexpr (!Epi::AFTER_DRAIN) { E(acc, cur, wr, wc, fr, fq); S.done(cur); }
        PG8_STAMP();
        if (!has_next) break;
#pragma unroll
        for (int a = 0; a < 2; ++a)
#pragma unroll
            for (int b = 0; b < 2; ++b)
#pragma unroll
                for (int m = 0; m < 4; ++m)
#pragma unroll
                    for (int n = 0; n < 2; ++n) acc[a][b][m][n] = (f32x4){0.f, 0.f, 0.f, 0.f};
        cur = nxt; cA = nA; cB = nB; ++ui;
    }
    PG8_WAIT_V(0);
    if (wr == 0) PG8_BAR;
    PG8_BAR;
    if constexpr (Epi::AFTER_DRAIN) { E.fused(acc, cur, wr, wc, fr, fq, lds, wid, lane); S.done(cur); }
    PG8_STAMP();
    if (STAMP && wid == 0) { stamps[lane] = lane < nts ? (((unsigned long long)(unsigned)ts_hi << 32) | (unsigned)ts_lo) : 0ull;
        if (lane == 62) stamps[62] = rt_entry; if (lane == 63) stamps[63] = (unsigned long long)wall_clock64(); }
#undef PG8_STAMP
#undef PG8_SA
#undef PG8_SB
#undef PG8_STAGE
#undef PG8_LDA
#undef PG8_LDB
#undef PG8_MMA
#undef PG8_WAIT_V
#undef PG8_WAIT_L
#undef PG8_BAR
#undef PG8_SCHED
}
}

#define XB_TMO      128
#define XB_XCNT(j)  (256  + 64 * (j))
#define XB_XSUB(j)  (1280 + 64 * (j))
#define XB_XGEN(j)  (2304 + 64 * (j))
#define XB_TOP      3328
#define XB_TOPGEN   3392
#define XCD_BAR_WORDS 3456
#define XB_SPIN_CAP (1u << 18)
#define LAS __attribute__((address_space(3)))

__device__ __forceinline__ unsigned xb_ld(unsigned* p)              { return __hip_atomic_load(p, __ATOMIC_RELAXED, __HIP_MEMORY_SCOPE_AGENT); }
__device__ __forceinline__ unsigned xb_add(unsigned* p, unsigned v) { return __hip_atomic_fetch_add(p, v, __ATOMIC_RELAXED, __HIP_MEMORY_SCOPE_AGENT); }
__device__ __forceinline__ unsigned xb_xcc_id() { return (unsigned)__builtin_amdgcn_s_getreg((3 << 11) | 20) & 0xFu; }
#define XB_SPIN(cond, bar) do { unsigned _sp = 0; while (cond) { __builtin_amdgcn_s_sleep(1); \
    if ((++_sp & 255u) == 0u) { if (xb_ld(&(bar)[XB_TMO])) break; if (_sp > XB_SPIN_CAP) { atomicAdd(&(bar)[XB_TMO], 1u); break; } } } } while (0)

struct XcdBarrier {
    unsigned* bar; unsigned x;
    volatile LAS unsigned* st;
};

__device__ __forceinline__ XcdBarrier xcd_barrier_post(unsigned* bar, volatile LAS unsigned* st) {
    XcdBarrier b; b.bar = bar; b.x = xb_xcc_id(); b.st = st;
    if (threadIdx.x == 0) (void)xb_add(&bar[XB_XCNT(b.x)], 1u);
    return b;
}
__device__ __forceinline__ void xcd_barrier_complete(unsigned* bar, unsigned x, unsigned& nloc, unsigned& nx) {
    const unsigned G = gridDim.x * gridDim.y * gridDim.z;
    unsigned sum, cnt, mine, sp = 0u;
    for (;;) {
        sum = 0u; cnt = 0u; mine = 0u;
#pragma unroll
        for (unsigned j = 0; j < 16; ++j) { const unsigned c = xb_ld(&bar[XB_XCNT(j)]); sum += c; cnt += (c > 0u) ? 1u : 0u; mine = (j == x) ? c : mine; }
        if (sum == G) break;
        __builtin_amdgcn_s_sleep(1);
        if ((++sp & 255u) == 0u) { if (xb_ld(&bar[XB_TMO])) break; if (sp > XB_SPIN_CAP) { atomicAdd(&bar[XB_TMO], 1u); break; } }
    }
    nloc = mine > 0u ? mine : 1u; nx = cnt > 0u ? cnt : 1u;
}

__device__ __forceinline__ void xcd_barrier(const XcdBarrier& b) {
    asm volatile("s_waitcnt vmcnt(0)" ::: "memory");
    __syncthreads();
    if (threadIdx.x == 0) {
        unsigned* bar = b.bar;
        __builtin_amdgcn_s_waitcnt(0);
        unsigned nloc = b.st[0], nx = b.st[1];
        if (nloc == 0u) { xcd_barrier_complete(bar, b.x, nloc, nx); b.st[0] = nloc; b.st[1] = nx; }
        const unsigned old = xb_add(&bar[XB_XSUB(b.x)], 1u);
        const unsigned gen = old / nloc;
        if (old + 1u == (gen + 1u) * nloc) {
            __builtin_amdgcn_fence(__ATOMIC_RELEASE, "agent");
            asm volatile("s_waitcnt vmcnt(0)" ::: "memory");
            const unsigned og = xb_add(&bar[XB_TOP], 1u);
            const unsigned tg = og / nx;
            if (og + 1u == (tg + 1u) * nx) xb_add(&bar[XB_TOPGEN], 1u);
            else XB_SPIN(xb_ld(&bar[XB_TOPGEN]) == tg, bar);
            __builtin_amdgcn_fence(__ATOMIC_ACQUIRE, "agent");
            xb_add(&bar[XB_XGEN(b.x)], 1u);
            asm volatile("s_waitcnt vmcnt(0)" ::: "memory");
        } else {
            XB_SPIN(xb_ld(&bar[XB_XGEN(b.x)]) == gen, bar);
            __builtin_amdgcn_fence(__ATOMIC_ACQUIRE, "agent");
            asm volatile("s_waitcnt vmcnt(0)" ::: "memory");
        }
    }
    __syncthreads();
}

typedef unsigned short bf16_t;
typedef short bf16x8 __attribute__((ext_vector_type(8)));
typedef float f32x4 __attribute__((ext_vector_type(4)));
typedef float f32x16 __attribute__((ext_vector_type(16)));

constexpr int DM = 2048, SEQ = 4096, NBP = 2, NBS = 32, TP = NBP * SEQ, MT = TP + NBS, MP = 8448;
constexpr int INW = 6784, INWP = 6912, SHD = 3200, DEPTH = 2;
constexpr size_t NRI = (size_t)MT * 1024;
constexpr int LDS_BYTES = 131072 + 16;
constexpr size_t O_CKP = (size_t)MT * DM;
constexpr size_t O_CVP = O_CKP + (size_t)DEPTH * NBP * 128 * 256;
constexpr size_t O_WKVP = O_CVP + (size_t)DEPTH * NBP * 128 * 256;
constexpr size_t O_SHP = O_WKVP + (size_t)DEPTH * NBP * 16 * 4096;
constexpr size_t O_CKS = O_SHP + (size_t)DEPTH * NBP * SHD;
constexpr size_t O_CVS = O_CKS + (size_t)DEPTH * NBS * 128 * 256;
constexpr size_t O_WKVS = O_CVS + (size_t)DEPTH * NBS * 128 * 256;
constexpr size_t O_SHS = O_WKVS + (size_t)DEPTH * NBS * 16 * 4096;
constexpr size_t O_END = O_SHS + (size_t)DEPTH * NBS * SHD;
constexpr size_t al256(size_t x) { return (x + 255) & ~(size_t)255; }
constexpr size_t WS_WTIN = 0;
constexpr size_t WS_WTOUT = WS_WTIN + (size_t)INWP * DM * 2;
constexpr size_t WS_MOD = WS_WTOUT + (size_t)DEPTH * DM * DM * 2;
constexpr size_t WS_ROPE = WS_MOD + al256((size_t)DEPTH * 34 * 6144 * 4);
constexpr size_t WS_HB = WS_ROPE + al256((size_t)4097 * 16 * 4);
constexpr size_t WS_QB = WS_HB + (size_t)MP * DM * 2;
constexpr size_t WS_KB = WS_QB + (size_t)MP * 1024 * 2;
constexpr size_t WS_VB = WS_KB + (size_t)MP * 256 * 2;
constexpr size_t WS_RW = WS_VB + (size_t)MP * 256 * 2;
constexpr size_t WS_GT = WS_RW + (size_t)MP * SHD * 2;
constexpr size_t WS_RIB = WS_GT + (size_t)MP * DM * 2;
constexpr size_t WS_RIW = WS_RIB + 5 * NRI * 2;
constexpr size_t WS_REC = WS_RIW + NRI * 4;
constexpr size_t WS_COEF = WS_REC + (size_t)32 * 256 * 14592;
constexpr size_t WS_BAR = WS_COEF + al256((size_t)MT * 16 * 4);
constexpr size_t WS_END = WS_BAR + 16384;

struct Params {
    const float *x_prompt, *x_sample, *cache_k, *cache_v, *state_wkv, *state_shift, *c_prompt, *c_sample, *norm_g, *w_ada, *b_ada, *w_in, *mu_shift, *w0, *w_decay, *a0,
        *w_iclr, *k_k, *k_a, *r_k, *ln_w, *ln_b, *sinks, *w_out, *final_g;
    float* out;
    unsigned char* ws;
    int repk, repl;
};
typedef const __attribute__((address_space(4))) Params* KParamsPtr;
__device__ __forceinline__ const Params& kparams() {
    KParamsPtr k = (KParamsPtr)__builtin_amdgcn_kernarg_segment_ptr();
    asm volatile("" : "+s"(k));
    return *(const Params*)k;
}

__device__ __forceinline__ unsigned short f2bf(float f) { return (unsigned short)(hw_cvt_pk_bf16(f, 0.f) & 0xffffu); }
__device__ __forceinline__ float bf2f(unsigned short b) { return __uint_as_float(((unsigned)b) << 16); }
__device__ __forceinline__ unsigned pack2(float lo, float hi) { return hw_cvt_pk_bf16(lo, hi); }
__device__ __forceinline__ float bflo(unsigned w) { return __uint_as_float(w << 16); }
__device__ __forceinline__ float bfhi(unsigned w) { return __uint_as_float(w & 0xffff0000u); }
__device__ __forceinline__ float silu_f(float x) { return x / (1.f + __expf(-x)); }
__device__ __forceinline__ float wave_sum(float x) {
#pragma unroll
    for (int o = 32; o >= 1; o >>= 1) x += __shfl_xor(x, o);
    return x;
}
__device__ __forceinline__ float wave_max(float x) {
#pragma unroll
    for (int o = 32; o >= 1; o >>= 1) x = fmaxf(x, __shfl_xor(x, o));
    return x;
}
template <int CTRL> __device__ __forceinline__ float dpp_f(float x) {
    return __builtin_bit_cast(float, __builtin_amdgcn_update_dpp(0, __builtin_bit_cast(int, x), CTRL, 0xF, 0xF, false));
}
__device__ __forceinline__ float allreduce16(float x) {
    x += dpp_f<0x128>(x);
    x += dpp_f<0x124>(x);
    x += dpp_f<0x122>(x);
    x += dpp_f<0x121>(x);
    return x;
}

__device__ void p0_mod_item(const Params& p, float* red, int l, int nc) {
    const int tid = opq_tid(), wv = tid >> 6, lane = tid & 63, n = lane & 31, kh = lane >> 5;
    f32x16 acc0, acc1;
#pragma unroll
    for (int i = 0; i < 16; ++i) { acc0[i] = 0.f; acc1[i] = 0.f; }
    const float* W = p.w_ada + (size_t)l * DM * 6144 + nc * 32 + n;
#pragma unroll 4
    for (int ks = 0; ks < 16; ++ks) {
        const int k0 = wv * 256 + ks * 16 + kh * 8;
        bf16x8 bfr, a0, a1;
#pragma unroll
        for (int j = 0; j < 8; ++j) bfr[j] = (short)f2bf(W[(size_t)(k0 + j) * 6144]);
        const float4* cs = (const float4*)(p.c_sample + (size_t)n * DM + k0);
        const float4 u0 = cs[0], u1 = cs[1];
        a0[0] = (short)f2bf(silu_f(u0.x)); a0[1] = (short)f2bf(silu_f(u0.y)); a0[2] = (short)f2bf(silu_f(u0.z)); a0[3] = (short)f2bf(silu_f(u0.w));
        a0[4] = (short)f2bf(silu_f(u1.x)); a0[5] = (short)f2bf(silu_f(u1.y)); a0[6] = (short)f2bf(silu_f(u1.z)); a0[7] = (short)f2bf(silu_f(u1.w));
        float4 q0 = make_float4(0.f, 0.f, 0.f, 0.f), q1 = q0;
        if (n < 2) { const float4* cp = (const float4*)(p.c_prompt + (size_t)n * DM + k0); q0 = cp[0]; q1 = cp[1]; }
        a1[0] = (short)f2bf(silu_f(q0.x)); a1[1] = (short)f2bf(silu_f(q0.y)); a1[2] = (short)f2bf(silu_f(q0.z)); a1[3] = (short)f2bf(silu_f(q0.w));
        a1[4] = (short)f2bf(silu_f(q1.x)); a1[5] = (short)f2bf(silu_f(q1.y)); a1[6] = (short)f2bf(silu_f(q1.z)); a1[7] = (short)f2bf(silu_f(q1.w));
        acc0 = __builtin_amdgcn_mfma_f32_32x32x16_bf16(a0, bfr, acc0, 0, 0, 0);
        acc1 = __builtin_amdgcn_mfma_f32_32x32x16_bf16(a1, bfr, acc1, 0, 0, 0);
    }
#pragma unroll
    for (int i = 0; i < 16; ++i) red[(wv * 18 + i) * 64 + lane] = acc0[i];
    red[(wv * 18 + 16) * 64 + lane] = acc1[0];
    red[(wv * 18 + 17) * 64 + lane] = acc1[1];
    __syncthreads();
    float* mod = (float*)(p.ws + WS_MOD);
    for (int o = tid; o < 34 * 32; o += 512) {
        const int row = o >> 5, col = o & 31;
        int ri, ln, mrow;
        if (row < 32) { const int khh = (row >> 2) & 1; ri = (row & 3) + 4 * (row >> 3); ln = col + 32 * khh; mrow = 2 + row; }
        else { ri = 16 + (row - 32); ln = col; mrow = row - 32; }
        float s = 0.f;
#pragma unroll
        for (int w = 0; w < 8; ++w) s += red[(w * 18 + ri) * 64 + ln];
        mod[((size_t)l * 34 + mrow) * 6144 + nc * 32 + col] = s + p.b_ada[l * 6144 + nc * 32 + col];
    }
    __syncthreads();
}

struct ConvIt { const float* src; bf16_t* dst; int N, k0, n0; };
__device__ __forceinline__ ConvIt conv_decode(const Params& p, int cidx, int lw) {
    ConvIt c;
    int kt, nt;
    if (cidx < 1728) { kt = cidx & 15; nt = cidx >> 4; c.N = INW; c.src = p.w_in + (size_t)lw * DM * INW; c.dst = (bf16_t*)(p.ws + WS_WTIN); }
    else { int rem = cidx - 1728; const int l2 = rem >> 9; rem &= 511; kt = rem & 15; nt = rem >> 4; c.N = DM; c.src = p.w_out + (size_t)l2 * DM * DM; c.dst = (bf16_t*)(p.ws + WS_WTOUT) + (size_t)l2 * DM * DM; }
    c.k0 = kt * 128; c.n0 = nt * 64;
    return c;
}
__device__ void p0_conv_all(const Params& p, float* s, int bid, int G, int total, int lw) {
    const int tid = opq_tid();
    const int lrow = tid >> 4, c4 = tid & 15, n = tid >> 3, kg = tid & 7;
    float4 v[4];
    int cidx = bid;
    ConvIt cur = conv_decode(p, cidx < total ? cidx : 0, lw);
    if (cidx < total) {
#pragma unroll
        for (int p4 = 0; p4 < 4; ++p4) { v[p4] = make_float4(0.f, 0.f, 0.f, 0.f); if (cur.n0 < cur.N) v[p4] = *(const float4*)(cur.src + (size_t)(cur.k0 + lrow + 32 * p4) * cur.N + cur.n0 + 4 * c4); }
    }
#pragma unroll 1
    while (cidx < total) {
#pragma unroll
        for (int p4 = 0; p4 < 4; ++p4) { float* d = s + (lrow + 32 * p4) * 65 + 4 * c4; d[0] = v[p4].x; d[1] = v[p4].y; d[2] = v[p4].z; d[3] = v[p4].w; }
        __syncthreads();
        const int nxt = cidx + G;
        const ConvIt nx = conv_decode(p, nxt < total ? nxt : 0, lw);
        if (nxt < total) {
#pragma unroll
            for (int p4 = 0; p4 < 4; ++p4) { v[p4] = make_float4(0.f, 0.f, 0.f, 0.f); if (nx.n0 < nx.N) v[p4] = *(const float4*)(nx.src + (size_t)(nx.k0 + lrow + 32 * p4) * nx.N + nx.n0 + 4 * c4); }
        }
        unsigned w[8];
#pragma unroll
        for (int j = 0; j < 8; ++j) w[j] = pack2(s[(kg * 16 + 2 * j) * 65 + n], s[(kg * 16 + 2 * j + 1) * 65 + n]);
        uint4* o = (uint4*)(cur.dst + (size_t)(cur.n0 + n) * DM + cur.k0 + kg * 16);
        o[0] = make_uint4(w[0], w[1], w[2], w[3]);
        o[1] = make_uint4(w[4], w[5], w[6], w[7]);
        __syncthreads();
        cur = nx; cidx = nxt;
    }
}

__device__ void p0_rope_item(const Params& p, int it) {
    float* rope = (float*)(p.ws + WS_ROPE);
#pragma unroll
    for (int q = 0; q < 4; ++q) {
        const int e = it * 2048 + q * 512 + opq_tid();
        if (e < 4097 * 8) {
            const int idx = e >> 3, i = e & 7;
            double invf = 1.0;
            for (int q = 0; q < i; ++q) invf *= 0.19392274474868576;
            const double pos = idx < 4096 ? (double)idx : 16384.0;
            const double rev = pos * invf * 0.15915494309189535;
            const float f = (float)(rev - floor(rev));
            rope[idx * 16 + i] = __builtin_amdgcn_cosf(f);
            rope[idx * 16 + 8 + i] = __builtin_amdgcn_sinf(f);
        }
    }
}

__device__ void p1_norm(const Params& p, int l, int bid, int G) {
    const int tid = opq_tid(), wv = tid >> 6, lane = tid & 63;
    bf16_t* hb = (bf16_t*)(p.ws + WS_HB);
    const float* mod = (const float*)(p.ws + WS_MOD);
    const float4* g4 = (const float4*)(p.norm_g + l * DM);
    for (int r = bid * 8 + wv; r < MT; r += G * 8) {
        const float* xr = l == 0 ? (r < TP ? p.x_prompt + (size_t)r * DM : p.x_sample + (size_t)(r - TP) * DM) : p.out + (size_t)r * DM;
        const int mrow = r < TP ? (r >> 12) : 2 + (r - TP);
        const float* md = mod + ((size_t)l * 34 + mrow) * 6144;
        float4 v[8]; float ss = 0.f;
#pragma unroll
        for (int i = 0; i < 8; ++i) { v[i] = ((const float4*)xr)[lane + 64 * i]; ss += v[i].x * v[i].x + v[i].y * v[i].y + v[i].z * v[i].z + v[i].w * v[i].w; }
        ss = wave_sum(ss);
        const float rinv = rsqrtf(ss * (1.f / 2048.f) + 1e-5f);
#pragma unroll
        for (int i = 0; i < 8; ++i) {
            const int c4 = lane + 64 * i;
            const float4 g = g4[c4], sc = ((const float4*)(md + 2048))[c4], sh = ((const float4*)md)[c4];
            const float y0 = v[i].x * rinv * g.x * (1.f + sc.x) + sh.x, y1 = v[i].y * rinv * g.y * (1.f + sc.y) + sh.y;
            const float y2 = v[i].z * rinv * g.z * (1.f + sc.z) + sh.z, y3 = v[i].w * rinv * g.w * (1.f + sc.w) + sh.w;
            *(uint2*)(hb + (size_t)r * DM + 4 * c4) = make_uint2(pack2(y0, y1), pack2(y2, y3));
        }
    }
}

struct Epi1 {
    static constexpr bool PERM = false, AFTER_DRAIN = false;
    int l;
    __device__ __forceinline__ void operator()(const f32x4 (&acc)[2][2][4][2], const pg8::Unit& u, int wr, int wc, int fr, int fq) const {
        const Params& p = kparams();
        bf16_t* const qb = (bf16_t*)(p.ws + WS_QB); bf16_t* const kb = (bf16_t*)(p.ws + WS_KB); bf16_t* const vb = (bf16_t*)(p.ws + WS_VB);
        bf16_t* const rw = (bf16_t*)(p.ws + WS_RW); bf16_t* const gt = (bf16_t*)(p.ws + WS_GT); const float* const rope = (const float*)(p.ws + WS_ROPE); float* const out = p.out;
#pragma unroll
        for (int bj = 0; bj < 2; ++bj)
#pragma unroll
            for (int n = 0; n < 2; ++n) {
                const int cb = u.pn * 256 + bj * 128 + wc * 32 + n * 16;
                if (cb >= INW) continue;
                const int c = cb + 4 * fq;
                const bool do_rope = (cb < 1280) && ((cb & 63) == 0);
#pragma unroll
                for (int ai = 0; ai < 2; ++ai)
#pragma unroll
                    for (int m = 0; m < 4; ++m) {
                        const int rb = u.pm * 256 + ai * 128 + wr * 64 + m * 16;
                        if (rb >= MT) continue;
                        const int r = rb + fr;
                        f32x4 v = acc[ai][bj][m][n];
                        if (do_rope) {
                            const int idx = r < TP ? (r & 4095) : 4096;
                            const float4 cs = *(const float4*)(rope + idx * 16 + 4 * (fq & 1));
                            const float4 sn = *(const float4*)(rope + idx * 16 + 8 + 4 * (fq & 1));
                            const float p0 = __shfl_xor(v[0], 32), p1 = __shfl_xor(v[1], 32), p2 = __shfl_xor(v[2], 32), p3 = __shfl_xor(v[3], 32);
                            const float sg = fq < 2 ? -1.f : 1.f;
                            v[0] = v[0] * cs.x + sg * p0 * sn.x; v[1] = v[1] * cs.y + sg * p1 * sn.y; v[2] = v[2] * cs.z + sg * p2 * sn.z; v[3] = v[3] * cs.w + sg * p3 * sn.w;
                        }
                        if (cb < 1024) {
                            *(uint2*)(qb + (size_t)r * 1024 + c) = make_uint2(pack2(v[0] * 0.125f, v[1] * 0.125f), pack2(v[2] * 0.125f, v[3] * 0.125f));
                        } else if (cb < 1536) {
                            const bool isk = cb < 1280;
                            const int cc = c - (isk ? 1024 : 1280);
                            *(uint2*)((isk ? kb : vb) + (size_t)r * 256 + cc) = make_uint2(pack2(v[0], v[1]), pack2(v[2], v[3]));
                            if (r >= TP) {
                                *(f32x4*)(out + (isk ? O_CKS : O_CVS) + ((size_t)(l * NBS + (r - TP)) * 128 + 127) * 256 + cc) = v;
                            } else if ((r & 4095) >= SEQ - 128) {
                                *(f32x4*)(out + (isk ? O_CKP : O_CVP) + ((size_t)(l * NBP + (r >> 12)) * 128 + ((r & 4095) - (SEQ - 128))) * 256 + cc) = v;
                            }
                        } else if (cb < 4736) {
                            const int cc = c - 1536;
                            *(uint2*)(rw + (size_t)r * SHD + cc) = make_uint2(pack2(v[0], v[1]), pack2(v[2], v[3]));
                            if (r >= TP) *(f32x4*)(out + O_SHS + (size_t)(l * NBS + (r - TP)) * SHD + cc) = v;
                            else if ((r & 4095) == SEQ - 1) *(f32x4*)(out + O_SHP + (size_t)(l * NBP + (r >> 12)) * SHD + cc) = v;
                        } else {
                            const int cc = c - 4736;
                            *(uint2*)(gt + (size_t)r * DM + cc) = make_uint2(pack2(silu_f(v[0]), silu_f(v[1])), pack2(silu_f(v[2]), silu_f(v[3])));
                        }
                    }
            }
    }
};

struct Epi2 {
    static constexpr bool PERM = false, AFTER_DRAIN = false;
    int l;
    __device__ __forceinline__ void operator()(const f32x4 (&acc)[2][2][4][2], const pg8::Unit& u, int wr, int wc, int fr, int fq) const {
        const Params& p = kparams();
        const float* const xp = p.x_prompt; const float* const xs = p.x_sample; const float* const modl = (const float*)(p.ws + WS_MOD) + (size_t)l * 34 * 6144; float* const out = p.out;
#pragma unroll
        for (int ai = 0; ai < 2; ++ai)
#pragma unroll
            for (int m = 0; m < 4; ++m) {
                const int rb = u.pm * 256 + ai * 128 + wr * 64 + m * 16;
                if (rb >= MT) continue;
                const int r = rb + fr;
                const int mrow = r < TP ? (r >> 12) : 2 + (r - TP);
                const float* xo = l == 0 ? (r < TP ? xp + (size_t)r * DM : xs + (size_t)(r - TP) * DM) : out + (size_t)r * DM;
                const float* gr = modl + (size_t)mrow * 6144 + 4096;
#pragma unroll
                for (int bj = 0; bj < 2; ++bj)
#pragma unroll
                    for (int n = 0; n < 2; ++n) {
                        const int c = u.pn * 256 + bj * 128 + wc * 32 + n * 16 + 4 * fq;
                        const f32x4 x4 = *(const f32x4*)(xo + c), g4 = *(const f32x4*)(gr + c);
                        *(f32x4*)(out + (size_t)r * DM + c) = x4 + g4 * acc[ai][bj][m][n];
                    }
            }
    }
};

__device__ void g2_sample_item(const Params& p, float* red, int l, int nb) {
    const int tid = opq_tid(), wv = tid >> 6, lane = tid & 63, n = lane & 31, h = lane >> 5;
    const bf16_t* A = (const bf16_t*)(p.ws + WS_HB) + (size_t)TP * DM;
    const bf16_t* Bt = (const bf16_t*)(p.ws + WS_WTOUT) + (size_t)l * DM * DM + (size_t)(nb * 32) * DM;
    f32x16 acc;
#pragma unroll
    for (int i = 0; i < 16; ++i) acc[i] = 0.f;
#pragma unroll 4
    for (int ks = 0; ks < 16; ++ks) {
        const int k0 = wv * 256 + ks * 16 + 8 * h;
        const bf16x8 a = *(const bf16x8*)(A + (size_t)n * DM + k0);
        const bf16x8 bq = *(const bf16x8*)(Bt + (size_t)n * DM + k0);
        acc = __builtin_amdgcn_mfma_f32_32x32x16_bf16(a, bq, acc, 0, 0, 0);
    }
#pragma unroll
    for (int i = 0; i < 16; ++i) red[(wv * 16 + i) * 64 + lane] = acc[i];
    __syncthreads();
    const float* mod = (const float*)(p.ws + WS_MOD) + (size_t)l * 34 * 6144;
    for (int o = tid; o < 1024; o += 512) {
        const int row = o >> 5, col = o & 31, hh = (row >> 2) & 1, ri = (row & 3) + 4 * (row >> 3), ln = col + 32 * hh;
        float s = 0.f;
#pragma unroll
        for (int w = 0; w < 8; ++w) s += red[(w * 16 + ri) * 64 + ln];
        const int c = nb * 32 + col;
        const float gate = mod[(size_t)(2 + row) * 6144 + 4096 + c];
        const float xo = l == 0 ? p.x_sample[(size_t)row * DM + c] : p.out[(size_t)(TP + row) * DM + c];
        p.out[(size_t)(TP + row) * DM + c] = xo + gate * s;
    }
    __syncthreads();
}

__device__ void p3_attn_unit(const Params& p, unsigned char* lds, int l, int unit) {
    const int tid = opq_tid(), wv = tid >> 6, lane = tid & 63;
    const int b = unit >> 7, n = (unit >> 2) & 31, g = unit & 3;
    bf16_t* Ks = (bf16_t*)lds;
    bf16_t* Vt = (bf16_t*)(lds + 36864);
    const bf16_t* qb = (const bf16_t*)(p.ws + WS_QB);
    const bf16_t* kb = (const bf16_t*)(p.ws + WS_KB);
    const bf16_t* vb = (const bf16_t*)(p.ws + WS_VB);
    const bf16_t* gt = (const bf16_t*)(p.ws + WS_GT);
    bf16_t* cc = (bf16_t*)(p.ws + WS_HB);
#pragma unroll
    for (int i = 0; i < 4; ++i) {
        const int chunk = tid + 512 * i, kl = chunk >> 3, dc = chunk & 7, kp = 128 * (n - 1) + kl;
        uint4 kv4 = make_uint4(0u, 0u, 0u, 0u), vv4 = kv4;
        if (kp >= 0) { const size_t row = (size_t)b * SEQ + kp; kv4 = *(const uint4*)(kb + row * 256 + g * 64 + dc * 8); vv4 = *(const uint4*)(vb + row * 256 + g * 64 + dc * 8); }
        *(uint4*)(Ks + kl * 72 + dc * 8) = kv4;
        bf16_t* vd = Vt + (dc * 8) * 264 + kl;
        vd[0 * 264] = (bf16_t)(vv4.x & 0xffffu); vd[1 * 264] = (bf16_t)(vv4.x >> 16);
        vd[2 * 264] = (bf16_t)(vv4.y & 0xffffu); vd[3 * 264] = (bf16_t)(vv4.y >> 16);
        vd[4 * 264] = (bf16_t)(vv4.z & 0xffffu); vd[5 * 264] = (bf16_t)(vv4.z >> 16);
        vd[6 * 264] = (bf16_t)(vv4.w & 0xffffu); vd[7 * 264] = (bf16_t)(vv4.w >> 16);
    }
    __syncthreads();
    const int hq = 4 * g + (wv >> 1), qh = wv & 1, q32 = lane & 31, h = lane >> 5;
    const float sink = p.sinks[l * 16 + hq];
#pragma unroll 1
    for (int s = 0; s < 2; ++s) {
        const int qp = 128 * n + 64 * qh + 32 * s + q32;
        const size_t qrow = (size_t)b * SEQ + qp;
        const int klb0 = 64 * qh + 32 * s;
        bf16x8 qf[4];
#pragma unroll
        for (int ks = 0; ks < 4; ++ks) qf[ks] = *(const bf16x8*)(qb + qrow * 1024 + hq * 64 + ks * 16 + 8 * h);
        f32x16 S[5];
#pragma unroll
        for (int kt = 0; kt < 5; ++kt) {
#pragma unroll
            for (int i = 0; i < 16; ++i) S[kt][i] = 0.f;
#pragma unroll
            for (int ks = 0; ks < 4; ++ks) {
                const bf16x8 a = *(const bf16x8*)(Ks + (klb0 + 32 * kt + q32) * 72 + ks * 16 + 8 * h);
                S[kt] = __builtin_amdgcn_mfma_f32_32x32x16_bf16(a, qf[ks], S[kt], 0, 0, 0);
            }
        }
        float mx = -1e30f;
#pragma unroll
        for (int kt = 0; kt < 5; ++kt)
#pragma unroll
            for (int i = 0; i < 16; ++i) {
                const int m = 8 * (i >> 2) + 4 * h + (i & 3);
                const int kp = 128 * (n - 1) + klb0 + 32 * kt + m;
                const int rel = qp - kp;
                const bool ok = (rel >= 0) && (rel <= 128) && (kp >= 0);
                const float sv = ok ? S[kt][i] : -1e30f;
                S[kt][i] = sv; mx = fmaxf(mx, sv);
            }
        mx = fmaxf(mx, __shfl_xor(mx, 32));
        mx = fmaxf(mx, sink);
        float sum = 0.f;
#pragma unroll
        for (int kt = 0; kt < 5; ++kt)
#pragma unroll
            for (int i = 0; i < 16; ++i) { const float e = __expf(S[kt][i] - mx); S[kt][i] = e; sum += e; }
        sum += __shfl_xor(sum, 32);
        const float inv = 1.f / (sum + __expf(sink - mx));
        f32x16 O[2];
#pragma unroll
        for (int i = 0; i < 16; ++i) { O[0][i] = 0.f; O[1][i] = 0.f; }
#pragma unroll
        for (int kt = 0; kt < 5; ++kt)
#pragma unroll
            for (int sp = 0; sp < 2; ++sp) {
                bf16x8 pf;
#pragma unroll
                for (int j = 0; j < 8; ++j) pf[j] = (short)f2bf(S[kt][8 * sp + j]);
#pragma unroll
                for (int dt = 0; dt < 2; ++dt) {
                    const bf16_t* vp = Vt + (32 * dt + q32) * 264 + klb0 + 32 * kt + 16 * sp + 4 * h;
                    const uint2 lo = *(const uint2*)vp, hi = *(const uint2*)(vp + 8);
                    const uint4 av = make_uint4(lo.x, lo.y, hi.x, hi.y);
                    O[dt] = __builtin_amdgcn_mfma_f32_32x32x16_bf16(__builtin_bit_cast(bf16x8, av), pf, O[dt], 0, 0, 0);
                }
            }
#pragma unroll
        for (int dt = 0; dt < 2; ++dt)
#pragma unroll
            for (int ig = 0; ig < 4; ++ig) {
                const int col = hq * 64 + 32 * dt + 8 * ig + 4 * h;
                const uint2 gg = *(const uint2*)(gt + qrow * DM + col);
                const float o0 = O[dt][4 * ig + 0] * inv * bflo(gg.x), o1 = O[dt][4 * ig + 1] * inv * bfhi(gg.x);
                const float o2 = O[dt][4 * ig + 2] * inv * bflo(gg.y), o3 = O[dt][4 * ig + 3] * inv * bfhi(gg.y);
                *(uint2*)(cc + qrow * DM + col) = make_uint2(pack2(o0, o1), pack2(o2, o3));
            }
    }
    __syncthreads();
}

__device__ void p3_sattn_item(const Params& p, float* lds, int l, int item) {
    const int tid = opq_tid(), wv = tid >> 6, lane = tid & 63;
    float* pl = lds + wv * 128;
    const int w = item * 8 + wv, bd = w >> 4, hq = w & 15, g = hq >> 2;
    const size_t row = (size_t)TP + bd;
    const bf16_t* qb = (const bf16_t*)(p.ws + WS_QB);
    const bf16_t* gt = (const bf16_t*)(p.ws + WS_GT);
    bf16_t* cc = (bf16_t*)(p.ws + WS_HB);
    float q[64];
#pragma unroll
    for (int c = 0; c < 8; ++c) {
        const uint4 u = *(const uint4*)(qb + row * 1024 + hq * 64 + c * 8);
        q[c * 8 + 0] = bflo(u.x); q[c * 8 + 1] = bfhi(u.x); q[c * 8 + 2] = bflo(u.y); q[c * 8 + 3] = bfhi(u.y);
        q[c * 8 + 4] = bflo(u.z); q[c * 8 + 5] = bfhi(u.z); q[c * 8 + 6] = bflo(u.w); q[c * 8 + 7] = bfhi(u.w);
    }
    const size_t cbase = ((size_t)(l * NBS + bd) * 128) * 256 + g * 64;
    const float* ck = p.cache_k + cbase;
    const float* cv = p.cache_v + cbase;
    float* nk = p.out + O_CKS + cbase;
    float* nv = p.out + O_CVS + cbase;
    float s0 = 0.f, s1 = 0.f, s2 = 0.f;
#pragma unroll
    for (int c = 0; c < 16; ++c) {
        const float4 a = ((const float4*)(ck + (size_t)lane * 256))[c];
        const float4 bq = ((const float4*)(ck + (size_t)(lane + 64) * 256))[c];
        const float4 e = ((const float4*)(nk + (size_t)127 * 256))[c];
        s0 += a.x * q[4 * c] + a.y * q[4 * c + 1] + a.z * q[4 * c + 2] + a.w * q[4 * c + 3];
        s1 += bq.x * q[4 * c] + bq.y * q[4 * c + 1] + bq.z * q[4 * c + 2] + bq.w * q[4 * c + 3];
        s2 += e.x * q[4 * c] + e.y * q[4 * c + 1] + e.z * q[4 * c + 2] + e.w * q[4 * c + 3];
    }
    const float sink = p.sinks[l * 16 + hq];
    const float mx = fmaxf(wave_max(fmaxf(s0, s1)), fmaxf(s2, sink));
    const float p0 = __expf(s0 - mx), p1 = __expf(s1 - mx), p2 = __expf(s2 - mx);
    const float sum = wave_sum(p0 + p1) + p2 + __expf(sink - mx);
    pl[lane] = p0; pl[lane + 64] = p1;
    __builtin_amdgcn_fence(__ATOMIC_RELEASE, "wavefront");
    __builtin_amdgcn_wave_barrier();
    __builtin_amdgcn_fence(__ATOMIC_ACQUIRE, "wavefront");
    float o = 0.f;
#pragma unroll 32
    for (int key = 0; key < 128; ++key) o += pl[key] * cv[(size_t)key * 256 + lane];
    o += p2 * nv[(size_t)127 * 256 + lane];
    o /= sum;
    const float gate = bf2f(gt[row * DM + hq * 64 + lane]);
    cc[row * DM + hq * 64 + lane] = f2bf(o * gate);
    {
        float tk[32], tv[32];
#pragma unroll
        for (int i = 0; i < 32; ++i) {
            const int ww = (hq & 3) + 4 * i;
            tk[i] = ck[(size_t)(ww + 1 < 128 ? ww + 1 : 127) * 256 + lane]; tv[i] = cv[(size_t)(ww + 1 < 128 ? ww + 1 : 127) * 256 + lane];
        }
#pragma unroll
        for (int i = 0; i < 32; ++i) {
            const int ww = (hq & 3) + 4 * i;
            if (ww < 127) { nk[(size_t)ww * 256 + lane] = tk[i]; nv[(size_t)ww * 256 + lane] = tv[i]; }
        }
    }
    __builtin_amdgcn_wave_barrier();
}

__device__ __forceinline__ float mix_val(const bf16_t* rw, const float* sshift, const float* mu, int r, int c) {
    const float cur = bf2f(rw[(size_t)r * SHD + c]);
    float prev;
    if (r >= TP) prev = sshift[(size_t)(r - TP) * SHD + c];
    else if ((r & 4095) == 0) prev = 0.f;
    else prev = bf2f(rw[(size_t)(r - 1) * SHD + c]);
    return cur + (prev - cur) * mu[c];
}

__device__ __forceinline__ float4 mix4(const bf16_t* rw, const float* sshift, int r, int c, float4 mu4) {
    const uint2 cu = *(const uint2*)(rw + (size_t)r * SHD + c);
    const float4 cur = make_float4(bflo(cu.x), bfhi(cu.x), bflo(cu.y), bfhi(cu.y));
    float4 prev = make_float4(0.f, 0.f, 0.f, 0.f);
    if (r >= TP) prev = *(const float4*)(sshift + (size_t)(r - TP) * SHD + c);
    else if ((r & 4095) != 0) { const uint2 pu = *(const uint2*)(rw + (size_t)(r - 1) * SHD + c); prev = make_float4(bflo(pu.x), bfhi(pu.x), bflo(pu.y), bfhi(pu.y)); }
    return make_float4(cur.x + (prev.x - cur.x) * mu4.x, cur.y + (prev.y - cur.y) * mu4.y, cur.z + (prev.z - cur.z) * mu4.z, cur.w + (prev.w - cur.w) * mu4.w);
}
__device__ __forceinline__ float decay_of(float x) {
    const float z = -x;
    const float sp = fmaxf(z, 0.f) + __logf(1.f + __expf(-fabsf(z)));
    return __expf(-__expf(-sp - 0.5f));
}

__device__ void p3_prep_tile(const Params& p, unsigned char* lds, int l, int tile) {
    const int tid = opq_tid(), wv = tid >> 6, lane = tid & 63, n = lane & 31, h = lane >> 5;
    bf16_t* TW = (bf16_t*)lds;
    bf16_t* AD = TW + 32 * 72;
    const bf16_t* rw = (const bf16_t*)(p.ws + WS_RW);
    const float* sshift = p.state_shift + (size_t)l * NBS * SHD;
    const float* mu = p.mu_shift + l * SHD;
    bf16_t* RIB = (bf16_t*)(p.ws + WS_RIB);
    float* RIW = (float*)(p.ws + WS_RIW);
    float* coef = (float*)(p.ws + WS_COEF);
    const int r0 = tile * 32;
#pragma unroll
    for (int i = 0; i < 8; ++i) {
        const int idx = tid + 512 * i, tt = idx >> 7, c2 = idx & 127;
        const float m = mix_val(rw, sshift, mu, r0 + tt, 3072 + c2);
        if (c2 < 64) { const float e = __expf(2.f * m); TW[tt * 72 + c2] = f2bf(1.f - 2.f / (e + 1.f)); }
        else AD[tt * 72 + (c2 - 64)] = f2bf(m);
    }
    __syncthreads();
    const int col0 = wv * 128 + 4 * n;
    f32x16 acc[4];
    {
        const float* wp = p.w_decay + (size_t)l * 64 * 1024 + col0;
#pragma unroll
        for (int nt = 0; nt < 4; ++nt)
#pragma unroll
            for (int i = 0; i < 16; ++i) acc[nt][i] = 0.f;
#pragma unroll
        for (int ks = 0; ks < 4; ++ks) {
            const bf16x8 a = *(const bf16x8*)(TW + n * 72 + 16 * ks + 8 * h);
            float4 w4[8];
#pragma unroll
            for (int e = 0; e < 8; ++e) w4[e] = *(const float4*)(wp + (size_t)(16 * ks + 8 * h + e) * 1024);
            bf16x8 b0, b1, b2, b3;
#pragma unroll
            for (int e = 0; e < 8; ++e) { b0[e] = (short)f2bf(w4[e].x); b1[e] = (short)f2bf(w4[e].y); b2[e] = (short)f2bf(w4[e].z); b3[e] = (short)f2bf(w4[e].w); }
            acc[0] = __builtin_amdgcn_mfma_f32_32x32x16_bf16(a, b0, acc[0], 0, 0, 0);
            acc[1] = __builtin_amdgcn_mfma_f32_32x32x16_bf16(a, b1, acc[1], 0, 0, 0);
            acc[2] = __builtin_amdgcn_mfma_f32_32x32x16_bf16(a, b2, acc[2], 0, 0, 0);
            acc[3] = __builtin_amdgcn_mfma_f32_32x32x16_bf16(a, b3, acc[3], 0, 0, 0);
        }
        const float4 w0c = *(const float4*)(p.w0 + l * 1024 + col0);
#pragma unroll
        for (int r = 0; r < 16; ++r) {
            const int row = r0 + 8 * (r >> 2) + 4 * h + (r & 3);
            *(float4*)(RIW + (size_t)row * 1024 + col0) =
                make_float4(decay_of(w0c.x + acc[0][r]), decay_of(w0c.y + acc[1][r]), decay_of(w0c.z + acc[2][r]), decay_of(w0c.w + acc[3][r]));
        }
    }
    {
        const float* wp = p.w_iclr + (size_t)l * 64 * 1024 + col0;
#pragma unroll
        for (int nt = 0; nt < 4; ++nt)
#pragma unroll
            for (int i = 0; i < 16; ++i) acc[nt][i] = 0.f;
#pragma unroll
        for (int ks = 0; ks < 4; ++ks) {
            const bf16x8 a = *(const bf16x8*)(AD + n * 72 + 16 * ks + 8 * h);
            float4 w4[8];
#pragma unroll
            for (int e = 0; e < 8; ++e) w4[e] = *(const float4*)(wp + (size_t)(16 * ks + 8 * h + e) * 1024);
            bf16x8 b0, b1, b2, b3;
#pragma unroll
            for (int e = 0; e < 8; ++e) { b0[e] = (short)f2bf(w4[e].x); b1[e] = (short)f2bf(w4[e].y); b2[e] = (short)f2bf(w4[e].z); b3[e] = (short)f2bf(w4[e].w); }
            acc[0] = __builtin_amdgcn_mfma_f32_32x32x16_bf16(a, b0, acc[0], 0, 0, 0);
            acc[1] = __builtin_amdgcn_mfma_f32_32x32x16_bf16(a, b1, acc[1], 0, 0, 0);
            acc[2] = __builtin_amdgcn_mfma_f32_32x32x16_bf16(a, b2, acc[2], 0, 0, 0);
            acc[3] = __builtin_amdgcn_mfma_f32_32x32x16_bf16(a, b3, acc[3], 0, 0, 0);
        }
    }
    const float4 a0c = *(const float4*)(p.a0 + l * 1024 + col0), kkc = *(const float4*)(p.k_k + l * 1024 + col0), kac = *(const float4*)(p.k_a + l * 1024 + col0), rkc = *(const float4*)(p.r_k + l * 1024 + col0);
    const float4 mur = *(const float4*)(mu + col0), muk = *(const float4*)(mu + 1024 + col0), muv = *(const float4*)(mu + 2048 + col0);
    const int head = 2 * wv + (n >> 4);
#pragma unroll
    for (int r = 0; r < 16; ++r) {
        const int row = r0 + 8 * (r >> 2) + 4 * h + (r & 3);
        const float4 rr = mix4(rw, sshift, row, col0, mur), kr = mix4(rw, sshift, row, 1024 + col0, muk), vr = mix4(rw, sshift, row, 2048 + col0, muv);
        const float ax = 1.f / (1.f + __expf(-(a0c.x + acc[0][r]))), ay = 1.f / (1.f + __expf(-(a0c.y + acc[1][r])));
        const float az = 1.f / (1.f + __expf(-(a0c.z + acc[2][r]))), aw = 1.f / (1.f + __expf(-(a0c.w + acc[3][r])));
        const float k0 = kr.x * kkc.x, k1 = kr.y * kkc.y, k2 = kr.z * kkc.z, k3 = kr.w * kkc.w;
        const float ss = allreduce16(k0 * k0 + k1 * k1 + k2 * k2 + k3 * k3);
        const float inv = 1.f / fmaxf(sqrtf(ss), 1e-12f);
        const float4 kk = make_float4(k0 * inv, k1 * inv, k2 * inv, k3 * inv);
        const float4 ke = make_float4(kr.x * (1.f + (ax - 1.f) * kac.x), kr.y * (1.f + (ay - 1.f) * kac.y), kr.z * (1.f + (az - 1.f) * kac.z), kr.w * (1.f + (aw - 1.f) * kac.w));
        const float cf = allreduce16(rr.x * ke.x * rkc.x + rr.y * ke.y * rkc.y + rr.z * ke.z * rkc.z + rr.w * ke.w * rkc.w);
        if ((n & 15) == 0) coef[(size_t)row * 16 + head] = cf;
        const size_t o = (size_t)row * 1024 + col0;
        *(uint2*)(RIB + o) = make_uint2(pack2(rr.x, rr.y), pack2(rr.z, rr.w));
        *(uint2*)(RIB + NRI + o) = make_uint2(pack2(ke.x, ke.y), pack2(ke.z, ke.w));
        *(uint2*)(RIB + 2 * NRI + o) = make_uint2(pack2(kk.x, kk.y), pack2(kk.z, kk.w));
        *(uint2*)(RIB + 3 * NRI + o) = make_uint2(pack2(kk.x * ax, kk.y * ay), pack2(kk.z * az, kk.w * aw));
        *(uint2*)(RIB + 4 * NRI + o) = make_uint2(pack2(vr.x, vr.y), pack2(vr.z, vr.w));
    }
    __syncthreads();
}

constexpr int REC_BYTES = 14592;
constexpr int PA_WLDS = 16384;
typedef float f32x4v __attribute__((ext_vector_type(4)));

__device__ void pa_chunk(const Params& p, unsigned char* wl, int l, int ct) {
    const int lane = opq_tid() & 63;
    const int hh = ct >> 8, c = ct & 255, b = hh >> 4, h = hh & 15;
    const size_t row0 = (size_t)b * SEQ + 16 * c;
    const int col = h * 64 + lane;
    const bf16_t* RIB = (const bf16_t*)(p.ws + WS_RIB);
    const float* RIW = (const float*)(p.ws + WS_RIW);
    float vv[16];
    float gC;
    bf16_t* S_AB = (bf16_t*)wl; bf16_t* S_BB = S_AB + 16 * 72; bf16_t* S_KB = S_BB + 16 * 72; bf16_t* S_RT = S_KB + 16 * 72;
    {
        float g = 1.f;
#pragma unroll
        for (int t = 0; t < 16; ++t) {
            const unsigned idx = (unsigned)(row0 + t) * 1024u + (unsigned)col;
            const float r_ = bf2f(RIB[idx]), k_ = bf2f(RIB[(unsigned)NRI + idx]), kk_ = bf2f(RIB[2u * (unsigned)NRI + idx]), b_ = bf2f(RIB[3u * (unsigned)NRI + idx]);
            vv[t] = bf2f(RIB[4u * (unsigned)NRI + idx]);
            const float w_ = RIW[idx];
            S_AB[t * 72 + lane] = f2bf(-g * kk_);
            g *= w_;
            const float ig = __builtin_amdgcn_rcpf(g);
            S_BB[t * 72 + lane] = f2bf(b_ * ig); S_KB[t * 72 + lane] = f2bf(k_ * ig); S_RT[t * 72 + lane] = f2bf(g * r_);
        }
        gC = g;
    }
    __builtin_amdgcn_fence(__ATOMIC_RELEASE, "wavefront"); __builtin_amdgcn_wave_barrier(); __builtin_amdgcn_fence(__ATOMIC_ACQUIRE, "wavefront");
    f32x4v Gab = {0.f, 0.f, 0.f, 0.f}, Gak = Gab, Grb = Gab, Grk = Gab;
    {
        const int rr = lane & 15, kg = lane >> 4;
#pragma unroll
        for (int ks = 0; ks < 2; ++ks) {
            const int o = rr * 72 + 32 * ks + 8 * kg;
            const bf16x8 fA = *(const bf16x8*)(S_AB + o), fB = *(const bf16x8*)(S_BB + o), fK = *(const bf16x8*)(S_KB + o), fR = *(const bf16x8*)(S_RT + o);
            Gab = __builtin_amdgcn_mfma_f32_16x16x32_bf16(fB, fA, Gab, 0, 0, 0);
            Gak = __builtin_amdgcn_mfma_f32_16x16x32_bf16(fK, fA, Gak, 0, 0, 0);
            Grb = __builtin_amdgcn_mfma_f32_16x16x32_bf16(fB, fR, Grb, 0, 0, 0);
            Grk = __builtin_amdgcn_mfma_f32_16x16x32_bf16(fK, fR, Grk, 0, 0, 0);
        }
    }
    __builtin_amdgcn_fence(__ATOMIC_RELEASE, "wavefront"); __builtin_amdgcn_wave_barrier(); __builtin_amdgcn_fence(__ATOMIC_ACQUIRE, "wavefront");
    float* M_AB = (float*)(wl + 9216); float* M_AK = M_AB + 256; float* M_RB = M_AK + 256; float* M_RK = M_RB + 256; float* T_ = M_RK + 256; float* Q_ = T_ + 256; float* W2_ = Q_ + 256;
    {
        const int t = lane & 15, kg = lane >> 4;
#pragma unroll
        for (int rg = 0; rg < 4; ++rg) {
            const int s = 4 * kg + rg;
            M_AB[s * 16 + t] = s < t ? Gab[rg] : 0.f; M_AK[s * 16 + t] = s < t ? Gak[rg] : 0.f;
            M_RB[s * 16 + t] = s <= t ? Grb[rg] : 0.f; M_RK[s * 16 + t] = s <= t ? Grk[rg] : 0.f;
        }
    }
    __builtin_amdgcn_fence(__ATOMIC_RELEASE, "wavefront"); __builtin_amdgcn_wave_barrier(); __builtin_amdgcn_fence(__ATOMIC_ACQUIRE, "wavefront");
    {
        const int rr = lane & 15;
        float Tr[16];
#pragma unroll
        for (int t = 0; t < 16; ++t) {
            float acc = (rr == t) ? 1.f : 0.f;
#pragma unroll
            for (int s = 0; s < t; ++s) acc += Tr[s] * M_AB[s * 16 + t];
            Tr[t] = acc;
        }
#pragma unroll
        for (int t = 0; t < 16; ++t) T_[rr * 16 + t] = Tr[t];
    }
    __builtin_amdgcn_fence(__ATOMIC_RELEASE, "wavefront"); __builtin_amdgcn_wave_barrier(); __builtin_amdgcn_fence(__ATOMIC_ACQUIRE, "wavefront");
    {
        const int s = lane & 15, tq = lane >> 4;
        float4 q = make_float4(0.f, 0.f, 0.f, 0.f);
#pragma unroll
        for (int u = 0; u < 16; ++u) { const float a = M_AK[s * 16 + u]; const float4 t4 = *(const float4*)(T_ + u * 16 + 4 * tq); q.x += a * t4.x; q.y += a * t4.y; q.z += a * t4.z; q.w += a * t4.w; }
        *(float4*)(Q_ + s * 16 + 4 * tq) = q;
        __builtin_amdgcn_fence(__ATOMIC_RELEASE, "wavefront"); __builtin_amdgcn_wave_barrier(); __builtin_amdgcn_fence(__ATOMIC_ACQUIRE, "wavefront");
        float4 w2 = *(const float4*)(M_RK + s * 16 + 4 * tq);
#pragma unroll
        for (int u = 0; u < 16; ++u) { const float a = Q_[s * 16 + u]; const float4 m4 = *(const float4*)(M_RB + u * 16 + 4 * tq); w2.x += a * m4.x; w2.y += a * m4.y; w2.z += a * m4.z; w2.w += a * m4.w; }
        *(float4*)(W2_ + s * 16 + 4 * tq) = w2;
    }
    __builtin_amdgcn_fence(__ATOMIC_RELEASE, "wavefront"); __builtin_amdgcn_wave_barrier(); __builtin_amdgcn_fence(__ATOMIC_ACQUIRE, "wavefront");
    cvt_f32x2 pt2[8], r22[8], ul2[8], yl2[8];
#pragma unroll
    for (int t = 0; t < 8; ++t) { pt2[t] = (cvt_f32x2){0.f, 0.f}; r22[t] = (cvt_f32x2){bf2f(S_RT[(2 * t) * 72 + lane]), bf2f(S_RT[(2 * t + 1) * 72 + lane])}; ul2[t] = pt2[t]; yl2[t] = pt2[t]; }
#pragma unroll
    for (int s = 0; s < 16; ++s) {
        const float as_ = bf2f(S_AB[s * 72 + lane]), vs_ = vv[s];
        const cvt_f32x2 as2 = {as_, as_}, vs2 = {vs_, vs_};
#pragma unroll
        for (int tq = 0; tq < 4; ++tq) {
            const float4 t4 = *(const float4*)(T_ + s * 16 + 4 * tq), q4 = *(const float4*)(Q_ + s * 16 + 4 * tq), w4 = *(const float4*)(W2_ + s * 16 + 4 * tq);
            pt2[2 * tq] += (cvt_f32x2){t4.x, t4.y} * as2; pt2[2 * tq + 1] += (cvt_f32x2){t4.z, t4.w} * as2;
            ul2[2 * tq] += (cvt_f32x2){q4.x, q4.y} * vs2; ul2[2 * tq + 1] += (cvt_f32x2){q4.z, q4.w} * vs2;
            yl2[2 * tq] += (cvt_f32x2){w4.x, w4.y} * vs2; yl2[2 * tq + 1] += (cvt_f32x2){w4.z, w4.w} * vs2;
        }
        __builtin_amdgcn_sched_barrier(0);
    }
    float pt[16], ul[16], yl[16];
#pragma unroll
    for (int t = 0; t < 8; ++t) { pt[2 * t] = pt2[t].x; pt[2 * t + 1] = pt2[t].y; ul[2 * t] = ul2[t].x; ul[2 * t + 1] = ul2[t].y; yl[2 * t] = yl2[t].x; yl[2 * t + 1] = yl2[t].y; }
#pragma unroll
    for (int s = 0; s < 16; ++s) {
        const cvt_f32x2 ps2 = {pt[s], pt[s]};
#pragma unroll
        for (int tq = 0; tq < 4; ++tq) {
            const float4 m4 = *(const float4*)(M_RB + s * 16 + 4 * tq);
            r22[2 * tq] += (cvt_f32x2){m4.x, m4.y} * ps2; r22[2 * tq + 1] += (cvt_f32x2){m4.z, m4.w} * ps2;
        }
        __builtin_amdgcn_sched_barrier(0);
    }
    float r2[16];
#pragma unroll
    for (int t = 0; t < 8; ++t) { r2[2 * t] = r22[t].x; r2[2 * t + 1] = r22[t].y; }
    unsigned char* rec = p.ws + WS_REC + (size_t)ct * REC_BYTES;
    float* ys = (float*)(p.ws + WS_RW);
#pragma unroll
    for (int t = 0; t < 16; ++t) {
        *(bf16_t*)(rec + t * 128 + lane * 2) = f2bf(pt[t]);
        *(bf16_t*)(rec + 2048 + t * 128 + lane * 2) = f2bf(r2[t]);
        ys[(unsigned)(row0 + t) * 1024u + (unsigned)col] = yl[t];
    }
    {
        unsigned w[8];
#pragma unroll
        for (int e = 0; e < 8; ++e) w[e] = pack2(gC * bf2f(S_BB[(2 * e) * 72 + lane]), gC * bf2f(S_BB[(2 * e + 1) * 72 + lane]));
        *(uint4*)(rec + 4096 + lane * 32) = make_uint4(w[0], w[1], w[2], w[3]); *(uint4*)(rec + 4096 + lane * 32 + 16) = make_uint4(w[4], w[5], w[6], w[7]);
#pragma unroll
        for (int e = 0; e < 8; ++e) w[e] = pack2(gC * bf2f(S_KB[(2 * e) * 72 + lane]), gC * bf2f(S_KB[(2 * e + 1) * 72 + lane]));
        *(uint4*)(rec + 6144 + lane * 32) = make_uint4(w[0], w[1], w[2], w[3]); *(uint4*)(rec + 6144 + lane * 32 + 16) = make_uint4(w[4], w[5], w[6], w[7]);
        *(float*)(rec + 8192 + lane * 4) = gC;
        unsigned char* ip = rec + 8448 + (lane >> 5) * 3072;
#pragma unroll
        for (int e = 0; e < 8; ++e) w[e] = pack2(vv[2 * e], vv[2 * e + 1]);
        *(uint4*)(ip + (lane & 31) * 32) = make_uint4(w[0], w[1], w[2], w[3]); *(uint4*)(ip + (lane & 31) * 32 + 16) = make_uint4(w[4], w[5], w[6], w[7]);
#pragma unroll
        for (int tq = 0; tq < 4; ++tq) *(float4*)(ip + 1024 + (lane & 31) * 64 + tq * 16) = make_float4(ul[4 * tq], ul[4 * tq + 1], ul[4 * tq + 2], ul[4 * tq + 3]);
    }
    __builtin_amdgcn_fence(__ATOMIC_RELEASE, "wavefront"); __builtin_amdgcn_wave_barrier();
}

__device__ void pa_sample_task(const Params& p, int l, int task) {
    const int lane = opq_tid() & 63;
    const int bd = task >> 8, h = (task >> 4) & 15, wq = task & 15;
    const int irow = 4 * wq + (lane >> 4), jq = lane & 15;
    const size_t row = (size_t)TP + bd;
    const bf16_t* RIB = (const bf16_t*)(p.ws + WS_RIB);
    const float* RIW = (const float*)(p.ws + WS_RIW);
    float* ys = (float*)(p.ws + WS_RW);
    const size_t so = (((size_t)(l * NBS + bd) * 16 + h) * 64 + irow) * 64 + 4 * jq;
    float4 s = *(const float4*)(p.state_wkv + so);
    const size_t o = row * 1024 + h * 64 + 4 * jq;
    const uint2 ur = *(const uint2*)(RIB + o), uk = *(const uint2*)(RIB + NRI + o), ukk = *(const uint2*)(RIB + 2 * NRI + o), ub = *(const uint2*)(RIB + 3 * NRI + o);
    const float4 w4 = *(const float4*)(RIW + o);
    const float v = bf2f(RIB[4 * NRI + row * 1024 + h * 64 + irow]);
    float pa = s.x * bflo(ukk.x) + s.y * bfhi(ukk.x) + s.z * bflo(ukk.y) + s.w * bfhi(ukk.y);
    pa = allreduce16(pa);
    const float sa = -pa;
    s.x = fmaf(sa, bflo(ub.x), fmaf(s.x, w4.x, v * bflo(uk.x)));
    s.y = fmaf(sa, bfhi(ub.x), fmaf(s.y, w4.y, v * bfhi(uk.x)));
    s.z = fmaf(sa, bflo(ub.y), fmaf(s.z, w4.z, v * bflo(uk.y)));
    s.w = fmaf(sa, bfhi(ub.y), fmaf(s.w, w4.w, v * bfhi(uk.y)));
    float py = s.x * bflo(ur.x) + s.y * bfhi(ur.x) + s.z * bflo(ur.y) + s.w * bfhi(ur.y);
    py = allreduce16(py);
    *(float4*)(p.out + O_WKVS + so) = s;
    if (jq == 0) ys[row * 1024 + h * 64 + irow] = py;
}

constexpr int PB_NB = 8, PB_SLOT = 13568, PB_NCH = SEQ / 16;
__device__ void pb_head(const Params& p, unsigned char* lds, int l, int blk) {
    const int tid = opq_tid(), wv = tid >> 6, lane = tid & 63;
    const int hh = blk >> 1, it = blk & 1, b = hh >> 4, h = hh & 15;
    volatile LAS unsigned* flags = (volatile LAS unsigned*)((LAS unsigned char*)lds + PB_NB * PB_SLOT);
    if (tid <= PB_NB) flags[tid] = 0u;
    __syncthreads();
    const unsigned char* rec0 = p.ws + WS_REC + (size_t)(hh * 256) * REC_BYTES;
    float* ys = (float*)(p.ws + WS_RW) + ((size_t)b * SEQ) * 1024 + h * 64 + 32 * it;
    if (wv >= 1) {
#pragma unroll 1
        for (int c = wv - 1; c < PB_NCH; c += 7) {
            while (c - (int)flags[PB_NB] >= PB_NB) __builtin_amdgcn_s_sleep(1);
            asm volatile("" ::: "memory");
            const unsigned char* rec = rec0 + (size_t)c * REC_BYTES;
            unsigned char* sl = lds + (c % PB_NB) * PB_SLOT;
            uint4 d[14];
#pragma unroll
            for (int q = 0; q < 8; ++q) d[q] = *(const uint4*)(rec + (q * 64 + lane) * 16);
            d[8] = *(const uint4*)(rec + 8192 + (lane & 15) * 16);
#pragma unroll
            for (int q = 0; q < 3; ++q) d[9 + q] = *(const uint4*)(rec + 8448 + it * 3072 + (q * 64 + lane) * 16);
#pragma unroll
            for (int q = 0; q < 2; ++q) { const int x = q * 64 + lane, t = x >> 3, cc = x & 7; d[12 + q] = *(const uint4*)(ys + (size_t)(16 * c + t) * 1024 + cc * 4); }
#pragma unroll
            for (int q = 0; q < 8; ++q) *(uint4*)(sl + (q * 64 + lane) * 16) = d[q];
            if (lane < 16) *(uint4*)(sl + 8192 + lane * 16) = d[8];
#pragma unroll
            for (int q = 0; q < 3; ++q) *(uint4*)(sl + 8448 + (q * 64 + lane) * 16) = d[9 + q];
#pragma unroll
            for (int q = 0; q < 2; ++q) { const int x = q * 64 + lane, t = x >> 3, cc = x & 7; float* yd = (float*)(sl + 11520) + (4 * cc) * 16 + t;
                yd[0] = __uint_as_float(d[12 + q].x); yd[16] = __uint_as_float(d[12 + q].y); yd[32] = __uint_as_float(d[12 + q].z); yd[48] = __uint_as_float(d[12 + q].w); }
            asm volatile("s_waitcnt lgkmcnt(0)" ::: "memory");
            if (lane == 0) flags[c % PB_NB] = (unsigned)(c + 1);
        }
    } else {
        const int q32 = lane & 31, hf = lane >> 5;
        f32x16 X0, X1;
#pragma unroll
        for (int i = 0; i < 16; ++i) { X0[i] = 0.f; X1[i] = 0.f; }
#pragma unroll 1
        for (int c = 0; c < PB_NCH; ++c) {
            const unsigned char* sl = lds + (c % PB_NB) * PB_SLOT;
            while (flags[c % PB_NB] != (unsigned)(c + 1)) __builtin_amdgcn_s_sleep(0);
            asm volatile("" ::: "memory");
            bf16x8 xb[4];
            xb[0] = __builtin_bit_cast(bf16x8, make_uint4(pack2(X0[0], X0[1]), pack2(X0[2], X0[3]), pack2(X0[4], X0[5]), pack2(X0[6], X0[7])));
            xb[1] = __builtin_bit_cast(bf16x8, make_uint4(pack2(X0[8], X0[9]), pack2(X0[10], X0[11]), pack2(X0[12], X0[13]), pack2(X0[14], X0[15])));
            xb[2] = __builtin_bit_cast(bf16x8, make_uint4(pack2(X1[0], X1[1]), pack2(X1[2], X1[3]), pack2(X1[4], X1[5]), pack2(X1[6], X1[7])));
            xb[3] = __builtin_bit_cast(bf16x8, make_uint4(pack2(X1[8], X1[9]), pack2(X1[10], X1[11]), pack2(X1[12], X1[13]), pack2(X1[14], X1[15])));
            f32x16 Ua, Ub, Ya, Yb;
            {
                const float4 u0 = *(const float4*)(sl + 9472 + q32 * 64 + 16 * hf), u1 = *(const float4*)(sl + 9472 + q32 * 64 + 32 + 16 * hf);
                const float4 y0 = *(const float4*)(sl + 11520 + q32 * 64 + 16 * hf), y1 = *(const float4*)(sl + 11520 + q32 * 64 + 32 + 16 * hf);
                Ua[0] = u0.x; Ua[1] = u0.y; Ua[2] = u0.z; Ua[3] = u0.w; Ua[4] = u1.x; Ua[5] = u1.y; Ua[6] = u1.z; Ua[7] = u1.w;
                Ya[0] = y0.x; Ya[1] = y0.y; Ya[2] = y0.z; Ya[3] = y0.w; Ya[4] = y1.x; Ya[5] = y1.y; Ya[6] = y1.z; Ya[7] = y1.w;
            }
#pragma unroll
            for (int r = 8; r < 16; ++r) { Ua[r] = 0.f; Ya[r] = 0.f; }
#pragma unroll
            for (int r = 0; r < 16; ++r) { Ub[r] = 0.f; Yb[r] = 0.f; }
#pragma unroll
            for (int f = 0; f < 4; ++f) {
                const int jo = 16 * f + 4 * hf;
                const unsigned char* pr = sl + (q32 & 15) * 128 + jo * 2;
                const uint2 p0 = *(const uint2*)pr, p1 = *(const uint2*)(pr + 16);
                const uint2 r0 = *(const uint2*)(pr + 2048), r1 = *(const uint2*)(pr + 2048 + 16);
                const bf16x8 pa = __builtin_bit_cast(bf16x8, make_uint4(p0.x, p0.y, p1.x, p1.y));
                const bf16x8 ra = __builtin_bit_cast(bf16x8, make_uint4(r0.x, r0.y, r1.x, r1.y));
                if (f & 1) { Ub = __builtin_amdgcn_mfma_f32_32x32x16_bf16(pa, xb[f], Ub, 0, 0, 0); Yb = __builtin_amdgcn_mfma_f32_32x32x16_bf16(ra, xb[f], Yb, 0, 0, 0); }
                else { Ua = __builtin_amdgcn_mfma_f32_32x32x16_bf16(pa, xb[f], Ua, 0, 0, 0); Ya = __builtin_amdgcn_mfma_f32_32x32x16_bf16(ra, xb[f], Ya, 0, 0, 0); }
            }
            const bf16x8 ub = __builtin_bit_cast(bf16x8, make_uint4(pack2(Ua[0] + Ub[0], Ua[1] + Ub[1]), pack2(Ua[2] + Ub[2], Ua[3] + Ub[3]), pack2(Ua[4] + Ub[4], Ua[5] + Ub[5]), pack2(Ua[6] + Ub[6], Ua[7] + Ub[7])));
#pragma unroll
            for (int r = 0; r < 8; ++r) {
                const int t = 8 * (r >> 2) + 4 * hf + (r & 3);
                ys[(size_t)(16 * c + t) * 1024 + q32] = Ya[r] + Yb[r];
            }
            const bf16x8 vf = *(const bf16x8*)(sl + 8448 + q32 * 32 + 16 * hf);
#pragma unroll
            for (int jt = 0; jt < 2; ++jt) {
                f32x16 Xn;
#pragma unroll
                for (int g = 0; g < 4; ++g) {
                    const float4 gm = *(const float4*)(sl + 8192 + (32 * jt + 8 * g + 4 * hf) * 4);
                    if (jt == 0) { Xn[4 * g + 0] = X0[4 * g + 0] * gm.x; Xn[4 * g + 1] = X0[4 * g + 1] * gm.y; Xn[4 * g + 2] = X0[4 * g + 2] * gm.z; Xn[4 * g + 3] = X0[4 * g + 3] * gm.w; }
                    else { Xn[4 * g + 0] = X1[4 * g + 0] * gm.x; Xn[4 * g + 1] = X1[4 * g + 1] * gm.y; Xn[4 * g + 2] = X1[4 * g + 2] * gm.z; Xn[4 * g + 3] = X1[4 * g + 3] * gm.w; }
                }
                const int j = 32 * jt + q32;
                const bf16x8 gk = *(const bf16x8*)(sl + 6144 + j * 32 + 16 * hf);
                const uint2 b0 = *(const uint2*)(sl + 4096 + j * 32 + 8 * hf), b1 = *(const uint2*)(sl + 4096 + j * 32 + 16 + 8 * hf);
                const bf16x8 gb = __builtin_bit_cast(bf16x8, make_uint4(b0.x, b0.y, b1.x, b1.y));
                Xn = __builtin_amdgcn_mfma_f32_32x32x16_bf16(gk, vf, Xn, 0, 0, 0);
                Xn = __builtin_amdgcn_mfma_f32_32x32x16_bf16(gb, ub, Xn, 0, 0, 0);
                if (jt == 0) X0 = Xn; else X1 = Xn;
            }
            asm volatile("s_waitcnt lgkmcnt(0)" ::: "memory");
            if (lane == 0) flags[PB_NB] = (unsigned)(c + 1);
        }
        float* so = p.out + O_WKVP + ((size_t)(l * NBP + b) * 16 + h) * 4096 + (size_t)(32 * it + q32) * 64;
#pragma unroll
        for (int g = 0; g < 4; ++g) {
            *(float4*)(so + 8 * g + 4 * hf) = make_float4(X0[4 * g], X0[4 * g + 1], X0[4 * g + 2], X0[4 * g + 3]);
            *(float4*)(so + 32 + 8 * g + 4 * hf) = make_float4(X1[4 * g], X1[4 * g + 1], X1[4 * g + 2], X1[4 * g + 3]);
        }
    }
    __syncthreads();
}

__device__ void p3_post(const Params& p, int l, int bid, int G) {
    const int tid = opq_tid(), wv = tid >> 6, lane = tid & 63;
    const float* ys = (const float*)(p.ws + WS_RW);
    const bf16_t* V = (const bf16_t*)(p.ws + WS_RIB) + 4 * NRI;
    const float* coef = (const float*)(p.ws + WS_COEF);
    const bf16_t* gt = (const bf16_t*)(p.ws + WS_GT);
    bf16_t* cc = (bf16_t*)(p.ws + WS_HB);
    for (int r = bid * 8 + wv; r < MT; r += G * 8) {
#pragma unroll
        for (int hg = 0; hg < 4; ++hg) {
            const int head = 4 * hg + (lane >> 4), c = head * 64 + 4 * (lane & 15);
            const float4 y = *(const float4*)(ys + (size_t)r * 1024 + c);
            const float mu = allreduce16(y.x + y.y + y.z + y.w) * (1.f / 64.f);
            const float d0 = y.x - mu, d1 = y.y - mu, d2 = y.z - mu, d3 = y.w - mu;
            const float var = allreduce16(d0 * d0 + d1 * d1 + d2 * d2 + d3 * d3) * (1.f / 64.f);
            const float rs = rsqrtf(var + 64e-5f);
            const float4 lw = *(const float4*)(p.ln_w + l * 1024 + c), lb = *(const float4*)(p.ln_b + l * 1024 + c);
            const uint2 vu = *(const uint2*)(V + (size_t)r * 1024 + c);
            const float4 v4 = make_float4(bflo(vu.x), bfhi(vu.x), bflo(vu.y), bfhi(vu.y));
            const float cf = coef[(size_t)r * 16 + head];
            const uint2 gg = *(const uint2*)(gt + (size_t)r * DM + 1024 + c);
            const float o0 = (d0 * rs * lw.x + lb.x + cf * v4.x) * bflo(gg.x), o1 = (d1 * rs * lw.y + lb.y + cf * v4.y) * bfhi(gg.x);
            const float o2 = (d2 * rs * lw.z + lb.z + cf * v4.z) * bflo(gg.y), o3 = (d3 * rs * lw.w + lb.w + cf * v4.w) * bfhi(gg.y);
            *(uint2*)(cc + (size_t)r * DM + 1024 + c) = make_uint2(pack2(o0, o1), pack2(o2, o3));
        }
    }
}

__device__ void p_final(const Params& p, int bid, int G) {
    const int tid = opq_tid(), wv = tid >> 6, lane = tid & 63;
    const float4* g4 = (const float4*)p.final_g;
    for (int r = bid * 8 + wv; r < MT; r += G * 8) {
        float4* xr = (float4*)(p.out + (size_t)r * DM);
        float4 v[8]; float ss = 0.f;
#pragma unroll
        for (int i = 0; i < 8; ++i) { v[i] = xr[lane + 64 * i]; ss += v[i].x * v[i].x + v[i].y * v[i].y + v[i].z * v[i].z + v[i].w * v[i].w; }
        ss = wave_sum(ss);
        const float rinv = rsqrtf(ss * (1.f / 2048.f) + 1e-5f);
#pragma unroll
        for (int i = 0; i < 8; ++i) { const float4 g = g4[lane + 64 * i]; xr[lane + 64 * i] = make_float4(v[i].x * rinv * g.x, v[i].y * rinv * g.y, v[i].z * rinv * g.z, v[i].w * rinv * g.w); }
    }
}

#ifndef REPL
#define REPL -1
#endif
#ifndef REPK
#define REPK -100
#endif
__global__ void __launch_bounds__(512, 2) fwd_kernel(Params p_unused) {
    extern __shared__ __attribute__((aligned(16))) unsigned char shm[];
    cg::grid_group grid = cg::this_grid();
    const int bid0 = blockIdx.x, G0 = gridDim.x;
    float* shf = (float*)shm;
    volatile LAS unsigned* xst = (volatile LAS unsigned*)((LAS unsigned char*)shm + 131072);
    if (threadIdx.x == 0) { xst[0] = 0u; xst[1] = 0u; }
    __syncthreads();
    const XcdBarrier xb = xcd_barrier_post((unsigned*)(kparams().ws + WS_BAR), xst);
    if (G0 == 0x7fffffff) grid.sync();

#pragma unroll 1
    for (int ph = 0; ph < 16; ++ph) {
        const int bid = opq_s(bid0), G = opq_s(G0);
        const int l = ph >= 8 ? 1 : 0, k = ph == 0 ? -1 : (ph == 15 ? 7 : (ph - 1) - 7 * l);
#pragma unroll 1
        for (int rep = 0; rep < ((k == kparams().repk && (kparams().repl < 0 || kparams().repl == l)) ? 2 : 1); ++rep) {
        if (k == -1) {
            for (int it = bid; it < 384; it += G) p0_mod_item(kparams(), shf, it / 192, it % 192);
            for (int it = bid; it < 17; it += G) p0_rope_item(kparams(), it);
            p0_conv_all(kparams(), shf, bid, G, 2752, 0);
        } else if (k == 0) {
            p1_norm(kparams(), l, bid, G);
        } else if (k == 1) {
            pg8::StaticOrder S; S.init(MP, INWP, G, bid);
            pg8::Gemm g{(const bf16_t*)(kparams().ws + WS_HB), (const bf16_t*)(kparams().ws + WS_WTIN), MP, INWP, DM};
            Epi1 E{l};
            pg8::gemm_phase<Epi1, pg8::StaticOrder, false>((PG8_LAS unsigned char*)shm, g, S, E, nullptr);
        } else if (k == 2) {
            for (int it = bid; it < 256 + 64 + 257; it += G) {
                if (it < 256) p3_attn_unit(kparams(), shm, l, it);
                else if (it < 320) p3_sattn_item(kparams(), shf, l, it - 256);
                else p3_prep_tile(kparams(), shm, l, it - 320);
            }
        } else if (k == 3) {
            const int wvq = opq_tid() >> 6, gw = bid * 8 + wvq, nw = G * 8;
            for (int ct = gw; ct < 32 * 256; ct += nw) pa_chunk(kparams(), shm + wvq * PA_WLDS, l, ct);
            for (int task = gw; task < NBS * 256; task += nw) pa_sample_task(kparams(), l, task);
        } else if (k == 4) {
            if (bid < 64) pb_head(kparams(), shm, l, bid);
            else if (l == 0) p0_conv_all(kparams(), shf, bid - 64, G - 64, 1728, 1);
        } else if (k == 5) {
            p3_post(kparams(), l, bid, G);
        } else if (k == 6) {
            pg8::StaticOrder S; S.init(TP, DM, G, bid);
            pg8::Gemm g{(const bf16_t*)(kparams().ws + WS_HB), (const bf16_t*)(kparams().ws + WS_WTOUT) + (size_t)l * DM * DM, TP, DM, DM};
            Epi2 E{l};
            pg8::gemm_phase<Epi2, pg8::StaticOrder, false>((PG8_LAS unsigned char*)shm, g, S, E, nullptr);
            for (int nb = bid; nb < 64; nb += G) g2_sample_item(kparams(), shf, l, nb);
        } else {
            p_final(kparams(), bid, G);
        }
        if (ph < 15) xcd_barrier(xb);
        }
    }
}

extern "C" void kernel_launch(void* const* d_in, const int* in_sizes, int n_in, void* d_out, int out_size, void* d_ws, size_t ws_size, hipStream_t stream) {
    static int grid_blocks = 0;
    if (grid_blocks == 0) {
        if (n_in != 25 || (size_t)out_size != O_END || ws_size < WS_END) {
            fprintf(stderr, "kernel_launch: unexpected shapes: n_in %d out_size %d ws_size %zu (need %zu)\n", n_in, out_size, ws_size, (size_t)WS_END);
            grid_blocks = -1; return;
        }
        if (hipFuncSetAttribute((const void*)fwd_kernel, hipFuncAttributeMaxDynamicSharedMemorySize, LDS_BYTES) != hipSuccess) { fprintf(stderr, "kernel_launch: hipFuncSetAttribute failed\n"); grid_blocks = -1; return; }
        int dev = 0, cus = 0, per_cu = 0;
        hipGetDevice(&dev);
        hipDeviceGetAttribute(&cus, hipDeviceAttributeMultiprocessorCount, dev);
        hipOccupancyMaxActiveBlocksPerMultiprocessor(&per_cu, (const void*)fwd_kernel, 512, LDS_BYTES);
        if (per_cu < 1) { fprintf(stderr, "kernel_launch: occupancy query gives %d blocks per CU\n", per_cu); per_cu = 1; }
        (void)hipGetLastError();
        grid_blocks = cus;
        if (grid_blocks < 192) { fprintf(stderr, "kernel_launch: only %d CUs\n", grid_blocks); grid_blocks = -1; return; }
    }
    if (grid_blocks < 0) return;
    if (hipMemsetAsync((unsigned char*)d_ws + WS_BAR, 0, 16384, stream) != hipSuccess) { fprintf(stderr, "kernel_launch: memset of the barrier words failed\n"); return; }
    Params p{};
    const float** pp = (const float**)&p;
    for (int i = 0; i < 25; ++i) pp[i] = (const float*)d_in[i];
    p.out = (float*)d_out; p.ws = (unsigned char*)d_ws; p.repk = REPK; p.repl = REPL;
    void* args[] = {&p};
    hipError_t e = hipLaunchCooperativeKernel((const void*)fwd_kernel, dim3(grid_blocks), dim3(512), args, LDS_BYTES, stream);
    if (e != hipSuccess) fprintf(stderr, "cooperative launch failed: %s (grid %d)\n", hipGetErrorString(e), grid_blocks);
}
```

```cpp
#include <hip/hip_runtime.h>
#include <hip/hip_cooperative_groups.h>
#include <cstdio>
namespace cg = cooperative_groups;
__device__ __forceinline__ int opq_tid() { int t = threadIdx.x; asm volatile("" : "+v"(t)); return t; }
__device__ __forceinline__ int opq_s(int x) { asm volatile("" : "+s"(x)); return x; }
typedef float cvt_f32x2 __attribute__((ext_vector_type(2)));
typedef __bf16 cvt_bf16x2 __attribute__((ext_vector_type(2)));
__device__ __forceinline__ unsigned hw_cvt_pk_bf16(float lo, float hi) { const cvt_f32x2 v = {lo, hi}; return __builtin_bit_cast(unsigned, __builtin_convertvector(v, cvt_bf16x2)); }
namespace pg8 {
#define PG8_LAS __attribute__((address_space(3)))
typedef unsigned short bf16_t;
typedef short bf16x8 __attribute__((ext_vector_type(8)));
typedef float f32x4 __attribute__((ext_vector_type(4)));
typedef unsigned u32x4 __attribute__((ext_vector_type(4)));
constexpr int BM = 256, BK = 64, HALF = 128, HTB = HALF * BK * 2  , STAGE_BYTES = 8 * HTB, NXCD = 8, WGM = 8;

__host__ __device__ __forceinline__ int lds_byte(int r, int c) { const int st = (r >> 4) * 2 + (c >> 5), rr = r & 15, cc = c & 31, ob = rr * 64 + cc * 2; return st * 1024 + (ob ^ (((ob >> 9) & 1) << 5)); }
__host__ __device__ __forceinline__ void stage_rc(int b, int& R, int& C) { const int st = b / 1024, sb = b % 1024, swz = sb ^ (((sb >> 9) & 1) << 5); R = (st >> 1) * 16 + swz / 64; C = (st & 1) * 32 + (swz % 64) / 2; }
__host__ __device__ __forceinline__ int perm32(int rho) { const int n = rho >> 4, i = rho & 15; return 8 * (i >> 2) + 4 * n + (i & 3); }

struct Unit { int pm, pn; };
struct Gemm { const bf16_t* A; const bf16_t* Bt; int M, N, K; };

struct StaticOrder {
    int nM, nN, nwg, G, c;
    __host__ __device__ void init(int M, int N, int G_, int c_) { nM = M / BM; nN = N / BM; nwg = nM * nN; G = G_; c = c_; }
    __host__ __device__ bool next(int i, Unit& u) const {
        const long L = (long)i * G + c; if (L >= nwg) return false;
        int wgid = (int)L; { const int q = nwg / NXCD, r = nwg % NXCD, xcd = wgid % NXCD, off = wgid / NXCD; wgid = (xcd < r ? xcd * (q + 1) : r * (q + 1) + (xcd - r) * q) + off; }
        const int nig = WGM * nN, gid = wgid / nig, fm = gid * WGM, gsz = (nM - fm) < WGM ? (nM - fm) : WGM;
        u.pm = fm + ((wgid % nig) % gsz); u.pn = (wgid % nig) / gsz; return true;
    }
    __device__ __forceinline__ void a_ready(const Unit&) const {}
    __device__ __forceinline__ void done(const Unit&) const {}
};
template <class Epi, class Sched, bool STAMP = false>
__device__ __forceinline__ void gemm_phase(PG8_LAS unsigned char* lds, const Gemm g, const Sched& S, const Epi& E, unsigned long long* stamps) {
    const int tid = opq_tid(), wid = __builtin_amdgcn_readfirstlane(tid >> 6), lane = tid & 63, wr = wid >> 2, wc = wid & 3, fr = lane & 15, fq = lane >> 4;
    const int K = g.K, nt = K / BK;
    int ts_lo = 0, ts_hi = 0, nts = 0; const unsigned long long rt_entry = STAMP ? (unsigned long long)wall_clock64() : 0ull;
#define PG8_STAMP() do { if (STAMP && wid == 0 && nts < 64) { const unsigned long long _c = (unsigned long long)clock64(); \
        ts_lo = (lane == nts) ? (int)(unsigned)_c : ts_lo; ts_hi = (lane == nts) ? (int)(unsigned)(_c >> 32) : ts_hi; ++nts; } } while (0)
    PG8_STAMP();
    unsigned voffA[2], voffB[2];
#pragma unroll
    for (int i = 0; i < 2; ++i) { int R, C; stage_rc(tid * 16 + i * 8192, R, C); const int Rb = Epi::PERM ? ((R & ~31) + perm32(R & 31)) : R;
        voffA[i] = (unsigned)(R * K + C) * 2u; voffB[i] = (unsigned)(Rb * K + C) * 2u; }
    const size_t kstep = (size_t)(BK * 2);
    const size_t hstep = (size_t)HALF * K * 2;
    const size_t tstep = 2 * hstep;
    const unsigned ldsw = (unsigned)wid * 1024u;
    const int aoff = lds_byte(wr * 64 + fr, fq * 8), boff = lds_byte(wc * 32 + fr, fq * 8);
#define PG8_SA(b, h) (((b) * 2 + (h)) * HTB)
#define PG8_SB(b, h) ((4 + (b) * 2 + (h)) * HTB)
#define PG8_STAGE(bufoff, gbase, voff) do { _Pragma("unroll") for (int _i = 0; _i < 2; ++_i) \
        __builtin_amdgcn_global_load_lds((const unsigned*)((const char*)(gbase) + (voff)[_i]), (PG8_LAS unsigned*)(lds + (bufoff) + ldsw + _i * 8192), 16, 0, 0); } while (0)
#define PG8_LDA(dst, b, h) do { _Pragma("unroll") for (int m = 0; m < 4; ++m) _Pragma("unroll") for (int k = 0; k < 2; ++k) dst[m][k] = *(const PG8_LAS bf16x8*)(lds + PG8_SA(b, h) + aoff + m * 2048 + k * 1024); } while (0)
#define PG8_LDB(dst, b, h) do { _Pragma("unroll") for (int n = 0; n < 2; ++n) _Pragma("unroll") for (int k = 0; k < 2; ++k) dst[n][k] = *(const PG8_LAS bf16x8*)(lds + PG8_SB(b, h) + boff + n * 2048 + k * 1024); } while (0)
#define PG8_MMA(ai, bj, At, Bt) do { __builtin_amdgcn_s_setprio(1); _Pragma("unroll") for (int m = 0; m < 4; ++m) _Pragma("unroll") for (int n = 0; n < 2; ++n) _Pragma("unroll") for (int k = 0; k < 2; ++k) \
        acc[ai][bj][m][n] = __builtin_amdgcn_mfma_f32_16x16x32_bf16(Bt[n][k], At[m][k], acc[ai][bj][m][n], 0, 0, 0); __builtin_amdgcn_s_setprio(0); } while (0)
#define PG8_WAIT_V(n) asm volatile("s_waitcnt vmcnt(" #n ")" ::: "memory")
#define PG8_WAIT_L(n) asm volatile("s_waitcnt lgkmcnt(" #n ")" ::: "memory")
#define PG8_BAR __builtin_amdgcn_s_barrier()
#define PG8_SCHED __builtin_amdgcn_sched_barrier(0)
    Unit cur, nxt; int ui = 0;
    if (!S.next(0, cur)) return;
    f32x4 acc[2][2][4][2];
#pragma unroll
    for (int a = 0; a < 2; ++a)
#pragma unroll
        for (int b = 0; b < 2; ++b)
#pragma unroll
            for (int m = 0; m < 4; ++m)
#pragma unroll
                for (int n = 0; n < 2; ++n) acc[a][b][m][n] = (f32x4){0.f, 0.f, 0.f, 0.f};
    bf16x8 At[4][2], B0[2][2], B1[2][2];
    const char* cA = (const char*)g.A + (size_t)cur.pm * tstep; const char* cB = (const char*)g.Bt + (size_t)cur.pn * tstep;
    S.a_ready(cur);
    PG8_STAGE(PG8_SB(0, 0), cB, voffB); PG8_STAGE(PG8_SA(0, 0), cA, voffA); PG8_STAGE(PG8_SB(0, 1), cB + hstep, voffB); PG8_STAGE(PG8_SA(0, 1), cA + hstep, voffA);
    if (wr == 1) PG8_BAR;
    PG8_WAIT_V(4); PG8_BAR;
    PG8_STAGE(PG8_SB(1, 0), cB + kstep, voffB); PG8_STAGE(PG8_SA(1, 0), cA + kstep, voffA); PG8_STAGE(PG8_SB(1, 1), cB + hstep + kstep, voffB);
    PG8_WAIT_V(6); PG8_BAR;
    PG8_STAMP();
    for (;;) {
        const bool has_next = S.next(ui + 1, nxt);
        const char* nA = has_next ? (const char*)g.A + (size_t)nxt.pm * tstep : cA; const char* nB = has_next ? (const char*)g.Bt + (size_t)nxt.pn * tstep : cB;
        for (int t = 0; t < nt; t += 2) {
            const bool last = (t == nt - 2);
            const char* a1 = cA + (size_t)(t + 1) * kstep;
            const char* a2 = last ? nA : cA + (size_t)(t + 2) * kstep; const char* b2 = last ? nB : cB + (size_t)(t + 2) * kstep;
            const char* a3 = a2 + kstep; const char* b3 = b2 + kstep;
            if (last && has_next) S.a_ready(nxt);
            PG8_LDB(B0, 0, 0); PG8_SCHED; PG8_LDA(At, 0, 0); PG8_STAGE(PG8_SA(1, 1), a1 + hstep, voffA);
            PG8_WAIT_L(8); PG8_BAR; PG8_WAIT_L(0); PG8_MMA(0, 0, At, B0); PG8_BAR; PG8_SCHED;
            PG8_LDB(B1, 0, 1); PG8_STAGE(PG8_SB(0, 0), b2, voffB);
            PG8_BAR; PG8_WAIT_L(0); PG8_MMA(0, 1, At, B1); PG8_BAR;
            PG8_LDA(At, 0, 1); PG8_STAGE(PG8_SA(0, 0), a2, voffA);
            PG8_BAR; PG8_WAIT_L(0); PG8_MMA(1, 0, At, B0); PG8_BAR; PG8_SCHED;
            PG8_STAGE(PG8_SB(0, 1), b2 + hstep, voffB);
            PG8_WAIT_V(6); PG8_BAR; PG8_MMA(1, 1, At, B1); PG8_BAR;
            PG8_LDB(B0, 1, 0); PG8_SCHED; PG8_LDA(At, 1, 0); PG8_STAGE(PG8_SA(0, 1), a2 + hstep, voffA);
            PG8_WAIT_L(8); PG8_BAR; PG8_WAIT_L(0); PG8_MMA(0, 0, At, B0); PG8_BAR; PG8_SCHED;
            PG8_LDB(B1, 1, 1); PG8_STAGE(PG8_SB(1, 0), b3, voffB);
            PG8_BAR; PG8_WAIT_L(0); PG8_MMA(0, 1, At, B1); PG8_BAR;
            PG8_LDA(At, 1, 1); PG8_STAGE(PG8_SA(1, 0), a3, voffA);
            PG8_BAR; PG8_WAIT_L(0); PG8_MMA(1, 0, At, B0); PG8_BAR; PG8_SCHED;
            PG8_STAGE(PG8_SB(1, 1), b3 + hstep, voffB);
            PG8_WAIT_V(6); PG8_BAR; PG8_MMA(1, 1, At, B1); PG8_BAR;
        }
        PG8_STAMP();
        if constexpr (!Epi::AFTER_DRAIN) { E(acc, cur, wr, wc, fr, fq); S.done(cur); }
        PG8_STAMP();
        if (!has_next) break;
#pragma unroll
        for (int a = 0; a < 2; ++a)
#pragma unroll
            for (int b = 0; b < 2; ++b)
#pragma unroll
                for (int m = 0; m < 4; ++m)
#pragma unroll
                    for (int n = 0; n < 2; ++n) acc[a][b][m][n] = (f32x4){0.f, 0.f, 0.f, 0.f};
        cur = nxt; cA = nA; cB = nB; ++ui;
    }
    PG8_WAIT_V(0);
    if (wr == 0) PG8_BAR;
    PG8_BAR;
    if constexpr (Epi::AFTER_DRAIN) { E.fused(acc, cur, wr, wc, fr, fq, lds, wid, lane); S.done(cur); }
    PG8_STAMP();
    if (STAMP && wid == 0) { stamps[lane] = lane < nts ? (((unsigned long long)(unsigned)ts_hi << 32) | (unsigned)ts_lo) : 0ull;
        if (lane == 62) stamps[62] = rt_entry; if (lane == 63) stamps[63] = (unsigned long long)wall_clock64(); }
#undef PG8_STAMP
#undef PG8_SA
#undef PG8_SB
#undef PG8_STAGE
#undef PG8_LDA
#undef PG8_LDB
#undef PG8_MMA
#undef PG8_WAIT_V
#undef PG8_WAIT_L
#undef PG8_BAR
#undef PG8_SCHED
}
}

#define XB_TMO      128
#define XB_XCNT(j)  (256  + 64 * (j))
#define XB_XSUB(j)  (1280 + 64 * (j))
#define XB_XGEN(j)  (2304 + 64 * (j))
#define XB_TOP      3328
#define XB_TOPGEN   3392
#define XCD_BAR_WORDS 3456
#define XB_SPIN_CAP (1u << 18)
#define LAS __attribute__((address_space(3)))

__device__ __forceinline__ unsigned xb_ld(unsigned* p)              { return __hip_atomic_load(p, __ATOMIC_RELAXED, __HIP_MEMORY_SCOPE_AGENT); }
__device__ __forceinline__ unsigned xb_add(unsigned* p, unsigned v) { return __hip_atomic_fetch_add(p, v, __ATOMIC_RELAXED, __HIP_MEMORY_SCOPE_AGENT); }
__device__ __forceinline__ unsigned xb_xcc_id() { return (unsigned)__builtin_amdgcn_s_getreg((3 << 11) | 20) & 0xFu; }
#define XB_SPIN(cond, bar) do { unsigned _sp = 0; while (cond) { __builtin_amdgcn_s_sleep(1); \
    if ((++_sp & 255u) == 0u) { if (xb_ld(&(bar)[XB_TMO])) break; if (_sp > XB_SPIN_CAP) { atomicAdd(&(bar)[XB_TMO], 1u); break; } } } } while (0)

struct XcdBarrier {
    unsigned* bar; unsigned x;
    volatile LAS unsigned* st;
};

__device__ __forceinline__ XcdBarrier xcd_barrier_post(unsigned* bar, volatile LAS unsigned* st) {
    XcdBarrier b; b.bar = bar; b.x = xb_xcc_id(); b.st = st;
    if (threadIdx.x == 0) (void)xb_add(&bar[XB_XCNT(b.x)], 1u);
    return b;
}
__device__ __forceinline__ void xcd_barrier_complete(unsigned* bar, unsigned x, unsigned& nloc, unsigned& nx) {
    const unsigned G = gridDim.x * gridDim.y * gridDim.z;
    unsigned sum, cnt, mine, sp = 0u;
    for (;;) {
        sum = 0u; cnt = 0u; mine = 0u;
#pragma unroll
        for (unsigned j = 0; j < 16; ++j) { const unsigned c = xb_ld(&bar[XB_XCNT(j)]); sum += c; cnt += (c > 0u) ? 1u : 0u; mine = (j == x) ? c : mine; }
        if (sum == G) break;
        __builtin_amdgcn_s_sleep(1);
        if ((++sp & 255u) == 0u) { if (xb_ld(&bar[XB_TMO])) break; if (sp > XB_SPIN_CAP) { atomicAdd(&bar[XB_TMO], 1u); break; } }
    }
    nloc = mine > 0u ? mine : 1u; nx = cnt > 0u ? cnt : 1u;
}

__device__ __forceinline__ void xcd_barrier(const XcdBarrier& b) {
    asm volatile("s_waitcnt vmcnt(0)" ::: "memory");
    __syncthreads();
    if (threadIdx.x == 0) {
        unsigned* bar = b.bar;
        __builtin_amdgcn_s_waitcnt(0);
        unsigned nloc = b.st[0], nx = b.st[1];
        if (nloc == 0u) { xcd_barrier_complete(bar, b.x, nloc, nx); b.st[0] = nloc; b.st[1] = nx; }
        const unsigned old = xb_add(&bar[XB_XSUB(b.x)], 1u);
        const unsigned gen = old / nloc;
        if (old + 1u == (gen + 1u) * nloc) {
            __builtin_amdgcn_fence(__ATOMIC_RELEASE, "agent");
            asm volatile("s_waitcnt vmcnt(0)" ::: "memory");
            const unsigned og = xb_add(&bar[XB_TOP], 1u);
            const unsigned tg = og / nx;
            if (og + 1u == (tg + 1u) * nx) xb_add(&bar[XB_TOPGEN], 1u);
            else XB_SPIN(xb_ld(&bar[XB_TOPGEN]) == tg, bar);
            __builtin_amdgcn_fence(__ATOMIC_ACQUIRE, "agent");
            xb_add(&bar[XB_XGEN(b.x)], 1u);
            asm volatile("s_waitcnt vmcnt(0)" ::: "memory");
        } else {
            XB_SPIN(xb_ld(&bar[XB_XGEN(b.x)]) == gen, bar);
            __builtin_amdgcn_fence(__ATOMIC_ACQUIRE, "agent");
            asm volatile("s_waitcnt vmcnt(0)" ::: "memory");
        }
    }
    __syncthreads();
}

typedef unsigned short bf16_t;
typedef short bf16x8 __attribute__((ext_vector_type(8)));
typedef float f32x4 __attribute__((ext_vector_type(4)));
typedef float f32x16 __attribute__((ext_vector_type(16)));

constexpr int DM = 2048, SEQ = 4096, NBP = 2, NBS = 32, TP = NBP * SEQ, MT = TP + NBS, MP = 8448;
constexpr int INW = 6784, INWP = 6912, SHD = 3200, DEPTH = 2;
constexpr size_t NRI = (size_t)MT * 1024;
constexpr int LDS_BYTES = 131072 + 16;
constexpr size_t O_CKP = (size_t)MT * DM;
constexpr size_t O_CVP = O_CKP + (size_t)DEPTH * NBP * 128 * 256;
constexpr size_t O_WKVP = O_CVP + (size_t)DEPTH * NBP * 128 * 256;
constexpr size_t O_SHP = O_WKVP + (size_t)DEPTH * NBP * 16 * 4096;
constexpr size_t O_CKS = O_SHP + (size_t)DEPTH * NBP * SHD;
constexpr size_t O_CVS = O_CKS + (size_t)DEPTH * NBS * 128 * 256;
constexpr size_t O_WKVS = O_CVS + (size_t)DEPTH * NBS * 128 * 256;
constexpr size_t O_SHS = O_WKVS + (size_t)DEPTH * NBS * 16 * 4096;
constexpr size_t O_END = O_SHS + (size_t)DEPTH * NBS * SHD;
constexpr size_t al256(size_t x) { return (x + 255) & ~(size_t)255; }
constexpr size_t WS_WTIN = 0;
constexpr size_t WS_WTOUT = WS_WTIN + (size_t)INWP * DM * 2;
constexpr size_t WS_MOD = WS_WTOUT + (size_t)DEPTH * DM * DM * 2;
constexpr size_t WS_ROPE = WS_MOD + al256((size_t)DEPTH * 34 * 6144 * 4);
constexpr size_t WS_HB = WS_ROPE + al256((size_t)4097 * 16 * 4);
constexpr size_t WS_QB = WS_HB + (size_t)MP * DM * 2;
constexpr size_t WS_KB = WS_QB + (size_t)MP * 1024 * 2;
constexpr size_t WS_VB = WS_KB + (size_t)MP * 256 * 2;
constexpr size_t WS_RW = WS_VB + (size_t)MP * 256 * 2;
constexpr size_t WS_GT = WS_RW + (size_t)MP * SHD * 2;
constexpr size_t WS_RIB = WS_GT + (size_t)MP * DM * 2;
constexpr size_t WS_RIW = WS_RIB + 5 * NRI * 2;
constexpr size_t WS_REC = WS_RIW + NRI * 4;
constexpr size_t WS_COEF = WS_REC + (size_t)32 * 256 * 14592;
constexpr size_t WS_BAR = WS_COEF + al256((size_t)MT * 16 * 4);
constexpr size_t WS_END = WS_BAR + 16384;

struct Params {
    const float *x_prompt, *x_sample, *cache_k, *cache_v, *state_wkv, *state_shift, *c_prompt, *c_sample, *norm_g, *w_ada, *b_ada, *w_in, *mu_shift, *w0, *w_decay, *a0,
        *w_iclr, *k_k, *k_a, *r_k, *ln_w, *ln_b, *sinks, *w_out, *final_g;
    float* out;
    unsigned char* ws;
    int repk, repl;
};
typedef const __attribute__((address_space(4))) Params* KParamsPtr;
__device__ __forceinline__ const Params& kparams() {
    KParamsPtr k = (KParamsPtr)__builtin_amdgcn_kernarg_segment_ptr();
    asm volatile("" : "+s"(k));
    return *(const Params*)k;
}

__device__ __forceinline__ unsigned short f2bf(float f) { return (unsigned short)(hw_cvt_pk_bf16(f, 0.f) & 0xffffu); }
__device__ __forceinline__ float bf2f(unsigned short b) { return __uint_as_float(((unsigned)b) << 16); }
__device__ __forceinline__ unsigned pack2(float lo, float hi) { return hw_cvt_pk_bf16(lo, hi); }
__device__ __forceinline__ float bflo(unsigned w) { return __uint_as_float(w << 16); }
__device__ __forceinline__ float bfhi(unsigned w) { return __uint_as_float(w & 0xffff0000u); }
__device__ __forceinline__ float silu_f(float x) { return x / (1.f + __expf(-x)); }
__device__ __forceinline__ float wave_sum(float x) {
#pragma unroll
    for (int o = 32; o >= 1; o >>= 1) x += __shfl_xor(x, o);
    return x;
}
__device__ __forceinline__ float wave_max(float x) {
#pragma unroll
    for (int o = 32; o >= 1; o >>= 1) x = fmaxf(x, __shfl_xor(x, o));
    return x;
}
template <int CTRL> __device__ __forceinline__ float dpp_f(float x) {
    return __builtin_bit_cast(float, __builtin_amdgcn_update_dpp(0, __builtin_bit_cast(int, x), CTRL, 0xF, 0xF, false));
}
__device__ __forceinline__ float allreduce16(float x) {
    x += dpp_f<0x128>(x);
    x += dpp_f<0x124>(x);
    x += dpp_f<0x122>(x);
    x += dpp_f<0x121>(x);
    return x;
}

__device__ void p0_mod_item(const Params& p, float* red, int l, int nc) {
    const int tid = opq_tid(), wv = tid >> 6, lane = tid & 63, n = lane & 31, kh = lane >> 5;
    f32x16 acc0, acc1;
#pragma unroll
    for (int i = 0; i < 16; ++i) { acc0[i] = 0.f; acc1[i] = 0.f; }
    const float* W = p.w_ada + (size_t)l * DM * 6144 + nc * 32 + n;
#pragma unroll 4
    for (int ks = 0; ks < 16; ++ks) {
        const int k0 = wv * 256 + ks * 16 + kh * 8;
        bf16x8 bfr, a0, a1;
#pragma unroll
        for (int j = 0; j < 8; ++j) bfr[j] = (short)f2bf(W[(size_t)(k0 + j) * 6144]);
        const float4* cs = (const float4*)(p.c_sample + (size_t)n * DM + k0);
        const float4 u0 = cs[0], u1 = cs[1];
        a0[0] = (short)f2bf(silu_f(u0.x)); a0[1] = (short)f2bf(silu_f(u0.y)); a0[2] = (short)f2bf(silu_f(u0.z)); a0[3] = (short)f2bf(silu_f(u0.w));
        a0[4] = (short)f2bf(silu_f(u1.x)); a0[5] = (short)f2bf(silu_f(u1.y)); a0[6] = (short)f2bf(silu_f(u1.z)); a0[7] = (short)f2bf(silu_f(u1.w));
        float4 q0 = make_float4(0.f, 0.f, 0.f, 0.f), q1 = q0;
        if (n < 2) { const float4* cp = (const float4*)(p.c_prompt + (size_t)n * DM + k0); q0 = cp[0]; q1 = cp[1]; }
        a1[0] = (short)f2bf(silu_f(q0.x)); a1[1] = (short)f2bf(silu_f(q0.y)); a1[2] = (short)f2bf(silu_f(q0.z)); a1[3] = (short)f2bf(silu_f(q0.w));
        a1[4] = (short)f2bf(silu_f(q1.x)); a1[5] = (short)f2bf(silu_f(q1.y)); a1[6] = (short)f2bf(silu_f(q1.z)); a1[7] = (short)f2bf(silu_f(q1.w));
        acc0 = __builtin_amdgcn_mfma_f32_32x32x16_bf16(a0, bfr, acc0, 0, 0, 0);
        acc1 = __builtin_amdgcn_mfma_f32_32x32x16_bf16(a1, bfr, acc1, 0, 0, 0);
    }
#pragma unroll
    for (int i = 0; i < 16; ++i) red[(wv * 18 + i) * 64 + lane] = acc0[i];
    red[(wv * 18 + 16) * 64 + lane] = acc1[0];
    red[(wv * 18 + 17) * 64 + lane] = acc1[1];
    __syncthreads();
    float* mod = (float*)(p.ws + WS_MOD);
    for (int o = tid; o < 34 * 32; o += 512) {
        const int row = o >> 5, col = o & 31;
        int ri, ln, mrow;
        if (row < 32) { const int khh = (row >> 2) & 1; ri = (row & 3) + 4 * (row >> 3); ln = col + 32 * khh; mrow = 2 + row; }
        else { ri = 16 + (row - 32); ln = col; mrow = row - 32; }
        float s = 0.f;
#pragma unroll
        for (int w = 0; w < 8; ++w) s += red[(w * 18 + ri) * 64 + ln];
        mod[((size_t)l * 34 + mrow) * 6144 + nc * 32 + col] = s + p.b_ada[l * 6144 + nc * 32 + col];
    }
    __syncthreads();
}

struct ConvIt { const float* src; bf16_t* dst; int N, k0, n0; };
__device__ __forceinline__ ConvIt conv_decode(const Params& p, int cidx, int lw) {
    ConvIt c;
    int kt, nt;
    if (cidx < 1728) { kt = cidx & 15; nt = cidx >> 4; c.N = INW; c.src = p.w_in + (size_t)lw * DM * INW; c.dst = (bf16_t*)(p.ws + WS_WTIN); }
    else { int rem = cidx - 1728; const int l2 = rem >> 9; rem &= 511; kt = rem & 15; nt = rem >> 4; c.N = DM; c.src = p.w_out + (size_t)l2 * DM * DM; c.dst = (bf16_t*)(p.ws + WS_WTOUT) + (size_t)l2 * DM * DM; }
    c.k0 = kt * 128; c.n0 = nt * 64;
    return c;
}
__device__ void p0_conv_all(const Params& p, float* s, int bid, int G, int total, int lw) {
    const int tid = opq_tid();
    const int lrow = tid >> 4, c4 = tid & 15, n = tid >> 3, kg = tid & 7;
    float4 v[4];
    int cidx = bid;
    ConvIt cur = conv_decode(p, cidx < total ? cidx : 0, lw);
    if (cidx < total) {
#pragma unroll
        for (int p4 = 0; p4 < 4; ++p4) { v[p4] = make_float4(0.f, 0.f, 0.f, 0.f); if (cur.n0 < cur.N) v[p4] = *(const float4*)(cur.src + (size_t)(cur.k0 + lrow + 32 * p4) * cur.N + cur.n0 + 4 * c4); }
    }
#pragma unroll 1
    while (cidx < total) {
#pragma unroll
        for (int p4 = 0; p4 < 4; ++p4) { float* d = s + (lrow + 32 * p4) * 65 + 4 * c4; d[0] = v[p4].x; d[1] = v[p4].y; d[2] = v[p4].z; d[3] = v[p4].w; }
        __syncthreads();
        const int nxt = cidx + G;
        const ConvIt nx = conv_decode(p, nxt < total ? nxt : 0, lw);
        if (nxt < total) {
#pragma unroll
            for (int p4 = 0; p4 < 4; ++p4) { v[p4] = make_float4(0.f, 0.f, 0.f, 0.f); if (nx.n0 < nx.N) v[p4] = *(const float4*)(nx.src + (size_t)(nx.k0 + lrow + 32 * p4) * nx.N + nx.n0 + 4 * c4); }
        }
        unsigned w[8];
#pragma unroll
        for (int j = 0; j < 8; ++j) w[j] = pack2(s[(kg * 16 + 2 * j) * 65 + n], s[(kg * 16 + 2 * j + 1) * 65 + n]);
        uint4* o = (uint4*)(cur.dst + (size_t)(cur.n0 + n) * DM + cur.k0 + kg * 16);
        o[0] = make_uint4(w[0], w[1], w[2], w[3]);
        o[1] = make_uint4(w[4], w[5], w[6], w[7]);
        __syncthreads();
        cur = nx; cidx = nxt;
    }
}

__device__ void p0_rope_item(const Params& p, int it) {
    float* rope = (float*)(p.ws + WS_ROPE);
#pragma unroll
    for (int q = 0; q < 4; ++q) {
        const int e = it * 2048 + q * 512 + opq_tid();
        if (e < 4097 * 8) {
            const int idx = e >> 3, i = e & 7;
            double invf = 1.0;
            for (int q = 0; q < i; ++q) invf *= 0.19392274474868576;
            const double pos = idx < 4096 ? (double)idx : 16384.0;
            const double rev = pos * invf * 0.15915494309189535;
            const float f = (float)(rev - floor(rev));
            rope[idx * 16 + i] = __builtin_amdgcn_cosf(f);
            rope[idx * 16 + 8 + i] = __builtin_amdgcn_sinf(f);
        }
    }
}

__device__ void p1_norm(const Params& p, int l, int bid, int G) {
    const int tid = opq_tid(), wv = tid >> 6, lane = tid & 63;
    bf16_t* hb = (bf16_t*)(p.ws + WS_HB);
    const float* mod = (const float*)(p.ws + WS_MOD);
    const float4* g4 = (const float4*)(p.norm_g + l * DM);
    for (int r = bid * 8 + wv; r < MT; r += G * 8) {
        const float* xr = l == 0 ? (r < TP ? p.x_prompt + (size_t)r * DM : p.x_sample + (size_t)(r - TP) * DM) : p.out + (size_t)r * DM;
        const int mrow = r < TP ? (r >> 12) : 2 + (r - TP);
        const float* md = mod + ((size_t)l * 34 + mrow) * 6144;
        float4 v[8]; float ss = 0.f;
#pragma unroll
        for (int i = 0; i < 8; ++i) { v[i] = ((const float4*)xr)[lane + 64 * i]; ss += v[i].x * v[i].x + v[i].y * v[i].y + v[i].z * v[i].z + v[i].w * v[i].w; }
        ss = wave_sum(ss);
        const float rinv = rsqrtf(ss * (1.f / 2048.f) + 1e-5f);
#pragma unroll
        for (int i = 0; i < 8; ++i) {
            const int c4 = lane + 64 * i;
            const float4 g = g4[c4], sc = ((const float4*)(md + 2048))[c4], sh = ((const float4*)md)[c4];
            const float y0 = v[i].x * rinv * g.x * (1.f + sc.x) + sh.x, y1 = v[i].y * rinv * g.y * (1.f + sc.y) + sh.y;
            const float y2 = v[i].z * rinv * g.z * (1.f + sc.z) + sh.z, y3 = v[i].w * rinv * g.w * (1.f + sc.w) + sh.w;
            *(uint2*)(hb + (size_t)r * DM + 4 * c4) = make_uint2(pack2(y0, y1), pack2(y2, y3));
        }
    }
}

struct Epi1 {
    static constexpr bool PERM = false, AFTER_DRAIN = false;
    int l;
    __device__ __forceinline__ void operator()(const f32x4 (&acc)[2][2][4][2], const pg8::Unit& u, int wr, int wc, int fr, int fq) const {
        const Params& p = kparams();
        bf16_t* const qb = (bf16_t*)(p.ws + WS_QB); bf16_t* const kb = (bf16_t*)(p.ws + WS_KB); bf16_t* const vb = (bf16_t*)(p.ws + WS_VB);
        bf16_t* const rw = (bf16_t*)(p.ws + WS_RW); bf16_t* const gt = (bf16_t*)(p.ws + WS_GT); const float* const rope = (const float*)(p.ws + WS_ROPE); float* const out = p.out;
#pragma unroll
        for (int bj = 0; bj < 2; ++bj)
#pragma unroll
            for (int n = 0; n < 2; ++n) {
                const int cb = u.pn * 256 + bj * 128 + wc * 32 + n * 16;
                if (cb >= INW) continue;
                const int c = cb + 4 * fq;
                const bool do_rope = (cb < 1280) && ((cb & 63) == 0);
#pragma unroll
                for (int ai = 0; ai < 2; ++ai)
#pragma unroll
                    for (int m = 0; m < 4; ++m) {
                        const int rb = u.pm * 256 + ai * 128 + wr * 64 + m * 16;
                        if (rb >= MT) continue;
                        const int r = rb + fr;
                        f32x4 v = acc[ai][bj][m][n];
                        if (do_rope) {
                            const int idx = r < TP ? (r & 4095) : 4096;
                            const float4 cs = *(const float4*)(rope + idx * 16 + 4 * (fq & 1));
                            const float4 sn = *(const float4*)(rope + idx * 16 + 8 + 4 * (fq & 1));
                            const float p0 = __shfl_xor(v[0], 32), p1 = __shfl_xor(v[1], 32), p2 = __shfl_xor(v[2], 32), p3 = __shfl_xor(v[3], 32);
                            const float sg = fq < 2 ? -1.f : 1.f;
                            v[0] = v[0] * cs.x + sg * p0 * sn.x; v[1] = v[1] * cs.y + sg * p1 * sn.y; v[2] = v[2] * cs.z + sg * p2 * sn.z; v[3] = v[3] * cs.w + sg * p3 * sn.w;
                        }
                        if (cb < 1024) {
                            *(uint2*)(qb + (size_t)r * 1024 + c) = make_uint2(pack2(v[0] * 0.125f, v[1] * 0.125f), pack2(v[2] * 0.125f, v[3] * 0.125f));
                        } else if (cb < 1536) {
                            const bool isk = cb < 1280;
                            const int cc = c - (isk ? 1024 : 1280);
                            *(uint2*)((isk ? kb : vb) + (size_t)r * 256 + cc) = make_uint2(pack2(v[0], v[1]), pack2(v[2], v[3]));
                            if (r >= TP) {
                                *(f32x4*)(out + (isk ? O_CKS : O_CVS) + ((size_t)(l * NBS + (r - TP)) * 128 + 127) * 256 + cc) = v;
                            } else if ((r & 4095) >= SEQ - 128) {
                                *(f32x4*)(out + (isk ? O_CKP : O_CVP) + ((size_t)(l * NBP + (r >> 12)) * 128 + ((r & 4095) - (SEQ - 128))) * 256 + cc) = v;
                            }
                        } else if (cb < 4736) {
                            const int cc = c - 1536;
                            *(uint2*)(rw + (size_t)r * SHD + cc) = make_uint2(pack2(v[0], v[1]), pack2(v[2], v[3]));
                            if (r >= TP) *(f32x4*)(out + O_SHS + (size_t)(l * NBS + (r - TP)) * SHD + cc) = v;
                            else if ((r & 4095) == SEQ - 1) *(f32x4*)(out + O_SHP + (size_t)(l * NBP + (r >> 12)) * SHD + cc) = v;
                        } else {
                            const int cc = c - 4736;
                            *(uint2*)(gt + (size_t)r * DM + cc) = make_uint2(pack2(silu_f(v[0]), silu_f(v[1])), pack2(silu_f(v[2]), silu_f(v[3])));
                        }
                    }
            }
    }
};

struct Epi2 {
    static constexpr bool PERM = false, AFTER_DRAIN = false;
    int l;
    __device__ __forceinline__ void operator()(const f32x4 (&acc)[2][2][4][2], const pg8::Unit& u, int wr, int wc, int fr, int fq) const {
        const Params& p = kparams();
        const float* const xp = p.x_prompt; const float* const xs = p.x_sample; const float* const modl = (const float*)(p.ws + WS_MOD) + (size_t)l * 34 * 6144; float* const out = p.out;
#pragma unroll
        for (int ai = 0; ai < 2; ++ai)
#pragma unroll
            for (int m = 0; m < 4; ++m) {
                const int rb = u.pm * 256 + ai * 128 + wr * 64 + m * 16;
                if (rb >= MT) continue;
                const int r = rb + fr;
                const int mrow = r < TP ? (r >> 12) : 2 + (r - TP);
                const float* xo = l == 0 ? (r < TP ? xp + (size_t)r * DM : xs + (size_t)(r - TP) * DM) : out + (size_t)r * DM;
                const float* gr = modl + (size_t)mrow * 6144 + 4096;
#pragma unroll
                for (int bj = 0; bj < 2; ++bj)
#pragma unroll
                    for (int n = 0; n < 2; ++n) {
                        const int c = u.pn * 256 + bj * 128 + wc * 32 + n * 16 + 4 * fq;
                        const f32x4 x4 = *(const f32x4*)(xo + c), g4 = *(const f32x4*)(gr + c);
                        *(f32x4*)(out + (size_t)r * DM + c) = x4 + g4 * acc[ai][bj][m][n];
                    }
            }
    }
};

__device__ void g2_sample_item(const Params& p, float* red, int l, int nb) {
    const int tid = opq_tid(), wv = tid >> 6, lane = tid & 63, n = lane & 31, h = lane >> 5;
    const bf16_t* A = (const bf16_t*)(p.ws + WS_HB) + (size_t)TP * DM;
    const bf16_t* Bt = (const bf16_t*)(p.ws + WS_WTOUT) + (size_t)l * DM * DM + (size_t)(nb * 32) * DM;
    f32x16 acc;
#pragma unroll
    for (int i = 0; i < 16; ++i) acc[i] = 0.f;
#pragma unroll 4
    for (int ks = 0; ks < 16; ++ks) {
        const int k0 = wv * 256 + ks * 16 + 8 * h;
        const bf16x8 a = *(const bf16x8*)(A + (size_t)n * DM + k0);
        const bf16x8 bq = *(const bf16x8*)(Bt + (size_t)n * DM + k0);
        acc = __builtin_amdgcn_mfma_f32_32x32x16_bf16(a, bq, acc, 0, 0, 0);
    }
#pragma unroll
    for (int i = 0; i < 16; ++i) red[(wv * 16 + i) * 64 + lane] = acc[i];
    __syncthreads();
    const float* mod = (const float*)(p.ws + WS_MOD) + (size_t)l * 34 * 6144;
    for (int o = tid; o < 1024; o += 512) {
        const int row = o >> 5, col = o & 31, hh = (row >> 2) & 1, ri = (row & 3) + 4 * (row >> 3), ln = col + 32 * hh;
        float s = 0.f;
#pragma unroll
        for (int w = 0; w < 8; ++w) s += red[(w * 16 + ri) * 64 + ln];
        const int c = nb * 32 + col;
        const float gate = mod[(size_t)(2 + row) * 6144 + 4096 + c];
        const float xo = l == 0 ? p.x_sample[(size_t)row * DM + c] : p.out[(size_t)(TP + row) * DM + c];
        p.out[(size_t)(TP + row) * DM + c] = xo + gate * s;
    }
    __syncthreads();
}

__device__ void p3_attn_unit(const Params& p, unsigned char* lds, int l, int unit) {
    const int tid = opq_tid(), wv = tid >> 6, lane = tid & 63;
    const int b = unit >> 7, n = (unit >> 2) & 31, g = unit & 3;
    bf16_t* Ks = (bf16_t*)lds;
    bf16_t* Vt = (bf16_t*)(lds + 36864);
    const bf16_t* qb = (const bf16_t*)(p.ws + WS_QB);
    const bf16_t* kb = (const bf16_t*)(p.ws + WS_KB);
    const bf16_t* vb = (const bf16_t*)(p.ws + WS_VB);
    const bf16_t* gt = (const bf16_t*)(p.ws + WS_GT);
    bf16_t* cc = (bf16_t*)(p.ws + WS_HB);
    {
        uint4 kv4[4], vv4[4];
#pragma unroll
        for (int i = 0; i < 4; ++i) {
            const int chunk = tid + 512 * i, kl = chunk >> 3, dc = chunk & 7, kp = 128 * (n - 1) + kl;
            kv4[i] = make_uint4(0u, 0u, 0u, 0u); vv4[i] = kv4[i];
            if (kp >= 0) { const size_t row = (size_t)b * SEQ + kp; kv4[i] = *(const uint4*)(kb + row * 256 + g * 64 + dc * 8); vv4[i] = *(const uint4*)(vb + row * 256 + g * 64 + dc * 8); }
        }
        __builtin_amdgcn_sched_barrier(0);
#pragma unroll
        for (int i = 0; i < 4; ++i) {
            const int chunk = tid + 512 * i, kl = chunk >> 3, dc = chunk & 7;
            *(uint4*)(Ks + kl * 72 + dc * 8) = kv4[i];
            bf16_t* vd = Vt + (dc * 8) * 264 + kl;
            vd[0 * 264] = (bf16_t)(vv4[i].x & 0xffffu); vd[1 * 264] = (bf16_t)(vv4[i].x >> 16);
            vd[2 * 264] = (bf16_t)(vv4[i].y & 0xffffu); vd[3 * 264] = (bf16_t)(vv4[i].y >> 16);
            vd[4 * 264] = (bf16_t)(vv4[i].z & 0xffffu); vd[5 * 264] = (bf16_t)(vv4[i].z >> 16);
            vd[6 * 264] = (bf16_t)(vv4[i].w & 0xffffu); vd[7 * 264] = (bf16_t)(vv4[i].w >> 16);
        }
    }
    __syncthreads();
    const int hq = 4 * g + (wv >> 1), qh = wv & 1, q32 = lane & 31, h = lane >> 5;
    const float sink = p.sinks[l * 16 + hq];
#pragma unroll 1
    for (int s = 0; s < 2; ++s) {
        const int qp = 128 * n + 64 * qh + 32 * s + q32;
        const size_t qrow = (size_t)b * SEQ + qp;
        const int klb0 = 64 * qh + 32 * s;
        bf16x8 qf[4];
#pragma unroll
        for (int ks = 0; ks < 4; ++ks) qf[ks] = *(const bf16x8*)(qb + qrow * 1024 + hq * 64 + ks * 16 + 8 * h);
        f32x16 S[5];
#pragma unroll
        for (int kt = 0; kt < 5; ++kt) {
#pragma unroll
            for (int i = 0; i < 16; ++i) S[kt][i] = 0.f;
#pragma unroll
            for (int ks = 0; ks < 4; ++ks) {
                const bf16x8 a = *(const bf16x8*)(Ks + (klb0 + 32 * kt + q32) * 72 + ks * 16 + 8 * h);
                S[kt] = __builtin_amdgcn_mfma_f32_32x32x16_bf16(a, qf[ks], S[kt], 0, 0, 0);
            }
        }
        float mx = -1e30f;
#pragma unroll
        for (int kt = 0; kt < 5; ++kt)
#pragma unroll
            for (int i = 0; i < 16; ++i) {
                const int m = 8 * (i >> 2) + 4 * h + (i & 3);
                const int kp = 128 * (n - 1) + klb0 + 32 * kt + m;
                const int rel = qp - kp;
                const bool ok = (rel >= 0) && (rel <= 128) && (kp >= 0);
                const float sv = ok ? S[kt][i] : -1e30f;
                S[kt][i] = sv; mx = fmaxf(mx, sv);
            }
        mx = fmaxf(mx, __shfl_xor(mx, 32));
        mx = fmaxf(mx, sink);
        float sum = 0.f;
#pragma unroll
        for (int kt = 0; kt < 5; ++kt)
#pragma unroll
            for (int i = 0; i < 16; ++i) { const float e = __expf(S[kt][i] - mx); S[kt][i] = e; sum += e; }
        sum += __shfl_xor(sum, 32);
        const float inv = 1.f / (sum + __expf(sink - mx));
        f32x16 O[2];
#pragma unroll
        for (int i = 0; i < 16; ++i) { O[0][i] = 0.f; O[1][i] = 0.f; }
#pragma unroll
        for (int kt = 0; kt < 5; ++kt)
#pragma unroll
            for (int sp = 0; sp < 2; ++sp) {
                bf16x8 pf;
#pragma unroll
                for (int j = 0; j < 8; ++j) pf[j] = (short)f2bf(S[kt][8 * sp + j]);
#pragma unroll
                for (int dt = 0; dt < 2; ++dt) {
                    const bf16_t* vp = Vt + (32 * dt + q32) * 264 + klb0 + 32 * kt + 16 * sp + 4 * h;
                    const uint2 lo = *(const uint2*)vp, hi = *(const uint2*)(vp + 8);
                    const uint4 av = make_uint4(lo.x, lo.y, hi.x, hi.y);
                    O[dt] = __builtin_amdgcn_mfma_f32_32x32x16_bf16(__builtin_bit_cast(bf16x8, av), pf, O[dt], 0, 0, 0);
                }
            }
#pragma unroll
        for (int dt = 0; dt < 2; ++dt)
#pragma unroll
            for (int ig = 0; ig < 4; ++ig) {
                const int col = hq * 64 + 32 * dt + 8 * ig + 4 * h;
                const uint2 gg = *(const uint2*)(gt + qrow * DM + col);
                const float o0 = O[dt][4 * ig + 0] * inv * bflo(gg.x), o1 = O[dt][4 * ig + 1] * inv * bfhi(gg.x);
                const float o2 = O[dt][4 * ig + 2] * inv * bflo(gg.y), o3 = O[dt][4 * ig + 3] * inv * bfhi(gg.y);
                *(uint2*)(cc + qrow * DM + col) = make_uint2(pack2(o0, o1), pack2(o2, o3));
            }
    }
    __syncthreads();
}

__device__ void p3_sattn_item(const Params& p, float* lds, int l, int item) {
    const int tid = opq_tid(), wv = tid >> 6, lane = tid & 63;
    float* pl = lds + wv * 128;
    const int w = item * 8 + wv, bd = w >> 4, hq = w & 15, g = hq >> 2;
    const size_t row = (size_t)TP + bd;
    const bf16_t* qb = (const bf16_t*)(p.ws + WS_QB);
    const bf16_t* gt = (const bf16_t*)(p.ws + WS_GT);
    bf16_t* cc = (bf16_t*)(p.ws + WS_HB);
    float q[64];
#pragma unroll
    for (int c = 0; c < 8; ++c) {
        const uint4 u = *(const uint4*)(qb + row * 1024 + hq * 64 + c * 8);
        q[c * 8 + 0] = bflo(u.x); q[c * 8 + 1] = bfhi(u.x); q[c * 8 + 2] = bflo(u.y); q[c * 8 + 3] = bfhi(u.y);
        q[c * 8 + 4] = bflo(u.z); q[c * 8 + 5] = bfhi(u.z); q[c * 8 + 6] = bflo(u.w); q[c * 8 + 7] = bfhi(u.w);
    }
    const size_t cbase = ((size_t)(l * NBS + bd) * 128) * 256 + g * 64;
    const float* ck = p.cache_k + cbase;
    const float* cv = p.cache_v + cbase;
    float* nk = p.out + O_CKS + cbase;
    float* nv = p.out + O_CVS + cbase;
    float s0 = 0.f, s1 = 0.f, s2 = 0.f;
#pragma unroll
    for (int c = 0; c < 16; ++c) {
        const float4 a = ((const float4*)(ck + (size_t)lane * 256))[c];
        const float4 bq = ((const float4*)(ck + (size_t)(lane + 64) * 256))[c];
        const float4 e = ((const float4*)(nk + (size_t)127 * 256))[c];
        s0 += a.x * q[4 * c] + a.y * q[4 * c + 1] + a.z * q[4 * c + 2] + a.w * q[4 * c + 3];
        s1 += bq.x * q[4 * c] + bq.y * q[4 * c + 1] + bq.z * q[4 * c + 2] + bq.w * q[4 * c + 3];
        s2 += e.x * q[4 * c] + e.y * q[4 * c + 1] + e.z * q[4 * c + 2] + e.w * q[4 * c + 3];
    }
    const float sink = p.sinks[l * 16 + hq];
    const float mx = fmaxf(wave_max(fmaxf(s0, s1)), fmaxf(s2, sink));
    const float p0 = __expf(s0 - mx), p1 = __expf(s1 - mx), p2 = __expf(s2 - mx);
    const float sum = wave_sum(p0 + p1) + p2 + __expf(sink - mx);
    pl[lane] = p0; pl[lane + 64] = p1;
    __builtin_amdgcn_fence(__ATOMIC_RELEASE, "wavefront");
    __builtin_amdgcn_wave_barrier();
    __builtin_amdgcn_fence(__ATOMIC_ACQUIRE, "wavefront");
    float o = 0.f;
#pragma unroll 32
    for (int key = 0; key < 128; ++key) o += pl[key] * cv[(size_t)key * 256 + lane];
    o += p2 * nv[(size_t)127 * 256 + lane];
    o /= sum;
    const float gate = bf2f(gt[row * DM + hq * 64 + lane]);
    cc[row * DM + hq * 64 + lane] = f2bf(o * gate);
    {
        float tk[32], tv[32];
#pragma unroll
        for (int i = 0; i < 32; ++i) {
            const int ww = (hq & 3) + 4 * i;
            tk[i] = ck[(size_t)(ww + 1 < 128 ? ww + 1 : 127) * 256 + lane]; tv[i] = cv[(size_t)(ww + 1 < 128 ? ww + 1 : 127) * 256 + lane];
        }
#pragma unroll
        for (int i = 0; i < 32; ++i) {
            const int ww = (hq & 3) + 4 * i;
            if (ww < 127) { nk[(size_t)ww * 256 + lane] = tk[i]; nv[(size_t)ww * 256 + lane] = tv[i]; }
        }
    }
    __builtin_amdgcn_wave_barrier();
}

__device__ __forceinline__ float mix_val(const bf16_t* rw, const float* sshift, const float* mu, int r, int c) {
    const float cur = bf2f(rw[(size_t)r * SHD + c]);
    float prev;
    if (r >= TP) prev = sshift[(size_t)(r - TP) * SHD + c];
    else if ((r & 4095) == 0) prev = 0.f;
    else prev = bf2f(rw[(size_t)(r - 1) * SHD + c]);
    return cur + (prev - cur) * mu[c];
}

__device__ __forceinline__ float4 mix4(const bf16_t* rw, const float* sshift, int r, int c, float4 mu4) {
    const uint2 cu = *(const uint2*)(rw + (size_t)r * SHD + c);
    const float4 cur = make_float4(bflo(cu.x), bfhi(cu.x), bflo(cu.y), bfhi(cu.y));
    float4 prev = make_float4(0.f, 0.f, 0.f, 0.f);
    if (r >= TP) prev = *(const float4*)(sshift + (size_t)(r - TP) * SHD + c);
    else if ((r & 4095) != 0) { const uint2 pu = *(const uint2*)(rw + (size_t)(r - 1) * SHD + c); prev = make_float4(bflo(pu.x), bfhi(pu.x), bflo(pu.y), bfhi(pu.y)); }
    return make_float4(cur.x + (prev.x - cur.x) * mu4.x, cur.y + (prev.y - cur.y) * mu4.y, cur.z + (prev.z - cur.z) * mu4.z, cur.w + (prev.w - cur.w) * mu4.w);
}
__device__ __forceinline__ float decay_of(float x) {
    const float z = -x;
    const float sp = fmaxf(z, 0.f) + __logf(1.f + __expf(-fabsf(z)));
    return __expf(-__expf(-sp - 0.5f));
}

__device__ void p3_prep_tile(const Params& p, unsigned char* lds, int l, int tile) {
    const int tid = opq_tid(), wv = tid >> 6, lane = tid & 63, n = lane & 31, h = lane >> 5;
    bf16_t* TW = (bf16_t*)lds;
    bf16_t* AD = TW + 32 * 72;
    const bf16_t* rw = (const bf16_t*)(p.ws + WS_RW);
    const float* sshift = p.state_shift + (size_t)l * NBS * SHD;
    const float* mu = p.mu_shift + l * SHD;
    bf16_t* RIB = (bf16_t*)(p.ws + WS_RIB);
    float* RIW = (float*)(p.ws + WS_RIW);
    float* coef = (float*)(p.ws + WS_COEF);
    const int r0 = tile * 32;
    {
        float mm[8];
#pragma unroll
        for (int i = 0; i < 8; ++i) { const int idx = tid + 512 * i, tt = idx >> 7, c2 = idx & 127; mm[i] = mix_val(rw, sshift, mu, r0 + tt, 3072 + c2); }
        __builtin_amdgcn_sched_barrier(0);
#pragma unroll
        for (int i = 0; i < 8; ++i) {
            const int idx = tid + 512 * i, tt = idx >> 7, c2 = idx & 127;
            if (c2 < 64) { const float e = __expf(2.f * mm[i]); TW[tt * 72 + c2] = f2bf(1.f - 2.f / (e + 1.f)); }
            else AD[tt * 72 + (c2 - 64)] = f2bf(mm[i]);
        }
    }
    __syncthreads();
    const int col0 = wv * 128 + 4 * n;
    f32x16 acc[4];
    {
        const float* wp = p.w_decay + (size_t)l * 64 * 1024 + col0;
#pragma unroll
        for (int nt = 0; nt < 4; ++nt)
#pragma unroll
            for (int i = 0; i < 16; ++i) acc[nt][i] = 0.f;
#pragma unroll
        for (int ks = 0; ks < 4; ++ks) {
            const bf16x8 a = *(const bf16x8*)(TW + n * 72 + 16 * ks + 8 * h);
            float4 w4[8];
#pragma unroll
            for (int e = 0; e < 8; ++e) w4[e] = *(const float4*)(wp + (size_t)(16 * ks + 8 * h + e) * 1024);
            bf16x8 b0, b1, b2, b3;
#pragma unroll
            for (int e = 0; e < 8; ++e) { b0[e] = (short)f2bf(w4[e].x); b1[e] = (short)f2bf(w4[e].y); b2[e] = (short)f2bf(w4[e].z); b3[e] = (short)f2bf(w4[e].w); }
            acc[0] = __builtin_amdgcn_mfma_f32_32x32x16_bf16(a, b0, acc[0], 0, 0, 0);
            acc[1] = __builtin_amdgcn_mfma_f32_32x32x16_bf16(a, b1, acc[1], 0, 0, 0);
            acc[2] = __builtin_amdgcn_mfma_f32_32x32x16_bf16(a, b2, acc[2], 0, 0, 0);
            acc[3] = __builtin_amdgcn_mfma_f32_32x32x16_bf16(a, b3, acc[3], 0, 0, 0);
        }
        const float4 w0c = *(const float4*)(p.w0 + l * 1024 + col0);
#pragma unroll
        for (int r = 0; r < 16; ++r) {
            const int row = r0 + 8 * (r >> 2) + 4 * h + (r & 3);
            *(float4*)(RIW + (size_t)row * 1024 + col0) =
                make_float4(decay_of(w0c.x + acc[0][r]), decay_of(w0c.y + acc[1][r]), decay_of(w0c.z + acc[2][r]), decay_of(w0c.w + acc[3][r]));
        }
    }
    {
        const float* wp = p.w_iclr + (size_t)l * 64 * 1024 + col0;
#pragma unroll
        for (int nt = 0; nt < 4; ++nt)
#pragma unroll
            for (int i = 0; i < 16; ++i) acc[nt][i] = 0.f;
#pragma unroll
        for (int ks = 0; ks < 4; ++ks) {
            const bf16x8 a = *(const bf16x8*)(AD + n * 72 + 16 * ks + 8 * h);
            float4 w4[8];
#pragma unroll
            for (int e = 0; e < 8; ++e) w4[e] = *(const float4*)(wp + (size_t)(16 * ks + 8 * h + e) * 1024);
            bf16x8 b0, b1, b2, b3;
#pragma unroll
            for (int e = 0; e < 8; ++e) { b0[e] = (short)f2bf(w4[e].x); b1[e] = (short)f2bf(w4[e].y); b2[e] = (short)f2bf(w4[e].z); b3[e] = (short)f2bf(w4[e].w); }
            acc[0] = __builtin_amdgcn_mfma_f32_32x32x16_bf16(a, b0, acc[0], 0, 0, 0);
            acc[1] = __builtin_amdgcn_mfma_f32_32x32x16_bf16(a, b1, acc[1], 0, 0, 0);
            acc[2] = __builtin_amdgcn_mfma_f32_32x32x16_bf16(a, b2, acc[2], 0, 0, 0);
            acc[3] = __builtin_amdgcn_mfma_f32_32x32x16_bf16(a, b3, acc[3], 0, 0, 0);
        }
    }
    const float4 a0c = *(const float4*)(p.a0 + l * 1024 + col0), kkc = *(const float4*)(p.k_k + l * 1024 + col0), kac = *(const float4*)(p.k_a + l * 1024 + col0), rkc = *(const float4*)(p.r_k + l * 1024 + col0);
    const float4 mur = *(const float4*)(mu + col0), muk = *(const float4*)(mu + 1024 + col0), muv = *(const float4*)(mu + 2048 + col0);
    const int head = 2 * wv + (n >> 4);
#pragma unroll
    for (int r = 0; r < 16; ++r) {
        const int row = r0 + 8 * (r >> 2) + 4 * h + (r & 3);
        const float4 rr = mix4(rw, sshift, row, col0, mur), kr = mix4(rw, sshift, row, 1024 + col0, muk), vr = mix4(rw, sshift, row, 2048 + col0, muv);
        const float ax = 1.f / (1.f + __expf(-(a0c.x + acc[0][r]))), ay = 1.f / (1.f + __expf(-(a0c.y + acc[1][r])));
        const float az = 1.f / (1.f + __expf(-(a0c.z + acc[2][r]))), aw = 1.f / (1.f + __expf(-(a0c.w + acc[3][r])));
        const float k0 = kr.x * kkc.x, k1 = kr.y * kkc.y, k2 = kr.z * kkc.z, k3 = kr.w * kkc.w;
        const float ss = allreduce16(k0 * k0 + k1 * k1 + k2 * k2 + k3 * k3);
        const float inv = 1.f / fmaxf(sqrtf(ss), 1e-12f);
        const float4 kk = make_float4(k0 * inv, k1 * inv, k2 * inv, k3 * inv);
        const float4 ke = make_float4(kr.x * (1.f + (ax - 1.f) * kac.x), kr.y * (1.f + (ay - 1.f) * kac.y), kr.z * (1.f + (az - 1.f) * kac.z), kr.w * (1.f + (aw - 1.f) * kac.w));
        const float cf = allreduce16(rr.x * ke.x * rkc.x + rr.y * ke.y * rkc.y + rr.z * ke.z * rkc.z + rr.w * ke.w * rkc.w);
        if ((n & 15) == 0) coef[(size_t)row * 16 + head] = cf;
        const size_t o = (size_t)row * 1024 + col0;
        *(uint2*)(RIB + o) = make_uint2(pack2(rr.x, rr.y), pack2(rr.z, rr.w));
        *(uint2*)(RIB + NRI + o) = make_uint2(pack2(ke.x, ke.y), pack2(ke.z, ke.w));
        *(uint2*)(RIB + 2 * NRI + o) = make_uint2(pack2(kk.x, kk.y), pack2(kk.z, kk.w));
        *(uint2*)(RIB + 3 * NRI + o) = make_uint2(pack2(kk.x * ax, kk.y * ay), pack2(kk.z * az, kk.w * aw));
        *(uint2*)(RIB + 4 * NRI + o) = make_uint2(pack2(vr.x, vr.y), pack2(vr.z, vr.w));
    }
    __syncthreads();
}

constexpr int REC_BYTES = 14592;
constexpr int PA_WLDS = 16384;
typedef float f32x4v __attribute__((ext_vector_type(4)));

__device__ void pa_chunk(const Params& p, unsigned char* wl, int l, int ct) {
    const int lane = opq_tid() & 63;
    const int hh = ct >> 8, c = ct & 255, b = hh >> 4, h = hh & 15;
    const size_t row0 = (size_t)b * SEQ + 16 * c;
    const int col = h * 64 + lane;
    const bf16_t* RIB = (const bf16_t*)(p.ws + WS_RIB);
    const float* RIW = (const float*)(p.ws + WS_RIW);
    float vv[16];
    float gC;
    bf16_t* S_AB = (bf16_t*)wl; bf16_t* S_BB = S_AB + 16 * 72; bf16_t* S_KB = S_BB + 16 * 72; bf16_t* S_RT = S_KB + 16 * 72;
    {
        unsigned ir[16], ik[16], ikk[16], ib[16], iv[16]; float iw[16];
#pragma unroll
        for (int t = 0; t < 16; ++t) {
            const unsigned idx = (unsigned)(row0 + t) * 1024u + (unsigned)col;
            ir[t] = RIB[idx]; ik[t] = RIB[(unsigned)NRI + idx]; ikk[t] = RIB[2u * (unsigned)NRI + idx]; ib[t] = RIB[3u * (unsigned)NRI + idx]; iv[t] = RIB[4u * (unsigned)NRI + idx]; iw[t] = RIW[idx];
        }
        __builtin_amdgcn_sched_barrier(0);
        float g = 1.f;
#pragma unroll
        for (int t = 0; t < 16; ++t) {
            vv[t] = bf2f((unsigned short)iv[t]);
            S_AB[t * 72 + lane] = f2bf(-g * bf2f((unsigned short)ikk[t]));
            g *= iw[t];
            const float ig = __builtin_amdgcn_rcpf(g);
            S_BB[t * 72 + lane] = f2bf(bf2f((unsigned short)ib[t]) * ig); S_KB[t * 72 + lane] = f2bf(bf2f((unsigned short)ik[t]) * ig); S_RT[t * 72 + lane] = f2bf(g * bf2f((unsigned short)ir[t]));
        }
        gC = g;
    }
    __builtin_amdgcn_fence(__ATOMIC_RELEASE, "wavefront"); __builtin_amdgcn_wave_barrier(); __builtin_amdgcn_fence(__ATOMIC_ACQUIRE, "wavefront");
    f32x4v Gab = {0.f, 0.f, 0.f, 0.f}, Gak = Gab, Grb = Gab, Grk = Gab;
    {
        const int rr = lane & 15, kg = lane >> 4;
#pragma unroll
        for (int ks = 0; ks < 2; ++ks) {
            const int o = rr * 72 + 32 * ks + 8 * kg;
            const bf16x8 fA = *(const bf16x8*)(S_AB + o), fB = *(const bf16x8*)(S_BB + o), fK = *(const bf16x8*)(S_KB + o), fR = *(const bf16x8*)(S_RT + o);
            Gab = __builtin_amdgcn_mfma_f32_16x16x32_bf16(fB, fA, Gab, 0, 0, 0);
            Gak = __builtin_amdgcn_mfma_f32_16x16x32_bf16(fK, fA, Gak, 0, 0, 0);
            Grb = __builtin_amdgcn_mfma_f32_16x16x32_bf16(fB, fR, Grb, 0, 0, 0);
            Grk = __builtin_amdgcn_mfma_f32_16x16x32_bf16(fK, fR, Grk, 0, 0, 0);
        }
    }
    __builtin_amdgcn_fence(__ATOMIC_RELEASE, "wavefront"); __builtin_amdgcn_wave_barrier(); __builtin_amdgcn_fence(__ATOMIC_ACQUIRE, "wavefront");
    float* M_AB = (float*)(wl + 9216); float* M_AK = M_AB + 256; float* M_RB = M_AK + 256; float* M_RK = M_RB + 256; float* T_ = M_RK + 256; float* Q_ = T_ + 256; float* W2_ = Q_ + 256;
    {
        const int t = lane & 15, kg = lane >> 4;
#pragma unroll
        for (int rg = 0; rg < 4; ++rg) {
            const int s = 4 * kg + rg;
            M_AB[s * 16 + t] = s < t ? Gab[rg] : 0.f; M_AK[s * 16 + t] = s < t ? Gak[rg] : 0.f;
            M_RB[s * 16 + t] = s <= t ? Grb[rg] : 0.f; M_RK[s * 16 + t] = s <= t ? Grk[rg] : 0.f;
        }
    }
    __builtin_amdgcn_fence(__ATOMIC_RELEASE, "wavefront"); __builtin_amdgcn_wave_barrier(); __builtin_amdgcn_fence(__ATOMIC_ACQUIRE, "wavefront");
    {
        const int rr = lane & 15;
        float Tr[16];
#pragma unroll
        for (int t = 0; t < 16; ++t) {
            float acc = (rr == t) ? 1.f : 0.f;
#pragma unroll
            for (int s = 0; s < t; ++s) acc += Tr[s] * M_AB[s * 16 + t];
            Tr[t] = acc;
        }
#pragma unroll
        for (int t = 0; t < 16; ++t) T_[rr * 16 + t] = Tr[t];
    }
    __builtin_amdgcn_fence(__ATOMIC_RELEASE, "wavefront"); __builtin_amdgcn_wave_barrier(); __builtin_amdgcn_fence(__ATOMIC_ACQUIRE, "wavefront");
    {
        const int s = lane & 15, tq = lane >> 4;
        float4 q = make_float4(0.f, 0.f, 0.f, 0.f);
#pragma unroll
        for (int u = 0; u < 16; ++u) { const float a = M_AK[s * 16 + u]; const float4 t4 = *(const float4*)(T_ + u * 16 + 4 * tq); q.x += a * t4.x; q.y += a * t4.y; q.z += a * t4.z; q.w += a * t4.w; }
        *(float4*)(Q_ + s * 16 + 4 * tq) = q;
        __builtin_amdgcn_fence(__ATOMIC_RELEASE, "wavefront"); __builtin_amdgcn_wave_barrier(); __builtin_amdgcn_fence(__ATOMIC_ACQUIRE, "wavefront");
        float4 w2 = *(const float4*)(M_RK + s * 16 + 4 * tq);
#pragma unroll
        for (int u = 0; u < 16; ++u) { const float a = Q_[s * 16 + u]; const float4 m4 = *(const float4*)(M_RB + u * 16 + 4 * tq); w2.x += a * m4.x; w2.y += a * m4.y; w2.z += a * m4.z; w2.w += a * m4.w; }
        *(float4*)(W2_ + s * 16 + 4 * tq) = w2;
    }
    __builtin_amdgcn_fence(__ATOMIC_RELEASE, "wavefront"); __builtin_amdgcn_wave_barrier(); __builtin_amdgcn_fence(__ATOMIC_ACQUIRE, "wavefront");
    cvt_f32x2 pt2[8], r22[8], ul2[8], yl2[8];
#pragma unroll
    for (int t = 0; t < 8; ++t) { pt2[t] = (cvt_f32x2){0.f, 0.f}; r22[t] = (cvt_f32x2){bf2f(S_RT[(2 * t) * 72 + lane]), bf2f(S_RT[(2 * t + 1) * 72 + lane])}; ul2[t] = pt2[t]; yl2[t] = pt2[t]; }
#pragma unroll
    for (int s = 0; s < 16; ++s) {
        const float as_ = bf2f(S_AB[s * 72 + lane]), vs_ = vv[s];
        const cvt_f32x2 as2 = {as_, as_}, vs2 = {vs_, vs_};
#pragma unroll
        for (int tq = 0; tq < 4; ++tq) {
            const float4 t4 = *(const float4*)(T_ + s * 16 + 4 * tq), q4 = *(const float4*)(Q_ + s * 16 + 4 * tq), w4 = *(const float4*)(W2_ + s * 16 + 4 * tq);
            pt2[2 * tq] += (cvt_f32x2){t4.x, t4.y} * as2; pt2[2 * tq + 1] += (cvt_f32x2){t4.z, t4.w} * as2;
            ul2[2 * tq] += (cvt_f32x2){q4.x, q4.y} * vs2; ul2[2 * tq + 1] += (cvt_f32x2){q4.z, q4.w} * vs2;
            yl2[2 * tq] += (cvt_f32x2){w4.x, w4.y} * vs2; yl2[2 * tq + 1] += (cvt_f32x2){w4.z, w4.w} * vs2;
        }
        __builtin_amdgcn_sched_barrier(0);
    }
    float pt[16], ul[16], yl[16];
#pragma unroll
    for (int t = 0; t < 8; ++t) { pt[2 * t] = pt2[t].x; pt[2 * t + 1] = pt2[t].y; ul[2 * t] = ul2[t].x; ul[2 * t + 1] = ul2[t].y; yl[2 * t] = yl2[t].x; yl[2 * t + 1] = yl2[t].y; }
#pragma unroll
    for (int s = 0; s < 16; ++s) {
        const cvt_f32x2 ps2 = {pt[s], pt[s]};
#pragma unroll
        for (int tq = 0; tq < 4; ++tq) {
            const float4 m4 = *(const float4*)(M_RB + s * 16 + 4 * tq);
            r22[2 * tq] += (cvt_f32x2){m4.x, m4.y} * ps2; r22[2 * tq + 1] += (cvt_f32x2){m4.z, m4.w} * ps2;
        }
        __builtin_amdgcn_sched_barrier(0);
    }
    float r2[16];
#pragma unroll
    for (int t = 0; t < 8; ++t) { r2[2 * t] = r22[t].x; r2[2 * t + 1] = r22[t].y; }
    unsigned char* rec = p.ws + WS_REC + (size_t)ct * REC_BYTES;
    float* ys = (float*)(p.ws + WS_RW);
    {
        const int jj = lane & 15, fo = (((lane >> 4) * 2 + ((jj >> 2) & 1)) * 16) * 16 + ((jj & 3) + 4 * (jj >> 3)) * 2;
#pragma unroll
        for (int t = 0; t < 16; ++t) {
            *(bf16_t*)(rec + fo + t * 16) = f2bf(pt[t]);
            *(bf16_t*)(rec + 2048 + fo + t * 16) = f2bf(r2[t]);
            ys[(unsigned)(row0 + t) * 1024u + (unsigned)col] = yl[t];
        }
    }
    {
        float gb[16], gk[16];
#pragma unroll
        for (int t = 0; t < 16; ++t) { gb[t] = gC * bf2f(S_BB[t * 72 + lane]); gk[t] = gC * bf2f(S_KB[t * 72 + lane]); }
        *(uint4*)(rec + 4096 + lane * 16) = make_uint4(pack2(gb[0], gb[1]), pack2(gb[2], gb[3]), pack2(gb[8], gb[9]), pack2(gb[10], gb[11]));
        *(uint4*)(rec + 4096 + (64 + lane) * 16) = make_uint4(pack2(gb[4], gb[5]), pack2(gb[6], gb[7]), pack2(gb[12], gb[13]), pack2(gb[14], gb[15]));
        *(uint4*)(rec + 6144 + lane * 16) = make_uint4(pack2(gk[0], gk[1]), pack2(gk[2], gk[3]), pack2(gk[4], gk[5]), pack2(gk[6], gk[7]));
        *(uint4*)(rec + 6144 + (64 + lane) * 16) = make_uint4(pack2(gk[8], gk[9]), pack2(gk[10], gk[11]), pack2(gk[12], gk[13]), pack2(gk[14], gk[15]));
        *(float*)(rec + 8192 + lane * 4) = gC;
        unsigned char* ip = rec + 8448 + (lane >> 5) * 3072;
        const int il = lane & 31;
        *(uint4*)(ip + il * 16) = make_uint4(pack2(vv[0], vv[1]), pack2(vv[2], vv[3]), pack2(vv[4], vv[5]), pack2(vv[6], vv[7]));
        *(uint4*)(ip + (32 + il) * 16) = make_uint4(pack2(vv[8], vv[9]), pack2(vv[10], vv[11]), pack2(vv[12], vv[13]), pack2(vv[14], vv[15]));
#pragma unroll
        for (int tq = 0; tq < 4; ++tq) *(float4*)(ip + 1024 + (((tq >> 1) * 2 + (tq & 1)) * 32 + il) * 16) = make_float4(ul[4 * tq], ul[4 * tq + 1], ul[4 * tq + 2], ul[4 * tq + 3]);
    }
    __builtin_amdgcn_fence(__ATOMIC_RELEASE, "wavefront"); __builtin_amdgcn_wave_barrier();
}

__device__ void pa_sample_task(const Params& p, int l, int task) {
    const int lane = opq_tid() & 63;
    const int bd = task >> 8, h = (task >> 4) & 15, wq = task & 15;
    const int irow = 4 * wq + (lane >> 4), jq = lane & 15;
    const size_t row = (size_t)TP + bd;
    const bf16_t* RIB = (const bf16_t*)(p.ws + WS_RIB);
    const float* RIW = (const float*)(p.ws + WS_RIW);
    float* ys = (float*)(p.ws + WS_RW);
    const size_t so = (((size_t)(l * NBS + bd) * 16 + h) * 64 + irow) * 64 + 4 * jq;
    float4 s = *(const float4*)(p.state_wkv + so);
    const size_t o = row * 1024 + h * 64 + 4 * jq;
    const uint2 ur = *(const uint2*)(RIB + o), uk = *(const uint2*)(RIB + NRI + o), ukk = *(const uint2*)(RIB + 2 * NRI + o), ub = *(const uint2*)(RIB + 3 * NRI + o);
    const float4 w4 = *(const float4*)(RIW + o);
    const float v = bf2f(RIB[4 * NRI + row * 1024 + h * 64 + irow]);
    float pa = s.x * bflo(ukk.x) + s.y * bfhi(ukk.x) + s.z * bflo(ukk.y) + s.w * bfhi(ukk.y);
    pa = allreduce16(pa);
    const float sa = -pa;
    s.x = fmaf(sa, bflo(ub.x), fmaf(s.x, w4.x, v * bflo(uk.x)));
    s.y = fmaf(sa, bfhi(ub.x), fmaf(s.y, w4.y, v * bfhi(uk.x)));
    s.z = fmaf(sa, bflo(ub.y), fmaf(s.z, w4.z, v * bflo(uk.y)));
    s.w = fmaf(sa, bfhi(ub.y), fmaf(s.w, w4.w, v * bfhi(uk.y)));
    float py = s.x * bflo(ur.x) + s.y * bfhi(ur.x) + s.z * bflo(ur.y) + s.w * bfhi(ur.y);
    py = allreduce16(py);
    *(float4*)(p.out + O_WKVS + so) = s;
    if (jq == 0) ys[row * 1024 + h * 64 + irow] = py;
}

constexpr int PB_NB = 8, PB_SLOT = 13568, PB_NCH = SEQ / 16;
__device__ void pb_head(const Params& p, unsigned char* lds, int l, int blk, bool dry) {
    const int tid = opq_tid(), wv = tid >> 6, lane = tid & 63;
    const int hh = blk >> 1, it = blk & 1, b = hh >> 4, h = hh & 15;
    volatile LAS unsigned* flags = (volatile LAS unsigned*)((LAS unsigned char*)lds + PB_NB * PB_SLOT);
    if (tid <= PB_NB) flags[tid] = 0u;
    __syncthreads();
    const unsigned char* rec0 = p.ws + WS_REC + (size_t)(hh * 256) * REC_BYTES;
    float* ys = (float*)(p.ws + WS_RW) + ((size_t)b * SEQ) * 1024 + h * 64 + 32 * it;
    if (wv >= 1) {
#pragma unroll 1
        for (int c = wv - 1; c < PB_NCH; c += 7) {
            while (c - (int)flags[PB_NB] >= PB_NB) __builtin_amdgcn_s_sleep(1);
            asm volatile("" ::: "memory");
            const unsigned char* rec = rec0 + (size_t)c * REC_BYTES;
            unsigned char* sl = lds + (c % PB_NB) * PB_SLOT;
            const unsigned char* rc = rec + lane * 16;
            const unsigned char* ri = rec + 8448 + it * 3072 + lane * 16;
            const uint4 d0 = *(const uint4*)(rc), d1 = *(const uint4*)(rc + 1024), d2 = *(const uint4*)(rc + 2048), d3 = *(const uint4*)(rc + 3072);
            const uint4 d4 = *(const uint4*)(rc + 4096), d5 = *(const uint4*)(rc + 5120), d6 = *(const uint4*)(rc + 6144), d7 = *(const uint4*)(rc + 7168);
            const uint4 d8 = *(const uint4*)(rec + 8192 + (lane & 15) * 16);
            const uint4 d9 = *(const uint4*)(ri), d10 = *(const uint4*)(ri + 1024), d11 = *(const uint4*)(ri + 2048);
            const int t0 = lane >> 3, cc = lane & 7;
            const uint4 d12 = *(const uint4*)(ys + (size_t)(16 * c + t0) * 1024 + cc * 4), d13 = *(const uint4*)(ys + (size_t)(16 * c + 8 + t0) * 1024 + cc * 4);
            __builtin_amdgcn_sched_barrier(0);
            unsigned char* sd = sl + lane * 16;
            *(uint4*)(sd) = d0; *(uint4*)(sd + 1024) = d1; *(uint4*)(sd + 2048) = d2; *(uint4*)(sd + 3072) = d3;
            *(uint4*)(sd + 4096) = d4; *(uint4*)(sd + 5120) = d5; *(uint4*)(sd + 6144) = d6; *(uint4*)(sd + 7168) = d7;
            if (lane < 16) *(uint4*)(sl + 8192 + lane * 16) = d8;
            *(uint4*)(sd + 8448) = d9; *(uint4*)(sd + 9472) = d10; *(uint4*)(sd + 10496) = d11;
            {
                float* yd = (float*)(sl + 11520) + ((((t0 >> 2) & 1) * 32 + 4 * cc) * 4 + (t0 & 3));
                yd[0] = __uint_as_float(d12.x); yd[4] = __uint_as_float(d12.y); yd[8] = __uint_as_float(d12.z); yd[12] = __uint_as_float(d12.w);
                yd[256] = __uint_as_float(d13.x); yd[260] = __uint_as_float(d13.y); yd[264] = __uint_as_float(d13.z); yd[268] = __uint_as_float(d13.w);
            }
            asm volatile("s_waitcnt lgkmcnt(0)" ::: "memory");
            if (lane == 0) flags[c % PB_NB] = (unsigned)(c + 1);
        }
    } else {
        const int q32 = lane & 31, hf = lane >> 5;
        f32x16 X0, X1;
#pragma unroll
        for (int i = 0; i < 16; ++i) { X0[i] = 0.f; X1[i] = 0.f; }
#pragma unroll 1
        for (int c = 0; c < PB_NCH; ++c) {
            const unsigned char* sl = lds + (c % PB_NB) * PB_SLOT;
            while (flags[c % PB_NB] != (unsigned)(c + 1)) __builtin_amdgcn_s_sleep(0);
            asm volatile("" ::: "memory");
            bf16x8 xb[4];
            xb[0] = __builtin_bit_cast(bf16x8, make_uint4(pack2(X0[0], X0[1]), pack2(X0[2], X0[3]), pack2(X0[4], X0[5]), pack2(X0[6], X0[7])));
            xb[1] = __builtin_bit_cast(bf16x8, make_uint4(pack2(X0[8], X0[9]), pack2(X0[10], X0[11]), pack2(X0[12], X0[13]), pack2(X0[14], X0[15])));
            xb[2] = __builtin_bit_cast(bf16x8, make_uint4(pack2(X1[0], X1[1]), pack2(X1[2], X1[3]), pack2(X1[4], X1[5]), pack2(X1[6], X1[7])));
            xb[3] = __builtin_bit_cast(bf16x8, make_uint4(pack2(X1[8], X1[9]), pack2(X1[10], X1[11]), pack2(X1[12], X1[13]), pack2(X1[14], X1[15])));
            f32x16 Ua, Ub, Ya, Yb;
            {
                const float4 u0 = *(const float4*)(sl + 9472 + (hf * 32 + q32) * 16), u1 = *(const float4*)(sl + 9472 + ((2 + hf) * 32 + q32) * 16);
                const float4 y0 = *(const float4*)(sl + 11520 + (hf * 32 + q32) * 16), y1 = *(const float4*)(sl + 11520 + ((2 + hf) * 32 + q32) * 16);
                Ua[0] = u0.x; Ua[1] = u0.y; Ua[2] = u0.z; Ua[3] = u0.w; Ua[4] = u1.x; Ua[5] = u1.y; Ua[6] = u1.z; Ua[7] = u1.w;
                Ya[0] = y0.x; Ya[1] = y0.y; Ya[2] = y0.z; Ya[3] = y0.w; Ya[4] = y1.x; Ya[5] = y1.y; Ya[6] = y1.z; Ya[7] = y1.w;
            }
#pragma unroll
            for (int r = 8; r < 16; ++r) { Ua[r] = 0.f; Ya[r] = 0.f; }
#pragma unroll
            for (int r = 0; r < 16; ++r) { Ub[r] = 0.f; Yb[r] = 0.f; }
#pragma unroll
            for (int f = 0; f < 4; ++f) {
                const unsigned char* pr = sl + ((f * 2 + hf) * 16 + (q32 & 15)) * 16;
                const bf16x8 pa = *(const bf16x8*)pr;
                const bf16x8 ra = *(const bf16x8*)(pr + 2048);
                if (f & 1) { Ub = __builtin_amdgcn_mfma_f32_32x32x16_bf16(pa, xb[f], Ub, 0, 0, 0); Yb = __builtin_amdgcn_mfma_f32_32x32x16_bf16(ra, xb[f], Yb, 0, 0, 0); }
                else { Ua = __builtin_amdgcn_mfma_f32_32x32x16_bf16(pa, xb[f], Ua, 0, 0, 0); Ya = __builtin_amdgcn_mfma_f32_32x32x16_bf16(ra, xb[f], Ya, 0, 0, 0); }
            }
            const bf16x8 ub = __builtin_bit_cast(bf16x8, make_uint4(pack2(Ua[0] + Ub[0], Ua[1] + Ub[1]), pack2(Ua[2] + Ub[2], Ua[3] + Ub[3]), pack2(Ua[4] + Ub[4], Ua[5] + Ub[5]), pack2(Ua[6] + Ub[6], Ua[7] + Ub[7])));
#pragma unroll
            for (int r = 0; r < 8; ++r) {
                const int t = 8 * (r >> 2) + 4 * hf + (r & 3);
                if (!dry) ys[(size_t)(16 * c + t) * 1024 + q32] = Ya[r] + Yb[r];
            }
            const bf16x8 vf = *(const bf16x8*)(sl + 8448 + (hf * 32 + q32) * 16);
#pragma unroll
            for (int jt = 0; jt < 2; ++jt) {
                f32x16 Xn;
#pragma unroll
                for (int g = 0; g < 4; ++g) {
                    const float4 gm = *(const float4*)(sl + 8192 + (32 * jt + 8 * g + 4 * hf) * 4);
                    if (jt == 0) { Xn[4 * g + 0] = X0[4 * g + 0] * gm.x; Xn[4 * g + 1] = X0[4 * g + 1] * gm.y; Xn[4 * g + 2] = X0[4 * g + 2] * gm.z; Xn[4 * g + 3] = X0[4 * g + 3] * gm.w; }
                    else { Xn[4 * g + 0] = X1[4 * g + 0] * gm.x; Xn[4 * g + 1] = X1[4 * g + 1] * gm.y; Xn[4 * g + 2] = X1[4 * g + 2] * gm.z; Xn[4 * g + 3] = X1[4 * g + 3] * gm.w; }
                }
                const int j = 32 * jt + q32;
                const bf16x8 gk = *(const bf16x8*)(sl + 6144 + (hf * 64 + j) * 16);
                const bf16x8 gb = *(const bf16x8*)(sl + 4096 + (hf * 64 + j) * 16);
                Xn = __builtin_amdgcn_mfma_f32_32x32x16_bf16(gk, vf, Xn, 0, 0, 0);
                Xn = __builtin_amdgcn_mfma_f32_32x32x16_bf16(gb, ub, Xn, 0, 0, 0);
                if (jt == 0) X0 = Xn; else X1 = Xn;
            }
            asm volatile("s_waitcnt lgkmcnt(0)" ::: "memory");
            if (lane == 0) flags[PB_NB] = (unsigned)(c + 1);
        }
        float* so = p.out + O_WKVP + ((size_t)(l * NBP + b) * 16 + h) * 4096 + (size_t)(32 * it + q32) * 64;
#pragma unroll
        for (int g = 0; g < 4; ++g) {
            *(float4*)(so + 8 * g + 4 * hf) = make_float4(X0[4 * g], X0[4 * g + 1], X0[4 * g + 2], X0[4 * g + 3]);
            *(float4*)(so + 32 + 8 * g + 4 * hf) = make_float4(X1[4 * g], X1[4 * g + 1], X1[4 * g + 2], X1[4 * g + 3]);
        }
    }
    __syncthreads();
}

__device__ void p3_post(const Params& p, int l, int bid, int G) {
    const int tid = opq_tid(), wv = tid >> 6, lane = tid & 63;
    const float* ys = (const float*)(p.ws + WS_RW);
    const bf16_t* V = (const bf16_t*)(p.ws + WS_RIB) + 4 * NRI;
    const float* coef = (const float*)(p.ws + WS_COEF);
    const bf16_t* gt = (const bf16_t*)(p.ws + WS_GT);
    bf16_t* cc = (bf16_t*)(p.ws + WS_HB);
    for (int r = bid * 8 + wv; r < MT; r += G * 8) {
#pragma unroll
        for (int hg = 0; hg < 4; ++hg) {
            const int head = 4 * hg + (lane >> 4), c = head * 64 + 4 * (lane & 15);
            const float4 y = *(const float4*)(ys + (size_t)r * 1024 + c);
            const float mu = allreduce16(y.x + y.y + y.z + y.w) * (1.f / 64.f);
            const float d0 = y.x - mu, d1 = y.y - mu, d2 = y.z - mu, d3 = y.w - mu;
            const float var = allreduce16(d0 * d0 + d1 * d1 + d2 * d2 + d3 * d3) * (1.f / 64.f);
            const float rs = rsqrtf(var + 64e-5f);
            const float4 lw = *(const float4*)(p.ln_w + l * 1024 + c), lb = *(const float4*)(p.ln_b + l * 1024 + c);
            const uint2 vu = *(const uint2*)(V + (size_t)r * 1024 + c);
            const float4 v4 = make_float4(bflo(vu.x), bfhi(vu.x), bflo(vu.y), bfhi(vu.y));
            const float cf = coef[(size_t)r * 16 + head];
            const uint2 gg = *(const uint2*)(gt + (size_t)r * DM + 1024 + c);
            const float o0 = (d0 * rs * lw.x + lb.x + cf * v4.x) * bflo(gg.x), o1 = (d1 * rs * lw.y + lb.y + cf * v4.y) * bfhi(gg.x);
            const float o2 = (d2 * rs * lw.z + lb.z + cf * v4.z) * bflo(gg.y), o3 = (d3 * rs * lw.w + lb.w + cf * v4.w) * bfhi(gg.y);
            *(uint2*)(cc + (size_t)r * DM + 1024 + c) = make_uint2(pack2(o0, o1), pack2(o2, o3));
        }
    }
}

__device__ void p_final(const Params& p, int bid, int G) {
    const int tid = opq_tid(), wv = tid >> 6, lane = tid & 63;
    const float4* g4 = (const float4*)p.final_g;
    for (int r = bid * 8 + wv; r < MT; r += G * 8) {
        float4* xr = (float4*)(p.out + (size_t)r * DM);
        float4 v[8]; float ss = 0.f;
#pragma unroll
        for (int i = 0; i < 8; ++i) { v[i] = xr[lane + 64 * i]; ss += v[i].x * v[i].x + v[i].y * v[i].y + v[i].z * v[i].z + v[i].w * v[i].w; }
        ss = wave_sum(ss);
        const float rinv = rsqrtf(ss * (1.f / 2048.f) + 1e-5f);
#pragma unroll
        for (int i = 0; i < 8; ++i) { const float4 g = g4[lane + 64 * i]; xr[lane + 64 * i] = make_float4(v[i].x * rinv * g.x, v[i].y * rinv * g.y, v[i].z * rinv * g.z, v[i].w * rinv * g.w); }
    }
}

#ifndef REPL
#define REPL -1
#endif
#ifndef REPK
#define REPK -100
#endif
__global__ void __launch_bounds__(512, 2) fwd_kernel(Params p_unused) {
    extern __shared__ __attribute__((aligned(16))) unsigned char shm[];
    cg::grid_group grid = cg::this_grid();
    const int bid0 = blockIdx.x, G0 = gridDim.x;
    float* shf = (float*)shm;
    volatile LAS unsigned* xst = (volatile LAS unsigned*)((LAS unsigned char*)shm + 131072);
    if (threadIdx.x == 0) { xst[0] = 0u; xst[1] = 0u; }
    __syncthreads();
    const XcdBarrier xb = xcd_barrier_post((unsigned*)(kparams().ws + WS_BAR), xst);
    if (G0 == 0x7fffffff) grid.sync();

#pragma unroll 1
    for (int ph = 0; ph < 16; ++ph) {
        const int bid = opq_s(bid0), G = opq_s(G0);
        const int l = ph >= 8 ? 1 : 0, k = ph == 0 ? -1 : (ph == 15 ? 7 : (ph - 1) - 7 * l);
#pragma unroll 1
        for (int rep = 0; rep < ((k == kparams().repk && (kparams().repl < 0 || kparams().repl == l)) ? 2 : 1); ++rep) {
        if (k == -1) {
            for (int it = bid; it < 384; it += G) p0_mod_item(kparams(), shf, it / 192, it % 192);
            for (int it = bid; it < 17; it += G) p0_rope_item(kparams(), it);
            p0_conv_all(kparams(), shf, bid, G, 2752, 0);
        } else if (k == 0) {
            p1_norm(kparams(), l, bid, G);
        } else if (k == 1) {
            pg8::StaticOrder S; S.init(MP, INWP, G, bid);
            pg8::Gemm g{(const bf16_t*)(kparams().ws + WS_HB), (const bf16_t*)(kparams().ws + WS_WTIN), MP, INWP, DM};
            Epi1 E{l};
            pg8::gemm_phase<Epi1, pg8::StaticOrder, false>((PG8_LAS unsigned char*)shm, g, S, E, nullptr);
        } else if (k == 2) {
            for (int it = bid; it < 256 + 64 + 257; it += G) {
                if (it < 256) p3_attn_unit(kparams(), shm, l, it);
                else if (it < 320) p3_sattn_item(kparams(), shf, l, it - 256);
                else p3_prep_tile(kparams(), shm, l, it - 320);
            }
        } else if (k == 3) {
            const int wvq = opq_tid() >> 6, gw = bid * 8 + wvq, nw = G * 8;
            for (int ct = gw; ct < 32 * 256; ct += nw) pa_chunk(kparams(), shm + wvq * PA_WLDS, l, ct);
            for (int task = gw; task < NBS * 256; task += nw) pa_sample_task(kparams(), l, task);
        } else if (k == 4) {
            if (bid < 64) pb_head(kparams(), shm, l, bid, rep == 0 && k == kparams().repk);
            else if (l == 0) p0_conv_all(kparams(), shf, bid - 64, G - 64, 1728, 1);
        } else if (k == 5) {
            p3_post(kparams(), l, bid, G);
        } else if (k == 6) {
            pg8::StaticOrder S; S.init(TP, DM, G, bid);
            pg8::Gemm g{(const bf16_t*)(kparams().ws + WS_HB), (const bf16_t*)(kparams().ws + WS_WTOUT) + (size_t)l * DM * DM, TP, DM, DM};
            Epi2 E{l};
            pg8::gemm_phase<Epi2, pg8::StaticOrder, false>((PG8_LAS unsigned char*)shm, g, S, E, nullptr);
            for (int nb = bid; nb < 64; nb += G) g2_sample_item(kparams(), shf, l, nb);
        } else {
            p_final(kparams(), bid, G);
        }
        if (ph < 15) xcd_barrier(xb);
        }
    }
}

extern "C" void kernel_launch(void* const* d_in, const int* in_sizes, int n_in, void* d_out, int out_size, void* d_ws, size_t ws_size, hipStream_t stream) {
    static int grid_blocks = 0;
    if (grid_blocks == 0) {
        if (n_in != 25 || (size_t)out_size != O_END || ws_size < WS_END) {
            fprintf(stderr, "kernel_launch: unexpected shapes: n_in %d out_size %d ws_size %zu (need %zu)\n", n_in, out_size, ws_size, (size_t)WS_END);
            grid_blocks = -1; return;
        }
        if (hipFuncSetAttribute((const void*)fwd_kernel, hipFuncAttributeMaxDynamicSharedMemorySize, LDS_BYTES) != hipSuccess) { fprintf(stderr, "kernel_launch: hipFuncSetAttribute failed\n"); grid_blocks = -1; return; }
        int dev = 0, cus = 0, per_cu = 0;
        hipGetDevice(&dev);
        hipDeviceGetAttribute(&cus, hipDeviceAttributeMultiprocessorCount, dev);
        hipOccupancyMaxActiveBlocksPerMultiprocessor(&per_cu, (const void*)fwd_kernel, 512, LDS_BYTES);
        if (per_cu < 1) { fprintf(stderr, "kernel_launch: occupancy query gives %d blocks per CU\n", per_cu); per_cu = 1; }
        (void)hipGetLastError();
        grid_blocks = cus;
        if (grid_blocks < 192) { fprintf(stderr, "kernel_launch: only %d CUs\n", grid_blocks); grid_blocks = -1; return; }
    }
    if (grid_blocks < 0) return;
    if (hipMemsetAsync((unsigned char*)d_ws + WS_BAR, 0, 16384, stream) != hipSuccess) { fprintf(stderr, "kernel_launch: memset of the barrier words failed\n"); return; }
    Params p{};
    const float** pp = (const float**)&p;
    for (int i = 0; i < 25; ++i) pp[i] = (const float*)d_in[i];
    p.out = (float*)d_out; p.ws = (unsigned char*)d_ws; p.repk = REPK; p.repl = REPL;
    void* args[] = {&p};
    hipError_t e = hipLaunchCooperativeKernel((const void*)fwd_kernel, dim3(grid_blocks), dim3(512), args, LDS_BYTES, stream);
    if (e != hipSuccess) fprintf(stderr, "cooperative launch failed: %s (grid %d)\n", hipGetErrorString(e), grid_blocks);
}
```

```cpp
#include <hip/hip_runtime.h>
#include <hip/hip_cooperative_groups.h>
#include <cstdio>
namespace cg = cooperative_groups;
__device__ __forceinline__ int opq_tid() { int t = threadIdx.x; asm volatile("" : "+v"(t)); return t; }
__device__ __forceinline__ int opq_s(int x) { asm volatile("" : "+s"(x)); return x; }
typedef float cvt_f32x2 __attribute__((ext_vector_type(2)));
typedef __bf16 cvt_bf16x2 __attribute__((ext_vector_type(2)));
__device__ __forceinline__ unsigned hw_cvt_pk_bf16(float lo, float hi) { const cvt_f32x2 v = {lo, hi}; return __builtin_bit_cast(unsigned, __builtin_convertvector(v, cvt_bf16x2)); }
namespace pg8 {
#define PG8_LAS __attribute__((address_space(3)))
typedef unsigned short bf16_t;
typedef short bf16x8 __attribute__((ext_vector_type(8)));
typedef float f32x4 __attribute__((ext_vector_type(4)));
typedef unsigned u32x4 __attribute__((ext_vector_type(4)));
constexpr int BM = 256, BK = 64, HALF = 128, HTB = HALF * BK * 2  , STAGE_BYTES = 8 * HTB, NXCD = 8, WGM = 8;

__host__ __device__ __forceinline__ int lds_byte(int r, int c) { const int st = (r >> 4) * 2 + (c >> 5), rr = r & 15, cc = c & 31, ob = rr * 64 + cc * 2; return st * 1024 + (ob ^ (((ob >> 9) & 1) << 5)); }
__host__ __device__ __forceinline__ void stage_rc(int b, int& R, int& C) { const int st = b / 1024, sb = b % 1024, swz = sb ^ (((sb >> 9) & 1) << 5); R = (st >> 1) * 16 + swz / 64; C = (st & 1) * 32 + (swz % 64) / 2; }
__host__ __device__ __forceinline__ int perm32(int rho) { const int n = rho >> 4, i = rho & 15; return 8 * (i >> 2) + 4 * n + (i & 3); }

struct Unit { int pm, pn; };
struct Gemm { const bf16_t* A; const bf16_t* Bt; int M, N, K; };

struct StaticOrder {
    int nM, nN, nwg, G, c;
    __host__ __device__ void init(int M, int N, int G_, int c_) { nM = M / BM; nN = N / BM; nwg = nM * nN; G = G_; c = c_; }
    __host__ __device__ bool next(int i, Unit& u) const {
        const long L = (long)i * G + c; if (L >= nwg) return false;
        int wgid = (int)L; { const int q = nwg / NXCD, r = nwg % NXCD, xcd = wgid % NXCD, off = wgid / NXCD; wgid = (xcd < r ? xcd * (q + 1) : r * (q + 1) + (xcd - r) * q) + off; }
        const int nig = WGM * nN, gid = wgid / nig, fm = gid * WGM, gsz = (nM - fm) < WGM ? (nM - fm) : WGM;
        u.pm = fm + ((wgid % nig) % gsz); u.pn = (wgid % nig) / gsz; return true;
    }
    __device__ __forceinline__ void a_ready(const Unit&) const {}
    __device__ __forceinline__ void done(const Unit&) const {}
};
template <class Epi, class Sched, bool STAMP = false>
__device__ __forceinline__ void gemm_phase(PG8_LAS unsigned char* lds, const Gemm g, const Sched& S, const Epi& E, unsigned long long* stamps) {
    const int tid = opq_tid(), wid = __builtin_amdgcn_readfirstlane(tid >> 6), lane = tid & 63, wr = wid >> 2, wc = wid & 3, fr = lane & 15, fq = lane >> 4;
    const int K = g.K, nt = K / BK;
    int ts_lo = 0, ts_hi = 0, nts = 0; const unsigned long long rt_entry = STAMP ? (unsigned long long)wall_clock64() : 0ull;
#define PG8_STAMP() do { if (STAMP && wid == 0 && nts < 64) { const unsigned long long _c = (unsigned long long)clock64(); \
        ts_lo = (lane == nts) ? (int)(unsigned)_c : ts_lo; ts_hi = (lane == nts) ? (int)(unsigned)(_c >> 32) : ts_hi; ++nts; } } while (0)
    PG8_STAMP();
    unsigned voffA[2], voffB[2];
#pragma unroll
    for (int i = 0; i < 2; ++i) { int R, C; stage_rc(tid * 16 + i * 8192, R, C); const int Rb = Epi::PERM ? ((R & ~31) + perm32(R & 31)) : R;
        voffA[i] = (unsigned)(R * K + C) * 2u; voffB[i] = (unsigned)(Rb * K + C) * 2u; }
    const size_t kstep = (size_t)(BK * 2);
    const size_t hstep = (size_t)HALF * K * 2;
    const size_t tstep = 2 * hstep;
    const unsigned ldsw = (unsigned)wid * 1024u;
    const int aoff = lds_byte(wr * 64 + fr, fq * 8), boff = lds_byte(wc * 32 + fr, fq * 8);
#define PG8_SA(b, h) (((b) * 2 + (h)) * HTB)
#define PG8_SB(b, h) ((4 + (b) * 2 + (h)) * HTB)
#define PG8_STAGE(bufoff, gbase, voff) do { _Pragma("unroll") for (int _i = 0; _i < 2; ++_i) \
        __builtin_amdgcn_global_load_lds((const unsigned*)((const char*)(gbase) + (voff)[_i]), (PG8_LAS unsigned*)(lds + (bufoff) + ldsw + _i * 8192), 16, 0, 0); } while (0)
#define PG8_LDA(dst, b, h) do { _Pragma("unroll") for (int m = 0; m < 4; ++m) _Pragma("unroll") for (int k = 0; k < 2; ++k) dst[m][k] = *(const PG8_LAS bf16x8*)(lds + PG8_SA(b, h) + aoff + m * 2048 + k * 1024); } while (0)
#define PG8_LDB(dst, b, h) do { _Pragma("unroll") for (int n = 0; n < 2; ++n) _Pragma("unroll") for (int k = 0; k < 2; ++k) dst[n][k] = *(const PG8_LAS bf16x8*)(lds + PG8_SB(b, h) + boff + n * 2048 + k * 1024); } while (0)
#define PG8_MMA(ai, bj, At, Bt) do { __builtin_amdgcn_s_setprio(1); _Pragma("unroll") for (int m = 0; m < 4; ++m) _Pragma("unroll") for (int n = 0; n < 2; ++n) _Pragma("unroll") for (int k = 0; k < 2; ++k) \
        acc[ai][bj][m][n] = __builtin_amdgcn_mfma_f32_16x16x32_bf16(Bt[n][k], At[m][k], acc[ai][bj][m][n], 0, 0, 0); __builtin_amdgcn_s_setprio(0); } while (0)
#define PG8_WAIT_V(n) asm volatile("s_waitcnt vmcnt(" #n ")" ::: "memory")
#define PG8_WAIT_L(n) asm volatile("s_waitcnt lgkmcnt(" #n ")" ::: "memory")
#define PG8_BAR __builtin_amdgcn_s_barrier()
#define PG8_SCHED __builtin_amdgcn_sched_barrier(0)
    Unit cur, nxt; int ui = 0;
    if (!S.next(0, cur)) return;
    f32x4 acc[2][2][4][2];
#pragma unroll
    for (int a = 0; a < 2; ++a)
#pragma unroll
        for (int b = 0; b < 2; ++b)
#pragma unroll
            for (int m = 0; m < 4; ++m)
#pragma unroll
                for (int n = 0; n < 2; ++n) acc[a][b][m][n] = (f32x4){0.f, 0.f, 0.f, 0.f};
    bf16x8 At[4][2], B0[2][2], B1[2][2];
    const char* cA = (const char*)g.A + (size_t)cur.pm * tstep; const char* cB = (const char*)g.Bt + (size_t)cur.pn * tstep;
    S.a_ready(cur);
    PG8_STAGE(PG8_SB(0, 0), cB, voffB); PG8_STAGE(PG8_SA(0, 0), cA, voffA); PG8_STAGE(PG8_SB(0, 1), cB + hstep, voffB); PG8_STAGE(PG8_SA(0, 1), cA + hstep, voffA);
    if (wr == 1) PG8_BAR;
    PG8_WAIT_V(4); PG8_BAR;
    PG8_STAGE(PG8_SB(1, 0), cB + kstep, voffB); PG8_STAGE(PG8_SA(1, 0), cA + kstep, voffA); PG8_STAGE(PG8_SB(1, 1), cB + hstep + kstep, voffB);
    PG8_WAIT_V(6); PG8_BAR;
    PG8_STAMP();
    for (;;) {
        const bool has_next = S.next(ui + 1, nxt);
        const char* nA = has_next ? (const char*)g.A + (size_t)nxt.pm * tstep : cA; const char* nB = has_next ? (const char*)g.Bt + (size_t)nxt.pn * tstep : cB;
        for (int t = 0; t < nt; t += 2) {
            const bool last = (t == nt - 2);
            const char* a1 = cA + (size_t)(t + 1) * kstep;
            const char* a2 = last ? nA : cA + (size_t)(t + 2) * kstep; const char* b2 = last ? nB : cB + (size_t)(t + 2) * kstep;
            const char* a3 = a2 + kstep; const char* b3 = b2 + kstep;
            if (last && has_next) S.a_ready(nxt);
            PG8_LDB(B0, 0, 0); PG8_SCHED; PG8_LDA(At, 0, 0); PG8_STAGE(PG8_SA(1, 1), a1 + hstep, voffA);
            PG8_WAIT_L(8); PG8_BAR; PG8_WAIT_L(0); PG8_MMA(0, 0, At, B0); PG8_BAR; PG8_SCHED;
            PG8_LDB(B1, 0, 1); PG8_STAGE(PG8_SB(0, 0), b2, voffB);
            PG8_BAR; PG8_WAIT_L(0); PG8_MMA(0, 1, At, B1); PG8_BAR;
            PG8_LDA(At, 0, 1); PG8_STAGE(PG8_SA(0, 0), a2, voffA);
            PG8_BAR; PG8_WAIT_L(0); PG8_MMA(1, 0, At, B0); PG8_BAR; PG8_SCHED;
            PG8_STAGE(PG8_SB(0, 1), b2 + hstep, voffB);
            PG8_WAIT_V(6); PG8_BAR; PG8_MMA(1, 1, At, B1); PG8_BAR;
            PG8_LDB(B0, 1, 0); PG8_SCHED; PG8_LDA(At, 1, 0); PG8_STAGE(PG8_SA(0, 1), a2 + hstep, voffA);
            PG8_WAIT_L(8); PG8_BAR; PG8_WAIT_L(0); PG8_MMA(0, 0, At, B0); PG8_BAR; PG8_SCHED;
            PG8_LDB(B1, 1, 1); PG8_STAGE(PG8_SB(1, 0), b3, voffB);
            PG8_BAR; PG8_WAIT_L(0); PG8_MMA(0, 1, At, B1); PG8_BAR;
            PG8_LDA(At, 1, 1); PG8_STAGE(PG8_SA(1, 0), a3, voffA);
            PG8_BAR; PG8_WAIT_L(0); PG8_MMA(1, 0, At, B0); PG8_BAR; PG8_SCHED;
            PG8_STAGE(PG8_SB(1, 1), b3 + hstep, voffB);
            PG8_WAIT_V(6); PG8_BAR; PG8_MMA(1, 1, At, B1); PG8_BAR;
        }
        PG8_STAMP();
        if constexpr (!Epi::AFTER_DRAIN) { E(acc, cur, wr, wc, fr, fq); S.done(cur); }
        PG8_STAMP();
        if (!has_next) break;
#pragma unroll
        for (int a = 0; a < 2; ++a)
#pragma unroll
            for (int b = 0; b < 2; ++b)
#pragma unroll
                for (int m = 0; m < 4; ++m)
#pragma unroll
                    for (int n = 0; n < 2; ++n) acc[a][b][m][n] = (f32x4){0.f, 0.f, 0.f, 0.f};
        cur = nxt; cA = nA; cB = nB; ++ui;
    }
    PG8_WAIT_V(0);
    if (wr == 0) PG8_BAR;
    PG8_BAR;
    if constexpr (Epi::AFTER_DRAIN) { E.fused(acc, cur, wr, wc, fr, fq, lds, wid, lane); S.done(cur); }
    PG8_STAMP();
    if (STAMP && wid == 0) { stamps[lane] = lane < nts ? (((unsigned long long)(unsigned)ts_hi << 32) | (unsigned)ts_lo) : 0ull;
        if (lane == 62) stamps[62] = rt_entry; if (lane == 63) stamps[63] = (unsigned long long)wall_clock64(); }
#undef PG8_STAMP
#undef PG8_SA
#undef PG8_SB
#undef PG8_STAGE
#undef PG8_LDA
#undef PG8_LDB
#undef PG8_MMA
#undef PG8_WAIT_V
#undef PG8_WAIT_L
#undef PG8_BAR
#undef PG8_SCHED
}
}

#define XB_TMO      128
#define XB_XCNT(j)  (256  + 64 * (j))
#define XB_XSUB(j)  (1280 + 64 * (j))
#define XB_XGEN(j)  (2304 + 64 * (j))
#define XB_TOP      3328
#define XB_TOPGEN   3392
#define XCD_BAR_WORDS 3456
#define XB_SPIN_CAP (1u << 18)
#define LAS __attribute__((address_space(3)))

__device__ __forceinline__ unsigned xb_ld(unsigned* p)              { return __hip_atomic_load(p, __ATOMIC_RELAXED, __HIP_MEMORY_SCOPE_AGENT); }
__device__ __forceinline__ unsigned xb_add(unsigned* p, unsigned v) { return __hip_atomic_fetch_add(p, v, __ATOMIC_RELAXED, __HIP_MEMORY_SCOPE_AGENT); }
__device__ __forceinline__ unsigned xb_xcc_id() { return (unsigned)__builtin_amdgcn_s_getreg((3 << 11) | 20) & 0xFu; }
#define XB_SPIN(cond, bar) do { unsigned _sp = 0; while (cond) { __builtin_amdgcn_s_sleep(1); \
    if ((++_sp & 255u) == 0u) { if (xb_ld(&(bar)[XB_TMO])) break; if (_sp > XB_SPIN_CAP) { atomicAdd(&(bar)[XB_TMO], 1u); break; } } } } while (0)

struct XcdBarrier {
    unsigned* bar; unsigned x;
    volatile LAS unsigned* st;
};

__device__ __forceinline__ XcdBarrier xcd_barrier_post(unsigned* bar, volatile LAS unsigned* st) {
    XcdBarrier b; b.bar = bar; b.x = xb_xcc_id(); b.st = st;
    if (threadIdx.x == 0) (void)xb_add(&bar[XB_XCNT(b.x)], 1u);
    return b;
}
__device__ __forceinline__ void xcd_barrier_complete(unsigned* bar, unsigned x, unsigned& nloc, unsigned& nx) {
    const unsigned G = gridDim.x * gridDim.y * gridDim.z;
    unsigned sum, cnt, mine, sp = 0u;
    for (;;) {
        sum = 0u; cnt = 0u; mine = 0u;
#pragma unroll
        for (unsigned j = 0; j < 16; ++j) { const unsigned c = xb_ld(&bar[XB_XCNT(j)]); sum += c; cnt += (c > 0u) ? 1u : 0u; mine = (j == x) ? c : mine; }
        if (sum == G) break;
        __builtin_amdgcn_s_sleep(1);
        if ((++sp & 255u) == 0u) { if (xb_ld(&bar[XB_TMO])) break; if (sp > XB_SPIN_CAP) { atomicAdd(&bar[XB_TMO], 1u); break; } }
    }
    nloc = mine > 0u ? mine : 1u; nx = cnt > 0u ? cnt : 1u;
}

__device__ __forceinline__ void xcd_barrier(const XcdBarrier& b) {
    asm volatile("s_waitcnt vmcnt(0)" ::: "memory");
    __syncthreads();
    if (threadIdx.x == 0) {
        unsigned* bar = b.bar;
        __builtin_amdgcn_s_waitcnt(0);
        unsigned nloc = b.st[0], nx = b.st[1];
        if (nloc == 0u) { xcd_barrier_complete(bar, b.x, nloc, nx); b.st[0] = nloc; b.st[1] = nx; }
        const unsigned old = xb_add(&bar[XB_XSUB(b.x)], 1u);
        const unsigned gen = old / nloc;
        if (old + 1u == (gen + 1u) * nloc) {
            __builtin_amdgcn_fence(__ATOMIC_RELEASE, "agent");
            asm volatile("s_waitcnt vmcnt(0)" ::: "memory");
            const unsigned og = xb_add(&bar[XB_TOP], 1u);
            const unsigned tg = og / nx;
            if (og + 1u == (tg + 1u) * nx) xb_add(&bar[XB_TOPGEN], 1u);
            else XB_SPIN(xb_ld(&bar[XB_TOPGEN]) == tg, bar);
            __builtin_amdgcn_fence(__ATOMIC_ACQUIRE, "agent");
            xb_add(&bar[XB_XGEN(b.x)], 1u);
            asm volatile("s_waitcnt vmcnt(0)" ::: "memory");
        } else {
            XB_SPIN(xb_ld(&bar[XB_XGEN(b.x)]) == gen, bar);
            __builtin_amdgcn_fence(__ATOMIC_ACQUIRE, "agent");
            asm volatile("s_waitcnt vmcnt(0)" ::: "memory");
        }
    }
    __syncthreads();
}

typedef unsigned short bf16_t;
typedef short bf16x8 __attribute__((ext_vector_type(8)));
typedef float f32x4 __attribute__((ext_vector_type(4)));
typedef float f32x16 __attribute__((ext_vector_type(16)));

constexpr int DM = 2048, SEQ = 4096, NBP = 2, NBS = 32, TP = NBP * SEQ, MT = TP + NBS, MP = 8448;
constexpr int INW = 6784, INWP = 6912, SHD = 3200, DEPTH = 2;
constexpr size_t NRI = (size_t)MT * 1024;
constexpr int LDS_BYTES = 131072 + 16;
constexpr size_t O_CKP = (size_t)MT * DM;
constexpr size_t O_CVP = O_CKP + (size_t)DEPTH * NBP * 128 * 256;
constexpr size_t O_WKVP = O_CVP + (size_t)DEPTH * NBP * 128 * 256;
constexpr size_t O_SHP = O_WKVP + (size_t)DEPTH * NBP * 16 * 4096;
constexpr size_t O_CKS = O_SHP + (size_t)DEPTH * NBP * SHD;
constexpr size_t O_CVS = O_CKS + (size_t)DEPTH * NBS * 128 * 256;
constexpr size_t O_WKVS = O_CVS + (size_t)DEPTH * NBS * 128 * 256;
constexpr size_t O_SHS = O_WKVS + (size_t)DEPTH * NBS * 16 * 4096;
constexpr size_t O_END = O_SHS + (size_t)DEPTH * NBS * SHD;
constexpr size_t al256(size_t x) { return (x + 255) & ~(size_t)255; }
constexpr size_t WS_WTIN = 0;
constexpr size_t WS_WTOUT = WS_WTIN + (size_t)INWP * DM * 2;
constexpr size_t WS_MOD = WS_WTOUT + (size_t)DEPTH * DM * DM * 2;
constexpr size_t WS_ROPE = WS_MOD + al256((size_t)DEPTH * 34 * 6144 * 4);
constexpr size_t WS_HB = WS_ROPE + al256((size_t)4097 * 16 * 4);
constexpr size_t WS_QB = WS_HB + (size_t)MP * DM * 2;
constexpr size_t WS_KB = WS_QB + (size_t)MP * 1024 * 2;
constexpr size_t WS_VB = WS_KB + (size_t)MP * 256 * 2;
constexpr size_t WS_RW = WS_VB + (size_t)MP * 256 * 2;
constexpr size_t WS_GT = WS_RW + (size_t)MP * SHD * 2;
constexpr size_t WS_RIB = WS_GT + (size_t)MP * DM * 2;
constexpr size_t WS_RIW = WS_RIB + 5 * NRI * 2;
constexpr size_t WS_REC = WS_RIW + NRI * 4;
constexpr size_t WS_COEF = WS_REC + (size_t)32 * 256 * 14592;
constexpr size_t WS_BAR = WS_COEF + al256((size_t)MT * 16 * 4);
constexpr size_t WS_END = WS_BAR + 16384;

struct Params {
    const float *x_prompt, *x_sample, *cache_k, *cache_v, *state_wkv, *state_shift, *c_prompt, *c_sample, *norm_g, *w_ada, *b_ada, *w_in, *mu_shift, *w0, *w_decay, *a0,
        *w_iclr, *k_k, *k_a, *r_k, *ln_w, *ln_b, *sinks, *w_out, *final_g;
    float* out;
    unsigned char* ws;
    int repk, repl;
};
typedef const __attribute__((address_space(4))) Params* KParamsPtr;
__device__ __forceinline__ const Params& kparams() {
    KParamsPtr k = (KParamsPtr)__builtin_amdgcn_kernarg_segment_ptr();
    asm volatile("" : "+s"(k));
    return *(const Params*)k;
}

__device__ __forceinline__ unsigned short f2bf(float f) { return (unsigned short)(hw_cvt_pk_bf16(f, 0.f) & 0xffffu); }
__device__ __forceinline__ float bf2f(unsigned short b) { return __uint_as_float(((unsigned)b) << 16); }
__device__ __forceinline__ unsigned pack2(float lo, float hi) { return hw_cvt_pk_bf16(lo, hi); }
__device__ __forceinline__ float bflo(unsigned w) { return __uint_as_float(w << 16); }
__device__ __forceinline__ float bfhi(unsigned w) { return __uint_as_float(w & 0xffff0000u); }
__device__ __forceinline__ float silu_f(float x) { return x / (1.f + __expf(-x)); }
__device__ __forceinline__ float wave_sum(float x) {
#pragma unroll
    for (int o = 32; o >= 1; o >>= 1) x += __shfl_xor(x, o);
    return x;
}
__device__ __forceinline__ float wave_max(float x) {
#pragma unroll
    for (int o = 32; o >= 1; o >>= 1) x = fmaxf(x, __shfl_xor(x, o));
    return x;
}
template <int CTRL> __device__ __forceinline__ float dpp_f(float x) {
    return __builtin_bit_cast(float, __builtin_amdgcn_update_dpp(0, __builtin_bit_cast(int, x), CTRL, 0xF, 0xF, false));
}
__device__ __forceinline__ float allreduce16(float x) {
    x += dpp_f<0x128>(x);
    x += dpp_f<0x124>(x);
    x += dpp_f<0x122>(x);
    x += dpp_f<0x121>(x);
    return x;
}

__device__ void p0_mod_item(const Params& p, float* red, int l, int nc) {
    const int tid = opq_tid(), wv = tid >> 6, lane = tid & 63, n = lane & 31, kh = lane >> 5;
    f32x16 acc0, acc1;
#pragma unroll
    for (int i = 0; i < 16; ++i) { acc0[i] = 0.f; acc1[i] = 0.f; }
    const float* W = p.w_ada + (size_t)l * DM * 6144 + nc * 32 + n;
#pragma unroll 4
    for (int ks = 0; ks < 16; ++ks) {
        const int k0 = wv * 256 + ks * 16 + kh * 8;
        bf16x8 bfr, a0, a1;
#pragma unroll
        for (int j = 0; j < 8; ++j) bfr[j] = (short)f2bf(W[(size_t)(k0 + j) * 6144]);
        const float4* cs = (const float4*)(p.c_sample + (size_t)n * DM + k0);
        const float4 u0 = cs[0], u1 = cs[1];
        a0[0] = (short)f2bf(silu_f(u0.x)); a0[1] = (short)f2bf(silu_f(u0.y)); a0[2] = (short)f2bf(silu_f(u0.z)); a0[3] = (short)f2bf(silu_f(u0.w));
        a0[4] = (short)f2bf(silu_f(u1.x)); a0[5] = (short)f2bf(silu_f(u1.y)); a0[6] = (short)f2bf(silu_f(u1.z)); a0[7] = (short)f2bf(silu_f(u1.w));
        float4 q0 = make_float4(0.f, 0.f, 0.f, 0.f), q1 = q0;
        if (n < 2) { const float4* cp = (const float4*)(p.c_prompt + (size_t)n * DM + k0); q0 = cp[0]; q1 = cp[1]; }
        a1[0] = (short)f2bf(silu_f(q0.x)); a1[1] = (short)f2bf(silu_f(q0.y)); a1[2] = (short)f2bf(silu_f(q0.z)); a1[3] = (short)f2bf(silu_f(q0.w));
        a1[4] = (short)f2bf(silu_f(q1.x)); a1[5] = (short)f2bf(silu_f(q1.y)); a1[6] = (short)f2bf(silu_f(q1.z)); a1[7] = (short)f2bf(silu_f(q1.w));
        acc0 = __builtin_amdgcn_mfma_f32_32x32x16_bf16(a0, bfr, acc0, 0, 0, 0);
        acc1 = __builtin_amdgcn_mfma_f32_32x32x16_bf16(a1, bfr, acc1, 0, 0, 0);
    }
#pragma unroll
    for (int i = 0; i < 16; ++i) red[(wv * 18 + i) * 64 + lane] = acc0[i];
    red[(wv * 18 + 16) * 64 + lane] = acc1[0];
    red[(wv * 18 + 17) * 64 + lane] = acc1[1];
    __syncthreads();
    float* mod = (float*)(p.ws + WS_MOD);
    for (int o = tid; o < 34 * 32; o += 512) {
        const int row = o >> 5, col = o & 31;
        int ri, ln, mrow;
        if (row < 32) { const int khh = (row >> 2) & 1; ri = (row & 3) + 4 * (row >> 3); ln = col + 32 * khh; mrow = 2 + row; }
        else { ri = 16 + (row - 32); ln = col; mrow = row - 32; }
        float s = 0.f;
#pragma unroll
        for (int w = 0; w < 8; ++w) s += red[(w * 18 + ri) * 64 + ln];
        mod[((size_t)l * 34 + mrow) * 6144 + nc * 32 + col] = s + p.b_ada[l * 6144 + nc * 32 + col];
    }
    __syncthreads();
}

struct ConvIt { const float* src; bf16_t* dst; int N, k0, n0; };
__device__ __forceinline__ ConvIt conv_decode(const Params& p, int cidx, int lw) {
    ConvIt c;
    int kt, nt;
    if (cidx < 1728) { kt = cidx & 15; nt = cidx >> 4; c.N = INW; c.src = p.w_in + (size_t)lw * DM * INW; c.dst = (bf16_t*)(p.ws + WS_WTIN); }
    else { int rem = cidx - 1728; const int l2 = rem >> 9; rem &= 511; kt = rem & 15; nt = rem >> 4; c.N = DM; c.src = p.w_out + (size_t)l2 * DM * DM; c.dst = (bf16_t*)(p.ws + WS_WTOUT) + (size_t)l2 * DM * DM; }
    c.k0 = kt * 128; c.n0 = nt * 64;
    return c;
}
__device__ void p0_conv_all(const Params& p, float* s, int bid, int G, int total, int lw) {
    const int tid = opq_tid();
    const int lrow = tid >> 4, c4 = tid & 15, n = tid >> 3, kg = tid & 7;
    float4 v[4];
    int cidx = bid;
    ConvIt cur = conv_decode(p, cidx < total ? cidx : 0, lw);
    if (cidx < total) {
#pragma unroll
        for (int p4 = 0; p4 < 4; ++p4) { v[p4] = make_float4(0.f, 0.f, 0.f, 0.f); if (cur.n0 < cur.N) v[p4] = *(const float4*)(cur.src + (size_t)(cur.k0 + lrow + 32 * p4) * cur.N + cur.n0 + 4 * c4); }
    }
#pragma unroll 1
    while (cidx < total) {
#pragma unroll
        for (int p4 = 0; p4 < 4; ++p4) { float* d = s + (lrow + 32 * p4) * 65 + 4 * c4; d[0] = v[p4].x; d[1] = v[p4].y; d[2] = v[p4].z; d[3] = v[p4].w; }
        __syncthreads();
        const int nxt = cidx + G;
        const ConvIt nx = conv_decode(p, nxt < total ? nxt : 0, lw);
        if (nxt < total) {
#pragma unroll
            for (int p4 = 0; p4 < 4; ++p4) { v[p4] = make_float4(0.f, 0.f, 0.f, 0.f); if (nx.n0 < nx.N) v[p4] = *(const float4*)(nx.src + (size_t)(nx.k0 + lrow + 32 * p4) * nx.N + nx.n0 + 4 * c4); }
        }
        unsigned w[8];
#pragma unroll
        for (int j = 0; j < 8; ++j) w[j] = pack2(s[(kg * 16 + 2 * j) * 65 + n], s[(kg * 16 + 2 * j + 1) * 65 + n]);
        uint4* o = (uint4*)(cur.dst + (size_t)(cur.n0 + n) * DM + cur.k0 + kg * 16);
        o[0] = make_uint4(w[0], w[1], w[2], w[3]);
        o[1] = make_uint4(w[4], w[5], w[6], w[7]);
        __syncthreads();
        cur = nx; cidx = nxt;
    }
}

__device__ void p0_rope_item(const Params& p, int it) {
    float* rope = (float*)(p.ws + WS_ROPE);
#pragma unroll
    for (int q = 0; q < 4; ++q) {
        const int e = it * 2048 + q * 512 + opq_tid();
        if (e < 4097 * 8) {
            const int idx = e >> 3, i = e & 7;
            double invf = 1.0;
            for (int q = 0; q < i; ++q) invf *= 0.19392274474868576;
            const double pos = idx < 4096 ? (double)idx : 16384.0;
            const double rev = pos * invf * 0.15915494309189535;
            const float f = (float)(rev - floor(rev));
            rope[idx * 16 + i] = __builtin_amdgcn_cosf(f);
            rope[idx * 16 + 8 + i] = __builtin_amdgcn_sinf(f);
        }
    }
}

__device__ void p1_norm(const Params& p, int l, int bid, int G) {
    const int tid = opq_tid(), wv = tid >> 6, lane = tid & 63;
    bf16_t* hb = (bf16_t*)(p.ws + WS_HB);
    const float* mod = (const float*)(p.ws + WS_MOD);
    const float4* g4 = (const float4*)(p.norm_g + l * DM);
    for (int r = bid * 8 + wv; r < MT; r += G * 8) {
        const float* xr = l == 0 ? (r < TP ? p.x_prompt + (size_t)r * DM : p.x_sample + (size_t)(r - TP) * DM) : p.out + (size_t)r * DM;
        const int mrow = r < TP ? (r >> 12) : 2 + (r - TP);
        const float* md = mod + ((size_t)l * 34 + mrow) * 6144;
        float4 v[8]; float ss = 0.f;
#pragma unroll
        for (int i = 0; i < 8; ++i) { v[i] = ((const float4*)xr)[lane + 64 * i]; ss += v[i].x * v[i].x + v[i].y * v[i].y + v[i].z * v[i].z + v[i].w * v[i].w; }
        ss = wave_sum(ss);
        const float rinv = rsqrtf(ss * (1.f / 2048.f) + 1e-5f);
#pragma unroll
        for (int i = 0; i < 8; ++i) {
            const int c4 = lane + 64 * i;
            const float4 g = g4[c4], sc = ((const float4*)(md + 2048))[c4], sh = ((const float4*)md)[c4];
            const float y0 = v[i].x * rinv * g.x * (1.f + sc.x) + sh.x, y1 = v[i].y * rinv * g.y * (1.f + sc.y) + sh.y;
            const float y2 = v[i].z * rinv * g.z * (1.f + sc.z) + sh.z, y3 = v[i].w * rinv * g.w * (1.f + sc.w) + sh.w;
            *(uint2*)(hb + (size_t)r * DM + 4 * c4) = make_uint2(pack2(y0, y1), pack2(y2, y3));
        }
    }
}

struct Epi1 {
    static constexpr bool PERM = false, AFTER_DRAIN = false;
    int l;
    __device__ __forceinline__ void operator()(const f32x4 (&acc)[2][2][4][2], const pg8::Unit& u, int wr, int wc, int fr, int fq) const {
        const Params& p = kparams();
        bf16_t* const qb = (bf16_t*)(p.ws + WS_QB); bf16_t* const kb = (bf16_t*)(p.ws + WS_KB); bf16_t* const vb = (bf16_t*)(p.ws + WS_VB);
        bf16_t* const rw = (bf16_t*)(p.ws + WS_RW); bf16_t* const gt = (bf16_t*)(p.ws + WS_GT); const float* const rope = (const float*)(p.ws + WS_ROPE); float* const out = p.out;
#pragma unroll
        for (int bj = 0; bj < 2; ++bj)
#pragma unroll
            for (int n = 0; n < 2; ++n) {
                const int cb = u.pn * 256 + bj * 128 + wc * 32 + n * 16;
                if (cb >= INW) continue;
                const int c = cb + 4 * fq;
                const bool do_rope = (cb < 1280) && ((cb & 63) == 0);
#pragma unroll
                for (int ai = 0; ai < 2; ++ai)
#pragma unroll
                    for (int m = 0; m < 4; ++m) {
                        const int rb = u.pm * 256 + ai * 128 + wr * 64 + m * 16;
                        if (rb >= MT) continue;
                        const int r = rb + fr;
                        f32x4 v = acc[ai][bj][m][n];
                        if (do_rope) {
                            const int idx = r < TP ? (r & 4095) : 4096;
                            const float4 cs = *(const float4*)(rope + idx * 16 + 4 * (fq & 1));
                            const float4 sn = *(const float4*)(rope + idx * 16 + 8 + 4 * (fq & 1));
                            const float p0 = __shfl_xor(v[0], 32), p1 = __shfl_xor(v[1], 32), p2 = __shfl_xor(v[2], 32), p3 = __shfl_xor(v[3], 32);
                            const float sg = fq < 2 ? -1.f : 1.f;
                            v[0] = v[0] * cs.x + sg * p0 * sn.x; v[1] = v[1] * cs.y + sg * p1 * sn.y; v[2] = v[2] * cs.z + sg * p2 * sn.z; v[3] = v[3] * cs.w + sg * p3 * sn.w;
                        }
                        if (cb < 1024) {
                            *(uint2*)(qb + (size_t)r * 1024 + c) = make_uint2(pack2(v[0] * 0.125f, v[1] * 0.125f), pack2(v[2] * 0.125f, v[3] * 0.125f));
                        } else if (cb < 1536) {
                            const bool isk = cb < 1280;
                            const int cc = c - (isk ? 1024 : 1280);
                            *(uint2*)((isk ? kb : vb) + (size_t)r * 256 + cc) = make_uint2(pack2(v[0], v[1]), pack2(v[2], v[3]));
                            if (r >= TP) {
                                *(f32x4*)(out + (isk ? O_CKS : O_CVS) + ((size_t)(l * NBS + (r - TP)) * 128 + 127) * 256 + cc) = v;
                            } else if ((r & 4095) >= SEQ - 128) {
                                *(f32x4*)(out + (isk ? O_CKP : O_CVP) + ((size_t)(l * NBP + (r >> 12)) * 128 + ((r & 4095) - (SEQ - 128))) * 256 + cc) = v;
                            }
                        } else if (cb < 4736) {
                            const int cc = c - 1536;
                            *(uint2*)(rw + (size_t)r * SHD + cc) = make_uint2(pack2(v[0], v[1]), pack2(v[2], v[3]));
                            if (r >= TP) *(f32x4*)(out + O_SHS + (size_t)(l * NBS + (r - TP)) * SHD + cc) = v;
                            else if ((r & 4095) == SEQ - 1) *(f32x4*)(out + O_SHP + (size_t)(l * NBP + (r >> 12)) * SHD + cc) = v;
                        } else {
                            const int cc = c - 4736;
                            *(uint2*)(gt + (size_t)r * DM + cc) = make_uint2(pack2(silu_f(v[0]), silu_f(v[1])), pack2(silu_f(v[2]), silu_f(v[3])));
                        }
                    }
            }
    }
};

struct Epi2 {
    static constexpr bool PERM = false, AFTER_DRAIN = false;
    int l;
    __device__ __forceinline__ void operator()(const f32x4 (&acc)[2][2][4][2], const pg8::Unit& u, int wr, int wc, int fr, int fq) const {
        const Params& p = kparams();
        const float* const xp = p.x_prompt; const float* const xs = p.x_sample; const float* const modl = (const float*)(p.ws + WS_MOD) + (size_t)l * 34 * 6144; float* const out = p.out;
#pragma unroll
        for (int ai = 0; ai < 2; ++ai)
#pragma unroll
            for (int m = 0; m < 4; ++m) {
                const int rb = u.pm * 256 + ai * 128 + wr * 64 + m * 16;
                if (rb >= MT) continue;
                const int r = rb + fr;
                const int mrow = r < TP ? (r >> 12) : 2 + (r - TP);
                const float* xo = l == 0 ? (r < TP ? xp + (size_t)r * DM : xs + (size_t)(r - TP) * DM) : out + (size_t)r * DM;
                const float* gr = modl + (size_t)mrow * 6144 + 4096;
#pragma unroll
                for (int bj = 0; bj < 2; ++bj)
#pragma unroll
                    for (int n = 0; n < 2; ++n) {
                        const int c = u.pn * 256 + bj * 128 + wc * 32 + n * 16 + 4 * fq;
                        const f32x4 x4 = *(const f32x4*)(xo + c), g4 = *(const f32x4*)(gr + c);
                        *(f32x4*)(out + (size_t)r * DM + c) = x4 + g4 * acc[ai][bj][m][n];
                    }
            }
    }
};

__device__ void g2_sample_item(const Params& p, float* red, int l, int nb) {
    const int tid = opq_tid(), wv = tid >> 6, lane = tid & 63, n = lane & 31, h = lane >> 5;
    const bf16_t* A = (const bf16_t*)(p.ws + WS_HB) + (size_t)TP * DM;
    const bf16_t* Bt = (const bf16_t*)(p.ws + WS_WTOUT) + (size_t)l * DM * DM + (size_t)(nb * 32) * DM;
    f32x16 acc;
#pragma unroll
    for (int i = 0; i < 16; ++i) acc[i] = 0.f;
#pragma unroll 4
    for (int ks = 0; ks < 16; ++ks) {
        const int k0 = wv * 256 + ks * 16 + 8 * h;
        const bf16x8 a = *(const bf16x8*)(A + (size_t)n * DM + k0);
        const bf16x8 bq = *(const bf16x8*)(Bt + (size_t)n * DM + k0);
        acc = __builtin_amdgcn_mfma_f32_32x32x16_bf16(a, bq, acc, 0, 0, 0);
    }
#pragma unroll
    for (int i = 0; i < 16; ++i) red[(wv * 16 + i) * 64 + lane] = acc[i];
    __syncthreads();
    const float* mod = (const float*)(p.ws + WS_MOD) + (size_t)l * 34 * 6144;
    for (int o = tid; o < 1024; o += 512) {
        const int row = o >> 5, col = o & 31, hh = (row >> 2) & 1, ri = (row & 3) + 4 * (row >> 3), ln = col + 32 * hh;
        float s = 0.f;
#pragma unroll
        for (int w = 0; w < 8; ++w) s += red[(w * 16 + ri) * 64 + ln];
        const int c = nb * 32 + col;
        const float gate = mod[(size_t)(2 + row) * 6144 + 4096 + c];
        const float xo = l == 0 ? p.x_sample[(size_t)row * DM + c] : p.out[(size_t)(TP + row) * DM + c];
        p.out[(size_t)(TP + row) * DM + c] = xo + gate * s;
    }
    __syncthreads();
}

__device__ void p3_attn_unit(const Params& p, unsigned char* lds, int l, int unit) {
    const int tid = opq_tid(), wv = tid >> 6, lane = tid & 63;
    const int b = unit >> 7, n = (unit >> 2) & 31, g = unit & 3;
    bf16_t* Ks = (bf16_t*)lds;
    bf16_t* Vt = (bf16_t*)(lds + 36864);
    const bf16_t* qb = (const bf16_t*)(p.ws + WS_QB);
    const bf16_t* kb = (const bf16_t*)(p.ws + WS_KB);
    const bf16_t* vb = (const bf16_t*)(p.ws + WS_VB);
    const bf16_t* gt = (const bf16_t*)(p.ws + WS_GT);
    bf16_t* cc = (bf16_t*)(p.ws + WS_HB);
    {
        uint4 kv4[4], vv4[4];
#pragma unroll
        for (int i = 0; i < 4; ++i) {
            const int chunk = tid + 512 * i, kl = chunk >> 3, dc = chunk & 7, kp = 128 * (n - 1) + kl;
            kv4[i] = make_uint4(0u, 0u, 0u, 0u); vv4[i] = kv4[i];
            if (kp >= 0) { const size_t row = (size_t)b * SEQ + kp; kv4[i] = *(const uint4*)(kb + row * 256 + g * 64 + dc * 8); vv4[i] = *(const uint4*)(vb + row * 256 + g * 64 + dc * 8); }
        }
        __builtin_amdgcn_sched_barrier(0);
#pragma unroll
        for (int i = 0; i < 4; ++i) {
            const int chunk = tid + 512 * i, kl = chunk >> 3, dc = chunk & 7;
            *(uint4*)(Ks + kl * 72 + dc * 8) = kv4[i];
            bf16_t* vd = Vt + (dc * 8) * 264 + kl;
            vd[0 * 264] = (bf16_t)(vv4[i].x & 0xffffu); vd[1 * 264] = (bf16_t)(vv4[i].x >> 16);
            vd[2 * 264] = (bf16_t)(vv4[i].y & 0xffffu); vd[3 * 264] = (bf16_t)(vv4[i].y >> 16);
            vd[4 * 264] = (bf16_t)(vv4[i].z & 0xffffu); vd[5 * 264] = (bf16_t)(vv4[i].z >> 16);
            vd[6 * 264] = (bf16_t)(vv4[i].w & 0xffffu); vd[7 * 264] = (bf16_t)(vv4[i].w >> 16);
        }
    }
    __syncthreads();
    const int hq = 4 * g + (wv >> 1), qh = wv & 1, q32 = lane & 31, h = lane >> 5;
    const float sink = p.sinks[l * 16 + hq];
#pragma unroll 1
    for (int s = 0; s < 2; ++s) {
        const int qp = 128 * n + 64 * qh + 32 * s + q32;
        const size_t qrow = (size_t)b * SEQ + qp;
        const int klb0 = 64 * qh + 32 * s;
        bf16x8 qf[4];
#pragma unroll
        for (int ks = 0; ks < 4; ++ks) qf[ks] = *(const bf16x8*)(qb + qrow * 1024 + hq * 64 + ks * 16 + 8 * h);
        f32x16 S[5];
#pragma unroll
        for (int kt = 0; kt < 5; ++kt) {
#pragma unroll
            for (int i = 0; i < 16; ++i) S[kt][i] = 0.f;
#pragma unroll
            for (int ks = 0; ks < 4; ++ks) {
                const bf16x8 a = *(const bf16x8*)(Ks + (klb0 + 32 * kt + q32) * 72 + ks * 16 + 8 * h);
                S[kt] = __builtin_amdgcn_mfma_f32_32x32x16_bf16(a, qf[ks], S[kt], 0, 0, 0);
            }
        }
        float mx = -1e30f;
#pragma unroll
        for (int kt = 0; kt < 5; ++kt)
#pragma unroll
            for (int i = 0; i < 16; ++i) {
                const int m = 8 * (i >> 2) + 4 * h + (i & 3);
                const int kp = 128 * (n - 1) + klb0 + 32 * kt + m;
                const int rel = qp - kp;
                const bool ok = (rel >= 0) && (rel <= 128) && (kp >= 0);
                const float sv = ok ? S[kt][i] : -1e30f;
                S[kt][i] = sv; mx = fmaxf(mx, sv);
            }
        mx = fmaxf(mx, __shfl_xor(mx, 32));
        mx = fmaxf(mx, sink);
        float sum = 0.f;
#pragma unroll
        for (int kt = 0; kt < 5; ++kt)
#pragma unroll
            for (int i = 0; i < 16; ++i) { const float e = __expf(S[kt][i] - mx); S[kt][i] = e; sum += e; }
        sum += __shfl_xor(sum, 32);
        const float inv = 1.f / (sum + __expf(sink - mx));
        f32x16 O[2];
#pragma unroll
        for (int i = 0; i < 16; ++i) { O[0][i] = 0.f; O[1][i] = 0.f; }
#pragma unroll
        for (int kt = 0; kt < 5; ++kt)
#pragma unroll
            for (int sp = 0; sp < 2; ++sp) {
                bf16x8 pf;
#pragma unroll
                for (int j = 0; j < 8; ++j) pf[j] = (short)f2bf(S[kt][8 * sp + j]);
#pragma unroll
                for (int dt = 0; dt < 2; ++dt) {
                    const bf16_t* vp = Vt + (32 * dt + q32) * 264 + klb0 + 32 * kt + 16 * sp + 4 * h;
                    const uint2 lo = *(const uint2*)vp, hi = *(const uint2*)(vp + 8);
                    const uint4 av = make_uint4(lo.x, lo.y, hi.x, hi.y);
                    O[dt] = __builtin_amdgcn_mfma_f32_32x32x16_bf16(__builtin_bit_cast(bf16x8, av), pf, O[dt], 0, 0, 0);
                }
            }
#pragma unroll
        for (int dt = 0; dt < 2; ++dt)
#pragma unroll
            for (int ig = 0; ig < 4; ++ig) {
                const int col = hq * 64 + 32 * dt + 8 * ig + 4 * h;
                const uint2 gg = *(const uint2*)(gt + qrow * DM + col);
                const float o0 = O[dt][4 * ig + 0] * inv * bflo(gg.x), o1 = O[dt][4 * ig + 1] * inv * bfhi(gg.x);
                const float o2 = O[dt][4 * ig + 2] * inv * bflo(gg.y), o3 = O[dt][4 * ig + 3] * inv * bfhi(gg.y);
                *(uint2*)(cc + qrow * DM + col) = make_uint2(pack2(o0, o1), pack2(o2, o3));
            }
    }
    __syncthreads();
}

__device__ void p3_sattn_item(const Params& p, float* lds, int l, int item) {
    const int tid = opq_tid(), wv = tid >> 6, lane = tid & 63;
    float* pl = lds + wv * 128;
    const int w = item * 8 + wv, bd = w >> 4, hq = w & 15, g = hq >> 2;
    const size_t row = (size_t)TP + bd;
    const bf16_t* qb = (const bf16_t*)(p.ws + WS_QB);
    const bf16_t* gt = (const bf16_t*)(p.ws + WS_GT);
    bf16_t* cc = (bf16_t*)(p.ws + WS_HB);
    float q[64];
#pragma unroll
    for (int c = 0; c < 8; ++c) {
        const uint4 u = *(const uint4*)(qb + row * 1024 + hq * 64 + c * 8);
        q[c * 8 + 0] = bflo(u.x); q[c * 8 + 1] = bfhi(u.x); q[c * 8 + 2] = bflo(u.y); q[c * 8 + 3] = bfhi(u.y);
        q[c * 8 + 4] = bflo(u.z); q[c * 8 + 5] = bfhi(u.z); q[c * 8 + 6] = bflo(u.w); q[c * 8 + 7] = bfhi(u.w);
    }
    const size_t cbase = ((size_t)(l * NBS + bd) * 128) * 256 + g * 64;
    const float* ck = p.cache_k + cbase;
    const float* cv = p.cache_v + cbase;
    float* nk = p.out + O_CKS + cbase;
    float* nv = p.out + O_CVS + cbase;
    float s0 = 0.f, s1 = 0.f, s2 = 0.f;
#pragma unroll
    for (int c = 0; c < 16; ++c) {
        const float4 a = ((const float4*)(ck + (size_t)lane * 256))[c];
        const float4 bq = ((const float4*)(ck + (size_t)(lane + 64) * 256))[c];
        const float4 e = ((const float4*)(nk + (size_t)127 * 256))[c];
        s0 += a.x * q[4 * c] + a.y * q[4 * c + 1] + a.z * q[4 * c + 2] + a.w * q[4 * c + 3];
        s1 += bq.x * q[4 * c] + bq.y * q[4 * c + 1] + bq.z * q[4 * c + 2] + bq.w * q[4 * c + 3];
        s2 += e.x * q[4 * c] + e.y * q[4 * c + 1] + e.z * q[4 * c + 2] + e.w * q[4 * c + 3];
    }
    const float sink = p.sinks[l * 16 + hq];
    const float mx = fmaxf(wave_max(fmaxf(s0, s1)), fmaxf(s2, sink));
    const float p0 = __expf(s0 - mx), p1 = __expf(s1 - mx), p2 = __expf(s2 - mx);
    const float sum = wave_sum(p0 + p1) + p2 + __expf(sink - mx);
    pl[lane] = p0; pl[lane + 64] = p1;
    __builtin_amdgcn_fence(__ATOMIC_RELEASE, "wavefront");
    __builtin_amdgcn_wave_barrier();
    __builtin_amdgcn_fence(__ATOMIC_ACQUIRE, "wavefront");
    float o = 0.f;
#pragma unroll 32
    for (int key = 0; key < 128; ++key) o += pl[key] * cv[(size_t)key * 256 + lane];
    o += p2 * nv[(size_t)127 * 256 + lane];
    o /= sum;
    const float gate = bf2f(gt[row * DM + hq * 64 + lane]);
    cc[row * DM + hq * 64 + lane] = f2bf(o * gate);
    {
        float tk[32], tv[32];
#pragma unroll
        for (int i = 0; i < 32; ++i) {
            const int ww = (hq & 3) + 4 * i;
            tk[i] = ck[(size_t)(ww + 1 < 128 ? ww + 1 : 127) * 256 + lane]; tv[i] = cv[(size_t)(ww + 1 < 128 ? ww + 1 : 127) * 256 + lane];
        }
#pragma unroll
        for (int i = 0; i < 32; ++i) {
            const int ww = (hq & 3) + 4 * i;
            if (ww < 127) { nk[(size_t)ww * 256 + lane] = tk[i]; nv[(size_t)ww * 256 + lane] = tv[i]; }
        }
    }
    __builtin_amdgcn_wave_barrier();
}

__device__ __forceinline__ float mix_val(const bf16_t* rw, const float* sshift, const float* mu, int r, int c) {
    const float cur = bf2f(rw[(size_t)r * SHD + c]);
    float prev;
    if (r >= TP) prev = sshift[(size_t)(r - TP) * SHD + c];
    else if ((r & 4095) == 0) prev = 0.f;
    else prev = bf2f(rw[(size_t)(r - 1) * SHD + c]);
    return cur + (prev - cur) * mu[c];
}

__device__ __forceinline__ float4 mix4(const bf16_t* rw, const float* sshift, int r, int c, float4 mu4) {
    const uint2 cu = *(const uint2*)(rw + (size_t)r * SHD + c);
    const float4 cur = make_float4(bflo(cu.x), bfhi(cu.x), bflo(cu.y), bfhi(cu.y));
    float4 prev = make_float4(0.f, 0.f, 0.f, 0.f);
    if (r >= TP) prev = *(const float4*)(sshift + (size_t)(r - TP) * SHD + c);
    else if ((r & 4095) != 0) { const uint2 pu = *(const uint2*)(rw + (size_t)(r - 1) * SHD + c); prev = make_float4(bflo(pu.x), bfhi(pu.x), bflo(pu.y), bfhi(pu.y)); }
    return make_float4(cur.x + (prev.x - cur.x) * mu4.x, cur.y + (prev.y - cur.y) * mu4.y, cur.z + (prev.z - cur.z) * mu4.z, cur.w + (prev.w - cur.w) * mu4.w);
}
__device__ __forceinline__ float decay_of(float x) {
    const float z = -x;
    const float sp = fmaxf(z, 0.f) + __logf(1.f + __expf(-fabsf(z)));
    return __expf(-__expf(-sp - 0.5f));
}

__device__ void p3_prep_tile(const Params& p, unsigned char* lds, int l, int tile) {
    const int tid = opq_tid(), wv = tid >> 6, lane = tid & 63, n = lane & 31, h = lane >> 5;
    bf16_t* TW = (bf16_t*)lds;
    bf16_t* AD = TW + 32 * 72;
    const bf16_t* rw = (const bf16_t*)(p.ws + WS_RW);
    const float* sshift = p.state_shift + (size_t)l * NBS * SHD;
    const float* mu = p.mu_shift + l * SHD;
    bf16_t* RIB = (bf16_t*)(p.ws + WS_RIB);
    float* RIW = (float*)(p.ws + WS_RIW);
    float* coef = (float*)(p.ws + WS_COEF);
    const int r0 = tile * 32;
    {
        float mm[8];
#pragma unroll
        for (int i = 0; i < 8; ++i) { const int idx = tid + 512 * i, tt = idx >> 7, c2 = idx & 127; mm[i] = mix_val(rw, sshift, mu, r0 + tt, 3072 + c2); }
        __builtin_amdgcn_sched_barrier(0);
#pragma unroll
        for (int i = 0; i < 8; ++i) {
            const int idx = tid + 512 * i, tt = idx >> 7, c2 = idx & 127;
            if (c2 < 64) { const float e = __expf(2.f * mm[i]); TW[tt * 72 + c2] = f2bf(1.f - 2.f / (e + 1.f)); }
            else AD[tt * 72 + (c2 - 64)] = f2bf(mm[i]);
        }
    }
    __syncthreads();
    const int col0 = wv * 128 + 4 * n;
    f32x16 acc[4];
    {
        const float* wp = p.w_decay + (size_t)l * 64 * 1024 + col0;
#pragma unroll
        for (int nt = 0; nt < 4; ++nt)
#pragma unroll
            for (int i = 0; i < 16; ++i) acc[nt][i] = 0.f;
#pragma unroll
        for (int ks = 0; ks < 4; ++ks) {
            const bf16x8 a = *(const bf16x8*)(TW + n * 72 + 16 * ks + 8 * h);
            float4 w4[8];
#pragma unroll
            for (int e = 0; e < 8; ++e) w4[e] = *(const float4*)(wp + (size_t)(16 * ks + 8 * h + e) * 1024);
            bf16x8 b0, b1, b2, b3;
#pragma unroll
            for (int e = 0; e < 8; ++e) { b0[e] = (short)f2bf(w4[e].x); b1[e] = (short)f2bf(w4[e].y); b2[e] = (short)f2bf(w4[e].z); b3[e] = (short)f2bf(w4[e].w); }
            acc[0] = __builtin_amdgcn_mfma_f32_32x32x16_bf16(a, b0, acc[0], 0, 0, 0);
            acc[1] = __builtin_amdgcn_mfma_f32_32x32x16_bf16(a, b1, acc[1], 0, 0, 0);
            acc[2] = __builtin_amdgcn_mfma_f32_32x32x16_bf16(a, b2, acc[2], 0, 0, 0);
            acc[3] = __builtin_amdgcn_mfma_f32_32x32x16_bf16(a, b3, acc[3], 0, 0, 0);
        }
        const float4 w0c = *(const float4*)(p.w0 + l * 1024 + col0);
#pragma unroll
        for (int r = 0; r < 16; ++r) {
            const int row = r0 + 8 * (r >> 2) + 4 * h + (r & 3);
            *(float4*)(RIW + (size_t)row * 1024 + col0) =
                make_float4(decay_of(w0c.x + acc[0][r]), decay_of(w0c.y + acc[1][r]), decay_of(w0c.z + acc[2][r]), decay_of(w0c.w + acc[3][r]));
        }
    }
    {
        const float* wp = p.w_iclr + (size_t)l * 64 * 1024 + col0;
#pragma unroll
        for (int nt = 0; nt < 4; ++nt)
#pragma unroll
            for (int i = 0; i < 16; ++i) acc[nt][i] = 0.f;
#pragma unroll
        for (int ks = 0; ks < 4; ++ks) {
            const bf16x8 a = *(const bf16x8*)(AD + n * 72 + 16 * ks + 8 * h);
            float4 w4[8];
#pragma unroll
            for (int e = 0; e < 8; ++e) w4[e] = *(const float4*)(wp + (size_t)(16 * ks + 8 * h + e) * 1024);
            bf16x8 b0, b1, b2, b3;
#pragma unroll
            for (int e = 0; e < 8; ++e) { b0[e] = (short)f2bf(w4[e].x); b1[e] = (short)f2bf(w4[e].y); b2[e] = (short)f2bf(w4[e].z); b3[e] = (short)f2bf(w4[e].w); }
            acc[0] = __builtin_amdgcn_mfma_f32_32x32x16_bf16(a, b0, acc[0], 0, 0, 0);
            acc[1] = __builtin_amdgcn_mfma_f32_32x32x16_bf16(a, b1, acc[1], 0, 0, 0);
            acc[2] = __builtin_amdgcn_mfma_f32_32x32x16_bf16(a, b2, acc[2], 0, 0, 0);
            acc[3] = __builtin_amdgcn_mfma_f32_32x32x16_bf16(a, b3, acc[3], 0, 0, 0);
        }
    }
    const float4 a0c = *(const float4*)(p.a0 + l * 1024 + col0), kkc = *(const float4*)(p.k_k + l * 1024 + col0), kac = *(const float4*)(p.k_a + l * 1024 + col0), rkc = *(const float4*)(p.r_k + l * 1024 + col0);
    const float4 mur = *(const float4*)(mu + col0), muk = *(const float4*)(mu + 1024 + col0), muv = *(const float4*)(mu + 2048 + col0);
    const int head = 2 * wv + (n >> 4);
#pragma unroll
    for (int g4 = 0; g4 < 4; ++g4) {
        float4 rr4[4], kr4[4], vr4[4];
#pragma unroll
        for (int q = 0; q < 4; ++q) {
            const int row = r0 + 8 * g4 + 4 * h + q;
            rr4[q] = mix4(rw, sshift, row, col0, mur); kr4[q] = mix4(rw, sshift, row, 1024 + col0, muk); vr4[q] = mix4(rw, sshift, row, 2048 + col0, muv);
        }
        __builtin_amdgcn_sched_barrier(0);
#pragma unroll
        for (int q = 0; q < 4; ++q) {
            const int r = 4 * g4 + q;
            const int row = r0 + 8 * g4 + 4 * h + q;
            const float4 rr = rr4[q], kr = kr4[q], vr = vr4[q];
            const float ax = 1.f / (1.f + __expf(-(a0c.x + acc[0][r]))), ay = 1.f / (1.f + __expf(-(a0c.y + acc[1][r])));
            const float az = 1.f / (1.f + __expf(-(a0c.z + acc[2][r]))), aw = 1.f / (1.f + __expf(-(a0c.w + acc[3][r])));
            const float k0 = kr.x * kkc.x, k1 = kr.y * kkc.y, k2 = kr.z * kkc.z, k3 = kr.w * kkc.w;
            const float ss = allreduce16(k0 * k0 + k1 * k1 + k2 * k2 + k3 * k3);
            const float inv = 1.f / fmaxf(sqrtf(ss), 1e-12f);
            const float4 kk = make_float4(k0 * inv, k1 * inv, k2 * inv, k3 * inv);
            const float4 ke = make_float4(kr.x * (1.f + (ax - 1.f) * kac.x), kr.y * (1.f + (ay - 1.f) * kac.y), kr.z * (1.f + (az - 1.f) * kac.z), kr.w * (1.f + (aw - 1.f) * kac.w));
            const float cf = allreduce16(rr.x * ke.x * rkc.x + rr.y * ke.y * rkc.y + rr.z * ke.z * rkc.z + rr.w * ke.w * rkc.w);
            if ((n & 15) == 0) coef[(size_t)row * 16 + head] = cf;
            const size_t o = (size_t)row * 1024 + col0;
            *(uint2*)(RIB + o) = make_uint2(pack2(rr.x, rr.y), pack2(rr.z, rr.w));
            *(uint2*)(RIB + NRI + o) = make_uint2(pack2(ke.x, ke.y), pack2(ke.z, ke.w));
            *(uint2*)(RIB + 2 * NRI + o) = make_uint2(pack2(kk.x, kk.y), pack2(kk.z, kk.w));
            *(uint2*)(RIB + 3 * NRI + o) = make_uint2(pack2(kk.x * ax, kk.y * ay), pack2(kk.z * az, kk.w * aw));
            *(uint2*)(RIB + 4 * NRI + o) = make_uint2(pack2(vr.x, vr.y), pack2(vr.z, vr.w));
        }
        __builtin_amdgcn_sched_barrier(0);
    }
    __syncthreads();
}

constexpr int REC_BYTES = 14592;
constexpr int PA_WLDS = 16384;
typedef float f32x4v __attribute__((ext_vector_type(4)));

__device__ void pa_chunk(const Params& p, unsigned char* wl, int l, int ct) {
    const int lane = opq_tid() & 63;
    const int hh = ct >> 8, c = ct & 255, b = hh >> 4, h = hh & 15;
    const size_t row0 = (size_t)b * SEQ + 16 * c;
    const int col = h * 64 + lane;
    const bf16_t* RIB = (const bf16_t*)(p.ws + WS_RIB);
    const float* RIW = (const float*)(p.ws + WS_RIW);
    float vv[16];
    float gC;
    bf16_t* S_AB = (bf16_t*)wl; bf16_t* S_BB = S_AB + 16 * 72; bf16_t* S_KB = S_BB + 16 * 72; bf16_t* S_RT = S_KB + 16 * 72;
    {
        unsigned ir[16], ik[16], ikk[16], ib[16], iv[16]; float iw[16];
#pragma unroll
        for (int t = 0; t < 16; ++t) {
            const unsigned idx = (unsigned)(row0 + t) * 1024u + (unsigned)col;
            ir[t] = RIB[idx]; ik[t] = RIB[(unsigned)NRI + idx]; ikk[t] = RIB[2u * (unsigned)NRI + idx]; ib[t] = RIB[3u * (unsigned)NRI + idx]; iv[t] = RIB[4u * (unsigned)NRI + idx]; iw[t] = RIW[idx];
        }
        __builtin_amdgcn_sched_barrier(0);
        float g = 1.f;
#pragma unroll
        for (int t = 0; t < 16; ++t) {
            vv[t] = bf2f((unsigned short)iv[t]);
            S_AB[t * 72 + lane] = f2bf(-g * bf2f((unsigned short)ikk[t]));
            g *= iw[t];
            const float ig = __builtin_amdgcn_rcpf(g);
            S_BB[t * 72 + lane] = f2bf(bf2f((unsigned short)ib[t]) * ig); S_KB[t * 72 + lane] = f2bf(bf2f((unsigned short)ik[t]) * ig); S_RT[t * 72 + lane] = f2bf(g * bf2f((unsigned short)ir[t]));
        }
        gC = g;
    }
    __builtin_amdgcn_fence(__ATOMIC_RELEASE, "wavefront"); __builtin_amdgcn_wave_barrier(); __builtin_amdgcn_fence(__ATOMIC_ACQUIRE, "wavefront");
    f32x4v Gab = {0.f, 0.f, 0.f, 0.f}, Gak = Gab, Grb = Gab, Grk = Gab;
    {
        const int rr = lane & 15, kg = lane >> 4;
#pragma unroll
        for (int ks = 0; ks < 2; ++ks) {
            const int o = rr * 72 + 32 * ks + 8 * kg;
            const bf16x8 fA = *(const bf16x8*)(S_AB + o), fB = *(const bf16x8*)(S_BB + o), fK = *(const bf16x8*)(S_KB + o), fR = *(const bf16x8*)(S_RT + o);
            Gab = __builtin_amdgcn_mfma_f32_16x16x32_bf16(fB, fA, Gab, 0, 0, 0);
            Gak = __builtin_amdgcn_mfma_f32_16x16x32_bf16(fK, fA, Gak, 0, 0, 0);
            Grb = __builtin_amdgcn_mfma_f32_16x16x32_bf16(fB, fR, Grb, 0, 0, 0);
            Grk = __builtin_amdgcn_mfma_f32_16x16x32_bf16(fK, fR, Grk, 0, 0, 0);
        }
    }
    __builtin_amdgcn_fence(__ATOMIC_RELEASE, "wavefront"); __builtin_amdgcn_wave_barrier(); __builtin_amdgcn_fence(__ATOMIC_ACQUIRE, "wavefront");
    float* M_AB = (float*)(wl + 9216); float* M_AK = M_AB + 256; float* M_RB = M_AK + 256; float* M_RK = M_RB + 256; float* T_ = M_RK + 256; float* Q_ = T_ + 256; float* W2_ = Q_ + 256;
    {
        const int t = lane & 15, kg = lane >> 4;
#pragma unroll
        for (int rg = 0; rg < 4; ++rg) {
            const int s = 4 * kg + rg;
            M_AB[s * 16 + t] = s < t ? Gab[rg] : 0.f; M_AK[s * 16 + t] = s < t ? Gak[rg] : 0.f;
            M_RB[s * 16 + t] = s <= t ? Grb[rg] : 0.f; M_RK[s * 16 + t] = s <= t ? Grk[rg] : 0.f;
        }
    }
    __builtin_amdgcn_fence(__ATOMIC_RELEASE, "wavefront"); __builtin_amdgcn_wave_barrier(); __builtin_amdgcn_fence(__ATOMIC_ACQUIRE, "wavefront");
    {
        const int rr = lane & 15;
        float Tr[16];
#pragma unroll
        for (int t = 0; t < 16; ++t) {
            float acc = (rr == t) ? 1.f : 0.f;
#pragma unroll
            for (int s = 0; s < t; ++s) acc += Tr[s] * M_AB[s * 16 + t];
            Tr[t] = acc;
        }
#pragma unroll
        for (int t = 0; t < 16; ++t) T_[rr * 16 + t] = Tr[t];
    }
    __builtin_amdgcn_fence(__ATOMIC_RELEASE, "wavefront"); __builtin_amdgcn_wave_barrier(); __builtin_amdgcn_fence(__ATOMIC_ACQUIRE, "wavefront");
    {
        const int s = lane & 15, tq = lane >> 4;
        float4 q = make_float4(0.f, 0.f, 0.f, 0.f);
#pragma unroll
        for (int u = 0; u < 16; ++u) { const float a = M_AK[s * 16 + u]; const float4 t4 = *(const float4*)(T_ + u * 16 + 4 * tq); q.x += a * t4.x; q.y += a * t4.y; q.z += a * t4.z; q.w += a * t4.w; }
        *(float4*)(Q_ + s * 16 + 4 * tq) = q;
        __builtin_amdgcn_fence(__ATOMIC_RELEASE, "wavefront"); __builtin_amdgcn_wave_barrier(); __builtin_amdgcn_fence(__ATOMIC_ACQUIRE, "wavefront");
        float4 w2 = *(const float4*)(M_RK + s * 16 + 4 * tq);
#pragma unroll
        for (int u = 0; u < 16; ++u) { const float a = Q_[s * 16 + u]; const float4 m4 = *(const float4*)(M_RB + u * 16 + 4 * tq); w2.x += a * m4.x; w2.y += a * m4.y; w2.z += a * m4.z; w2.w += a * m4.w; }
        *(float4*)(W2_ + s * 16 + 4 * tq) = w2;
    }
    __builtin_amdgcn_fence(__ATOMIC_RELEASE, "wavefront"); __builtin_amdgcn_wave_barrier(); __builtin_amdgcn_fence(__ATOMIC_ACQUIRE, "wavefront");
    cvt_f32x2 pt2[8], r22[8], ul2[8], yl2[8];
#pragma unroll
    for (int t = 0; t < 8; ++t) { pt2[t] = (cvt_f32x2){0.f, 0.f}; r22[t] = (cvt_f32x2){bf2f(S_RT[(2 * t) * 72 + lane]), bf2f(S_RT[(2 * t + 1) * 72 + lane])}; ul2[t] = pt2[t]; yl2[t] = pt2[t]; }
#pragma unroll
    for (int s = 0; s < 16; ++s) {
        const float as_ = bf2f(S_AB[s * 72 + lane]), vs_ = vv[s];
        const cvt_f32x2 as2 = {as_, as_}, vs2 = {vs_, vs_};
#pragma unroll
        for (int tq = 0; tq < 4; ++tq) {
            const float4 t4 = *(const float4*)(T_ + s * 16 + 4 * tq), q4 = *(const float4*)(Q_ + s * 16 + 4 * tq), w4 = *(const float4*)(W2_ + s * 16 + 4 * tq);
            pt2[2 * tq] += (cvt_f32x2){t4.x, t4.y} * as2; pt2[2 * tq + 1] += (cvt_f32x2){t4.z, t4.w} * as2;
            ul2[2 * tq] += (cvt_f32x2){q4.x, q4.y} * vs2; ul2[2 * tq + 1] += (cvt_f32x2){q4.z, q4.w} * vs2;
            yl2[2 * tq] += (cvt_f32x2){w4.x, w4.y} * vs2; yl2[2 * tq + 1] += (cvt_f32x2){w4.z, w4.w} * vs2;
        }
        __builtin_amdgcn_sched_barrier(0);
    }
    float pt[16], ul[16], yl[16];
#pragma unroll
    for (int t = 0; t < 8; ++t) { pt[2 * t] = pt2[t].x; pt[2 * t + 1] = pt2[t].y; ul[2 * t] = ul2[t].x; ul[2 * t + 1] = ul2[t].y; yl[2 * t] = yl2[t].x; yl[2 * t + 1] = yl2[t].y; }
#pragma unroll
    for (int s = 0; s < 16; ++s) {
        const cvt_f32x2 ps2 = {pt[s], pt[s]};
#pragma unroll
        for (int tq = 0; tq < 4; ++tq) {
            const float4 m4 = *(const float4*)(M_RB + s * 16 + 4 * tq);
            r22[2 * tq] += (cvt_f32x2){m4.x, m4.y} * ps2; r22[2 * tq + 1] += (cvt_f32x2){m4.z, m4.w} * ps2;
        }
        __builtin_amdgcn_sched_barrier(0);
    }
    float r2[16];
#pragma unroll
    for (int t = 0; t < 8; ++t) { r2[2 * t] = r22[t].x; r2[2 * t + 1] = r22[t].y; }
    unsigned char* rec = p.ws + WS_REC + (size_t)ct * REC_BYTES;
    float* ys = (float*)(p.ws + WS_RW);
    {
        const int jj = lane & 15, fo = (((lane >> 4) * 2 + ((jj >> 2) & 1)) * 16) * 16 + ((jj & 3) + 4 * (jj >> 3)) * 2;
#pragma unroll
        for (int t = 0; t < 16; ++t) {
            *(bf16_t*)(rec + fo + t * 16) = f2bf(pt[t]);
            *(bf16_t*)(rec + 2048 + fo + t * 16) = f2bf(r2[t]);
            ys[(unsigned)(row0 + t) * 1024u + (unsigned)col] = yl[t];
        }
    }
    {
        float gb[16], gk[16];
#pragma unroll
        for (int t = 0; t < 16; ++t) { gb[t] = gC * bf2f(S_BB[t * 72 + lane]); gk[t] = gC * bf2f(S_KB[t * 72 + lane]); }
        *(uint4*)(rec + 4096 + lane * 16) = make_uint4(pack2(gb[0], gb[1]), pack2(gb[2], gb[3]), pack2(gb[8], gb[9]), pack2(gb[10], gb[11]));
        *(uint4*)(rec + 4096 + (64 + lane) * 16) = make_uint4(pack2(gb[4], gb[5]), pack2(gb[6], gb[7]), pack2(gb[12], gb[13]), pack2(gb[14], gb[15]));
        *(uint4*)(rec + 6144 + lane * 16) = make_uint4(pack2(gk[0], gk[1]), pack2(gk[2], gk[3]), pack2(gk[4], gk[5]), pack2(gk[6], gk[7]));
        *(uint4*)(rec + 6144 + (64 + lane) * 16) = make_uint4(pack2(gk[8], gk[9]), pack2(gk[10], gk[11]), pack2(gk[12], gk[13]), pack2(gk[14], gk[15]));
        *(float*)(rec + 8192 + lane * 4) = gC;
        unsigned char* ip = rec + 8448 + (lane >> 5) * 3072;
        const int il = lane & 31;
        *(uint4*)(ip + il * 16) = make_uint4(pack2(vv[0], vv[1]), pack2(vv[2], vv[3]), pack2(vv[4], vv[5]), pack2(vv[6], vv[7]));
        *(uint4*)(ip + (32 + il) * 16) = make_uint4(pack2(vv[8], vv[9]), pack2(vv[10], vv[11]), pack2(vv[12], vv[13]), pack2(vv[14], vv[15]));
#pragma unroll
        for (int tq = 0; tq < 4; ++tq) *(float4*)(ip + 1024 + (((tq >> 1) * 2 + (tq & 1)) * 32 + il) * 16) = make_float4(ul[4 * tq], ul[4 * tq + 1], ul[4 * tq + 2], ul[4 * tq + 3]);
    }
    __builtin_amdgcn_fence(__ATOMIC_RELEASE, "wavefront"); __builtin_amdgcn_wave_barrier();
}

__device__ void pa_sample_task(const Params& p, int l, int task) {
    const int lane = opq_tid() & 63;
    const int bd = task >> 8, h = (task >> 4) & 15, wq = task & 15;
    const int irow = 4 * wq + (lane >> 4), jq = lane & 15;
    const size_t row = (size_t)TP + bd;
    const bf16_t* RIB = (const bf16_t*)(p.ws + WS_RIB);
    const float* RIW = (const float*)(p.ws + WS_RIW);
    float* ys = (float*)(p.ws + WS_RW);
    const size_t so = (((size_t)(l * NBS + bd) * 16 + h) * 64 + irow) * 64 + 4 * jq;
    float4 s = *(const float4*)(p.state_wkv + so);
    const size_t o = row * 1024 + h * 64 + 4 * jq;
    const uint2 ur = *(const uint2*)(RIB + o), uk = *(const uint2*)(RIB + NRI + o), ukk = *(const uint2*)(RIB + 2 * NRI + o), ub = *(const uint2*)(RIB + 3 * NRI + o);
    const float4 w4 = *(const float4*)(RIW + o);
    const float v = bf2f(RIB[4 * NRI + row * 1024 + h * 64 + irow]);
    float pa = s.x * bflo(ukk.x) + s.y * bfhi(ukk.x) + s.z * bflo(ukk.y) + s.w * bfhi(ukk.y);
    pa = allreduce16(pa);
    const float sa = -pa;
    s.x = fmaf(sa, bflo(ub.x), fmaf(s.x, w4.x, v * bflo(uk.x)));
    s.y = fmaf(sa, bfhi(ub.x), fmaf(s.y, w4.y, v * bfhi(uk.x)));
    s.z = fmaf(sa, bflo(ub.y), fmaf(s.z, w4.z, v * bflo(uk.y)));
    s.w = fmaf(sa, bfhi(ub.y), fmaf(s.w, w4.w, v * bfhi(uk.y)));
    float py = s.x * bflo(ur.x) + s.y * bfhi(ur.x) + s.z * bflo(ur.y) + s.w * bfhi(ur.y);
    py = allreduce16(py);
    *(float4*)(p.out + O_WKVS + so) = s;
    if (jq == 0) ys[row * 1024 + h * 64 + irow] = py;
}

constexpr int PB_NB = 8, PB_SLOT = 13568, PB_NCH = SEQ / 16, PB_NX = 4, PB_XOFF = PB_NB * PB_SLOT  , PB_FOFF = PB_XOFF + PB_NX * 4096;
__device__ void pb_head(const Params& p, unsigned char* lds, int l, int blk, bool dry) {
    const int tid = opq_tid(), wv = tid >> 6, lane = tid & 63;
    const int hh = blk >> 1, it = blk & 1, b = hh >> 4, h = hh & 15;
    volatile LAS unsigned* flags = (volatile LAS unsigned*)((LAS unsigned char*)lds + PB_FOFF);
    if (tid < 16) flags[tid] = 0u;
    __syncthreads();
    const unsigned char* rec0 = p.ws + WS_REC + (size_t)(hh * 256) * REC_BYTES;
    float* ys = (float*)(p.ws + WS_RW) + ((size_t)b * SEQ) * 1024 + h * 64 + 32 * it;
    const int q32 = lane & 31, hf = lane >> 5;
    if (wv >= 2) {
#pragma unroll 1
        for (int c = wv - 2; c < PB_NCH; c += 6) {
            while (c - (int)flags[8] >= PB_NB || c - (int)flags[9] >= PB_NB) __builtin_amdgcn_s_sleep(1);
            asm volatile("" ::: "memory");
            const unsigned char* rec = rec0 + (size_t)c * REC_BYTES;
            unsigned char* sl = lds + (c % PB_NB) * PB_SLOT;
            const unsigned char* rc = rec + lane * 16;
            const unsigned char* ri = rec + 8448 + it * 3072 + lane * 16;
            const uint4 d0 = *(const uint4*)(rc), d1 = *(const uint4*)(rc + 1024), d2 = *(const uint4*)(rc + 2048), d3 = *(const uint4*)(rc + 3072);
            const uint4 d4 = *(const uint4*)(rc + 4096), d5 = *(const uint4*)(rc + 5120), d6 = *(const uint4*)(rc + 6144), d7 = *(const uint4*)(rc + 7168);
            const uint4 d8 = *(const uint4*)(rec + 8192 + (lane & 15) * 16);
            const uint4 d9 = *(const uint4*)(ri), d10 = *(const uint4*)(ri + 1024), d11 = *(const uint4*)(ri + 2048);
            const int t0 = lane >> 3, cc = lane & 7;
            const uint4 d12 = *(const uint4*)(ys + (size_t)(16 * c + t0) * 1024 + cc * 4), d13 = *(const uint4*)(ys + (size_t)(16 * c + 8 + t0) * 1024 + cc * 4);
            __builtin_amdgcn_sched_barrier(0);
            unsigned char* sd = sl + lane * 16;
            *(uint4*)(sd) = d0; *(uint4*)(sd + 1024) = d1; *(uint4*)(sd + 2048) = d2; *(uint4*)(sd + 3072) = d3;
            *(uint4*)(sd + 4096) = d4; *(uint4*)(sd + 5120) = d5; *(uint4*)(sd + 6144) = d6; *(uint4*)(sd + 7168) = d7;
            if (lane < 16) *(uint4*)(sl + 8192 + lane * 16) = d8;
            *(uint4*)(sd + 8448) = d9; *(uint4*)(sd + 9472) = d10; *(uint4*)(sd + 10496) = d11;
            {
                float* yd = (float*)(sl + 11520) + ((((t0 >> 2) & 1) * 32 + 4 * cc) * 4 + (t0 & 3));
                yd[0] = __uint_as_float(d12.x); yd[4] = __uint_as_float(d12.y); yd[8] = __uint_as_float(d12.z); yd[12] = __uint_as_float(d12.w);
                yd[256] = __uint_as_float(d13.x); yd[260] = __uint_as_float(d13.y); yd[264] = __uint_as_float(d13.z); yd[268] = __uint_as_float(d13.w);
            }
            asm volatile("" ::: "memory");
            if (lane == 0) flags[c % PB_NB] = (unsigned)(c + 1);
        }
    } else if (wv == 1) {
        bf16x8 ra0, ra1, ra2, ra3; float4 y0, y1;
#define PB_FETCHY(c_) do { const unsigned char* sl_ = lds + ((c_) % PB_NB) * PB_SLOT; \
            while (flags[(c_) % PB_NB] != (unsigned)((c_) + 1)) __builtin_amdgcn_s_sleep(0); \
            asm volatile("" ::: "memory"); \
            const unsigned char* pr_ = sl_ + 2048 + (hf * 16 + (q32 & 15)) * 16; \
            ra0 = *(const bf16x8*)(pr_); ra1 = *(const bf16x8*)(pr_ + 512); ra2 = *(const bf16x8*)(pr_ + 1024); ra3 = *(const bf16x8*)(pr_ + 1536); \
            y0 = *(const float4*)(sl_ + 11520 + (hf * 32 + q32) * 16); y1 = *(const float4*)(sl_ + 11520 + ((2 + hf) * 32 + q32) * 16); \
            asm volatile("" ::: "memory"); \
            if (lane == 0) flags[9] = (unsigned)((c_) + 1); } while (0)
        PB_FETCHY(0);
#pragma unroll 1
        for (int c = 0; c < PB_NCH; ++c) {
            const unsigned char* xr = lds + PB_XOFF + (c % PB_NX) * 4096 + lane * 16;
            f32x16 Ya, Yb;
            Ya[0] = y0.x; Ya[1] = y0.y; Ya[2] = y0.z; Ya[3] = y0.w; Ya[4] = y1.x; Ya[5] = y1.y; Ya[6] = y1.z; Ya[7] = y1.w;
#pragma unroll
            for (int r = 8; r < 16; ++r) Ya[r] = 0.f;
#pragma unroll
            for (int r = 0; r < 16; ++r) Yb[r] = 0.f;
            const bf16x8 rc0 = ra0, rc1 = ra1, rc2 = ra2, rc3 = ra3;
            while (flags[10 + (c % PB_NX)] != (unsigned)(c + 1)) __builtin_amdgcn_s_sleep(0);
            asm volatile("" ::: "memory");
            const bf16x8 xf0 = *(const bf16x8*)(xr), xf1 = *(const bf16x8*)(xr + 1024), xf2 = *(const bf16x8*)(xr + 2048), xf3 = *(const bf16x8*)(xr + 3072);
            asm volatile("" ::: "memory");
            if (lane == 0) flags[14] = (unsigned)(c + 1);
            Ya = __builtin_amdgcn_mfma_f32_32x32x16_bf16(rc0, xf0, Ya, 0, 0, 0);
            Yb = __builtin_amdgcn_mfma_f32_32x32x16_bf16(rc1, xf1, Yb, 0, 0, 0);
            Ya = __builtin_amdgcn_mfma_f32_32x32x16_bf16(rc2, xf2, Ya, 0, 0, 0);
            Yb = __builtin_amdgcn_mfma_f32_32x32x16_bf16(rc3, xf3, Yb, 0, 0, 0);
            if (c + 1 < PB_NCH) PB_FETCHY(c + 1);
            float* yc = ys + (size_t)c * (16 * 1024);
            if (!dry) {
#pragma unroll
                for (int r = 0; r < 8; ++r) yc[(8 * (r >> 2) + 4 * hf + (r & 3)) * 1024 + q32] = Ya[r] + Yb[r];
            }
        }
#undef PB_FETCHY
    } else {
        f32x16 X0, X1;
#pragma unroll
        for (int i = 0; i < 16; ++i) { X0[i] = 0.f; X1[i] = 0.f; }
        bf16x8 pa0, pa1, pa2, pa3, gb0, gb1, gk0, gk1, vf;
        float4 gm0, gm1, gm2, gm3, gm4, gm5, gm6, gm7, u0, u1;
#define PB_FETCH(c_) do { const unsigned char* sl_ = lds + ((c_) % PB_NB) * PB_SLOT; \
            { unsigned rv_ = rdy; while (rv_ != (unsigned)((c_) + 1)) { __builtin_amdgcn_s_sleep(0); rv_ = flags[(c_) % PB_NB]; } } \
            asm volatile("" ::: "memory"); \
            const unsigned char* pr_ = sl_ + (hf * 16 + (q32 & 15)) * 16; \
            pa0 = *(const bf16x8*)(pr_); pa1 = *(const bf16x8*)(pr_ + 512); pa2 = *(const bf16x8*)(pr_ + 1024); pa3 = *(const bf16x8*)(pr_ + 1536); \
            gb0 = *(const bf16x8*)(sl_ + 4096 + (hf * 64 + q32) * 16); gb1 = *(const bf16x8*)(sl_ + 4096 + (hf * 64 + 32 + q32) * 16); \
            gk0 = *(const bf16x8*)(sl_ + 6144 + (hf * 64 + q32) * 16); gk1 = *(const bf16x8*)(sl_ + 6144 + (hf * 64 + 32 + q32) * 16); \
            vf = *(const bf16x8*)(sl_ + 8448 + (hf * 32 + q32) * 16); \
            const unsigned char* gp_ = sl_ + 8192 + 16 * hf; \
            gm0 = *(const float4*)(gp_); gm1 = *(const float4*)(gp_ + 32); gm2 = *(const float4*)(gp_ + 64); gm3 = *(const float4*)(gp_ + 96); \
            gm4 = *(const float4*)(gp_ + 128); gm5 = *(const float4*)(gp_ + 160); gm6 = *(const float4*)(gp_ + 192); gm7 = *(const float4*)(gp_ + 224); \
            u0 = *(const float4*)(sl_ + 9472 + (hf * 32 + q32) * 16); u1 = *(const float4*)(sl_ + 9472 + ((2 + hf) * 32 + q32) * 16); \
            asm volatile("" ::: "memory"); \
            if (lane == 0) flags[8] = (unsigned)((c_) + 1); } while (0)
        unsigned rdy = flags[0];
        PB_FETCH(0);
        int xfree = 0;
#pragma unroll 1
        for (int c = 0; c < PB_NCH; ++c) {
            unsigned char* xw = lds + PB_XOFF + (c % PB_NX) * 4096 + lane * 16;
            rdy = flags[(c + 1) % PB_NB];
            const bf16x8 xb0 = __builtin_bit_cast(bf16x8, make_uint4(pack2(X0[0], X0[1]), pack2(X0[2], X0[3]), pack2(X0[4], X0[5]), pack2(X0[6], X0[7])));
            const bf16x8 xb1 = __builtin_bit_cast(bf16x8, make_uint4(pack2(X0[8], X0[9]), pack2(X0[10], X0[11]), pack2(X0[12], X0[13]), pack2(X0[14], X0[15])));
            const bf16x8 xb2 = __builtin_bit_cast(bf16x8, make_uint4(pack2(X1[0], X1[1]), pack2(X1[2], X1[3]), pack2(X1[4], X1[5]), pack2(X1[6], X1[7])));
            const bf16x8 xb3 = __builtin_bit_cast(bf16x8, make_uint4(pack2(X1[8], X1[9]), pack2(X1[10], X1[11]), pack2(X1[12], X1[13]), pack2(X1[14], X1[15])));
            f32x16 Ua, Ub;
            Ua[0] = u0.x; Ua[1] = u0.y; Ua[2] = u0.z; Ua[3] = u0.w; Ua[4] = u1.x; Ua[5] = u1.y; Ua[6] = u1.z; Ua[7] = u1.w;
#pragma unroll
            for (int r = 8; r < 16; ++r) Ua[r] = 0.f;
#pragma unroll
            for (int r = 0; r < 16; ++r) Ub[r] = 0.f;
            Ua = __builtin_amdgcn_mfma_f32_32x32x16_bf16(pa0, xb0, Ua, 0, 0, 0);
            Ub = __builtin_amdgcn_mfma_f32_32x32x16_bf16(pa1, xb1, Ub, 0, 0, 0);
            Ua = __builtin_amdgcn_mfma_f32_32x32x16_bf16(pa2, xb2, Ua, 0, 0, 0);
            Ub = __builtin_amdgcn_mfma_f32_32x32x16_bf16(pa3, xb3, Ub, 0, 0, 0);
            f32x16 Xn0, Xn1;
            Xn0[0] = X0[0] * gm0.x; Xn0[1] = X0[1] * gm0.y; Xn0[2] = X0[2] * gm0.z; Xn0[3] = X0[3] * gm0.w; Xn0[4] = X0[4] * gm1.x; Xn0[5] = X0[5] * gm1.y; Xn0[6] = X0[6] * gm1.z; Xn0[7] = X0[7] * gm1.w;
            Xn0[8] = X0[8] * gm2.x; Xn0[9] = X0[9] * gm2.y; Xn0[10] = X0[10] * gm2.z; Xn0[11] = X0[11] * gm2.w; Xn0[12] = X0[12] * gm3.x; Xn0[13] = X0[13] * gm3.y; Xn0[14] = X0[14] * gm3.z; Xn0[15] = X0[15] * gm3.w;
            Xn1[0] = X1[0] * gm4.x; Xn1[1] = X1[1] * gm4.y; Xn1[2] = X1[2] * gm4.z; Xn1[3] = X1[3] * gm4.w; Xn1[4] = X1[4] * gm5.x; Xn1[5] = X1[5] * gm5.y; Xn1[6] = X1[6] * gm5.z; Xn1[7] = X1[7] * gm5.w;
            Xn1[8] = X1[8] * gm6.x; Xn1[9] = X1[9] * gm6.y; Xn1[10] = X1[10] * gm6.z; Xn1[11] = X1[11] * gm6.w; Xn1[12] = X1[12] * gm7.x; Xn1[13] = X1[13] * gm7.y; Xn1[14] = X1[14] * gm7.z; Xn1[15] = X1[15] * gm7.w;
            Xn0 = __builtin_amdgcn_mfma_f32_32x32x16_bf16(gk0, vf, Xn0, 0, 0, 0);
            Xn1 = __builtin_amdgcn_mfma_f32_32x32x16_bf16(gk1, vf, Xn1, 0, 0, 0);
            const bf16x8 gbc0 = gb0, gbc1 = gb1;
            while (c - xfree >= PB_NX) { xfree = (int)flags[14]; }
            asm volatile("" ::: "memory");
            *(bf16x8*)(xw) = xb0; *(bf16x8*)(xw + 1024) = xb1; *(bf16x8*)(xw + 2048) = xb2; *(bf16x8*)(xw + 3072) = xb3;
            asm volatile("" ::: "memory");
            if (lane == 0) flags[10 + (c % PB_NX)] = (unsigned)(c + 1);
            if (c + 1 < PB_NCH) PB_FETCH(c + 1);
            const bf16x8 ub = __builtin_bit_cast(bf16x8, make_uint4(pack2(Ua[0] + Ub[0], Ua[1] + Ub[1]), pack2(Ua[2] + Ub[2], Ua[3] + Ub[3]), pack2(Ua[4] + Ub[4], Ua[5] + Ub[5]), pack2(Ua[6] + Ub[6], Ua[7] + Ub[7])));
            X0 = __builtin_amdgcn_mfma_f32_32x32x16_bf16(gbc0, ub, Xn0, 0, 0, 0);
            X1 = __builtin_amdgcn_mfma_f32_32x32x16_bf16(gbc1, ub, Xn1, 0, 0, 0);
        }
#undef PB_FETCH
        float* so = p.out + O_WKVP + ((size_t)(l * NBP + b) * 16 + h) * 4096 + (size_t)(32 * it + q32) * 64;
#pragma unroll
        for (int g = 0; g < 4; ++g) {
            *(float4*)(so + 8 * g + 4 * hf) = make_float4(X0[4 * g], X0[4 * g + 1], X0[4 * g + 2], X0[4 * g + 3]);
            *(float4*)(so + 32 + 8 * g + 4 * hf) = make_float4(X1[4 * g], X1[4 * g + 1], X1[4 * g + 2], X1[4 * g + 3]);
        }
    }
    __syncthreads();
}

__device__ void p3_post(const Params& p, int l, int bid, int G) {
    const int tid = opq_tid(), wv = tid >> 6, lane = tid & 63;
    const float* ys = (const float*)(p.ws + WS_RW);
    const bf16_t* V = (const bf16_t*)(p.ws + WS_RIB) + 4 * NRI;
    const float* coef = (const float*)(p.ws + WS_COEF);
    const bf16_t* gt = (const bf16_t*)(p.ws + WS_GT);
    bf16_t* cc = (bf16_t*)(p.ws + WS_HB);
    for (int r = bid * 8 + wv; r < MT; r += G * 8) {
#pragma unroll
        for (int hg = 0; hg < 4; ++hg) {
            const int head = 4 * hg + (lane >> 4), c = head * 64 + 4 * (lane & 15);
            const float4 y = *(const float4*)(ys + (size_t)r * 1024 + c);
            const float mu = allreduce16(y.x + y.y + y.z + y.w) * (1.f / 64.f);
            const float d0 = y.x - mu, d1 = y.y - mu, d2 = y.z - mu, d3 = y.w - mu;
            const float var = allreduce16(d0 * d0 + d1 * d1 + d2 * d2 + d3 * d3) * (1.f / 64.f);
            const float rs = rsqrtf(var + 64e-5f);
            const float4 lw = *(const float4*)(p.ln_w + l * 1024 + c), lb = *(const float4*)(p.ln_b + l * 1024 + c);
            const uint2 vu = *(const uint2*)(V + (size_t)r * 1024 + c);
            const float4 v4 = make_float4(bflo(vu.x), bfhi(vu.x), bflo(vu.y), bfhi(vu.y));
            const float cf = coef[(size_t)r * 16 + head];
            const uint2 gg = *(const uint2*)(gt + (size_t)r * DM + 1024 + c);
            const float o0 = (d0 * rs * lw.x + lb.x + cf * v4.x) * bflo(gg.x), o1 = (d1 * rs * lw.y + lb.y + cf * v4.y) * bfhi(gg.x);
            const float o2 = (d2 * rs * lw.z + lb.z + cf * v4.z) * bflo(gg.y), o3 = (d3 * rs * lw.w + lb.w + cf * v4.w) * bfhi(gg.y);
            *(uint2*)(cc + (size_t)r * DM + 1024 + c) = make_uint2(pack2(o0, o1), pack2(o2, o3));
        }
    }
}

__device__ void p_final(const Params& p, int bid, int G) {
    const int tid = opq_tid(), wv = tid >> 6, lane = tid & 63;
    const float4* g4 = (const float4*)p.final_g;
    for (int r = bid * 8 + wv; r < MT; r += G * 8) {
        float4* xr = (float4*)(p.out + (size_t)r * DM);
        float4 v[8]; float ss = 0.f;
#pragma unroll
        for (int i = 0; i < 8; ++i) { v[i] = xr[lane + 64 * i]; ss += v[i].x * v[i].x + v[i].y * v[i].y + v[i].z * v[i].z + v[i].w * v[i].w; }
        ss = wave_sum(ss);
        const float rinv = rsqrtf(ss * (1.f / 2048.f) + 1e-5f);
#pragma unroll
        for (int i = 0; i < 8; ++i) { const float4 g = g4[lane + 64 * i]; xr[lane + 64 * i] = make_float4(v[i].x * rinv * g.x, v[i].y * rinv * g.y, v[i].z * rinv * g.z, v[i].w * rinv * g.w); }
    }
}

#ifndef REPL
#define REPL -1
#endif
#ifndef REPK
#define REPK -100
#endif
__global__ void __launch_bounds__(512, 2) fwd_kernel(Params p_unused) {
    extern __shared__ __attribute__((aligned(16))) unsigned char shm[];
    cg::grid_group grid = cg::this_grid();
    const int bid0 = blockIdx.x, G0 = gridDim.x;
    float* shf = (float*)shm;
    volatile LAS unsigned* xst = (volatile LAS unsigned*)((LAS unsigned char*)shm + 131072);
    if (threadIdx.x == 0) { xst[0] = 0u; xst[1] = 0u; }
    __syncthreads();
    const XcdBarrier xb = xcd_barrier_post((unsigned*)(kparams().ws + WS_BAR), xst);
    if (G0 == 0x7fffffff) grid.sync();

#pragma unroll 1
    for (int ph = 0; ph < 16; ++ph) {
        const int bid = opq_s(bid0), G = opq_s(G0);
        const int l = ph >= 8 ? 1 : 0, k = ph == 0 ? -1 : (ph == 15 ? 7 : (ph - 1) - 7 * l);
#pragma unroll 1
        for (int rep = 0; rep < ((k == kparams().repk && (kparams().repl < 0 || kparams().repl == l)) ? 2 : 1); ++rep) {
        if (k == -1) {
            for (int it = bid; it < 384; it += G) p0_mod_item(kparams(), shf, it / 192, it % 192);
            for (int it = bid; it < 17; it += G) p0_rope_item(kparams(), it);
            p0_conv_all(kparams(), shf, bid, G, 2752, 0);
        } else if (k == 0) {
            p1_norm(kparams(), l, bid, G);
        } else if (k == 1) {
            pg8::StaticOrder S; S.init(MP, INWP, G, bid);
            pg8::Gemm g{(const bf16_t*)(kparams().ws + WS_HB), (const bf16_t*)(kparams().ws + WS_WTIN), MP, INWP, DM};
            Epi1 E{l};
            pg8::gemm_phase<Epi1, pg8::StaticOrder, false>((PG8_LAS unsigned char*)shm, g, S, E, nullptr);
        } else if (k == 2) {
            for (int it = bid; it < 256 + 257; it += G) {
                if (it < 256) p3_attn_unit(kparams(), shm, l, it);
                else p3_prep_tile(kparams(), shm, l, it - 256);
            }
        } else if (k == 3) {
            const int wvq = opq_tid() >> 6, gw = bid * 8 + wvq, nw = G * 8;
            for (int ct = gw; ct < 32 * 256; ct += nw) pa_chunk(kparams(), shm + wvq * PA_WLDS, l, ct);
            for (int task = gw; task < NBS * 256; task += nw) pa_sample_task(kparams(), l, task);
        } else if (k == 4) {
            if (bid < 64) pb_head(kparams(), shm, l, bid, rep == 0 && k == kparams().repk);
            else if (bid < 128) p3_sattn_item(kparams(), shf, l, bid - 64);
            else if (l == 0) p0_conv_all(kparams(), shf, bid - 128, G - 128, 1728, 1);
        } else if (k == 5) {
            p3_post(kparams(), l, bid, G);
        } else if (k == 6) {
            pg8::StaticOrder S; S.init(TP, DM, G, bid);
            pg8::Gemm g{(const bf16_t*)(kparams().ws + WS_HB), (const bf16_t*)(kparams().ws + WS_WTOUT) + (size_t)l * DM * DM, TP, DM, DM};
            Epi2 E{l};
            pg8::gemm_phase<Epi2, pg8::StaticOrder, false>((PG8_LAS unsigned char*)shm, g, S, E, nullptr);
            for (int nb = bid; nb < 64; nb += G) g2_sample_item(kparams(), shf, l, nb);
        } else {
            p_final(kparams(), bid, G);
        }
        if (ph < 15) xcd_barrier(xb);
        }
    }
}

extern "C" void kernel_launch(void* const* d_in, const int* in_sizes, int n_in, void* d_out, int out_size, void* d_ws, size_t ws_size, hipStream_t stream) {
    static int grid_blocks = 0;
    if (grid_blocks == 0) {
        if (n_in != 25 || (size_t)out_size != O_END || ws_size < WS_END) {
            fprintf(stderr, "kernel_launch: unexpected shapes: n_in %d out_size %d ws_size %zu (need %zu)\n", n_in, out_size, ws_size, (size_t)WS_END);
            grid_blocks = -1; return;
        }
        if (hipFuncSetAttribute((const void*)fwd_kernel, hipFuncAttributeMaxDynamicSharedMemorySize, LDS_BYTES) != hipSuccess) { fprintf(stderr, "kernel_launch: hipFuncSetAttribute failed\n"); grid_blocks = -1; return; }
        int dev = 0, cus = 0, per_cu = 0;
        hipGetDevice(&dev);
        hipDeviceGetAttribute(&cus, hipDeviceAttributeMultiprocessorCount, dev);
        hipOccupancyMaxActiveBlocksPerMultiprocessor(&per_cu, (const void*)fwd_kernel, 512, LDS_BYTES);
        if (per_cu < 1) { fprintf(stderr, "kernel_launch: occupancy query gives %d blocks per CU\n", per_cu); per_cu = 1; }
        (void)hipGetLastError();
        grid_blocks = cus;
        if (grid_blocks < 192) { fprintf(stderr, "kernel_launch: only %d CUs\n", grid_blocks); grid_blocks = -1; return; }
    }
    if (grid_blocks < 0) return;
    if (hipMemsetAsync((unsigned char*)d_ws + WS_BAR, 0, 16384, stream) != hipSuccess) { fprintf(stderr, "kernel_launch: memset of the barrier words failed\n"); return; }
    Params p{};
    const float** pp = (const float**)&p;
    for (int i = 0; i < 25; ++i) pp[i] = (const float*)d_in[i];
    p.out = (float*)d_out; p.ws = (unsigned char*)d_ws; p.repk = REPK; p.repl = REPL;
    void* args[] = {&p};
    hipError_t e = hipLaunchCooperativeKernel((const void*)fwd_kernel, dim3(grid_blocks), dim3(512), args, LDS_BYTES, stream);
    if (e != hipSuccess) fprintf(stderr, "cooperative launch failed: %s (grid %d)\n", hipGetErrorString(e), grid_blocks);
}
```

```cpp
#include <hip/hip_runtime.h>
#include <hip/hip_cooperative_groups.h>
#include <cstdio>
namespace cg = cooperative_groups;
__device__ __forceinline__ int opq_tid() { int t = threadIdx.x; asm volatile("" : "+v"(t)); return t; }
__device__ __forceinline__ int opq_s(int x) { asm volatile("" : "+s"(x)); return x; }
typedef float cvt_f32x2 __attribute__((ext_vector_type(2)));
typedef __bf16 cvt_bf16x2 __attribute__((ext_vector_type(2)));
__device__ __forceinline__ unsigned hw_cvt_pk_bf16(float lo, float hi) { const cvt_f32x2 v = {lo, hi}; return __builtin_bit_cast(unsigned, __builtin_convertvector(v, cvt_bf16x2)); }
namespace pg8 {
#define PG8_LAS __attribute__((address_space(3)))
typedef unsigned short bf16_t;
typedef short bf16x8 __attribute__((ext_vector_type(8)));
typedef float f32x4 __attribute__((ext_vector_type(4)));
typedef unsigned u32x4 __attribute__((ext_vector_type(4)));
constexpr int BM = 256, BK = 64, HALF = 128, HTB = HALF * BK * 2  , STAGE_BYTES = 8 * HTB, NXCD = 8, WGM = 8;

__host__ __device__ __forceinline__ int lds_byte(int r, int c) { const int st = (r >> 4) * 2 + (c >> 5), rr = r & 15, cc = c & 31, ob = rr * 64 + cc * 2; return st * 1024 + (ob ^ (((ob >> 9) & 1) << 5)); }
__host__ __device__ __forceinline__ void stage_rc(int b, int& R, int& C) { const int st = b / 1024, sb = b % 1024, swz = sb ^ (((sb >> 9) & 1) << 5); R = (st >> 1) * 16 + swz / 64; C = (st & 1) * 32 + (swz % 64) / 2; }
__host__ __device__ __forceinline__ int perm32(int rho) { const int n = rho >> 4, i = rho & 15; return 8 * (i >> 2) + 4 * n + (i & 3); }

struct Unit { int pm, pn; };
struct Gemm { const bf16_t* A; const bf16_t* Bt; int M, N, K; };

struct StaticOrder {
    int nM, nN, nwg, G, c;
    __host__ __device__ void init(int M, int N, int G_, int c_) { nM = M / BM; nN = N / BM; nwg = nM * nN; G = G_; c = c_; }
    __host__ __device__ bool next(int i, Unit& u) const {
        const long L = (long)i * G + c; if (L >= nwg) return false;
        int wgid = (int)L; { const int q = nwg / NXCD, r = nwg % NXCD, xcd = wgid % NXCD, off = wgid / NXCD; wgid = (xcd < r ? xcd * (q + 1) : r * (q + 1) + (xcd - r) * q) + off; }
        const int nig = WGM * nN, gid = wgid / nig, fm = gid * WGM, gsz = (nM - fm) < WGM ? (nM - fm) : WGM;
        u.pm = fm + ((wgid % nig) % gsz); u.pn = (wgid % nig) / gsz; return true;
    }
    __device__ __forceinline__ void a_ready(const Unit&) const {}
    __device__ __forceinline__ void done(const Unit&) const {}
};
template <class Epi, class Sched, bool STAMP = false>
__device__ __forceinline__ void gemm_phase(PG8_LAS unsigned char* lds, const Gemm g, const Sched& S, const Epi& E, unsigned long long* stamps) {
    const int tid = opq_tid(), wid = __builtin_amdgcn_readfirstlane(tid >> 6), lane = tid & 63, wr = wid >> 2, wc = wid & 3, fr = lane & 15, fq = lane >> 4;
    const int K = g.K, nt = K / BK;
    int ts_lo = 0, ts_hi = 0, nts = 0; const unsigned long long rt_entry = STAMP ? (unsigned long long)wall_clock64() : 0ull;
#define PG8_STAMP() do { if (STAMP && wid == 0 && nts < 64) { const unsigned long long _c = (unsigned long long)clock64(); \
        ts_lo = (lane == nts) ? (int)(unsigned)_c : ts_lo; ts_hi = (lane == nts) ? (int)(unsigned)(_c >> 32) : ts_hi; ++nts; } } while (0)
    PG8_STAMP();
    unsigned voffA[2], voffB[2];
#pragma unroll
    for (int i = 0; i < 2; ++i) { int R, C; stage_rc(tid * 16 + i * 8192, R, C); const int Rb = Epi::PERM ? ((R & ~31) + perm32(R & 31)) : R;
        voffA[i] = (unsigned)(R * K + C) * 2u; voffB[i] = (unsigned)(Rb * K + C) * 2u; }
    const size_t kstep = (size_t)(BK * 2);
    const size_t hstep = (size_t)HALF * K * 2;
    const size_t tstep = 2 * hstep;
    const unsigned ldsw = (unsigned)wid * 1024u;
    const int aoff = lds_byte(wr * 64 + fr, fq * 8), boff = lds_byte(wc * 32 + fr, fq * 8);
#define PG8_SA(b, h) (((b) * 2 + (h)) * HTB)
#define PG8_SB(b, h) ((4 + (b) * 2 + (h)) * HTB)
#define PG8_STAGE(bufoff, gbase, voff) do { _Pragma("unroll") for (int _i = 0; _i < 2; ++_i) \
        __builtin_amdgcn_global_load_lds((const unsigned*)((const char*)(gbase) + (voff)[_i]), (PG8_LAS unsigned*)(lds + (bufoff) + ldsw + _i * 8192), 16, 0, 0); } while (0)
#define PG8_LDA(dst, b, h) do { _Pragma("unroll") for (int m = 0; m < 4; ++m) _Pragma("unroll") for (int k = 0; k < 2; ++k) dst[m][k] = *(const PG8_LAS bf16x8*)(lds + PG8_SA(b, h) + aoff + m * 2048 + k * 1024); } while (0)
#define PG8_LDB(dst, b, h) do { _Pragma("unroll") for (int n = 0; n < 2; ++n) _Pragma("unroll") for (int k = 0; k < 2; ++k) dst[n][k] = *(const PG8_LAS bf16x8*)(lds + PG8_SB(b, h) + boff + n * 2048 + k * 1024); } while (0)
#define PG8_MMA(ai, bj, At, Bt) do { __builtin_amdgcn_s_setprio(1); _Pragma("unroll") for (int m = 0; m < 4; ++m) _Pragma("unroll") for (int n = 0; n < 2; ++n) _Pragma("unroll") for (int k = 0; k < 2; ++k) \
        acc[ai][bj][m][n] = __builtin_amdgcn_mfma_f32_16x16x32_bf16(Bt[n][k], At[m][k], acc[ai][bj][m][n], 0, 0, 0); __builtin_amdgcn_s_setprio(0); } while (0)
#define PG8_WAIT_V(n) asm volatile("s_waitcnt vmcnt(" #n ")" ::: "memory")
#define PG8_WAIT_L(n) asm volatile("s_waitcnt lgkmcnt(" #n ")" ::: "memory")
#define PG8_BAR __builtin_amdgcn_s_barrier()
#define PG8_SCHED __builtin_amdgcn_sched_barrier(0)
    Unit cur, nxt; int ui = 0;
    if (!S.next(0, cur)) return;
    f32x4 acc[2][2][4][2];
#pragma unroll
    for (int a = 0; a < 2; ++a)
#pragma unroll
        for (int b = 0; b < 2; ++b)
#pragma unroll
            for (int m = 0; m < 4; ++m)
#pragma unroll
                for (int n = 0; n < 2; ++n) acc[a][b][m][n] = (f32x4){0.f, 0.f, 0.f, 0.f};
    bf16x8 At[4][2], B0[2][2], B1[2][2];
    const char* cA = (const char*)g.A + (size_t)cur.pm * tstep; const char* cB = (const char*)g.Bt + (size_t)cur.pn * tstep;
    S.a_ready(cur);
    PG8_STAGE(PG8_SB(0, 0), cB, voffB); PG8_STAGE(PG8_SA(0, 0), cA, voffA); PG8_STAGE(PG8_SB(0, 1), cB + hstep, voffB); PG8_STAGE(PG8_SA(0, 1), cA + hstep, voffA);
    if (wr == 1) PG8_BAR;
    PG8_WAIT_V(4); PG8_BAR;
    PG8_STAGE(PG8_SB(1, 0), cB + kstep, voffB); PG8_STAGE(PG8_SA(1, 0), cA + kstep, voffA); PG8_STAGE(PG8_SB(1, 1), cB + hstep + kstep, voffB);
    PG8_WAIT_V(6); PG8_BAR;
    PG8_STAMP();
    for (;;) {
        const bool has_next = S.next(ui + 1, nxt);
        const char* nA = has_next ? (const char*)g.A + (size_t)nxt.pm * tstep : cA; const char* nB = has_next ? (const char*)g.Bt + (size_t)nxt.pn * tstep : cB;
        for (int t = 0; t < nt; t += 2) {
            const bool last = (t == nt - 2);
            const char* a1 = cA + (size_t)(t + 1) * kstep;
            const char* a2 = last ? nA : cA + (size_t)(t + 2) * kstep; const char* b2 = last ? nB : cB + (size_t)(t + 2) * kstep;
            const char* a3 = a2 + kstep; const char* b3 = b2 + kstep;
            if (last && has_next) S.a_ready(nxt);
            PG8_LDB(B0, 0, 0); PG8_SCHED; PG8_LDA(At, 0, 0); PG8_STAGE(PG8_SA(1, 1), a1 + hstep, voffA);
            PG8_WAIT_L(8); PG8_BAR; PG8_WAIT_L(0); PG8_MMA(0, 0, At, B0); PG8_BAR; PG8_SCHED;
            PG8_LDB(B1, 0, 1); PG8_STAGE(PG8_SB(0, 0), b2, voffB);
            PG8_BAR; PG8_WAIT_L(0); PG8_MMA(0, 1, At, B1); PG8_BAR;
            PG8_LDA(At, 0, 1); PG8_STAGE(PG8_SA(0, 0), a2, voffA);
            PG8_BAR; PG8_WAIT_L(0); PG8_MMA(1, 0, At, B0); PG8_BAR; PG8_SCHED;
            PG8_STAGE(PG8_SB(0, 1), b2 + hstep, voffB);
            PG8_WAIT_V(6); PG8_BAR; PG8_MMA(1, 1, At, B1); PG8_BAR;
            PG8_LDB(B0, 1, 0); PG8_SCHED; PG8_LDA(At, 1, 0); PG8_STAGE(PG8_SA(0, 1), a2 + hstep, voffA);
            PG8_WAIT_L(8); PG8_BAR; PG8_WAIT_L(0); PG8_MMA(0, 0, At, B0); PG8_BAR; PG8_SCHED;
            PG8_LDB(B1, 1, 1); PG8_STAGE(PG8_SB(1, 0), b3, voffB);
            PG8_BAR; PG8_WAIT_L(0); PG8_MMA(0, 1, At, B1); PG8_BAR;
            PG8_LDA(At, 1, 1); PG8_STAGE(PG8_SA(1, 0), a3, voffA);
            PG8_BAR; PG8_WAIT_L(0); PG8_MMA(1, 0, At, B0); PG8_BAR; PG8_SCHED;
            PG8_STAGE(PG8_SB(1, 1), b3 + hstep, voffB);
            PG8_WAIT_V(6); PG8_BAR; PG8_MMA(1, 1, At, B1); PG8_BAR;
        }
        PG8_STAMP();
        if constexpr (!Epi::AFTER_DRAIN) { E(acc, cur, wr, wc, fr, fq); S.done(cur); }
        PG8_STAMP();
        if (!has_next) break;
#pragma unroll
        for (int a = 0; a < 2; ++a)
#pragma unroll
            for (int b = 0; b < 2; ++b)
#pragma unroll
                for (int m = 0; m < 4; ++m)
#pragma unroll
                    for (int n = 0; n < 2; ++n) acc[a][b][m][n] = (f32x4){0.f, 0.f, 0.f, 0.f};
        cur = nxt; cA = nA; cB = nB; ++ui;
    }
    PG8_WAIT_V(0);
    if (wr == 0) PG8_BAR;
    PG8_BAR;
    if constexpr (Epi::AFTER_DRAIN) { E.fused(acc, cur, wr, wc, fr, fq, lds, wid, lane); S.done(cur); }
    PG8_STAMP();
    if (STAMP && wid == 0) { stamps[lane] = lane < nts ? (((unsigned long long)(unsigned)ts_hi << 32) | (unsigned)ts_lo) : 0ull;
        if (lane == 62) stamps[62] = rt_entry; if (lane == 63) stamps[63] = (unsigned long long)wall_clock64(); }
#undef PG8_STAMP
#undef PG8_SA
#undef PG8_SB
#undef PG8_STAGE
#undef PG8_LDA
#undef PG8_LDB
#undef PG8_MMA
#undef PG8_WAIT_V
#undef PG8_WAIT_L
#undef PG8_BAR
#undef PG8_SCHED
}
}

#define XB_TMO      128
#define XB_XCNT(j)  (256  + 64 * (j))
#define XB_XSUB(j)  (1280 + 64 * (j))
#define XB_XGEN(j)  (2304 + 64 * (j))
#define XB_TOP      3328
#define XB_TOPGEN   3392
#define XCD_BAR_WORDS 3456
#define XB_SPIN_CAP (1u << 18)
#define LAS __attribute__((address_space(3)))

__device__ __forceinline__ unsigned xb_ld(unsigned* p)              { return __hip_atomic_load(p, __ATOMIC_RELAXED, __HIP_MEMORY_SCOPE_AGENT); }
__device__ __forceinline__ unsigned xb_add(unsigned* p, unsigned v) { return __hip_atomic_fetch_add(p, v, __ATOMIC_RELAXED, __HIP_MEMORY_SCOPE_AGENT); }
__device__ __forceinline__ unsigned xb_xcc_id() { return (unsigned)__builtin_amdgcn_s_getreg((3 << 11) | 20) & 0xFu; }
#define XB_SPIN(cond, bar) do { unsigned _sp = 0; while (cond) { __builtin_amdgcn_s_sleep(1); \
    if ((++_sp & 255u) == 0u) { if (xb_ld(&(bar)[XB_TMO])) break; if (_sp > XB_SPIN_CAP) { atomicAdd(&(bar)[XB_TMO], 1u); break; } } } } while (0)

struct XcdBarrier {
    unsigned* bar; unsigned x;
    volatile LAS unsigned* st;
};

__device__ __forceinline__ XcdBarrier xcd_barrier_post(unsigned* bar, volatile LAS unsigned* st) {
    XcdBarrier b; b.bar = bar; b.x = xb_xcc_id(); b.st = st;
    if (threadIdx.x == 0) (void)xb_add(&bar[XB_XCNT(b.x)], 1u);
    return b;
}
__device__ __forceinline__ void xcd_barrier_complete(unsigned* bar, unsigned x, unsigned& nloc, unsigned& nx) {
    const unsigned G = gridDim.x * gridDim.y * gridDim.z;
    unsigned sum, cnt, mine, sp = 0u;
    for (;;) {
        sum = 0u; cnt = 0u; mine = 0u;
#pragma unroll
        for (unsigned j = 0; j < 16; ++j) { const unsigned c = xb_ld(&bar[XB_XCNT(j)]); sum += c; cnt += (c > 0u) ? 1u : 0u; mine = (j == x) ? c : mine; }
        if (sum == G) break;
        __builtin_amdgcn_s_sleep(1);
        if ((++sp & 255u) == 0u) { if (xb_ld(&bar[XB_TMO])) break; if (sp > XB_SPIN_CAP) { atomicAdd(&bar[XB_TMO], 1u); break; } }
    }
    nloc = mine > 0u ? mine : 1u; nx = cnt > 0u ? cnt : 1u;
}

__device__ __forceinline__ void xcd_barrier(const XcdBarrier& b) {
    asm volatile("s_waitcnt vmcnt(0)" ::: "memory");
    __syncthreads();
    if (threadIdx.x == 0) {
        unsigned* bar = b.bar;
        __builtin_amdgcn_s_waitcnt(0);
        unsigned nloc = b.st[0], nx = b.st[1];
        if (nloc == 0u) { xcd_barrier_complete(bar, b.x, nloc, nx); b.st[0] = nloc; b.st[1] = nx; }
        const unsigned old = xb_add(&bar[XB_XSUB(b.x)], 1u);
        const unsigned gen = old / nloc;
        if (old + 1u == (gen + 1u) * nloc) {
            __builtin_amdgcn_fence(__ATOMIC_RELEASE, "agent");
            asm volatile("s_waitcnt vmcnt(0)" ::: "memory");
            const unsigned og = xb_add(&bar[XB_TOP], 1u);
            const unsigned tg = og / nx;
            if (og + 1u == (tg + 1u) * nx) xb_add(&bar[XB_TOPGEN], 1u);
            else XB_SPIN(xb_ld(&bar[XB_TOPGEN]) == tg, bar);
            __builtin_amdgcn_fence(__ATOMIC_ACQUIRE, "agent");
            xb_add(&bar[XB_XGEN(b.x)], 1u);
            asm volatile("s_waitcnt vmcnt(0)" ::: "memory");
        } else {
            XB_SPIN(xb_ld(&bar[XB_XGEN(b.x)]) == gen, bar);
            __builtin_amdgcn_fence(__ATOMIC_ACQUIRE, "agent");
            asm volatile("s_waitcnt vmcnt(0)" ::: "memory");
        }
    }
    __syncthreads();
}

typedef unsigned short bf16_t;
typedef short bf16x8 __attribute__((ext_vector_type(8)));
typedef float f32x4 __attribute__((ext_vector_type(4)));
typedef float f32x16 __attribute__((ext_vector_type(16)));

constexpr int DM = 2048, SEQ = 4096, NBP = 2, NBS = 32, TP = NBP * SEQ, MT = TP + NBS, MP = 8448;
constexpr int INW = 6784, INWP = 6912, SHD = 3200, DEPTH = 2;
constexpr size_t NRI = (size_t)MT * 1024;
constexpr int LDS_BYTES = 131072 + 16;
constexpr size_t O_CKP = (size_t)MT * DM;
constexpr size_t O_CVP = O_CKP + (size_t)DEPTH * NBP * 128 * 256;
constexpr size_t O_WKVP = O_CVP + (size_t)DEPTH * NBP * 128 * 256;
constexpr size_t O_SHP = O_WKVP + (size_t)DEPTH * NBP * 16 * 4096;
constexpr size_t O_CKS = O_SHP + (size_t)DEPTH * NBP * SHD;
constexpr size_t O_CVS = O_CKS + (size_t)DEPTH * NBS * 128 * 256;
constexpr size_t O_WKVS = O_CVS + (size_t)DEPTH * NBS * 128 * 256;
constexpr size_t O_SHS = O_WKVS + (size_t)DEPTH * NBS * 16 * 4096;
constexpr size_t O_END = O_SHS + (size_t)DEPTH * NBS * SHD;
constexpr size_t al256(size_t x) { return (x + 255) & ~(size_t)255; }
constexpr size_t WS_WTIN = 0;
constexpr size_t WS_WTOUT = WS_WTIN + (size_t)INWP * DM * 2;
constexpr size_t WS_MOD = WS_WTOUT + (size_t)DEPTH * DM * DM * 2;
constexpr size_t WS_ROPE = WS_MOD + al256((size_t)DEPTH * 34 * 6144 * 4);
constexpr size_t WS_HB = WS_ROPE + al256((size_t)4097 * 16 * 4);
constexpr size_t WS_QB = WS_HB + (size_t)MP * DM * 2;
constexpr size_t WS_KB = WS_QB + (size_t)MP * 1024 * 2;
constexpr size_t WS_VB = WS_KB + (size_t)MP * 256 * 2;
constexpr size_t WS_RW = WS_VB + (size_t)MP * 256 * 2;
constexpr size_t WS_GT = WS_RW + (size_t)MP * SHD * 2;
constexpr size_t WS_VALL = WS_GT + (size_t)MP * DM * 2;
constexpr size_t SRI = (size_t)NBS * 1024;
constexpr size_t WS_RSB = WS_VALL + NRI * 2;
constexpr size_t WS_RSW = WS_RSB + 4 * SRI * 2;
constexpr size_t WS_YS = WS_RSW + SRI * 4;
constexpr size_t WS_REC = WS_YS + NRI * 4;
constexpr size_t WS_COEF = WS_REC + (size_t)32 * 256 * 14592;
constexpr size_t WS_TWAD = WS_COEF + al256((size_t)MT * 16 * 4);
constexpr size_t WS_WFRAG = WS_TWAD + (size_t)MT * 128 * 2;
constexpr size_t WS_BAR = WS_WFRAG + (size_t)DEPTH * 2 * 16 * 4 * 2 * 64 * 16;
constexpr size_t WS_END = WS_BAR + 16384;

struct Params {
    const float *x_prompt, *x_sample, *cache_k, *cache_v, *state_wkv, *state_shift, *c_prompt, *c_sample, *norm_g, *w_ada, *b_ada, *w_in, *mu_shift, *w0, *w_decay, *a0,
        *w_iclr, *k_k, *k_a, *r_k, *ln_w, *ln_b, *sinks, *w_out, *final_g;
    float* out;
    unsigned char* ws;
    int repk, repl;
};
typedef const __attribute__((address_space(4))) Params* KParamsPtr;
__device__ __forceinline__ const Params& kparams() {
    KParamsPtr k = (KParamsPtr)__builtin_amdgcn_kernarg_segment_ptr();
    asm volatile("" : "+s"(k));
    return *(const Params*)k;
}

__device__ __forceinline__ unsigned short f2bf(float f) { return (unsigned short)(hw_cvt_pk_bf16(f, 0.f) & 0xffffu); }
__device__ __forceinline__ float bf2f(unsigned short b) { return __uint_as_float(((unsigned)b) << 16); }
__device__ __forceinline__ unsigned pack2(float lo, float hi) { return hw_cvt_pk_bf16(lo, hi); }
__device__ __forceinline__ float bflo(unsigned w) { return __uint_as_float(w << 16); }
__device__ __forceinline__ float bfhi(unsigned w) { return __uint_as_float(w & 0xffff0000u); }
__device__ __forceinline__ float silu_f(float x) { return x / (1.f + __expf(-x)); }
__device__ __forceinline__ float wave_sum(float x) {
#pragma unroll
    for (int o = 32; o >= 1; o >>= 1) x += __shfl_xor(x, o);
    return x;
}
__device__ __forceinline__ float wave_max(float x) {
#pragma unroll
    for (int o = 32; o >= 1; o >>= 1) x = fmaxf(x, __shfl_xor(x, o));
    return x;
}
template <int CTRL> __device__ __forceinline__ float dpp_f(float x) {
    return __builtin_bit_cast(float, __builtin_amdgcn_update_dpp(0, __builtin_bit_cast(int, x), CTRL, 0xF, 0xF, false));
}
__device__ __forceinline__ float allreduce16(float x) {
    x += dpp_f<0x128>(x);
    x += dpp_f<0x124>(x);
    x += dpp_f<0x122>(x);
    x += dpp_f<0x121>(x);
    return x;
}

__device__ void p0_mod_item(const Params& p, float* red, int l, int nc) {
    const int tid = opq_tid(), wv = tid >> 6, lane = tid & 63, n = lane & 31, kh = lane >> 5;
    f32x16 acc0, acc1;
#pragma unroll
    for (int i = 0; i < 16; ++i) { acc0[i] = 0.f; acc1[i] = 0.f; }
    const float* W = p.w_ada + (size_t)l * DM * 6144 + nc * 32 + n;
#pragma unroll 4
    for (int ks = 0; ks < 16; ++ks) {
        const int k0 = wv * 256 + ks * 16 + kh * 8;
        bf16x8 bfr, a0, a1;
#pragma unroll
        for (int j = 0; j < 8; ++j) bfr[j] = (short)f2bf(W[(size_t)(k0 + j) * 6144]);
        const float4* cs = (const float4*)(p.c_sample + (size_t)n * DM + k0);
        const float4 u0 = cs[0], u1 = cs[1];
        a0[0] = (short)f2bf(silu_f(u0.x)); a0[1] = (short)f2bf(silu_f(u0.y)); a0[2] = (short)f2bf(silu_f(u0.z)); a0[3] = (short)f2bf(silu_f(u0.w));
        a0[4] = (short)f2bf(silu_f(u1.x)); a0[5] = (short)f2bf(silu_f(u1.y)); a0[6] = (short)f2bf(silu_f(u1.z)); a0[7] = (short)f2bf(silu_f(u1.w));
        float4 q0 = make_float4(0.f, 0.f, 0.f, 0.f), q1 = q0;
        if (n < 2) { const float4* cp = (const float4*)(p.c_prompt + (size_t)n * DM + k0); q0 = cp[0]; q1 = cp[1]; }
        a1[0] = (short)f2bf(silu_f(q0.x)); a1[1] = (short)f2bf(silu_f(q0.y)); a1[2] = (short)f2bf(silu_f(q0.z)); a1[3] = (short)f2bf(silu_f(q0.w));
        a1[4] = (short)f2bf(silu_f(q1.x)); a1[5] = (short)f2bf(silu_f(q1.y)); a1[6] = (short)f2bf(silu_f(q1.z)); a1[7] = (short)f2bf(silu_f(q1.w));
        acc0 = __builtin_amdgcn_mfma_f32_32x32x16_bf16(a0, bfr, acc0, 0, 0, 0);
        acc1 = __builtin_amdgcn_mfma_f32_32x32x16_bf16(a1, bfr, acc1, 0, 0, 0);
    }
#pragma unroll
    for (int i = 0; i < 16; ++i) red[(wv * 18 + i) * 64 + lane] = acc0[i];
    red[(wv * 18 + 16) * 64 + lane] = acc1[0];
    red[(wv * 18 + 17) * 64 + lane] = acc1[1];
    __syncthreads();
    float* mod = (float*)(p.ws + WS_MOD);
    for (int o = tid; o < 34 * 32; o += 512) {
        const int row = o >> 5, col = o & 31;
        int ri, ln, mrow;
        if (row < 32) { const int khh = (row >> 2) & 1; ri = (row & 3) + 4 * (row >> 3); ln = col + 32 * khh; mrow = 2 + row; }
        else { ri = 16 + (row - 32); ln = col; mrow = row - 32; }
        float s = 0.f;
#pragma unroll
        for (int w = 0; w < 8; ++w) s += red[(w * 18 + ri) * 64 + ln];
        mod[((size_t)l * 34 + mrow) * 6144 + nc * 32 + col] = s + p.b_ada[l * 6144 + nc * 32 + col];
    }
    __syncthreads();
}

struct ConvIt { const float* src; bf16_t* dst; int N, k0, n0; };
__device__ __forceinline__ ConvIt conv_decode(const Params& p, int cidx, int lw) {
    ConvIt c;
    int kt, nt;
    if (cidx < 1728) { kt = cidx & 15; nt = cidx >> 4; c.N = INW; c.src = p.w_in + (size_t)lw * DM * INW; c.dst = (bf16_t*)(p.ws + WS_WTIN); }
    else { int rem = cidx - 1728; const int l2 = rem >> 9; rem &= 511; kt = rem & 15; nt = rem >> 4; c.N = DM; c.src = p.w_out + (size_t)l2 * DM * DM; c.dst = (bf16_t*)(p.ws + WS_WTOUT) + (size_t)l2 * DM * DM; }
    c.k0 = kt * 128; c.n0 = nt * 64;
    return c;
}
__device__ void p0_conv_all(const Params& p, float* s, int bid, int G, int total, int lw) {
    const int tid = opq_tid();
    const int lrow = tid >> 4, c4 = tid & 15, n = tid >> 3, kg = tid & 7;
    float4 v[4];
    int cidx = bid;
    ConvIt cur = conv_decode(p, cidx < total ? cidx : 0, lw);
    if (cidx < total) {
#pragma unroll
        for (int p4 = 0; p4 < 4; ++p4) { v[p4] = make_float4(0.f, 0.f, 0.f, 0.f); if (cur.n0 < cur.N) v[p4] = *(const float4*)(cur.src + (size_t)(cur.k0 + lrow + 32 * p4) * cur.N + cur.n0 + 4 * c4); }
    }
#pragma unroll 1
    while (cidx < total) {
#pragma unroll
        for (int p4 = 0; p4 < 4; ++p4) { float* d = s + (lrow + 32 * p4) * 65 + 4 * c4; d[0] = v[p4].x; d[1] = v[p4].y; d[2] = v[p4].z; d[3] = v[p4].w; }
        __syncthreads();
        const int nxt = cidx + G;
        const ConvIt nx = conv_decode(p, nxt < total ? nxt : 0, lw);
        if (nxt < total) {
#pragma unroll
            for (int p4 = 0; p4 < 4; ++p4) { v[p4] = make_float4(0.f, 0.f, 0.f, 0.f); if (nx.n0 < nx.N) v[p4] = *(const float4*)(nx.src + (size_t)(nx.k0 + lrow + 32 * p4) * nx.N + nx.n0 + 4 * c4); }
        }
        unsigned w[8];
#pragma unroll
        for (int j = 0; j < 8; ++j) w[j] = pack2(s[(kg * 16 + 2 * j) * 65 + n], s[(kg * 16 + 2 * j + 1) * 65 + n]);
        uint4* o = (uint4*)(cur.dst + (size_t)(cur.n0 + n) * DM + cur.k0 + kg * 16);
        o[0] = make_uint4(w[0], w[1], w[2], w[3]);
        o[1] = make_uint4(w[4], w[5], w[6], w[7]);
        __syncthreads();
        cur = nx; cidx = nxt;
    }
}

__device__ void p0_rope_item(const Params& p, int it) {
    float* rope = (float*)(p.ws + WS_ROPE);
#pragma unroll
    for (int q = 0; q < 4; ++q) {
        const int e = it * 2048 + q * 512 + opq_tid();
        if (e < 4097 * 8) {
            const int idx = e >> 3, i = e & 7;
            double invf = 1.0;
            for (int q = 0; q < i; ++q) invf *= 0.19392274474868576;
            const double pos = idx < 4096 ? (double)idx : 16384.0;
            const double rev = pos * invf * 0.15915494309189535;
            const float f = (float)(rev - floor(rev));
            rope[idx * 16 + i] = __builtin_amdgcn_cosf(f);
            rope[idx * 16 + 8 + i] = __builtin_amdgcn_sinf(f);
        }
    }
}

__device__ void p0_wfrag_item(const Params& p, int it) {
    const int e0 = it * 512 + opq_tid();
    const int lane = e0 & 63, ks = (e0 >> 6) & 1, ct = (e0 >> 7) & 3, hd = (e0 >> 9) & 15, mtx = (e0 >> 13) & 1, l = e0 >> 14;
    const float* W = (mtx == 0 ? p.w_decay : p.w_iclr) + (size_t)l * 64 * 1024 + hd * 64 + 16 * ct + (lane & 15);
    const int k0 = 32 * ks + 8 * (lane >> 4);
    float v[8];
#pragma unroll
    for (int e = 0; e < 8; ++e) v[e] = W[(size_t)(k0 + e) * 1024];
    ((uint4*)(p.ws + WS_WFRAG))[e0] = make_uint4(pack2(v[0], v[1]), pack2(v[2], v[3]), pack2(v[4], v[5]), pack2(v[6], v[7]));
}

__device__ void p1_norm(const Params& p, int l, int bid, int G) {
    const int tid = opq_tid(), wv = tid >> 6, lane = tid & 63;
    bf16_t* hb = (bf16_t*)(p.ws + WS_HB);
    const float* mod = (const float*)(p.ws + WS_MOD);
    const float4* g4 = (const float4*)(p.norm_g + l * DM);
    for (int r = bid * 8 + wv; r < MT; r += G * 8) {
        const float* xr = l == 0 ? (r < TP ? p.x_prompt + (size_t)r * DM : p.x_sample + (size_t)(r - TP) * DM) : p.out + (size_t)r * DM;
        const int mrow = r < TP ? (r >> 12) : 2 + (r - TP);
        const float* md = mod + ((size_t)l * 34 + mrow) * 6144;
        float4 v[8]; float ss = 0.f;
#pragma unroll
        for (int i = 0; i < 8; ++i) { v[i] = ((const float4*)xr)[lane + 64 * i]; ss += v[i].x * v[i].x + v[i].y * v[i].y + v[i].z * v[i].z + v[i].w * v[i].w; }
        ss = wave_sum(ss);
        const float rinv = rsqrtf(ss * (1.f / 2048.f) + 1e-5f);
#pragma unroll
        for (int i = 0; i < 8; ++i) {
            const int c4 = lane + 64 * i;
            const float4 g = g4[c4], sc = ((const float4*)(md + 2048))[c4], sh = ((const float4*)md)[c4];
            const float y0 = v[i].x * rinv * g.x * (1.f + sc.x) + sh.x, y1 = v[i].y * rinv * g.y * (1.f + sc.y) + sh.y;
            const float y2 = v[i].z * rinv * g.z * (1.f + sc.z) + sh.z, y3 = v[i].w * rinv * g.w * (1.f + sc.w) + sh.w;
            *(uint2*)(hb + (size_t)r * DM + 4 * c4) = make_uint2(pack2(y0, y1), pack2(y2, y3));
        }
    }
}

struct Epi1 {
    static constexpr bool PERM = false, AFTER_DRAIN = false;
    int l;
    __device__ __forceinline__ void operator()(const f32x4 (&acc)[2][2][4][2], const pg8::Unit& u, int wr, int wc, int fr, int fq) const {
        const Params& p = kparams();
        bf16_t* const qb = (bf16_t*)(p.ws + WS_QB); bf16_t* const kb = (bf16_t*)(p.ws + WS_KB); bf16_t* const vb = (bf16_t*)(p.ws + WS_VB);
        bf16_t* const rw = (bf16_t*)(p.ws + WS_RW); bf16_t* const gt = (bf16_t*)(p.ws + WS_GT); const float* const rope = (const float*)(p.ws + WS_ROPE); float* const out = p.out;
#pragma unroll
        for (int bj = 0; bj < 2; ++bj)
#pragma unroll
            for (int n = 0; n < 2; ++n) {
                const int cb = u.pn * 256 + bj * 128 + wc * 32 + n * 16;
                if (cb >= INW) continue;
                const int c = cb + 4 * fq;
                const bool do_rope = (cb < 1280) && ((cb & 63) == 0);
#pragma unroll
                for (int ai = 0; ai < 2; ++ai)
#pragma unroll
                    for (int m = 0; m < 4; ++m) {
                        const int rb = u.pm * 256 + ai * 128 + wr * 64 + m * 16;
                        if (rb >= MT) continue;
                        const int r = rb + fr;
                        f32x4 v = acc[ai][bj][m][n];
                        if (do_rope) {
                            const int idx = r < TP ? (r & 4095) : 4096;
                            const float4 cs = *(const float4*)(rope + idx * 16 + 4 * (fq & 1));
                            const float4 sn = *(const float4*)(rope + idx * 16 + 8 + 4 * (fq & 1));
                            const float p0 = __shfl_xor(v[0], 32), p1 = __shfl_xor(v[1], 32), p2 = __shfl_xor(v[2], 32), p3 = __shfl_xor(v[3], 32);
                            const float sg = fq < 2 ? -1.f : 1.f;
                            v[0] = v[0] * cs.x + sg * p0 * sn.x; v[1] = v[1] * cs.y + sg * p1 * sn.y; v[2] = v[2] * cs.z + sg * p2 * sn.z; v[3] = v[3] * cs.w + sg * p3 * sn.w;
                        }
                        if (cb < 1024) {
                            *(uint2*)(qb + (size_t)r * 1024 + c) = make_uint2(pack2(v[0] * 0.125f, v[1] * 0.125f), pack2(v[2] * 0.125f, v[3] * 0.125f));
                        } else if (cb < 1536) {
                            const bool isk = cb < 1280;
                            const int cc = c - (isk ? 1024 : 1280);
                            *(uint2*)((isk ? kb : vb) + (size_t)r * 256 + cc) = make_uint2(pack2(v[0], v[1]), pack2(v[2], v[3]));
                            if (r >= TP) {
                                *(f32x4*)(out + (isk ? O_CKS : O_CVS) + ((size_t)(l * NBS + (r - TP)) * 128 + 127) * 256 + cc) = v;
                            } else if ((r & 4095) >= SEQ - 128) {
                                *(f32x4*)(out + (isk ? O_CKP : O_CVP) + ((size_t)(l * NBP + (r >> 12)) * 128 + ((r & 4095) - (SEQ - 128))) * 256 + cc) = v;
                            }
                        } else if (cb < 4736) {
                            const int cc = c - 1536;
                            *(uint2*)(rw + (size_t)r * SHD + cc) = make_uint2(pack2(v[0], v[1]), pack2(v[2], v[3]));
                            if (r >= TP) *(f32x4*)(out + O_SHS + (size_t)(l * NBS + (r - TP)) * SHD + cc) = v;
                            else if ((r & 4095) == SEQ - 1) *(f32x4*)(out + O_SHP + (size_t)(l * NBP + (r >> 12)) * SHD + cc) = v;
                        } else {
                            const int cc = c - 4736;
                            *(uint2*)(gt + (size_t)r * DM + cc) = make_uint2(pack2(silu_f(v[0]), silu_f(v[1])), pack2(silu_f(v[2]), silu_f(v[3])));
                        }
                    }
            }
    }
};

struct Epi2 {
    static constexpr bool PERM = false, AFTER_DRAIN = false;
    int l;
    __device__ __forceinline__ void operator()(const f32x4 (&acc)[2][2][4][2], const pg8::Unit& u, int wr, int wc, int fr, int fq) const {
        const Params& p = kparams();
        const float* const xp = p.x_prompt; const float* const xs = p.x_sample; const float* const modl = (const float*)(p.ws + WS_MOD) + (size_t)l * 34 * 6144; float* const out = p.out;
#pragma unroll
        for (int ai = 0; ai < 2; ++ai)
#pragma unroll
            for (int m = 0; m < 4; ++m) {
                const int rb = u.pm * 256 + ai * 128 + wr * 64 + m * 16;
                if (rb >= MT) continue;
                const int r = rb + fr;
                const int mrow = r < TP ? (r >> 12) : 2 + (r - TP);
                const float* xo = l == 0 ? (r < TP ? xp + (size_t)r * DM : xs + (size_t)(r - TP) * DM) : out + (size_t)r * DM;
                const float* gr = modl + (size_t)mrow * 6144 + 4096;
#pragma unroll
                for (int bj = 0; bj < 2; ++bj)
#pragma unroll
                    for (int n = 0; n < 2; ++n) {
                        const int c = u.pn * 256 + bj * 128 + wc * 32 + n * 16 + 4 * fq;
                        const f32x4 x4 = *(const f32x4*)(xo + c), g4 = *(const f32x4*)(gr + c);
                        *(f32x4*)(out + (size_t)r * DM + c) = x4 + g4 * acc[ai][bj][m][n];
                    }
            }
    }
};

__device__ void g2_sample_item(const Params& p, float* red, int l, int nb) {
    const int tid = opq_tid(), wv = tid >> 6, lane = tid & 63, n = lane & 31, h = lane >> 5;
    const bf16_t* A = (const bf16_t*)(p.ws + WS_HB) + (size_t)TP * DM;
    const bf16_t* Bt = (const bf16_t*)(p.ws + WS_WTOUT) + (size_t)l * DM * DM + (size_t)(nb * 32) * DM;
    f32x16 acc;
#pragma unroll
    for (int i = 0; i < 16; ++i) acc[i] = 0.f;
#pragma unroll 4
    for (int ks = 0; ks < 16; ++ks) {
        const int k0 = wv * 256 + ks * 16 + 8 * h;
        const bf16x8 a = *(const bf16x8*)(A + (size_t)n * DM + k0);
        const bf16x8 bq = *(const bf16x8*)(Bt + (size_t)n * DM + k0);
        acc = __builtin_amdgcn_mfma_f32_32x32x16_bf16(a, bq, acc, 0, 0, 0);
    }
#pragma unroll
    for (int i = 0; i < 16; ++i) red[(wv * 16 + i) * 64 + lane] = acc[i];
    __syncthreads();
    const float* mod = (const float*)(p.ws + WS_MOD) + (size_t)l * 34 * 6144;
    for (int o = tid; o < 1024; o += 512) {
        const int row = o >> 5, col = o & 31, hh = (row >> 2) & 1, ri = (row & 3) + 4 * (row >> 3), ln = col + 32 * hh;
        float s = 0.f;
#pragma unroll
        for (int w = 0; w < 8; ++w) s += red[(w * 16 + ri) * 64 + ln];
        const int c = nb * 32 + col;
        const float gate = mod[(size_t)(2 + row) * 6144 + 4096 + c];
        const float xo = l == 0 ? p.x_sample[(size_t)row * DM + c] : p.out[(size_t)(TP + row) * DM + c];
        p.out[(size_t)(TP + row) * DM + c] = xo + gate * s;
    }
    __syncthreads();
}

__device__ void p3_attn_unit(const Params& p, unsigned char* lds, int l, int unit) {
    const int tid = opq_tid(), wv = tid >> 6, lane = tid & 63;
    const int b = unit >> 7, n = (unit >> 2) & 31, g = unit & 3;
    bf16_t* Ks = (bf16_t*)lds;
    bf16_t* Vt = (bf16_t*)(lds + 36864);
    const bf16_t* qb = (const bf16_t*)(p.ws + WS_QB);
    const bf16_t* kb = (const bf16_t*)(p.ws + WS_KB);
    const bf16_t* vb = (const bf16_t*)(p.ws + WS_VB);
    const bf16_t* gt = (const bf16_t*)(p.ws + WS_GT);
    bf16_t* cc = (bf16_t*)(p.ws + WS_HB);
    {
        uint4 kv4[4], vv4[4];
#pragma unroll
        for (int i = 0; i < 4; ++i) {
            const int chunk = tid + 512 * i, kl = chunk >> 3, dc = chunk & 7, kp = 128 * (n - 1) + kl;
            kv4[i] = make_uint4(0u, 0u, 0u, 0u); vv4[i] = kv4[i];
            if (kp >= 0) { const size_t row = (size_t)b * SEQ + kp; kv4[i] = *(const uint4*)(kb + row * 256 + g * 64 + dc * 8); vv4[i] = *(const uint4*)(vb + row * 256 + g * 64 + dc * 8); }
        }
        __builtin_amdgcn_sched_barrier(0);
#pragma unroll
        for (int i = 0; i < 4; ++i) {
            const int chunk = tid + 512 * i, kl = chunk >> 3, dc = chunk & 7;
            *(uint4*)(Ks + kl * 72 + dc * 8) = kv4[i];
            bf16_t* vd = Vt + (dc * 8) * 264 + kl;
            vd[0 * 264] = (bf16_t)(vv4[i].x & 0xffffu); vd[1 * 264] = (bf16_t)(vv4[i].x >> 16);
            vd[2 * 264] = (bf16_t)(vv4[i].y & 0xffffu); vd[3 * 264] = (bf16_t)(vv4[i].y >> 16);
            vd[4 * 264] = (bf16_t)(vv4[i].z & 0xffffu); vd[5 * 264] = (bf16_t)(vv4[i].z >> 16);
            vd[6 * 264] = (bf16_t)(vv4[i].w & 0xffffu); vd[7 * 264] = (bf16_t)(vv4[i].w >> 16);
        }
    }
    __syncthreads();
    const int hq = 4 * g + (wv >> 1), qh = wv & 1, q32 = lane & 31, h = lane >> 5;
    const float sink = p.sinks[l * 16 + hq];
#pragma unroll 1
    for (int s = 0; s < 2; ++s) {
        const int qp = 128 * n + 64 * qh + 32 * s + q32;
        const size_t qrow = (size_t)b * SEQ + qp;
        const int klb0 = 64 * qh + 32 * s;
        bf16x8 qf[4];
#pragma unroll
        for (int ks = 0; ks < 4; ++ks) qf[ks] = *(const bf16x8*)(qb + qrow * 1024 + hq * 64 + ks * 16 + 8 * h);
        f32x16 S[5];
#pragma unroll
        for (int kt = 0; kt < 5; ++kt) {
#pragma unroll
            for (int i = 0; i < 16; ++i) S[kt][i] = 0.f;
#pragma unroll
            for (int ks = 0; ks < 4; ++ks) {
                const bf16x8 a = *(const bf16x8*)(Ks + (klb0 + 32 * kt + q32) * 72 + ks * 16 + 8 * h);
                S[kt] = __builtin_amdgcn_mfma_f32_32x32x16_bf16(a, qf[ks], S[kt], 0, 0, 0);
            }
        }
        float mx = -1e30f;
#pragma unroll
        for (int kt = 0; kt < 5; ++kt)
#pragma unroll
            for (int i = 0; i < 16; ++i) {
                const int m = 8 * (i >> 2) + 4 * h + (i & 3);
                const int kp = 128 * (n - 1) + klb0 + 32 * kt + m;
                const int rel = qp - kp;
                const bool ok = (rel >= 0) && (rel <= 128) && (kp >= 0);
                const float sv = ok ? S[kt][i] : -1e30f;
                S[kt][i] = sv; mx = fmaxf(mx, sv);
            }
        mx = fmaxf(mx, __shfl_xor(mx, 32));
        mx = fmaxf(mx, sink);
        float sum = 0.f;
#pragma unroll
        for (int kt = 0; kt < 5; ++kt)
#pragma unroll
            for (int i = 0; i < 16; ++i) { const float e = __expf(S[kt][i] - mx); S[kt][i] = e; sum += e; }
        sum += __shfl_xor(sum, 32);
        const float inv = 1.f / (sum + __expf(sink - mx));
        f32x16 O[2];
#pragma unroll
        for (int i = 0; i < 16; ++i) { O[0][i] = 0.f; O[1][i] = 0.f; }
#pragma unroll
        for (int kt = 0; kt < 5; ++kt)
#pragma unroll
            for (int sp = 0; sp < 2; ++sp) {
                bf16x8 pf;
#pragma unroll
                for (int j = 0; j < 8; ++j) pf[j] = (short)f2bf(S[kt][8 * sp + j]);
#pragma unroll
                for (int dt = 0; dt < 2; ++dt) {
                    const bf16_t* vp = Vt + (32 * dt + q32) * 264 + klb0 + 32 * kt + 16 * sp + 4 * h;
                    const uint2 lo = *(const uint2*)vp, hi = *(const uint2*)(vp + 8);
                    const uint4 av = make_uint4(lo.x, lo.y, hi.x, hi.y);
                    O[dt] = __builtin_amdgcn_mfma_f32_32x32x16_bf16(__builtin_bit_cast(bf16x8, av), pf, O[dt], 0, 0, 0);
                }
            }
#pragma unroll
        for (int dt = 0; dt < 2; ++dt)
#pragma unroll
            for (int ig = 0; ig < 4; ++ig) {
                const int col = hq * 64 + 32 * dt + 8 * ig + 4 * h;
                const uint2 gg = *(const uint2*)(gt + qrow * DM + col);
                const float o0 = O[dt][4 * ig + 0] * inv * bflo(gg.x), o1 = O[dt][4 * ig + 1] * inv * bfhi(gg.x);
                const float o2 = O[dt][4 * ig + 2] * inv * bflo(gg.y), o3 = O[dt][4 * ig + 3] * inv * bfhi(gg.y);
                *(uint2*)(cc + qrow * DM + col) = make_uint2(pack2(o0, o1), pack2(o2, o3));
            }
    }
    __syncthreads();
}

__device__ void p3_sattn_item(const Params& p, float* lds, int l, int item) {
    const int tid = opq_tid(), wv = tid >> 6, lane = tid & 63;
    float* pl = lds + wv * 128;
    const int w = item * 8 + wv, bd = w >> 4, hq = w & 15, g = hq >> 2;
    const size_t row = (size_t)TP + bd;
    const bf16_t* qb = (const bf16_t*)(p.ws + WS_QB);
    const bf16_t* gt = (const bf16_t*)(p.ws + WS_GT);
    bf16_t* cc = (bf16_t*)(p.ws + WS_HB);
    float q[64];
#pragma unroll
    for (int c = 0; c < 8; ++c) {
        const uint4 u = *(const uint4*)(qb + row * 1024 + hq * 64 + c * 8);
        q[c * 8 + 0] = bflo(u.x); q[c * 8 + 1] = bfhi(u.x); q[c * 8 + 2] = bflo(u.y); q[c * 8 + 3] = bfhi(u.y);
        q[c * 8 + 4] = bflo(u.z); q[c * 8 + 5] = bfhi(u.z); q[c * 8 + 6] = bflo(u.w); q[c * 8 + 7] = bfhi(u.w);
    }
    const size_t cbase = ((size_t)(l * NBS + bd) * 128) * 256 + g * 64;
    const float* ck = p.cache_k + cbase;
    const float* cv = p.cache_v + cbase;
    float* nk = p.out + O_CKS + cbase;
    float* nv = p.out + O_CVS + cbase;
    float s0 = 0.f, s1 = 0.f, s2 = 0.f;
#pragma unroll
    for (int c = 0; c < 16; ++c) {
        const float4 a = ((const float4*)(ck + (size_t)lane * 256))[c];
        const float4 bq = ((const float4*)(ck + (size_t)(lane + 64) * 256))[c];
        const float4 e = ((const float4*)(nk + (size_t)127 * 256))[c];
        s0 += a.x * q[4 * c] + a.y * q[4 * c + 1] + a.z * q[4 * c + 2] + a.w * q[4 * c + 3];
        s1 += bq.x * q[4 * c] + bq.y * q[4 * c + 1] + bq.z * q[4 * c + 2] + bq.w * q[4 * c + 3];
        s2 += e.x * q[4 * c] + e.y * q[4 * c + 1] + e.z * q[4 * c + 2] + e.w * q[4 * c + 3];
    }
    const float sink = p.sinks[l * 16 + hq];
    const float mx = fmaxf(wave_max(fmaxf(s0, s1)), fmaxf(s2, sink));
    const float p0 = __expf(s0 - mx), p1 = __expf(s1 - mx), p2 = __expf(s2 - mx);
    const float sum = wave_sum(p0 + p1) + p2 + __expf(sink - mx);
    pl[lane] = p0; pl[lane + 64] = p1;
    __builtin_amdgcn_fence(__ATOMIC_RELEASE, "wavefront");
    __builtin_amdgcn_wave_barrier();
    __builtin_amdgcn_fence(__ATOMIC_ACQUIRE, "wavefront");
    float o = 0.f;
#pragma unroll 32
    for (int key = 0; key < 128; ++key) o += pl[key] * cv[(size_t)key * 256 + lane];
    o += p2 * nv[(size_t)127 * 256 + lane];
    o /= sum;
    const float gate = bf2f(gt[row * DM + hq * 64 + lane]);
    cc[row * DM + hq * 64 + lane] = f2bf(o * gate);
    {
        float tk[32], tv[32];
#pragma unroll
        for (int i = 0; i < 32; ++i) {
            const int ww = (hq & 3) + 4 * i;
            tk[i] = ck[(size_t)(ww + 1 < 128 ? ww + 1 : 127) * 256 + lane]; tv[i] = cv[(size_t)(ww + 1 < 128 ? ww + 1 : 127) * 256 + lane];
        }
#pragma unroll
        for (int i = 0; i < 32; ++i) {
            const int ww = (hq & 3) + 4 * i;
            if (ww < 127) { nk[(size_t)ww * 256 + lane] = tk[i]; nv[(size_t)ww * 256 + lane] = tv[i]; }
        }
    }
    __builtin_amdgcn_wave_barrier();
}

__device__ __forceinline__ float mix_val(const bf16_t* rw, const float* sshift, const float* mu, int r, int c) {
    const float cur = bf2f(rw[(size_t)r * SHD + c]);
    float prev;
    if (r >= TP) prev = sshift[(size_t)(r - TP) * SHD + c];
    else if ((r & 4095) == 0) prev = 0.f;
    else prev = bf2f(rw[(size_t)(r - 1) * SHD + c]);
    return cur + (prev - cur) * mu[c];
}

__device__ __forceinline__ float4 mix4(const bf16_t* rw, const float* sshift, int r, int c, float4 mu4) {
    const uint2 cu = *(const uint2*)(rw + (size_t)r * SHD + c);
    const float4 cur = make_float4(bflo(cu.x), bfhi(cu.x), bflo(cu.y), bfhi(cu.y));
    float4 prev = make_float4(0.f, 0.f, 0.f, 0.f);
    if (r >= TP) prev = *(const float4*)(sshift + (size_t)(r - TP) * SHD + c);
    else if ((r & 4095) != 0) { const uint2 pu = *(const uint2*)(rw + (size_t)(r - 1) * SHD + c); prev = make_float4(bflo(pu.x), bfhi(pu.x), bflo(pu.y), bfhi(pu.y)); }
    return make_float4(cur.x + (prev.x - cur.x) * mu4.x, cur.y + (prev.y - cur.y) * mu4.y, cur.z + (prev.z - cur.z) * mu4.z, cur.w + (prev.w - cur.w) * mu4.w);
}
__device__ __forceinline__ float decay_of(float x) {
    const float z = -x;
    const float sp = fmaxf(z, 0.f) + __logf(1.f + __expf(-fabsf(z)));
    return __expf(-__expf(-sp - 0.5f));
}

__device__ void p3_twad_item(const Params& p, int l, int tile) {
    const int tid = opq_tid();
    const bf16_t* rw = (const bf16_t*)(p.ws + WS_RW);
    const float* sshift = p.state_shift + (size_t)l * NBS * SHD;
    const float* mu = p.mu_shift + l * SHD;
    bf16_t* TWAD = (bf16_t*)(p.ws + WS_TWAD);
    const int r0 = tile * 32;
    float mm[8];
#pragma unroll
    for (int i = 0; i < 8; ++i) { const int idx = tid + 512 * i, tt = idx >> 7, c2 = idx & 127; mm[i] = mix_val(rw, sshift, mu, r0 + tt, 3072 + c2); }
#pragma unroll
    for (int i = 0; i < 8; ++i) {
        const int idx = tid + 512 * i, tt = idx >> 7, c2 = idx & 127;
        float o = mm[i];
        if (c2 < 64) { const float e = __expf(2.f * mm[i]); o = 1.f - 2.f / (e + 1.f); }
        TWAD[(size_t)(r0 + tt) * 128 + c2] = f2bf(o);
    }
}

__device__ void p3_prep_tile(const Params& p, unsigned char* lds, int l, int tile) {
    const int tid = opq_tid(), wv = tid >> 6, lane = tid & 63, n = lane & 31, h = lane >> 5;
    bf16_t* TW = (bf16_t*)lds;
    bf16_t* AD = TW + 32 * 72;
    const bf16_t* rw = (const bf16_t*)(p.ws + WS_RW);
    const float* sshift = p.state_shift + (size_t)l * NBS * SHD;
    const float* mu = p.mu_shift + l * SHD;
    bf16_t* RSB = (bf16_t*)(p.ws + WS_RSB);
    bf16_t* VALL = (bf16_t*)(p.ws + WS_VALL);
    float* RSW = (float*)(p.ws + WS_RSW);
    float* coef = (float*)(p.ws + WS_COEF);
    const int r0 = tile * 32;
    {
        float mm[8];
#pragma unroll
        for (int i = 0; i < 8; ++i) { const int idx = tid + 512 * i, tt = idx >> 7, c2 = idx & 127; mm[i] = mix_val(rw, sshift, mu, r0 + tt, 3072 + c2); }
        __builtin_amdgcn_sched_barrier(0);
#pragma unroll
        for (int i = 0; i < 8; ++i) {
            const int idx = tid + 512 * i, tt = idx >> 7, c2 = idx & 127;
            if (c2 < 64) { const float e = __expf(2.f * mm[i]); TW[tt * 72 + c2] = f2bf(1.f - 2.f / (e + 1.f)); }
            else AD[tt * 72 + (c2 - 64)] = f2bf(mm[i]);
        }
    }
    __syncthreads();
    const int col0 = wv * 128 + 4 * n;
    f32x16 acc[4];
    {
        const float* wp = p.w_decay + (size_t)l * 64 * 1024 + col0;
#pragma unroll
        for (int nt = 0; nt < 4; ++nt)
#pragma unroll
            for (int i = 0; i < 16; ++i) acc[nt][i] = 0.f;
#pragma unroll
        for (int ks = 0; ks < 4; ++ks) {
            const bf16x8 a = *(const bf16x8*)(TW + n * 72 + 16 * ks + 8 * h);
            float4 w4[8];
#pragma unroll
            for (int e = 0; e < 8; ++e) w4[e] = *(const float4*)(wp + (size_t)(16 * ks + 8 * h + e) * 1024);
            bf16x8 b0, b1, b2, b3;
#pragma unroll
            for (int e = 0; e < 8; ++e) { b0[e] = (short)f2bf(w4[e].x); b1[e] = (short)f2bf(w4[e].y); b2[e] = (short)f2bf(w4[e].z); b3[e] = (short)f2bf(w4[e].w); }
            acc[0] = __builtin_amdgcn_mfma_f32_32x32x16_bf16(a, b0, acc[0], 0, 0, 0);
            acc[1] = __builtin_amdgcn_mfma_f32_32x32x16_bf16(a, b1, acc[1], 0, 0, 0);
            acc[2] = __builtin_amdgcn_mfma_f32_32x32x16_bf16(a, b2, acc[2], 0, 0, 0);
            acc[3] = __builtin_amdgcn_mfma_f32_32x32x16_bf16(a, b3, acc[3], 0, 0, 0);
        }
        const float4 w0c = *(const float4*)(p.w0 + l * 1024 + col0);
#pragma unroll
        for (int r = 0; r < 16; ++r) {
            const int row = r0 + 8 * (r >> 2) + 4 * h + (r & 3);
            *(float4*)(RSW + (size_t)(row - TP) * 1024 + col0) =
                make_float4(decay_of(w0c.x + acc[0][r]), decay_of(w0c.y + acc[1][r]), decay_of(w0c.z + acc[2][r]), decay_of(w0c.w + acc[3][r]));
        }
    }
    {
        const float* wp = p.w_iclr + (size_t)l * 64 * 1024 + col0;
#pragma unroll
        for (int nt = 0; nt < 4; ++nt)
#pragma unroll
            for (int i = 0; i < 16; ++i) acc[nt][i] = 0.f;
#pragma unroll
        for (int ks = 0; ks < 4; ++ks) {
            const bf16x8 a = *(const bf16x8*)(AD + n * 72 + 16 * ks + 8 * h);
            float4 w4[8];
#pragma unroll
            for (int e = 0; e < 8; ++e) w4[e] = *(const float4*)(wp + (size_t)(16 * ks + 8 * h + e) * 1024);
            bf16x8 b0, b1, b2, b3;
#pragma unroll
            for (int e = 0; e < 8; ++e) { b0[e] = (short)f2bf(w4[e].x); b1[e] = (short)f2bf(w4[e].y); b2[e] = (short)f2bf(w4[e].z); b3[e] = (short)f2bf(w4[e].w); }
            acc[0] = __builtin_amdgcn_mfma_f32_32x32x16_bf16(a, b0, acc[0], 0, 0, 0);
            acc[1] = __builtin_amdgcn_mfma_f32_32x32x16_bf16(a, b1, acc[1], 0, 0, 0);
            acc[2] = __builtin_amdgcn_mfma_f32_32x32x16_bf16(a, b2, acc[2], 0, 0, 0);
            acc[3] = __builtin_amdgcn_mfma_f32_32x32x16_bf16(a, b3, acc[3], 0, 0, 0);
        }
    }
    const float4 a0c = *(const float4*)(p.a0 + l * 1024 + col0), kkc = *(const float4*)(p.k_k + l * 1024 + col0), kac = *(const float4*)(p.k_a + l * 1024 + col0), rkc = *(const float4*)(p.r_k + l * 1024 + col0);
    const float4 mur = *(const float4*)(mu + col0), muk = *(const float4*)(mu + 1024 + col0), muv = *(const float4*)(mu + 2048 + col0);
    const int head = 2 * wv + (n >> 4);
#pragma unroll
    for (int g4 = 0; g4 < 4; ++g4) {
        float4 rr4[4], kr4[4], vr4[4];
#pragma unroll
        for (int q = 0; q < 4; ++q) {
            const int row = r0 + 8 * g4 + 4 * h + q;
            rr4[q] = mix4(rw, sshift, row, col0, mur); kr4[q] = mix4(rw, sshift, row, 1024 + col0, muk); vr4[q] = mix4(rw, sshift, row, 2048 + col0, muv);
        }
        __builtin_amdgcn_sched_barrier(0);
#pragma unroll
        for (int q = 0; q < 4; ++q) {
            const int r = 4 * g4 + q;
            const int row = r0 + 8 * g4 + 4 * h + q;
            const float4 rr = rr4[q], kr = kr4[q], vr = vr4[q];
            const float ax = 1.f / (1.f + __expf(-(a0c.x + acc[0][r]))), ay = 1.f / (1.f + __expf(-(a0c.y + acc[1][r])));
            const float az = 1.f / (1.f + __expf(-(a0c.z + acc[2][r]))), aw = 1.f / (1.f + __expf(-(a0c.w + acc[3][r])));
            const float k0 = kr.x * kkc.x, k1 = kr.y * kkc.y, k2 = kr.z * kkc.z, k3 = kr.w * kkc.w;
            const float ss = allreduce16(k0 * k0 + k1 * k1 + k2 * k2 + k3 * k3);
            const float inv = 1.f / fmaxf(sqrtf(ss), 1e-12f);
            const float4 kk = make_float4(k0 * inv, k1 * inv, k2 * inv, k3 * inv);
            const float4 ke = make_float4(kr.x * (1.f + (ax - 1.f) * kac.x), kr.y * (1.f + (ay - 1.f) * kac.y), kr.z * (1.f + (az - 1.f) * kac.z), kr.w * (1.f + (aw - 1.f) * kac.w));
            const float cf = allreduce16(rr.x * ke.x * rkc.x + rr.y * ke.y * rkc.y + rr.z * ke.z * rkc.z + rr.w * ke.w * rkc.w);
            if ((n & 15) == 0) coef[(size_t)row * 16 + head] = cf;
            const size_t o = (size_t)row * 1024 + col0;
            const size_t os = (size_t)(row - TP) * 1024 + col0;
            *(uint2*)(RSB + os) = make_uint2(pack2(rr.x, rr.y), pack2(rr.z, rr.w));
            *(uint2*)(RSB + SRI + os) = make_uint2(pack2(ke.x, ke.y), pack2(ke.z, ke.w));
            *(uint2*)(RSB + 2 * SRI + os) = make_uint2(pack2(kk.x, kk.y), pack2(kk.z, kk.w));
            *(uint2*)(RSB + 3 * SRI + os) = make_uint2(pack2(kk.x * ax, kk.y * ay), pack2(kk.z * az, kk.w * aw));
            *(uint2*)(VALL + o) = make_uint2(pack2(vr.x, vr.y), pack2(vr.z, vr.w));
        }
        __builtin_amdgcn_sched_barrier(0);
    }
    __syncthreads();
}

constexpr int REC_BYTES = 14592;
constexpr int PA_WLDS = 16384;
typedef float f32x4v __attribute__((ext_vector_type(4)));

__device__ void pa_chunk(const Params& p, unsigned char* wl, int l, int ct) {
    const int lane = opq_tid() & 63;
    const int hh = ct >> 8, c = ct & 255, b = hh >> 4, h = hh & 15;
    const size_t row0 = (size_t)b * SEQ + 16 * c;
    const int col = h * 64 + lane;
    bf16_t* VALL = (bf16_t*)(p.ws + WS_VALL);
    float vv[16];
    float gC;
    bf16_t* S_AB = (bf16_t*)wl; bf16_t* S_BB = S_AB + 16 * 72; bf16_t* S_KB = S_BB + 16 * 72; bf16_t* S_RT = S_KB + 16 * 72;
    {
        const bf16_t* rw = (const bf16_t*)(p.ws + WS_RW);
        const bf16_t* TWAD = (const bf16_t*)(p.ws + WS_TWAD);
        const uint4* WFd = (const uint4*)(p.ws + WS_WFRAG) + (size_t)((l * 2 + 0) * 16 + h) * 512 + lane;
        const uint4* WFi = (const uint4*)(p.ws + WS_WFRAG) + (size_t)((l * 2 + 1) * 16 + h) * 512 + lane;
        unsigned xr[17], xk[17], xv[17];
        const bool first = (row0 & 4095) == 0;
#pragma unroll
        for (int t = 0; t < 17; ++t) {
            const unsigned ro = (unsigned)(row0 + t - 1) * (unsigned)SHD + (unsigned)col;
            if (t == 0 && first) { xr[0] = 0u; xk[0] = 0u; xv[0] = 0u; }
            else { xr[t] = rw[ro]; xk[t] = rw[ro + 1024u]; xv[t] = rw[ro + 2048u]; }
        }
        const int rr = lane & 15, kg = lane >> 4;
        f32x4v Dd[4], Da[4];
#pragma unroll
        for (int ct = 0; ct < 4; ++ct) { Dd[ct] = (f32x4v){0.f, 0.f, 0.f, 0.f}; Da[ct] = Dd[ct]; }
#pragma unroll
        for (int ks = 0; ks < 2; ++ks) {
            const bf16x8 atw = *(const bf16x8*)(TWAD + (size_t)(row0 + rr) * 128 + 32 * ks + 8 * kg);
            const bf16x8 aad = *(const bf16x8*)(TWAD + (size_t)(row0 + rr) * 128 + 64 + 32 * ks + 8 * kg);
#pragma unroll
            for (int ct = 0; ct < 4; ++ct) {
                const bf16x8 bd = __builtin_bit_cast(bf16x8, WFd[(ct * 2 + ks) * 64]);
                const bf16x8 bi = __builtin_bit_cast(bf16x8, WFi[(ct * 2 + ks) * 64]);
                Dd[ct] = __builtin_amdgcn_mfma_f32_16x16x32_bf16(atw, bd, Dd[ct], 0, 0, 0);
                Da[ct] = __builtin_amdgcn_mfma_f32_16x16x32_bf16(aad, bi, Da[ct], 0, 0, 0);
            }
        }
        float* LD = (float*)wl; float* LA = LD + 1024;
#pragma unroll
        for (int ct = 0; ct < 4; ++ct)
#pragma unroll
            for (int rg = 0; rg < 4; ++rg) { LD[(4 * kg + rg) * 64 + 16 * ct + rr] = Dd[ct][rg]; LA[(4 * kg + rg) * 64 + 16 * ct + rr] = Da[ct][rg]; }
        __builtin_amdgcn_fence(__ATOMIC_RELEASE, "wavefront"); __builtin_amdgcn_wave_barrier(); __builtin_amdgcn_fence(__ATOMIC_ACQUIRE, "wavefront");
        float din[16], ain[16];
#pragma unroll
        for (int t = 0; t < 16; ++t) { din[t] = LD[t * 64 + lane]; ain[t] = LA[t * 64 + lane]; }
        __builtin_amdgcn_fence(__ATOMIC_RELEASE, "wavefront"); __builtin_amdgcn_wave_barrier(); __builtin_amdgcn_fence(__ATOMIC_ACQUIRE, "wavefront");
        const float mur = p.mu_shift[l * SHD + col], muk = p.mu_shift[l * SHD + 1024 + col], muv = p.mu_shift[l * SHD + 2048 + col];
        const float w0c = p.w0[l * 1024 + col], a0c = p.a0[l * 1024 + col], kkc = p.k_k[l * 1024 + col], kac = p.k_a[l * 1024 + col], rkc = p.r_k[l * 1024 + col];
        float* coef = (float*)(p.ws + WS_COEF);
        float g = 1.f;
#pragma unroll
        for (int t = 0; t < 16; ++t) {
            const float cr = bf2f((unsigned short)xr[t + 1]), pr = bf2f((unsigned short)xr[t]), ck = bf2f((unsigned short)xk[t + 1]), pk = bf2f((unsigned short)xk[t]);
            const float cv = bf2f((unsigned short)xv[t + 1]), pv = bf2f((unsigned short)xv[t]);
            const float r_ = cr + (pr - cr) * mur, kr = ck + (pk - ck) * muk, vr = cv + (pv - cv) * muv;
            const float a = 1.f / (1.f + __expf(-(a0c + ain[t])));
            const float dec = decay_of(w0c + din[t]);
            const float kkr = kr * kkc;
            float ss = allreduce16(kkr * kkr); ss += __shfl_xor(ss, 16); ss += __shfl_xor(ss, 32);
            const float kkv = kkr / fmaxf(sqrtf(ss), 1e-12f);
            const float ke = kr * (1.f + (a - 1.f) * kac);
            float cf = allreduce16(r_ * ke * rkc); cf += __shfl_xor(cf, 16); cf += __shfl_xor(cf, 32);
            if (lane == 0) coef[(size_t)(row0 + t) * 16 + h] = cf;
            VALL[(unsigned)(row0 + t) * 1024u + (unsigned)col] = f2bf(vr);
            vv[t] = vr;
            S_AB[t * 72 + lane] = f2bf(-g * kkv);
            g *= dec;
            const float ig = __builtin_amdgcn_rcpf(g);
            S_BB[t * 72 + lane] = f2bf(kkv * a * ig); S_KB[t * 72 + lane] = f2bf(ke * ig); S_RT[t * 72 + lane] = f2bf(g * r_);
        }
        gC = g;
    }
    __builtin_amdgcn_fence(__ATOMIC_RELEASE, "wavefront"); __builtin_amdgcn_wave_barrier(); __builtin_amdgcn_fence(__ATOMIC_ACQUIRE, "wavefront");
    f32x4v Gab = {0.f, 0.f, 0.f, 0.f}, Gak = Gab, Grb = Gab, Grk = Gab;
    {
        const int rr = lane & 15, kg = lane >> 4;
#pragma unroll
        for (int ks = 0; ks < 2; ++ks) {
            const int o = rr * 72 + 32 * ks + 8 * kg;
            const bf16x8 fA = *(const bf16x8*)(S_AB + o), fB = *(const bf16x8*)(S_BB + o), fK = *(const bf16x8*)(S_KB + o), fR = *(const bf16x8*)(S_RT + o);
            Gab = __builtin_amdgcn_mfma_f32_16x16x32_bf16(fB, fA, Gab, 0, 0, 0);
            Gak = __builtin_amdgcn_mfma_f32_16x16x32_bf16(fK, fA, Gak, 0, 0, 0);
            Grb = __builtin_amdgcn_mfma_f32_16x16x32_bf16(fB, fR, Grb, 0, 0, 0);
            Grk = __builtin_amdgcn_mfma_f32_16x16x32_bf16(fK, fR, Grk, 0, 0, 0);
        }
    }
    __builtin_amdgcn_fence(__ATOMIC_RELEASE, "wavefront"); __builtin_amdgcn_wave_barrier(); __builtin_amdgcn_fence(__ATOMIC_ACQUIRE, "wavefront");
    float* M_AB = (float*)(wl + 9216); float* M_AK = M_AB + 256; float* M_RB = M_AK + 256; float* M_RK = M_RB + 256; float* T_ = M_RK + 256; float* Q_ = T_ + 256; float* W2_ = Q_ + 256;
    {
        const int t = lane & 15, kg = lane >> 4;
#pragma unroll
        for (int rg = 0; rg < 4; ++rg) {
            const int s = 4 * kg + rg;
            M_AB[s * 16 + t] = s < t ? Gab[rg] : 0.f; M_AK[s * 16 + t] = s < t ? Gak[rg] : 0.f;
            M_RB[s * 16 + t] = s <= t ? Grb[rg] : 0.f; M_RK[s * 16 + t] = s <= t ? Grk[rg] : 0.f;
        }
    }
    __builtin_amdgcn_fence(__ATOMIC_RELEASE, "wavefront"); __builtin_amdgcn_wave_barrier(); __builtin_amdgcn_fence(__ATOMIC_ACQUIRE, "wavefront");
    {
        const int rr = lane & 15;
        float Tr[16];
#pragma unroll
        for (int t = 0; t < 16; ++t) {
            float acc = (rr == t) ? 1.f : 0.f;
#pragma unroll
            for (int s = 0; s < t; ++s) acc += Tr[s] * M_AB[s * 16 + t];
            Tr[t] = acc;
        }
#pragma unroll
        for (int t = 0; t < 16; ++t) T_[rr * 16 + t] = Tr[t];
    }
    __builtin_amdgcn_fence(__ATOMIC_RELEASE, "wavefront"); __builtin_amdgcn_wave_barrier(); __builtin_amdgcn_fence(__ATOMIC_ACQUIRE, "wavefront");
    {
        const int s = lane & 15, tq = lane >> 4;
        float4 q = make_float4(0.f, 0.f, 0.f, 0.f);
#pragma unroll
        for (int u = 0; u < 16; ++u) { const float a = M_AK[s * 16 + u]; const float4 t4 = *(const float4*)(T_ + u * 16 + 4 * tq); q.x += a * t4.x; q.y += a * t4.y; q.z += a * t4.z; q.w += a * t4.w; }
        *(float4*)(Q_ + s * 16 + 4 * tq) = q;
        __builtin_amdgcn_fence(__ATOMIC_RELEASE, "wavefront"); __builtin_amdgcn_wave_barrier(); __builtin_amdgcn_fence(__ATOMIC_ACQUIRE, "wavefront");
        float4 w2 = *(const float4*)(M_RK + s * 16 + 4 * tq);
#pragma unroll
        for (int u = 0; u < 16; ++u) { const float a = Q_[s * 16 + u]; const float4 m4 = *(const float4*)(M_RB + u * 16 + 4 * tq); w2.x += a * m4.x; w2.y += a * m4.y; w2.z += a * m4.z; w2.w += a * m4.w; }
        *(float4*)(W2_ + s * 16 + 4 * tq) = w2;
    }
    __builtin_amdgcn_fence(__ATOMIC_RELEASE, "wavefront"); __builtin_amdgcn_wave_barrier(); __builtin_amdgcn_fence(__ATOMIC_ACQUIRE, "wavefront");
    cvt_f32x2 pt2[8], r22[8], ul2[8], yl2[8];
#pragma unroll
    for (int t = 0; t < 8; ++t) { pt2[t] = (cvt_f32x2){0.f, 0.f}; r22[t] = (cvt_f32x2){bf2f(S_RT[(2 * t) * 72 + lane]), bf2f(S_RT[(2 * t + 1) * 72 + lane])}; ul2[t] = pt2[t]; yl2[t] = pt2[t]; }
#pragma unroll
    for (int s = 0; s < 16; ++s) {
        const float as_ = bf2f(S_AB[s * 72 + lane]), vs_ = vv[s];
        const cvt_f32x2 as2 = {as_, as_}, vs2 = {vs_, vs_};
#pragma unroll
        for (int tq = 0; tq < 4; ++tq) {
            const float4 t4 = *(const float4*)(T_ + s * 16 + 4 * tq), q4 = *(const float4*)(Q_ + s * 16 + 4 * tq), w4 = *(const float4*)(W2_ + s * 16 + 4 * tq);
            pt2[2 * tq] += (cvt_f32x2){t4.x, t4.y} * as2; pt2[2 * tq + 1] += (cvt_f32x2){t4.z, t4.w} * as2;
            ul2[2 * tq] += (cvt_f32x2){q4.x, q4.y} * vs2; ul2[2 * tq + 1] += (cvt_f32x2){q4.z, q4.w} * vs2;
            yl2[2 * tq] += (cvt_f32x2){w4.x, w4.y} * vs2; yl2[2 * tq + 1] += (cvt_f32x2){w4.z, w4.w} * vs2;
        }
        __builtin_amdgcn_sched_barrier(0);
    }
    float pt[16], ul[16], yl[16];
#pragma unroll
    for (int t = 0; t < 8; ++t) { pt[2 * t] = pt2[t].x; pt[2 * t + 1] = pt2[t].y; ul[2 * t] = ul2[t].x; ul[2 * t + 1] = ul2[t].y; yl[2 * t] = yl2[t].x; yl[2 * t + 1] = yl2[t].y; }
#pragma unroll
    for (int s = 0; s < 16; ++s) {
        const cvt_f32x2 ps2 = {pt[s], pt[s]};
#pragma unroll
        for (int tq = 0; tq < 4; ++tq) {
            const float4 m4 = *(const float4*)(M_RB + s * 16 + 4 * tq);
            r22[2 * tq] += (cvt_f32x2){m4.x, m4.y} * ps2; r22[2 * tq + 1] += (cvt_f32x2){m4.z, m4.w} * ps2;
        }
        __builtin_amdgcn_sched_barrier(0);
    }
    float r2[16];
#pragma unroll
    for (int t = 0; t < 8; ++t) { r2[2 * t] = r22[t].x; r2[2 * t + 1] = r22[t].y; }
    unsigned char* rec = p.ws + WS_REC + (size_t)ct * REC_BYTES;
    float* ys = (float*)(p.ws + WS_YS);
    {
        const int jj = lane & 15, fo = (((lane >> 4) * 2 + ((jj >> 2) & 1)) * 16) * 16 + ((jj & 3) + 4 * (jj >> 3)) * 2;
#pragma unroll
        for (int t = 0; t < 16; ++t) {
            *(bf16_t*)(rec + fo + t * 16) = f2bf(pt[t]);
            *(bf16_t*)(rec + 2048 + fo + t * 16) = f2bf(r2[t]);
            ys[(unsigned)(row0 + t) * 1024u + (unsigned)col] = yl[t];
        }
    }
    {
        float gb[16], gk[16];
#pragma unroll
        for (int t = 0; t < 16; ++t) { gb[t] = gC * bf2f(S_BB[t * 72 + lane]); gk[t] = gC * bf2f(S_KB[t * 72 + lane]); }
        *(uint4*)(rec + 4096 + lane * 16) = make_uint4(pack2(gb[0], gb[1]), pack2(gb[2], gb[3]), pack2(gb[8], gb[9]), pack2(gb[10], gb[11]));
        *(uint4*)(rec + 4096 + (64 + lane) * 16) = make_uint4(pack2(gb[4], gb[5]), pack2(gb[6], gb[7]), pack2(gb[12], gb[13]), pack2(gb[14], gb[15]));
        *(uint4*)(rec + 6144 + lane * 16) = make_uint4(pack2(gk[0], gk[1]), pack2(gk[2], gk[3]), pack2(gk[4], gk[5]), pack2(gk[6], gk[7]));
        *(uint4*)(rec + 6144 + (64 + lane) * 16) = make_uint4(pack2(gk[8], gk[9]), pack2(gk[10], gk[11]), pack2(gk[12], gk[13]), pack2(gk[14], gk[15]));
        *(float*)(rec + 8192 + lane * 4) = gC;
        unsigned char* ip = rec + 8448 + (lane >> 5) * 3072;
        const int il = lane & 31;
        *(uint4*)(ip + il * 16) = make_uint4(pack2(vv[0], vv[1]), pack2(vv[2], vv[3]), pack2(vv[4], vv[5]), pack2(vv[6], vv[7]));
        *(uint4*)(ip + (32 + il) * 16) = make_uint4(pack2(vv[8], vv[9]), pack2(vv[10], vv[11]), pack2(vv[12], vv[13]), pack2(vv[14], vv[15]));
#pragma unroll
        for (int tq = 0; tq < 4; ++tq) *(float4*)(ip + 1024 + (((tq >> 1) * 2 + (tq & 1)) * 32 + il) * 16) = make_float4(ul[4 * tq], ul[4 * tq + 1], ul[4 * tq + 2], ul[4 * tq + 3]);
    }
    __builtin_amdgcn_fence(__ATOMIC_RELEASE, "wavefront"); __builtin_amdgcn_wave_barrier();
}

__device__ void pa_sample_task(const Params& p, int l, int task) {
    const int lane = opq_tid() & 63;
    const int bd = task >> 8, h = (task >> 4) & 15, wq = task & 15;
    const int irow = 4 * wq + (lane >> 4), jq = lane & 15;
    const size_t row = (size_t)TP + bd;
    const bf16_t* RSB = (const bf16_t*)(p.ws + WS_RSB);
    const float* RSW = (const float*)(p.ws + WS_RSW);
    const bf16_t* VALL = (const bf16_t*)(p.ws + WS_VALL);
    float* ys = (float*)(p.ws + WS_YS);
    const size_t so = (((size_t)(l * NBS + bd) * 16 + h) * 64 + irow) * 64 + 4 * jq;
    float4 s = *(const float4*)(p.state_wkv + so);
    const size_t o = row * 1024 + h * 64 + 4 * jq;
    const size_t os = (size_t)bd * 1024 + h * 64 + 4 * jq;
    const uint2 ur = *(const uint2*)(RSB + os), uk = *(const uint2*)(RSB + SRI + os), ukk = *(const uint2*)(RSB + 2 * SRI + os), ub = *(const uint2*)(RSB + 3 * SRI + os);
    const float4 w4 = *(const float4*)(RSW + os);
    const float v = bf2f(VALL[row * 1024 + h * 64 + irow]);
    float pa = s.x * bflo(ukk.x) + s.y * bfhi(ukk.x) + s.z * bflo(ukk.y) + s.w * bfhi(ukk.y);
    pa = allreduce16(pa);
    const float sa = -pa;
    s.x = fmaf(sa, bflo(ub.x), fmaf(s.x, w4.x, v * bflo(uk.x)));
    s.y = fmaf(sa, bfhi(ub.x), fmaf(s.y, w4.y, v * bfhi(uk.x)));
    s.z = fmaf(sa, bflo(ub.y), fmaf(s.z, w4.z, v * bflo(uk.y)));
    s.w = fmaf(sa, bfhi(ub.y), fmaf(s.w, w4.w, v * bfhi(uk.y)));
    float py = s.x * bflo(ur.x) + s.y * bfhi(ur.x) + s.z * bflo(ur.y) + s.w * bfhi(ur.y);
    py = allreduce16(py);
    *(float4*)(p.out + O_WKVS + so) = s;
    if (jq == 0) ys[row * 1024 + h * 64 + irow] = py;
}

constexpr int PB_NB = 8, PB_SLOT = 13568, PB_NCH = SEQ / 16, PB_NX = 4, PB_XOFF = PB_NB * PB_SLOT  , PB_FOFF = PB_XOFF + PB_NX * 4096;
__device__ void pb_head(const Params& p, unsigned char* lds, int l, int blk, bool dry) {
    const int tid = opq_tid(), wv = tid >> 6, lane = tid & 63;
    const int hh = blk >> 1, it = blk & 1, b = hh >> 4, h = hh & 15;
    volatile LAS unsigned* flags = (volatile LAS unsigned*)((LAS unsigned char*)lds + PB_FOFF);
    if (tid < 16) flags[tid] = 0u;
    __syncthreads();
    const unsigned char* rec0 = p.ws + WS_REC + (size_t)(hh * 256) * REC_BYTES;
    float* ys = (float*)(p.ws + WS_YS) + ((size_t)b * SEQ) * 1024 + h * 64 + 32 * it;
    const int q32 = lane & 31, hf = lane >> 5;
    if (wv >= 2) {
#pragma unroll 1
        for (int c = wv - 2; c < PB_NCH; c += 6) {
            while (c - (int)flags[8] >= PB_NB || c - (int)flags[9] >= PB_NB) __builtin_amdgcn_s_sleep(1);
            asm volatile("" ::: "memory");
            const unsigned char* rec = rec0 + (size_t)c * REC_BYTES;
            unsigned char* sl = lds + (c % PB_NB) * PB_SLOT;
            const unsigned char* rc = rec + lane * 16;
            const unsigned char* ri = rec + 8448 + it * 3072 + lane * 16;
            const uint4 d0 = *(const uint4*)(rc), d1 = *(const uint4*)(rc + 1024), d2 = *(const uint4*)(rc + 2048), d3 = *(const uint4*)(rc + 3072);
            const uint4 d4 = *(const uint4*)(rc + 4096), d5 = *(const uint4*)(rc + 5120), d6 = *(const uint4*)(rc + 6144), d7 = *(const uint4*)(rc + 7168);
            const uint4 d8 = *(const uint4*)(rec + 8192 + (lane & 15) * 16);
            const uint4 d9 = *(const uint4*)(ri), d10 = *(const uint4*)(ri + 1024), d11 = *(const uint4*)(ri + 2048);
            const int t0 = lane >> 3, cc = lane & 7;
            const uint4 d12 = *(const uint4*)(ys + (size_t)(16 * c + t0) * 1024 + cc * 4), d13 = *(const uint4*)(ys + (size_t)(16 * c + 8 + t0) * 1024 + cc * 4);
            __builtin_amdgcn_sched_barrier(0);
            unsigned char* sd = sl + lane * 16;
            *(uint4*)(sd) = d0; *(uint4*)(sd + 1024) = d1; *(uint4*)(sd + 2048) = d2; *(uint4*)(sd + 3072) = d3;
            *(uint4*)(sd + 4096) = d4; *(uint4*)(sd + 5120) = d5; *(uint4*)(sd + 6144) = d6; *(uint4*)(sd + 7168) = d7;
            if (lane < 16) *(uint4*)(sl + 8192 + lane * 16) = d8;
            *(uint4*)(sd + 8448) = d9; *(uint4*)(sd + 9472) = d10; *(uint4*)(sd + 10496) = d11;
            {
                float* yd = (float*)(sl + 11520) + ((((t0 >> 2) & 1) * 32 + 4 * cc) * 4 + (t0 & 3));
                yd[0] = __uint_as_float(d12.x); yd[4] = __uint_as_float(d12.y); yd[8] = __uint_as_float(d12.z); yd[12] = __uint_as_float(d12.w);
                yd[256] = __uint_as_float(d13.x); yd[260] = __uint_as_float(d13.y); yd[264] = __uint_as_float(d13.z); yd[268] = __uint_as_float(d13.w);
            }
            asm volatile("" ::: "memory");
            if (lane == 0) flags[c % PB_NB] = (unsigned)(c + 1);
        }
    } else if (wv == 1) {
        bf16x8 ra0, ra1, ra2, ra3; float4 y0, y1;
#define PB_FETCHY(c_) do { const unsigned char* sl_ = lds + ((c_) % PB_NB) * PB_SLOT; \
            while (flags[(c_) % PB_NB] != (unsigned)((c_) + 1)) __builtin_amdgcn_s_sleep(0); \
            asm volatile("" ::: "memory"); \
            const unsigned char* pr_ = sl_ + 2048 + (hf * 16 + (q32 & 15)) * 16; \
            ra0 = *(const bf16x8*)(pr_); ra1 = *(const bf16x8*)(pr_ + 512); ra2 = *(const bf16x8*)(pr_ + 1024); ra3 = *(const bf16x8*)(pr_ + 1536); \
            y0 = *(const float4*)(sl_ + 11520 + (hf * 32 + q32) * 16); y1 = *(const float4*)(sl_ + 11520 + ((2 + hf) * 32 + q32) * 16); \
            asm volatile("" ::: "memory"); \
            if (lane == 0) flags[9] = (unsigned)((c_) + 1); } while (0)
        PB_FETCHY(0);
#pragma unroll 1
        for (int c = 0; c < PB_NCH; ++c) {
            const unsigned char* xr = lds + PB_XOFF + (c % PB_NX) * 4096 + lane * 16;
            f32x16 Ya, Yb;
            Ya[0] = y0.x; Ya[1] = y0.y; Ya[2] = y0.z; Ya[3] = y0.w; Ya[4] = y1.x; Ya[5] = y1.y; Ya[6] = y1.z; Ya[7] = y1.w;
#pragma unroll
            for (int r = 8; r < 16; ++r) Ya[r] = 0.f;
#pragma unroll
            for (int r = 0; r < 16; ++r) Yb[r] = 0.f;
            const bf16x8 rc0 = ra0, rc1 = ra1, rc2 = ra2, rc3 = ra3;
            while (flags[10 + (c % PB_NX)] != (unsigned)(c + 1)) __builtin_amdgcn_s_sleep(0);
            asm volatile("" ::: "memory");
            const bf16x8 xf0 = *(const bf16x8*)(xr), xf1 = *(const bf16x8*)(xr + 1024), xf2 = *(const bf16x8*)(xr + 2048), xf3 = *(const bf16x8*)(xr + 3072);
            asm volatile("" ::: "memory");
            if (lane == 0) flags[14] = (unsigned)(c + 1);
            Ya = __builtin_amdgcn_mfma_f32_32x32x16_bf16(rc0, xf0, Ya, 0, 0, 0);
            Yb = __builtin_amdgcn_mfma_f32_32x32x16_bf16(rc1, xf1, Yb, 0, 0, 0);
            Ya = __builtin_amdgcn_mfma_f32_32x32x16_bf16(rc2, xf2, Ya, 0, 0, 0);
            Yb = __builtin_amdgcn_mfma_f32_32x32x16_bf16(rc3, xf3, Yb, 0, 0, 0);
            if (c + 1 < PB_NCH) PB_FETCHY(c + 1);
            float* yc = ys + (size_t)c * (16 * 1024);
            if (!dry) {
#pragma unroll
                for (int r = 0; r < 8; ++r) yc[(8 * (r >> 2) + 4 * hf + (r & 3)) * 1024 + q32] = Ya[r] + Yb[r];
            }
        }
#undef PB_FETCHY
    } else {
        f32x16 X0, X1;
#pragma unroll
        for (int i = 0; i < 16; ++i) { X0[i] = 0.f; X1[i] = 0.f; }
        bf16x8 pa0, pa1, pa2, pa3, gb0, gb1, gk0, gk1, vf;
        float4 gm0, gm1, gm2, gm3, gm4, gm5, gm6, gm7, u0, u1;
#define PB_FETCH(c_) do { const unsigned char* sl_ = lds + ((c_) % PB_NB) * PB_SLOT; \
            { unsigned rv_ = rdy; while (rv_ != (unsigned)((c_) + 1)) { __builtin_amdgcn_s_sleep(0); rv_ = flags[(c_) % PB_NB]; } } \
            asm volatile("" ::: "memory"); \
            const unsigned char* pr_ = sl_ + (hf * 16 + (q32 & 15)) * 16; \
            pa0 = *(const bf16x8*)(pr_); pa1 = *(const bf16x8*)(pr_ + 512); pa2 = *(const bf16x8*)(pr_ + 1024); pa3 = *(const bf16x8*)(pr_ + 1536); \
            gb0 = *(const bf16x8*)(sl_ + 4096 + (hf * 64 + q32) * 16); gb1 = *(const bf16x8*)(sl_ + 4096 + (hf * 64 + 32 + q32) * 16); \
            gk0 = *(const bf16x8*)(sl_ + 6144 + (hf * 64 + q32) * 16); gk1 = *(const bf16x8*)(sl_ + 6144 + (hf * 64 + 32 + q32) * 16); \
            vf = *(const bf16x8*)(sl_ + 8448 + (hf * 32 + q32) * 16); \
            const unsigned char* gp_ = sl_ + 8192 + 16 * hf; \
            gm0 = *(const float4*)(gp_); gm1 = *(const float4*)(gp_ + 32); gm2 = *(const float4*)(gp_ + 64); gm3 = *(const float4*)(gp_ + 96); \
            gm4 = *(const float4*)(gp_ + 128); gm5 = *(const float4*)(gp_ + 160); gm6 = *(const float4*)(gp_ + 192); gm7 = *(const float4*)(gp_ + 224); \
            u0 = *(const float4*)(sl_ + 9472 + (hf * 32 + q32) * 16); u1 = *(const float4*)(sl_ + 9472 + ((2 + hf) * 32 + q32) * 16); \
            asm volatile("" ::: "memory"); \
            if (lane == 0) flags[8] = (unsigned)((c_) + 1); } while (0)
        unsigned rdy = flags[0];
        PB_FETCH(0);
        int xfree = 0;
#pragma unroll 1
        for (int c = 0; c < PB_NCH; ++c) {
            unsigned char* xw = lds + PB_XOFF + (c % PB_NX) * 4096 + lane * 16;
            rdy = flags[(c + 1) % PB_NB];
            const bf16x8 xb0 = __builtin_bit_cast(bf16x8, make_uint4(pack2(X0[0], X0[1]), pack2(X0[2], X0[3]), pack2(X0[4], X0[5]), pack2(X0[6], X0[7])));
            const bf16x8 xb1 = __builtin_bit_cast(bf16x8, make_uint4(pack2(X0[8], X0[9]), pack2(X0[10], X0[11]), pack2(X0[12], X0[13]), pack2(X0[14], X0[15])));
            const bf16x8 xb2 = __builtin_bit_cast(bf16x8, make_uint4(pack2(X1[0], X1[1]), pack2(X1[2], X1[3]), pack2(X1[4], X1[5]), pack2(X1[6], X1[7])));
            const bf16x8 xb3 = __builtin_bit_cast(bf16x8, make_uint4(pack2(X1[8], X1[9]), pack2(X1[10], X1[11]), pack2(X1[12], X1[13]), pack2(X1[14], X1[15])));
            f32x16 Ua, Ub;
            Ua[0] = u0.x; Ua[1] = u0.y; Ua[2] = u0.z; Ua[3] = u0.w; Ua[4] = u1.x; Ua[5] = u1.y; Ua[6] = u1.z; Ua[7] = u1.w;
#pragma unroll
            for (int r = 8; r < 16; ++r) Ua[r] = 0.f;
#pragma unroll
            for (int r = 0; r < 16; ++r) Ub[r] = 0.f;
            Ua = __builtin_amdgcn_mfma_f32_32x32x16_bf16(pa0, xb0, Ua, 0, 0, 0);
            Ub = __builtin_amdgcn_mfma_f32_32x32x16_bf16(pa1, xb1, Ub, 0, 0, 0);
            Ua = __builtin_amdgcn_mfma_f32_32x32x16_bf16(pa2, xb2, Ua, 0, 0, 0);
            Ub = __builtin_amdgcn_mfma_f32_32x32x16_bf16(pa3, xb3, Ub, 0, 0, 0);
            f32x16 Xn0, Xn1;
            Xn0[0] = X0[0] * gm0.x; Xn0[1] = X0[1] * gm0.y; Xn0[2] = X0[2] * gm0.z; Xn0[3] = X0[3] * gm0.w; Xn0[4] = X0[4] * gm1.x; Xn0[5] = X0[5] * gm1.y; Xn0[6] = X0[6] * gm1.z; Xn0[7] = X0[7] * gm1.w;
            Xn0[8] = X0[8] * gm2.x; Xn0[9] = X0[9] * gm2.y; Xn0[10] = X0[10] * gm2.z; Xn0[11] = X0[11] * gm2.w; Xn0[12] = X0[12] * gm3.x; Xn0[13] = X0[13] * gm3.y; Xn0[14] = X0[14] * gm3.z; Xn0[15] = X0[15] * gm3.w;
            Xn1[0] = X1[0] * gm4.x; Xn1[1] = X1[1] * gm4.y; Xn1[2] = X1[2] * gm4.z; Xn1[3] = X1[3] * gm4.w; Xn1[4] = X1[4] * gm5.x; Xn1[5] = X1[5] * gm5.y; Xn1[6] = X1[6] * gm5.z; Xn1[7] = X1[7] * gm5.w;
            Xn1[8] = X1[8] * gm6.x; Xn1[9] = X1[9] * gm6.y; Xn1[10] = X1[10] * gm6.z; Xn1[11] = X1[11] * gm6.w; Xn1[12] = X1[12] * gm7.x; Xn1[13] = X1[13] * gm7.y; Xn1[14] = X1[14] * gm7.z; Xn1[15] = X1[15] * gm7.w;
            Xn0 = __builtin_amdgcn_mfma_f32_32x32x16_bf16(gk0, vf, Xn0, 0, 0, 0);
            Xn1 = __builtin_amdgcn_mfma_f32_32x32x16_bf16(gk1, vf, Xn1, 0, 0, 0);
            const bf16x8 gbc0 = gb0, gbc1 = gb1;
            while (c - xfree >= PB_NX) { xfree = (int)flags[14]; }
            asm volatile("" ::: "memory");
            *(bf16x8*)(xw) = xb0; *(bf16x8*)(xw + 1024) = xb1; *(bf16x8*)(xw + 2048) = xb2; *(bf16x8*)(xw + 3072) = xb3;
            asm volatile("" ::: "memory");
            if (lane == 0) flags[10 + (c % PB_NX)] = (unsigned)(c + 1);
            if (c + 1 < PB_NCH) PB_FETCH(c + 1);
            const bf16x8 ub = __builtin_bit_cast(bf16x8, make_uint4(pack2(Ua[0] + Ub[0], Ua[1] + Ub[1]), pack2(Ua[2] + Ub[2], Ua[3] + Ub[3]), pack2(Ua[4] + Ub[4], Ua[5] + Ub[5]), pack2(Ua[6] + Ub[6], Ua[7] + Ub[7])));
            X0 = __builtin_amdgcn_mfma_f32_32x32x16_bf16(gbc0, ub, Xn0, 0, 0, 0);
            X1 = __builtin_amdgcn_mfma_f32_32x32x16_bf16(gbc1, ub, Xn1, 0, 0, 0);
        }
#undef PB_FETCH
        float* so = p.out + O_WKVP + ((size_t)(l * NBP + b) * 16 + h) * 4096 + (size_t)(32 * it + q32) * 64;
#pragma unroll
        for (int g = 0; g < 4; ++g) {
            *(float4*)(so + 8 * g + 4 * hf) = make_float4(X0[4 * g], X0[4 * g + 1], X0[4 * g + 2], X0[4 * g + 3]);
            *(float4*)(so + 32 + 8 * g + 4 * hf) = make_float4(X1[4 * g], X1[4 * g + 1], X1[4 * g + 2], X1[4 * g + 3]);
        }
    }
    __syncthreads();
}

__device__ void p3_post(const Params& p, int l, int bid, int G) {
    const int tid = opq_tid(), wv = tid >> 6, lane = tid & 63;
    const float* ys = (const float*)(p.ws + WS_YS);
    const bf16_t* V = (const bf16_t*)(p.ws + WS_VALL);
    const float* coef = (const float*)(p.ws + WS_COEF);
    const bf16_t* gt = (const bf16_t*)(p.ws + WS_GT);
    bf16_t* cc = (bf16_t*)(p.ws + WS_HB);
    for (int r = bid * 8 + wv; r < MT; r += G * 8) {
#pragma unroll
        for (int hg = 0; hg < 4; ++hg) {
            const int head = 4 * hg + (lane >> 4), c = head * 64 + 4 * (lane & 15);
            const float4 y = *(const float4*)(ys + (size_t)r * 1024 + c);
            const float mu = allreduce16(y.x + y.y + y.z + y.w) * (1.f / 64.f);
            const float d0 = y.x - mu, d1 = y.y - mu, d2 = y.z - mu, d3 = y.w - mu;
            const float var = allreduce16(d0 * d0 + d1 * d1 + d2 * d2 + d3 * d3) * (1.f / 64.f);
            const float rs = rsqrtf(var + 64e-5f);
            const float4 lw = *(const float4*)(p.ln_w + l * 1024 + c), lb = *(const float4*)(p.ln_b + l * 1024 + c);
            const uint2 vu = *(const uint2*)(V + (size_t)r * 1024 + c);
            const float4 v4 = make_float4(bflo(vu.x), bfhi(vu.x), bflo(vu.y), bfhi(vu.y));
            const float cf = coef[(size_t)r * 16 + head];
            const uint2 gg = *(const uint2*)(gt + (size_t)r * DM + 1024 + c);
            const float o0 = (d0 * rs * lw.x + lb.x + cf * v4.x) * bflo(gg.x), o1 = (d1 * rs * lw.y + lb.y + cf * v4.y) * bfhi(gg.x);
            const float o2 = (d2 * rs * lw.z + lb.z + cf * v4.z) * bflo(gg.y), o3 = (d3 * rs * lw.w + lb.w + cf * v4.w) * bfhi(gg.y);
            *(uint2*)(cc + (size_t)r * DM + 1024 + c) = make_uint2(pack2(o0, o1), pack2(o2, o3));
        }
    }
}

__device__ void p_final(const Params& p, int bid, int G) {
    const int tid = opq_tid(), wv = tid >> 6, lane = tid & 63;
    const float4* g4 = (const float4*)p.final_g;
    for (int r = bid * 8 + wv; r < MT; r += G * 8) {
        float4* xr = (float4*)(p.out + (size_t)r * DM);
        float4 v[8]; float ss = 0.f;
#pragma unroll
        for (int i = 0; i < 8; ++i) { v[i] = xr[lane + 64 * i]; ss += v[i].x * v[i].x + v[i].y * v[i].y + v[i].z * v[i].z + v[i].w * v[i].w; }
        ss = wave_sum(ss);
        const float rinv = rsqrtf(ss * (1.f / 2048.f) + 1e-5f);
#pragma unroll
        for (int i = 0; i < 8; ++i) { const float4 g = g4[lane + 64 * i]; xr[lane + 64 * i] = make_float4(v[i].x * rinv * g.x, v[i].y * rinv * g.y, v[i].z * rinv * g.z, v[i].w * rinv * g.w); }
    }
}

#ifndef REPL
#define REPL -1
#endif
#ifndef REPK
#define REPK -100
#endif
__global__ void __launch_bounds__(512, 2) fwd_kernel(Params p_unused) {
    extern __shared__ __attribute__((aligned(16))) unsigned char shm[];
    cg::grid_group grid = cg::this_grid();
    const int bid0 = blockIdx.x, G0 = gridDim.x;
    float* shf = (float*)shm;
    volatile LAS unsigned* xst = (volatile LAS unsigned*)((LAS unsigned char*)shm + 131072);
    if (threadIdx.x == 0) { xst[0] = 0u; xst[1] = 0u; }
    __syncthreads();
    const XcdBarrier xb = xcd_barrier_post((unsigned*)(kparams().ws + WS_BAR), xst);
    if (G0 == 0x7fffffff) grid.sync();

#pragma unroll 1
    for (int ph = 0; ph < 16; ++ph) {
        const int bid = opq_s(bid0), G = opq_s(G0);
        const int l = ph >= 8 ? 1 : 0, k = ph == 0 ? -1 : (ph == 15 ? 7 : (ph - 1) - 7 * l);
#pragma unroll 1
        for (int rep = 0; rep < ((k == kparams().repk && (kparams().repl < 0 || kparams().repl == l)) ? 2 : 1); ++rep) {
        if (k == -1) {
            for (int it = bid; it < 384; it += G) p0_mod_item(kparams(), shf, it / 192, it % 192);
            for (int it = bid; it < 17; it += G) p0_rope_item(kparams(), it);
            for (int it = bid; it < 64; it += G) p0_wfrag_item(kparams(), it);
            p0_conv_all(kparams(), shf, bid, G, 2752, 0);
        } else if (k == 0) {
            p1_norm(kparams(), l, bid, G);
        } else if (k == 1) {
            pg8::StaticOrder S; S.init(MP, INWP, G, bid);
            pg8::Gemm g{(const bf16_t*)(kparams().ws + WS_HB), (const bf16_t*)(kparams().ws + WS_WTIN), MP, INWP, DM};
            Epi1 E{l};
            pg8::gemm_phase<Epi1, pg8::StaticOrder, false>((PG8_LAS unsigned char*)shm, g, S, E, nullptr);
        } else if (k == 2) {
            for (int it = bid; it < 256 + 256 + 1; it += G) {
                if (it < 256) p3_attn_unit(kparams(), shm, l, it);
                else if (it < 512) p3_twad_item(kparams(), l, it - 256);
                else p3_prep_tile(kparams(), shm, l, 256);
            }
        } else if (k == 3) {
            const int wvq = opq_tid() >> 6, gw = bid * 8 + wvq, nw = G * 8;
            for (int ct = gw; ct < 32 * 256; ct += nw) pa_chunk(kparams(), shm + wvq * PA_WLDS, l, ct);
            for (int task = gw; task < NBS * 256; task += nw) pa_sample_task(kparams(), l, task);
        } else if (k == 4) {
            if (bid < 64) pb_head(kparams(), shm, l, bid, rep == 0 && k == kparams().repk);
            else if (bid < 128) p3_sattn_item(kparams(), shf, l, bid - 64);
            else if (l == 0) p0_conv_all(kparams(), shf, bid - 128, G - 128, 1728, 1);
        } else if (k == 5) {
            p3_post(kparams(), l, bid, G);
        } else if (k == 6) {
            pg8::StaticOrder S; S.init(TP, DM, G, bid);
            pg8::Gemm g{(const bf16_t*)(kparams().ws + WS_HB), (const bf16_t*)(kparams().ws + WS_WTOUT) + (size_t)l * DM * DM, TP, DM, DM};
            Epi2 E{l};
            pg8::gemm_phase<Epi2, pg8::StaticOrder, false>((PG8_LAS unsigned char*)shm, g, S, E, nullptr);
            for (int nb = bid; nb < 64; nb += G) g2_sample_item(kparams(), shf, l, nb);
        } else {
            p_final(kparams(), bid, G);
        }
        if (ph < 15) xcd_barrier(xb);
        }
    }
}

extern "C" void kernel_launch(void* const* d_in, const int* in_sizes, int n_in, void* d_out, int out_size, void* d_ws, size_t ws_size, hipStream_t stream) {
    static int grid_blocks = 0;
    if (grid_blocks == 0) {
        if (n_in != 25 || (size_t)out_size != O_END || ws_size < WS_END) {
            fprintf(stderr, "kernel_launch: unexpected shapes: n_in %d out_size %d ws_size %zu (need %zu)\n", n_in, out_size, ws_size, (size_t)WS_END);
            grid_blocks = -1; return;
        }
        if (hipFuncSetAttribute((const void*)fwd_kernel, hipFuncAttributeMaxDynamicSharedMemorySize, LDS_BYTES) != hipSuccess) { fprintf(stderr, "kernel_launch: hipFuncSetAttribute failed\n"); grid_blocks = -1; return; }
        int dev = 0, cus = 0, per_cu = 0;
        hipGetDevice(&dev);
        hipDeviceGetAttribute(&cus, hipDeviceAttributeMultiprocessorCount, dev);
        hipOccupancyMaxActiveBlocksPerMultiprocessor(&per_cu, (const void*)fwd_kernel, 512, LDS_BYTES);
        if (per_cu < 1) { fprintf(stderr, "kernel_launch: occupancy query gives %d blocks per CU\n", per_cu); per_cu = 1; }
        (void)hipGetLastError();
        grid_blocks = cus;
        if (grid_blocks < 192) { fprintf(stderr, "kernel_launch: only %d CUs\n", grid_blocks); grid_blocks = -1; return; }
    }
    if (grid_blocks < 0) return;
    if (hipMemsetAsync((unsigned char*)d_ws + WS_BAR, 0, 16384, stream) != hipSuccess) { fprintf(stderr, "kernel_launch: memset of the barrier words failed\n"); return; }
    Params p{};
    const float** pp = (const float**)&p;
    for (int i = 0; i < 25; ++i) pp[i] = (const float*)d_in[i];
    p.out = (float*)d_out; p.ws = (unsigned char*)d_ws; p.repk = REPK; p.repl = REPL;
    void* args[] = {&p};
    hipError_t e = hipLaunchCooperativeKernel((const void*)fwd_kernel, dim3(grid_blocks), dim3(512), args, LDS_BYTES, stream);
    if (e != hipSuccess) fprintf(stderr, "cooperative launch failed: %s (grid %d)\n", hipGetErrorString(e), grid_blocks);
}
```

```cpp
#include <hip/hip_runtime.h>
#include <hip/hip_cooperative_groups.h>
#include <cstdio>
namespace cg = cooperative_groups;
__device__ __forceinline__ int opq_tid() { int t = threadIdx.x; asm volatile("" : "+v"(t)); return t; }
__device__ __forceinline__ int opq_s(int x) { asm volatile("" : "+s"(x)); return x; }
typedef float cvt_f32x2 __attribute__((ext_vector_type(2)));
typedef __bf16 cvt_bf16x2 __attribute__((ext_vector_type(2)));
__device__ __forceinline__ unsigned hw_cvt_pk_bf16(float lo, float hi) { const cvt_f32x2 v = {lo, hi}; return __builtin_bit_cast(unsigned, __builtin_convertvector(v, cvt_bf16x2)); }
typedef unsigned sc1_v4u __attribute__((ext_vector_type(4)));
__device__ __forceinline__ void st_sc1_b128(void* p, unsigned a, unsigned b, unsigned c, unsigned d) { const sc1_v4u v = {a, b, c, d}; asm volatile("global_store_dwordx4 %0, %1, off sc0 sc1\n\ts_nop 2" :: "v"(p), "v"(v) : "memory"); }
__device__ __forceinline__ void st_sc1_b32(void* p, float v) { asm volatile("global_store_dword %0, %1, off sc0 sc1\n\ts_nop 2" :: "v"(p), "v"(v) : "memory"); }
namespace pg8 {
#define PG8_LAS __attribute__((address_space(3)))
typedef unsigned short bf16_t;
typedef short bf16x8 __attribute__((ext_vector_type(8)));
typedef float f32x4 __attribute__((ext_vector_type(4)));
typedef unsigned u32x4 __attribute__((ext_vector_type(4)));
constexpr int BM = 256, BK = 64, HALF = 128, HTB = HALF * BK * 2  , STAGE_BYTES = 8 * HTB, NXCD = 8, WGM = 8;

__host__ __device__ __forceinline__ int lds_byte(int r, int c) { const int st = (r >> 4) * 2 + (c >> 5), rr = r & 15, cc = c & 31, ob = rr * 64 + cc * 2; return st * 1024 + (ob ^ (((ob >> 9) & 1) << 5)); }
__host__ __device__ __forceinline__ void stage_rc(int b, int& R, int& C) { const int st = b / 1024, sb = b % 1024, swz = sb ^ (((sb >> 9) & 1) << 5); R = (st >> 1) * 16 + swz / 64; C = (st & 1) * 32 + (swz % 64) / 2; }
__host__ __device__ __forceinline__ int perm32(int rho) { const int n = rho >> 4, i = rho & 15; return 8 * (i >> 2) + 4 * n + (i & 3); }

struct Unit { int pm, pn; };
struct Gemm { const bf16_t* A; const bf16_t* Bt; int M, N, K; };

struct StaticOrder {
    int nM, nN, nwg, G, c;
    __host__ __device__ void init(int M, int N, int G_, int c_) { nM = M / BM; nN = N / BM; nwg = nM * nN; G = G_; c = c_; }
    __host__ __device__ bool next(int i, Unit& u) const {
        const long L = (long)i * G + c; if (L >= nwg) return false;
        int wgid = (int)L; { const int q = nwg / NXCD, r = nwg % NXCD, xcd = wgid % NXCD, off = wgid / NXCD; wgid = (xcd < r ? xcd * (q + 1) : r * (q + 1) + (xcd - r) * q) + off; }
        const int nig = WGM * nN, gid = wgid / nig, fm = gid * WGM, gsz = (nM - fm) < WGM ? (nM - fm) : WGM;
        u.pm = fm + ((wgid % nig) % gsz); u.pn = (wgid % nig) / gsz; return true;
    }
    __device__ __forceinline__ void a_ready(const Unit&) const {}
    __device__ __forceinline__ void done(const Unit&) const {}
};
template <class Epi, class Sched, bool STAMP = false>
__device__ __forceinline__ void gemm_phase(PG8_LAS unsigned char* lds, const Gemm g, const Sched& S, const Epi& E, unsigned long long* stamps) {
    const int tid = opq_tid(), wid = __builtin_amdgcn_readfirstlane(tid >> 6), lane = tid & 63, wr = wid >> 2, wc = wid & 3, fr = lane & 15, fq = lane >> 4;
    const int K = g.K, nt = K / BK;
    int ts_lo = 0, ts_hi = 0, nts = 0; const unsigned long long rt_entry = STAMP ? (unsigned long long)wall_clock64() : 0ull;
#define PG8_STAMP() do { if (STAMP && wid == 0 && nts < 64) { const unsigned long long _c = (unsigned long long)clock64(); \
        ts_lo = (lane == nts) ? (int)(unsigned)_c : ts_lo; ts_hi = (lane == nts) ? (int)(unsigned)(_c >> 32) : ts_hi; ++nts; } } while (0)
    PG8_STAMP();
    unsigned voffA[2], voffB[2];
#pragma unroll
    for (int i = 0; i < 2; ++i) { int R, C; stage_rc(tid * 16 + i * 8192, R, C); const int Rb = Epi::PERM ? ((R & ~31) + perm32(R & 31)) : R;
        voffA[i] = (unsigned)(R * K + C) * 2u; voffB[i] = (unsigned)(Rb * K + C) * 2u; }
    const size_t kstep = (size_t)(BK * 2);
    const size_t hstep = (size_t)HALF * K * 2;
    const size_t tstep = 2 * hstep;
    const unsigned ldsw = (unsigned)wid * 1024u;
    const int aoff = lds_byte(wr * 64 + fr, fq * 8), boff = lds_byte(wc * 32 + fr, fq * 8);
#define PG8_SA(b, h) (((b) * 2 + (h)) * HTB)
#define PG8_SB(b, h) ((4 + (b) * 2 + (h)) * HTB)
#define PG8_STAGE(bufoff, gbase, voff) do { _Pragma("unroll") for (int _i = 0; _i < 2; ++_i) \
        __builtin_amdgcn_global_load_lds((const unsigned*)((const char*)(gbase) + (voff)[_i]), (PG8_LAS unsigned*)(lds + (bufoff) + ldsw + _i * 8192), 16, 0, 0); } while (0)
#define PG8_LDA(dst, b, h) do { _Pragma("unroll") for (int m = 0; m < 4; ++m) _Pragma("unroll") for (int k = 0; k < 2; ++k) dst[m][k] = *(const PG8_LAS bf16x8*)(lds + PG8_SA(b, h) + aoff + m * 2048 + k * 1024); } while (0)
#define PG8_LDB(dst, b, h) do { _Pragma("unroll") for (int n = 0; n < 2; ++n) _Pragma("unroll") for (int k = 0; k < 2; ++k) dst[n][k] = *(const PG8_LAS bf16x8*)(lds + PG8_SB(b, h) + boff + n * 2048 + k * 1024); } while (0)
#define PG8_MMA(ai, bj, At, Bt) do { __builtin_amdgcn_s_setprio(1); _Pragma("unroll") for (int m = 0; m < 4; ++m) _Pragma("unroll") for (int n = 0; n < 2; ++n) _Pragma("unroll") for (int k = 0; k < 2; ++k) \
        acc[ai][bj][m][n] = __builtin_amdgcn_mfma_f32_16x16x32_bf16(Bt[n][k], At[m][k], acc[ai][bj][m][n], 0, 0, 0); __builtin_amdgcn_s_setprio(0); } while (0)
#define PG8_WAIT_V(n) asm volatile("s_waitcnt vmcnt(" #n ")" ::: "memory")
#define PG8_WAIT_L(n) asm volatile("s_waitcnt lgkmcnt(" #n ")" ::: "memory")
#define PG8_BAR __builtin_amdgcn_s_barrier()
#define PG8_SCHED __builtin_amdgcn_sched_barrier(0)
    Unit cur, nxt; int ui = 0;
    if (!S.next(0, cur)) return;
    f32x4 acc[2][2][4][2];
#pragma unroll
    for (int a = 0; a < 2; ++a)
#pragma unroll
        for (int b = 0; b < 2; ++b)
#pragma unroll
            for (int m = 0; m < 4; ++m)
#pragma unroll
                for (int n = 0; n < 2; ++n) acc[a][b][m][n] = (f32x4){0.f, 0.f, 0.f, 0.f};
    bf16x8 At[4][2], B0[2][2], B1[2][2];
    const char* cA = (const char*)g.A + (size_t)cur.pm * tstep; const char* cB = (const char*)g.Bt + (size_t)cur.pn * tstep;
    S.a_ready(cur);
    PG8_STAGE(PG8_SB(0, 0), cB, voffB); PG8_STAGE(PG8_SA(0, 0), cA, voffA); PG8_STAGE(PG8_SB(0, 1), cB + hstep, voffB); PG8_STAGE(PG8_SA(0, 1), cA + hstep, voffA);
    if (wr == 1) PG8_BAR;
    PG8_WAIT_V(4); PG8_BAR;
    PG8_STAGE(PG8_SB(1, 0), cB + kstep, voffB); PG8_STAGE(PG8_SA(1, 0), cA + kstep, voffA); PG8_STAGE(PG8_SB(1, 1), cB + hstep + kstep, voffB);
    PG8_WAIT_V(6); PG8_BAR;
    PG8_STAMP();
    for (;;) {
        const bool has_next = S.next(ui + 1, nxt);
        const char* nA = has_next ? (const char*)g.A + (size_t)nxt.pm * tstep : cA; const char* nB = has_next ? (const char*)g.Bt + (size_t)nxt.pn * tstep : cB;
        for (int t = 0; t < nt; t += 2) {
            const bool last = (t == nt - 2);
            const char* a1 = cA + (size_t)(t + 1) * kstep;
            const char* a2 = last ? nA : cA + (size_t)(t + 2) * kstep; const char* b2 = last ? nB : cB + (size_t)(t + 2) * kstep;
            const char* a3 = a2 + kstep; const char* b3 = b2 + kstep;
            if (last && has_next) S.a_ready(nxt);
            PG8_LDB(B0, 0, 0); PG8_SCHED; PG8_LDA(At, 0, 0); PG8_STAGE(PG8_SA(1, 1), a1 + hstep, voffA);
            PG8_WAIT_L(8); PG8_BAR; PG8_WAIT_L(0); PG8_MMA(0, 0, At, B0); PG8_BAR; PG8_SCHED;
            PG8_LDB(B1, 0, 1); PG8_STAGE(PG8_SB(0, 0), b2, voffB);
            PG8_BAR; PG8_WAIT_L(0); PG8_MMA(0, 1, At, B1); PG8_BAR;
            PG8_LDA(At, 0, 1); PG8_STAGE(PG8_SA(0, 0), a2, voffA);
            PG8_BAR; PG8_WAIT_L(0); PG8_MMA(1, 0, At, B0); PG8_BAR; PG8_SCHED;
            PG8_STAGE(PG8_SB(0, 1), b2 + hstep, voffB);
            PG8_WAIT_V(6); PG8_BAR; PG8_MMA(1, 1, At, B1); PG8_BAR;
            PG8_LDB(B0, 1, 0); PG8_SCHED; PG8_LDA(At, 1, 0); PG8_STAGE(PG8_SA(0, 1), a2 + hstep, voffA);
            PG8_WAIT_L(8); PG8_BAR; PG8_WAIT_L(0); PG8_MMA(0, 0, At, B0); PG8_BAR; PG8_SCHED;
            PG8_LDB(B1, 1, 1); PG8_STAGE(PG8_SB(1, 0), b3, voffB);
            PG8_BAR; PG8_WAIT_L(0); PG8_MMA(0, 1, At, B1); PG8_BAR;
            PG8_LDA(At, 1, 1); PG8_STAGE(PG8_SA(1, 0), a3, voffA);
            PG8_BAR; PG8_WAIT_L(0); PG8_MMA(1, 0, At, B0); PG8_BAR; PG8_SCHED;
            PG8_STAGE(PG8_SB(1, 1), b3 + hstep, voffB);
            PG8_WAIT_V(6); PG8_BAR; PG8_MMA(1, 1, At, B1); PG8_BAR;
        }
        PG8_STAMP();
        if constexpr (!Epi::AFTER_DRAIN) { E(acc, cur, wr, wc, fr, fq); S.done(cur); }
        PG8_STAMP();
        if (!has_next) break;
#pragma unroll
        for (int a = 0; a < 2; ++a)
#pragma unroll
            for (int b = 0; b < 2; ++b)
#pragma unroll
                for (int m = 0; m < 4; ++m)
#pragma unroll
                    for (int n = 0; n < 2; ++n) acc[a][b][m][n] = (f32x4){0.f, 0.f, 0.f, 0.f};
        cur = nxt; cA = nA; cB = nB; ++ui;
    }
    PG8_WAIT_V(0);
    if (wr == 0) PG8_BAR;
    PG8_BAR;
    if constexpr (Epi::AFTER_DRAIN) { E.fused(acc, cur, wr, wc, fr, fq, lds, wid, lane); S.done(cur); }
    PG8_STAMP();
    if (STAMP && wid == 0) { stamps[lane] = lane < nts ? (((unsigned long long)(unsigned)ts_hi << 32) | (unsigned)ts_lo) : 0ull;
        if (lane == 62) stamps[62] = rt_entry; if (lane == 63) stamps[63] = (unsigned long long)wall_clock64(); }
#undef PG8_STAMP
#undef PG8_SA
#undef PG8_SB
#undef PG8_STAGE
#undef PG8_LDA
#undef PG8_LDB
#undef PG8_MMA
#undef PG8_WAIT_V
#undef PG8_WAIT_L
#undef PG8_BAR
#undef PG8_SCHED
}
}

#define XB_TMO      128
#define XB_XCNT(j)  (256  + 64 * (j))
#define XB_XSUB(j)  (1280 + 64 * (j))
#define XB_XGEN(j)  (2304 + 64 * (j))
#define XB_TOP      3328
#define XB_TOPGEN   3392
#define XCD_BAR_WORDS 3456
#define XB_SPIN_CAP (1u << 18)
#define LAS __attribute__((address_space(3)))

__device__ __forceinline__ unsigned xb_ld(unsigned* p)              { return __hip_atomic_load(p, __ATOMIC_RELAXED, __HIP_MEMORY_SCOPE_AGENT); }
__device__ __forceinline__ unsigned xb_add(unsigned* p, unsigned v) { return __hip_atomic_fetch_add(p, v, __ATOMIC_RELAXED, __HIP_MEMORY_SCOPE_AGENT); }
__device__ __forceinline__ unsigned xb_xcc_id() { return (unsigned)__builtin_amdgcn_s_getreg((3 << 11) | 20) & 0xFu; }
#define XB_SPIN(cond, bar) do { unsigned _sp = 0; while (cond) { __builtin_amdgcn_s_sleep(1); \
    if ((++_sp & 255u) == 0u) { if (xb_ld(&(bar)[XB_TMO])) break; if (_sp > XB_SPIN_CAP) { atomicAdd(&(bar)[XB_TMO], 1u); break; } } } } while (0)

struct XcdBarrier {
    unsigned* bar; unsigned x;
    volatile LAS unsigned* st;
};

__device__ __forceinline__ XcdBarrier xcd_barrier_post(unsigned* bar, volatile LAS unsigned* st) {
    XcdBarrier b; b.bar = bar; b.x = xb_xcc_id(); b.st = st;
    if (threadIdx.x == 0) (void)xb_add(&bar[XB_XCNT(b.x)], 1u);
    return b;
}
__device__ __forceinline__ void xcd_barrier_complete(unsigned* bar, unsigned x, unsigned& nloc, unsigned& nx) {
    const unsigned G = gridDim.x * gridDim.y * gridDim.z;
    unsigned sum, cnt, mine, sp = 0u;
    for (;;) {
        sum = 0u; cnt = 0u; mine = 0u;
#pragma unroll
        for (unsigned j = 0; j < 16; ++j) { const unsigned c = xb_ld(&bar[XB_XCNT(j)]); sum += c; cnt += (c > 0u) ? 1u : 0u; mine = (j == x) ? c : mine; }
        if (sum == G) break;
        __builtin_amdgcn_s_sleep(1);
        if ((++sp & 255u) == 0u) { if (xb_ld(&bar[XB_TMO])) break; if (sp > XB_SPIN_CAP) { atomicAdd(&bar[XB_TMO], 1u); break; } }
    }
    nloc = mine > 0u ? mine : 1u; nx = cnt > 0u ? cnt : 1u;
}

__device__ __forceinline__ void xcd_barrier(const XcdBarrier& b) {
    asm volatile("s_waitcnt vmcnt(0)" ::: "memory");
    __syncthreads();
    if (threadIdx.x == 0) {
        unsigned* bar = b.bar;
        __builtin_amdgcn_s_waitcnt(0);
        unsigned nloc = b.st[0], nx = b.st[1];
        if (nloc == 0u) { xcd_barrier_complete(bar, b.x, nloc, nx); b.st[0] = nloc; b.st[1] = nx; }
        const unsigned old = xb_add(&bar[XB_XSUB(b.x)], 1u);
        const unsigned gen = old / nloc;
        if (old + 1u == (gen + 1u) * nloc) {
            __builtin_amdgcn_fence(__ATOMIC_RELEASE, "agent");
            asm volatile("s_waitcnt vmcnt(0)" ::: "memory");
            const unsigned og = xb_add(&bar[XB_TOP], 1u);
            const unsigned tg = og / nx;
            if (og + 1u == (tg + 1u) * nx) xb_add(&bar[XB_TOPGEN], 1u);
            else XB_SPIN(xb_ld(&bar[XB_TOPGEN]) == tg, bar);
            __builtin_amdgcn_fence(__ATOMIC_ACQUIRE, "agent");
            xb_add(&bar[XB_XGEN(b.x)], 1u);
            asm volatile("s_waitcnt vmcnt(0)" ::: "memory");
        } else {
            XB_SPIN(xb_ld(&bar[XB_XGEN(b.x)]) == gen, bar);
            __builtin_amdgcn_fence(__ATOMIC_ACQUIRE, "agent");
            asm volatile("s_waitcnt vmcnt(0)" ::: "memory");
        }
    }
    __syncthreads();
}

typedef unsigned short bf16_t;
typedef short bf16x8 __attribute__((ext_vector_type(8)));
typedef float f32x4 __attribute__((ext_vector_type(4)));
typedef float f32x16 __attribute__((ext_vector_type(16)));

constexpr int DM = 2048, SEQ = 4096, NBP = 2, NBS = 32, TP = NBP * SEQ, MT = TP + NBS, MP = 8448;
constexpr int INW = 6784, INWP = 6912, SHD = 3200, DEPTH = 2;
constexpr size_t NRI = (size_t)MT * 1024;
constexpr int LDS_BYTES = 131072 + 16;
constexpr size_t O_CKP = (size_t)MT * DM;
constexpr size_t O_CVP = O_CKP + (size_t)DEPTH * NBP * 128 * 256;
constexpr size_t O_WKVP = O_CVP + (size_t)DEPTH * NBP * 128 * 256;
constexpr size_t O_SHP = O_WKVP + (size_t)DEPTH * NBP * 16 * 4096;
constexpr size_t O_CKS = O_SHP + (size_t)DEPTH * NBP * SHD;
constexpr size_t O_CVS = O_CKS + (size_t)DEPTH * NBS * 128 * 256;
constexpr size_t O_WKVS = O_CVS + (size_t)DEPTH * NBS * 128 * 256;
constexpr size_t O_SHS = O_WKVS + (size_t)DEPTH * NBS * 16 * 4096;
constexpr size_t O_END = O_SHS + (size_t)DEPTH * NBS * SHD;
constexpr size_t al256(size_t x) { return (x + 255) & ~(size_t)255; }
constexpr size_t WS_WTIN = 0;
constexpr size_t WS_WTOUT = WS_WTIN + (size_t)INWP * DM * 2;
constexpr size_t WS_MOD = WS_WTOUT + (size_t)DEPTH * DM * DM * 2;
constexpr size_t WS_ROPE = WS_MOD + al256((size_t)DEPTH * 34 * 6144 * 4);
constexpr size_t WS_HB = WS_ROPE + al256((size_t)4097 * 16 * 4);
constexpr size_t WS_QB = WS_HB + (size_t)MP * DM * 2;
constexpr size_t WS_KB = WS_QB + (size_t)MP * 1024 * 2;
constexpr size_t WS_VB = WS_KB + (size_t)MP * 256 * 2;
constexpr size_t WS_RW = WS_VB + (size_t)MP * 256 * 2;
constexpr size_t WS_GT = WS_RW + (size_t)MP * SHD * 2;
constexpr size_t WS_VALL = WS_GT + (size_t)MP * DM * 2;
constexpr size_t SRI = (size_t)NBS * 1024;
constexpr size_t WS_RSB = WS_VALL + NRI * 2;
constexpr size_t WS_RSW = WS_RSB + 4 * SRI * 2;
constexpr size_t WS_YS = WS_RSW + SRI * 4;
constexpr size_t WS_REC = WS_YS + NRI * 4;
constexpr size_t WS_COEF = WS_REC + (size_t)32 * 256 * 14592;
constexpr size_t WS_TWAD = WS_COEF + al256((size_t)MT * 16 * 4);
constexpr size_t WS_WFRAG = WS_TWAD + (size_t)MT * 128 * 2;
constexpr size_t WS_BAR = WS_WFRAG + (size_t)DEPTH * 2 * 16 * 4 * 2 * 64 * 16;
constexpr size_t WS_RFLAG = WS_BAR + 16384;
constexpr size_t RFLAG_BYTES = (size_t)32 * 256 * 64;
constexpr size_t WS_END = WS_RFLAG + RFLAG_BYTES;

struct Params {
    const float *x_prompt, *x_sample, *cache_k, *cache_v, *state_wkv, *state_shift, *c_prompt, *c_sample, *norm_g, *w_ada, *b_ada, *w_in, *mu_shift, *w0, *w_decay, *a0,
        *w_iclr, *k_k, *k_a, *r_k, *ln_w, *ln_b, *sinks, *w_out, *final_g;
    float* out;
    unsigned char* ws;
    int repk, repl;
};
typedef const __attribute__((address_space(4))) Params* KParamsPtr;
__device__ __forceinline__ const Params& kparams() {
    KParamsPtr k = (KParamsPtr)__builtin_amdgcn_kernarg_segment_ptr();
    asm volatile("" : "+s"(k));
    return *(const Params*)k;
}

__device__ __forceinline__ unsigned short f2bf(float f) { return (unsigned short)(hw_cvt_pk_bf16(f, 0.f) & 0xffffu); }
__device__ __forceinline__ float bf2f(unsigned short b) { return __uint_as_float(((unsigned)b) << 16); }
__device__ __forceinline__ unsigned pack2(float lo, float hi) { return hw_cvt_pk_bf16(lo, hi); }
__device__ __forceinline__ float bflo(unsigned w) { return __uint_as_float(w << 16); }
__device__ __forceinline__ float bfhi(unsigned w) { return __uint_as_float(w & 0xffff0000u); }
__device__ __forceinline__ float silu_f(float x) { return x / (1.f + __expf(-x)); }
__device__ __forceinline__ float wave_sum(float x) {
#pragma unroll
    for (int o = 32; o >= 1; o >>= 1) x += __shfl_xor(x, o);
    return x;
}
__device__ __forceinline__ float wave_max(float x) {
#pragma unroll
    for (int o = 32; o >= 1; o >>= 1) x = fmaxf(x, __shfl_xor(x, o));
    return x;
}
template <int CTRL> __device__ __forceinline__ float dpp_f(float x) {
    return __builtin_bit_cast(float, __builtin_amdgcn_update_dpp(0, __builtin_bit_cast(int, x), CTRL, 0xF, 0xF, false));
}
__device__ __forceinline__ float allreduce16(float x) {
    x += dpp_f<0x128>(x);
    x += dpp_f<0x124>(x);
    x += dpp_f<0x122>(x);
    x += dpp_f<0x121>(x);
    return x;
}

__device__ void p0_mod_item(const Params& p, float* red, int l, int nc) {
    const int tid = opq_tid(), wv = tid >> 6, lane = tid & 63, n = lane & 31, kh = lane >> 5;
    f32x16 acc0, acc1;
#pragma unroll
    for (int i = 0; i < 16; ++i) { acc0[i] = 0.f; acc1[i] = 0.f; }
    const float* W = p.w_ada + (size_t)l * DM * 6144 + nc * 32 + n;
#pragma unroll 4
    for (int ks = 0; ks < 16; ++ks) {
        const int k0 = wv * 256 + ks * 16 + kh * 8;
        bf16x8 bfr, a0, a1;
#pragma unroll
        for (int j = 0; j < 8; ++j) bfr[j] = (short)f2bf(W[(size_t)(k0 + j) * 6144]);
        const float4* cs = (const float4*)(p.c_sample + (size_t)n * DM + k0);
        const float4 u0 = cs[0], u1 = cs[1];
        a0[0] = (short)f2bf(silu_f(u0.x)); a0[1] = (short)f2bf(silu_f(u0.y)); a0[2] = (short)f2bf(silu_f(u0.z)); a0[3] = (short)f2bf(silu_f(u0.w));
        a0[4] = (short)f2bf(silu_f(u1.x)); a0[5] = (short)f2bf(silu_f(u1.y)); a0[6] = (short)f2bf(silu_f(u1.z)); a0[7] = (short)f2bf(silu_f(u1.w));
        float4 q0 = make_float4(0.f, 0.f, 0.f, 0.f), q1 = q0;
        if (n < 2) { const float4* cp = (const float4*)(p.c_prompt + (size_t)n * DM + k0); q0 = cp[0]; q1 = cp[1]; }
        a1[0] = (short)f2bf(silu_f(q0.x)); a1[1] = (short)f2bf(silu_f(q0.y)); a1[2] = (short)f2bf(silu_f(q0.z)); a1[3] = (short)f2bf(silu_f(q0.w));
        a1[4] = (short)f2bf(silu_f(q1.x)); a1[5] = (short)f2bf(silu_f(q1.y)); a1[6] = (short)f2bf(silu_f(q1.z)); a1[7] = (short)f2bf(silu_f(q1.w));
        acc0 = __builtin_amdgcn_mfma_f32_32x32x16_bf16(a0, bfr, acc0, 0, 0, 0);
        acc1 = __builtin_amdgcn_mfma_f32_32x32x16_bf16(a1, bfr, acc1, 0, 0, 0);
    }
#pragma unroll
    for (int i = 0; i < 16; ++i) red[(wv * 18 + i) * 64 + lane] = acc0[i];
    red[(wv * 18 + 16) * 64 + lane] = acc1[0];
    red[(wv * 18 + 17) * 64 + lane] = acc1[1];
    __syncthreads();
    float* mod = (float*)(p.ws + WS_MOD);
    for (int o = tid; o < 34 * 32; o += 512) {
        const int row = o >> 5, col = o & 31;
        int ri, ln, mrow;
        if (row < 32) { const int khh = (row >> 2) & 1; ri = (row & 3) + 4 * (row >> 3); ln = col + 32 * khh; mrow = 2 + row; }
        else { ri = 16 + (row - 32); ln = col; mrow = row - 32; }
        float s = 0.f;
#pragma unroll
        for (int w = 0; w < 8; ++w) s += red[(w * 18 + ri) * 64 + ln];
        mod[((size_t)l * 34 + mrow) * 6144 + nc * 32 + col] = s + p.b_ada[l * 6144 + nc * 32 + col];
    }
    __syncthreads();
}

struct ConvIt { const float* src; bf16_t* dst; int N, k0, n0; };
__device__ __forceinline__ ConvIt conv_decode(const Params& p, int cidx, int lw) {
    ConvIt c;
    int kt, nt;
    if (cidx < 1728) { kt = cidx & 15; nt = cidx >> 4; c.N = INW; c.src = p.w_in + (size_t)lw * DM * INW; c.dst = (bf16_t*)(p.ws + WS_WTIN); }
    else { int rem = cidx - 1728; const int l2 = rem >> 9; rem &= 511; kt = rem & 15; nt = rem >> 4; c.N = DM; c.src = p.w_out + (size_t)l2 * DM * DM; c.dst = (bf16_t*)(p.ws + WS_WTOUT) + (size_t)l2 * DM * DM; }
    c.k0 = kt * 128; c.n0 = nt * 64;
    return c;
}
__device__ void p0_conv_all(const Params& p, float* s, int bid, int G, int total, int lw) {
    const int tid = opq_tid();
    const int lrow = tid >> 4, c4 = tid & 15, n = tid >> 3, kg = tid & 7;
    float4 v[4];
    int cidx = bid;
    ConvIt cur = conv_decode(p, cidx < total ? cidx : 0, lw);
    if (cidx < total) {
#pragma unroll
        for (int p4 = 0; p4 < 4; ++p4) { v[p4] = make_float4(0.f, 0.f, 0.f, 0.f); if (cur.n0 < cur.N) v[p4] = *(const float4*)(cur.src + (size_t)(cur.k0 + lrow + 32 * p4) * cur.N + cur.n0 + 4 * c4); }
    }
#pragma unroll 1
    while (cidx < total) {
#pragma unroll
        for (int p4 = 0; p4 < 4; ++p4) { float* d = s + (lrow + 32 * p4) * 65 + 4 * c4; d[0] = v[p4].x; d[1] = v[p4].y; d[2] = v[p4].z; d[3] = v[p4].w; }
        __syncthreads();
        const int nxt = cidx + G;
        const ConvIt nx = conv_decode(p, nxt < total ? nxt : 0, lw);
        if (nxt < total) {
#pragma unroll
            for (int p4 = 0; p4 < 4; ++p4) { v[p4] = make_float4(0.f, 0.f, 0.f, 0.f); if (nx.n0 < nx.N) v[p4] = *(const float4*)(nx.src + (size_t)(nx.k0 + lrow + 32 * p4) * nx.N + nx.n0 + 4 * c4); }
        }
        unsigned w[8];
#pragma unroll
        for (int j = 0; j < 8; ++j) w[j] = pack2(s[(kg * 16 + 2 * j) * 65 + n], s[(kg * 16 + 2 * j + 1) * 65 + n]);
        uint4* o = (uint4*)(cur.dst + (size_t)(cur.n0 + n) * DM + cur.k0 + kg * 16);
        o[0] = make_uint4(w[0], w[1], w[2], w[3]);
        o[1] = make_uint4(w[4], w[5], w[6], w[7]);
        __syncthreads();
        cur = nx; cidx = nxt;
    }
}

__device__ void p0_rope_item(const Params& p, int it) {
    float* rope = (float*)(p.ws + WS_ROPE);
#pragma unroll
    for (int q = 0; q < 4; ++q) {
        const int e = it * 2048 + q * 512 + opq_tid();
        if (e < 4097 * 8) {
            const int idx = e >> 3, i = e & 7;
            double invf = 1.0;
            for (int q = 0; q < i; ++q) invf *= 0.19392274474868576;
            const double pos = idx < 4096 ? (double)idx : 16384.0;
            const double rev = pos * invf * 0.15915494309189535;
            const float f = (float)(rev - floor(rev));
            rope[idx * 16 + i] = __builtin_amdgcn_cosf(f);
            rope[idx * 16 + 8 + i] = __builtin_amdgcn_sinf(f);
        }
    }
}

__device__ void p0_wfrag_item(const Params& p, int it) {
    const int e0 = it * 512 + opq_tid();
    const int lane = e0 & 63, ks = (e0 >> 6) & 1, ct = (e0 >> 7) & 3, hd = (e0 >> 9) & 15, mtx = (e0 >> 13) & 1, l = e0 >> 14;
    const float* W = (mtx == 0 ? p.w_decay : p.w_iclr) + (size_t)l * 64 * 1024 + hd * 64 + 16 * ct + (lane & 15);
    const int k0 = 32 * ks + 8 * (lane >> 4);
    float v[8];
#pragma unroll
    for (int e = 0; e < 8; ++e) v[e] = W[(size_t)(k0 + e) * 1024];
    ((uint4*)(p.ws + WS_WFRAG))[e0] = make_uint4(pack2(v[0], v[1]), pack2(v[2], v[3]), pack2(v[4], v[5]), pack2(v[6], v[7]));
}

__device__ void p1_norm(const Params& p, int l, int bid, int G) {
    const int tid = opq_tid(), wv = tid >> 6, lane = tid & 63;
    bf16_t* hb = (bf16_t*)(p.ws + WS_HB);
    const float* mod = (const float*)(p.ws + WS_MOD);
    const float4* g4 = (const float4*)(p.norm_g + l * DM);
    for (int r = bid * 8 + wv; r < MT; r += G * 8) {
        const float* xr = l == 0 ? (r < TP ? p.x_prompt + (size_t)r * DM : p.x_sample + (size_t)(r - TP) * DM) : p.out + (size_t)r * DM;
        const int mrow = r < TP ? (r >> 12) : 2 + (r - TP);
        const float* md = mod + ((size_t)l * 34 + mrow) * 6144;
        float4 v[8]; float ss = 0.f;
#pragma unroll
        for (int i = 0; i < 8; ++i) { v[i] = ((const float4*)xr)[lane + 64 * i]; ss += v[i].x * v[i].x + v[i].y * v[i].y + v[i].z * v[i].z + v[i].w * v[i].w; }
        ss = wave_sum(ss);
        const float rinv = rsqrtf(ss * (1.f / 2048.f) + 1e-5f);
#pragma unroll
        for (int i = 0; i < 8; ++i) {
            const int c4 = lane + 64 * i;
            const float4 g = g4[c4], sc = ((const float4*)(md + 2048))[c4], sh = ((const float4*)md)[c4];
            const float y0 = v[i].x * rinv * g.x * (1.f + sc.x) + sh.x, y1 = v[i].y * rinv * g.y * (1.f + sc.y) + sh.y;
            const float y2 = v[i].z * rinv * g.z * (1.f + sc.z) + sh.z, y3 = v[i].w * rinv * g.w * (1.f + sc.w) + sh.w;
            *(uint2*)(hb + (size_t)r * DM + 4 * c4) = make_uint2(pack2(y0, y1), pack2(y2, y3));
        }
    }
}

struct Epi1 {
    static constexpr bool PERM = false, AFTER_DRAIN = false;
    int l;
    __device__ __forceinline__ void operator()(const f32x4 (&acc)[2][2][4][2], const pg8::Unit& u, int wr, int wc, int fr, int fq) const {
        const Params& p = kparams();
        bf16_t* const qb = (bf16_t*)(p.ws + WS_QB); bf16_t* const kb = (bf16_t*)(p.ws + WS_KB); bf16_t* const vb = (bf16_t*)(p.ws + WS_VB);
        bf16_t* const rw = (bf16_t*)(p.ws + WS_RW); bf16_t* const gt = (bf16_t*)(p.ws + WS_GT); const float* const rope = (const float*)(p.ws + WS_ROPE); float* const out = p.out;
#pragma unroll
        for (int bj = 0; bj < 2; ++bj)
#pragma unroll
            for (int n = 0; n < 2; ++n) {
                const int cb = u.pn * 256 + bj * 128 + wc * 32 + n * 16;
                if (cb >= INW) continue;
                const int c = cb + 4 * fq;
                const bool do_rope = (cb < 1280) && ((cb & 63) == 0);
#pragma unroll
                for (int ai = 0; ai < 2; ++ai)
#pragma unroll
                    for (int m = 0; m < 4; ++m) {
                        const int rb = u.pm * 256 + ai * 128 + wr * 64 + m * 16;
                        if (rb >= MT) continue;
                        const int r = rb + fr;
                        f32x4 v = acc[ai][bj][m][n];
                        if (do_rope) {
                            const int idx = r < TP ? (r & 4095) : 4096;
                            const float4 cs = *(const float4*)(rope + idx * 16 + 4 * (fq & 1));
                            const float4 sn = *(const float4*)(rope + idx * 16 + 8 + 4 * (fq & 1));
                            const float p0 = __shfl_xor(v[0], 32), p1 = __shfl_xor(v[1], 32), p2 = __shfl_xor(v[2], 32), p3 = __shfl_xor(v[3], 32);
                            const float sg = fq < 2 ? -1.f : 1.f;
                            v[0] = v[0] * cs.x + sg * p0 * sn.x; v[1] = v[1] * cs.y + sg * p1 * sn.y; v[2] = v[2] * cs.z + sg * p2 * sn.z; v[3] = v[3] * cs.w + sg * p3 * sn.w;
                        }
                        if (cb < 1024) {
                            *(uint2*)(qb + (size_t)r * 1024 + c) = make_uint2(pack2(v[0] * 0.125f, v[1] * 0.125f), pack2(v[2] * 0.125f, v[3] * 0.125f));
                        } else if (cb < 1536) {
                            const bool isk = cb < 1280;
                            const int cc = c - (isk ? 1024 : 1280);
                            *(uint2*)((isk ? kb : vb) + (size_t)r * 256 + cc) = make_uint2(pack2(v[0], v[1]), pack2(v[2], v[3]));
                            if (r >= TP) {
                                *(f32x4*)(out + (isk ? O_CKS : O_CVS) + ((size_t)(l * NBS + (r - TP)) * 128 + 127) * 256 + cc) = v;
                            } else if ((r & 4095) >= SEQ - 128) {
                                *(f32x4*)(out + (isk ? O_CKP : O_CVP) + ((size_t)(l * NBP + (r >> 12)) * 128 + ((r & 4095) - (SEQ - 128))) * 256 + cc) = v;
                            }
                        } else if (cb < 4736) {
                            const int cc = c - 1536;
                            *(uint2*)(rw + (size_t)r * SHD + cc) = make_uint2(pack2(v[0], v[1]), pack2(v[2], v[3]));
                            if (r >= TP) *(f32x4*)(out + O_SHS + (size_t)(l * NBS + (r - TP)) * SHD + cc) = v;
                            else if ((r & 4095) == SEQ - 1) *(f32x4*)(out + O_SHP + (size_t)(l * NBP + (r >> 12)) * SHD + cc) = v;
                        } else {
                            const int cc = c - 4736;
                            *(uint2*)(gt + (size_t)r * DM + cc) = make_uint2(pack2(silu_f(v[0]), silu_f(v[1])), pack2(silu_f(v[2]), silu_f(v[3])));
                        }
                    }
            }
    }
};

struct Epi2 {
    static constexpr bool PERM = false, AFTER_DRAIN = false;
    int l;
    __device__ __forceinline__ void operator()(const f32x4 (&acc)[2][2][4][2], const pg8::Unit& u, int wr, int wc, int fr, int fq) const {
        const Params& p = kparams();
        const float* const xp = p.x_prompt; const float* const xs = p.x_sample; const float* const modl = (const float*)(p.ws + WS_MOD) + (size_t)l * 34 * 6144; float* const out = p.out;
#pragma unroll
        for (int ai = 0; ai < 2; ++ai)
#pragma unroll
            for (int m = 0; m < 4; ++m) {
                const int rb = u.pm * 256 + ai * 128 + wr * 64 + m * 16;
                if (rb >= MT) continue;
                const int r = rb + fr;
                const int mrow = r < TP ? (r >> 12) : 2 + (r - TP);
                const float* xo = l == 0 ? (r < TP ? xp + (size_t)r * DM : xs + (size_t)(r - TP) * DM) : out + (size_t)r * DM;
                const float* gr = modl + (size_t)mrow * 6144 + 4096;
#pragma unroll
                for (int bj = 0; bj < 2; ++bj)
#pragma unroll
                    for (int n = 0; n < 2; ++n) {
                        const int c = u.pn * 256 + bj * 128 + wc * 32 + n * 16 + 4 * fq;
                        const f32x4 x4 = *(const f32x4*)(xo + c), g4 = *(const f32x4*)(gr + c);
                        *(f32x4*)(out + (size_t)r * DM + c) = x4 + g4 * acc[ai][bj][m][n];
                    }
            }
    }
};

__device__ void g2_sample_item(const Params& p, float* red, int l, int nb) {
    const int tid = opq_tid(), wv = tid >> 6, lane = tid & 63, n = lane & 31, h = lane >> 5;
    const bf16_t* A = (const bf16_t*)(p.ws + WS_HB) + (size_t)TP * DM;
    const bf16_t* Bt = (const bf16_t*)(p.ws + WS_WTOUT) + (size_t)l * DM * DM + (size_t)(nb * 32) * DM;
    f32x16 acc;
#pragma unroll
    for (int i = 0; i < 16; ++i) acc[i] = 0.f;
#pragma unroll 4
    for (int ks = 0; ks < 16; ++ks) {
        const int k0 = wv * 256 + ks * 16 + 8 * h;
        const bf16x8 a = *(const bf16x8*)(A + (size_t)n * DM + k0);
        const bf16x8 bq = *(const bf16x8*)(Bt + (size_t)n * DM + k0);
        acc = __builtin_amdgcn_mfma_f32_32x32x16_bf16(a, bq, acc, 0, 0, 0);
    }
#pragma unroll
    for (int i = 0; i < 16; ++i) red[(wv * 16 + i) * 64 + lane] = acc[i];
    __syncthreads();
    const float* mod = (const float*)(p.ws + WS_MOD) + (size_t)l * 34 * 6144;
    for (int o = tid; o < 1024; o += 512) {
        const int row = o >> 5, col = o & 31, hh = (row >> 2) & 1, ri = (row & 3) + 4 * (row >> 3), ln = col + 32 * hh;
        float s = 0.f;
#pragma unroll
        for (int w = 0; w < 8; ++w) s += red[(w * 16 + ri) * 64 + ln];
        const int c = nb * 32 + col;
        const float gate = mod[(size_t)(2 + row) * 6144 + 4096 + c];
        const float xo = l == 0 ? p.x_sample[(size_t)row * DM + c] : p.out[(size_t)(TP + row) * DM + c];
        p.out[(size_t)(TP + row) * DM + c] = xo + gate * s;
    }
    __syncthreads();
}

__device__ void p3_attn_unit(const Params& p, unsigned char* lds, int l, int unit) {
    const int tid = opq_tid(), wv = tid >> 6, lane = tid & 63;
    const int b = unit >> 7, n = (unit >> 2) & 31, g = unit & 3;
    bf16_t* Ks = (bf16_t*)lds;
    bf16_t* Vt = (bf16_t*)(lds + 36864);
    const bf16_t* qb = (const bf16_t*)(p.ws + WS_QB);
    const bf16_t* kb = (const bf16_t*)(p.ws + WS_KB);
    const bf16_t* vb = (const bf16_t*)(p.ws + WS_VB);
    const bf16_t* gt = (const bf16_t*)(p.ws + WS_GT);
    bf16_t* cc = (bf16_t*)(p.ws + WS_HB);
    {
        uint4 kv4[4], vv4[4];
#pragma unroll
        for (int i = 0; i < 4; ++i) {
            const int chunk = tid + 512 * i, kl = chunk >> 3, dc = chunk & 7, kp = 128 * (n - 1) + kl;
            kv4[i] = make_uint4(0u, 0u, 0u, 0u); vv4[i] = kv4[i];
            if (kp >= 0) { const size_t row = (size_t)b * SEQ + kp; kv4[i] = *(const uint4*)(kb + row * 256 + g * 64 + dc * 8); vv4[i] = *(const uint4*)(vb + row * 256 + g * 64 + dc * 8); }
        }
        __builtin_amdgcn_sched_barrier(0);
#pragma unroll
        for (int i = 0; i < 4; ++i) {
            const int chunk = tid + 512 * i, kl = chunk >> 3, dc = chunk & 7;
            *(uint4*)(Ks + kl * 72 + dc * 8) = kv4[i];
            bf16_t* vd = Vt + (dc * 8) * 264 + kl;
            vd[0 * 264] = (bf16_t)(vv4[i].x & 0xffffu); vd[1 * 264] = (bf16_t)(vv4[i].x >> 16);
            vd[2 * 264] = (bf16_t)(vv4[i].y & 0xffffu); vd[3 * 264] = (bf16_t)(vv4[i].y >> 16);
            vd[4 * 264] = (bf16_t)(vv4[i].z & 0xffffu); vd[5 * 264] = (bf16_t)(vv4[i].z >> 16);
            vd[6 * 264] = (bf16_t)(vv4[i].w & 0xffffu); vd[7 * 264] = (bf16_t)(vv4[i].w >> 16);
        }
    }
    __syncthreads();
    const int hq = 4 * g + (wv >> 1), qh = wv & 1, q32 = lane & 31, h = lane >> 5;
    const float sink = p.sinks[l * 16 + hq];
#pragma unroll 1
    for (int s = 0; s < 2; ++s) {
        const int qp = 128 * n + 64 * qh + 32 * s + q32;
        const size_t qrow = (size_t)b * SEQ + qp;
        const int klb0 = 64 * qh + 32 * s;
        bf16x8 qf[4];
#pragma unroll
        for (int ks = 0; ks < 4; ++ks) qf[ks] = *(const bf16x8*)(qb + qrow * 1024 + hq * 64 + ks * 16 + 8 * h);
        f32x16 S[5];
#pragma unroll
        for (int kt = 0; kt < 5; ++kt) {
#pragma unroll
            for (int i = 0; i < 16; ++i) S[kt][i] = 0.f;
#pragma unroll
            for (int ks = 0; ks < 4; ++ks) {
                const bf16x8 a = *(const bf16x8*)(Ks + (klb0 + 32 * kt + q32) * 72 + ks * 16 + 8 * h);
                S[kt] = __builtin_amdgcn_mfma_f32_32x32x16_bf16(a, qf[ks], S[kt], 0, 0, 0);
            }
        }
        float mx = -1e30f;
#pragma unroll
        for (int kt = 0; kt < 5; ++kt)
#pragma unroll
            for (int i = 0; i < 16; ++i) {
                const int m = 8 * (i >> 2) + 4 * h + (i & 3);
                const int kp = 128 * (n - 1) + klb0 + 32 * kt + m;
                const int rel = qp - kp;
                const bool ok = (rel >= 0) && (rel <= 128) && (kp >= 0);
                const float sv = ok ? S[kt][i] : -1e30f;
                S[kt][i] = sv; mx = fmaxf(mx, sv);
            }
        mx = fmaxf(mx, __shfl_xor(mx, 32));
        mx = fmaxf(mx, sink);
        float sum = 0.f;
#pragma unroll
        for (int kt = 0; kt < 5; ++kt)
#pragma unroll
            for (int i = 0; i < 16; ++i) { const float e = __expf(S[kt][i] - mx); S[kt][i] = e; sum += e; }
        sum += __shfl_xor(sum, 32);
        const float inv = 1.f / (sum + __expf(sink - mx));
        f32x16 O[2];
#pragma unroll
        for (int i = 0; i < 16; ++i) { O[0][i] = 0.f; O[1][i] = 0.f; }
#pragma unroll
        for (int kt = 0; kt < 5; ++kt)
#pragma unroll
            for (int sp = 0; sp < 2; ++sp) {
                bf16x8 pf;
#pragma unroll
                for (int j = 0; j < 8; ++j) pf[j] = (short)f2bf(S[kt][8 * sp + j]);
#pragma unroll
                for (int dt = 0; dt < 2; ++dt) {
                    const bf16_t* vp = Vt + (32 * dt + q32) * 264 + klb0 + 32 * kt + 16 * sp + 4 * h;
                    const uint2 lo = *(const uint2*)vp, hi = *(const uint2*)(vp + 8);
                    const uint4 av = make_uint4(lo.x, lo.y, hi.x, hi.y);
                    O[dt] = __builtin_amdgcn_mfma_f32_32x32x16_bf16(__builtin_bit_cast(bf16x8, av), pf, O[dt], 0, 0, 0);
                }
            }
#pragma unroll
        for (int dt = 0; dt < 2; ++dt)
#pragma unroll
            for (int ig = 0; ig < 4; ++ig) {
                const int col = hq * 64 + 32 * dt + 8 * ig + 4 * h;
                const uint2 gg = *(const uint2*)(gt + qrow * DM + col);
                const float o0 = O[dt][4 * ig + 0] * inv * bflo(gg.x), o1 = O[dt][4 * ig + 1] * inv * bfhi(gg.x);
                const float o2 = O[dt][4 * ig + 2] * inv * bflo(gg.y), o3 = O[dt][4 * ig + 3] * inv * bfhi(gg.y);
                *(uint2*)(cc + qrow * DM + col) = make_uint2(pack2(o0, o1), pack2(o2, o3));
            }
    }
    __syncthreads();
}

__device__ void p3_sattn_item(const Params& p, float* lds, int l, int item) {
    const int tid = opq_tid(), wv = tid >> 6, lane = tid & 63;
    float* pl = lds + wv * 128;
    const int w = item * 8 + wv, bd = w >> 4, hq = w & 15, g = hq >> 2;
    const size_t row = (size_t)TP + bd;
    const bf16_t* qb = (const bf16_t*)(p.ws + WS_QB);
    const bf16_t* gt = (const bf16_t*)(p.ws + WS_GT);
    bf16_t* cc = (bf16_t*)(p.ws + WS_HB);
    float q[64];
#pragma unroll
    for (int c = 0; c < 8; ++c) {
        const uint4 u = *(const uint4*)(qb + row * 1024 + hq * 64 + c * 8);
        q[c * 8 + 0] = bflo(u.x); q[c * 8 + 1] = bfhi(u.x); q[c * 8 + 2] = bflo(u.y); q[c * 8 + 3] = bfhi(u.y);
        q[c * 8 + 4] = bflo(u.z); q[c * 8 + 5] = bfhi(u.z); q[c * 8 + 6] = bflo(u.w); q[c * 8 + 7] = bfhi(u.w);
    }
    const size_t cbase = ((size_t)(l * NBS + bd) * 128) * 256 + g * 64;
    const float* ck = p.cache_k + cbase;
    const float* cv = p.cache_v + cbase;
    float* nk = p.out + O_CKS + cbase;
    float* nv = p.out + O_CVS + cbase;
    float s0 = 0.f, s1 = 0.f, s2 = 0.f;
#pragma unroll
    for (int c = 0; c < 16; ++c) {
        const float4 a = ((const float4*)(ck + (size_t)lane * 256))[c];
        const float4 bq = ((const float4*)(ck + (size_t)(lane + 64) * 256))[c];
        const float4 e = ((const float4*)(nk + (size_t)127 * 256))[c];
        s0 += a.x * q[4 * c] + a.y * q[4 * c + 1] + a.z * q[4 * c + 2] + a.w * q[4 * c + 3];
        s1 += bq.x * q[4 * c] + bq.y * q[4 * c + 1] + bq.z * q[4 * c + 2] + bq.w * q[4 * c + 3];
        s2 += e.x * q[4 * c] + e.y * q[4 * c + 1] + e.z * q[4 * c + 2] + e.w * q[4 * c + 3];
    }
    const float sink = p.sinks[l * 16 + hq];
    const float mx = fmaxf(wave_max(fmaxf(s0, s1)), fmaxf(s2, sink));
    const float p0 = __expf(s0 - mx), p1 = __expf(s1 - mx), p2 = __expf(s2 - mx);
    const float sum = wave_sum(p0 + p1) + p2 + __expf(sink - mx);
    pl[lane] = p0; pl[lane + 64] = p1;
    __builtin_amdgcn_fence(__ATOMIC_RELEASE, "wavefront");
    __builtin_amdgcn_wave_barrier();
    __builtin_amdgcn_fence(__ATOMIC_ACQUIRE, "wavefront");
    float o = 0.f;
#pragma unroll 32
    for (int key = 0; key < 128; ++key) o += pl[key] * cv[(size_t)key * 256 + lane];
    o += p2 * nv[(size_t)127 * 256 + lane];
    o /= sum;
    const float gate = bf2f(gt[row * DM + hq * 64 + lane]);
    cc[row * DM + hq * 64 + lane] = f2bf(o * gate);
    {
        float tk[32], tv[32];
#pragma unroll
        for (int i = 0; i < 32; ++i) {
            const int ww = (hq & 3) + 4 * i;
            tk[i] = ck[(size_t)(ww + 1 < 128 ? ww + 1 : 127) * 256 + lane]; tv[i] = cv[(size_t)(ww + 1 < 128 ? ww + 1 : 127) * 256 + lane];
        }
#pragma unroll
        for (int i = 0; i < 32; ++i) {
            const int ww = (hq & 3) + 4 * i;
            if (ww < 127) { nk[(size_t)ww * 256 + lane] = tk[i]; nv[(size_t)ww * 256 + lane] = tv[i]; }
        }
    }
    __builtin_amdgcn_wave_barrier();
}

__device__ __forceinline__ float mix_val(const bf16_t* rw, const float* sshift, const float* mu, int r, int c) {
    const float cur = bf2f(rw[(size_t)r * SHD + c]);
    float prev;
    if (r >= TP) prev = sshift[(size_t)(r - TP) * SHD + c];
    else if ((r & 4095) == 0) prev = 0.f;
    else prev = bf2f(rw[(size_t)(r - 1) * SHD + c]);
    return cur + (prev - cur) * mu[c];
}

__device__ __forceinline__ float4 mix4(const bf16_t* rw, const float* sshift, int r, int c, float4 mu4) {
    const uint2 cu = *(const uint2*)(rw + (size_t)r * SHD + c);
    const float4 cur = make_float4(bflo(cu.x), bfhi(cu.x), bflo(cu.y), bfhi(cu.y));
    float4 prev = make_float4(0.f, 0.f, 0.f, 0.f);
    if (r >= TP) prev = *(const float4*)(sshift + (size_t)(r - TP) * SHD + c);
    else if ((r & 4095) != 0) { const uint2 pu = *(const uint2*)(rw + (size_t)(r - 1) * SHD + c); prev = make_float4(bflo(pu.x), bfhi(pu.x), bflo(pu.y), bfhi(pu.y)); }
    return make_float4(cur.x + (prev.x - cur.x) * mu4.x, cur.y + (prev.y - cur.y) * mu4.y, cur.z + (prev.z - cur.z) * mu4.z, cur.w + (prev.w - cur.w) * mu4.w);
}
__device__ __forceinline__ float decay_of(float x) {
    const float z = -x;
    const float sp = fmaxf(z, 0.f) + __logf(1.f + __expf(-fabsf(z)));
    return __expf(-__expf(-sp - 0.5f));
}

__device__ void p3_twad_item(const Params& p, int l, int tile) {
    const int tid = opq_tid();
    const bf16_t* rw = (const bf16_t*)(p.ws + WS_RW);
    const float* sshift = p.state_shift + (size_t)l * NBS * SHD;
    const float* mu = p.mu_shift + l * SHD;
    bf16_t* TWAD = (bf16_t*)(p.ws + WS_TWAD);
    const int r0 = tile * 32;
    float mm[8];
#pragma unroll
    for (int i = 0; i < 8; ++i) { const int idx = tid + 512 * i, tt = idx >> 7, c2 = idx & 127; mm[i] = mix_val(rw, sshift, mu, r0 + tt, 3072 + c2); }
#pragma unroll
    for (int i = 0; i < 8; ++i) {
        const int idx = tid + 512 * i, tt = idx >> 7, c2 = idx & 127;
        float o = mm[i];
        if (c2 < 64) { const float e = __expf(2.f * mm[i]); o = 1.f - 2.f / (e + 1.f); }
        TWAD[(size_t)(r0 + tt) * 128 + c2] = f2bf(o);
    }
}

__device__ void p3_prep_tile(const Params& p, unsigned char* lds, int l, int tile) {
    const int tid = opq_tid(), wv = tid >> 6, lane = tid & 63, n = lane & 31, h = lane >> 5;
    bf16_t* TW = (bf16_t*)lds;
    bf16_t* AD = TW + 32 * 72;
    const bf16_t* rw = (const bf16_t*)(p.ws + WS_RW);
    const float* sshift = p.state_shift + (size_t)l * NBS * SHD;
    const float* mu = p.mu_shift + l * SHD;
    bf16_t* RSB = (bf16_t*)(p.ws + WS_RSB);
    bf16_t* VALL = (bf16_t*)(p.ws + WS_VALL);
    float* RSW = (float*)(p.ws + WS_RSW);
    float* coef = (float*)(p.ws + WS_COEF);
    const int r0 = tile * 32;
    {
        float mm[8];
#pragma unroll
        for (int i = 0; i < 8; ++i) { const int idx = tid + 512 * i, tt = idx >> 7, c2 = idx & 127; mm[i] = mix_val(rw, sshift, mu, r0 + tt, 3072 + c2); }
        __builtin_amdgcn_sched_barrier(0);
#pragma unroll
        for (int i = 0; i < 8; ++i) {
            const int idx = tid + 512 * i, tt = idx >> 7, c2 = idx & 127;
            if (c2 < 64) { const float e = __expf(2.f * mm[i]); TW[tt * 72 + c2] = f2bf(1.f - 2.f / (e + 1.f)); }
            else AD[tt * 72 + (c2 - 64)] = f2bf(mm[i]);
        }
    }
    __syncthreads();
    const int col0 = wv * 128 + 4 * n;
    f32x16 acc[4];
    {
        const float* wp = p.w_decay + (size_t)l * 64 * 1024 + col0;
#pragma unroll
        for (int nt = 0; nt < 4; ++nt)
#pragma unroll
            for (int i = 0; i < 16; ++i) acc[nt][i] = 0.f;
#pragma unroll
        for (int ks = 0; ks < 4; ++ks) {
            const bf16x8 a = *(const bf16x8*)(TW + n * 72 + 16 * ks + 8 * h);
            float4 w4[8];
#pragma unroll
            for (int e = 0; e < 8; ++e) w4[e] = *(const float4*)(wp + (size_t)(16 * ks + 8 * h + e) * 1024);
            bf16x8 b0, b1, b2, b3;
#pragma unroll
            for (int e = 0; e < 8; ++e) { b0[e] = (short)f2bf(w4[e].x); b1[e] = (short)f2bf(w4[e].y); b2[e] = (short)f2bf(w4[e].z); b3[e] = (short)f2bf(w4[e].w); }
            acc[0] = __builtin_amdgcn_mfma_f32_32x32x16_bf16(a, b0, acc[0], 0, 0, 0);
            acc[1] = __builtin_amdgcn_mfma_f32_32x32x16_bf16(a, b1, acc[1], 0, 0, 0);
            acc[2] = __builtin_amdgcn_mfma_f32_32x32x16_bf16(a, b2, acc[2], 0, 0, 0);
            acc[3] = __builtin_amdgcn_mfma_f32_32x32x16_bf16(a, b3, acc[3], 0, 0, 0);
        }
        const float4 w0c = *(const float4*)(p.w0 + l * 1024 + col0);
#pragma unroll
        for (int r = 0; r < 16; ++r) {
            const int row = r0 + 8 * (r >> 2) + 4 * h + (r & 3);
            *(float4*)(RSW + (size_t)(row - TP) * 1024 + col0) =
                make_float4(decay_of(w0c.x + acc[0][r]), decay_of(w0c.y + acc[1][r]), decay_of(w0c.z + acc[2][r]), decay_of(w0c.w + acc[3][r]));
        }
    }
    {
        const float* wp = p.w_iclr + (size_t)l * 64 * 1024 + col0;
#pragma unroll
        for (int nt = 0; nt < 4; ++nt)
#pragma unroll
            for (int i = 0; i < 16; ++i) acc[nt][i] = 0.f;
#pragma unroll
        for (int ks = 0; ks < 4; ++ks) {
            const bf16x8 a = *(const bf16x8*)(AD + n * 72 + 16 * ks + 8 * h);
            float4 w4[8];
#pragma unroll
            for (int e = 0; e < 8; ++e) w4[e] = *(const float4*)(wp + (size_t)(16 * ks + 8 * h + e) * 1024);
            bf16x8 b0, b1, b2, b3;
#pragma unroll
            for (int e = 0; e < 8; ++e) { b0[e] = (short)f2bf(w4[e].x); b1[e] = (short)f2bf(w4[e].y); b2[e] = (short)f2bf(w4[e].z); b3[e] = (short)f2bf(w4[e].w); }
            acc[0] = __builtin_amdgcn_mfma_f32_32x32x16_bf16(a, b0, acc[0], 0, 0, 0);
            acc[1] = __builtin_amdgcn_mfma_f32_32x32x16_bf16(a, b1, acc[1], 0, 0, 0);
            acc[2] = __builtin_amdgcn_mfma_f32_32x32x16_bf16(a, b2, acc[2], 0, 0, 0);
            acc[3] = __builtin_amdgcn_mfma_f32_32x32x16_bf16(a, b3, acc[3], 0, 0, 0);
        }
    }
    const float4 a0c = *(const float4*)(p.a0 + l * 1024 + col0), kkc = *(const float4*)(p.k_k + l * 1024 + col0), kac = *(const float4*)(p.k_a + l * 1024 + col0), rkc = *(const float4*)(p.r_k + l * 1024 + col0);
    const float4 mur = *(const float4*)(mu + col0), muk = *(const float4*)(mu + 1024 + col0), muv = *(const float4*)(mu + 2048 + col0);
    const int head = 2 * wv + (n >> 4);
#pragma unroll
    for (int g4 = 0; g4 < 4; ++g4) {
        float4 rr4[4], kr4[4], vr4[4];
#pragma unroll
        for (int q = 0; q < 4; ++q) {
            const int row = r0 + 8 * g4 + 4 * h + q;
            rr4[q] = mix4(rw, sshift, row, col0, mur); kr4[q] = mix4(rw, sshift, row, 1024 + col0, muk); vr4[q] = mix4(rw, sshift, row, 2048 + col0, muv);
        }
        __builtin_amdgcn_sched_barrier(0);
#pragma unroll
        for (int q = 0; q < 4; ++q) {
            const int r = 4 * g4 + q;
            const int row = r0 + 8 * g4 + 4 * h + q;
            const float4 rr = rr4[q], kr = kr4[q], vr = vr4[q];
            const float ax = 1.f / (1.f + __expf(-(a0c.x + acc[0][r]))), ay = 1.f / (1.f + __expf(-(a0c.y + acc[1][r])));
            const float az = 1.f / (1.f + __expf(-(a0c.z + acc[2][r]))), aw = 1.f / (1.f + __expf(-(a0c.w + acc[3][r])));
            const float k0 = kr.x * kkc.x, k1 = kr.y * kkc.y, k2 = kr.z * kkc.z, k3 = kr.w * kkc.w;
            const float ss = allreduce16(k0 * k0 + k1 * k1 + k2 * k2 + k3 * k3);
            const float inv = 1.f / fmaxf(sqrtf(ss), 1e-12f);
            const float4 kk = make_float4(k0 * inv, k1 * inv, k2 * inv, k3 * inv);
            const float4 ke = make_float4(kr.x * (1.f + (ax - 1.f) * kac.x), kr.y * (1.f + (ay - 1.f) * kac.y), kr.z * (1.f + (az - 1.f) * kac.z), kr.w * (1.f + (aw - 1.f) * kac.w));
            const float cf = allreduce16(rr.x * ke.x * rkc.x + rr.y * ke.y * rkc.y + rr.z * ke.z * rkc.z + rr.w * ke.w * rkc.w);
            if ((n & 15) == 0) coef[(size_t)row * 16 + head] = cf;
            const size_t o = (size_t)row * 1024 + col0;
            const size_t os = (size_t)(row - TP) * 1024 + col0;
            *(uint2*)(RSB + os) = make_uint2(pack2(rr.x, rr.y), pack2(rr.z, rr.w));
            *(uint2*)(RSB + SRI + os) = make_uint2(pack2(ke.x, ke.y), pack2(ke.z, ke.w));
            *(uint2*)(RSB + 2 * SRI + os) = make_uint2(pack2(kk.x, kk.y), pack2(kk.z, kk.w));
            *(uint2*)(RSB + 3 * SRI + os) = make_uint2(pack2(kk.x * ax, kk.y * ay), pack2(kk.z * az, kk.w * aw));
            *(uint2*)(VALL + o) = make_uint2(pack2(vr.x, vr.y), pack2(vr.z, vr.w));
        }
        __builtin_amdgcn_sched_barrier(0);
    }
    __syncthreads();
}

constexpr int REC_BYTES = 14592;
constexpr int PA_WLDS = 16384;
typedef float f32x4v __attribute__((ext_vector_type(4)));

__device__ void pa_chunk(const Params& p, unsigned char* wl, int l, int ct) {
    const int lane = opq_tid() & 63;
    const int hh = ct >> 8, c = ct & 255, b = hh >> 4, h = hh & 15;
    const size_t row0 = (size_t)b * SEQ + 16 * c;
    const int col = h * 64 + lane;
    bf16_t* VALL = (bf16_t*)(p.ws + WS_VALL);
    float vv[16];
    float gC;
    bf16_t* S_AB = (bf16_t*)wl; bf16_t* S_BB = S_AB + 16 * 72; bf16_t* S_KB = S_BB + 16 * 72; bf16_t* S_RT = S_KB + 16 * 72;
    {
        const bf16_t* rw = (const bf16_t*)(p.ws + WS_RW);
        const bf16_t* TWAD = (const bf16_t*)(p.ws + WS_TWAD);
        const uint4* WFd = (const uint4*)(p.ws + WS_WFRAG) + (size_t)((l * 2 + 0) * 16 + h) * 512 + lane;
        const uint4* WFi = (const uint4*)(p.ws + WS_WFRAG) + (size_t)((l * 2 + 1) * 16 + h) * 512 + lane;
        unsigned xr[17], xk[17], xv[17];
        const bool first = (row0 & 4095) == 0;
#pragma unroll
        for (int t = 0; t < 17; ++t) {
            const unsigned ro = (unsigned)(row0 + t - 1) * (unsigned)SHD + (unsigned)col;
            if (t == 0 && first) { xr[0] = 0u; xk[0] = 0u; xv[0] = 0u; }
            else { xr[t] = rw[ro]; xk[t] = rw[ro + 1024u]; xv[t] = rw[ro + 2048u]; }
        }
        const int rr = lane & 15, kg = lane >> 4;
        f32x4v Dd[4], Da[4];
#pragma unroll
        for (int ct = 0; ct < 4; ++ct) { Dd[ct] = (f32x4v){0.f, 0.f, 0.f, 0.f}; Da[ct] = Dd[ct]; }
#pragma unroll
        for (int ks = 0; ks < 2; ++ks) {
            const bf16x8 atw = *(const bf16x8*)(TWAD + (size_t)(row0 + rr) * 128 + 32 * ks + 8 * kg);
            const bf16x8 aad = *(const bf16x8*)(TWAD + (size_t)(row0 + rr) * 128 + 64 + 32 * ks + 8 * kg);
#pragma unroll
            for (int ct = 0; ct < 4; ++ct) {
                const bf16x8 bd = __builtin_bit_cast(bf16x8, WFd[(ct * 2 + ks) * 64]);
                const bf16x8 bi = __builtin_bit_cast(bf16x8, WFi[(ct * 2 + ks) * 64]);
                Dd[ct] = __builtin_amdgcn_mfma_f32_16x16x32_bf16(atw, bd, Dd[ct], 0, 0, 0);
                Da[ct] = __builtin_amdgcn_mfma_f32_16x16x32_bf16(aad, bi, Da[ct], 0, 0, 0);
            }
        }
        float* LD = (float*)wl; float* LA = LD + 1024;
#pragma unroll
        for (int ct = 0; ct < 4; ++ct)
#pragma unroll
            for (int rg = 0; rg < 4; ++rg) { LD[(4 * kg + rg) * 64 + 16 * ct + rr] = Dd[ct][rg]; LA[(4 * kg + rg) * 64 + 16 * ct + rr] = Da[ct][rg]; }
        __builtin_amdgcn_fence(__ATOMIC_RELEASE, "wavefront"); __builtin_amdgcn_wave_barrier(); __builtin_amdgcn_fence(__ATOMIC_ACQUIRE, "wavefront");
        float din[16], ain[16];
#pragma unroll
        for (int t = 0; t < 16; ++t) { din[t] = LD[t * 64 + lane]; ain[t] = LA[t * 64 + lane]; }
        __builtin_amdgcn_fence(__ATOMIC_RELEASE, "wavefront"); __builtin_amdgcn_wave_barrier(); __builtin_amdgcn_fence(__ATOMIC_ACQUIRE, "wavefront");
        const float mur = p.mu_shift[l * SHD + col], muk = p.mu_shift[l * SHD + 1024 + col], muv = p.mu_shift[l * SHD + 2048 + col];
        const float w0c = p.w0[l * 1024 + col], a0c = p.a0[l * 1024 + col], kkc = p.k_k[l * 1024 + col], kac = p.k_a[l * 1024 + col], rkc = p.r_k[l * 1024 + col];
        float* coef = (float*)(p.ws + WS_COEF);
        float g = 1.f;
#pragma unroll
        for (int t = 0; t < 16; ++t) {
            const float cr = bf2f((unsigned short)xr[t + 1]), pr = bf2f((unsigned short)xr[t]), ck = bf2f((unsigned short)xk[t + 1]), pk = bf2f((unsigned short)xk[t]);
            const float cv = bf2f((unsigned short)xv[t + 1]), pv = bf2f((unsigned short)xv[t]);
            const float r_ = cr + (pr - cr) * mur, kr = ck + (pk - ck) * muk, vr = cv + (pv - cv) * muv;
            const float a = 1.f / (1.f + __expf(-(a0c + ain[t])));
            const float dec = decay_of(w0c + din[t]);
            const float kkr = kr * kkc;
            float ss = allreduce16(kkr * kkr); ss += __shfl_xor(ss, 16); ss += __shfl_xor(ss, 32);
            const float kkv = kkr / fmaxf(sqrtf(ss), 1e-12f);
            const float ke = kr * (1.f + (a - 1.f) * kac);
            float cf = allreduce16(r_ * ke * rkc); cf += __shfl_xor(cf, 16); cf += __shfl_xor(cf, 32);
            if (lane == 0) coef[(size_t)(row0 + t) * 16 + h] = cf;
            VALL[(unsigned)(row0 + t) * 1024u + (unsigned)col] = f2bf(vr);
            vv[t] = vr;
            S_AB[t * 72 + lane] = f2bf(-g * kkv);
            g *= dec;
            const float ig = __builtin_amdgcn_rcpf(g);
            S_BB[t * 72 + lane] = f2bf(kkv * a * ig); S_KB[t * 72 + lane] = f2bf(ke * ig); S_RT[t * 72 + lane] = f2bf(g * r_);
        }
        gC = g;
    }
    __builtin_amdgcn_fence(__ATOMIC_RELEASE, "wavefront"); __builtin_amdgcn_wave_barrier(); __builtin_amdgcn_fence(__ATOMIC_ACQUIRE, "wavefront");
    f32x4v Gab = {0.f, 0.f, 0.f, 0.f}, Gak = Gab, Grb = Gab, Grk = Gab;
    {
        const int rr = lane & 15, kg = lane >> 4;
#pragma unroll
        for (int ks = 0; ks < 2; ++ks) {
            const int o = rr * 72 + 32 * ks + 8 * kg;
            const bf16x8 fA = *(const bf16x8*)(S_AB + o), fB = *(const bf16x8*)(S_BB + o), fK = *(const bf16x8*)(S_KB + o), fR = *(const bf16x8*)(S_RT + o);
            Gab = __builtin_amdgcn_mfma_f32_16x16x32_bf16(fB, fA, Gab, 0, 0, 0);
            Gak = __builtin_amdgcn_mfma_f32_16x16x32_bf16(fK, fA, Gak, 0, 0, 0);
            Grb = __builtin_amdgcn_mfma_f32_16x16x32_bf16(fB, fR, Grb, 0, 0, 0);
            Grk = __builtin_amdgcn_mfma_f32_16x16x32_bf16(fK, fR, Grk, 0, 0, 0);
        }
    }
    __builtin_amdgcn_fence(__ATOMIC_RELEASE, "wavefront"); __builtin_amdgcn_wave_barrier(); __builtin_amdgcn_fence(__ATOMIC_ACQUIRE, "wavefront");
    float* M_AB = (float*)(wl + 9216); float* M_AK = M_AB + 256; float* M_RB = M_AK + 256; float* M_RK = M_RB + 256; float* T_ = M_RK + 256; float* Q_ = T_ + 256; float* W2_ = Q_ + 256;
    {
        const int t = lane & 15, kg = lane >> 4;
#pragma unroll
        for (int rg = 0; rg < 4; ++rg) {
            const int s = 4 * kg + rg;
            M_AB[s * 16 + t] = s < t ? Gab[rg] : 0.f; M_AK[s * 16 + t] = s < t ? Gak[rg] : 0.f;
            M_RB[s * 16 + t] = s <= t ? Grb[rg] : 0.f; M_RK[s * 16 + t] = s <= t ? Grk[rg] : 0.f;
        }
    }
    __builtin_amdgcn_fence(__ATOMIC_RELEASE, "wavefront"); __builtin_amdgcn_wave_barrier(); __builtin_amdgcn_fence(__ATOMIC_ACQUIRE, "wavefront");
    {
        const int rr = lane & 15;
        float Tr[16];
#pragma unroll
        for (int t = 0; t < 16; ++t) {
            float acc = (rr == t) ? 1.f : 0.f;
#pragma unroll
            for (int s = 0; s < t; ++s) acc += Tr[s] * M_AB[s * 16 + t];
            Tr[t] = acc;
        }
#pragma unroll
        for (int t = 0; t < 16; ++t) T_[rr * 16 + t] = Tr[t];
    }
    __builtin_amdgcn_fence(__ATOMIC_RELEASE, "wavefront"); __builtin_amdgcn_wave_barrier(); __builtin_amdgcn_fence(__ATOMIC_ACQUIRE, "wavefront");
    {
        const int s = lane & 15, tq = lane >> 4;
        float4 q = make_float4(0.f, 0.f, 0.f, 0.f);
#pragma unroll
        for (int u = 0; u < 16; ++u) { const float a = M_AK[s * 16 + u]; const float4 t4 = *(const float4*)(T_ + u * 16 + 4 * tq); q.x += a * t4.x; q.y += a * t4.y; q.z += a * t4.z; q.w += a * t4.w; }
        *(float4*)(Q_ + s * 16 + 4 * tq) = q;
        __builtin_amdgcn_fence(__ATOMIC_RELEASE, "wavefront"); __builtin_amdgcn_wave_barrier(); __builtin_amdgcn_fence(__ATOMIC_ACQUIRE, "wavefront");
        float4 w2 = *(const float4*)(M_RK + s * 16 + 4 * tq);
#pragma unroll
        for (int u = 0; u < 16; ++u) { const float a = Q_[s * 16 + u]; const float4 m4 = *(const float4*)(M_RB + u * 16 + 4 * tq); w2.x += a * m4.x; w2.y += a * m4.y; w2.z += a * m4.z; w2.w += a * m4.w; }
        *(float4*)(W2_ + s * 16 + 4 * tq) = w2;
    }
    __builtin_amdgcn_fence(__ATOMIC_RELEASE, "wavefront"); __builtin_amdgcn_wave_barrier(); __builtin_amdgcn_fence(__ATOMIC_ACQUIRE, "wavefront");
    cvt_f32x2 pt2[8], r22[8], ul2[8], yl2[8];
#pragma unroll
    for (int t = 0; t < 8; ++t) { pt2[t] = (cvt_f32x2){0.f, 0.f}; r22[t] = (cvt_f32x2){bf2f(S_RT[(2 * t) * 72 + lane]), bf2f(S_RT[(2 * t + 1) * 72 + lane])}; ul2[t] = pt2[t]; yl2[t] = pt2[t]; }
#pragma unroll
    for (int s = 0; s < 16; ++s) {
        const float as_ = bf2f(S_AB[s * 72 + lane]), vs_ = vv[s];
        const cvt_f32x2 as2 = {as_, as_}, vs2 = {vs_, vs_};
#pragma unroll
        for (int tq = 0; tq < 4; ++tq) {
            const float4 t4 = *(const float4*)(T_ + s * 16 + 4 * tq), q4 = *(const float4*)(Q_ + s * 16 + 4 * tq), w4 = *(const float4*)(W2_ + s * 16 + 4 * tq);
            pt2[2 * tq] += (cvt_f32x2){t4.x, t4.y} * as2; pt2[2 * tq + 1] += (cvt_f32x2){t4.z, t4.w} * as2;
            ul2[2 * tq] += (cvt_f32x2){q4.x, q4.y} * vs2; ul2[2 * tq + 1] += (cvt_f32x2){q4.z, q4.w} * vs2;
            yl2[2 * tq] += (cvt_f32x2){w4.x, w4.y} * vs2; yl2[2 * tq + 1] += (cvt_f32x2){w4.z, w4.w} * vs2;
        }
        __builtin_amdgcn_sched_barrier(0);
    }
    float pt[16], ul[16], yl[16];
#pragma unroll
    for (int t = 0; t < 8; ++t) { pt[2 * t] = pt2[t].x; pt[2 * t + 1] = pt2[t].y; ul[2 * t] = ul2[t].x; ul[2 * t + 1] = ul2[t].y; yl[2 * t] = yl2[t].x; yl[2 * t + 1] = yl2[t].y; }
#pragma unroll
    for (int s = 0; s < 16; ++s) {
        const cvt_f32x2 ps2 = {pt[s], pt[s]};
#pragma unroll
        for (int tq = 0; tq < 4; ++tq) {
            const float4 m4 = *(const float4*)(M_RB + s * 16 + 4 * tq);
            r22[2 * tq] += (cvt_f32x2){m4.x, m4.y} * ps2; r22[2 * tq + 1] += (cvt_f32x2){m4.z, m4.w} * ps2;
        }
        __builtin_amdgcn_sched_barrier(0);
    }
    float r2[16];
#pragma unroll
    for (int t = 0; t < 8; ++t) { r2[2 * t] = r22[t].x; r2[2 * t + 1] = r22[t].y; }
    unsigned char* rec = p.ws + WS_REC + (size_t)ct * REC_BYTES;
    float* ys = (float*)(p.ws + WS_YS);
    {
#pragma unroll
        for (int t = 0; t < 16; ++t) { S_AB[t * 72 + lane] = f2bf(pt[t]); S_RT[t * 72 + lane] = f2bf(r2[t]); }
        __builtin_amdgcn_fence(__ATOMIC_RELEASE, "wavefront"); __builtin_amdgcn_wave_barrier(); __builtin_amdgcn_fence(__ATOMIC_ACQUIRE, "wavefront");
#pragma unroll
        for (int i2 = 0; i2 < 2; ++i2) {
            const int q = lane + 64 * i2, f = q >> 5, hf = (q >> 4) & 1, t = q & 15;
            const uint2 a0 = *(const uint2*)(S_AB + t * 72 + 16 * f + 4 * hf), a1 = *(const uint2*)(S_AB + t * 72 + 16 * f + 8 + 4 * hf);
            const uint2 c0 = *(const uint2*)(S_RT + t * 72 + 16 * f + 4 * hf), c1 = *(const uint2*)(S_RT + t * 72 + 16 * f + 8 + 4 * hf);
            st_sc1_b128(rec + q * 16, a0.x, a0.y, a1.x, a1.y);
            st_sc1_b128(rec + 2048 + q * 16, c0.x, c0.y, c1.x, c1.y);
        }
        {
            float* YT = (float*)(wl + 9216);
#pragma unroll
            for (int t = 0; t < 16; ++t) YT[t * 64 + lane] = yl[t];
            __builtin_amdgcn_fence(__ATOMIC_RELEASE, "wavefront"); __builtin_amdgcn_wave_barrier(); __builtin_amdgcn_fence(__ATOMIC_ACQUIRE, "wavefront");
#pragma unroll
            for (int i4 = 0; i4 < 4; ++i4) {
                const int idx = lane + 64 * i4, t = idx >> 4, q4 = idx & 15;
                const float4 y4 = *(const float4*)(YT + t * 64 + 4 * q4);
                st_sc1_b128(ys + (unsigned)(row0 + t) * 1024u + (unsigned)(h * 64 + 4 * q4), __float_as_uint(y4.x), __float_as_uint(y4.y), __float_as_uint(y4.z), __float_as_uint(y4.w));
            }
        }
    }
    {
        float gb[16], gk[16];
#pragma unroll
        for (int t = 0; t < 16; ++t) { gb[t] = gC * bf2f(S_BB[t * 72 + lane]); gk[t] = gC * bf2f(S_KB[t * 72 + lane]); }
        st_sc1_b128(rec + 4096 + lane * 16, pack2(gb[0], gb[1]), pack2(gb[2], gb[3]), pack2(gb[8], gb[9]), pack2(gb[10], gb[11]));
        st_sc1_b128(rec + 4096 + (64 + lane) * 16, pack2(gb[4], gb[5]), pack2(gb[6], gb[7]), pack2(gb[12], gb[13]), pack2(gb[14], gb[15]));
        st_sc1_b128(rec + 6144 + lane * 16, pack2(gk[0], gk[1]), pack2(gk[2], gk[3]), pack2(gk[4], gk[5]), pack2(gk[6], gk[7]));
        st_sc1_b128(rec + 6144 + (64 + lane) * 16, pack2(gk[8], gk[9]), pack2(gk[10], gk[11]), pack2(gk[12], gk[13]), pack2(gk[14], gk[15]));
        st_sc1_b32(rec + 8192 + lane * 4, gC);
        unsigned char* ip = rec + 8448 + (lane >> 5) * 3072;
        const int il = lane & 31;
        st_sc1_b128(ip + il * 16, pack2(vv[0], vv[1]), pack2(vv[2], vv[3]), pack2(vv[4], vv[5]), pack2(vv[6], vv[7]));
        st_sc1_b128(ip + (32 + il) * 16, pack2(vv[8], vv[9]), pack2(vv[10], vv[11]), pack2(vv[12], vv[13]), pack2(vv[14], vv[15]));
#pragma unroll
        for (int tq = 0; tq < 4; ++tq) st_sc1_b128(ip + 1024 + (((tq >> 1) * 2 + (tq & 1)) * 32 + il) * 16, __float_as_uint(ul[4 * tq]), __float_as_uint(ul[4 * tq + 1]), __float_as_uint(ul[4 * tq + 2]), __float_as_uint(ul[4 * tq + 3]));
    }
    asm volatile("s_waitcnt vmcnt(0)" ::: "memory");
    if (lane == 0) __hip_atomic_store((unsigned*)(p.ws + WS_RFLAG + (size_t)ct * 64), (unsigned)(l + 1), __ATOMIC_RELAXED, __HIP_MEMORY_SCOPE_AGENT);
    __builtin_amdgcn_fence(__ATOMIC_RELEASE, "wavefront"); __builtin_amdgcn_wave_barrier();
}

__device__ void pa_sample_task(const Params& p, int l, int task) {
    const int lane = opq_tid() & 63;
    const int bd = task >> 8, h = (task >> 4) & 15, wq = task & 15;
    const int irow = 4 * wq + (lane >> 4), jq = lane & 15;
    const size_t row = (size_t)TP + bd;
    const bf16_t* RSB = (const bf16_t*)(p.ws + WS_RSB);
    const float* RSW = (const float*)(p.ws + WS_RSW);
    const bf16_t* VALL = (const bf16_t*)(p.ws + WS_VALL);
    float* ys = (float*)(p.ws + WS_YS);
    const size_t so = (((size_t)(l * NBS + bd) * 16 + h) * 64 + irow) * 64 + 4 * jq;
    float4 s = *(const float4*)(p.state_wkv + so);
    const size_t o = row * 1024 + h * 64 + 4 * jq;
    const size_t os = (size_t)bd * 1024 + h * 64 + 4 * jq;
    const uint2 ur = *(const uint2*)(RSB + os), uk = *(const uint2*)(RSB + SRI + os), ukk = *(const uint2*)(RSB + 2 * SRI + os), ub = *(const uint2*)(RSB + 3 * SRI + os);
    const float4 w4 = *(const float4*)(RSW + os);
    const float v = bf2f(VALL[row * 1024 + h * 64 + irow]);
    float pa = s.x * bflo(ukk.x) + s.y * bfhi(ukk.x) + s.z * bflo(ukk.y) + s.w * bfhi(ukk.y);
    pa = allreduce16(pa);
    const float sa = -pa;
    s.x = fmaf(sa, bflo(ub.x), fmaf(s.x, w4.x, v * bflo(uk.x)));
    s.y = fmaf(sa, bfhi(ub.x), fmaf(s.y, w4.y, v * bfhi(uk.x)));
    s.z = fmaf(sa, bflo(ub.y), fmaf(s.z, w4.z, v * bflo(uk.y)));
    s.w = fmaf(sa, bfhi(ub.y), fmaf(s.w, w4.w, v * bfhi(uk.y)));
    float py = s.x * bflo(ur.x) + s.y * bfhi(ur.x) + s.z * bflo(ur.y) + s.w * bfhi(ur.y);
    py = allreduce16(py);
    *(float4*)(p.out + O_WKVS + so) = s;
    if (jq == 0) ys[row * 1024 + h * 64 + irow] = py;
}

__device__ __forceinline__ uint4 ld_sc1_b128(const unsigned char* p) {
    const unsigned long long a = __hip_atomic_load((const unsigned long long*)p, __ATOMIC_RELAXED, __HIP_MEMORY_SCOPE_AGENT), c = __hip_atomic_load((const unsigned long long*)(p + 8), __ATOMIC_RELAXED, __HIP_MEMORY_SCOPE_AGENT);
    return make_uint4((unsigned)a, (unsigned)(a >> 32), (unsigned)c, (unsigned)(c >> 32));
}
constexpr int PB_NB = 8, PB_SLOT = 13568, PB_NCH = SEQ / 16, PB_NX = 4, PB_XOFF = PB_NB * PB_SLOT  , PB_FOFF = PB_XOFF + PB_NX * 4096;
__device__ void pb_head(const Params& p, unsigned char* lds, int l, int blk, bool dry) {
    const int tid = opq_tid(), wv = tid >> 6, lane = tid & 63;
    const int hh = blk >> 1, it = blk & 1, b = hh >> 4, h = hh & 15;
    volatile LAS unsigned* flags = (volatile LAS unsigned*)((LAS unsigned char*)lds + PB_FOFF);
    if (tid < 16) flags[tid] = 0u;
    __syncthreads();
    const unsigned char* rec0 = p.ws + WS_REC + (size_t)(hh * 256) * REC_BYTES;
    float* ys = (float*)(p.ws + WS_YS) + ((size_t)b * SEQ) * 1024 + h * 64 + 32 * it;
    const int q32 = lane & 31, hf = lane >> 5;
    if (wv >= 2) {
        unsigned nf = __hip_atomic_load((const unsigned*)(p.ws + WS_RFLAG + (size_t)(hh * 256 + (wv - 2)) * 64), __ATOMIC_RELAXED, __HIP_MEMORY_SCOPE_AGENT);
#pragma unroll 1
        for (int c = wv - 2; c < PB_NCH; c += 6) {
            while (c - (int)flags[8] >= PB_NB || c - (int)flags[9] >= PB_NB) __builtin_amdgcn_s_sleep(1);
            asm volatile("" ::: "memory");
            {
                const unsigned* rf = (const unsigned*)(p.ws + WS_RFLAG + (size_t)(hh * 256 + c) * 64);
                while (nf != (unsigned)(l + 1)) { __builtin_amdgcn_s_sleep(2); nf = __hip_atomic_load(rf, __ATOMIC_RELAXED, __HIP_MEMORY_SCOPE_AGENT); }
                asm volatile("" ::: "memory");
            }
            const unsigned char* rec = rec0 + (size_t)c * REC_BYTES;
            unsigned char* sl = lds + (c % PB_NB) * PB_SLOT;
            const unsigned char* rc = rec + lane * 16;
            const unsigned char* ri = rec + 8448 + it * 3072 + lane * 16;
#define LD_SC1(p_) ld_sc1_b128((const unsigned char*)(p_))
            const uint4 d0 = LD_SC1(rc), d1 = LD_SC1(rc + 1024), d2 = LD_SC1(rc + 2048), d3 = LD_SC1(rc + 3072);
            const uint4 d4 = LD_SC1(rc + 4096), d5 = LD_SC1(rc + 5120), d6 = LD_SC1(rc + 6144), d7 = LD_SC1(rc + 7168);
            const uint4 d8 = LD_SC1(rec + 8192 + (lane & 15) * 16);
            const uint4 d9 = LD_SC1(ri), d10 = LD_SC1(ri + 1024), d11 = LD_SC1(ri + 2048);
            const int t0 = lane >> 3, cc = lane & 7;
            const uint4 d12 = LD_SC1(ys + (size_t)(16 * c + t0) * 1024 + cc * 4), d13 = LD_SC1(ys + (size_t)(16 * c + 8 + t0) * 1024 + cc * 4);
#undef LD_SC1
            nf = (c + 6 < PB_NCH) ? __hip_atomic_load((const unsigned*)(p.ws + WS_RFLAG + (size_t)(hh * 256 + c + 6) * 64), __ATOMIC_RELAXED, __HIP_MEMORY_SCOPE_AGENT) : 0u;
            __builtin_amdgcn_sched_barrier(0);
            unsigned char* sd = sl + lane * 16;
            *(uint4*)(sd) = d0; *(uint4*)(sd + 1024) = d1; *(uint4*)(sd + 2048) = d2; *(uint4*)(sd + 3072) = d3;
            *(uint4*)(sd + 4096) = d4; *(uint4*)(sd + 5120) = d5; *(uint4*)(sd + 6144) = d6; *(uint4*)(sd + 7168) = d7;
            if (lane < 16) *(uint4*)(sl + 8192 + lane * 16) = d8;
            *(uint4*)(sd + 8448) = d9; *(uint4*)(sd + 9472) = d10; *(uint4*)(sd + 10496) = d11;
            {
                float* yd = (float*)(sl + 11520) + ((((t0 >> 2) & 1) * 32 + 4 * cc) * 4 + (t0 & 3));
                yd[0] = __uint_as_float(d12.x); yd[4] = __uint_as_float(d12.y); yd[8] = __uint_as_float(d12.z); yd[12] = __uint_as_float(d12.w);
                yd[256] = __uint_as_float(d13.x); yd[260] = __uint_as_float(d13.y); yd[264] = __uint_as_float(d13.z); yd[268] = __uint_as_float(d13.w);
            }
            asm volatile("" ::: "memory");
            if (lane == 0) flags[c % PB_NB] = (unsigned)(c + 1);
        }
    } else if (wv == 1) {
        bf16x8 ra0, ra1, ra2, ra3; float4 y0, y1;
#define PB_FETCHY(c_) do { const unsigned char* sl_ = lds + ((c_) % PB_NB) * PB_SLOT; \
            while (flags[(c_) % PB_NB] != (unsigned)((c_) + 1)) __builtin_amdgcn_s_sleep(0); \
            asm volatile("" ::: "memory"); \
            const unsigned char* pr_ = sl_ + 2048 + (hf * 16 + (q32 & 15)) * 16; \
            ra0 = *(const bf16x8*)(pr_); ra1 = *(const bf16x8*)(pr_ + 512); ra2 = *(const bf16x8*)(pr_ + 1024); ra3 = *(const bf16x8*)(pr_ + 1536); \
            y0 = *(const float4*)(sl_ + 11520 + (hf * 32 + q32) * 16); y1 = *(const float4*)(sl_ + 11520 + ((2 + hf) * 32 + q32) * 16); \
            asm volatile("" ::: "memory"); \
            if (lane == 0) flags[9] = (unsigned)((c_) + 1); } while (0)
        PB_FETCHY(0);
#pragma unroll 1
        for (int c = 0; c < PB_NCH; ++c) {
            const unsigned char* xr = lds + PB_XOFF + (c % PB_NX) * 4096 + lane * 16;
            f32x16 Ya, Yb;
            Ya[0] = y0.x; Ya[1] = y0.y; Ya[2] = y0.z; Ya[3] = y0.w; Ya[4] = y1.x; Ya[5] = y1.y; Ya[6] = y1.z; Ya[7] = y1.w;
#pragma unroll
            for (int r = 8; r < 16; ++r) Ya[r] = 0.f;
#pragma unroll
            for (int r = 0; r < 16; ++r) Yb[r] = 0.f;
            const bf16x8 rc0 = ra0, rc1 = ra1, rc2 = ra2, rc3 = ra3;
            while (flags[10 + (c % PB_NX)] != (unsigned)(c + 1)) __builtin_amdgcn_s_sleep(0);
            asm volatile("" ::: "memory");
            const bf16x8 xf0 = *(const bf16x8*)(xr), xf1 = *(const bf16x8*)(xr + 1024), xf2 = *(const bf16x8*)(xr + 2048), xf3 = *(const bf16x8*)(xr + 3072);
            asm volatile("" ::: "memory");
            if (lane == 0) flags[14] = (unsigned)(c + 1);
            Ya = __builtin_amdgcn_mfma_f32_32x32x16_bf16(rc0, xf0, Ya, 0, 0, 0);
            Yb = __builtin_amdgcn_mfma_f32_32x32x16_bf16(rc1, xf1, Yb, 0, 0, 0);
            Ya = __builtin_amdgcn_mfma_f32_32x32x16_bf16(rc2, xf2, Ya, 0, 0, 0);
            Yb = __builtin_amdgcn_mfma_f32_32x32x16_bf16(rc3, xf3, Yb, 0, 0, 0);
            if (c + 1 < PB_NCH) PB_FETCHY(c + 1);
            float* yc = ys + (size_t)c * (16 * 1024);
            if (!dry) {
#pragma unroll
                for (int r = 0; r < 8; ++r) yc[(8 * (r >> 2) + 4 * hf + (r & 3)) * 1024 + q32] = Ya[r] + Yb[r];
            }
        }
#undef PB_FETCHY
    } else {
        f32x16 X0, X1;
#pragma unroll
        for (int i = 0; i < 16; ++i) { X0[i] = 0.f; X1[i] = 0.f; }
        bf16x8 pa0, pa1, pa2, pa3, gb0, gb1, gk0, gk1, vf;
        float4 gm0, gm1, gm2, gm3, gm4, gm5, gm6, gm7, u0, u1;
#define PB_FETCH(c_) do { const unsigned char* sl_ = lds + ((c_) % PB_NB) * PB_SLOT; \
            { unsigned rv_ = rdy; while (rv_ != (unsigned)((c_) + 1)) { __builtin_amdgcn_s_sleep(0); rv_ = flags[(c_) % PB_NB]; } } \
            asm volatile("" ::: "memory"); \
            const unsigned char* pr_ = sl_ + (hf * 16 + (q32 & 15)) * 16; \
            pa0 = *(const bf16x8*)(pr_); pa1 = *(const bf16x8*)(pr_ + 512); pa2 = *(const bf16x8*)(pr_ + 1024); pa3 = *(const bf16x8*)(pr_ + 1536); \
            gb0 = *(const bf16x8*)(sl_ + 4096 + (hf * 64 + q32) * 16); gb1 = *(const bf16x8*)(sl_ + 4096 + (hf * 64 + 32 + q32) * 16); \
            gk0 = *(const bf16x8*)(sl_ + 6144 + (hf * 64 + q32) * 16); gk1 = *(const bf16x8*)(sl_ + 6144 + (hf * 64 + 32 + q32) * 16); \
            vf = *(const bf16x8*)(sl_ + 8448 + (hf * 32 + q32) * 16); \
            const unsigned char* gp_ = sl_ + 8192 + 16 * hf; \
            gm0 = *(const float4*)(gp_); gm1 = *(const float4*)(gp_ + 32); gm2 = *(const float4*)(gp_ + 64); gm3 = *(const float4*)(gp_ + 96); \
            gm4 = *(const float4*)(gp_ + 128); gm5 = *(const float4*)(gp_ + 160); gm6 = *(const float4*)(gp_ + 192); gm7 = *(const float4*)(gp_ + 224); \
            u0 = *(const float4*)(sl_ + 9472 + (hf * 32 + q32) * 16); u1 = *(const float4*)(sl_ + 9472 + ((2 + hf) * 32 + q32) * 16); \
            asm volatile("" ::: "memory"); \
            if (lane == 0) flags[8] = (unsigned)((c_) + 1); } while (0)
        unsigned rdy = flags[0];
        PB_FETCH(0);
        int xfree = 0;
#pragma unroll 1
        for (int c = 0; c < PB_NCH; ++c) {
            unsigned char* xw = lds + PB_XOFF + (c % PB_NX) * 4096 + lane * 16;
            rdy = flags[(c + 1) % PB_NB];
            const bf16x8 xb0 = __builtin_bit_cast(bf16x8, make_uint4(pack2(X0[0], X0[1]), pack2(X0[2], X0[3]), pack2(X0[4], X0[5]), pack2(X0[6], X0[7])));
            const bf16x8 xb1 = __builtin_bit_cast(bf16x8, make_uint4(pack2(X0[8], X0[9]), pack2(X0[10], X0[11]), pack2(X0[12], X0[13]), pack2(X0[14], X0[15])));
            const bf16x8 xb2 = __builtin_bit_cast(bf16x8, make_uint4(pack2(X1[0], X1[1]), pack2(X1[2], X1[3]), pack2(X1[4], X1[5]), pack2(X1[6], X1[7])));
            const bf16x8 xb3 = __builtin_bit_cast(bf16x8, make_uint4(pack2(X1[8], X1[9]), pack2(X1[10], X1[11]), pack2(X1[12], X1[13]), pack2(X1[14], X1[15])));
            f32x16 Ua, Ub;
            Ua[0] = u0.x; Ua[1] = u0.y; Ua[2] = u0.z; Ua[3] = u0.w; Ua[4] = u1.x; Ua[5] = u1.y; Ua[6] = u1.z; Ua[7] = u1.w;
#pragma unroll
            for (int r = 8; r < 16; ++r) Ua[r] = 0.f;
#pragma unroll
            for (int r = 0; r < 16; ++r) Ub[r] = 0.f;
            Ua = __builtin_amdgcn_mfma_f32_32x32x16_bf16(pa0, xb0, Ua, 0, 0, 0);
            Ub = __builtin_amdgcn_mfma_f32_32x32x16_bf16(pa1, xb1, Ub, 0, 0, 0);
            Ua = __builtin_amdgcn_mfma_f32_32x32x16_bf16(pa2, xb2, Ua, 0, 0, 0);
            Ub = __builtin_amdgcn_mfma_f32_32x32x16_bf16(pa3, xb3, Ub, 0, 0, 0);
            f32x16 Xn0, Xn1;
            Xn0[0] = X0[0] * gm0.x; Xn0[1] = X0[1] * gm0.y; Xn0[2] = X0[2] * gm0.z; Xn0[3] = X0[3] * gm0.w; Xn0[4] = X0[4] * gm1.x; Xn0[5] = X0[5] * gm1.y; Xn0[6] = X0[6] * gm1.z; Xn0[7] = X0[7] * gm1.w;
            Xn0[8] = X0[8] * gm2.x; Xn0[9] = X0[9] * gm2.y; Xn0[10] = X0[10] * gm2.z; Xn0[11] = X0[11] * gm2.w; Xn0[12] = X0[12] * gm3.x; Xn0[13] = X0[13] * gm3.y; Xn0[14] = X0[14] * gm3.z; Xn0[15] = X0[15] * gm3.w;
            Xn1[0] = X1[0] * gm4.x; Xn1[1] = X1[1] * gm4.y; Xn1[2] = X1[2] * gm4.z; Xn1[3] = X1[3] * gm4.w; Xn1[4] = X1[4] * gm5.x; Xn1[5] = X1[5] * gm5.y; Xn1[6] = X1[6] * gm5.z; Xn1[7] = X1[7] * gm5.w;
            Xn1[8] = X1[8] * gm6.x; Xn1[9] = X1[9] * gm6.y; Xn1[10] = X1[10] * gm6.z; Xn1[11] = X1[11] * gm6.w; Xn1[12] = X1[12] * gm7.x; Xn1[13] = X1[13] * gm7.y; Xn1[14] = X1[14] * gm7.z; Xn1[15] = X1[15] * gm7.w;
            Xn0 = __builtin_amdgcn_mfma_f32_32x32x16_bf16(gk0, vf, Xn0, 0, 0, 0);
            Xn1 = __builtin_amdgcn_mfma_f32_32x32x16_bf16(gk1, vf, Xn1, 0, 0, 0);
            const bf16x8 gbc0 = gb0, gbc1 = gb1;
            while (c - xfree >= PB_NX) { xfree = (int)flags[14]; }
            asm volatile("" ::: "memory");
            *(bf16x8*)(xw) = xb0; *(bf16x8*)(xw + 1024) = xb1; *(bf16x8*)(xw + 2048) = xb2; *(bf16x8*)(xw + 3072) = xb3;
            asm volatile("" ::: "memory");
            if (lane == 0) flags[10 + (c % PB_NX)] = (unsigned)(c + 1);
            if (c + 1 < PB_NCH) PB_FETCH(c + 1);
            const bf16x8 ub = __builtin_bit_cast(bf16x8, make_uint4(pack2(Ua[0] + Ub[0], Ua[1] + Ub[1]), pack2(Ua[2] + Ub[2], Ua[3] + Ub[3]), pack2(Ua[4] + Ub[4], Ua[5] + Ub[5]), pack2(Ua[6] + Ub[6], Ua[7] + Ub[7])));
            X0 = __builtin_amdgcn_mfma_f32_32x32x16_bf16(gbc0, ub, Xn0, 0, 0, 0);
            X1 = __builtin_amdgcn_mfma_f32_32x32x16_bf16(gbc1, ub, Xn1, 0, 0, 0);
        }
#undef PB_FETCH
        float* so = p.out + O_WKVP + ((size_t)(l * NBP + b) * 16 + h) * 4096 + (size_t)(32 * it + q32) * 64;
#pragma unroll
        for (int g = 0; g < 4; ++g) {
            *(float4*)(so + 8 * g + 4 * hf) = make_float4(X0[4 * g], X0[4 * g + 1], X0[4 * g + 2], X0[4 * g + 3]);
            *(float4*)(so + 32 + 8 * g + 4 * hf) = make_float4(X1[4 * g], X1[4 * g + 1], X1[4 * g + 2], X1[4 * g + 3]);
        }
    }
    __syncthreads();
}

__device__ void p3_post(const Params& p, int l, int bid, int G) {
    const int tid = opq_tid(), wv = tid >> 6, lane = tid & 63;
    const float* ys = (const float*)(p.ws + WS_YS);
    const bf16_t* V = (const bf16_t*)(p.ws + WS_VALL);
    const float* coef = (const float*)(p.ws + WS_COEF);
    const bf16_t* gt = (const bf16_t*)(p.ws + WS_GT);
    bf16_t* cc = (bf16_t*)(p.ws + WS_HB);
    for (int r = bid * 8 + wv; r < MT; r += G * 8) {
#pragma unroll
        for (int hg = 0; hg < 4; ++hg) {
            const int head = 4 * hg + (lane >> 4), c = head * 64 + 4 * (lane & 15);
            const float4 y = *(const float4*)(ys + (size_t)r * 1024 + c);
            const float mu = allreduce16(y.x + y.y + y.z + y.w) * (1.f / 64.f);
            const float d0 = y.x - mu, d1 = y.y - mu, d2 = y.z - mu, d3 = y.w - mu;
            const float var = allreduce16(d0 * d0 + d1 * d1 + d2 * d2 + d3 * d3) * (1.f / 64.f);
            const float rs = rsqrtf(var + 64e-5f);
            const float4 lw = *(const float4*)(p.ln_w + l * 1024 + c), lb = *(const float4*)(p.ln_b + l * 1024 + c);
            const uint2 vu = *(const uint2*)(V + (size_t)r * 1024 + c);
            const float4 v4 = make_float4(bflo(vu.x), bfhi(vu.x), bflo(vu.y), bfhi(vu.y));
            const float cf = coef[(size_t)r * 16 + head];
            const uint2 gg = *(const uint2*)(gt + (size_t)r * DM + 1024 + c);
            const float o0 = (d0 * rs * lw.x + lb.x + cf * v4.x) * bflo(gg.x), o1 = (d1 * rs * lw.y + lb.y + cf * v4.y) * bfhi(gg.x);
            const float o2 = (d2 * rs * lw.z + lb.z + cf * v4.z) * bflo(gg.y), o3 = (d3 * rs * lw.w + lb.w + cf * v4.w) * bfhi(gg.y);
            *(uint2*)(cc + (size_t)r * DM + 1024 + c) = make_uint2(pack2(o0, o1), pack2(o2, o3));
        }
    }
}

__device__ void p_final(const Params& p, int bid, int G) {
    const int tid = opq_tid(), wv = tid >> 6, lane = tid & 63;
    const float4* g4 = (const float4*)p.final_g;
    for (int r = bid * 8 + wv; r < MT; r += G * 8) {
        float4* xr = (float4*)(p.out + (size_t)r * DM);
        float4 v[8]; float ss = 0.f;
#pragma unroll
        for (int i = 0; i < 8; ++i) { v[i] = xr[lane + 64 * i]; ss += v[i].x * v[i].x + v[i].y * v[i].y + v[i].z * v[i].z + v[i].w * v[i].w; }
        ss = wave_sum(ss);
        const float rinv = rsqrtf(ss * (1.f / 2048.f) + 1e-5f);
#pragma unroll
        for (int i = 0; i < 8; ++i) { const float4 g = g4[lane + 64 * i]; xr[lane + 64 * i] = make_float4(v[i].x * rinv * g.x, v[i].y * rinv * g.y, v[i].z * rinv * g.z, v[i].w * rinv * g.w); }
    }
}

#ifndef REPL
#define REPL -1
#endif
#ifndef REPK
#define REPK -100
#endif
__global__ void __launch_bounds__(512, 2) fwd_kernel(Params p_unused) {
    extern __shared__ __attribute__((aligned(16))) unsigned char shm[];
    cg::grid_group grid = cg::this_grid();
    const int bid0 = blockIdx.x, G0 = gridDim.x;
    float* shf = (float*)shm;
    volatile LAS unsigned* xst = (volatile LAS unsigned*)((LAS unsigned char*)shm + 131072);
    if (threadIdx.x == 0) { xst[0] = 0u; xst[1] = 0u; }
    __syncthreads();
    const XcdBarrier xb = xcd_barrier_post((unsigned*)(kparams().ws + WS_BAR), xst);
    if (G0 == 0x7fffffff) grid.sync();

#pragma unroll 1
    for (int ph = 0; ph < 16; ++ph) {
        const int bid = opq_s(bid0), G = opq_s(G0);
        const int l = ph >= 8 ? 1 : 0, k = ph == 0 ? -1 : (ph == 15 ? 7 : (ph - 1) - 7 * l);
#pragma unroll 1
        for (int rep = 0; rep < ((k == kparams().repk && (kparams().repl < 0 || kparams().repl == l)) ? 2 : 1); ++rep) {
        if (k == -1) {
            for (int it = bid; it < 384; it += G) p0_mod_item(kparams(), shf, it / 192, it % 192);
            for (int it = bid; it < 17; it += G) p0_rope_item(kparams(), it);
            for (int it = bid; it < 64; it += G) p0_wfrag_item(kparams(), it);
            p0_conv_all(kparams(), shf, bid, G, 2752, 0);
        } else if (k == 0) {
            p1_norm(kparams(), l, bid, G);
        } else if (k == 1) {
            pg8::StaticOrder S; S.init(MP, INWP, G, bid);
            pg8::Gemm g{(const bf16_t*)(kparams().ws + WS_HB), (const bf16_t*)(kparams().ws + WS_WTIN), MP, INWP, DM};
            Epi1 E{l};
            pg8::gemm_phase<Epi1, pg8::StaticOrder, false>((PG8_LAS unsigned char*)shm, g, S, E, nullptr);
        } else if (k == 2) {
            for (int it = bid; it < 256 + 256 + 1; it += G) {
                if (it < 256) p3_attn_unit(kparams(), shm, l, it);
                else if (it < 512) p3_twad_item(kparams(), l, it - 256);
                else p3_prep_tile(kparams(), shm, l, 256);
            }
        } else if (k == 3) {
            if (bid < 64) pb_head(kparams(), shm, l, bid, false);
            else {
                const int wvq = opq_tid() >> 6, gw = (bid - 64) * 8 + wvq, nw = (G - 64) * 8;
                for (int i2 = gw; i2 < 32 * 256; i2 += nw) pa_chunk(kparams(), shm + wvq * PA_WLDS, l, (i2 & 31) * 256 + (i2 >> 5));
                for (int task = gw; task < NBS * 256; task += nw) pa_sample_task(kparams(), l, task);
                __syncthreads();
                if (bid < 128) p3_sattn_item(kparams(), shf, l, bid - 64);
                __syncthreads();
                if (l == 0) p0_conv_all(kparams(), shf, bid - 64, G - 64, 1728, 1);
            }
        } else if (k == 4) {
        } else if (k == 5) {
            p3_post(kparams(), l, bid, G);
        } else if (k == 6) {
            pg8::StaticOrder S; S.init(TP, DM, G, bid);
            pg8::Gemm g{(const bf16_t*)(kparams().ws + WS_HB), (const bf16_t*)(kparams().ws + WS_WTOUT) + (size_t)l * DM * DM, TP, DM, DM};
            Epi2 E{l};
            pg8::gemm_phase<Epi2, pg8::StaticOrder, false>((PG8_LAS unsigned char*)shm, g, S, E, nullptr);
            for (int nb = bid; nb < 64; nb += G) g2_sample_item(kparams(), shf, l, nb);
        } else {
            p_final(kparams(), bid, G);
        }
        if (ph < 15) xcd_barrier(xb);
        }
    }
}

extern "C" void kernel_launch(void* const* d_in, const int* in_sizes, int n_in, void* d_out, int out_size, void* d_ws, size_t ws_size, hipStream_t stream) {
    static int grid_blocks = 0;
    if (grid_blocks == 0) {
        if (n_in != 25 || (size_t)out_size != O_END || ws_size < WS_END) {
            fprintf(stderr, "kernel_launch: unexpected shapes: n_in %d out_size %d ws_size %zu (need %zu)\n", n_in, out_size, ws_size, (size_t)WS_END);
            grid_blocks = -1; return;
        }
        if (hipFuncSetAttribute((const void*)fwd_kernel, hipFuncAttributeMaxDynamicSharedMemorySize, LDS_BYTES) != hipSuccess) { fprintf(stderr, "kernel_launch: hipFuncSetAttribute failed\n"); grid_blocks = -1; return; }
        int dev = 0, cus = 0, per_cu = 0;
        hipGetDevice(&dev);
        hipDeviceGetAttribute(&cus, hipDeviceAttributeMultiprocessorCount, dev);
        hipOccupancyMaxActiveBlocksPerMultiprocessor(&per_cu, (const void*)fwd_kernel, 512, LDS_BYTES);
        if (per_cu < 1) { fprintf(stderr, "kernel_launch: occupancy query gives %d blocks per CU\n", per_cu); per_cu = 1; }
        (void)hipGetLastError();
        grid_blocks = cus;
        if (grid_blocks < 192) { fprintf(stderr, "kernel_launch: only %d CUs\n", grid_blocks); grid_blocks = -1; return; }
    }
    if (grid_blocks < 0) return;
    if (hipMemsetAsync((unsigned char*)d_ws + WS_BAR, 0, 16384 + RFLAG_BYTES, stream) != hipSuccess) { fprintf(stderr, "kernel_launch: memset of the barrier words failed\n"); return; }
    Params p{};
    const float** pp = (const float**)&p;
    for (int i = 0; i < 25; ++i) pp[i] = (const float*)d_in[i];
    p.out = (float*)d_out; p.ws = (unsigned char*)d_ws; p.repk = REPK; p.repl = REPL;
    void* args[] = {&p};
    hipError_t e = hipLaunchCooperativeKernel((const void*)fwd_kernel, dim3(grid_blocks), dim3(512), args, LDS_BYTES, stream);
    if (e != hipSuccess) fprintf(stderr, "cooperative launch failed: %s (grid %d)\n", hipGetErrorString(e), grid_blocks);
}
```

```cpp
#include <hip/hip_runtime.h>
#include <hip/hip_cooperative_groups.h>
#include <cstdio>
namespace cg = cooperative_groups;
__device__ __forceinline__ int opq_tid() { int t = threadIdx.x; asm volatile("" : "+v"(t)); return t; }
__device__ __forceinline__ int opq_s(int x) { asm volatile("" : "+s"(x)); return x; }
typedef float cvt_f32x2 __attribute__((ext_vector_type(2)));
typedef __bf16 cvt_bf16x2 __attribute__((ext_vector_type(2)));
__device__ __forceinline__ unsigned hw_cvt_pk_bf16(float lo, float hi) { const cvt_f32x2 v = {lo, hi}; return __builtin_bit_cast(unsigned, __builtin_convertvector(v, cvt_bf16x2)); }
typedef unsigned sc1_v4u __attribute__((ext_vector_type(4)));
__device__ __forceinline__ void st_sc1_b128(void* p, unsigned a, unsigned b, unsigned c, unsigned d) { const sc1_v4u v = {a, b, c, d}; asm volatile("global_store_dwordx4 %0, %1, off sc0 sc1\n\ts_nop 2" :: "v"(p), "v"(v) : "memory"); }
__device__ __forceinline__ void st_sc1_b32(void* p, float v) { asm volatile("global_store_dword %0, %1, off sc0 sc1\n\ts_nop 2" :: "v"(p), "v"(v) : "memory"); }
namespace pg8 {
#define PG8_LAS __attribute__((address_space(3)))
typedef unsigned short bf16_t;
typedef short bf16x8 __attribute__((ext_vector_type(8)));
typedef float f32x4 __attribute__((ext_vector_type(4)));
typedef unsigned u32x4 __attribute__((ext_vector_type(4)));
constexpr int BM = 256, BK = 64, HALF = 128, HTB = HALF * BK * 2  , STAGE_BYTES = 8 * HTB, NXCD = 8, WGM = 8;

__host__ __device__ __forceinline__ int lds_byte(int r, int c) { const int st = (r >> 4) * 2 + (c >> 5), rr = r & 15, cc = c & 31, ob = rr * 64 + cc * 2; return st * 1024 + (ob ^ (((ob >> 9) & 1) << 5)); }
__host__ __device__ __forceinline__ void stage_rc(int b, int& R, int& C) { const int st = b / 1024, sb = b % 1024, swz = sb ^ (((sb >> 9) & 1) << 5); R = (st >> 1) * 16 + swz / 64; C = (st & 1) * 32 + (swz % 64) / 2; }
__host__ __device__ __forceinline__ int perm32(int rho) { const int n = rho >> 4, i = rho & 15; return 8 * (i >> 2) + 4 * n + (i & 3); }

struct Unit { int pm, pn; };
struct Gemm { const bf16_t* A; const bf16_t* Bt; int M, N, K; };

struct StaticOrder {
    int nM, nN, nwg, G, c;
    __host__ __device__ void init(int M, int N, int G_, int c_) { nM = M / BM; nN = N / BM; nwg = nM * nN; G = G_; c = c_; }
    __host__ __device__ bool next(int i, Unit& u) const {
        const long L = (long)i * G + c; if (L >= nwg) return false;
        int wgid = (int)L; { const int q = nwg / NXCD, r = nwg % NXCD, xcd = wgid % NXCD, off = wgid / NXCD; wgid = (xcd < r ? xcd * (q + 1) : r * (q + 1) + (xcd - r) * q) + off; }
        const int nig = WGM * nN, gid = wgid / nig, fm = gid * WGM, gsz = (nM - fm) < WGM ? (nM - fm) : WGM;
        u.pm = fm + ((wgid % nig) % gsz); u.pn = (wgid % nig) / gsz; return true;
    }
    __device__ __forceinline__ void a_ready(const Unit&) const {}
    __device__ __forceinline__ void done(const Unit&) const {}
};
template <class Epi, class Sched, bool STAMP = false>
__device__ __forceinline__ void gemm_phase(PG8_LAS unsigned char* lds, const Gemm g, const Sched& S, const Epi& E, unsigned long long* stamps) {
    const int tid = opq_tid(), wid = __builtin_amdgcn_readfirstlane(tid >> 6), lane = tid & 63, wr = wid >> 2, wc = wid & 3, fr = lane & 15, fq = lane >> 4;
    const int K = g.K, nt = K / BK;
    int ts_lo = 0, ts_hi = 0, nts = 0; const unsigned long long rt_entry = STAMP ? (unsigned long long)wall_clock64() : 0ull;
#define PG8_STAMP() do { if (STAMP && wid == 0 && nts < 64) { const unsigned long long _c = (unsigned long long)clock64(); \
        ts_lo = (lane == nts) ? (int)(unsigned)_c : ts_lo; ts_hi = (lane == nts) ? (int)(unsigned)(_c >> 32) : ts_hi; ++nts; } } while (0)
    PG8_STAMP();
    unsigned voffA[2], voffB[2];
#pragma unroll
    for (int i = 0; i < 2; ++i) { int R, C; stage_rc(tid * 16 + i * 8192, R, C); const int Rb = Epi::PERM ? ((R & ~31) + perm32(R & 31)) : R;
        voffA[i] = (unsigned)(R * K + C) * 2u; voffB[i] = (unsigned)(Rb * K + C) * 2u; }
    const size_t kstep = (size_t)(BK * 2);
    const size_t hstep = (size_t)HALF * K * 2;
    const size_t tstep = 2 * hstep;
    const unsigned ldsw = (unsigned)wid * 1024u;
    const int aoff = lds_byte(wr * 64 + fr, fq * 8), boff = lds_byte(wc * 32 + fr, fq * 8);
#define PG8_SA(b, h) (((b) * 2 + (h)) * HTB)
#define PG8_SB(b, h) ((4 + (b) * 2 + (h)) * HTB)
#define PG8_STAGE(bufoff, gbase, voff) do { _Pragma("unroll") for (int _i = 0; _i < 2; ++_i) \
        __builtin_amdgcn_global_load_lds((const unsigned*)((const char*)(gbase) + (voff)[_i]), (PG8_LAS unsigned*)(lds + (bufoff) + ldsw + _i * 8192), 16, 0, 0); } while (0)
#define PG8_LDA(dst, b, h) do { _Pragma("unroll") for (int m = 0; m < 4; ++m) _Pragma("unroll") for (int k = 0; k < 2; ++k) dst[m][k] = *(const PG8_LAS bf16x8*)(lds + PG8_SA(b, h) + aoff + m * 2048 + k * 1024); } while (0)
#define PG8_LDB(dst, b, h) do { _Pragma("unroll") for (int n = 0; n < 2; ++n) _Pragma("unroll") for (int k = 0; k < 2; ++k) dst[n][k] = *(const PG8_LAS bf16x8*)(lds + PG8_SB(b, h) + boff + n * 2048 + k * 1024); } while (0)
#define PG8_MMA(ai, bj, At, Bt) do { __builtin_amdgcn_s_setprio(1); _Pragma("unroll") for (int m = 0; m < 4; ++m) _Pragma("unroll") for (int n = 0; n < 2; ++n) _Pragma("unroll") for (int k = 0; k < 2; ++k) \
        acc[ai][bj][m][n] = __builtin_amdgcn_mfma_f32_16x16x32_bf16(Bt[n][k], At[m][k], acc[ai][bj][m][n], 0, 0, 0); __builtin_amdgcn_s_setprio(0); } while (0)
#define PG8_WAIT_V(n) asm volatile("s_waitcnt vmcnt(" #n ")" ::: "memory")
#define PG8_WAIT_L(n) asm volatile("s_waitcnt lgkmcnt(" #n ")" ::: "memory")
#define PG8_BAR __builtin_amdgcn_s_barrier()
#define PG8_SCHED __builtin_amdgcn_sched_barrier(0)
    Unit cur, nxt; int ui = 0;
    if (!S.next(0, cur)) return;
    f32x4 acc[2][2][4][2];
#pragma unroll
    for (int a = 0; a < 2; ++a)
#pragma unroll
        for (int b = 0; b < 2; ++b)
#pragma unroll
            for (int m = 0; m < 4; ++m)
#pragma unroll
                for (int n = 0; n < 2; ++n) acc[a][b][m][n] = (f32x4){0.f, 0.f, 0.f, 0.f};
    bf16x8 At[4][2], B0[2][2], B1[2][2];
    const char* cA = (const char*)g.A + (size_t)cur.pm * tstep; const char* cB = (const char*)g.Bt + (size_t)cur.pn * tstep;
    S.a_ready(cur);
    PG8_STAGE(PG8_SB(0, 0), cB, voffB); PG8_STAGE(PG8_SA(0, 0), cA, voffA); PG8_STAGE(PG8_SB(0, 1), cB + hstep, voffB); PG8_STAGE(PG8_SA(0, 1), cA + hstep, voffA);
    if (wr == 1) PG8_BAR;
    PG8_WAIT_V(4); PG8_BAR;
    PG8_STAGE(PG8_SB(1, 0), cB + kstep, voffB); PG8_STAGE(PG8_SA(1, 0), cA + kstep, voffA); PG8_STAGE(PG8_SB(1, 1), cB + hstep + kstep, voffB);
    PG8_WAIT_V(6); PG8_BAR;
    PG8_STAMP();
    for (;;) {
        const bool has_next = S.next(ui + 1, nxt);
        const char* nA = has_next ? (const char*)g.A + (size_t)nxt.pm * tstep : cA; const char* nB = has_next ? (const char*)g.Bt + (size_t)nxt.pn * tstep : cB;
        for (int t = 0; t < nt; t += 2) {
            const bool last = (t == nt - 2);
            const char* a1 = cA + (size_t)(t + 1) * kstep;
            const char* a2 = last ? nA : cA + (size_t)(t + 2) * kstep; const char* b2 = last ? nB : cB + (size_t)(t + 2) * kstep;
            const char* a3 = a2 + kstep; const char* b3 = b2 + kstep;
            if (last && has_next) S.a_ready(nxt);
            PG8_LDB(B0, 0, 0); PG8_SCHED; PG8_LDA(At, 0, 0); PG8_STAGE(PG8_SA(1, 1), a1 + hstep, voffA);
            PG8_WAIT_L(8); PG8_BAR; PG8_WAIT_L(0); PG8_MMA(0, 0, At, B0); PG8_BAR; PG8_SCHED;
            PG8_LDB(B1, 0, 1); PG8_STAGE(PG8_SB(0, 0), b2, voffB);
            PG8_BAR; PG8_WAIT_L(0); PG8_MMA(0, 1, At, B1); PG8_BAR;
            PG8_LDA(At, 0, 1); PG8_STAGE(PG8_SA(0, 0), a2, voffA);
            PG8_BAR; PG8_WAIT_L(0); PG8_MMA(1, 0, At, B0); PG8_BAR; PG8_SCHED;
            PG8_STAGE(PG8_SB(0, 1), b2 + hstep, voffB);
            PG8_WAIT_V(6); PG8_BAR; PG8_MMA(1, 1, At, B1); PG8_BAR;
            PG8_LDB(B0, 1, 0); PG8_SCHED; PG8_LDA(At, 1, 0); PG8_STAGE(PG8_SA(0, 1), a2 + hstep, voffA);
            PG8_WAIT_L(8); PG8_BAR; PG8_WAIT_L(0); PG8_MMA(0, 0, At, B0); PG8_BAR; PG8_SCHED;
            PG8_LDB(B1, 1, 1); PG8_STAGE(PG8_SB(1, 0), b3, voffB);
            PG8_BAR; PG8_WAIT_L(0); PG8_MMA(0, 1, At, B1); PG8_BAR;
            PG8_LDA(At, 1, 1); PG8_STAGE(PG8_SA(1, 0), a3, voffA);
            PG8_BAR; PG8_WAIT_L(0); PG8_MMA(1, 0, At, B0); PG8_BAR; PG8_SCHED;
            PG8_STAGE(PG8_SB(1, 1), b3 + hstep, voffB);
            PG8_WAIT_V(6); PG8_BAR; PG8_MMA(1, 1, At, B1); PG8_BAR;
        }
        PG8_STAMP();
        if constexpr (!Epi::AFTER_DRAIN) { E(acc, cur, wr, wc, fr, fq); S.done(cur); }
        PG8_STAMP();
        if (!has_next) break;
#pragma unroll
        for (int a = 0; a < 2; ++a)
#pragma unroll
            for (int b = 0; b < 2; ++b)
#pragma unroll
                for (int m = 0; m < 4; ++m)
#pragma unroll
                    for (int n = 0; n < 2; ++n) acc[a][b][m][n] = (f32x4){0.f, 0.f, 0.f, 0.f};
        cur = nxt; cA = nA; cB = nB; ++ui;
    }
    PG8_WAIT_V(0);
    if (wr == 0) PG8_BAR;
    PG8_BAR;
    if constexpr (Epi::AFTER_DRAIN) { E.fused(acc, cur, wr, wc, fr, fq, lds, wid, lane); S.done(cur); }
    PG8_STAMP();
    if (STAMP && wid == 0) { stamps[lane] = lane < nts ? (((unsigned long long)(unsigned)ts_hi << 32) | (unsigned)ts_lo) : 0ull;
        if (lane == 62) stamps[62] = rt_entry; if (lane == 63) stamps[63] = (unsigned long long)wall_clock64(); }
#undef PG8_STAMP
#undef PG8_SA
#undef PG8_SB
#undef PG8_STAGE
#undef PG8_LDA
#undef PG8_LDB
#undef PG8_MMA
#undef PG8_WAIT_V
#undef PG8_WAIT_L
#undef PG8_BAR
#undef PG8_SCHED
}
}

#define XB_TMO      128
#define XB_XCNT(j)  (256  + 64 * (j))
#define XB_XSUB(j)  (1280 + 64 * (j))
#define XB_XGEN(j)  (2304 + 64 * (j))
#define XB_TOP      3328
#define XB_TOPGEN   3392
#define XCD_BAR_WORDS 3456
#define XB_SPIN_CAP (1u << 18)
#define LAS __attribute__((address_space(3)))

__device__ __forceinline__ unsigned xb_ld(unsigned* p)              { return __hip_atomic_load(p, __ATOMIC_RELAXED, __HIP_MEMORY_SCOPE_AGENT); }
__device__ __forceinline__ unsigned xb_add(unsigned* p, unsigned v) { return __hip_atomic_fetch_add(p, v, __ATOMIC_RELAXED, __HIP_MEMORY_SCOPE_AGENT); }
__device__ __forceinline__ unsigned xb_xcc_id() { return (unsigned)__builtin_amdgcn_s_getreg((3 << 11) | 20) & 0xFu; }
#define XB_SPIN(cond, bar) do { unsigned _sp = 0; while (cond) { __builtin_amdgcn_s_sleep(1); \
    if ((++_sp & 255u) == 0u) { if (xb_ld(&(bar)[XB_TMO])) break; if (_sp > XB_SPIN_CAP) { atomicAdd(&(bar)[XB_TMO], 1u); break; } } } } while (0)

struct XcdBarrier {
    unsigned* bar; unsigned x;
    volatile LAS unsigned* st;
};

__device__ __forceinline__ XcdBarrier xcd_barrier_post(unsigned* bar, volatile LAS unsigned* st) {
    XcdBarrier b; b.bar = bar; b.x = xb_xcc_id(); b.st = st;
    if (threadIdx.x == 0) (void)xb_add(&bar[XB_XCNT(b.x)], 1u);
    return b;
}
__device__ __forceinline__ void xcd_barrier_complete(unsigned* bar, unsigned x, unsigned& nloc, unsigned& nx) {
    const unsigned G = gridDim.x * gridDim.y * gridDim.z;
    unsigned sum, cnt, mine, sp = 0u;
    for (;;) {
        sum = 0u; cnt = 0u; mine = 0u;
#pragma unroll
        for (unsigned j = 0; j < 16; ++j) { const unsigned c = xb_ld(&bar[XB_XCNT(j)]); sum += c; cnt += (c > 0u) ? 1u : 0u; mine = (j == x) ? c : mine; }
        if (sum == G) break;
        __builtin_amdgcn_s_sleep(1);
        if ((++sp & 255u) == 0u) { if (xb_ld(&bar[XB_TMO])) break; if (sp > XB_SPIN_CAP) { atomicAdd(&bar[XB_TMO], 1u); break; } }
    }
    nloc = mine > 0u ? mine : 1u; nx = cnt > 0u ? cnt : 1u;
}

__device__ __forceinline__ void xcd_barrier(const XcdBarrier& b) {
    asm volatile("s_waitcnt vmcnt(0)" ::: "memory");
    __syncthreads();
    if (threadIdx.x == 0) {
        unsigned* bar = b.bar;
        __builtin_amdgcn_s_waitcnt(0);
        unsigned nloc = b.st[0], nx = b.st[1];
        if (nloc == 0u) { xcd_barrier_complete(bar, b.x, nloc, nx); b.st[0] = nloc; b.st[1] = nx; }
        const unsigned old = xb_add(&bar[XB_XSUB(b.x)], 1u);
        const unsigned gen = old / nloc;
        if (old + 1u == (gen + 1u) * nloc) {
            __builtin_amdgcn_fence(__ATOMIC_RELEASE, "agent");
            asm volatile("s_waitcnt vmcnt(0)" ::: "memory");
            const unsigned og = xb_add(&bar[XB_TOP], 1u);
            const unsigned tg = og / nx;
            if (og + 1u == (tg + 1u) * nx) xb_add(&bar[XB_TOPGEN], 1u);
            else XB_SPIN(xb_ld(&bar[XB_TOPGEN]) == tg, bar);
            __builtin_amdgcn_fence(__ATOMIC_ACQUIRE, "agent");
            xb_add(&bar[XB_XGEN(b.x)], 1u);
            asm volatile("s_waitcnt vmcnt(0)" ::: "memory");
        } else {
            XB_SPIN(xb_ld(&bar[XB_XGEN(b.x)]) == gen, bar);
            __builtin_amdgcn_fence(__ATOMIC_ACQUIRE, "agent");
            asm volatile("s_waitcnt vmcnt(0)" ::: "memory");
        }
    }
    __syncthreads();
}

typedef unsigned short bf16_t;
typedef short bf16x8 __attribute__((ext_vector_type(8)));
typedef float f32x4 __attribute__((ext_vector_type(4)));
typedef float f32x16 __attribute__((ext_vector_type(16)));

constexpr int DM = 2048, SEQ = 4096, NBP = 2, NBS = 32, TP = NBP * SEQ, MT = TP + NBS, MP = 8448;
constexpr int INW = 6784, INWP = 6912, SHD = 3200, DEPTH = 2;
constexpr size_t NRI = (size_t)MT * 1024;
constexpr int LDS_BYTES = 131072 + 16;
constexpr size_t O_CKP = (size_t)MT * DM;
constexpr size_t O_CVP = O_CKP + (size_t)DEPTH * NBP * 128 * 256;
constexpr size_t O_WKVP = O_CVP + (size_t)DEPTH * NBP * 128 * 256;
constexpr size_t O_SHP = O_WKVP + (size_t)DEPTH * NBP * 16 * 4096;
constexpr size_t O_CKS = O_SHP + (size_t)DEPTH * NBP * SHD;
constexpr size_t O_CVS = O_CKS + (size_t)DEPTH * NBS * 128 * 256;
constexpr size_t O_WKVS = O_CVS + (size_t)DEPTH * NBS * 128 * 256;
constexpr size_t O_SHS = O_WKVS + (size_t)DEPTH * NBS * 16 * 4096;
constexpr size_t O_END = O_SHS + (size_t)DEPTH * NBS * SHD;
constexpr size_t al256(size_t x) { return (x + 255) & ~(size_t)255; }
constexpr size_t WS_WTIN = 0;
constexpr size_t WS_WTOUT = WS_WTIN + (size_t)INWP * DM * 2;
constexpr size_t WS_MOD = WS_WTOUT + (size_t)DEPTH * DM * DM * 2;
constexpr size_t WS_ROPE = WS_MOD + al256((size_t)DEPTH * 34 * 6144 * 4);
constexpr size_t WS_HB = WS_ROPE + al256((size_t)4097 * 16 * 4);
constexpr size_t WS_QB = WS_HB + (size_t)MP * DM * 2;
constexpr size_t WS_KB = WS_QB + (size_t)MP * 1024 * 2;
constexpr size_t WS_VB = WS_KB + (size_t)MP * 256 * 2;
constexpr size_t WS_RW = WS_VB + (size_t)MP * 256 * 2;
constexpr size_t WS_GT = WS_RW + (size_t)MP * SHD * 2;
constexpr size_t WS_VALL = WS_GT + (size_t)MP * DM * 2;
constexpr size_t SRI = (size_t)NBS * 1024;
constexpr size_t WS_RSB = WS_VALL + NRI * 2;
constexpr size_t WS_RSW = WS_RSB + 4 * SRI * 2;
constexpr size_t WS_YS = WS_RSW + SRI * 4;
constexpr size_t WS_REC = WS_YS + NRI * 4;
constexpr size_t WS_COEF = WS_REC + (size_t)32 * 256 * 14592;
constexpr size_t WS_TWAD = WS_COEF + al256((size_t)MT * 16 * 4);
constexpr size_t WS_WFRAG = WS_TWAD + (size_t)MT * 128 * 2;
constexpr size_t WS_BAR = WS_WFRAG + (size_t)DEPTH * 2 * 16 * 4 * 2 * 64 * 16;
constexpr size_t WS_RFLAG = WS_BAR + 16384;
constexpr size_t RFLAG_BYTES = (size_t)32 * 256 * 64;
constexpr size_t WS_END = WS_RFLAG + RFLAG_BYTES;

struct Params {
    const float *x_prompt, *x_sample, *cache_k, *cache_v, *state_wkv, *state_shift, *c_prompt, *c_sample, *norm_g, *w_ada, *b_ada, *w_in, *mu_shift, *w0, *w_decay, *a0,
        *w_iclr, *k_k, *k_a, *r_k, *ln_w, *ln_b, *sinks, *w_out, *final_g;
    float* out;
    unsigned char* ws;
    int repk, repl;
};
typedef const __attribute__((address_space(4))) Params* KParamsPtr;
__device__ __forceinline__ const Params& kparams() {
    KParamsPtr k = (KParamsPtr)__builtin_amdgcn_kernarg_segment_ptr();
    asm volatile("" : "+s"(k));
    return *(const Params*)k;
}

__device__ __forceinline__ unsigned short f2bf(float f) { return (unsigned short)(hw_cvt_pk_bf16(f, 0.f) & 0xffffu); }
__device__ __forceinline__ float bf2f(unsigned short b) { return __uint_as_float(((unsigned)b) << 16); }
__device__ __forceinline__ unsigned pack2(float lo, float hi) { return hw_cvt_pk_bf16(lo, hi); }
__device__ __forceinline__ float bflo(unsigned w) { return __uint_as_float(w << 16); }
__device__ __forceinline__ float bfhi(unsigned w) { return __uint_as_float(w & 0xffff0000u); }
__device__ __forceinline__ float silu_f(float x) { return x / (1.f + __expf(-x)); }
__device__ __forceinline__ float wave_sum(float x) {
#pragma unroll
    for (int o = 32; o >= 1; o >>= 1) x += __shfl_xor(x, o);
    return x;
}
__device__ __forceinline__ float wave_max(float x) {
#pragma unroll
    for (int o = 32; o >= 1; o >>= 1) x = fmaxf(x, __shfl_xor(x, o));
    return x;
}
template <int CTRL> __device__ __forceinline__ float dpp_f(float x) {
    return __builtin_bit_cast(float, __builtin_amdgcn_update_dpp(0, __builtin_bit_cast(int, x), CTRL, 0xF, 0xF, false));
}
__device__ __forceinline__ float allreduce16(float x) {
    x += dpp_f<0x128>(x);
    x += dpp_f<0x124>(x);
    x += dpp_f<0x122>(x);
    x += dpp_f<0x121>(x);
    return x;
}

__device__ void p0_mod_item(const Params& p, float* red, int l, int nc) {
    const int tid = opq_tid(), wv = tid >> 6, lane = tid & 63, n = lane & 31, kh = lane >> 5;
    f32x16 acc0, acc1;
#pragma unroll
    for (int i = 0; i < 16; ++i) { acc0[i] = 0.f; acc1[i] = 0.f; }
    const float* W = p.w_ada + (size_t)l * DM * 6144 + nc * 32 + n;
#pragma unroll 4
    for (int ks = 0; ks < 16; ++ks) {
        const int k0 = wv * 256 + ks * 16 + kh * 8;
        bf16x8 bfr, a0, a1;
#pragma unroll
        for (int j = 0; j < 8; ++j) bfr[j] = (short)f2bf(W[(size_t)(k0 + j) * 6144]);
        const float4* cs = (const float4*)(p.c_sample + (size_t)n * DM + k0);
        const float4 u0 = cs[0], u1 = cs[1];
        a0[0] = (short)f2bf(silu_f(u0.x)); a0[1] = (short)f2bf(silu_f(u0.y)); a0[2] = (short)f2bf(silu_f(u0.z)); a0[3] = (short)f2bf(silu_f(u0.w));
        a0[4] = (short)f2bf(silu_f(u1.x)); a0[5] = (short)f2bf(silu_f(u1.y)); a0[6] = (short)f2bf(silu_f(u1.z)); a0[7] = (short)f2bf(silu_f(u1.w));
        float4 q0 = make_float4(0.f, 0.f, 0.f, 0.f), q1 = q0;
        if (n < 2) { const float4* cp = (const float4*)(p.c_prompt + (size_t)n * DM + k0); q0 = cp[0]; q1 = cp[1]; }
        a1[0] = (short)f2bf(silu_f(q0.x)); a1[1] = (short)f2bf(silu_f(q0.y)); a1[2] = (short)f2bf(silu_f(q0.z)); a1[3] = (short)f2bf(silu_f(q0.w));
        a1[4] = (short)f2bf(silu_f(q1.x)); a1[5] = (short)f2bf(silu_f(q1.y)); a1[6] = (short)f2bf(silu_f(q1.z)); a1[7] = (short)f2bf(silu_f(q1.w));
        acc0 = __builtin_amdgcn_mfma_f32_32x32x16_bf16(a0, bfr, acc0, 0, 0, 0);
        acc1 = __builtin_amdgcn_mfma_f32_32x32x16_bf16(a1, bfr, acc1, 0, 0, 0);
    }
#pragma unroll
    for (int i = 0; i < 16; ++i) red[(wv * 18 + i) * 64 + lane] = acc0[i];
    red[(wv * 18 + 16) * 64 + lane] = acc1[0];
    red[(wv * 18 + 17) * 64 + lane] = acc1[1];
    __syncthreads();
    float* mod = (float*)(p.ws + WS_MOD);
    for (int o = tid; o < 34 * 32; o += 512) {
        const int row = o >> 5, col = o & 31;
        int ri, ln, mrow;
        if (row < 32) { const int khh = (row >> 2) & 1; ri = (row & 3) + 4 * (row >> 3); ln = col + 32 * khh; mrow = 2 + row; }
        else { ri = 16 + (row - 32); ln = col; mrow = row - 32; }
        float s = 0.f;
#pragma unroll
        for (int w = 0; w < 8; ++w) s += red[(w * 18 + ri) * 64 + ln];
        mod[((size_t)l * 34 + mrow) * 6144 + nc * 32 + col] = s + p.b_ada[l * 6144 + nc * 32 + col];
    }
    __syncthreads();
}

struct ConvIt { const float* src; bf16_t* dst; int N, k0, n0; };
__device__ __forceinline__ ConvIt conv_decode(const Params& p, int cidx, int lw) {
    ConvIt c;
    int kt, nt;
    if (cidx < 1728) { kt = cidx & 15; nt = cidx >> 4; c.N = INW; c.src = p.w_in + (size_t)lw * DM * INW; c.dst = (bf16_t*)(p.ws + WS_WTIN); }
    else { int rem = cidx - 1728; const int l2 = rem >> 9; rem &= 511; kt = rem & 15; nt = rem >> 4; c.N = DM; c.src = p.w_out + (size_t)l2 * DM * DM; c.dst = (bf16_t*)(p.ws + WS_WTOUT) + (size_t)l2 * DM * DM; }
    c.k0 = kt * 128; c.n0 = nt * 64;
    return c;
}
__device__ void p0_conv_all(const Params& p, float* s, int bid, int G, int total, int lw) {
    const int tid = opq_tid();
    const int lrow = tid >> 4, c4 = tid & 15, n = tid >> 3, kg = tid & 7;
    float4 v[4];
    int cidx = bid;
    ConvIt cur = conv_decode(p, cidx < total ? cidx : 0, lw);
    if (cidx < total) {
#pragma unroll
        for (int p4 = 0; p4 < 4; ++p4) { v[p4] = make_float4(0.f, 0.f, 0.f, 0.f); if (cur.n0 < cur.N) v[p4] = *(const float4*)(cur.src + (size_t)(cur.k0 + lrow + 32 * p4) * cur.N + cur.n0 + 4 * c4); }
    }
#pragma unroll 1
    while (cidx < total) {
#pragma unroll
        for (int p4 = 0; p4 < 4; ++p4) { float* d = s + (lrow + 32 * p4) * 65 + 4 * c4; d[0] = v[p4].x; d[1] = v[p4].y; d[2] = v[p4].z; d[3] = v[p4].w; }
        __syncthreads();
        const int nxt = cidx + G;
        const ConvIt nx = conv_decode(p, nxt < total ? nxt : 0, lw);
        if (nxt < total) {
#pragma unroll
            for (int p4 = 0; p4 < 4; ++p4) { v[p4] = make_float4(0.f, 0.f, 0.f, 0.f); if (nx.n0 < nx.N) v[p4] = *(const float4*)(nx.src + (size_t)(nx.k0 + lrow + 32 * p4) * nx.N + nx.n0 + 4 * c4); }
        }
        unsigned w[8];
#pragma unroll
        for (int j = 0; j < 8; ++j) w[j] = pack2(s[(kg * 16 + 2 * j) * 65 + n], s[(kg * 16 + 2 * j + 1) * 65 + n]);
        uint4* o = (uint4*)(cur.dst + (size_t)(cur.n0 + n) * DM + cur.k0 + kg * 16);
        o[0] = make_uint4(w[0], w[1], w[2], w[3]);
        o[1] = make_uint4(w[4], w[5], w[6], w[7]);
        __syncthreads();
        cur = nx; cidx = nxt;
    }
}

__device__ void p0_rope_item(const Params& p, int it) {
    float* rope = (float*)(p.ws + WS_ROPE);
#pragma unroll
    for (int q = 0; q < 4; ++q) {
        const int e = it * 2048 + q * 512 + opq_tid();
        if (e < 4097 * 8) {
            const int idx = e >> 3, i = e & 7;
            double invf = 1.0;
            for (int q = 0; q < i; ++q) invf *= 0.19392274474868576;
            const double pos = idx < 4096 ? (double)idx : 16384.0;
            const double rev = pos * invf * 0.15915494309189535;
            const float f = (float)(rev - floor(rev));
            rope[idx * 16 + i] = __builtin_amdgcn_cosf(f);
            rope[idx * 16 + 8 + i] = __builtin_amdgcn_sinf(f);
        }
    }
}

__device__ void p0_wfrag_item(const Params& p, int it) {
    const int e0 = it * 512 + opq_tid();
    const int lane = e0 & 63, ks = (e0 >> 6) & 1, ct = (e0 >> 7) & 3, hd = (e0 >> 9) & 15, mtx = (e0 >> 13) & 1, l = e0 >> 14;
    const float* W = (mtx == 0 ? p.w_decay : p.w_iclr) + (size_t)l * 64 * 1024 + hd * 64 + 16 * ct + (lane & 15);
    const int k0 = 32 * ks + 8 * (lane >> 4);
    float v[8];
#pragma unroll
    for (int e = 0; e < 8; ++e) v[e] = W[(size_t)(k0 + e) * 1024];
    ((uint4*)(p.ws + WS_WFRAG))[e0] = make_uint4(pack2(v[0], v[1]), pack2(v[2], v[3]), pack2(v[4], v[5]), pack2(v[6], v[7]));
}

__device__ void p1_norm(const Params& p, int l, int bid, int G) {
    const int tid = opq_tid(), wv = tid >> 6, lane = tid & 63;
    bf16_t* hb = (bf16_t*)(p.ws + WS_HB);
    const float* mod = (const float*)(p.ws + WS_MOD);
    const float4* g4 = (const float4*)(p.norm_g + l * DM);
    for (int r = bid * 8 + wv; r < MT; r += G * 8) {
        const float* xr = l == 0 ? (r < TP ? p.x_prompt + (size_t)r * DM : p.x_sample + (size_t)(r - TP) * DM) : p.out + (size_t)r * DM;
        const int mrow = r < TP ? (r >> 12) : 2 + (r - TP);
        const float* md = mod + ((size_t)l * 34 + mrow) * 6144;
        float4 v[8]; float ss = 0.f;
#pragma unroll
        for (int i = 0; i < 8; ++i) { v[i] = ((const float4*)xr)[lane + 64 * i]; ss += v[i].x * v[i].x + v[i].y * v[i].y + v[i].z * v[i].z + v[i].w * v[i].w; }
        ss = wave_sum(ss);
        const float rinv = rsqrtf(ss * (1.f / 2048.f) + 1e-5f);
#pragma unroll
        for (int i = 0; i < 8; ++i) {
            const int c4 = lane + 64 * i;
            const float4 g = g4[c4], sc = ((const float4*)(md + 2048))[c4], sh = ((const float4*)md)[c4];
            const float y0 = v[i].x * rinv * g.x * (1.f + sc.x) + sh.x, y1 = v[i].y * rinv * g.y * (1.f + sc.y) + sh.y;
            const float y2 = v[i].z * rinv * g.z * (1.f + sc.z) + sh.z, y3 = v[i].w * rinv * g.w * (1.f + sc.w) + sh.w;
            *(uint2*)(hb + (size_t)r * DM + 4 * c4) = make_uint2(pack2(y0, y1), pack2(y2, y3));
        }
    }
}

struct Epi1 {
    static constexpr bool PERM = false, AFTER_DRAIN = false;
    int l;
    __device__ __forceinline__ void operator()(const f32x4 (&acc)[2][2][4][2], const pg8::Unit& u, int wr, int wc, int fr, int fq) const {
        const Params& p = kparams();
        bf16_t* const qb = (bf16_t*)(p.ws + WS_QB); bf16_t* const kb = (bf16_t*)(p.ws + WS_KB); bf16_t* const vb = (bf16_t*)(p.ws + WS_VB);
        bf16_t* const rw = (bf16_t*)(p.ws + WS_RW); bf16_t* const gt = (bf16_t*)(p.ws + WS_GT); const float* const rope = (const float*)(p.ws + WS_ROPE); float* const out = p.out;
#pragma unroll
        for (int bj = 0; bj < 2; ++bj)
#pragma unroll
            for (int n = 0; n < 2; ++n) {
                const int cb = u.pn * 256 + bj * 128 + wc * 32 + n * 16;
                if (cb >= INW) continue;
                const int c = cb + 4 * fq;
                const bool do_rope = (cb < 1280) && ((cb & 63) == 0);
#pragma unroll
                for (int ai = 0; ai < 2; ++ai)
#pragma unroll
                    for (int m = 0; m < 4; ++m) {
                        const int rb = u.pm * 256 + ai * 128 + wr * 64 + m * 16;
                        if (rb >= MT) continue;
                        const int r = rb + fr;
                        f32x4 v = acc[ai][bj][m][n];
                        if (do_rope) {
                            const int idx = r < TP ? (r & 4095) : 4096;
                            const float4 cs = *(const float4*)(rope + idx * 16 + 4 * (fq & 1));
                            const float4 sn = *(const float4*)(rope + idx * 16 + 8 + 4 * (fq & 1));
                            const float p0 = __shfl_xor(v[0], 32), p1 = __shfl_xor(v[1], 32), p2 = __shfl_xor(v[2], 32), p3 = __shfl_xor(v[3], 32);
                            const float sg = fq < 2 ? -1.f : 1.f;
                            v[0] = v[0] * cs.x + sg * p0 * sn.x; v[1] = v[1] * cs.y + sg * p1 * sn.y; v[2] = v[2] * cs.z + sg * p2 * sn.z; v[3] = v[3] * cs.w + sg * p3 * sn.w;
                        }
                        if (cb < 1024) {
                            *(uint2*)(qb + (size_t)r * 1024 + c) = make_uint2(pack2(v[0] * 0.125f, v[1] * 0.125f), pack2(v[2] * 0.125f, v[3] * 0.125f));
                        } else if (cb < 1536) {
                            const bool isk = cb < 1280;
                            const int cc = c - (isk ? 1024 : 1280);
                            *(uint2*)((isk ? kb : vb) + (size_t)r * 256 + cc) = make_uint2(pack2(v[0], v[1]), pack2(v[2], v[3]));
                            if (r >= TP) {
                                *(f32x4*)(out + (isk ? O_CKS : O_CVS) + ((size_t)(l * NBS + (r - TP)) * 128 + 127) * 256 + cc) = v;
                            } else if ((r & 4095) >= SEQ - 128) {
                                *(f32x4*)(out + (isk ? O_CKP : O_CVP) + ((size_t)(l * NBP + (r >> 12)) * 128 + ((r & 4095) - (SEQ - 128))) * 256 + cc) = v;
                            }
                        } else if (cb < 4736) {
                            const int cc = c - 1536;
                            *(uint2*)(rw + (size_t)r * SHD + cc) = make_uint2(pack2(v[0], v[1]), pack2(v[2], v[3]));
                            if (r >= TP) *(f32x4*)(out + O_SHS + (size_t)(l * NBS + (r - TP)) * SHD + cc) = v;
                            else if ((r & 4095) == SEQ - 1) *(f32x4*)(out + O_SHP + (size_t)(l * NBP + (r >> 12)) * SHD + cc) = v;
                        } else {
                            const int cc = c - 4736;
                            *(uint2*)(gt + (size_t)r * DM + cc) = make_uint2(pack2(silu_f(v[0]), silu_f(v[1])), pack2(silu_f(v[2]), silu_f(v[3])));
                        }
                    }
            }
    }
};

struct Epi2 {
    static constexpr bool PERM = false, AFTER_DRAIN = false;
    int l;
    __device__ __forceinline__ void operator()(const f32x4 (&acc)[2][2][4][2], const pg8::Unit& u, int wr, int wc, int fr, int fq) const {
        const Params& p = kparams();
        const float* const xp = p.x_prompt; const float* const xs = p.x_sample; const float* const modl = (const float*)(p.ws + WS_MOD) + (size_t)l * 34 * 6144; float* const out = p.out;
#pragma unroll
        for (int ai = 0; ai < 2; ++ai)
#pragma unroll
            for (int m = 0; m < 4; ++m) {
                const int rb = u.pm * 256 + ai * 128 + wr * 64 + m * 16;
                if (rb >= MT) continue;
                const int r = rb + fr;
                const int mrow = r < TP ? (r >> 12) : 2 + (r - TP);
                const float* xo = l == 0 ? (r < TP ? xp + (size_t)r * DM : xs + (size_t)(r - TP) * DM) : out + (size_t)r * DM;
                const float* gr = modl + (size_t)mrow * 6144 + 4096;
#pragma unroll
                for (int bj = 0; bj < 2; ++bj)
#pragma unroll
                    for (int n = 0; n < 2; ++n) {
                        const int c = u.pn * 256 + bj * 128 + wc * 32 + n * 16 + 4 * fq;
                        const f32x4 x4 = *(const f32x4*)(xo + c), g4 = *(const f32x4*)(gr + c);
                        *(f32x4*)(out + (size_t)r * DM + c) = x4 + g4 * acc[ai][bj][m][n];
                    }
            }
    }
};

__device__ void g2_sample_item(const Params& p, float* red, int l, int nb) {
    const int tid = opq_tid(), wv = tid >> 6, lane = tid & 63, n = lane & 31, h = lane >> 5;
    const bf16_t* A = (const bf16_t*)(p.ws + WS_HB) + (size_t)TP * DM;
    const bf16_t* Bt = (const bf16_t*)(p.ws + WS_WTOUT) + (size_t)l * DM * DM + (size_t)(nb * 32) * DM;
    f32x16 acc;
#pragma unroll
    for (int i = 0; i < 16; ++i) acc[i] = 0.f;
#pragma unroll 4
    for (int ks = 0; ks < 16; ++ks) {
        const int k0 = wv * 256 + ks * 16 + 8 * h;
        const bf16x8 a = *(const bf16x8*)(A + (size_t)n * DM + k0);
        const bf16x8 bq = *(const bf16x8*)(Bt + (size_t)n * DM + k0);
        acc = __builtin_amdgcn_mfma_f32_32x32x16_bf16(a, bq, acc, 0, 0, 0);
    }
#pragma unroll
    for (int i = 0; i < 16; ++i) red[(wv * 16 + i) * 64 + lane] = acc[i];
    __syncthreads();
    const float* mod = (const float*)(p.ws + WS_MOD) + (size_t)l * 34 * 6144;
    for (int o = tid; o < 1024; o += 512) {
        const int row = o >> 5, col = o & 31, hh = (row >> 2) & 1, ri = (row & 3) + 4 * (row >> 3), ln = col + 32 * hh;
        float s = 0.f;
#pragma unroll
        for (int w = 0; w < 8; ++w) s += red[(w * 16 + ri) * 64 + ln];
        const int c = nb * 32 + col;
        const float gate = mod[(size_t)(2 + row) * 6144 + 4096 + c];
        const float xo = l == 0 ? p.x_sample[(size_t)row * DM + c] : p.out[(size_t)(TP + row) * DM + c];
        p.out[(size_t)(TP + row) * DM + c] = xo + gate * s;
    }
    __syncthreads();
}

__device__ void p3_attn_unit(const Params& p, unsigned char* lds, int l, int unit) {
    const int tid = opq_tid(), wv = tid >> 6, lane = tid & 63;
    const int b = unit >> 7, n = (unit >> 2) & 31, g = unit & 3;
    bf16_t* Ks = (bf16_t*)lds;
    bf16_t* Vt = (bf16_t*)(lds + 36864);
    const bf16_t* qb = (const bf16_t*)(p.ws + WS_QB);
    const bf16_t* kb = (const bf16_t*)(p.ws + WS_KB);
    const bf16_t* vb = (const bf16_t*)(p.ws + WS_VB);
    const bf16_t* gt = (const bf16_t*)(p.ws + WS_GT);
    bf16_t* cc = (bf16_t*)(p.ws + WS_HB);
    {
        uint4 kv4[4], vv4[4];
#pragma unroll
        for (int i = 0; i < 4; ++i) {
            const int chunk = tid + 512 * i, kl = chunk >> 3, dc = chunk & 7, kp = 128 * (n - 1) + kl;
            kv4[i] = make_uint4(0u, 0u, 0u, 0u); vv4[i] = kv4[i];
            if (kp >= 0) { const size_t row = (size_t)b * SEQ + kp; kv4[i] = *(const uint4*)(kb + row * 256 + g * 64 + dc * 8); vv4[i] = *(const uint4*)(vb + row * 256 + g * 64 + dc * 8); }
        }
        __builtin_amdgcn_sched_barrier(0);
#pragma unroll
        for (int i = 0; i < 4; ++i) {
            const int chunk = tid + 512 * i, kl = chunk >> 3, dc = chunk & 7;
            *(uint4*)(Ks + kl * 72 + dc * 8) = kv4[i];
            bf16_t* vd = Vt + (dc * 8) * 264 + kl;
            vd[0 * 264] = (bf16_t)(vv4[i].x & 0xffffu); vd[1 * 264] = (bf16_t)(vv4[i].x >> 16);
            vd[2 * 264] = (bf16_t)(vv4[i].y & 0xffffu); vd[3 * 264] = (bf16_t)(vv4[i].y >> 16);
            vd[4 * 264] = (bf16_t)(vv4[i].z & 0xffffu); vd[5 * 264] = (bf16_t)(vv4[i].z >> 16);
            vd[6 * 264] = (bf16_t)(vv4[i].w & 0xffffu); vd[7 * 264] = (bf16_t)(vv4[i].w >> 16);
        }
    }
    __syncthreads();
    const int hq = 4 * g + (wv >> 1), qh = wv & 1, q32 = lane & 31, h = lane >> 5;
    const float sink = p.sinks[l * 16 + hq];
#pragma unroll 1
    for (int s = 0; s < 2; ++s) {
        const int qp = 128 * n + 64 * qh + 32 * s + q32;
        const size_t qrow = (size_t)b * SEQ + qp;
        const int klb0 = 64 * qh + 32 * s;
        bf16x8 qf[4];
#pragma unroll
        for (int ks = 0; ks < 4; ++ks) qf[ks] = *(const bf16x8*)(qb + qrow * 1024 + hq * 64 + ks * 16 + 8 * h);
        f32x16 S[5];
#pragma unroll
        for (int kt = 0; kt < 5; ++kt) {
#pragma unroll
            for (int i = 0; i < 16; ++i) S[kt][i] = 0.f;
#pragma unroll
            for (int ks = 0; ks < 4; ++ks) {
                const bf16x8 a = *(const bf16x8*)(Ks + (klb0 + 32 * kt + q32) * 72 + ks * 16 + 8 * h);
                S[kt] = __builtin_amdgcn_mfma_f32_32x32x16_bf16(a, qf[ks], S[kt], 0, 0, 0);
            }
        }
        float mx = -1e30f;
#pragma unroll
        for (int kt = 0; kt < 5; ++kt)
#pragma unroll
            for (int i = 0; i < 16; ++i) {
                const int m = 8 * (i >> 2) + 4 * h + (i & 3);
                const int kp = 128 * (n - 1) + klb0 + 32 * kt + m;
                const int rel = qp - kp;
                const bool ok = (rel >= 0) && (rel <= 128) && (kp >= 0);
                const float sv = ok ? S[kt][i] : -1e30f;
                S[kt][i] = sv; mx = fmaxf(mx, sv);
            }
        mx = fmaxf(mx, __shfl_xor(mx, 32));
        mx = fmaxf(mx, sink);
        float sum = 0.f;
#pragma unroll
        for (int kt = 0; kt < 5; ++kt)
#pragma unroll
            for (int i = 0; i < 16; ++i) { const float e = __expf(S[kt][i] - mx); S[kt][i] = e; sum += e; }
        sum += __shfl_xor(sum, 32);
        const float inv = 1.f / (sum + __expf(sink - mx));
        f32x16 O[2];
#pragma unroll
        for (int i = 0; i < 16; ++i) { O[0][i] = 0.f; O[1][i] = 0.f; }
#pragma unroll
        for (int kt = 0; kt < 5; ++kt)
#pragma unroll
            for (int sp = 0; sp < 2; ++sp) {
                bf16x8 pf;
#pragma unroll
                for (int j = 0; j < 8; ++j) pf[j] = (short)f2bf(S[kt][8 * sp + j]);
#pragma unroll
                for (int dt = 0; dt < 2; ++dt) {
                    const bf16_t* vp = Vt + (32 * dt + q32) * 264 + klb0 + 32 * kt + 16 * sp + 4 * h;
                    const uint2 lo = *(const uint2*)vp, hi = *(const uint2*)(vp + 8);
                    const uint4 av = make_uint4(lo.x, lo.y, hi.x, hi.y);
                    O[dt] = __builtin_amdgcn_mfma_f32_32x32x16_bf16(__builtin_bit_cast(bf16x8, av), pf, O[dt], 0, 0, 0);
                }
            }
#pragma unroll
        for (int dt = 0; dt < 2; ++dt)
#pragma unroll
            for (int ig = 0; ig < 4; ++ig) {
                const int col = hq * 64 + 32 * dt + 8 * ig + 4 * h;
                const uint2 gg = *(const uint2*)(gt + qrow * DM + col);
                const float o0 = O[dt][4 * ig + 0] * inv * bflo(gg.x), o1 = O[dt][4 * ig + 1] * inv * bfhi(gg.x);
                const float o2 = O[dt][4 * ig + 2] * inv * bflo(gg.y), o3 = O[dt][4 * ig + 3] * inv * bfhi(gg.y);
                *(uint2*)(cc + qrow * DM + col) = make_uint2(pack2(o0, o1), pack2(o2, o3));
            }
    }
    __syncthreads();
}

__device__ void p3_sattn_item(const Params& p, float* lds, int l, int item) {
    const int tid = opq_tid(), wv = tid >> 6, lane = tid & 63;
    float* pl = lds + wv * 128;
    const int w = item * 8 + wv, bd = w >> 4, hq = w & 15, g = hq >> 2;
    const size_t row = (size_t)TP + bd;
    const bf16_t* qb = (const bf16_t*)(p.ws + WS_QB);
    const bf16_t* gt = (const bf16_t*)(p.ws + WS_GT);
    bf16_t* cc = (bf16_t*)(p.ws + WS_HB);
    float q[64];
#pragma unroll
    for (int c = 0; c < 8; ++c) {
        const uint4 u = *(const uint4*)(qb + row * 1024 + hq * 64 + c * 8);
        q[c * 8 + 0] = bflo(u.x); q[c * 8 + 1] = bfhi(u.x); q[c * 8 + 2] = bflo(u.y); q[c * 8 + 3] = bfhi(u.y);
        q[c * 8 + 4] = bflo(u.z); q[c * 8 + 5] = bfhi(u.z); q[c * 8 + 6] = bflo(u.w); q[c * 8 + 7] = bfhi(u.w);
    }
    const size_t cbase = ((size_t)(l * NBS + bd) * 128) * 256 + g * 64;
    const float* ck = p.cache_k + cbase;
    const float* cv = p.cache_v + cbase;
    float* nk = p.out + O_CKS + cbase;
    float* nv = p.out + O_CVS + cbase;
    float s0 = 0.f, s1 = 0.f, s2 = 0.f;
#pragma unroll
    for (int c = 0; c < 16; ++c) {
        const float4 a = ((const float4*)(ck + (size_t)lane * 256))[c];
        const float4 bq = ((const float4*)(ck + (size_t)(lane + 64) * 256))[c];
        const float4 e = ((const float4*)(nk + (size_t)127 * 256))[c];
        s0 += a.x * q[4 * c] + a.y * q[4 * c + 1] + a.z * q[4 * c + 2] + a.w * q[4 * c + 3];
        s1 += bq.x * q[4 * c] + bq.y * q[4 * c + 1] + bq.z * q[4 * c + 2] + bq.w * q[4 * c + 3];
        s2 += e.x * q[4 * c] + e.y * q[4 * c + 1] + e.z * q[4 * c + 2] + e.w * q[4 * c + 3];
    }
    const float sink = p.sinks[l * 16 + hq];
    const float mx = fmaxf(wave_max(fmaxf(s0, s1)), fmaxf(s2, sink));
    const float p0 = __expf(s0 - mx), p1 = __expf(s1 - mx), p2 = __expf(s2 - mx);
    const float sum = wave_sum(p0 + p1) + p2 + __expf(sink - mx);
    pl[lane] = p0; pl[lane + 64] = p1;
    __builtin_amdgcn_fence(__ATOMIC_RELEASE, "wavefront");
    __builtin_amdgcn_wave_barrier();
    __builtin_amdgcn_fence(__ATOMIC_ACQUIRE, "wavefront");
    float o = 0.f;
#pragma unroll 32
    for (int key = 0; key < 128; ++key) o += pl[key] * cv[(size_t)key * 256 + lane];
    o += p2 * nv[(size_t)127 * 256 + lane];
    o /= sum;
    const float gate = bf2f(gt[row * DM + hq * 64 + lane]);
    cc[row * DM + hq * 64 + lane] = f2bf(o * gate);
    {
        float tk[32], tv[32];
#pragma unroll
        for (int i = 0; i < 32; ++i) {
            const int ww = (hq & 3) + 4 * i;
            tk[i] = ck[(size_t)(ww + 1 < 128 ? ww + 1 : 127) * 256 + lane]; tv[i] = cv[(size_t)(ww + 1 < 128 ? ww + 1 : 127) * 256 + lane];
        }
#pragma unroll
        for (int i = 0; i < 32; ++i) {
            const int ww = (hq & 3) + 4 * i;
            if (ww < 127) { nk[(size_t)ww * 256 + lane] = tk[i]; nv[(size_t)ww * 256 + lane] = tv[i]; }
        }
    }
    __builtin_amdgcn_wave_barrier();
}

__device__ __forceinline__ float mix_val(const bf16_t* rw, const float* sshift, const float* mu, int r, int c) {
    const float cur = bf2f(rw[(size_t)r * SHD + c]);
    float prev;
    if (r >= TP) prev = sshift[(size_t)(r - TP) * SHD + c];
    else if ((r & 4095) == 0) prev = 0.f;
    else prev = bf2f(rw[(size_t)(r - 1) * SHD + c]);
    return cur + (prev - cur) * mu[c];
}

__device__ __forceinline__ float4 mix4(const bf16_t* rw, const float* sshift, int r, int c, float4 mu4) {
    const uint2 cu = *(const uint2*)(rw + (size_t)r * SHD + c);
    const float4 cur = make_float4(bflo(cu.x), bfhi(cu.x), bflo(cu.y), bfhi(cu.y));
    float4 prev = make_float4(0.f, 0.f, 0.f, 0.f);
    if (r >= TP) prev = *(const float4*)(sshift + (size_t)(r - TP) * SHD + c);
    else if ((r & 4095) != 0) { const uint2 pu = *(const uint2*)(rw + (size_t)(r - 1) * SHD + c); prev = make_float4(bflo(pu.x), bfhi(pu.x), bflo(pu.y), bfhi(pu.y)); }
    return make_float4(cur.x + (prev.x - cur.x) * mu4.x, cur.y + (prev.y - cur.y) * mu4.y, cur.z + (prev.z - cur.z) * mu4.z, cur.w + (prev.w - cur.w) * mu4.w);
}
__device__ __forceinline__ float decay_of(float x) {
    const float z = -x;
    const float sp = fmaxf(z, 0.f) + __logf(1.f + __expf(-fabsf(z)));
    return __expf(-__expf(-sp - 0.5f));
}

__device__ void p3_twad_item(const Params& p, int l, int tile) {
    const int tid = opq_tid();
    const bf16_t* rw = (const bf16_t*)(p.ws + WS_RW);
    const float* sshift = p.state_shift + (size_t)l * NBS * SHD;
    const float* mu = p.mu_shift + l * SHD;
    bf16_t* TWAD = (bf16_t*)(p.ws + WS_TWAD);
    const int r0 = tile * 32;
    float mm[8];
#pragma unroll
    for (int i = 0; i < 8; ++i) { const int idx = tid + 512 * i, tt = idx >> 7, c2 = idx & 127; mm[i] = mix_val(rw, sshift, mu, r0 + tt, 3072 + c2); }
#pragma unroll
    for (int i = 0; i < 8; ++i) {
        const int idx = tid + 512 * i, tt = idx >> 7, c2 = idx & 127;
        float o = mm[i];
        if (c2 < 64) { const float e = __expf(2.f * mm[i]); o = 1.f - 2.f / (e + 1.f); }
        TWAD[(size_t)(r0 + tt) * 128 + c2] = f2bf(o);
    }
}

__device__ void p3_prep_tile(const Params& p, unsigned char* lds, int l, int tile) {
    const int tid = opq_tid(), wv = tid >> 6, lane = tid & 63, n = lane & 31, h = lane >> 5;
    bf16_t* TW = (bf16_t*)lds;
    bf16_t* AD = TW + 32 * 72;
    const bf16_t* rw = (const bf16_t*)(p.ws + WS_RW);
    const float* sshift = p.state_shift + (size_t)l * NBS * SHD;
    const float* mu = p.mu_shift + l * SHD;
    bf16_t* RSB = (bf16_t*)(p.ws + WS_RSB);
    bf16_t* VALL = (bf16_t*)(p.ws + WS_VALL);
    float* RSW = (float*)(p.ws + WS_RSW);
    float* coef = (float*)(p.ws + WS_COEF);
    const int r0 = tile * 32;
    {
        float mm[8];
#pragma unroll
        for (int i = 0; i < 8; ++i) { const int idx = tid + 512 * i, tt = idx >> 7, c2 = idx & 127; mm[i] = mix_val(rw, sshift, mu, r0 + tt, 3072 + c2); }
        __builtin_amdgcn_sched_barrier(0);
#pragma unroll
        for (int i = 0; i < 8; ++i) {
            const int idx = tid + 512 * i, tt = idx >> 7, c2 = idx & 127;
            if (c2 < 64) { const float e = __expf(2.f * mm[i]); TW[tt * 72 + c2] = f2bf(1.f - 2.f / (e + 1.f)); }
            else AD[tt * 72 + (c2 - 64)] = f2bf(mm[i]);
        }
    }
    __syncthreads();
    const int col0 = wv * 128 + 4 * n;
    f32x16 acc[4];
    {
        const float* wp = p.w_decay + (size_t)l * 64 * 1024 + col0;
#pragma unroll
        for (int nt = 0; nt < 4; ++nt)
#pragma unroll
            for (int i = 0; i < 16; ++i) acc[nt][i] = 0.f;
#pragma unroll
        for (int ks = 0; ks < 4; ++ks) {
            const bf16x8 a = *(const bf16x8*)(TW + n * 72 + 16 * ks + 8 * h);
            float4 w4[8];
#pragma unroll
            for (int e = 0; e < 8; ++e) w4[e] = *(const float4*)(wp + (size_t)(16 * ks + 8 * h + e) * 1024);
            bf16x8 b0, b1, b2, b3;
#pragma unroll
            for (int e = 0; e < 8; ++e) { b0[e] = (short)f2bf(w4[e].x); b1[e] = (short)f2bf(w4[e].y); b2[e] = (short)f2bf(w4[e].z); b3[e] = (short)f2bf(w4[e].w); }
            acc[0] = __builtin_amdgcn_mfma_f32_32x32x16_bf16(a, b0, acc[0], 0, 0, 0);
            acc[1] = __builtin_amdgcn_mfma_f32_32x32x16_bf16(a, b1, acc[1], 0, 0, 0);
            acc[2] = __builtin_amdgcn_mfma_f32_32x32x16_bf16(a, b2, acc[2], 0, 0, 0);
            acc[3] = __builtin_amdgcn_mfma_f32_32x32x16_bf16(a, b3, acc[3], 0, 0, 0);
        }
        const float4 w0c = *(const float4*)(p.w0 + l * 1024 + col0);
#pragma unroll
        for (int r = 0; r < 16; ++r) {
            const int row = r0 + 8 * (r >> 2) + 4 * h + (r & 3);
            *(float4*)(RSW + (size_t)(row - TP) * 1024 + col0) =
                make_float4(decay_of(w0c.x + acc[0][r]), decay_of(w0c.y + acc[1][r]), decay_of(w0c.z + acc[2][r]), decay_of(w0c.w + acc[3][r]));
        }
    }
    {
        const float* wp = p.w_iclr + (size_t)l * 64 * 1024 + col0;
#pragma unroll
        for (int nt = 0; nt < 4; ++nt)
#pragma unroll
            for (int i = 0; i < 16; ++i) acc[nt][i] = 0.f;
#pragma unroll
        for (int ks = 0; ks < 4; ++ks) {
            const bf16x8 a = *(const bf16x8*)(AD + n * 72 + 16 * ks + 8 * h);
            float4 w4[8];
#pragma unroll
            for (int e = 0; e < 8; ++e) w4[e] = *(const float4*)(wp + (size_t)(16 * ks + 8 * h + e) * 1024);
            bf16x8 b0, b1, b2, b3;
#pragma unroll
            for (int e = 0; e < 8; ++e) { b0[e] = (short)f2bf(w4[e].x); b1[e] = (short)f2bf(w4[e].y); b2[e] = (short)f2bf(w4[e].z); b3[e] = (short)f2bf(w4[e].w); }
            acc[0] = __builtin_amdgcn_mfma_f32_32x32x16_bf16(a, b0, acc[0], 0, 0, 0);
            acc[1] = __builtin_amdgcn_mfma_f32_32x32x16_bf16(a, b1, acc[1], 0, 0, 0);
            acc[2] = __builtin_amdgcn_mfma_f32_32x32x16_bf16(a, b2, acc[2], 0, 0, 0);
            acc[3] = __builtin_amdgcn_mfma_f32_32x32x16_bf16(a, b3, acc[3], 0, 0, 0);
        }
    }
    const float4 a0c = *(const float4*)(p.a0 + l * 1024 + col0), kkc = *(const float4*)(p.k_k + l * 1024 + col0), kac = *(const float4*)(p.k_a + l * 1024 + col0), rkc = *(const float4*)(p.r_k + l * 1024 + col0);
    const float4 mur = *(const float4*)(mu + col0), muk = *(const float4*)(mu + 1024 + col0), muv = *(const float4*)(mu + 2048 + col0);
    const int head = 2 * wv + (n >> 4);
#pragma unroll
    for (int g4 = 0; g4 < 4; ++g4) {
        float4 rr4[4], kr4[4], vr4[4];
#pragma unroll
        for (int q = 0; q < 4; ++q) {
            const int row = r0 + 8 * g4 + 4 * h + q;
            rr4[q] = mix4(rw, sshift, row, col0, mur); kr4[q] = mix4(rw, sshift, row, 1024 + col0, muk); vr4[q] = mix4(rw, sshift, row, 2048 + col0, muv);
        }
        __builtin_amdgcn_sched_barrier(0);
#pragma unroll
        for (int q = 0; q < 4; ++q) {
            const int r = 4 * g4 + q;
            const int row = r0 + 8 * g4 + 4 * h + q;
            const float4 rr = rr4[q], kr = kr4[q], vr = vr4[q];
            const float ax = 1.f / (1.f + __expf(-(a0c.x + acc[0][r]))), ay = 1.f / (1.f + __expf(-(a0c.y + acc[1][r])));
            const float az = 1.f / (1.f + __expf(-(a0c.z + acc[2][r]))), aw = 1.f / (1.f + __expf(-(a0c.w + acc[3][r])));
            const float k0 = kr.x * kkc.x, k1 = kr.y * kkc.y, k2 = kr.z * kkc.z, k3 = kr.w * kkc.w;
            const float ss = allreduce16(k0 * k0 + k1 * k1 + k2 * k2 + k3 * k3);
            const float inv = 1.f / fmaxf(sqrtf(ss), 1e-12f);
            const float4 kk = make_float4(k0 * inv, k1 * inv, k2 * inv, k3 * inv);
            const float4 ke = make_float4(kr.x * (1.f + (ax - 1.f) * kac.x), kr.y * (1.f + (ay - 1.f) * kac.y), kr.z * (1.f + (az - 1.f) * kac.z), kr.w * (1.f + (aw - 1.f) * kac.w));
            const float cf = allreduce16(rr.x * ke.x * rkc.x + rr.y * ke.y * rkc.y + rr.z * ke.z * rkc.z + rr.w * ke.w * rkc.w);
            if ((n & 15) == 0) coef[(size_t)row * 16 + head] = cf;
            const size_t o = (size_t)row * 1024 + col0;
            const size_t os = (size_t)(row - TP) * 1024 + col0;
            *(uint2*)(RSB + os) = make_uint2(pack2(rr.x, rr.y), pack2(rr.z, rr.w));
            *(uint2*)(RSB + SRI + os) = make_uint2(pack2(ke.x, ke.y), pack2(ke.z, ke.w));
            *(uint2*)(RSB + 2 * SRI + os) = make_uint2(pack2(kk.x, kk.y), pack2(kk.z, kk.w));
            *(uint2*)(RSB + 3 * SRI + os) = make_uint2(pack2(kk.x * ax, kk.y * ay), pack2(kk.z * az, kk.w * aw));
            *(uint2*)(VALL + o) = make_uint2(pack2(vr.x, vr.y), pack2(vr.z, vr.w));
        }
        __builtin_amdgcn_sched_barrier(0);
    }
    __syncthreads();
}

constexpr int REC_BYTES = 14592;
constexpr int PA_WLDS = 16384;
typedef float f32x4v __attribute__((ext_vector_type(4)));

__device__ void pa_chunk(const Params& p, unsigned char* wl, int l, int ct) {
    const int lane = opq_tid() & 63;
    const int hh = ct >> 8, c = ct & 255, b = hh >> 4, h = hh & 15;
    const size_t row0 = (size_t)b * SEQ + 16 * c;
    const int col = h * 64 + lane;
    bf16_t* VALL = (bf16_t*)(p.ws + WS_VALL);
    float vv[16];
    float gC;
    bf16_t* S_AB = (bf16_t*)wl; bf16_t* S_BB = S_AB + 16 * 72; bf16_t* S_KB = S_BB + 16 * 72; bf16_t* S_RT = S_KB + 16 * 72;
    {
        const bf16_t* rw = (const bf16_t*)(p.ws + WS_RW);
        const bf16_t* TWAD = (const bf16_t*)(p.ws + WS_TWAD);
        const uint4* WFd = (const uint4*)(p.ws + WS_WFRAG) + (size_t)((l * 2 + 0) * 16 + h) * 512 + lane;
        const uint4* WFi = (const uint4*)(p.ws + WS_WFRAG) + (size_t)((l * 2 + 1) * 16 + h) * 512 + lane;
        unsigned xr[17], xk[17], xv[17];
        const bool first = (row0 & 4095) == 0;
#pragma unroll
        for (int t = 0; t < 17; ++t) {
            const unsigned ro = (unsigned)(row0 + t - 1) * (unsigned)SHD + (unsigned)col;
            if (t == 0 && first) { xr[0] = 0u; xk[0] = 0u; xv[0] = 0u; }
            else { xr[t] = rw[ro]; xk[t] = rw[ro + 1024u]; xv[t] = rw[ro + 2048u]; }
        }
        const int rr = lane & 15, kg = lane >> 4;
        f32x4v Dd[4], Da[4];
#pragma unroll
        for (int ct = 0; ct < 4; ++ct) { Dd[ct] = (f32x4v){0.f, 0.f, 0.f, 0.f}; Da[ct] = Dd[ct]; }
#pragma unroll
        for (int ks = 0; ks < 2; ++ks) {
            const bf16x8 atw = *(const bf16x8*)(TWAD + (size_t)(row0 + rr) * 128 + 32 * ks + 8 * kg);
            const bf16x8 aad = *(const bf16x8*)(TWAD + (size_t)(row0 + rr) * 128 + 64 + 32 * ks + 8 * kg);
#pragma unroll
            for (int ct = 0; ct < 4; ++ct) {
                const bf16x8 bd = __builtin_bit_cast(bf16x8, WFd[(ct * 2 + ks) * 64]);
                const bf16x8 bi = __builtin_bit_cast(bf16x8, WFi[(ct * 2 + ks) * 64]);
                Dd[ct] = __builtin_amdgcn_mfma_f32_16x16x32_bf16(atw, bd, Dd[ct], 0, 0, 0);
                Da[ct] = __builtin_amdgcn_mfma_f32_16x16x32_bf16(aad, bi, Da[ct], 0, 0, 0);
            }
        }
        float* LD = (float*)wl; float* LA = LD + 1024;
#pragma unroll
        for (int ct = 0; ct < 4; ++ct)
#pragma unroll
            for (int rg = 0; rg < 4; ++rg) { LD[(4 * kg + rg) * 64 + 16 * ct + rr] = Dd[ct][rg]; LA[(4 * kg + rg) * 64 + 16 * ct + rr] = Da[ct][rg]; }
        __builtin_amdgcn_fence(__ATOMIC_RELEASE, "wavefront"); __builtin_amdgcn_wave_barrier(); __builtin_amdgcn_fence(__ATOMIC_ACQUIRE, "wavefront");
        float din[16], ain[16];
#pragma unroll
        for (int t = 0; t < 16; ++t) { din[t] = LD[t * 64 + lane]; ain[t] = LA[t * 64 + lane]; }
        __builtin_amdgcn_fence(__ATOMIC_RELEASE, "wavefront"); __builtin_amdgcn_wave_barrier(); __builtin_amdgcn_fence(__ATOMIC_ACQUIRE, "wavefront");
        const float mur = p.mu_shift[l * SHD + col], muk = p.mu_shift[l * SHD + 1024 + col], muv = p.mu_shift[l * SHD + 2048 + col];
        const float w0c = p.w0[l * 1024 + col], a0c = p.a0[l * 1024 + col], kkc = p.k_k[l * 1024 + col], kac = p.k_a[l * 1024 + col], rkc = p.r_k[l * 1024 + col];
        float* coef = (float*)(p.ws + WS_COEF);
        float g = 1.f;
#pragma unroll
        for (int t = 0; t < 16; ++t) {
            const float cr = bf2f((unsigned short)xr[t + 1]), pr = bf2f((unsigned short)xr[t]), ck = bf2f((unsigned short)xk[t + 1]), pk = bf2f((unsigned short)xk[t]);
            const float cv = bf2f((unsigned short)xv[t + 1]), pv = bf2f((unsigned short)xv[t]);
            const float r_ = cr + (pr - cr) * mur, kr = ck + (pk - ck) * muk, vr = cv + (pv - cv) * muv;
            const float a = 1.f / (1.f + __expf(-(a0c + ain[t])));
            const float dec = decay_of(w0c + din[t]);
            const float kkr = kr * kkc;
            float ss = allreduce16(kkr * kkr); ss += __shfl_xor(ss, 16); ss += __shfl_xor(ss, 32);
            const float kkv = kkr / fmaxf(sqrtf(ss), 1e-12f);
            const float ke = kr * (1.f + (a - 1.f) * kac);
            float cf = allreduce16(r_ * ke * rkc); cf += __shfl_xor(cf, 16); cf += __shfl_xor(cf, 32);
            if (lane == 0) coef[(size_t)(row0 + t) * 16 + h] = cf;
            VALL[(unsigned)(row0 + t) * 1024u + (unsigned)col] = f2bf(vr);
            vv[t] = vr;
            S_AB[t * 72 + lane] = f2bf(-g * kkv);
            g *= dec;
            const float ig = __builtin_amdgcn_rcpf(g);
            S_BB[t * 72 + lane] = f2bf(kkv * a * ig); S_KB[t * 72 + lane] = f2bf(ke * ig); S_RT[t * 72 + lane] = f2bf(g * r_);
        }
        gC = g;
    }
    __builtin_amdgcn_fence(__ATOMIC_RELEASE, "wavefront"); __builtin_amdgcn_wave_barrier(); __builtin_amdgcn_fence(__ATOMIC_ACQUIRE, "wavefront");
    f32x4v Gab = {0.f, 0.f, 0.f, 0.f}, Gak = Gab, Grb = Gab, Grk = Gab;
    {
        const int rr = lane & 15, kg = lane >> 4;
#pragma unroll
        for (int ks = 0; ks < 2; ++ks) {
            const int o = rr * 72 + 32 * ks + 8 * kg;
            const bf16x8 fA = *(const bf16x8*)(S_AB + o), fB = *(const bf16x8*)(S_BB + o), fK = *(const bf16x8*)(S_KB + o), fR = *(const bf16x8*)(S_RT + o);
            Gab = __builtin_amdgcn_mfma_f32_16x16x32_bf16(fB, fA, Gab, 0, 0, 0);
            Gak = __builtin_amdgcn_mfma_f32_16x16x32_bf16(fK, fA, Gak, 0, 0, 0);
            Grb = __builtin_amdgcn_mfma_f32_16x16x32_bf16(fB, fR, Grb, 0, 0, 0);
            Grk = __builtin_amdgcn_mfma_f32_16x16x32_bf16(fK, fR, Grk, 0, 0, 0);
        }
    }
    __builtin_amdgcn_fence(__ATOMIC_RELEASE, "wavefront"); __builtin_amdgcn_wave_barrier(); __builtin_amdgcn_fence(__ATOMIC_ACQUIRE, "wavefront");
    float* M_AB = (float*)(wl + 9216); float* M_AK = M_AB + 256; float* M_RB = M_AK + 256; float* M_RK = M_RB + 256; float* T_ = M_RK + 256; float* Q_ = T_ + 256; float* W2_ = Q_ + 256;
    {
        const int t = lane & 15, kg = lane >> 4;
#pragma unroll
        for (int rg = 0; rg < 4; ++rg) {
            const int s = 4 * kg + rg;
            M_AB[s * 16 + t] = s < t ? Gab[rg] : 0.f; M_AK[s * 16 + t] = s < t ? Gak[rg] : 0.f;
            M_RB[s * 16 + t] = s <= t ? Grb[rg] : 0.f; M_RK[s * 16 + t] = s <= t ? Grk[rg] : 0.f;
        }
    }
    __builtin_amdgcn_fence(__ATOMIC_RELEASE, "wavefront"); __builtin_amdgcn_wave_barrier(); __builtin_amdgcn_fence(__ATOMIC_ACQUIRE, "wavefront");
    {
        const int rr = lane & 15;
        float Tr[16];
#pragma unroll
        for (int t = 0; t < 16; ++t) {
            float acc = (rr == t) ? 1.f : 0.f;
#pragma unroll
            for (int s = 0; s < t; ++s) acc += Tr[s] * M_AB[s * 16 + t];
            Tr[t] = acc;
        }
#pragma unroll
        for (int t = 0; t < 16; ++t) T_[rr * 16 + t] = Tr[t];
    }
    __builtin_amdgcn_fence(__ATOMIC_RELEASE, "wavefront"); __builtin_amdgcn_wave_barrier(); __builtin_amdgcn_fence(__ATOMIC_ACQUIRE, "wavefront");
    {
        const int s = lane & 15, tq = lane >> 4;
        float4 q = make_float4(0.f, 0.f, 0.f, 0.f);
#pragma unroll
        for (int u = 0; u < 16; ++u) { const float a = M_AK[s * 16 + u]; const float4 t4 = *(const float4*)(T_ + u * 16 + 4 * tq); q.x += a * t4.x; q.y += a * t4.y; q.z += a * t4.z; q.w += a * t4.w; }
        *(float4*)(Q_ + s * 16 + 4 * tq) = q;
        __builtin_amdgcn_fence(__ATOMIC_RELEASE, "wavefront"); __builtin_amdgcn_wave_barrier(); __builtin_amdgcn_fence(__ATOMIC_ACQUIRE, "wavefront");
        float4 w2 = *(const float4*)(M_RK + s * 16 + 4 * tq);
#pragma unroll
        for (int u = 0; u < 16; ++u) { const float a = Q_[s * 16 + u]; const float4 m4 = *(const float4*)(M_RB + u * 16 + 4 * tq); w2.x += a * m4.x; w2.y += a * m4.y; w2.z += a * m4.z; w2.w += a * m4.w; }
        *(float4*)(W2_ + s * 16 + 4 * tq) = w2;
    }
    __builtin_amdgcn_fence(__ATOMIC_RELEASE, "wavefront"); __builtin_amdgcn_wave_barrier(); __builtin_amdgcn_fence(__ATOMIC_ACQUIRE, "wavefront");
    cvt_f32x2 pt2[8], r22[8], ul2[8], yl2[8];
#pragma unroll
    for (int t = 0; t < 8; ++t) { pt2[t] = (cvt_f32x2){0.f, 0.f}; r22[t] = (cvt_f32x2){bf2f(S_RT[(2 * t) * 72 + lane]), bf2f(S_RT[(2 * t + 1) * 72 + lane])}; ul2[t] = pt2[t]; yl2[t] = pt2[t]; }
#pragma unroll
    for (int s = 0; s < 16; ++s) {
        const float as_ = bf2f(S_AB[s * 72 + lane]), vs_ = vv[s];
        const cvt_f32x2 as2 = {as_, as_}, vs2 = {vs_, vs_};
#pragma unroll
        for (int tq = 0; tq < 4; ++tq) {
            const float4 t4 = *(const float4*)(T_ + s * 16 + 4 * tq), q4 = *(const float4*)(Q_ + s * 16 + 4 * tq), w4 = *(const float4*)(W2_ + s * 16 + 4 * tq);
            pt2[2 * tq] += (cvt_f32x2){t4.x, t4.y} * as2; pt2[2 * tq + 1] += (cvt_f32x2){t4.z, t4.w} * as2;
            ul2[2 * tq] += (cvt_f32x2){q4.x, q4.y} * vs2; ul2[2 * tq + 1] += (cvt_f32x2){q4.z, q4.w} * vs2;
            yl2[2 * tq] += (cvt_f32x2){w4.x, w4.y} * vs2; yl2[2 * tq + 1] += (cvt_f32x2){w4.z, w4.w} * vs2;
        }
        __builtin_amdgcn_sched_barrier(0);
    }
    float pt[16], ul[16], yl[16];
#pragma unroll
    for (int t = 0; t < 8; ++t) { pt[2 * t] = pt2[t].x; pt[2 * t + 1] = pt2[t].y; ul[2 * t] = ul2[t].x; ul[2 * t + 1] = ul2[t].y; yl[2 * t] = yl2[t].x; yl[2 * t + 1] = yl2[t].y; }
#pragma unroll
    for (int s = 0; s < 16; ++s) {
        const cvt_f32x2 ps2 = {pt[s], pt[s]};
#pragma unroll
        for (int tq = 0; tq < 4; ++tq) {
            const float4 m4 = *(const float4*)(M_RB + s * 16 + 4 * tq);
            r22[2 * tq] += (cvt_f32x2){m4.x, m4.y} * ps2; r22[2 * tq + 1] += (cvt_f32x2){m4.z, m4.w} * ps2;
        }
        __builtin_amdgcn_sched_barrier(0);
    }
    float r2[16];
#pragma unroll
    for (int t = 0; t < 8; ++t) { r2[2 * t] = r22[t].x; r2[2 * t + 1] = r22[t].y; }
    unsigned char* rec = p.ws + WS_REC + (size_t)ct * REC_BYTES;
    float* ys = (float*)(p.ws + WS_YS);
    {
#pragma unroll
        for (int t = 0; t < 16; ++t) { S_AB[t * 72 + lane] = f2bf(pt[t]); S_RT[t * 72 + lane] = f2bf(r2[t]); }
        __builtin_amdgcn_fence(__ATOMIC_RELEASE, "wavefront"); __builtin_amdgcn_wave_barrier(); __builtin_amdgcn_fence(__ATOMIC_ACQUIRE, "wavefront");
#pragma unroll
        for (int i2 = 0; i2 < 2; ++i2) {
            const int q = lane + 64 * i2, f = q >> 5, hf = (q >> 4) & 1, t = q & 15;
            const uint2 a0 = *(const uint2*)(S_AB + t * 72 + 16 * f + 4 * hf), a1 = *(const uint2*)(S_AB + t * 72 + 16 * f + 8 + 4 * hf);
            const uint2 c0 = *(const uint2*)(S_RT + t * 72 + 16 * f + 4 * hf), c1 = *(const uint2*)(S_RT + t * 72 + 16 * f + 8 + 4 * hf);
            st_sc1_b128(rec + q * 16, a0.x, a0.y, a1.x, a1.y);
            st_sc1_b128(rec + 2048 + q * 16, c0.x, c0.y, c1.x, c1.y);
        }
        {
            float* YT = (float*)(wl + 9216);
#pragma unroll
            for (int t = 0; t < 16; ++t) YT[t * 64 + lane] = yl[t];
            __builtin_amdgcn_fence(__ATOMIC_RELEASE, "wavefront"); __builtin_amdgcn_wave_barrier(); __builtin_amdgcn_fence(__ATOMIC_ACQUIRE, "wavefront");
#pragma unroll
            for (int i4 = 0; i4 < 4; ++i4) {
                const int idx = lane + 64 * i4, t = idx >> 4, q4 = idx & 15;
                const float4 y4 = *(const float4*)(YT + t * 64 + 4 * q4);
                st_sc1_b128(ys + (unsigned)(row0 + t) * 1024u + (unsigned)(h * 64 + 4 * q4), __float_as_uint(y4.x), __float_as_uint(y4.y), __float_as_uint(y4.z), __float_as_uint(y4.w));
            }
        }
    }
    {
        float gb[16], gk[16];
#pragma unroll
        for (int t = 0; t < 16; ++t) { gb[t] = gC * bf2f(S_BB[t * 72 + lane]); gk[t] = gC * bf2f(S_KB[t * 72 + lane]); }
        st_sc1_b128(rec + 4096 + lane * 16, pack2(gb[0], gb[1]), pack2(gb[2], gb[3]), pack2(gb[8], gb[9]), pack2(gb[10], gb[11]));
        st_sc1_b128(rec + 4096 + (64 + lane) * 16, pack2(gb[4], gb[5]), pack2(gb[6], gb[7]), pack2(gb[12], gb[13]), pack2(gb[14], gb[15]));
        st_sc1_b128(rec + 6144 + lane * 16, pack2(gk[0], gk[1]), pack2(gk[2], gk[3]), pack2(gk[4], gk[5]), pack2(gk[6], gk[7]));
        st_sc1_b128(rec + 6144 + (64 + lane) * 16, pack2(gk[8], gk[9]), pack2(gk[10], gk[11]), pack2(gk[12], gk[13]), pack2(gk[14], gk[15]));
        st_sc1_b32(rec + 8192 + lane * 4, gC);
        unsigned char* ip = rec + 8448 + (lane >> 5) * 3072;
        const int il = lane & 31;
        st_sc1_b128(ip + il * 16, pack2(vv[0], vv[1]), pack2(vv[2], vv[3]), pack2(vv[4], vv[5]), pack2(vv[6], vv[7]));
        st_sc1_b128(ip + (32 + il) * 16, pack2(vv[8], vv[9]), pack2(vv[10], vv[11]), pack2(vv[12], vv[13]), pack2(vv[14], vv[15]));
#pragma unroll
        for (int tq = 0; tq < 4; ++tq) st_sc1_b128(ip + 1024 + (((tq >> 1) * 2 + (tq & 1)) * 32 + il) * 16, __float_as_uint(ul[4 * tq]), __float_as_uint(ul[4 * tq + 1]), __float_as_uint(ul[4 * tq + 2]), __float_as_uint(ul[4 * tq + 3]));
    }
    asm volatile("s_waitcnt vmcnt(0)" ::: "memory");
    if (lane == 0) __hip_atomic_store((unsigned*)(p.ws + WS_RFLAG + (size_t)ct * 64), (unsigned)(l + 1), __ATOMIC_RELAXED, __HIP_MEMORY_SCOPE_AGENT);
    __builtin_amdgcn_fence(__ATOMIC_RELEASE, "wavefront"); __builtin_amdgcn_wave_barrier();
}

__device__ void pa_sample_task(const Params& p, int l, int task) {
    const int lane = opq_tid() & 63;
    const int bd = task >> 8, h = (task >> 4) & 15, wq = task & 15;
    const int irow = 4 * wq + (lane >> 4), jq = lane & 15;
    const size_t row = (size_t)TP + bd;
    const bf16_t* RSB = (const bf16_t*)(p.ws + WS_RSB);
    const float* RSW = (const float*)(p.ws + WS_RSW);
    const bf16_t* VALL = (const bf16_t*)(p.ws + WS_VALL);
    float* ys = (float*)(p.ws + WS_YS);
    const size_t so = (((size_t)(l * NBS + bd) * 16 + h) * 64 + irow) * 64 + 4 * jq;
    float4 s = *(const float4*)(p.state_wkv + so);
    const size_t o = row * 1024 + h * 64 + 4 * jq;
    const size_t os = (size_t)bd * 1024 + h * 64 + 4 * jq;
    const uint2 ur = *(const uint2*)(RSB + os), uk = *(const uint2*)(RSB + SRI + os), ukk = *(const uint2*)(RSB + 2 * SRI + os), ub = *(const uint2*)(RSB + 3 * SRI + os);
    const float4 w4 = *(const float4*)(RSW + os);
    const float v = bf2f(VALL[row * 1024 + h * 64 + irow]);
    float pa = s.x * bflo(ukk.x) + s.y * bfhi(ukk.x) + s.z * bflo(ukk.y) + s.w * bfhi(ukk.y);
    pa = allreduce16(pa);
    const float sa = -pa;
    s.x = fmaf(sa, bflo(ub.x), fmaf(s.x, w4.x, v * bflo(uk.x)));
    s.y = fmaf(sa, bfhi(ub.x), fmaf(s.y, w4.y, v * bfhi(uk.x)));
    s.z = fmaf(sa, bflo(ub.y), fmaf(s.z, w4.z, v * bflo(uk.y)));
    s.w = fmaf(sa, bfhi(ub.y), fmaf(s.w, w4.w, v * bfhi(uk.y)));
    float py = s.x * bflo(ur.x) + s.y * bfhi(ur.x) + s.z * bflo(ur.y) + s.w * bfhi(ur.y);
    py = allreduce16(py);
    *(float4*)(p.out + O_WKVS + so) = s;
    if (jq == 0) ys[row * 1024 + h * 64 + irow] = py;
}

__device__ __forceinline__ uint4 ld_sc1_b128(const unsigned char* p) {
    const unsigned long long a = __hip_atomic_load((const unsigned long long*)p, __ATOMIC_RELAXED, __HIP_MEMORY_SCOPE_AGENT), c = __hip_atomic_load((const unsigned long long*)(p + 8), __ATOMIC_RELAXED, __HIP_MEMORY_SCOPE_AGENT);
    return make_uint4((unsigned)a, (unsigned)(a >> 32), (unsigned)c, (unsigned)(c >> 32));
}
constexpr int PB_NB = 8, PB_SLOT = 13568, PB_NCH = SEQ / 16, PB_NX = 4, PB_XOFF = PB_NB * PB_SLOT  , PB_FOFF = PB_XOFF + PB_NX * 4096;
__device__ void pb_head(const Params& p, unsigned char* lds, int l, int blk, bool dry) {
    const int tid = opq_tid(), wv = tid >> 6, lane = tid & 63;
    const int hh = blk >> 1, it = blk & 1, b = hh >> 4, h = hh & 15;
    volatile LAS unsigned* flags = (volatile LAS unsigned*)((LAS unsigned char*)lds + PB_FOFF);
    if (tid < 16) flags[tid] = 0u;
    __syncthreads();
    const unsigned char* rec0 = p.ws + WS_REC + (size_t)(hh * 256) * REC_BYTES;
    float* ys = (float*)(p.ws + WS_YS) + ((size_t)b * SEQ) * 1024 + h * 64 + 32 * it;
    const int q32 = lane & 31, hf = lane >> 5;
    if (wv >= 2) {
        unsigned nf = __hip_atomic_load((const unsigned*)(p.ws + WS_RFLAG + (size_t)(hh * 256 + (wv - 2)) * 64), __ATOMIC_RELAXED, __HIP_MEMORY_SCOPE_AGENT);
#pragma unroll 1
        for (int c = wv - 2; c < PB_NCH; c += 6) {
            while (c - (int)flags[8] >= PB_NB || c - (int)flags[9] >= PB_NB) __builtin_amdgcn_s_sleep(1);
            asm volatile("" ::: "memory");
            {
                const unsigned* rf = (const unsigned*)(p.ws + WS_RFLAG + (size_t)(hh * 256 + c) * 64);
                while (nf != (unsigned)(l + 1)) { __builtin_amdgcn_s_sleep(2); nf = __hip_atomic_load(rf, __ATOMIC_RELAXED, __HIP_MEMORY_SCOPE_AGENT); }
                asm volatile("" ::: "memory");
            }
            const unsigned char* rec = rec0 + (size_t)c * REC_BYTES;
            unsigned char* sl = lds + (c % PB_NB) * PB_SLOT;
            const unsigned char* rc = rec + lane * 16;
            const unsigned char* ri = rec + 8448 + it * 3072 + lane * 16;
#define LD_SC1(p_) ld_sc1_b128((const unsigned char*)(p_))
            const uint4 d0 = LD_SC1(rc), d1 = LD_SC1(rc + 1024), d2 = LD_SC1(rc + 2048), d3 = LD_SC1(rc + 3072);
            const uint4 d4 = LD_SC1(rc + 4096), d5 = LD_SC1(rc + 5120), d6 = LD_SC1(rc + 6144), d7 = LD_SC1(rc + 7168);
            const uint4 d8 = LD_SC1(rec + 8192 + (lane & 15) * 16);
            const uint4 d9 = LD_SC1(ri), d10 = LD_SC1(ri + 1024), d11 = LD_SC1(ri + 2048);
            const int t0 = lane >> 3, cc = lane & 7;
            const uint4 d12 = LD_SC1(ys + (size_t)(16 * c + t0) * 1024 + cc * 4), d13 = LD_SC1(ys + (size_t)(16 * c + 8 + t0) * 1024 + cc * 4);
#undef LD_SC1
            nf = (c + 6 < PB_NCH) ? __hip_atomic_load((const unsigned*)(p.ws + WS_RFLAG + (size_t)(hh * 256 + c + 6) * 64), __ATOMIC_RELAXED, __HIP_MEMORY_SCOPE_AGENT) : 0u;
            __builtin_amdgcn_sched_barrier(0);
            unsigned char* sd = sl + lane * 16;
            *(uint4*)(sd) = d0; *(uint4*)(sd + 1024) = d1; *(uint4*)(sd + 2048) = d2; *(uint4*)(sd + 3072) = d3;
            *(uint4*)(sd + 4096) = d4; *(uint4*)(sd + 5120) = d5; *(uint4*)(sd + 6144) = d6; *(uint4*)(sd + 7168) = d7;
            if (lane < 16) *(uint4*)(sl + 8192 + lane * 16) = d8;
            *(uint4*)(sd + 8448) = d9; *(uint4*)(sd + 9472) = d10; *(uint4*)(sd + 10496) = d11;
            {
                float* yd = (float*)(sl + 11520) + ((((t0 >> 2) & 1) * 32 + 4 * cc) * 4 + (t0 & 3));
                yd[0] = __uint_as_float(d12.x); yd[4] = __uint_as_float(d12.y); yd[8] = __uint_as_float(d12.z); yd[12] = __uint_as_float(d12.w);
                yd[256] = __uint_as_float(d13.x); yd[260] = __uint_as_float(d13.y); yd[264] = __uint_as_float(d13.z); yd[268] = __uint_as_float(d13.w);
            }
            asm volatile("" ::: "memory");
            if (lane == 0) flags[c % PB_NB] = (unsigned)(c + 1);
        }
    } else if (wv == 1) {
        bf16x8 ra0, ra1, ra2, ra3; float4 y0, y1;
#define PB_FETCHY(c_) do { const unsigned char* sl_ = lds + ((c_) % PB_NB) * PB_SLOT; \
            while (flags[(c_) % PB_NB] != (unsigned)((c_) + 1)) __builtin_amdgcn_s_sleep(0); \
            asm volatile("" ::: "memory"); \
            const unsigned char* pr_ = sl_ + 2048 + (hf * 16 + (q32 & 15)) * 16; \
            ra0 = *(const bf16x8*)(pr_); ra1 = *(const bf16x8*)(pr_ + 512); ra2 = *(const bf16x8*)(pr_ + 1024); ra3 = *(const bf16x8*)(pr_ + 1536); \
            y0 = *(const float4*)(sl_ + 11520 + (hf * 32 + q32) * 16); y1 = *(const float4*)(sl_ + 11520 + ((2 + hf) * 32 + q32) * 16); \
            asm volatile("" ::: "memory"); \
            if (lane == 0) flags[9] = (unsigned)((c_) + 1); } while (0)
        PB_FETCHY(0);
#pragma unroll 1
        for (int c = 0; c < PB_NCH; ++c) {
            const unsigned char* xr = lds + PB_XOFF + (c % PB_NX) * 4096 + lane * 16;
            f32x16 Ya, Yb;
            Ya[0] = y0.x; Ya[1] = y0.y; Ya[2] = y0.z; Ya[3] = y0.w; Ya[4] = y1.x; Ya[5] = y1.y; Ya[6] = y1.z; Ya[7] = y1.w;
#pragma unroll
            for (int r = 8; r < 16; ++r) Ya[r] = 0.f;
#pragma unroll
            for (int r = 0; r < 16; ++r) Yb[r] = 0.f;
            const bf16x8 rc0 = ra0, rc1 = ra1, rc2 = ra2, rc3 = ra3;
            while (flags[10 + (c % PB_NX)] != (unsigned)(c + 1)) __builtin_amdgcn_s_sleep(0);
            asm volatile("" ::: "memory");
            const bf16x8 xf0 = *(const bf16x8*)(xr), xf1 = *(const bf16x8*)(xr + 1024), xf2 = *(const bf16x8*)(xr + 2048), xf3 = *(const bf16x8*)(xr + 3072);
            asm volatile("" ::: "memory");
            if (lane == 0) flags[14] = (unsigned)(c + 1);
            Ya = __builtin_amdgcn_mfma_f32_32x32x16_bf16(rc0, xf0, Ya, 0, 0, 0);
            Yb = __builtin_amdgcn_mfma_f32_32x32x16_bf16(rc1, xf1, Yb, 0, 0, 0);
            Ya = __builtin_amdgcn_mfma_f32_32x32x16_bf16(rc2, xf2, Ya, 0, 0, 0);
            Yb = __builtin_amdgcn_mfma_f32_32x32x16_bf16(rc3, xf3, Yb, 0, 0, 0);
            if (c + 1 < PB_NCH) PB_FETCHY(c + 1);
            float* yc = ys + (size_t)c * (16 * 1024);
            if (!dry) {
#pragma unroll
                for (int r = 0; r < 8; ++r) yc[(8 * (r >> 2) + 4 * hf + (r & 3)) * 1024 + q32] = Ya[r] + Yb[r];
            }
        }
#undef PB_FETCHY
    } else {
        f32x16 X0, X1;
#pragma unroll
        for (int i = 0; i < 16; ++i) { X0[i] = 0.f; X1[i] = 0.f; }
        bf16x8 pa0, pa1, pa2, pa3, gb0, gb1, gk0, gk1, vf;
        float4 gm0, gm1, gm2, gm3, gm4, gm5, gm6, gm7, u0, u1;
#define PB_FETCH(c_) do { const unsigned char* sl_ = lds + ((c_) % PB_NB) * PB_SLOT; \
            { unsigned rv_ = rdy; while (rv_ != (unsigned)((c_) + 1)) { __builtin_amdgcn_s_sleep(0); rv_ = flags[(c_) % PB_NB]; } } \
            asm volatile("" ::: "memory"); \
            const unsigned char* pr_ = sl_ + (hf * 16 + (q32 & 15)) * 16; \
            pa0 = *(const bf16x8*)(pr_); pa1 = *(const bf16x8*)(pr_ + 512); pa2 = *(const bf16x8*)(pr_ + 1024); pa3 = *(const bf16x8*)(pr_ + 1536); \
            gb0 = *(const bf16x8*)(sl_ + 4096 + (hf * 64 + q32) * 16); gb1 = *(const bf16x8*)(sl_ + 4096 + (hf * 64 + 32 + q32) * 16); \
            gk0 = *(const bf16x8*)(sl_ + 6144 + (hf * 64 + q32) * 16); gk1 = *(const bf16x8*)(sl_ + 6144 + (hf * 64 + 32 + q32) * 16); \
            vf = *(const bf16x8*)(sl_ + 8448 + (hf * 32 + q32) * 16); \
            const unsigned char* gp_ = sl_ + 8192 + 16 * hf; \
            gm0 = *(const float4*)(gp_); gm1 = *(const float4*)(gp_ + 32); gm2 = *(const float4*)(gp_ + 64); gm3 = *(const float4*)(gp_ + 96); \
            gm4 = *(const float4*)(gp_ + 128); gm5 = *(const float4*)(gp_ + 160); gm6 = *(const float4*)(gp_ + 192); gm7 = *(const float4*)(gp_ + 224); \
            u0 = *(const float4*)(sl_ + 9472 + (hf * 32 + q32) * 16); u1 = *(const float4*)(sl_ + 9472 + ((2 + hf) * 32 + q32) * 16); \
            asm volatile("" ::: "memory"); \
            if (lane == 0) flags[8] = (unsigned)((c_) + 1); } while (0)
        unsigned rdy = flags[0];
        PB_FETCH(0);
        int xfree = 0;
#pragma unroll 1
        for (int c = 0; c < PB_NCH; ++c) {
            unsigned char* xw = lds + PB_XOFF + (c % PB_NX) * 4096 + lane * 16;
            rdy = flags[(c + 1) % PB_NB];
            const bf16x8 xb0 = __builtin_bit_cast(bf16x8, make_uint4(pack2(X0[0], X0[1]), pack2(X0[2], X0[3]), pack2(X0[4], X0[5]), pack2(X0[6], X0[7])));
            const bf16x8 xb1 = __builtin_bit_cast(bf16x8, make_uint4(pack2(X0[8], X0[9]), pack2(X0[10], X0[11]), pack2(X0[12], X0[13]), pack2(X0[14], X0[15])));
            const bf16x8 xb2 = __builtin_bit_cast(bf16x8, make_uint4(pack2(X1[0], X1[1]), pack2(X1[2], X1[3]), pack2(X1[4], X1[5]), pack2(X1[6], X1[7])));
            const bf16x8 xb3 = __builtin_bit_cast(bf16x8, make_uint4(pack2(X1[8], X1[9]), pack2(X1[10], X1[11]), pack2(X1[12], X1[13]), pack2(X1[14], X1[15])));
            f32x16 Ua, Ub;
            Ua[0] = u0.x; Ua[1] = u0.y; Ua[2] = u0.z; Ua[3] = u0.w; Ua[4] = u1.x; Ua[5] = u1.y; Ua[6] = u1.z; Ua[7] = u1.w;
#pragma unroll
            for (int r = 8; r < 16; ++r) Ua[r] = 0.f;
#pragma unroll
            for (int r = 0; r < 16; ++r) Ub[r] = 0.f;
            Ua = __builtin_amdgcn_mfma_f32_32x32x16_bf16(pa0, xb0, Ua, 0, 0, 0);
            Ub = __builtin_amdgcn_mfma_f32_32x32x16_bf16(pa1, xb1, Ub, 0, 0, 0);
            Ua = __builtin_amdgcn_mfma_f32_32x32x16_bf16(pa2, xb2, Ua, 0, 0, 0);
            Ub = __builtin_amdgcn_mfma_f32_32x32x16_bf16(pa3, xb3, Ub, 0, 0, 0);
            f32x16 Xn0, Xn1;
            Xn0[0] = X0[0] * gm0.x; Xn0[1] = X0[1] * gm0.y; Xn0[2] = X0[2] * gm0.z; Xn0[3] = X0[3] * gm0.w; Xn0[4] = X0[4] * gm1.x; Xn0[5] = X0[5] * gm1.y; Xn0[6] = X0[6] * gm1.z; Xn0[7] = X0[7] * gm1.w;
            Xn0[8] = X0[8] * gm2.x; Xn0[9] = X0[9] * gm2.y; Xn0[10] = X0[10] * gm2.z; Xn0[11] = X0[11] * gm2.w; Xn0[12] = X0[12] * gm3.x; Xn0[13] = X0[13] * gm3.y; Xn0[14] = X0[14] * gm3.z; Xn0[15] = X0[15] * gm3.w;
            Xn1[0] = X1[0] * gm4.x; Xn1[1] = X1[1] * gm4.y; Xn1[2] = X1[2] * gm4.z; Xn1[3] = X1[3] * gm4.w; Xn1[4] = X1[4] * gm5.x; Xn1[5] = X1[5] * gm5.y; Xn1[6] = X1[6] * gm5.z; Xn1[7] = X1[7] * gm5.w;
            Xn1[8] = X1[8] * gm6.x; Xn1[9] = X1[9] * gm6.y; Xn1[10] = X1[10] * gm6.z; Xn1[11] = X1[11] * gm6.w; Xn1[12] = X1[12] * gm7.x; Xn1[13] = X1[13] * gm7.y; Xn1[14] = X1[14] * gm7.z; Xn1[15] = X1[15] * gm7.w;
            Xn0 = __builtin_amdgcn_mfma_f32_32x32x16_bf16(gk0, vf, Xn0, 0, 0, 0);
            Xn1 = __builtin_amdgcn_mfma_f32_32x32x16_bf16(gk1, vf, Xn1, 0, 0, 0);
            const bf16x8 gbc0 = gb0, gbc1 = gb1;
            while (c - xfree >= PB_NX) { xfree = (int)flags[14]; }
            asm volatile("" ::: "memory");
            *(bf16x8*)(xw) = xb0; *(bf16x8*)(xw + 1024) = xb1; *(bf16x8*)(xw + 2048) = xb2; *(bf16x8*)(xw + 3072) = xb3;
            asm volatile("" ::: "memory");
            if (lane == 0) flags[10 + (c % PB_NX)] = (unsigned)(c + 1);
            if (c + 1 < PB_NCH) PB_FETCH(c + 1);
            const bf16x8 ub = __builtin_bit_cast(bf16x8, make_uint4(pack2(Ua[0] + Ub[0], Ua[1] + Ub[1]), pack2(Ua[2] + Ub[2], Ua[3] + Ub[3]), pack2(Ua[4] + Ub[4], Ua[5] + Ub[5]), pack2(Ua[6] + Ub[6], Ua[7] + Ub[7])));
            X0 = __builtin_amdgcn_mfma_f32_32x32x16_bf16(gbc0, ub, Xn0, 0, 0, 0);
            X1 = __builtin_amdgcn_mfma_f32_32x32x16_bf16(gbc1, ub, Xn1, 0, 0, 0);
        }
#undef PB_FETCH
        float* so = p.out + O_WKVP + ((size_t)(l * NBP + b) * 16 + h) * 4096 + (size_t)(32 * it + q32) * 64;
#pragma unroll
        for (int g = 0; g < 4; ++g) {
            *(float4*)(so + 8 * g + 4 * hf) = make_float4(X0[4 * g], X0[4 * g + 1], X0[4 * g + 2], X0[4 * g + 3]);
            *(float4*)(so + 32 + 8 * g + 4 * hf) = make_float4(X1[4 * g], X1[4 * g + 1], X1[4 * g + 2], X1[4 * g + 3]);
        }
    }
    __syncthreads();
}

__device__ void p3_post(const Params& p, int l, int bid, int G) {
    const int tid = opq_tid(), wv = tid >> 6, lane = tid & 63;
    const float* ys = (const float*)(p.ws + WS_YS);
    const bf16_t* V = (const bf16_t*)(p.ws + WS_VALL);
    const float* coef = (const float*)(p.ws + WS_COEF);
    const bf16_t* gt = (const bf16_t*)(p.ws + WS_GT);
    bf16_t* cc = (bf16_t*)(p.ws + WS_HB);
    for (int r = bid * 8 + wv; r < MT; r += G * 8) {
#pragma unroll
        for (int hg = 0; hg < 4; ++hg) {
            const int head = 4 * hg + (lane >> 4), c = head * 64 + 4 * (lane & 15);
            const float4 y = *(const float4*)(ys + (size_t)r * 1024 + c);
            const float mu = allreduce16(y.x + y.y + y.z + y.w) * (1.f / 64.f);
            const float d0 = y.x - mu, d1 = y.y - mu, d2 = y.z - mu, d3 = y.w - mu;
            const float var = allreduce16(d0 * d0 + d1 * d1 + d2 * d2 + d3 * d3) * (1.f / 64.f);
            const float rs = rsqrtf(var + 64e-5f);
            const float4 lw = *(const float4*)(p.ln_w + l * 1024 + c), lb = *(const float4*)(p.ln_b + l * 1024 + c);
            const uint2 vu = *(const uint2*)(V + (size_t)r * 1024 + c);
            const float4 v4 = make_float4(bflo(vu.x), bfhi(vu.x), bflo(vu.y), bfhi(vu.y));
            const float cf = coef[(size_t)r * 16 + head];
            const uint2 gg = *(const uint2*)(gt + (size_t)r * DM + 1024 + c);
            const float o0 = (d0 * rs * lw.x + lb.x + cf * v4.x) * bflo(gg.x), o1 = (d1 * rs * lw.y + lb.y + cf * v4.y) * bfhi(gg.x);
            const float o2 = (d2 * rs * lw.z + lb.z + cf * v4.z) * bflo(gg.y), o3 = (d3 * rs * lw.w + lb.w + cf * v4.w) * bfhi(gg.y);
            *(uint2*)(cc + (size_t)r * DM + 1024 + c) = make_uint2(pack2(o0, o1), pack2(o2, o3));
        }
    }
}

__device__ void p_final(const Params& p, int bid, int G) {
    const int tid = opq_tid(), wv = tid >> 6, lane = tid & 63;
    const float4* g4 = (const float4*)p.final_g;
    for (int r = bid * 8 + wv; r < MT; r += G * 8) {
        float4* xr = (float4*)(p.out + (size_t)r * DM);
        float4 v[8]; float ss = 0.f;
#pragma unroll
        for (int i = 0; i < 8; ++i) { v[i] = xr[lane + 64 * i]; ss += v[i].x * v[i].x + v[i].y * v[i].y + v[i].z * v[i].z + v[i].w * v[i].w; }
        ss = wave_sum(ss);
        const float rinv = rsqrtf(ss * (1.f / 2048.f) + 1e-5f);
#pragma unroll
        for (int i = 0; i < 8; ++i) { const float4 g = g4[lane + 64 * i]; xr[lane + 64 * i] = make_float4(v[i].x * rinv * g.x, v[i].y * rinv * g.y, v[i].z * rinv * g.z, v[i].w * rinv * g.w); }
    }
}

#ifndef REPL
#define REPL -1
#endif
#ifndef REPK
#define REPK -100
#endif
__global__ void __launch_bounds__(512, 2) fwd_kernel(Params p_unused) {
    extern __shared__ __attribute__((aligned(16))) unsigned char shm[];
    cg::grid_group grid = cg::this_grid();
    const int bid0 = blockIdx.x, G0 = gridDim.x;
    float* shf = (float*)shm;
    volatile LAS unsigned* xst = (volatile LAS unsigned*)((LAS unsigned char*)shm + 131072);
    if (threadIdx.x == 0) { xst[0] = 0u; xst[1] = 0u; }
    __syncthreads();
    const XcdBarrier xb = xcd_barrier_post((unsigned*)(kparams().ws + WS_BAR), xst);
    if (G0 == 0x7fffffff) grid.sync();

#pragma unroll 1
    for (int ph = 0; ph < 16; ++ph) {
        const int bid = opq_s(bid0), G = opq_s(G0);
        const int l = ph >= 8 ? 1 : 0, k = ph == 0 ? -1 : (ph == 15 ? 7 : (ph - 1) - 7 * l);
#pragma unroll 1
        for (int rep = 0; rep < ((k == kparams().repk && (kparams().repl < 0 || kparams().repl == l)) ? 2 : 1); ++rep) {
        if (k == -1) {
            for (int it = bid; it < 384; it += G) p0_mod_item(kparams(), shf, it / 192, it % 192);
            for (int it = bid; it < 17; it += G) p0_rope_item(kparams(), it);
            for (int it = bid; it < 64; it += G) p0_wfrag_item(kparams(), it);
            p0_conv_all(kparams(), shf, bid, G, 2752, 0);
        } else if (k == 0) {
            p1_norm(kparams(), l, bid, G);
        } else if (k == 1) {
            pg8::StaticOrder S; S.init(MP, INWP, G, bid);
            pg8::Gemm g{(const bf16_t*)(kparams().ws + WS_HB), (const bf16_t*)(kparams().ws + WS_WTIN), MP, INWP, DM};
            Epi1 E{l};
            pg8::gemm_phase<Epi1, pg8::StaticOrder, false>((PG8_LAS unsigned char*)shm, g, S, E, nullptr);
        } else if (k == 2) {
            for (int it = bid; it < 256 + 256 + 1 + 64; it += G) {
                if (it < 256) p3_attn_unit(kparams(), shm, l, it);
                else if (it < 512) p3_twad_item(kparams(), l, it - 256);
                else if (it == 512) p3_prep_tile(kparams(), shm, l, 256);
                else p3_sattn_item(kparams(), shf, l, it - 513);
            }
            __syncthreads();
            if (l == 0) p0_conv_all(kparams(), shf, bid, G, 1728, 1);
        } else if (k == 3) {
            {
                const int wvq = opq_tid() >> 6;
                int i2 = bid < 64 ? bid * 8 + wvq : 512 + (bid - 64) * 8 + wvq;
                const int step = bid < 64 ? (1 << 20) : (G - 64) * 8;
#pragma unroll 1
                for (; i2 < 32 * 256; i2 += step) pa_chunk(kparams(), shm + wvq * PA_WLDS, l, (i2 & 31) * 256 + (i2 >> 5));
                if (bid < 64) {
                    __syncthreads();
                    pb_head(kparams(), shm, l, bid, false);
                } else {
                    const int gw = (bid - 64) * 8 + wvq, nw = (G - 64) * 8;
                    for (int task = gw; task < NBS * 256; task += nw) pa_sample_task(kparams(), l, task);
                }
            }
        } else if (k == 4) {
        } else if (k == 5) {
            p3_post(kparams(), l, bid, G);
        } else if (k == 6) {
            pg8::StaticOrder S; S.init(TP, DM, G, bid);
            pg8::Gemm g{(const bf16_t*)(kparams().ws + WS_HB), (const bf16_t*)(kparams().ws + WS_WTOUT) + (size_t)l * DM * DM, TP, DM, DM};
            Epi2 E{l};
            pg8::gemm_phase<Epi2, pg8::StaticOrder, false>((PG8_LAS unsigned char*)shm, g, S, E, nullptr);
            for (int nb = bid; nb < 64; nb += G) g2_sample_item(kparams(), shf, l, nb);
        } else {
            p_final(kparams(), bid, G);
        }
        if (ph < 15) xcd_barrier(xb);
        }
    }
}

extern "C" void kernel_launch(void* const* d_in, const int* in_sizes, int n_in, void* d_out, int out_size, void* d_ws, size_t ws_size, hipStream_t stream) {
    static int grid_blocks = 0;
    if (grid_blocks == 0) {
        if (n_in != 25 || (size_t)out_size != O_END || ws_size < WS_END) {
            fprintf(stderr, "kernel_launch: unexpected shapes: n_in %d out_size %d ws_size %zu (need %zu)\n", n_in, out_size, ws_size, (size_t)WS_END);
            grid_blocks = -1; return;
        }
        if (hipFuncSetAttribute((const void*)fwd_kernel, hipFuncAttributeMaxDynamicSharedMemorySize, LDS_BYTES) != hipSuccess) { fprintf(stderr, "kernel_launch: hipFuncSetAttribute failed\n"); grid_blocks = -1; return; }
        int dev = 0, cus = 0, per_cu = 0;
        hipGetDevice(&dev);
        hipDeviceGetAttribute(&cus, hipDeviceAttributeMultiprocessorCount, dev);
        hipOccupancyMaxActiveBlocksPerMultiprocessor(&per_cu, (const void*)fwd_kernel, 512, LDS_BYTES);
        if (per_cu < 1) { fprintf(stderr, "kernel_launch: occupancy query gives %d blocks per CU\n", per_cu); per_cu = 1; }
        (void)hipGetLastError();
        grid_blocks = cus;
        if (grid_blocks < 192) { fprintf(stderr, "kernel_launch: only %d CUs\n", grid_blocks); grid_blocks = -1; return; }
    }
    if (grid_blocks < 0) return;
    if (hipMemsetAsync((unsigned char*)d_ws + WS_BAR, 0, 16384 + RFLAG_BYTES, stream) != hipSuccess) { fprintf(stderr, "kernel_launch: memset of the barrier words failed\n"); return; }
    Params p{};
    const float** pp = (const float**)&p;
    for (int i = 0; i < 25; ++i) pp[i] = (const float*)d_in[i];
    p.out = (float*)d_out; p.ws = (unsigned char*)d_ws; p.repk = REPK; p.repl = REPL;
    void* args[] = {&p};
    hipError_t e = hipLaunchCooperativeKernel((const void*)fwd_kernel, dim3(grid_blocks), dim3(512), args, LDS_BYTES, stream);
    if (e != hipSuccess) fprintf(stderr, "cooperative launch failed: %s (grid %d)\n", hipGetErrorString(e), grid_blocks);
}
```

```cpp
#include <hip/hip_runtime.h>
#include <hip/hip_cooperative_groups.h>
#include <cstdio>
namespace cg = cooperative_groups;
__device__ __forceinline__ int opq_tid() { int t = threadIdx.x; asm volatile("" : "+v"(t)); return t; }
__device__ __forceinline__ int opq_s(int x) { asm volatile("" : "+s"(x)); return x; }
typedef float cvt_f32x2 __attribute__((ext_vector_type(2)));
typedef __bf16 cvt_bf16x2 __attribute__((ext_vector_type(2)));
__device__ __forceinline__ unsigned hw_cvt_pk_bf16(float lo, float hi) { const cvt_f32x2 v = {lo, hi}; return __builtin_bit_cast(unsigned, __builtin_convertvector(v, cvt_bf16x2)); }
typedef unsigned sc1_v4u __attribute__((ext_vector_type(4)));
__device__ __forceinline__ void st_sc1_b128(void* p, unsigned a, unsigned b, unsigned c, unsigned d) { const sc1_v4u v = {a, b, c, d}; asm volatile("global_store_dwordx4 %0, %1, off sc0 sc1\n\ts_nop 2" :: "v"(p), "v"(v) : "memory"); }
__device__ __forceinline__ void st_sc1_b32(void* p, float v) { asm volatile("global_store_dword %0, %1, off sc0 sc1\n\ts_nop 2" :: "v"(p), "v"(v) : "memory"); }
namespace pg8 {
#define PG8_LAS __attribute__((address_space(3)))
typedef unsigned short bf16_t;
typedef short bf16x8 __attribute__((ext_vector_type(8)));
typedef float f32x4 __attribute__((ext_vector_type(4)));
typedef unsigned u32x4 __attribute__((ext_vector_type(4)));
constexpr int BM = 256, BK = 64, HALF = 128, HTB = HALF * BK * 2  , STAGE_BYTES = 8 * HTB, NXCD = 8, WGM = 8;

__host__ __device__ __forceinline__ int lds_byte(int r, int c) { const int st = (r >> 4) * 2 + (c >> 5), rr = r & 15, cc = c & 31, ob = rr * 64 + cc * 2; return st * 1024 + (ob ^ (((ob >> 9) & 1) << 5)); }
__host__ __device__ __forceinline__ void stage_rc(int b, int& R, int& C) { const int st = b / 1024, sb = b % 1024, swz = sb ^ (((sb >> 9) & 1) << 5); R = (st >> 1) * 16 + swz / 64; C = (st & 1) * 32 + (swz % 64) / 2; }
__host__ __device__ __forceinline__ int perm32(int rho) { const int n = rho >> 4, i = rho & 15; return 8 * (i >> 2) + 4 * n + (i & 3); }

struct Unit { int pm, pn; };
struct Gemm { const bf16_t* A; const bf16_t* Bt; int M, N, K; };

struct StaticOrder {
    int nM, nN, nwg, G, c;
    __host__ __device__ void init(int M, int N, int G_, int c_) { nM = M / BM; nN = N / BM; nwg = nM * nN; G = G_; c = c_; }
    __host__ __device__ bool next(int i, Unit& u) const {
        const long L = (long)i * G + c; if (L >= nwg) return false;
        int wgid = (int)L; { const int q = nwg / NXCD, r = nwg % NXCD, xcd = wgid % NXCD, off = wgid / NXCD; wgid = (xcd < r ? xcd * (q + 1) : r * (q + 1) + (xcd - r) * q) + off; }
        const int nig = WGM * nN, gid = wgid / nig, fm = gid * WGM, gsz = (nM - fm) < WGM ? (nM - fm) : WGM;
        u.pm = fm + ((wgid % nig) % gsz); u.pn = (wgid % nig) / gsz; return true;
    }
    __device__ __forceinline__ void a_ready(const Unit&) const {}
    __device__ __forceinline__ void done(const Unit&) const {}
};
template <class Epi, class Sched, bool STAMP = false>
__device__ __forceinline__ void gemm_phase(PG8_LAS unsigned char* lds, const Gemm g, const Sched& S, const Epi& E, unsigned long long* stamps) {
    const int tid = opq_tid(), wid = __builtin_amdgcn_readfirstlane(tid >> 6), lane = tid & 63, wr = wid >> 2, wc = wid & 3, fr = lane & 15, fq = lane >> 4;
    const int K = g.K, nt = K / BK;
    int ts_lo = 0, ts_hi = 0, nts = 0; const unsigned long long rt_entry = STAMP ? (unsigned long long)wall_clock64() : 0ull;
#define PG8_STAMP() do { if (STAMP && wid == 0 && nts < 64) { const unsigned long long _c = (unsigned long long)clock64(); \
        ts_lo = (lane == nts) ? (int)(unsigned)_c : ts_lo; ts_hi = (lane == nts) ? (int)(unsigned)(_c >> 32) : ts_hi; ++nts; } } while (0)
    PG8_STAMP();
    unsigned voffA[2], voffB[2];
#pragma unroll
    for (int i = 0; i < 2; ++i) { int R, C; stage_rc(tid * 16 + i * 8192, R, C); const int Rb = Epi::PERM ? ((R & ~31) + perm32(R & 31)) : R;
        voffA[i] = (unsigned)(R * K + C) * 2u; voffB[i] = (unsigned)(Rb * K + C) * 2u; }
    const size_t kstep = (size_t)(BK * 2);
    const size_t hstep = (size_t)HALF * K * 2;
    const size_t tstep = 2 * hstep;
    const unsigned ldsw = (unsigned)wid * 1024u;
    const int aoff = lds_byte(wr * 64 + fr, fq * 8), boff = lds_byte(wc * 32 + fr, fq * 8);
#define PG8_SA(b, h) (((b) * 2 + (h)) * HTB)
#define PG8_SB(b, h) ((4 + (b) * 2 + (h)) * HTB)
#define PG8_STAGE(bufoff, gbase, voff) do { _Pragma("unroll") for (int _i = 0; _i < 2; ++_i) \
        __builtin_amdgcn_global_load_lds((const unsigned*)((const char*)(gbase) + (voff)[_i]), (PG8_LAS unsigned*)(lds + (bufoff) + ldsw + _i * 8192), 16, 0, 0); } while (0)
#define PG8_LDA(dst, b, h) do { _Pragma("unroll") for (int m = 0; m < 4; ++m) _Pragma("unroll") for (int k = 0; k < 2; ++k) dst[m][k] = *(const PG8_LAS bf16x8*)(lds + PG8_SA(b, h) + aoff + m * 2048 + k * 1024); } while (0)
#define PG8_LDB(dst, b, h) do { _Pragma("unroll") for (int n = 0; n < 2; ++n) _Pragma("unroll") for (int k = 0; k < 2; ++k) dst[n][k] = *(const PG8_LAS bf16x8*)(lds + PG8_SB(b, h) + boff + n * 2048 + k * 1024); } while (0)
#define PG8_MMA(ai, bj, At, Bt) do { __builtin_amdgcn_s_setprio(1); _Pragma("unroll") for (int m = 0; m < 4; ++m) _Pragma("unroll") for (int n = 0; n < 2; ++n) _Pragma("unroll") for (int k = 0; k < 2; ++k) \
        acc[ai][bj][m][n] = __builtin_amdgcn_mfma_f32_16x16x32_bf16(Bt[n][k], At[m][k], acc[ai][bj][m][n], 0, 0, 0); __builtin_amdgcn_s_setprio(0); } while (0)
#define PG8_WAIT_V(n) asm volatile("s_waitcnt vmcnt(" #n ")" ::: "memory")
#define PG8_WAIT_L(n) asm volatile("s_waitcnt lgkmcnt(" #n ")" ::: "memory")
#define PG8_BAR __builtin_amdgcn_s_barrier()
#define PG8_SCHED __builtin_amdgcn_sched_barrier(0)
    Unit cur, nxt; int ui = 0;
    if (!S.next(0, cur)) return;
    f32x4 acc[2][2][4][2];
#pragma unroll
    for (int a = 0; a < 2; ++a)
#pragma unroll
        for (int b = 0; b < 2; ++b)
#pragma unroll
            for (int m = 0; m < 4; ++m)
#pragma unroll
                for (int n = 0; n < 2; ++n) acc[a][b][m][n] = (f32x4){0.f, 0.f, 0.f, 0.f};
    bf16x8 At[4][2], B0[2][2], B1[2][2];
    const char* cA = (const char*)g.A + (size_t)cur.pm * tstep; const char* cB = (const char*)g.Bt + (size_t)cur.pn * tstep;
    S.a_ready(cur);
    PG8_STAGE(PG8_SB(0, 0), cB, voffB); PG8_STAGE(PG8_SA(0, 0), cA, voffA); PG8_STAGE(PG8_SB(0, 1), cB + hstep, voffB); PG8_STAGE(PG8_SA(0, 1), cA + hstep, voffA);
    if (wr == 1) PG8_BAR;
    PG8_WAIT_V(4); PG8_BAR;
    PG8_STAGE(PG8_SB(1, 0), cB + kstep, voffB); PG8_STAGE(PG8_SA(1, 0), cA + kstep, voffA); PG8_STAGE(PG8_SB(1, 1), cB + hstep + kstep, voffB);
    PG8_WAIT_V(6); PG8_BAR;
    PG8_STAMP();
    for (;;) {
        const bool has_next = S.next(ui + 1, nxt);
        const char* nA = has_next ? (const char*)g.A + (size_t)nxt.pm * tstep : cA; const char* nB = has_next ? (const char*)g.Bt + (size_t)nxt.pn * tstep : cB;
        for (int t = 0; t < nt; t += 2) {
            const bool last = (t == nt - 2);
            const char* a1 = cA + (size_t)(t + 1) * kstep;
            const char* a2 = last ? nA : cA + (size_t)(t + 2) * kstep; const char* b2 = last ? nB : cB + (size_t)(t + 2) * kstep;
            const char* a3 = a2 + kstep; const char* b3 = b2 + kstep;
            if (last && has_next) S.a_ready(nxt);
            PG8_LDB(B0, 0, 0); PG8_SCHED; PG8_LDA(At, 0, 0); PG8_STAGE(PG8_SA(1, 1), a1 + hstep, voffA);
            PG8_WAIT_L(8); PG8_BAR; PG8_WAIT_L(0); PG8_MMA(0, 0, At, B0); PG8_BAR; PG8_SCHED;
            PG8_LDB(B1, 0, 1); PG8_STAGE(PG8_SB(0, 0), b2, voffB);
            PG8_BAR; PG8_WAIT_L(0); PG8_MMA(0, 1, At, B1); PG8_BAR;
            PG8_LDA(At, 0, 1); PG8_STAGE(PG8_SA(0, 0), a2, voffA);
            PG8_BAR; PG8_WAIT_L(0); PG8_MMA(1, 0, At, B0); PG8_BAR; PG8_SCHED;
            PG8_STAGE(PG8_SB(0, 1), b2 + hstep, voffB);
            PG8_WAIT_V(6); PG8_BAR; PG8_MMA(1, 1, At, B1); PG8_BAR;
            PG8_LDB(B0, 1, 0); PG8_SCHED; PG8_LDA(At, 1, 0); PG8_STAGE(PG8_SA(0, 1), a2 + hstep, voffA);
            PG8_WAIT_L(8); PG8_BAR; PG8_WAIT_L(0); PG8_MMA(0, 0, At, B0); PG8_BAR; PG8_SCHED;
            PG8_LDB(B1, 1, 1); PG8_STAGE(PG8_SB(1, 0), b3, voffB);
            PG8_BAR; PG8_WAIT_L(0); PG8_MMA(0, 1, At, B1); PG8_BAR;
            PG8_LDA(At, 1, 1); PG8_STAGE(PG8_SA(1, 0), a3, voffA);
            PG8_BAR; PG8_WAIT_L(0); PG8_MMA(1, 0, At, B0); PG8_BAR; PG8_SCHED;
            PG8_STAGE(PG8_SB(1, 1), b3 + hstep, voffB);
            PG8_WAIT_V(6); PG8_BAR; PG8_MMA(1, 1, At, B1); PG8_BAR;
        }
        PG8_STAMP();
        if constexpr (!Epi::AFTER_DRAIN) { E(acc, cur, wr, wc, fr, fq); S.done(cur); }
        PG8_STAMP();
        if (!has_next) break;
#pragma unroll
        for (int a = 0; a < 2; ++a)
#pragma unroll
            for (int b = 0; b < 2; ++b)
#pragma unroll
                for (int m = 0; m < 4; ++m)
#pragma unroll
                    for (int n = 0; n < 2; ++n) acc[a][b][m][n] = (f32x4){0.f, 0.f, 0.f, 0.f};
        cur = nxt; cA = nA; cB = nB; ++ui;
    }
    PG8_WAIT_V(0);
    if (wr == 0) PG8_BAR;
    PG8_BAR;
    if constexpr (Epi::AFTER_DRAIN) { E.fused(acc, cur, wr, wc, fr, fq, lds, wid, lane); S.done(cur); }
    PG8_STAMP();
    if (STAMP && wid == 0) { stamps[lane] = lane < nts ? (((unsigned long long)(unsigned)ts_hi << 32) | (unsigned)ts_lo) : 0ull;
        if (lane == 62) stamps[62] = rt_entry; if (lane == 63) stamps[63] = (unsigned long long)wall_clock64(); }
#undef PG8_STAMP
#undef PG8_SA
#undef PG8_SB
#undef PG8_STAGE
#undef PG8_LDA
#undef PG8_LDB
#undef PG8_MMA
#undef PG8_WAIT_V
#undef PG8_WAIT_L
#undef PG8_BAR
#undef PG8_SCHED
}
}

#define XB_TMO      128
#define XB_XCNT(j)  (256  + 64 * (j))
#define XB_XSUB(j)  (1280 + 64 * (j))
#define XB_XGEN(j)  (2304 + 64 * (j))
#define XB_TOP      3328
#define XB_TOPGEN   3392
#define XCD_BAR_WORDS 3456
#define XB_SPIN_CAP (1u << 18)
#define LAS __attribute__((address_space(3)))

__device__ __forceinline__ unsigned xb_ld(unsigned* p)              { return __hip_atomic_load(p, __ATOMIC_RELAXED, __HIP_MEMORY_SCOPE_AGENT); }
__device__ __forceinline__ unsigned xb_add(unsigned* p, unsigned v) { return __hip_atomic_fetch_add(p, v, __ATOMIC_RELAXED, __HIP_MEMORY_SCOPE_AGENT); }
__device__ __forceinline__ unsigned xb_xcc_id() { return (unsigned)__builtin_amdgcn_s_getreg((3 << 11) | 20) & 0xFu; }
#define XB_SPIN(cond, bar) do { unsigned _sp = 0; while (cond) { __builtin_amdgcn_s_sleep(1); \
    if ((++_sp & 255u) == 0u) { if (xb_ld(&(bar)[XB_TMO])) break; if (_sp > XB_SPIN_CAP) { atomicAdd(&(bar)[XB_TMO], 1u); break; } } } } while (0)

struct XcdBarrier {
    unsigned* bar; unsigned x;
    volatile LAS unsigned* st;
};

__device__ __forceinline__ XcdBarrier xcd_barrier_post(unsigned* bar, volatile LAS unsigned* st) {
    XcdBarrier b; b.bar = bar; b.x = xb_xcc_id(); b.st = st;
    if (threadIdx.x == 0) (void)xb_add(&bar[XB_XCNT(b.x)], 1u);
    return b;
}
__device__ __forceinline__ void xcd_barrier_complete(unsigned* bar, unsigned x, unsigned& nloc, unsigned& nx) {
    const unsigned G = gridDim.x * gridDim.y * gridDim.z;
    unsigned sum, cnt, mine, sp = 0u;
    for (;;) {
        sum = 0u; cnt = 0u; mine = 0u;
#pragma unroll
        for (unsigned j = 0; j < 16; ++j) { const unsigned c = xb_ld(&bar[XB_XCNT(j)]); sum += c; cnt += (c > 0u) ? 1u : 0u; mine = (j == x) ? c : mine; }
        if (sum == G) break;
        __builtin_amdgcn_s_sleep(1);
        if ((++sp & 255u) == 0u) { if (xb_ld(&bar[XB_TMO])) break; if (sp > XB_SPIN_CAP) { atomicAdd(&bar[XB_TMO], 1u); break; } }
    }
    nloc = mine > 0u ? mine : 1u; nx = cnt > 0u ? cnt : 1u;
}

__device__ __forceinline__ void xcd_barrier(const XcdBarrier& b) {
    asm volatile("s_waitcnt vmcnt(0)" ::: "memory");
    __syncthreads();
    if (threadIdx.x == 0) {
        unsigned* bar = b.bar;
        __builtin_amdgcn_s_waitcnt(0);
        unsigned nloc = b.st[0], nx = b.st[1];
        if (nloc == 0u) { xcd_barrier_complete(bar, b.x, nloc, nx); b.st[0] = nloc; b.st[1] = nx; }
        const unsigned old = xb_add(&bar[XB_XSUB(b.x)], 1u);
        const unsigned gen = old / nloc;
        if (old + 1u == (gen + 1u) * nloc) {
            __builtin_amdgcn_fence(__ATOMIC_RELEASE, "agent");
            asm volatile("s_waitcnt vmcnt(0)" ::: "memory");
            const unsigned og = xb_add(&bar[XB_TOP], 1u);
            const unsigned tg = og / nx;
            if (og + 1u == (tg + 1u) * nx) xb_add(&bar[XB_TOPGEN], 1u);
            else XB_SPIN(xb_ld(&bar[XB_TOPGEN]) == tg, bar);
            __builtin_amdgcn_fence(__ATOMIC_ACQUIRE, "agent");
            xb_add(&bar[XB_XGEN(b.x)], 1u);
            asm volatile("s_waitcnt vmcnt(0)" ::: "memory");
        } else {
            XB_SPIN(xb_ld(&bar[XB_XGEN(b.x)]) == gen, bar);
            __builtin_amdgcn_fence(__ATOMIC_ACQUIRE, "agent");
            asm volatile("s_waitcnt vmcnt(0)" ::: "memory");
        }
    }
    __syncthreads();
}

typedef unsigned short bf16_t;
typedef short bf16x8 __attribute__((ext_vector_type(8)));
typedef float f32x4 __attribute__((ext_vector_type(4)));
typedef float f32x16 __attribute__((ext_vector_type(16)));

constexpr int DM = 2048, SEQ = 4096, NBP = 2, NBS = 32, TP = NBP * SEQ, MT = TP + NBS, MP = 8448;
constexpr int INW = 6784, INWP = 6912, SHD = 3200, DEPTH = 2;
constexpr size_t NRI = (size_t)MT * 1024;
constexpr int LDS_BYTES = 131072 + 16;
constexpr size_t O_CKP = (size_t)MT * DM;
constexpr size_t O_CVP = O_CKP + (size_t)DEPTH * NBP * 128 * 256;
constexpr size_t O_WKVP = O_CVP + (size_t)DEPTH * NBP * 128 * 256;
constexpr size_t O_SHP = O_WKVP + (size_t)DEPTH * NBP * 16 * 4096;
constexpr size_t O_CKS = O_SHP + (size_t)DEPTH * NBP * SHD;
constexpr size_t O_CVS = O_CKS + (size_t)DEPTH * NBS * 128 * 256;
constexpr size_t O_WKVS = O_CVS + (size_t)DEPTH * NBS * 128 * 256;
constexpr size_t O_SHS = O_WKVS + (size_t)DEPTH * NBS * 16 * 4096;
constexpr size_t O_END = O_SHS + (size_t)DEPTH * NBS * SHD;
constexpr size_t al256(size_t x) { return (x + 255) & ~(size_t)255; }
constexpr size_t WS_WTIN = 0;
constexpr size_t WS_WTOUT = WS_WTIN + (size_t)INWP * DM * 2;
constexpr size_t WS_MOD = WS_WTOUT + (size_t)DEPTH * DM * DM * 2;
constexpr size_t WS_ROPE = WS_MOD + al256((size_t)DEPTH * 34 * 6144 * 4);
constexpr size_t WS_HB = WS_ROPE + al256((size_t)4097 * 16 * 4);
constexpr size_t WS_QB = WS_HB + (size_t)MP * DM * 2;
constexpr size_t WS_KB = WS_QB + (size_t)MP * 1024 * 2;
constexpr size_t WS_VB = WS_KB + (size_t)MP * 256 * 2;
constexpr size_t WS_RW = WS_VB + (size_t)MP * 256 * 2;
constexpr size_t WS_GT = WS_RW + (size_t)MP * SHD * 2;
constexpr size_t WS_VALL = WS_GT + (size_t)MP * DM * 2;
constexpr size_t SRI = (size_t)NBS * 1024;
constexpr size_t WS_RSB = WS_VALL + NRI * 2;
constexpr size_t WS_RSW = WS_RSB + 4 * SRI * 2;
constexpr size_t WS_YS = WS_RSW + SRI * 4;
constexpr size_t WS_REC = WS_YS + NRI * 4;
constexpr size_t WS_COEF = WS_REC + (size_t)32 * 256 * 14592;
constexpr size_t WS_TWAD = WS_COEF + al256((size_t)MT * 16 * 4);
constexpr size_t WS_WFRAG = WS_TWAD + (size_t)MT * 128 * 2;
constexpr size_t WS_BAR = WS_WFRAG + (size_t)DEPTH * 2 * 16 * 4 * 2 * 64 * 16;
constexpr size_t WS_RFLAG = WS_BAR + 16384;
constexpr size_t RFLAG_BYTES = (size_t)32 * 256 * 64;
constexpr size_t WS_END = WS_RFLAG + RFLAG_BYTES;

struct Params {
    const float *x_prompt, *x_sample, *cache_k, *cache_v, *state_wkv, *state_shift, *c_prompt, *c_sample, *norm_g, *w_ada, *b_ada, *w_in, *mu_shift, *w0, *w_decay, *a0,
        *w_iclr, *k_k, *k_a, *r_k, *ln_w, *ln_b, *sinks, *w_out, *final_g;
    float* out;
    unsigned char* ws;
    int repk, repl;
};
typedef const __attribute__((address_space(4))) Params* KParamsPtr;
__device__ __forceinline__ const Params& kparams() {
    KParamsPtr k = (KParamsPtr)__builtin_amdgcn_kernarg_segment_ptr();
    asm volatile("" : "+s"(k));
    return *(const Params*)k;
}

__device__ __forceinline__ unsigned short f2bf(float f) { return (unsigned short)(hw_cvt_pk_bf16(f, 0.f) & 0xffffu); }
__device__ __forceinline__ float bf2f(unsigned short b) { return __uint_as_float(((unsigned)b) << 16); }
__device__ __forceinline__ unsigned pack2(float lo, float hi) { return hw_cvt_pk_bf16(lo, hi); }
__device__ __forceinline__ float bflo(unsigned w) { return __uint_as_float(w << 16); }
__device__ __forceinline__ float bfhi(unsigned w) { return __uint_as_float(w & 0xffff0000u); }
__device__ __forceinline__ float silu_f(float x) { return x / (1.f + __expf(-x)); }
__device__ __forceinline__ float wave_sum(float x) {
#pragma unroll
    for (int o = 32; o >= 1; o >>= 1) x += __shfl_xor(x, o);
    return x;
}
__device__ __forceinline__ float wave_max(float x) {
#pragma unroll
    for (int o = 32; o >= 1; o >>= 1) x = fmaxf(x, __shfl_xor(x, o));
    return x;
}
template <int CTRL> __device__ __forceinline__ float dpp_f(float x) {
    return __builtin_bit_cast(float, __builtin_amdgcn_update_dpp(0, __builtin_bit_cast(int, x), CTRL, 0xF, 0xF, false));
}
__device__ __forceinline__ float allreduce16(float x) {
    x += dpp_f<0x128>(x);
    x += dpp_f<0x124>(x);
    x += dpp_f<0x122>(x);
    x += dpp_f<0x121>(x);
    return x;
}

__device__ void p0_mod_item(const Params& p, float* red, int l, int nc) {
    const int tid = opq_tid(), wv = tid >> 6, lane = tid & 63, n = lane & 31, kh = lane >> 5;
    f32x16 acc0, acc1;
#pragma unroll
    for (int i = 0; i < 16; ++i) { acc0[i] = 0.f; acc1[i] = 0.f; }
    const float* W = p.w_ada + (size_t)l * DM * 6144 + nc * 32 + n;
#pragma unroll 4
    for (int ks = 0; ks < 16; ++ks) {
        const int k0 = wv * 256 + ks * 16 + kh * 8;
        bf16x8 bfr, a0, a1;
#pragma unroll
        for (int j = 0; j < 8; ++j) bfr[j] = (short)f2bf(W[(size_t)(k0 + j) * 6144]);
        const float4* cs = (const float4*)(p.c_sample + (size_t)n * DM + k0);
        const float4 u0 = cs[0], u1 = cs[1];
        a0[0] = (short)f2bf(silu_f(u0.x)); a0[1] = (short)f2bf(silu_f(u0.y)); a0[2] = (short)f2bf(silu_f(u0.z)); a0[3] = (short)f2bf(silu_f(u0.w));
        a0[4] = (short)f2bf(silu_f(u1.x)); a0[5] = (short)f2bf(silu_f(u1.y)); a0[6] = (short)f2bf(silu_f(u1.z)); a0[7] = (short)f2bf(silu_f(u1.w));
        float4 q0 = make_float4(0.f, 0.f, 0.f, 0.f), q1 = q0;
        if (n < 2) { const float4* cp = (const float4*)(p.c_prompt + (size_t)n * DM + k0); q0 = cp[0]; q1 = cp[1]; }
        a1[0] = (short)f2bf(silu_f(q0.x)); a1[1] = (short)f2bf(silu_f(q0.y)); a1[2] = (short)f2bf(silu_f(q0.z)); a1[3] = (short)f2bf(silu_f(q0.w));
        a1[4] = (short)f2bf(silu_f(q1.x)); a1[5] = (short)f2bf(silu_f(q1.y)); a1[6] = (short)f2bf(silu_f(q1.z)); a1[7] = (short)f2bf(silu_f(q1.w));
        acc0 = __builtin_amdgcn_mfma_f32_32x32x16_bf16(a0, bfr, acc0, 0, 0, 0);
        acc1 = __builtin_amdgcn_mfma_f32_32x32x16_bf16(a1, bfr, acc1, 0, 0, 0);
    }
#pragma unroll
    for (int i = 0; i < 16; ++i) red[(wv * 18 + i) * 64 + lane] = acc0[i];
    red[(wv * 18 + 16) * 64 + lane] = acc1[0];
    red[(wv * 18 + 17) * 64 + lane] = acc1[1];
    __syncthreads();
    float* mod = (float*)(p.ws + WS_MOD);
    for (int o = tid; o < 34 * 32; o += 512) {
        const int row = o >> 5, col = o & 31;
        int ri, ln, mrow;
        if (row < 32) { const int khh = (row >> 2) & 1; ri = (row & 3) + 4 * (row >> 3); ln = col + 32 * khh; mrow = 2 + row; }
        else { ri = 16 + (row - 32); ln = col; mrow = row - 32; }
        float s = 0.f;
#pragma unroll
        for (int w = 0; w < 8; ++w) s += red[(w * 18 + ri) * 64 + ln];
        mod[((size_t)l * 34 + mrow) * 6144 + nc * 32 + col] = s + p.b_ada[l * 6144 + nc * 32 + col];
    }
    __syncthreads();
}

struct ConvIt { const float* src; bf16_t* dst; int N, k0, n0; };
__device__ __forceinline__ ConvIt conv_decode(const Params& p, int cidx, int lw) {
    ConvIt c;
    int kt, nt;
    if (cidx < 1728) { kt = cidx & 15; nt = cidx >> 4; c.N = INW; c.src = p.w_in + (size_t)lw * DM * INW; c.dst = (bf16_t*)(p.ws + WS_WTIN); }
    else { int rem = cidx - 1728; const int l2 = rem >> 9; rem &= 511; kt = rem & 15; nt = rem >> 4; c.N = DM; c.src = p.w_out + (size_t)l2 * DM * DM; c.dst = (bf16_t*)(p.ws + WS_WTOUT) + (size_t)l2 * DM * DM; }
    c.k0 = kt * 128; c.n0 = nt * 64;
    return c;
}
__device__ void p0_conv_all(const Params& p, float* s, int bid, int G, int total, int lw) {
    const int tid = opq_tid();
    const int lrow = tid >> 4, c4 = tid & 15, n = tid >> 3, kg = tid & 7;
    float4 v[4];
    int cidx = bid;
    ConvIt cur = conv_decode(p, cidx < total ? cidx : 0, lw);
    if (cidx < total) {
#pragma unroll
        for (int p4 = 0; p4 < 4; ++p4) { v[p4] = make_float4(0.f, 0.f, 0.f, 0.f); if (cur.n0 < cur.N) v[p4] = *(const float4*)(cur.src + (size_t)(cur.k0 + lrow + 32 * p4) * cur.N + cur.n0 + 4 * c4); }
    }
#pragma unroll 1
    while (cidx < total) {
#pragma unroll
        for (int p4 = 0; p4 < 4; ++p4) { float* d = s + (lrow + 32 * p4) * 65 + 4 * c4; d[0] = v[p4].x; d[1] = v[p4].y; d[2] = v[p4].z; d[3] = v[p4].w; }
        __syncthreads();
        const int nxt = cidx + G;
        const ConvIt nx = conv_decode(p, nxt < total ? nxt : 0, lw);
        if (nxt < total) {
#pragma unroll
            for (int p4 = 0; p4 < 4; ++p4) { v[p4] = make_float4(0.f, 0.f, 0.f, 0.f); if (nx.n0 < nx.N) v[p4] = *(const float4*)(nx.src + (size_t)(nx.k0 + lrow + 32 * p4) * nx.N + nx.n0 + 4 * c4); }
        }
        unsigned w[8];
#pragma unroll
        for (int j = 0; j < 8; ++j) w[j] = pack2(s[(kg * 16 + 2 * j) * 65 + n], s[(kg * 16 + 2 * j + 1) * 65 + n]);
        uint4* o = (uint4*)(cur.dst + (size_t)(cur.n0 + n) * DM + cur.k0 + kg * 16);
        o[0] = make_uint4(w[0], w[1], w[2], w[3]);
        o[1] = make_uint4(w[4], w[5], w[6], w[7]);
        __syncthreads();
        cur = nx; cidx = nxt;
    }
}

__device__ void p0_rope_item(const Params& p, int it) {
    float* rope = (float*)(p.ws + WS_ROPE);
#pragma unroll
    for (int q = 0; q < 4; ++q) {
        const int e = it * 2048 + q * 512 + opq_tid();
        if (e < 4097 * 8) {
            const int idx = e >> 3, i = e & 7;
            double invf = 1.0;
            for (int q = 0; q < i; ++q) invf *= 0.19392274474868576;
            const double pos = idx < 4096 ? (double)idx : 16384.0;
            const double rev = pos * invf * 0.15915494309189535;
            const float f = (float)(rev - floor(rev));
            rope[idx * 16 + i] = __builtin_amdgcn_cosf(f);
            rope[idx * 16 + 8 + i] = __builtin_amdgcn_sinf(f);
        }
    }
}

__device__ void p0_wfrag_item(const Params& p, int it) {
    const int e0 = it * 512 + opq_tid();
    const int lane = e0 & 63, ks = (e0 >> 6) & 1, ct = (e0 >> 7) & 3, hd = (e0 >> 9) & 15, mtx = (e0 >> 13) & 1, l = e0 >> 14;
    const float* W = (mtx == 0 ? p.w_decay : p.w_iclr) + (size_t)l * 64 * 1024 + hd * 64 + 16 * ct + (lane & 15);
    const int k0 = 32 * ks + 8 * (lane >> 4);
    float v[8];
#pragma unroll
    for (int e = 0; e < 8; ++e) v[e] = W[(size_t)(k0 + e) * 1024];
    ((uint4*)(p.ws + WS_WFRAG))[e0] = make_uint4(pack2(v[0], v[1]), pack2(v[2], v[3]), pack2(v[4], v[5]), pack2(v[6], v[7]));
}

__device__ void p1_norm(const Params& p, int l, int bid, int G) {
    const int tid = opq_tid(), wv = tid >> 6, lane = tid & 63;
    bf16_t* hb = (bf16_t*)(p.ws + WS_HB);
    const float* mod = (const float*)(p.ws + WS_MOD);
    const float4* g4 = (const float4*)(p.norm_g + l * DM);
    for (int r = bid * 8 + wv; r < MT; r += G * 8) {
        const float* xr = l == 0 ? (r < TP ? p.x_prompt + (size_t)r * DM : p.x_sample + (size_t)(r - TP) * DM) : p.out + (size_t)r * DM;
        const int mrow = r < TP ? (r >> 12) : 2 + (r - TP);
        const float* md = mod + ((size_t)l * 34 + mrow) * 6144;
        float4 v[8]; float ss = 0.f;
#pragma unroll
        for (int i = 0; i < 8; ++i) { v[i] = ((const float4*)xr)[lane + 64 * i]; ss += v[i].x * v[i].x + v[i].y * v[i].y + v[i].z * v[i].z + v[i].w * v[i].w; }
        ss = wave_sum(ss);
        const float rinv = rsqrtf(ss * (1.f / 2048.f) + 1e-5f);
#pragma unroll
        for (int i = 0; i < 8; ++i) {
            const int c4 = lane + 64 * i;
            const float4 g = g4[c4], sc = ((const float4*)(md + 2048))[c4], sh = ((const float4*)md)[c4];
            const float y0 = v[i].x * rinv * g.x * (1.f + sc.x) + sh.x, y1 = v[i].y * rinv * g.y * (1.f + sc.y) + sh.y;
            const float y2 = v[i].z * rinv * g.z * (1.f + sc.z) + sh.z, y3 = v[i].w * rinv * g.w * (1.f + sc.w) + sh.w;
            *(uint2*)(hb + (size_t)r * DM + 4 * c4) = make_uint2(pack2(y0, y1), pack2(y2, y3));
        }
    }
}

struct Epi1 {
    static constexpr bool PERM = false, AFTER_DRAIN = false;
    int l;
    __device__ __forceinline__ void operator()(const f32x4 (&acc)[2][2][4][2], const pg8::Unit& u, int wr, int wc, int fr, int fq) const {
        const Params& p = kparams();
        bf16_t* const qb = (bf16_t*)(p.ws + WS_QB); bf16_t* const kb = (bf16_t*)(p.ws + WS_KB); bf16_t* const vb = (bf16_t*)(p.ws + WS_VB);
        bf16_t* const rw = (bf16_t*)(p.ws + WS_RW); bf16_t* const gt = (bf16_t*)(p.ws + WS_GT); const float* const rope = (const float*)(p.ws + WS_ROPE); float* const out = p.out;
#pragma unroll
        for (int bj = 0; bj < 2; ++bj)
#pragma unroll
            for (int n = 0; n < 2; ++n) {
                const int cb = u.pn * 256 + bj * 128 + wc * 32 + n * 16;
                if (cb >= INW) continue;
                const int c = cb + 4 * fq;
                const bool do_rope = (cb < 1280) && ((cb & 63) == 0);
#pragma unroll
                for (int ai = 0; ai < 2; ++ai)
#pragma unroll
                    for (int m = 0; m < 4; ++m) {
                        const int rb = u.pm * 256 + ai * 128 + wr * 64 + m * 16;
                        if (rb >= MT) continue;
                        const int r = rb + fr;
                        f32x4 v = acc[ai][bj][m][n];
                        if (do_rope) {
                            const int idx = r < TP ? (r & 4095) : 4096;
                            const float4 cs = *(const float4*)(rope + idx * 16 + 4 * (fq & 1));
                            const float4 sn = *(const float4*)(rope + idx * 16 + 8 + 4 * (fq & 1));
                            const float p0 = __shfl_xor(v[0], 32), p1 = __shfl_xor(v[1], 32), p2 = __shfl_xor(v[2], 32), p3 = __shfl_xor(v[3], 32);
                            const float sg = fq < 2 ? -1.f : 1.f;
                            v[0] = v[0] * cs.x + sg * p0 * sn.x; v[1] = v[1] * cs.y + sg * p1 * sn.y; v[2] = v[2] * cs.z + sg * p2 * sn.z; v[3] = v[3] * cs.w + sg * p3 * sn.w;
                        }
                        if (cb < 1024) {
                            *(uint2*)(qb + (size_t)r * 1024 + c) = make_uint2(pack2(v[0] * 0.125f, v[1] * 0.125f), pack2(v[2] * 0.125f, v[3] * 0.125f));
                        } else if (cb < 1536) {
                            const bool isk = cb < 1280;
                            const int cc = c - (isk ? 1024 : 1280);
                            *(uint2*)((isk ? kb : vb) + (size_t)r * 256 + cc) = make_uint2(pack2(v[0], v[1]), pack2(v[2], v[3]));
                            if (r >= TP) {
                                *(f32x4*)(out + (isk ? O_CKS : O_CVS) + ((size_t)(l * NBS + (r - TP)) * 128 + 127) * 256 + cc) = v;
                            } else if ((r & 4095) >= SEQ - 128) {
                                *(f32x4*)(out + (isk ? O_CKP : O_CVP) + ((size_t)(l * NBP + (r >> 12)) * 128 + ((r & 4095) - (SEQ - 128))) * 256 + cc) = v;
                            }
                        } else if (cb < 4736) {
                            const int cc = c - 1536;
                            *(uint2*)(rw + (size_t)r * SHD + cc) = make_uint2(pack2(v[0], v[1]), pack2(v[2], v[3]));
                            if (r >= TP) *(f32x4*)(out + O_SHS + (size_t)(l * NBS + (r - TP)) * SHD + cc) = v;
                            else if ((r & 4095) == SEQ - 1) *(f32x4*)(out + O_SHP + (size_t)(l * NBP + (r >> 12)) * SHD + cc) = v;
                        } else {
                            const int cc = c - 4736;
                            *(uint2*)(gt + (size_t)r * DM + cc) = make_uint2(pack2(silu_f(v[0]), silu_f(v[1])), pack2(silu_f(v[2]), silu_f(v[3])));
                        }
                    }
            }
    }
};

struct Epi2 {
    static constexpr bool PERM = false, AFTER_DRAIN = false;
    int l;
    __device__ __forceinline__ void operator()(const f32x4 (&acc)[2][2][4][2], const pg8::Unit& u, int wr, int wc, int fr, int fq) const {
        const Params& p = kparams();
        float* const out = p.out;
        const int rb0 = u.pm * 256;
        const int mrow = rb0 < TP ? (rb0 >> 12) : 2;
        const float* gr = (const float*)(p.ws + WS_MOD) + ((size_t)l * 34 + mrow) * 6144 + 4096 + u.pn * 256 + wc * 32 + 4 * fq;
        f32x4 g4[2][2];
#pragma unroll
        for (int bj = 0; bj < 2; ++bj)
#pragma unroll
            for (int n = 0; n < 2; ++n) g4[bj][n] = *(const f32x4*)(gr + bj * 128 + n * 16);
        const float* xbase = l == 0 ? p.x_prompt : out;
        const int c0 = u.pn * 256 + wc * 32 + 4 * fq;
#pragma unroll
        for (int ai = 0; ai < 2; ++ai)
#pragma unroll
            for (int mh = 0; mh < 2; ++mh) {
                f32x4 x4[2][2][2];
#pragma unroll
                for (int mm = 0; mm < 2; ++mm) {
                    const int r = rb0 + ai * 128 + wr * 64 + (2 * mh + mm) * 16 + fr;
                    const float* xo = xbase + (size_t)r * DM + c0;
#pragma unroll
                    for (int bj = 0; bj < 2; ++bj)
#pragma unroll
                        for (int n = 0; n < 2; ++n) x4[mm][bj][n] = *(const f32x4*)(xo + bj * 128 + n * 16);
                }
                __builtin_amdgcn_sched_barrier(0);
#pragma unroll
                for (int mm = 0; mm < 2; ++mm) {
                    const int r = rb0 + ai * 128 + wr * 64 + (2 * mh + mm) * 16 + fr;
                    float* yo = out + (size_t)r * DM + c0;
#pragma unroll
                    for (int bj = 0; bj < 2; ++bj)
#pragma unroll
                        for (int n = 0; n < 2; ++n) *(f32x4*)(yo + bj * 128 + n * 16) = x4[mm][bj][n] + g4[bj][n] * acc[ai][bj][2 * mh + mm][n];
                }
                __builtin_amdgcn_sched_barrier(0);
            }
    }
};

__device__ void g2_sample_item(const Params& p, float* red, int l, int nb) {
    const int tid = opq_tid(), wv = tid >> 6, lane = tid & 63, n = lane & 31, h = lane >> 5;
    const bf16_t* A = (const bf16_t*)(p.ws + WS_HB) + (size_t)TP * DM;
    const bf16_t* Bt = (const bf16_t*)(p.ws + WS_WTOUT) + (size_t)l * DM * DM + (size_t)(nb * 32) * DM;
    f32x16 acc;
#pragma unroll
    for (int i = 0; i < 16; ++i) acc[i] = 0.f;
#pragma unroll 4
    for (int ks = 0; ks < 16; ++ks) {
        const int k0 = wv * 256 + ks * 16 + 8 * h;
        const bf16x8 a = *(const bf16x8*)(A + (size_t)n * DM + k0);
        const bf16x8 bq = *(const bf16x8*)(Bt + (size_t)n * DM + k0);
        acc = __builtin_amdgcn_mfma_f32_32x32x16_bf16(a, bq, acc, 0, 0, 0);
    }
#pragma unroll
    for (int i = 0; i < 16; ++i) red[(wv * 16 + i) * 64 + lane] = acc[i];
    __syncthreads();
    const float* mod = (const float*)(p.ws + WS_MOD) + (size_t)l * 34 * 6144;
    for (int o = tid; o < 1024; o += 512) {
        const int row = o >> 5, col = o & 31, hh = (row >> 2) & 1, ri = (row & 3) + 4 * (row >> 3), ln = col + 32 * hh;
        float s = 0.f;
#pragma unroll
        for (int w = 0; w < 8; ++w) s += red[(w * 16 + ri) * 64 + ln];
        const int c = nb * 32 + col;
        const float gate = mod[(size_t)(2 + row) * 6144 + 4096 + c];
        const float xo = l == 0 ? p.x_sample[(size_t)row * DM + c] : p.out[(size_t)(TP + row) * DM + c];
        p.out[(size_t)(TP + row) * DM + c] = xo + gate * s;
    }
    __syncthreads();
}

__device__ void p3_attn_unit(const Params& p, unsigned char* lds, int l, int unit) {
    const int tid = opq_tid(), wv = tid >> 6, lane = tid & 63;
    const int b = unit >> 7, n = (unit >> 2) & 31, g = unit & 3;
    bf16_t* Ks = (bf16_t*)lds;
    bf16_t* Vt = (bf16_t*)(lds + 36864);
    const bf16_t* qb = (const bf16_t*)(p.ws + WS_QB);
    const bf16_t* kb = (const bf16_t*)(p.ws + WS_KB);
    const bf16_t* vb = (const bf16_t*)(p.ws + WS_VB);
    const bf16_t* gt = (const bf16_t*)(p.ws + WS_GT);
    bf16_t* cc = (bf16_t*)(p.ws + WS_HB);
    {
        uint4 kv4[4], vv4[4];
#pragma unroll
        for (int i = 0; i < 4; ++i) {
            const int chunk = tid + 512 * i, kl = chunk >> 3, dc = chunk & 7, kp = 128 * (n - 1) + kl;
            kv4[i] = make_uint4(0u, 0u, 0u, 0u); vv4[i] = kv4[i];
            if (kp >= 0) { const size_t row = (size_t)b * SEQ + kp; kv4[i] = *(const uint4*)(kb + row * 256 + g * 64 + dc * 8); vv4[i] = *(const uint4*)(vb + row * 256 + g * 64 + dc * 8); }
        }
        __builtin_amdgcn_sched_barrier(0);
#pragma unroll
        for (int i = 0; i < 4; ++i) {
            const int chunk = tid + 512 * i, kl = chunk >> 3, dc = chunk & 7;
            *(uint4*)(Ks + kl * 72 + dc * 8) = kv4[i];
            bf16_t* vd = Vt + (dc * 8) * 264 + kl;
            vd[0 * 264] = (bf16_t)(vv4[i].x & 0xffffu); vd[1 * 264] = (bf16_t)(vv4[i].x >> 16);
            vd[2 * 264] = (bf16_t)(vv4[i].y & 0xffffu); vd[3 * 264] = (bf16_t)(vv4[i].y >> 16);
            vd[4 * 264] = (bf16_t)(vv4[i].z & 0xffffu); vd[5 * 264] = (bf16_t)(vv4[i].z >> 16);
            vd[6 * 264] = (bf16_t)(vv4[i].w & 0xffffu); vd[7 * 264] = (bf16_t)(vv4[i].w >> 16);
        }
    }
    __syncthreads();
    const int hq = 4 * g + (wv >> 1), qh = wv & 1, q32 = lane & 31, h = lane >> 5;
    const float sink = p.sinks[l * 16 + hq];
#pragma unroll 1
    for (int s = 0; s < 2; ++s) {
        const int qp = 128 * n + 64 * qh + 32 * s + q32;
        const size_t qrow = (size_t)b * SEQ + qp;
        const int klb0 = 64 * qh + 32 * s;
        bf16x8 qf[4];
#pragma unroll
        for (int ks = 0; ks < 4; ++ks) qf[ks] = *(const bf16x8*)(qb + qrow * 1024 + hq * 64 + ks * 16 + 8 * h);
        f32x16 S[5];
#pragma unroll
        for (int kt = 0; kt < 5; ++kt) {
#pragma unroll
            for (int i = 0; i < 16; ++i) S[kt][i] = 0.f;
#pragma unroll
            for (int ks = 0; ks < 4; ++ks) {
                const bf16x8 a = *(const bf16x8*)(Ks + (klb0 + 32 * kt + q32) * 72 + ks * 16 + 8 * h);
                S[kt] = __builtin_amdgcn_mfma_f32_32x32x16_bf16(a, qf[ks], S[kt], 0, 0, 0);
            }
        }
        float mx = -1e30f;
#pragma unroll
        for (int kt = 0; kt < 5; ++kt)
#pragma unroll
            for (int i = 0; i < 16; ++i) {
                const int m = 8 * (i >> 2) + 4 * h + (i & 3);
                const int kp = 128 * (n - 1) + klb0 + 32 * kt + m;
                const int rel = qp - kp;
                const bool ok = (rel >= 0) && (rel <= 128) && (kp >= 0);
                const float sv = ok ? S[kt][i] : -1e30f;
                S[kt][i] = sv; mx = fmaxf(mx, sv);
            }
        mx = fmaxf(mx, __shfl_xor(mx, 32));
        mx = fmaxf(mx, sink);
        float sum = 0.f;
#pragma unroll
        for (int kt = 0; kt < 5; ++kt)
#pragma unroll
            for (int i = 0; i < 16; ++i) { const float e = __expf(S[kt][i] - mx); S[kt][i] = e; sum += e; }
        sum += __shfl_xor(sum, 32);
        const float inv = 1.f / (sum + __expf(sink - mx));
        f32x16 O[2];
#pragma unroll
        for (int i = 0; i < 16; ++i) { O[0][i] = 0.f; O[1][i] = 0.f; }
#pragma unroll
        for (int kt = 0; kt < 5; ++kt)
#pragma unroll
            for (int sp = 0; sp < 2; ++sp) {
                bf16x8 pf;
#pragma unroll
                for (int j = 0; j < 8; ++j) pf[j] = (short)f2bf(S[kt][8 * sp + j]);
#pragma unroll
                for (int dt = 0; dt < 2; ++dt) {
                    const bf16_t* vp = Vt + (32 * dt + q32) * 264 + klb0 + 32 * kt + 16 * sp + 4 * h;
                    const uint2 lo = *(const uint2*)vp, hi = *(const uint2*)(vp + 8);
                    const uint4 av = make_uint4(lo.x, lo.y, hi.x, hi.y);
                    O[dt] = __builtin_amdgcn_mfma_f32_32x32x16_bf16(__builtin_bit_cast(bf16x8, av), pf, O[dt], 0, 0, 0);
                }
            }
        uint2 gq[2][4];
#pragma unroll
        for (int dt = 0; dt < 2; ++dt)
#pragma unroll
            for (int ig = 0; ig < 4; ++ig) gq[dt][ig] = *(const uint2*)(gt + qrow * DM + hq * 64 + 32 * dt + 8 * ig + 4 * h);
        __builtin_amdgcn_sched_barrier(0);
#pragma unroll
        for (int dt = 0; dt < 2; ++dt)
#pragma unroll
            for (int ig = 0; ig < 4; ++ig) {
                const int col = hq * 64 + 32 * dt + 8 * ig + 4 * h;
                const uint2 gg = gq[dt][ig];
                const float o0 = O[dt][4 * ig + 0] * inv * bflo(gg.x), o1 = O[dt][4 * ig + 1] * inv * bfhi(gg.x);
                const float o2 = O[dt][4 * ig + 2] * inv * bflo(gg.y), o3 = O[dt][4 * ig + 3] * inv * bfhi(gg.y);
                *(uint2*)(cc + qrow * DM + col) = make_uint2(pack2(o0, o1), pack2(o2, o3));
            }
    }
    __syncthreads();
}

__device__ void p3_sattn_item(const Params& p, float* lds, int l, int item) {
    const int tid = opq_tid(), wv = tid >> 6, lane = tid & 63;
    float* pl = lds + wv * 128;
    const int w = item * 8 + wv, bd = w >> 4, hq = w & 15, g = hq >> 2;
    const size_t row = (size_t)TP + bd;
    const bf16_t* qb = (const bf16_t*)(p.ws + WS_QB);
    const bf16_t* gt = (const bf16_t*)(p.ws + WS_GT);
    bf16_t* cc = (bf16_t*)(p.ws + WS_HB);
    float q[64];
#pragma unroll
    for (int c = 0; c < 8; ++c) {
        const uint4 u = *(const uint4*)(qb + row * 1024 + hq * 64 + c * 8);
        q[c * 8 + 0] = bflo(u.x); q[c * 8 + 1] = bfhi(u.x); q[c * 8 + 2] = bflo(u.y); q[c * 8 + 3] = bfhi(u.y);
        q[c * 8 + 4] = bflo(u.z); q[c * 8 + 5] = bfhi(u.z); q[c * 8 + 6] = bflo(u.w); q[c * 8 + 7] = bfhi(u.w);
    }
    const size_t cbase = ((size_t)(l * NBS + bd) * 128) * 256 + g * 64;
    const float* ck = p.cache_k + cbase;
    const float* cv = p.cache_v + cbase;
    float* nk = p.out + O_CKS + cbase;
    float* nv = p.out + O_CVS + cbase;
    float s0 = 0.f, s1 = 0.f, s2 = 0.f;
#pragma unroll
    for (int c = 0; c < 16; ++c) {
        const float4 a = ((const float4*)(ck + (size_t)lane * 256))[c];
        const float4 bq = ((const float4*)(ck + (size_t)(lane + 64) * 256))[c];
        const float4 e = ((const float4*)(nk + (size_t)127 * 256))[c];
        s0 += a.x * q[4 * c] + a.y * q[4 * c + 1] + a.z * q[4 * c + 2] + a.w * q[4 * c + 3];
        s1 += bq.x * q[4 * c] + bq.y * q[4 * c + 1] + bq.z * q[4 * c + 2] + bq.w * q[4 * c + 3];
        s2 += e.x * q[4 * c] + e.y * q[4 * c + 1] + e.z * q[4 * c + 2] + e.w * q[4 * c + 3];
    }
    const float sink = p.sinks[l * 16 + hq];
    const float mx = fmaxf(wave_max(fmaxf(s0, s1)), fmaxf(s2, sink));
    const float p0 = __expf(s0 - mx), p1 = __expf(s1 - mx), p2 = __expf(s2 - mx);
    const float sum = wave_sum(p0 + p1) + p2 + __expf(sink - mx);
    pl[lane] = p0; pl[lane + 64] = p1;
    __builtin_amdgcn_fence(__ATOMIC_RELEASE, "wavefront");
    __builtin_amdgcn_wave_barrier();
    __builtin_amdgcn_fence(__ATOMIC_ACQUIRE, "wavefront");
    float o = 0.f;
#pragma unroll 32
    for (int key = 0; key < 128; ++key) o += pl[key] * cv[(size_t)key * 256 + lane];
    o += p2 * nv[(size_t)127 * 256 + lane];
    o /= sum;
    const float gate = bf2f(gt[row * DM + hq * 64 + lane]);
    cc[row * DM + hq * 64 + lane] = f2bf(o * gate);
    {
        float tk[32], tv[32];
#pragma unroll
        for (int i = 0; i < 32; ++i) {
            const int ww = (hq & 3) + 4 * i;
            tk[i] = ck[(size_t)(ww + 1 < 128 ? ww + 1 : 127) * 256 + lane]; tv[i] = cv[(size_t)(ww + 1 < 128 ? ww + 1 : 127) * 256 + lane];
        }
#pragma unroll
        for (int i = 0; i < 32; ++i) {
            const int ww = (hq & 3) + 4 * i;
            if (ww < 127) { nk[(size_t)ww * 256 + lane] = tk[i]; nv[(size_t)ww * 256 + lane] = tv[i]; }
        }
    }
    __builtin_amdgcn_wave_barrier();
}

__device__ __forceinline__ float mix_val(const bf16_t* rw, const float* sshift, const float* mu, int r, int c) {
    const float cur = bf2f(rw[(size_t)r * SHD + c]);
    float prev;
    if (r >= TP) prev = sshift[(size_t)(r - TP) * SHD + c];
    else if ((r & 4095) == 0) prev = 0.f;
    else prev = bf2f(rw[(size_t)(r - 1) * SHD + c]);
    return cur + (prev - cur) * mu[c];
}

__device__ __forceinline__ float4 mix4(const bf16_t* rw, const float* sshift, int r, int c, float4 mu4) {
    const uint2 cu = *(const uint2*)(rw + (size_t)r * SHD + c);
    const float4 cur = make_float4(bflo(cu.x), bfhi(cu.x), bflo(cu.y), bfhi(cu.y));
    float4 prev = make_float4(0.f, 0.f, 0.f, 0.f);
    if (r >= TP) prev = *(const float4*)(sshift + (size_t)(r - TP) * SHD + c);
    else if ((r & 4095) != 0) { const uint2 pu = *(const uint2*)(rw + (size_t)(r - 1) * SHD + c); prev = make_float4(bflo(pu.x), bfhi(pu.x), bflo(pu.y), bfhi(pu.y)); }
    return make_float4(cur.x + (prev.x - cur.x) * mu4.x, cur.y + (prev.y - cur.y) * mu4.y, cur.z + (prev.z - cur.z) * mu4.z, cur.w + (prev.w - cur.w) * mu4.w);
}
__device__ __forceinline__ float decay_of(float x) {
    const float z = -x;
    const float sp = fmaxf(z, 0.f) + __logf(1.f + __expf(-fabsf(z)));
    return __expf(-__expf(-sp - 0.5f));
}

__device__ void p3_twad_item(const Params& p, int l, int tile) {
    const int tid = opq_tid();
    const bf16_t* rw = (const bf16_t*)(p.ws + WS_RW);
    const float* sshift = p.state_shift + (size_t)l * NBS * SHD;
    const float* mu = p.mu_shift + l * SHD;
    bf16_t* TWAD = (bf16_t*)(p.ws + WS_TWAD);
    const int r0 = tile * 32;
    float mm[8];
#pragma unroll
    for (int i = 0; i < 8; ++i) { const int idx = tid + 512 * i, tt = idx >> 7, c2 = idx & 127; mm[i] = mix_val(rw, sshift, mu, r0 + tt, 3072 + c2); }
#pragma unroll
    for (int i = 0; i < 8; ++i) {
        const int idx = tid + 512 * i, tt = idx >> 7, c2 = idx & 127;
        float o = mm[i];
        if (c2 < 64) { const float e = __expf(2.f * mm[i]); o = 1.f - 2.f / (e + 1.f); }
        TWAD[(size_t)(r0 + tt) * 128 + c2] = f2bf(o);
    }
}

__device__ void p3_prep_tile(const Params& p, unsigned char* lds, int l, int tile) {
    const int tid = opq_tid(), wv = tid >> 6, lane = tid & 63, n = lane & 31, h = lane >> 5;
    bf16_t* TW = (bf16_t*)lds;
    bf16_t* AD = TW + 32 * 72;
    const bf16_t* rw = (const bf16_t*)(p.ws + WS_RW);
    const float* sshift = p.state_shift + (size_t)l * NBS * SHD;
    const float* mu = p.mu_shift + l * SHD;
    bf16_t* RSB = (bf16_t*)(p.ws + WS_RSB);
    bf16_t* VALL = (bf16_t*)(p.ws + WS_VALL);
    float* RSW = (float*)(p.ws + WS_RSW);
    float* coef = (float*)(p.ws + WS_COEF);
    const int r0 = tile * 32;
    {
        float mm[8];
#pragma unroll
        for (int i = 0; i < 8; ++i) { const int idx = tid + 512 * i, tt = idx >> 7, c2 = idx & 127; mm[i] = mix_val(rw, sshift, mu, r0 + tt, 3072 + c2); }
        __builtin_amdgcn_sched_barrier(0);
#pragma unroll
        for (int i = 0; i < 8; ++i) {
            const int idx = tid + 512 * i, tt = idx >> 7, c2 = idx & 127;
            if (c2 < 64) { const float e = __expf(2.f * mm[i]); TW[tt * 72 + c2] = f2bf(1.f - 2.f / (e + 1.f)); }
            else AD[tt * 72 + (c2 - 64)] = f2bf(mm[i]);
        }
    }
    __syncthreads();
    const int col0 = wv * 128 + 4 * n;
    f32x16 acc[4];
    {
        const float* wp = p.w_decay + (size_t)l * 64 * 1024 + col0;
#pragma unroll
        for (int nt = 0; nt < 4; ++nt)
#pragma unroll
            for (int i = 0; i < 16; ++i) acc[nt][i] = 0.f;
#pragma unroll
        for (int ks = 0; ks < 4; ++ks) {
            const bf16x8 a = *(const bf16x8*)(TW + n * 72 + 16 * ks + 8 * h);
            float4 w4[8];
#pragma unroll
            for (int e = 0; e < 8; ++e) w4[e] = *(const float4*)(wp + (size_t)(16 * ks + 8 * h + e) * 1024);
            bf16x8 b0, b1, b2, b3;
#pragma unroll
            for (int e = 0; e < 8; ++e) { b0[e] = (short)f2bf(w4[e].x); b1[e] = (short)f2bf(w4[e].y); b2[e] = (short)f2bf(w4[e].z); b3[e] = (short)f2bf(w4[e].w); }
            acc[0] = __builtin_amdgcn_mfma_f32_32x32x16_bf16(a, b0, acc[0], 0, 0, 0);
            acc[1] = __builtin_amdgcn_mfma_f32_32x32x16_bf16(a, b1, acc[1], 0, 0, 0);
            acc[2] = __builtin_amdgcn_mfma_f32_32x32x16_bf16(a, b2, acc[2], 0, 0, 0);
            acc[3] = __builtin_amdgcn_mfma_f32_32x32x16_bf16(a, b3, acc[3], 0, 0, 0);
        }
        const float4 w0c = *(const float4*)(p.w0 + l * 1024 + col0);
#pragma unroll
        for (int r = 0; r < 16; ++r) {
            const int row = r0 + 8 * (r >> 2) + 4 * h + (r & 3);
            *(float4*)(RSW + (size_t)(row - TP) * 1024 + col0) =
                make_float4(decay_of(w0c.x + acc[0][r]), decay_of(w0c.y + acc[1][r]), decay_of(w0c.z + acc[2][r]), decay_of(w0c.w + acc[3][r]));
        }
    }
    {
        const float* wp = p.w_iclr + (size_t)l * 64 * 1024 + col0;
#pragma unroll
        for (int nt = 0; nt < 4; ++nt)
#pragma unroll
            for (int i = 0; i < 16; ++i) acc[nt][i] = 0.f;
#pragma unroll
        for (int ks = 0; ks < 4; ++ks) {
            const bf16x8 a = *(const bf16x8*)(AD + n * 72 + 16 * ks + 8 * h);
            float4 w4[8];
#pragma unroll
            for (int e = 0; e < 8; ++e) w4[e] = *(const float4*)(wp + (size_t)(16 * ks + 8 * h + e) * 1024);
            bf16x8 b0, b1, b2, b3;
#pragma unroll
            for (int e = 0; e < 8; ++e) { b0[e] = (short)f2bf(w4[e].x); b1[e] = (short)f2bf(w4[e].y); b2[e] = (short)f2bf(w4[e].z); b3[e] = (short)f2bf(w4[e].w); }
            acc[0] = __builtin_amdgcn_mfma_f32_32x32x16_bf16(a, b0, acc[0], 0, 0, 0);
            acc[1] = __builtin_amdgcn_mfma_f32_32x32x16_bf16(a, b1, acc[1], 0, 0, 0);
            acc[2] = __builtin_amdgcn_mfma_f32_32x32x16_bf16(a, b2, acc[2], 0, 0, 0);
            acc[3] = __builtin_amdgcn_mfma_f32_32x32x16_bf16(a, b3, acc[3], 0, 0, 0);
        }
    }
    const float4 a0c = *(const float4*)(p.a0 + l * 1024 + col0), kkc = *(const float4*)(p.k_k + l * 1024 + col0), kac = *(const float4*)(p.k_a + l * 1024 + col0), rkc = *(const float4*)(p.r_k + l * 1024 + col0);
    const float4 mur = *(const float4*)(mu + col0), muk = *(const float4*)(mu + 1024 + col0), muv = *(const float4*)(mu + 2048 + col0);
    const int head = 2 * wv + (n >> 4);
#pragma unroll
    for (int g4 = 0; g4 < 4; ++g4) {
        float4 rr4[4], kr4[4], vr4[4];
#pragma unroll
        for (int q = 0; q < 4; ++q) {
            const int row = r0 + 8 * g4 + 4 * h + q;
            rr4[q] = mix4(rw, sshift, row, col0, mur); kr4[q] = mix4(rw, sshift, row, 1024 + col0, muk); vr4[q] = mix4(rw, sshift, row, 2048 + col0, muv);
        }
        __builtin_amdgcn_sched_barrier(0);
#pragma unroll
        for (int q = 0; q < 4; ++q) {
            const int r = 4 * g4 + q;
            const int row = r0 + 8 * g4 + 4 * h + q;
            const float4 rr = rr4[q], kr = kr4[q], vr = vr4[q];
            const float ax = 1.f / (1.f + __expf(-(a0c.x + acc[0][r]))), ay = 1.f / (1.f + __expf(-(a0c.y + acc[1][r])));
            const float az = 1.f / (1.f + __expf(-(a0c.z + acc[2][r]))), aw = 1.f / (1.f + __expf(-(a0c.w + acc[3][r])));
            const float k0 = kr.x * kkc.x, k1 = kr.y * kkc.y, k2 = kr.z * kkc.z, k3 = kr.w * kkc.w;
            const float ss = allreduce16(k0 * k0 + k1 * k1 + k2 * k2 + k3 * k3);
            const float inv = 1.f / fmaxf(sqrtf(ss), 1e-12f);
            const float4 kk = make_float4(k0 * inv, k1 * inv, k2 * inv, k3 * inv);
            const float4 ke = make_float4(kr.x * (1.f + (ax - 1.f) * kac.x), kr.y * (1.f + (ay - 1.f) * kac.y), kr.z * (1.f + (az - 1.f) * kac.z), kr.w * (1.f + (aw - 1.f) * kac.w));
            const float cf = allreduce16(rr.x * ke.x * rkc.x + rr.y * ke.y * rkc.y + rr.z * ke.z * rkc.z + rr.w * ke.w * rkc.w);
            if ((n & 15) == 0) coef[(size_t)row * 16 + head] = cf;
            const size_t o = (size_t)row * 1024 + col0;
            const size_t os = (size_t)(row - TP) * 1024 + col0;
            *(uint2*)(RSB + os) = make_uint2(pack2(rr.x, rr.y), pack2(rr.z, rr.w));
            *(uint2*)(RSB + SRI + os) = make_uint2(pack2(ke.x, ke.y), pack2(ke.z, ke.w));
            *(uint2*)(RSB + 2 * SRI + os) = make_uint2(pack2(kk.x, kk.y), pack2(kk.z, kk.w));
            *(uint2*)(RSB + 3 * SRI + os) = make_uint2(pack2(kk.x * ax, kk.y * ay), pack2(kk.z * az, kk.w * aw));
            *(uint2*)(VALL + o) = make_uint2(pack2(vr.x, vr.y), pack2(vr.z, vr.w));
        }
        __builtin_amdgcn_sched_barrier(0);
    }
    __syncthreads();
}

constexpr int REC_BYTES = 14592;
constexpr int PA_WLDS = 16384;
typedef float f32x4v __attribute__((ext_vector_type(4)));

__device__ void pa_chunk(const Params& p, unsigned char* wl, int l, int ct) {
    const int lane = opq_tid() & 63;
    const int hh = ct >> 8, c = ct & 255, b = hh >> 4, h = hh & 15;
    const size_t row0 = (size_t)b * SEQ + 16 * c;
    const int col = h * 64 + lane;
    bf16_t* VALL = (bf16_t*)(p.ws + WS_VALL);
    float vv[16];
    float gC;
    bf16_t* S_AB = (bf16_t*)wl; bf16_t* S_BB = S_AB + 16 * 72; bf16_t* S_KB = S_BB + 16 * 72; bf16_t* S_RT = S_KB + 16 * 72;
    {
        const bf16_t* rw = (const bf16_t*)(p.ws + WS_RW);
        const bf16_t* TWAD = (const bf16_t*)(p.ws + WS_TWAD);
        const uint4* WFd = (const uint4*)(p.ws + WS_WFRAG) + (size_t)((l * 2 + 0) * 16 + h) * 512 + lane;
        const uint4* WFi = (const uint4*)(p.ws + WS_WFRAG) + (size_t)((l * 2 + 1) * 16 + h) * 512 + lane;
        unsigned xr[17], xk[17], xv[17];
        const bool first = (row0 & 4095) == 0;
#pragma unroll
        for (int t = 0; t < 17; ++t) {
            const unsigned ro = (unsigned)(row0 + t - 1) * (unsigned)SHD + (unsigned)col;
            if (t == 0 && first) { xr[0] = 0u; xk[0] = 0u; xv[0] = 0u; }
            else { xr[t] = rw[ro]; xk[t] = rw[ro + 1024u]; xv[t] = rw[ro + 2048u]; }
        }
        const int rr = lane & 15, kg = lane >> 4;
        f32x4v Dd[4], Da[4];
#pragma unroll
        for (int ct = 0; ct < 4; ++ct) { Dd[ct] = (f32x4v){0.f, 0.f, 0.f, 0.f}; Da[ct] = Dd[ct]; }
#pragma unroll
        for (int ks = 0; ks < 2; ++ks) {
            const bf16x8 atw = *(const bf16x8*)(TWAD + (size_t)(row0 + rr) * 128 + 32 * ks + 8 * kg);
            const bf16x8 aad = *(const bf16x8*)(TWAD + (size_t)(row0 + rr) * 128 + 64 + 32 * ks + 8 * kg);
#pragma unroll
            for (int ct = 0; ct < 4; ++ct) {
                const bf16x8 bd = __builtin_bit_cast(bf16x8, WFd[(ct * 2 + ks) * 64]);
                const bf16x8 bi = __builtin_bit_cast(bf16x8, WFi[(ct * 2 + ks) * 64]);
                Dd[ct] = __builtin_amdgcn_mfma_f32_16x16x32_bf16(atw, bd, Dd[ct], 0, 0, 0);
                Da[ct] = __builtin_amdgcn_mfma_f32_16x16x32_bf16(aad, bi, Da[ct], 0, 0, 0);
            }
        }
        float* LD = (float*)wl; float* LA = LD + 1024;
#pragma unroll
        for (int ct = 0; ct < 4; ++ct)
#pragma unroll
            for (int rg = 0; rg < 4; ++rg) { LD[(4 * kg + rg) * 64 + 16 * ct + rr] = Dd[ct][rg]; LA[(4 * kg + rg) * 64 + 16 * ct + rr] = Da[ct][rg]; }
        __builtin_amdgcn_fence(__ATOMIC_RELEASE, "wavefront"); __builtin_amdgcn_wave_barrier(); __builtin_amdgcn_fence(__ATOMIC_ACQUIRE, "wavefront");
        float din[16], ain[16];
#pragma unroll
        for (int t = 0; t < 16; ++t) { din[t] = LD[t * 64 + lane]; ain[t] = LA[t * 64 + lane]; }
        __builtin_amdgcn_fence(__ATOMIC_RELEASE, "wavefront"); __builtin_amdgcn_wave_barrier(); __builtin_amdgcn_fence(__ATOMIC_ACQUIRE, "wavefront");
        const float mur = p.mu_shift[l * SHD + col], muk = p.mu_shift[l * SHD + 1024 + col], muv = p.mu_shift[l * SHD + 2048 + col];
        const float w0c = p.w0[l * 1024 + col], a0c = p.a0[l * 1024 + col], kkc = p.k_k[l * 1024 + col], kac = p.k_a[l * 1024 + col], rkc = p.r_k[l * 1024 + col];
        float* coef = (float*)(p.ws + WS_COEF);
        float g = 1.f;
#pragma unroll
        for (int t = 0; t < 16; ++t) {
            const float cr = bf2f((unsigned short)xr[t + 1]), pr = bf2f((unsigned short)xr[t]), ck = bf2f((unsigned short)xk[t + 1]), pk = bf2f((unsigned short)xk[t]);
            const float cv = bf2f((unsigned short)xv[t + 1]), pv = bf2f((unsigned short)xv[t]);
            const float r_ = cr + (pr - cr) * mur, kr = ck + (pk - ck) * muk, vr = cv + (pv - cv) * muv;
            const float a = 1.f / (1.f + __expf(-(a0c + ain[t])));
            const float dec = decay_of(w0c + din[t]);
            const float kkr = kr * kkc;
            float ss = allreduce16(kkr * kkr); ss += __shfl_xor(ss, 16); ss += __shfl_xor(ss, 32);
            const float kkv = kkr / fmaxf(sqrtf(ss), 1e-12f);
            const float ke = kr * (1.f + (a - 1.f) * kac);
            float cf = allreduce16(r_ * ke * rkc); cf += __shfl_xor(cf, 16); cf += __shfl_xor(cf, 32);
            if (lane == 0) coef[(size_t)(row0 + t) * 16 + h] = cf;
            VALL[(unsigned)(row0 + t) * 1024u + (unsigned)col] = f2bf(vr);
            vv[t] = vr;
            S_AB[t * 72 + lane] = f2bf(-g * kkv);
            g *= dec;
            const float ig = __builtin_amdgcn_rcpf(g);
            S_BB[t * 72 + lane] = f2bf(kkv * a * ig); S_KB[t * 72 + lane] = f2bf(ke * ig); S_RT[t * 72 + lane] = f2bf(g * r_);
        }
        gC = g;
    }
    __builtin_amdgcn_fence(__ATOMIC_RELEASE, "wavefront"); __builtin_amdgcn_wave_barrier(); __builtin_amdgcn_fence(__ATOMIC_ACQUIRE, "wavefront");
    f32x4v Gab = {0.f, 0.f, 0.f, 0.f}, Gak = Gab, Grb = Gab, Grk = Gab;
    {
        const int rr = lane & 15, kg = lane >> 4;
#pragma unroll
        for (int ks = 0; ks < 2; ++ks) {
            const int o = rr * 72 + 32 * ks + 8 * kg;
            const bf16x8 fA = *(const bf16x8*)(S_AB + o), fB = *(const bf16x8*)(S_BB + o), fK = *(const bf16x8*)(S_KB + o), fR = *(const bf16x8*)(S_RT + o);
            Gab = __builtin_amdgcn_mfma_f32_16x16x32_bf16(fB, fA, Gab, 0, 0, 0);
            Gak = __builtin_amdgcn_mfma_f32_16x16x32_bf16(fK, fA, Gak, 0, 0, 0);
            Grb = __builtin_amdgcn_mfma_f32_16x16x32_bf16(fB, fR, Grb, 0, 0, 0);
            Grk = __builtin_amdgcn_mfma_f32_16x16x32_bf16(fK, fR, Grk, 0, 0, 0);
        }
    }
    __builtin_amdgcn_fence(__ATOMIC_RELEASE, "wavefront"); __builtin_amdgcn_wave_barrier(); __builtin_amdgcn_fence(__ATOMIC_ACQUIRE, "wavefront");
    float* M_AB = (float*)(wl + 9216); float* M_AK = M_AB + 256; float* M_RB = M_AK + 256; float* M_RK = M_RB + 256; float* T_ = M_RK + 256; float* Q_ = T_ + 256; float* W2_ = Q_ + 256;
    {
        const int t = lane & 15, kg = lane >> 4;
#pragma unroll
        for (int rg = 0; rg < 4; ++rg) {
            const int s = 4 * kg + rg;
            M_AB[s * 16 + t] = s < t ? Gab[rg] : 0.f; M_AK[s * 16 + t] = s < t ? Gak[rg] : 0.f;
            M_RB[s * 16 + t] = s <= t ? Grb[rg] : 0.f; M_RK[s * 16 + t] = s <= t ? Grk[rg] : 0.f;
        }
    }
    __builtin_amdgcn_fence(__ATOMIC_RELEASE, "wavefront"); __builtin_amdgcn_wave_barrier(); __builtin_amdgcn_fence(__ATOMIC_ACQUIRE, "wavefront");
    {
        const int rr = lane & 15;
        float Tr[16];
#pragma unroll
        for (int t = 0; t < 16; ++t) {
            float acc = (rr == t) ? 1.f : 0.f;
#pragma unroll
            for (int s = 0; s < t; ++s) acc += Tr[s] * M_AB[s * 16 + t];
            Tr[t] = acc;
        }
#pragma unroll
        for (int t = 0; t < 16; ++t) T_[rr * 16 + t] = Tr[t];
    }
    __builtin_amdgcn_fence(__ATOMIC_RELEASE, "wavefront"); __builtin_amdgcn_wave_barrier(); __builtin_amdgcn_fence(__ATOMIC_ACQUIRE, "wavefront");
    {
        const int s = lane & 15, tq = lane >> 4;
        float4 q = make_float4(0.f, 0.f, 0.f, 0.f);
#pragma unroll
        for (int u = 0; u < 16; ++u) { const float a = M_AK[s * 16 + u]; const float4 t4 = *(const float4*)(T_ + u * 16 + 4 * tq); q.x += a * t4.x; q.y += a * t4.y; q.z += a * t4.z; q.w += a * t4.w; }
        *(float4*)(Q_ + s * 16 + 4 * tq) = q;
        __builtin_amdgcn_fence(__ATOMIC_RELEASE, "wavefront"); __builtin_amdgcn_wave_barrier(); __builtin_amdgcn_fence(__ATOMIC_ACQUIRE, "wavefront");
        float4 w2 = *(const float4*)(M_RK + s * 16 + 4 * tq);
#pragma unroll
        for (int u = 0; u < 16; ++u) { const float a = Q_[s * 16 + u]; const float4 m4 = *(const float4*)(M_RB + u * 16 + 4 * tq); w2.x += a * m4.x; w2.y += a * m4.y; w2.z += a * m4.z; w2.w += a * m4.w; }
        *(float4*)(W2_ + s * 16 + 4 * tq) = w2;
    }
    __builtin_amdgcn_fence(__ATOMIC_RELEASE, "wavefront"); __builtin_amdgcn_wave_barrier(); __builtin_amdgcn_fence(__ATOMIC_ACQUIRE, "wavefront");
    cvt_f32x2 pt2[8], r22[8], ul2[8], yl2[8];
#pragma unroll
    for (int t = 0; t < 8; ++t) { pt2[t] = (cvt_f32x2){0.f, 0.f}; r22[t] = (cvt_f32x2){bf2f(S_RT[(2 * t) * 72 + lane]), bf2f(S_RT[(2 * t + 1) * 72 + lane])}; ul2[t] = pt2[t]; yl2[t] = pt2[t]; }
#pragma unroll
    for (int s = 0; s < 16; ++s) {
        const float as_ = bf2f(S_AB[s * 72 + lane]), vs_ = vv[s];
        const cvt_f32x2 as2 = {as_, as_}, vs2 = {vs_, vs_};
#pragma unroll
        for (int tq = 0; tq < 4; ++tq) {
            const float4 t4 = *(const float4*)(T_ + s * 16 + 4 * tq), q4 = *(const float4*)(Q_ + s * 16 + 4 * tq), w4 = *(const float4*)(W2_ + s * 16 + 4 * tq);
            pt2[2 * tq] += (cvt_f32x2){t4.x, t4.y} * as2; pt2[2 * tq + 1] += (cvt_f32x2){t4.z, t4.w} * as2;
            ul2[2 * tq] += (cvt_f32x2){q4.x, q4.y} * vs2; ul2[2 * tq + 1] += (cvt_f32x2){q4.z, q4.w} * vs2;
            yl2[2 * tq] += (cvt_f32x2){w4.x, w4.y} * vs2; yl2[2 * tq + 1] += (cvt_f32x2){w4.z, w4.w} * vs2;
        }
        __builtin_amdgcn_sched_barrier(0);
    }
    float pt[16], ul[16], yl[16];
#pragma unroll
    for (int t = 0; t < 8; ++t) { pt[2 * t] = pt2[t].x; pt[2 * t + 1] = pt2[t].y; ul[2 * t] = ul2[t].x; ul[2 * t + 1] = ul2[t].y; yl[2 * t] = yl2[t].x; yl[2 * t + 1] = yl2[t].y; }
#pragma unroll
    for (int s = 0; s < 16; ++s) {
        const cvt_f32x2 ps2 = {pt[s], pt[s]};
#pragma unroll
        for (int tq = 0; tq < 4; ++tq) {
            const float4 m4 = *(const float4*)(M_RB + s * 16 + 4 * tq);
            r22[2 * tq] += (cvt_f32x2){m4.x, m4.y} * ps2; r22[2 * tq + 1] += (cvt_f32x2){m4.z, m4.w} * ps2;
        }
        __builtin_amdgcn_sched_barrier(0);
    }
    float r2[16];
#pragma unroll
    for (int t = 0; t < 8; ++t) { r2[2 * t] = r22[t].x; r2[2 * t + 1] = r22[t].y; }
    unsigned char* rec = p.ws + WS_REC + (size_t)ct * REC_BYTES;
    float* ys = (float*)(p.ws + WS_YS);
    {
#pragma unroll
        for (int t = 0; t < 16; ++t) { S_AB[t * 72 + lane] = f2bf(pt[t]); S_RT[t * 72 + lane] = f2bf(r2[t]); }
        __builtin_amdgcn_fence(__ATOMIC_RELEASE, "wavefront"); __builtin_amdgcn_wave_barrier(); __builtin_amdgcn_fence(__ATOMIC_ACQUIRE, "wavefront");
#pragma unroll
        for (int i2 = 0; i2 < 2; ++i2) {
            const int q = lane + 64 * i2, f = q >> 5, hf = (q >> 4) & 1, t = q & 15;
            const uint2 a0 = *(const uint2*)(S_AB + t * 72 + 16 * f + 4 * hf), a1 = *(const uint2*)(S_AB + t * 72 + 16 * f + 8 + 4 * hf);
            const uint2 c0 = *(const uint2*)(S_RT + t * 72 + 16 * f + 4 * hf), c1 = *(const uint2*)(S_RT + t * 72 + 16 * f + 8 + 4 * hf);
            st_sc1_b128(rec + q * 16, a0.x, a0.y, a1.x, a1.y);
            st_sc1_b128(rec + 2048 + q * 16, c0.x, c0.y, c1.x, c1.y);
        }
        {
            float* YT = (float*)(wl + 9216);
#pragma unroll
            for (int t = 0; t < 16; ++t) YT[t * 64 + lane] = yl[t];
            __builtin_amdgcn_fence(__ATOMIC_RELEASE, "wavefront"); __builtin_amdgcn_wave_barrier(); __builtin_amdgcn_fence(__ATOMIC_ACQUIRE, "wavefront");
#pragma unroll
            for (int i4 = 0; i4 < 4; ++i4) {
                const int idx = lane + 64 * i4, t = idx >> 4, q4 = idx & 15;
                const float4 y4 = *(const float4*)(YT + t * 64 + 4 * q4);
                st_sc1_b128(ys + (unsigned)(row0 + t) * 1024u + (unsigned)(h * 64 + 4 * q4), __float_as_uint(y4.x), __float_as_uint(y4.y), __float_as_uint(y4.z), __float_as_uint(y4.w));
            }
        }
    }
    {
        float gb[16], gk[16];
#pragma unroll
        for (int t = 0; t < 16; ++t) { gb[t] = gC * bf2f(S_BB[t * 72 + lane]); gk[t] = gC * bf2f(S_KB[t * 72 + lane]); }
        st_sc1_b128(rec + 4096 + lane * 16, pack2(gb[0], gb[1]), pack2(gb[2], gb[3]), pack2(gb[8], gb[9]), pack2(gb[10], gb[11]));
        st_sc1_b128(rec + 4096 + (64 + lane) * 16, pack2(gb[4], gb[5]), pack2(gb[6], gb[7]), pack2(gb[12], gb[13]), pack2(gb[14], gb[15]));
        st_sc1_b128(rec + 6144 + lane * 16, pack2(gk[0], gk[1]), pack2(gk[2], gk[3]), pack2(gk[4], gk[5]), pack2(gk[6], gk[7]));
        st_sc1_b128(rec + 6144 + (64 + lane) * 16, pack2(gk[8], gk[9]), pack2(gk[10], gk[11]), pack2(gk[12], gk[13]), pack2(gk[14], gk[15]));
        st_sc1_b32(rec + 8192 + lane * 4, gC);
        unsigned char* ip = rec + 8448 + (lane >> 5) * 3072;
        const int il = lane & 31;
        st_sc1_b128(ip + il * 16, pack2(vv[0], vv[1]), pack2(vv[2], vv[3]), pack2(vv[4], vv[5]), pack2(vv[6], vv[7]));
        st_sc1_b128(ip + (32 + il) * 16, pack2(vv[8], vv[9]), pack2(vv[10], vv[11]), pack2(vv[12], vv[13]), pack2(vv[14], vv[15]));
#pragma unroll
        for (int tq = 0; tq < 4; ++tq) st_sc1_b128(ip + 1024 + (((tq >> 1) * 2 + (tq & 1)) * 32 + il) * 16, __float_as_uint(ul[4 * tq]), __float_as_uint(ul[4 * tq + 1]), __float_as_uint(ul[4 * tq + 2]), __float_as_uint(ul[4 * tq + 3]));
    }
    asm volatile("s_waitcnt vmcnt(0)" ::: "memory");
    if (lane == 0) __hip_atomic_store((unsigned*)(p.ws + WS_RFLAG + (size_t)ct * 64), (unsigned)(l + 1), __ATOMIC_RELAXED, __HIP_MEMORY_SCOPE_AGENT);
    __builtin_amdgcn_fence(__ATOMIC_RELEASE, "wavefront"); __builtin_amdgcn_wave_barrier();
}

__device__ void pa_sample_task(const Params& p, int l, int task) {
    const int lane = opq_tid() & 63;
    const int bd = task >> 8, h = (task >> 4) & 15, wq = task & 15;
    const int irow = 4 * wq + (lane >> 4), jq = lane & 15;
    const size_t row = (size_t)TP + bd;
    const bf16_t* RSB = (const bf16_t*)(p.ws + WS_RSB);
    const float* RSW = (const float*)(p.ws + WS_RSW);
    const bf16_t* VALL = (const bf16_t*)(p.ws + WS_VALL);
    float* ys = (float*)(p.ws + WS_YS);
    const size_t so = (((size_t)(l * NBS + bd) * 16 + h) * 64 + irow) * 64 + 4 * jq;
    float4 s = *(const float4*)(p.state_wkv + so);
    const size_t o = row * 1024 + h * 64 + 4 * jq;
    const size_t os = (size_t)bd * 1024 + h * 64 + 4 * jq;
    const uint2 ur = *(const uint2*)(RSB + os), uk = *(const uint2*)(RSB + SRI + os), ukk = *(const uint2*)(RSB + 2 * SRI + os), ub = *(const uint2*)(RSB + 3 * SRI + os);
    const float4 w4 = *(const float4*)(RSW + os);
    const float v = bf2f(VALL[row * 1024 + h * 64 + irow]);
    float pa = s.x * bflo(ukk.x) + s.y * bfhi(ukk.x) + s.z * bflo(ukk.y) + s.w * bfhi(ukk.y);
    pa = allreduce16(pa);
    const float sa = -pa;
    s.x = fmaf(sa, bflo(ub.x), fmaf(s.x, w4.x, v * bflo(uk.x)));
    s.y = fmaf(sa, bfhi(ub.x), fmaf(s.y, w4.y, v * bfhi(uk.x)));
    s.z = fmaf(sa, bflo(ub.y), fmaf(s.z, w4.z, v * bflo(uk.y)));
    s.w = fmaf(sa, bfhi(ub.y), fmaf(s.w, w4.w, v * bfhi(uk.y)));
    float py = s.x * bflo(ur.x) + s.y * bfhi(ur.x) + s.z * bflo(ur.y) + s.w * bfhi(ur.y);
    py = allreduce16(py);
    *(float4*)(p.out + O_WKVS + so) = s;
    if (jq == 0) ys[row * 1024 + h * 64 + irow] = py;
}

__device__ __forceinline__ uint4 ld_sc1_b128(const unsigned char* p) {
    const unsigned long long a = __hip_atomic_load((const unsigned long long*)p, __ATOMIC_RELAXED, __HIP_MEMORY_SCOPE_AGENT), c = __hip_atomic_load((const unsigned long long*)(p + 8), __ATOMIC_RELAXED, __HIP_MEMORY_SCOPE_AGENT);
    return make_uint4((unsigned)a, (unsigned)(a >> 32), (unsigned)c, (unsigned)(c >> 32));
}
constexpr int PB_NB = 8, PB_SLOT = 13568, PB_NCH = SEQ / 16, PB_NX = 4, PB_XOFF = PB_NB * PB_SLOT  , PB_FOFF = PB_XOFF + PB_NX * 4096;
__device__ void pb_head(const Params& p, unsigned char* lds, int l, int blk, bool dry) {
    const int tid = opq_tid(), wv = tid >> 6, lane = tid & 63;
    const int hh = blk >> 1, it = blk & 1, b = hh >> 4, h = hh & 15;
    volatile LAS unsigned* flags = (volatile LAS unsigned*)((LAS unsigned char*)lds + PB_FOFF);
    if (tid < 16) flags[tid] = 0u;
    __syncthreads();
    const unsigned char* rec0 = p.ws + WS_REC + (size_t)(hh * 256) * REC_BYTES;
    float* ys = (float*)(p.ws + WS_YS) + ((size_t)b * SEQ) * 1024 + h * 64 + 32 * it;
    const int q32 = lane & 31, hf = lane >> 5;
    if (wv >= 2) {
        unsigned nf = __hip_atomic_load((const unsigned*)(p.ws + WS_RFLAG + (size_t)(hh * 256 + (wv - 2)) * 64), __ATOMIC_RELAXED, __HIP_MEMORY_SCOPE_AGENT);
#pragma unroll 1
        for (int c = wv - 2; c < PB_NCH; c += 6) {
            while (c - (int)flags[8] >= PB_NB || c - (int)flags[9] >= PB_NB) __builtin_amdgcn_s_sleep(1);
            asm volatile("" ::: "memory");
            {
                const unsigned* rf = (const unsigned*)(p.ws + WS_RFLAG + (size_t)(hh * 256 + c) * 64);
                while (nf != (unsigned)(l + 1)) { __builtin_amdgcn_s_sleep(2); nf = __hip_atomic_load(rf, __ATOMIC_RELAXED, __HIP_MEMORY_SCOPE_AGENT); }
                asm volatile("" ::: "memory");
            }
            const unsigned char* rec = rec0 + (size_t)c * REC_BYTES;
            unsigned char* sl = lds + (c % PB_NB) * PB_SLOT;
            const unsigned char* rc = rec + lane * 16;
            const unsigned char* ri = rec + 8448 + it * 3072 + lane * 16;
#define LD_SC1(p_) ld_sc1_b128((const unsigned char*)(p_))
            const uint4 d0 = LD_SC1(rc), d1 = LD_SC1(rc + 1024), d2 = LD_SC1(rc + 2048), d3 = LD_SC1(rc + 3072);
            const uint4 d4 = LD_SC1(rc + 4096), d5 = LD_SC1(rc + 5120), d6 = LD_SC1(rc + 6144), d7 = LD_SC1(rc + 7168);
            const uint4 d8 = LD_SC1(rec + 8192 + (lane & 15) * 16);
            const uint4 d9 = LD_SC1(ri), d10 = LD_SC1(ri + 1024), d11 = LD_SC1(ri + 2048);
            const int t0 = lane >> 3, cc = lane & 7;
            const uint4 d12 = LD_SC1(ys + (size_t)(16 * c + t0) * 1024 + cc * 4), d13 = LD_SC1(ys + (size_t)(16 * c + 8 + t0) * 1024 + cc * 4);
#undef LD_SC1
            nf = (c + 6 < PB_NCH) ? __hip_atomic_load((const unsigned*)(p.ws + WS_RFLAG + (size_t)(hh * 256 + c + 6) * 64), __ATOMIC_RELAXED, __HIP_MEMORY_SCOPE_AGENT) : 0u;
            __builtin_amdgcn_sched_barrier(0);
            unsigned char* sd = sl + lane * 16;
            *(uint4*)(sd) = d0; *(uint4*)(sd + 1024) = d1; *(uint4*)(sd + 2048) = d2; *(uint4*)(sd + 3072) = d3;
            *(uint4*)(sd + 4096) = d4; *(uint4*)(sd + 5120) = d5; *(uint4*)(sd + 6144) = d6; *(uint4*)(sd + 7168) = d7;
            if (lane < 16) *(uint4*)(sl + 8192 + lane * 16) = d8;
            *(uint4*)(sd + 8448) = d9; *(uint4*)(sd + 9472) = d10; *(uint4*)(sd + 10496) = d11;
            {
                float* yd = (float*)(sl + 11520) + ((((t0 >> 2) & 1) * 32 + 4 * cc) * 4 + (t0 & 3));
                yd[0] = __uint_as_float(d12.x); yd[4] = __uint_as_float(d12.y); yd[8] = __uint_as_float(d12.z); yd[12] = __uint_as_float(d12.w);
                yd[256] = __uint_as_float(d13.x); yd[260] = __uint_as_float(d13.y); yd[264] = __uint_as_float(d13.z); yd[268] = __uint_as_float(d13.w);
            }
            asm volatile("" ::: "memory");
            if (lane == 0) flags[c % PB_NB] = (unsigned)(c + 1);
        }
    } else if (wv == 1) {
        bf16x8 ra0, ra1, ra2, ra3; float4 y0, y1;
#define PB_FETCHY(c_) do { const unsigned char* sl_ = lds + ((c_) % PB_NB) * PB_SLOT; \
            while (flags[(c_) % PB_NB] != (unsigned)((c_) + 1)) __builtin_amdgcn_s_sleep(0); \
            asm volatile("" ::: "memory"); \
            const unsigned char* pr_ = sl_ + 2048 + (hf * 16 + (q32 & 15)) * 16; \
            ra0 = *(const bf16x8*)(pr_); ra1 = *(const bf16x8*)(pr_ + 512); ra2 = *(const bf16x8*)(pr_ + 1024); ra3 = *(const bf16x8*)(pr_ + 1536); \
            y0 = *(const float4*)(sl_ + 11520 + (hf * 32 + q32) * 16); y1 = *(const float4*)(sl_ + 11520 + ((2 + hf) * 32 + q32) * 16); \
            asm volatile("" ::: "memory"); \
            if (lane == 0) flags[9] = (unsigned)((c_) + 1); } while (0)
        PB_FETCHY(0);
#pragma unroll 1
        for (int c = 0; c < PB_NCH; ++c) {
            const unsigned char* xr = lds + PB_XOFF + (c % PB_NX) * 4096 + lane * 16;
            f32x16 Ya, Yb;
            Ya[0] = y0.x; Ya[1] = y0.y; Ya[2] = y0.z; Ya[3] = y0.w; Ya[4] = y1.x; Ya[5] = y1.y; Ya[6] = y1.z; Ya[7] = y1.w;
#pragma unroll
            for (int r = 8; r < 16; ++r) Ya[r] = 0.f;
#pragma unroll
            for (int r = 0; r < 16; ++r) Yb[r] = 0.f;
            const bf16x8 rc0 = ra0, rc1 = ra1, rc2 = ra2, rc3 = ra3;
            while (flags[10 + (c % PB_NX)] != (unsigned)(c + 1)) __builtin_amdgcn_s_sleep(0);
            asm volatile("" ::: "memory");
            const bf16x8 xf0 = *(const bf16x8*)(xr), xf1 = *(const bf16x8*)(xr + 1024), xf2 = *(const bf16x8*)(xr + 2048), xf3 = *(const bf16x8*)(xr + 3072);
            asm volatile("" ::: "memory");
            if (lane == 0) flags[14] = (unsigned)(c + 1);
            Ya = __builtin_amdgcn_mfma_f32_32x32x16_bf16(rc0, xf0, Ya, 0, 0, 0);
            Yb = __builtin_amdgcn_mfma_f32_32x32x16_bf16(rc1, xf1, Yb, 0, 0, 0);
            Ya = __builtin_amdgcn_mfma_f32_32x32x16_bf16(rc2, xf2, Ya, 0, 0, 0);
            Yb = __builtin_amdgcn_mfma_f32_32x32x16_bf16(rc3, xf3, Yb, 0, 0, 0);
            if (c + 1 < PB_NCH) PB_FETCHY(c + 1);
            float* yc = ys + (size_t)c * (16 * 1024);
            if (!dry) {
#pragma unroll
                for (int r = 0; r < 8; ++r) yc[(8 * (r >> 2) + 4 * hf + (r & 3)) * 1024 + q32] = Ya[r] + Yb[r];
            }
        }
#undef PB_FETCHY
    } else {
        f32x16 X0, X1;
#pragma unroll
        for (int i = 0; i < 16; ++i) { X0[i] = 0.f; X1[i] = 0.f; }
        bf16x8 pa0, pa1, pa2, pa3, gb0, gb1, gk0, gk1, vf;
        float4 gm0, gm1, gm2, gm3, gm4, gm5, gm6, gm7, u0, u1;
#define PB_FETCH(c_) do { const unsigned char* sl_ = lds + ((c_) % PB_NB) * PB_SLOT; \
            { unsigned rv_ = rdy; while (rv_ != (unsigned)((c_) + 1)) { __builtin_amdgcn_s_sleep(0); rv_ = flags[(c_) % PB_NB]; } } \
            asm volatile("" ::: "memory"); \
            const unsigned char* pr_ = sl_ + (hf * 16 + (q32 & 15)) * 16; \
            pa0 = *(const bf16x8*)(pr_); pa1 = *(const bf16x8*)(pr_ + 512); pa2 = *(const bf16x8*)(pr_ + 1024); pa3 = *(const bf16x8*)(pr_ + 1536); \
            gb0 = *(const bf16x8*)(sl_ + 4096 + (hf * 64 + q32) * 16); gb1 = *(const bf16x8*)(sl_ + 4096 + (hf * 64 + 32 + q32) * 16); \
            gk0 = *(const bf16x8*)(sl_ + 6144 + (hf * 64 + q32) * 16); gk1 = *(const bf16x8*)(sl_ + 6144 + (hf * 64 + 32 + q32) * 16); \
            vf = *(const bf16x8*)(sl_ + 8448 + (hf * 32 + q32) * 16); \
            const unsigned char* gp_ = sl_ + 8192 + 16 * hf; \
            gm0 = *(const float4*)(gp_); gm1 = *(const float4*)(gp_ + 32); gm2 = *(const float4*)(gp_ + 64); gm3 = *(const float4*)(gp_ + 96); \
            gm4 = *(const float4*)(gp_ + 128); gm5 = *(const float4*)(gp_ + 160); gm6 = *(const float4*)(gp_ + 192); gm7 = *(const float4*)(gp_ + 224); \
            u0 = *(const float4*)(sl_ + 9472 + (hf * 32 + q32) * 16); u1 = *(const float4*)(sl_ + 9472 + ((2 + hf) * 32 + q32) * 16); \
            asm volatile("" ::: "memory"); \
            if (lane == 0) flags[8] = (unsigned)((c_) + 1); } while (0)
        unsigned rdy = flags[0];
        PB_FETCH(0);
        int xfree = 0;
#pragma unroll 1
        for (int c = 0; c < PB_NCH; ++c) {
            unsigned char* xw = lds + PB_XOFF + (c % PB_NX) * 4096 + lane * 16;
            rdy = flags[(c + 1) % PB_NB];
            const bf16x8 xb0 = __builtin_bit_cast(bf16x8, make_uint4(pack2(X0[0], X0[1]), pack2(X0[2], X0[3]), pack2(X0[4], X0[5]), pack2(X0[6], X0[7])));
            const bf16x8 xb1 = __builtin_bit_cast(bf16x8, make_uint4(pack2(X0[8], X0[9]), pack2(X0[10], X0[11]), pack2(X0[12], X0[13]), pack2(X0[14], X0[15])));
            const bf16x8 xb2 = __builtin_bit_cast(bf16x8, make_uint4(pack2(X1[0], X1[1]), pack2(X1[2], X1[3]), pack2(X1[4], X1[5]), pack2(X1[6], X1[7])));
            const bf16x8 xb3 = __builtin_bit_cast(bf16x8, make_uint4(pack2(X1[8], X1[9]), pack2(X1[10], X1[11]), pack2(X1[12], X1[13]), pack2(X1[14], X1[15])));
            f32x16 Ua, Ub;
            Ua[0] = u0.x; Ua[1] = u0.y; Ua[2] = u0.z; Ua[3] = u0.w; Ua[4] = u1.x; Ua[5] = u1.y; Ua[6] = u1.z; Ua[7] = u1.w;
#pragma unroll
            for (int r = 8; r < 16; ++r) Ua[r] = 0.f;
#pragma unroll
            for (int r = 0; r < 16; ++r) Ub[r] = 0.f;
            Ua = __builtin_amdgcn_mfma_f32_32x32x16_bf16(pa0, xb0, Ua, 0, 0, 0);
            Ub = __builtin_amdgcn_mfma_f32_32x32x16_bf16(pa1, xb1, Ub, 0, 0, 0);
            Ua = __builtin_amdgcn_mfma_f32_32x32x16_bf16(pa2, xb2, Ua, 0, 0, 0);
            Ub = __builtin_amdgcn_mfma_f32_32x32x16_bf16(pa3, xb3, Ub, 0, 0, 0);
            f32x16 Xn0, Xn1;
            Xn0[0] = X0[0] * gm0.x; Xn0[1] = X0[1] * gm0.y; Xn0[2] = X0[2] * gm0.z; Xn0[3] = X0[3] * gm0.w; Xn0[4] = X0[4] * gm1.x; Xn0[5] = X0[5] * gm1.y; Xn0[6] = X0[6] * gm1.z; Xn0[7] = X0[7] * gm1.w;
            Xn0[8] = X0[8] * gm2.x; Xn0[9] = X0[9] * gm2.y; Xn0[10] = X0[10] * gm2.z; Xn0[11] = X0[11] * gm2.w; Xn0[12] = X0[12] * gm3.x; Xn0[13] = X0[13] * gm3.y; Xn0[14] = X0[14] * gm3.z; Xn0[15] = X0[15] * gm3.w;
            Xn1[0] = X1[0] * gm4.x; Xn1[1] = X1[1] * gm4.y; Xn1[2] = X1[2] * gm4.z; Xn1[3] = X1[3] * gm4.w; Xn1[4] = X1[4] * gm5.x; Xn1[5] = X1[5] * gm5.y; Xn1[6] = X1[6] * gm5.z; Xn1[7] = X1[7] * gm5.w;
            Xn1[8] = X1[8] * gm6.x; Xn1[9] = X1[9] * gm6.y; Xn1[10] = X1[10] * gm6.z; Xn1[11] = X1[11] * gm6.w; Xn1[12] = X1[12] * gm7.x; Xn1[13] = X1[13] * gm7.y; Xn1[14] = X1[14] * gm7.z; Xn1[15] = X1[15] * gm7.w;
            Xn0 = __builtin_amdgcn_mfma_f32_32x32x16_bf16(gk0, vf, Xn0, 0, 0, 0);
            Xn1 = __builtin_amdgcn_mfma_f32_32x32x16_bf16(gk1, vf, Xn1, 0, 0, 0);
            const bf16x8 gbc0 = gb0, gbc1 = gb1;
            while (c - xfree >= PB_NX) { xfree = (int)flags[14]; }
            asm volatile("" ::: "memory");
            *(bf16x8*)(xw) = xb0; *(bf16x8*)(xw + 1024) = xb1; *(bf16x8*)(xw + 2048) = xb2; *(bf16x8*)(xw + 3072) = xb3;
            asm volatile("" ::: "memory");
            if (lane == 0) flags[10 + (c % PB_NX)] = (unsigned)(c + 1);
            if (c + 1 < PB_NCH) PB_FETCH(c + 1);
            const bf16x8 ub = __builtin_bit_cast(bf16x8, make_uint4(pack2(Ua[0] + Ub[0], Ua[1] + Ub[1]), pack2(Ua[2] + Ub[2], Ua[3] + Ub[3]), pack2(Ua[4] + Ub[4], Ua[5] + Ub[5]), pack2(Ua[6] + Ub[6], Ua[7] + Ub[7])));
            X0 = __builtin_amdgcn_mfma_f32_32x32x16_bf16(gbc0, ub, Xn0, 0, 0, 0);
            X1 = __builtin_amdgcn_mfma_f32_32x32x16_bf16(gbc1, ub, Xn1, 0, 0, 0);
        }
#undef PB_FETCH
        float* so = p.out + O_WKVP + ((size_t)(l * NBP + b) * 16 + h) * 4096 + (size_t)(32 * it + q32) * 64;
#pragma unroll
        for (int g = 0; g < 4; ++g) {
            *(float4*)(so + 8 * g + 4 * hf) = make_float4(X0[4 * g], X0[4 * g + 1], X0[4 * g + 2], X0[4 * g + 3]);
            *(float4*)(so + 32 + 8 * g + 4 * hf) = make_float4(X1[4 * g], X1[4 * g + 1], X1[4 * g + 2], X1[4 * g + 3]);
        }
    }
    __syncthreads();
}

__device__ void p3_post(const Params& p, int l, int bid, int G) {
    const int tid = opq_tid(), wv = tid >> 6, lane = tid & 63;
    const float* ys = (const float*)(p.ws + WS_YS);
    const bf16_t* V = (const bf16_t*)(p.ws + WS_VALL);
    const float* coef = (const float*)(p.ws + WS_COEF);
    const bf16_t* gt = (const bf16_t*)(p.ws + WS_GT);
    bf16_t* cc = (bf16_t*)(p.ws + WS_HB);
    for (int r = bid * 8 + wv; r < MT; r += G * 8) {
        float4 y4[4]; uint2 vu4[4], gg4[4]; float cf4[4];
#pragma unroll
        for (int hg = 0; hg < 4; ++hg) {
            const int head = 4 * hg + (lane >> 4), c = head * 64 + 4 * (lane & 15);
            y4[hg] = *(const float4*)(ys + (size_t)r * 1024 + c);
            vu4[hg] = *(const uint2*)(V + (size_t)r * 1024 + c);
            cf4[hg] = coef[(size_t)r * 16 + head];
            gg4[hg] = *(const uint2*)(gt + (size_t)r * DM + 1024 + c);
        }
        __builtin_amdgcn_sched_barrier(0);
#pragma unroll
        for (int hg = 0; hg < 4; ++hg) {
            const int head = 4 * hg + (lane >> 4), c = head * 64 + 4 * (lane & 15);
            const float4 y = y4[hg];
            const float mu = allreduce16(y.x + y.y + y.z + y.w) * (1.f / 64.f);
            const float d0 = y.x - mu, d1 = y.y - mu, d2 = y.z - mu, d3 = y.w - mu;
            const float var = allreduce16(d0 * d0 + d1 * d1 + d2 * d2 + d3 * d3) * (1.f / 64.f);
            const float rs = rsqrtf(var + 64e-5f);
            const float4 lw = *(const float4*)(p.ln_w + l * 1024 + c), lb = *(const float4*)(p.ln_b + l * 1024 + c);
            const uint2 vu = vu4[hg];
            const float4 v4 = make_float4(bflo(vu.x), bfhi(vu.x), bflo(vu.y), bfhi(vu.y));
            const float cf = cf4[hg];
            const uint2 gg = gg4[hg];
            const float o0 = (d0 * rs * lw.x + lb.x + cf * v4.x) * bflo(gg.x), o1 = (d1 * rs * lw.y + lb.y + cf * v4.y) * bfhi(gg.x);
            const float o2 = (d2 * rs * lw.z + lb.z + cf * v4.z) * bflo(gg.y), o3 = (d3 * rs * lw.w + lb.w + cf * v4.w) * bfhi(gg.y);
            *(uint2*)(cc + (size_t)r * DM + 1024 + c) = make_uint2(pack2(o0, o1), pack2(o2, o3));
        }
    }
}

__device__ void p_final(const Params& p, int bid, int G) {
    const int tid = opq_tid(), wv = tid >> 6, lane = tid & 63;
    const float4* g4 = (const float4*)p.final_g;
    for (int r = bid * 8 + wv; r < MT; r += G * 8) {
        float4* xr = (float4*)(p.out + (size_t)r * DM);
        float4 v[8]; float ss = 0.f;
#pragma unroll
        for (int i = 0; i < 8; ++i) { v[i] = xr[lane + 64 * i]; ss += v[i].x * v[i].x + v[i].y * v[i].y + v[i].z * v[i].z + v[i].w * v[i].w; }
        ss = wave_sum(ss);
        const float rinv = rsqrtf(ss * (1.f / 2048.f) + 1e-5f);
#pragma unroll
        for (int i = 0; i < 8; ++i) { const float4 g = g4[lane + 64 * i]; xr[lane + 64 * i] = make_float4(v[i].x * rinv * g.x, v[i].y * rinv * g.y, v[i].z * rinv * g.z, v[i].w * rinv * g.w); }
    }
}

#ifndef REPL
#define REPL -1
#endif
#ifndef REPK
#define REPK -100
#endif
__global__ void __launch_bounds__(512, 2) fwd_kernel(Params p_unused) {
    extern __shared__ __attribute__((aligned(16))) unsigned char shm[];
    cg::grid_group grid = cg::this_grid();
    const int bid0 = blockIdx.x, G0 = gridDim.x;
    float* shf = (float*)shm;
    volatile LAS unsigned* xst = (volatile LAS unsigned*)((LAS unsigned char*)shm + 131072);
    if (threadIdx.x == 0) { xst[0] = 0u; xst[1] = 0u; }
    __syncthreads();
    const XcdBarrier xb = xcd_barrier_post((unsigned*)(kparams().ws + WS_BAR), xst);
    if (G0 == 0x7fffffff) grid.sync();

#pragma unroll 1
    for (int ph = 0; ph < 14; ++ph) {
        const int bid = opq_s(bid0), G = opq_s(G0);
        const int l = ph >= 7 ? 1 : 0, k = ph == 0 ? -1 : (ph == 13 ? 6 : (ph - 1) - 6 * l);
#pragma unroll 1
        for (int rep = 0; rep < ((k == kparams().repk && (kparams().repl < 0 || kparams().repl == l)) ? 2 : 1); ++rep) {
        if (k == -1) {
            for (int it = bid; it < 384; it += G) p0_mod_item(kparams(), shf, it / 192, it % 192);
            for (int it = bid; it < 17; it += G) p0_rope_item(kparams(), it);
            for (int it = bid; it < 64; it += G) p0_wfrag_item(kparams(), it);
            p0_conv_all(kparams(), shf, bid, G, 2752, 0);
        } else if (k == 0) {
            p1_norm(kparams(), l, bid, G);
        } else if (k == 1) {
            pg8::StaticOrder S; S.init(MP, INWP, G, bid);
            pg8::Gemm g{(const bf16_t*)(kparams().ws + WS_HB), (const bf16_t*)(kparams().ws + WS_WTIN), MP, INWP, DM};
            Epi1 E{l};
            pg8::gemm_phase<Epi1, pg8::StaticOrder, false>((PG8_LAS unsigned char*)shm, g, S, E, nullptr);
        } else if (k == 2) {
            for (int it = bid; it < 256 + 256 + 1 + 64; it += G) {
                if (it < 256) p3_attn_unit(kparams(), shm, l, it);
                else if (it < 512) p3_twad_item(kparams(), l, it - 256);
                else if (it == 512) p3_prep_tile(kparams(), shm, l, 256);
                else p3_sattn_item(kparams(), shf, l, it - 513);
            }
            __syncthreads();
            if (l == 0) p0_conv_all(kparams(), shf, bid, G, 1728, 1);
        } else if (k == 3) {
            {
                const int wvq = opq_tid() >> 6;
                int i2 = bid < 64 ? bid * 8 + wvq : 512 + (bid - 64) * 8 + wvq;
                const int step = bid < 64 ? (1 << 20) : (G - 64) * 8;
#pragma unroll 1
                for (; i2 < 32 * 256; i2 += step) pa_chunk(kparams(), shm + wvq * PA_WLDS, l, (i2 & 31) * 256 + (i2 >> 5));
                if (bid < 64) {
                    __syncthreads();
                    pb_head(kparams(), shm, l, bid, false);
                } else {
                    const int gw = (bid - 64) * 8 + wvq, nw = (G - 64) * 8;
                    for (int task = gw; task < NBS * 256; task += nw) pa_sample_task(kparams(), l, task);
                }
            }
        } else if (k == 4) {
            p3_post(kparams(), l, bid, G);
        } else if (k == 5) {
            pg8::StaticOrder S; S.init(TP, DM, G, bid);
            pg8::Gemm g{(const bf16_t*)(kparams().ws + WS_HB), (const bf16_t*)(kparams().ws + WS_WTOUT) + (size_t)l * DM * DM, TP, DM, DM};
            Epi2 E{l};
            pg8::gemm_phase<Epi2, pg8::StaticOrder, false>((PG8_LAS unsigned char*)shm, g, S, E, nullptr);
            for (int nb = bid; nb < 64; nb += G) g2_sample_item(kparams(), shf, l, nb);
        } else {
            p_final(kparams(), bid, G);
        }
        if (ph < 13) xcd_barrier(xb);
        }
    }
}

extern "C" void kernel_launch(void* const* d_in, const int* in_sizes, int n_in, void* d_out, int out_size, void* d_ws, size_t ws_size, hipStream_t stream) {
    static int grid_blocks = 0;
    if (grid_blocks == 0) {
        if (n_in != 25 || (size_t)out_size != O_END || ws_size < WS_END) {
            fprintf(stderr, "kernel_launch: unexpected shapes: n_in %d out_size %d ws_size %zu (need %zu)\n", n_in, out_size, ws_size, (size_t)WS_END);
            grid_blocks = -1; return;
        }
        if (hipFuncSetAttribute((const void*)fwd_kernel, hipFuncAttributeMaxDynamicSharedMemorySize, LDS_BYTES) != hipSuccess) { fprintf(stderr, "kernel_launch: hipFuncSetAttribute failed\n"); grid_blocks = -1; return; }
        int dev = 0, cus = 0, per_cu = 0;
        hipGetDevice(&dev);
        hipDeviceGetAttribute(&cus, hipDeviceAttributeMultiprocessorCount, dev);
        hipOccupancyMaxActiveBlocksPerMultiprocessor(&per_cu, (const void*)fwd_kernel, 512, LDS_BYTES);
        if (per_cu < 1) { fprintf(stderr, "kernel_launch: occupancy query gives %d blocks per CU\n", per_cu); per_cu = 1; }
        (void)hipGetLastError();
        grid_blocks = cus;
        if (grid_blocks < 192) { fprintf(stderr, "kernel_launch: only %d CUs\n", grid_blocks); grid_blocks = -1; return; }
    }
    if (grid_blocks < 0) return;
    if (hipMemsetAsync((unsigned char*)d_ws + WS_BAR, 0, 16384 + RFLAG_BYTES, stream) != hipSuccess) { fprintf(stderr, "kernel_launch: memset of the barrier words failed\n"); return; }
    Params p{};
    const float** pp = (const float**)&p;
    for (int i = 0; i < 25; ++i) pp[i] = (const float*)d_in[i];
    p.out = (float*)d_out; p.ws = (unsigned char*)d_ws; p.repk = REPK; p.repl = REPL;
    void* args[] = {&p};
    hipError_t e = hipLaunchCooperativeKernel((const void*)fwd_kernel, dim3(grid_blocks), dim3(512), args, LDS_BYTES, stream);
    if (e != hipSuccess) fprintf(stderr, "cooperative launch failed: %s (grid %d)\n", hipGetErrorString(e), grid_blocks);
}
```

```cpp
#include <hip/hip_runtime.h>
#include <hip/hip_cooperative_groups.h>
#include <cstdio>
namespace cg = cooperative_groups;
__device__ __forceinline__ int opq_tid() { int t = threadIdx.x; asm volatile("" : "+v"(t)); return t; }
__device__ __forceinline__ int opq_s(int x) { asm volatile("" : "+s"(x)); return x; }
typedef float cvt_f32x2 __attribute__((ext_vector_type(2)));
typedef __bf16 cvt_bf16x2 __attribute__((ext_vector_type(2)));
__device__ __forceinline__ unsigned hw_cvt_pk_bf16(float lo, float hi) { const cvt_f32x2 v = {lo, hi}; return __builtin_bit_cast(unsigned, __builtin_convertvector(v, cvt_bf16x2)); }
typedef unsigned sc1_v4u __attribute__((ext_vector_type(4)));
__device__ __forceinline__ void st_sc1_b128(void* p, unsigned a, unsigned b, unsigned c, unsigned d) { const sc1_v4u v = {a, b, c, d}; asm volatile("global_store_dwordx4 %0, %1, off sc0 sc1\n\ts_nop 2" :: "v"(p), "v"(v) : "memory"); }
__device__ __forceinline__ void st_sc1_b32(void* p, float v) { asm volatile("global_store_dword %0, %1, off sc0 sc1\n\ts_nop 2" :: "v"(p), "v"(v) : "memory"); }
namespace pg8 {
#define PG8_LAS __attribute__((address_space(3)))
typedef unsigned short bf16_t;
typedef short bf16x8 __attribute__((ext_vector_type(8)));
typedef float f32x4 __attribute__((ext_vector_type(4)));
typedef unsigned u32x4 __attribute__((ext_vector_type(4)));
constexpr int BM = 256, BK = 64, HALF = 128, HTB = HALF * BK * 2  , STAGE_BYTES = 8 * HTB, NXCD = 8, WGM = 8;

__host__ __device__ __forceinline__ int lds_byte(int r, int c) { const int st = (r >> 4) * 2 + (c >> 5), rr = r & 15, cc = c & 31, ob = rr * 64 + cc * 2; return st * 1024 + (ob ^ (((ob >> 9) & 1) << 5)); }
__host__ __device__ __forceinline__ void stage_rc(int b, int& R, int& C) { const int st = b / 1024, sb = b % 1024, swz = sb ^ (((sb >> 9) & 1) << 5); R = (st >> 1) * 16 + swz / 64; C = (st & 1) * 32 + (swz % 64) / 2; }
__host__ __device__ __forceinline__ int perm32(int rho) { const int n = rho >> 4, i = rho & 15; return 8 * (i >> 2) + 4 * n + (i & 3); }

struct Unit { int pm, pn; };
struct Gemm { const bf16_t* A; const bf16_t* Bt; int M, N, K; };

struct StaticOrder {
    int nM, nN, nwg, G, c;
    __host__ __device__ void init(int M, int N, int G_, int c_) { nM = M / BM; nN = N / BM; nwg = nM * nN; G = G_; c = c_; }
    __host__ __device__ bool next(int i, Unit& u) const {
        const long L = (long)i * G + c; if (L >= nwg) return false;
        int wgid = (int)L; { const int q = nwg / NXCD, r = nwg % NXCD, xcd = wgid % NXCD, off = wgid / NXCD; wgid = (xcd < r ? xcd * (q + 1) : r * (q + 1) + (xcd - r) * q) + off; }
        const int nig = WGM * nN, gid = wgid / nig, fm = gid * WGM, gsz = (nM - fm) < WGM ? (nM - fm) : WGM;
        u.pm = fm + ((wgid % nig) % gsz); u.pn = (wgid % nig) / gsz; return true;
    }
    __device__ __forceinline__ void a_ready(const Unit&) const {}
    __device__ __forceinline__ void done(const Unit&) const {}
};
template <class Epi, class Sched, bool STAMP = false>
__device__ __forceinline__ void gemm_phase(PG8_LAS unsigned char* lds, const Gemm g, const Sched& S, const Epi& E, unsigned long long* stamps) {
    const int tid = opq_tid(), wid = __builtin_amdgcn_readfirstlane(tid >> 6), lane = tid & 63, wr = wid >> 2, wc = wid & 3, fr = lane & 15, fq = lane >> 4;
    const int K = g.K, nt = K / BK;
    int ts_lo = 0, ts_hi = 0, nts = 0; const unsigned long long rt_entry = STAMP ? (unsigned long long)wall_clock64() : 0ull;
#define PG8_STAMP() do { if (STAMP && wid == 0 && nts < 64) { const unsigned long long _c = (unsigned long long)clock64(); \
        ts_lo = (lane == nts) ? (int)(unsigned)_c : ts_lo; ts_hi = (lane == nts) ? (int)(unsigned)(_c >> 32) : ts_hi; ++nts; } } while (0)
    PG8_STAMP();
    unsigned voffA[2], voffB[2];
#pragma unroll
    for (int i = 0; i < 2; ++i) { int R, C; stage_rc(tid * 16 + i * 8192, R, C); const int Rb = Epi::PERM ? ((R & ~31) + perm32(R & 31)) : R;
        voffA[i] = (unsigned)(R * K + C) * 2u; voffB[i] = (unsigned)(Rb * K + C) * 2u; }
    const size_t kstep = (size_t)(BK * 2);
    const size_t hstep = (size_t)HALF * K * 2;
    const size_t tstep = 2 * hstep;
    const unsigned ldsw = (unsigned)wid * 1024u;
    const int aoff = lds_byte(wr * 64 + fr, fq * 8), boff = lds_byte(wc * 32 + fr, fq * 8);
#define PG8_SA(b, h) (((b) * 2 + (h)) * HTB)
#define PG8_SB(b, h) ((4 + (b) * 2 + (h)) * HTB)
#define PG8_STAGE(bufoff, gbase, voff) do { _Pragma("unroll") for (int _i = 0; _i < 2; ++_i) \
        __builtin_amdgcn_global_load_lds((const unsigned*)((const char*)(gbase) + (voff)[_i]), (PG8_LAS unsigned*)(lds + (bufoff) + ldsw + _i * 8192), 16, 0, 0); } while (0)
#define PG8_LDA(dst, b, h) do { _Pragma("unroll") for (int m = 0; m < 4; ++m) _Pragma("unroll") for (int k = 0; k < 2; ++k) dst[m][k] = *(const PG8_LAS bf16x8*)(lds + PG8_SA(b, h) + aoff + m * 2048 + k * 1024); } while (0)
#define PG8_LDB(dst, b, h) do { _Pragma("unroll") for (int n = 0; n < 2; ++n) _Pragma("unroll") for (int k = 0; k < 2; ++k) dst[n][k] = *(const PG8_LAS bf16x8*)(lds + PG8_SB(b, h) + boff + n * 2048 + k * 1024); } while (0)
#define PG8_MMA(ai, bj, At, Bt) do { __builtin_amdgcn_s_setprio(1); _Pragma("unroll") for (int m = 0; m < 4; ++m) _Pragma("unroll") for (int n = 0; n < 2; ++n) _Pragma("unroll") for (int k = 0; k < 2; ++k) \
        acc[ai][bj][m][n] = __builtin_amdgcn_mfma_f32_16x16x32_bf16(Bt[n][k], At[m][k], acc[ai][bj][m][n], 0, 0, 0); __builtin_amdgcn_s_setprio(0); } while (0)
#define PG8_WAIT_V(n) asm volatile("s_waitcnt vmcnt(" #n ")" ::: "memory")
#define PG8_WAIT_L(n) asm volatile("s_waitcnt lgkmcnt(" #n ")" ::: "memory")
#define PG8_BAR __builtin_amdgcn_s_barrier()
#define PG8_SCHED __builtin_amdgcn_sched_barrier(0)
    Unit cur, nxt; int ui = 0;
    if (!S.next(0, cur)) return;
    f32x4 acc[2][2][4][2];
#pragma unroll
    for (int a = 0; a < 2; ++a)
#pragma unroll
        for (int b = 0; b < 2; ++b)
#pragma unroll
            for (int m = 0; m < 4; ++m)
#pragma unroll
                for (int n = 0; n < 2; ++n) acc[a][b][m][n] = (f32x4){0.f, 0.f, 0.f, 0.f};
    bf16x8 At[4][2], B0[2][2], B1[2][2];
    const char* cA = (const char*)g.A + (size_t)cur.pm * tstep; const char* cB = (const char*)g.Bt + (size_t)cur.pn * tstep;
    S.a_ready(cur);
    PG8_STAGE(PG8_SB(0, 0), cB, voffB); PG8_STAGE(PG8_SA(0, 0), cA, voffA); PG8_STAGE(PG8_SB(0, 1), cB + hstep, voffB); PG8_STAGE(PG8_SA(0, 1), cA + hstep, voffA);
    if (wr == 1) PG8_BAR;
    PG8_WAIT_V(4); PG8_BAR;
    PG8_STAGE(PG8_SB(1, 0), cB + kstep, voffB); PG8_STAGE(PG8_SA(1, 0), cA + kstep, voffA); PG8_STAGE(PG8_SB(1, 1), cB + hstep + kstep, voffB);
    PG8_WAIT_V(6); PG8_BAR;
    PG8_STAMP();
    for (;;) {
        const bool has_next = S.next(ui + 1, nxt);
        const char* nA = has_next ? (const char*)g.A + (size_t)nxt.pm * tstep : cA; const char* nB = has_next ? (const char*)g.Bt + (size_t)nxt.pn * tstep : cB;
        for (int t = 0; t < nt; t += 2) {
            const bool last = (t == nt - 2);
            const char* a1 = cA + (size_t)(t + 1) * kstep;
            const char* a2 = last ? nA : cA + (size_t)(t + 2) * kstep; const char* b2 = last ? nB : cB + (size_t)(t + 2) * kstep;
            const char* a3 = a2 + kstep; const char* b3 = b2 + kstep;
            if (last && has_next) S.a_ready(nxt);
            PG8_LDB(B0, 0, 0); PG8_SCHED; PG8_LDA(At, 0, 0); PG8_STAGE(PG8_SA(1, 1), a1 + hstep, voffA);
            PG8_WAIT_L(8); PG8_BAR; PG8_WAIT_L(0); PG8_MMA(0, 0, At, B0); PG8_BAR; PG8_SCHED;
            PG8_LDB(B1, 0, 1); PG8_STAGE(PG8_SB(0, 0), b2, voffB);
            PG8_BAR; PG8_WAIT_L(0); PG8_MMA(0, 1, At, B1); PG8_BAR;
            PG8_LDA(At, 0, 1); PG8_STAGE(PG8_SA(0, 0), a2, voffA);
            PG8_BAR; PG8_WAIT_L(0); PG8_MMA(1, 0, At, B0); PG8_BAR; PG8_SCHED;
            PG8_STAGE(PG8_SB(0, 1), b2 + hstep, voffB);
            PG8_WAIT_V(6); PG8_BAR; PG8_MMA(1, 1, At, B1); PG8_BAR;
            PG8_LDB(B0, 1, 0); PG8_SCHED; PG8_LDA(At, 1, 0); PG8_STAGE(PG8_SA(0, 1), a2 + hstep, voffA);
            PG8_WAIT_L(8); PG8_BAR; PG8_WAIT_L(0); PG8_MMA(0, 0, At, B0); PG8_BAR; PG8_SCHED;
            PG8_LDB(B1, 1, 1); PG8_STAGE(PG8_SB(1, 0), b3, voffB);
            PG8_BAR; PG8_WAIT_L(0); PG8_MMA(0, 1, At, B1); PG8_BAR;
            PG8_LDA(At, 1, 1); PG8_STAGE(PG8_SA(1, 0), a3, voffA);
            PG8_BAR; PG8_WAIT_L(0); PG8_MMA(1, 0, At, B0); PG8_BAR; PG8_SCHED;
            PG8_STAGE(PG8_SB(1, 1), b3 + hstep, voffB);
            PG8_WAIT_V(6); PG8_BAR; PG8_MMA(1, 1, At, B1); PG8_BAR;
        }
        PG8_STAMP();
        if constexpr (!Epi::AFTER_DRAIN) { E(acc, cur, wr, wc, fr, fq); S.done(cur); }
        PG8_STAMP();
        if (!has_next) break;
#pragma unroll
        for (int a = 0; a < 2; ++a)
#pragma unroll
            for (int b = 0; b < 2; ++b)
#pragma unroll
                for (int m = 0; m < 4; ++m)
#pragma unroll
                    for (int n = 0; n < 2; ++n) acc[a][b][m][n] = (f32x4){0.f, 0.f, 0.f, 0.f};
        cur = nxt; cA = nA; cB = nB; ++ui;
    }
    PG8_WAIT_V(0);
    if (wr == 0) PG8_BAR;
    PG8_BAR;
    if constexpr (Epi::AFTER_DRAIN) { E.fused(acc, cur, wr, wc, fr, fq, lds, wid, lane); S.done(cur); }
    PG8_STAMP();
    if (STAMP && wid == 0) { stamps[lane] = lane < nts ? (((unsigned long long)(unsigned)ts_hi << 32) | (unsigned)ts_lo) : 0ull;
        if (lane == 62) stamps[62] = rt_entry; if (lane == 63) stamps[63] = (unsigned long long)wall_clock64(); }
#undef PG8_STAMP
#undef PG8_SA
#undef PG8_SB
#undef PG8_STAGE
#undef PG8_LDA
#undef PG8_LDB
#undef PG8_MMA
#undef PG8_WAIT_V
#undef PG8_WAIT_L
#undef PG8_BAR
#undef PG8_SCHED
}
}

#define XB_TMO      128
#define XB_XCNT(j)  (256  + 64 * (j))
#define XB_XSUB(j)  (1280 + 64 * (j))
#define XB_XGEN(j)  (2304 + 64 * (j))
#define XB_TOP      3328
#define XB_TOPGEN   3392
#define XCD_BAR_WORDS 3456
#define XB_SPIN_CAP (1u << 18)
#define LAS __attribute__((address_space(3)))

__device__ __forceinline__ unsigned xb_ld(unsigned* p)              { return __hip_atomic_load(p, __ATOMIC_RELAXED, __HIP_MEMORY_SCOPE_AGENT); }
__device__ __forceinline__ unsigned xb_add(unsigned* p, unsigned v) { return __hip_atomic_fetch_add(p, v, __ATOMIC_RELAXED, __HIP_MEMORY_SCOPE_AGENT); }
__device__ __forceinline__ unsigned xb_xcc_id() { return (unsigned)__builtin_amdgcn_s_getreg((3 << 11) | 20) & 0xFu; }
#define XB_SPIN(cond, bar) do { unsigned _sp = 0; while (cond) { __builtin_amdgcn_s_sleep(1); \
    if ((++_sp & 255u) == 0u) { if (xb_ld(&(bar)[XB_TMO])) break; if (_sp > XB_SPIN_CAP) { atomicAdd(&(bar)[XB_TMO], 1u); break; } } } } while (0)

struct XcdBarrier {
    unsigned* bar; unsigned x;
    volatile LAS unsigned* st;
};

__device__ __forceinline__ XcdBarrier xcd_barrier_post(unsigned* bar, volatile LAS unsigned* st) {
    XcdBarrier b; b.bar = bar; b.x = xb_xcc_id(); b.st = st;
    if (threadIdx.x == 0) (void)xb_add(&bar[XB_XCNT(b.x)], 1u);
    return b;
}
__device__ __forceinline__ void xcd_barrier_complete(unsigned* bar, unsigned x, unsigned& nloc, unsigned& nx) {
    const unsigned G = gridDim.x * gridDim.y * gridDim.z;
    unsigned sum, cnt, mine, sp = 0u;
    for (;;) {
        sum = 0u; cnt = 0u; mine = 0u;
#pragma unroll
        for (unsigned j = 0; j < 16; ++j) { const unsigned c = xb_ld(&bar[XB_XCNT(j)]); sum += c; cnt += (c > 0u) ? 1u : 0u; mine = (j == x) ? c : mine; }
        if (sum == G) break;
        __builtin_amdgcn_s_sleep(1);
        if ((++sp & 255u) == 0u) { if (xb_ld(&bar[XB_TMO])) break; if (sp > XB_SPIN_CAP) { atomicAdd(&bar[XB_TMO], 1u); break; } }
    }
    nloc = mine > 0u ? mine : 1u; nx = cnt > 0u ? cnt : 1u;
}

__device__ __forceinline__ void xcd_barrier(const XcdBarrier& b) {
    asm volatile("s_waitcnt vmcnt(0)" ::: "memory");
    __syncthreads();
    if (threadIdx.x == 0) {
        unsigned* bar = b.bar;
        __builtin_amdgcn_s_waitcnt(0);
        unsigned nloc = b.st[0], nx = b.st[1];
        if (nloc == 0u) { xcd_barrier_complete(bar, b.x, nloc, nx); b.st[0] = nloc; b.st[1] = nx; }
        const unsigned old = xb_add(&bar[XB_XSUB(b.x)], 1u);
        const unsigned gen = old / nloc;
        if (old + 1u == (gen + 1u) * nloc) {
            __builtin_amdgcn_fence(__ATOMIC_RELEASE, "agent");
            asm volatile("s_waitcnt vmcnt(0)" ::: "memory");
            const unsigned og = xb_add(&bar[XB_TOP], 1u);
            const unsigned tg = og / nx;
            if (og + 1u == (tg + 1u) * nx) xb_add(&bar[XB_TOPGEN], 1u);
            else XB_SPIN(xb_ld(&bar[XB_TOPGEN]) == tg, bar);
            __builtin_amdgcn_fence(__ATOMIC_ACQUIRE, "agent");
            xb_add(&bar[XB_XGEN(b.x)], 1u);
            asm volatile("s_waitcnt vmcnt(0)" ::: "memory");
        } else {
            XB_SPIN(xb_ld(&bar[XB_XGEN(b.x)]) == gen, bar);
            __builtin_amdgcn_fence(__ATOMIC_ACQUIRE, "agent");
            asm volatile("s_waitcnt vmcnt(0)" ::: "memory");
        }
    }
    __syncthreads();
}

typedef unsigned short bf16_t;
typedef short bf16x8 __attribute__((ext_vector_type(8)));
typedef float f32x4 __attribute__((ext_vector_type(4)));
typedef float f32x16 __attribute__((ext_vector_type(16)));

constexpr int DM = 2048, SEQ = 4096, NBP = 2, NBS = 32, TP = NBP * SEQ, MT = TP + NBS, MP = 8448;
constexpr int INW = 6784, INWP = 6912, SHD = 3200, DEPTH = 2;
constexpr size_t NRI = (size_t)MT * 1024;
constexpr int LDS_BYTES = 131072 + 16;
constexpr size_t O_CKP = (size_t)MT * DM;
constexpr size_t O_CVP = O_CKP + (size_t)DEPTH * NBP * 128 * 256;
constexpr size_t O_WKVP = O_CVP + (size_t)DEPTH * NBP * 128 * 256;
constexpr size_t O_SHP = O_WKVP + (size_t)DEPTH * NBP * 16 * 4096;
constexpr size_t O_CKS = O_SHP + (size_t)DEPTH * NBP * SHD;
constexpr size_t O_CVS = O_CKS + (size_t)DEPTH * NBS * 128 * 256;
constexpr size_t O_WKVS = O_CVS + (size_t)DEPTH * NBS * 128 * 256;
constexpr size_t O_SHS = O_WKVS + (size_t)DEPTH * NBS * 16 * 4096;
constexpr size_t O_END = O_SHS + (size_t)DEPTH * NBS * SHD;
constexpr size_t al256(size_t x) { return (x + 255) & ~(size_t)255; }
constexpr size_t WS_WTIN = 0;
constexpr size_t WS_WTOUT = WS_WTIN + (size_t)INWP * DM * 2;
constexpr size_t WS_MOD = WS_WTOUT + (size_t)DEPTH * DM * DM * 2;
constexpr size_t WS_ROPE = WS_MOD + al256((size_t)DEPTH * 34 * 6144 * 4);
constexpr size_t WS_HB = WS_ROPE + al256((size_t)4097 * 16 * 4);
constexpr size_t WS_QB = WS_HB + (size_t)MP * DM * 2;
constexpr size_t WS_KB = WS_QB + (size_t)MP * 1024 * 2;
constexpr size_t WS_VB = WS_KB + (size_t)MP * 256 * 2;
constexpr size_t WS_RW = WS_VB + (size_t)MP * 256 * 2;
constexpr size_t WS_GT = WS_RW + (size_t)MP * SHD * 2;
constexpr size_t WS_VALL = WS_GT + (size_t)MP * DM * 2;
constexpr size_t SRI = (size_t)NBS * 1024;
constexpr size_t WS_RSB = WS_VALL + NRI * 2;
constexpr size_t WS_RSW = WS_RSB + 4 * SRI * 2;
constexpr size_t WS_YS = WS_RSW + SRI * 4;
constexpr size_t WS_REC = WS_YS + NRI * 4;
constexpr size_t WS_COEF = WS_REC + (size_t)32 * 256 * 14592;
constexpr size_t WS_TWAD = WS_COEF + al256((size_t)MT * 16 * 4);
constexpr size_t WS_WFRAG = WS_TWAD + (size_t)MT * 128 * 2;
constexpr size_t WS_BAR = WS_WFRAG + (size_t)DEPTH * 2 * 16 * 4 * 2 * 64 * 16;
constexpr size_t WS_RFLAG = WS_BAR + 16384;
constexpr size_t RFLAG_BYTES = (size_t)32 * 256 * 64;
constexpr size_t WS_END = WS_RFLAG + RFLAG_BYTES;

struct Params {
    const float *x_prompt, *x_sample, *cache_k, *cache_v, *state_wkv, *state_shift, *c_prompt, *c_sample, *norm_g, *w_ada, *b_ada, *w_in, *mu_shift, *w0, *w_decay, *a0,
        *w_iclr, *k_k, *k_a, *r_k, *ln_w, *ln_b, *sinks, *w_out, *final_g;
    float* out;
    unsigned char* ws;
    int repk, repl;
};
typedef const __attribute__((address_space(4))) Params* KParamsPtr;
__device__ __forceinline__ const Params& kparams() {
    KParamsPtr k = (KParamsPtr)__builtin_amdgcn_kernarg_segment_ptr();
    asm volatile("" : "+s"(k));
    return *(const Params*)k;
}

__device__ __forceinline__ unsigned short f2bf(float f) { return (unsigned short)(hw_cvt_pk_bf16(f, 0.f) & 0xffffu); }
__device__ __forceinline__ float bf2f(unsigned short b) { return __uint_as_float(((unsigned)b) << 16); }
__device__ __forceinline__ unsigned pack2(float lo, float hi) { return hw_cvt_pk_bf16(lo, hi); }
__device__ __forceinline__ float bflo(unsigned w) { return __uint_as_float(w << 16); }
__device__ __forceinline__ float bfhi(unsigned w) { return __uint_as_float(w & 0xffff0000u); }
__device__ __forceinline__ float silu_f(float x) { return x / (1.f + __expf(-x)); }
__device__ __forceinline__ float wave_sum(float x) {
#pragma unroll
    for (int o = 32; o >= 1; o >>= 1) x += __shfl_xor(x, o);
    return x;
}
__device__ __forceinline__ float wave_max(float x) {
#pragma unroll
    for (int o = 32; o >= 1; o >>= 1) x = fmaxf(x, __shfl_xor(x, o));
    return x;
}
template <int CTRL> __device__ __forceinline__ float dpp_f(float x) {
    return __builtin_bit_cast(float, __builtin_amdgcn_update_dpp(0, __builtin_bit_cast(int, x), CTRL, 0xF, 0xF, false));
}
__device__ __forceinline__ float allreduce16(float x) {
    x += dpp_f<0x128>(x);
    x += dpp_f<0x124>(x);
    x += dpp_f<0x122>(x);
    x += dpp_f<0x121>(x);
    return x;
}

__device__ void p0_mod_item(const Params& p, float* red, int l, int nc) {
    const int tid = opq_tid(), wv = tid >> 6, lane = tid & 63, n = lane & 31, kh = lane >> 5;
    f32x16 acc0, acc1;
#pragma unroll
    for (int i = 0; i < 16; ++i) { acc0[i] = 0.f; acc1[i] = 0.f; }
    const float* W = p.w_ada + (size_t)l * DM * 6144 + nc * 32 + n;
#pragma unroll 8
    for (int ks = 0; ks < 16; ++ks) {
        const int k0 = wv * 256 + ks * 16 + kh * 8;
        bf16x8 bfr, a0, a1;
#pragma unroll
        for (int j = 0; j < 8; ++j) bfr[j] = (short)f2bf(W[(size_t)(k0 + j) * 6144]);
        const float4* cs = (const float4*)(p.c_sample + (size_t)n * DM + k0);
        const float4 u0 = cs[0], u1 = cs[1];
        a0[0] = (short)f2bf(silu_f(u0.x)); a0[1] = (short)f2bf(silu_f(u0.y)); a0[2] = (short)f2bf(silu_f(u0.z)); a0[3] = (short)f2bf(silu_f(u0.w));
        a0[4] = (short)f2bf(silu_f(u1.x)); a0[5] = (short)f2bf(silu_f(u1.y)); a0[6] = (short)f2bf(silu_f(u1.z)); a0[7] = (short)f2bf(silu_f(u1.w));
        float4 q0 = make_float4(0.f, 0.f, 0.f, 0.f), q1 = q0;
        if (n < 2) { const float4* cp = (const float4*)(p.c_prompt + (size_t)n * DM + k0); q0 = cp[0]; q1 = cp[1]; }
        a1[0] = (short)f2bf(silu_f(q0.x)); a1[1] = (short)f2bf(silu_f(q0.y)); a1[2] = (short)f2bf(silu_f(q0.z)); a1[3] = (short)f2bf(silu_f(q0.w));
        a1[4] = (short)f2bf(silu_f(q1.x)); a1[5] = (short)f2bf(silu_f(q1.y)); a1[6] = (short)f2bf(silu_f(q1.z)); a1[7] = (short)f2bf(silu_f(q1.w));
        acc0 = __builtin_amdgcn_mfma_f32_32x32x16_bf16(a0, bfr, acc0, 0, 0, 0);
        acc1 = __builtin_amdgcn_mfma_f32_32x32x16_bf16(a1, bfr, acc1, 0, 0, 0);
    }
#pragma unroll
    for (int i = 0; i < 16; ++i) red[(wv * 18 + i) * 64 + lane] = acc0[i];
    red[(wv * 18 + 16) * 64 + lane] = acc1[0];
    red[(wv * 18 + 17) * 64 + lane] = acc1[1];
    __syncthreads();
    float* mod = (float*)(p.ws + WS_MOD);
    for (int o = tid; o < 34 * 32; o += 512) {
        const int row = o >> 5, col = o & 31;
        int ri, ln, mrow;
        if (row < 32) { const int khh = (row >> 2) & 1; ri = (row & 3) + 4 * (row >> 3); ln = col + 32 * khh; mrow = 2 + row; }
        else { ri = 16 + (row - 32); ln = col; mrow = row - 32; }
        float s = 0.f;
#pragma unroll
        for (int w = 0; w < 8; ++w) s += red[(w * 18 + ri) * 64 + ln];
        mod[((size_t)l * 34 + mrow) * 6144 + nc * 32 + col] = s + p.b_ada[l * 6144 + nc * 32 + col];
    }
    __syncthreads();
}

struct ConvIt { const float* src; bf16_t* dst; int N, k0, n0; };
__device__ __forceinline__ ConvIt conv_decode(const Params& p, int cidx, int lw) {
    ConvIt c;
    int kt, nt;
    if (cidx < 1728) { kt = cidx & 15; nt = cidx >> 4; c.N = INW; c.src = p.w_in + (size_t)lw * DM * INW; c.dst = (bf16_t*)(p.ws + WS_WTIN); }
    else { int rem = cidx - 1728; const int l2 = rem >> 9; rem &= 511; kt = rem & 15; nt = rem >> 4; c.N = DM; c.src = p.w_out + (size_t)l2 * DM * DM; c.dst = (bf16_t*)(p.ws + WS_WTOUT) + (size_t)l2 * DM * DM; }
    c.k0 = kt * 128; c.n0 = nt * 64;
    return c;
}
__device__ void p0_conv_all(const Params& p, float* s, int bid, int G, int total, int lw) {
    const int tid = opq_tid();
    const int lrow = tid >> 4, c4 = tid & 15, n = tid >> 3, kg = tid & 7;
    float4 v[4];
    int cidx = bid;
    ConvIt cur = conv_decode(p, cidx < total ? cidx : 0, lw);
    if (cidx < total) {
#pragma unroll
        for (int p4 = 0; p4 < 4; ++p4) { v[p4] = make_float4(0.f, 0.f, 0.f, 0.f); if (cur.n0 < cur.N) v[p4] = *(const float4*)(cur.src + (size_t)(cur.k0 + lrow + 32 * p4) * cur.N + cur.n0 + 4 * c4); }
    }
#pragma unroll 1
    while (cidx < total) {
#pragma unroll
        for (int p4 = 0; p4 < 4; ++p4) { float* d = s + (lrow + 32 * p4) * 65 + 4 * c4; d[0] = v[p4].x; d[1] = v[p4].y; d[2] = v[p4].z; d[3] = v[p4].w; }
        __syncthreads();
        const int nxt = cidx + G;
        const ConvIt nx = conv_decode(p, nxt < total ? nxt : 0, lw);
        if (nxt < total) {
#pragma unroll
            for (int p4 = 0; p4 < 4; ++p4) { v[p4] = make_float4(0.f, 0.f, 0.f, 0.f); if (nx.n0 < nx.N) v[p4] = *(const float4*)(nx.src + (size_t)(nx.k0 + lrow + 32 * p4) * nx.N + nx.n0 + 4 * c4); }
        }
        unsigned w[8];
#pragma unroll
        for (int j = 0; j < 8; ++j) w[j] = pack2(s[(kg * 16 + 2 * j) * 65 + n], s[(kg * 16 + 2 * j + 1) * 65 + n]);
        uint4* o = (uint4*)(cur.dst + (size_t)(cur.n0 + n) * DM + cur.k0 + kg * 16);
        o[0] = make_uint4(w[0], w[1], w[2], w[3]);
        o[1] = make_uint4(w[4], w[5], w[6], w[7]);
        __syncthreads();
        cur = nx; cidx = nxt;
    }
}

__device__ void p0_rope_item(const Params& p, int it) {
    float* rope = (float*)(p.ws + WS_ROPE);
#pragma unroll
    for (int q = 0; q < 4; ++q) {
        const int e = it * 2048 + q * 512 + opq_tid();
        if (e < 4097 * 8) {
            const int idx = e >> 3, i = e & 7;
            double invf = 1.0;
            for (int q = 0; q < i; ++q) invf *= 0.19392274474868576;
            const double pos = idx < 4096 ? (double)idx : 16384.0;
            const double rev = pos * invf * 0.15915494309189535;
            const float f = (float)(rev - floor(rev));
            rope[idx * 16 + i] = __builtin_amdgcn_cosf(f);
            rope[idx * 16 + 8 + i] = __builtin_amdgcn_sinf(f);
        }
    }
}

__device__ void p0_wfrag_item(const Params& p, int it) {
    const int e0 = it * 512 + opq_tid();
    const int lane = e0 & 63, ks = (e0 >> 6) & 1, ct = (e0 >> 7) & 3, hd = (e0 >> 9) & 15, mtx = (e0 >> 13) & 1, l = e0 >> 14;
    const float* W = (mtx == 0 ? p.w_decay : p.w_iclr) + (size_t)l * 64 * 1024 + hd * 64 + 16 * ct + (lane & 15);
    const int k0 = 32 * ks + 8 * (lane >> 4);
    float v[8];
#pragma unroll
    for (int e = 0; e < 8; ++e) v[e] = W[(size_t)(k0 + e) * 1024];
    ((uint4*)(p.ws + WS_WFRAG))[e0] = make_uint4(pack2(v[0], v[1]), pack2(v[2], v[3]), pack2(v[4], v[5]), pack2(v[6], v[7]));
}

__device__ void p1_norm(const Params& p, int l, int bid, int G) {
    const int tid = opq_tid(), wv = tid >> 6, lane = tid & 63;
    bf16_t* hb = (bf16_t*)(p.ws + WS_HB);
    const float* mod = (const float*)(p.ws + WS_MOD);
    const float4* g4 = (const float4*)(p.norm_g + l * DM);
    for (int r = bid * 8 + wv; r < MT; r += G * 8) {
        const float* xr = l == 0 ? (r < TP ? p.x_prompt + (size_t)r * DM : p.x_sample + (size_t)(r - TP) * DM) : p.out + (size_t)r * DM;
        const int mrow = r < TP ? (r >> 12) : 2 + (r - TP);
        const float* md = mod + ((size_t)l * 34 + mrow) * 6144;
        float4 v[8]; float ss = 0.f;
#pragma unroll
        for (int i = 0; i < 8; ++i) { v[i] = ((const float4*)xr)[lane + 64 * i]; ss += v[i].x * v[i].x + v[i].y * v[i].y + v[i].z * v[i].z + v[i].w * v[i].w; }
        ss = wave_sum(ss);
        const float rinv = rsqrtf(ss * (1.f / 2048.f) + 1e-5f);
#pragma unroll
        for (int i = 0; i < 8; ++i) {
            const int c4 = lane + 64 * i;
            const float4 g = g4[c4], sc = ((const float4*)(md + 2048))[c4], sh = ((const float4*)md)[c4];
            const float y0 = v[i].x * rinv * g.x * (1.f + sc.x) + sh.x, y1 = v[i].y * rinv * g.y * (1.f + sc.y) + sh.y;
            const float y2 = v[i].z * rinv * g.z * (1.f + sc.z) + sh.z, y3 = v[i].w * rinv * g.w * (1.f + sc.w) + sh.w;
            *(uint2*)(hb + (size_t)r * DM + 4 * c4) = make_uint2(pack2(y0, y1), pack2(y2, y3));
        }
    }
}

struct Epi1 {
    static constexpr bool PERM = false, AFTER_DRAIN = false;
    int l;
    __device__ __forceinline__ void operator()(const f32x4 (&acc)[2][2][4][2], const pg8::Unit& u, int wr, int wc, int fr, int fq) const {
        const Params& p = kparams();
        bf16_t* const qb = (bf16_t*)(p.ws + WS_QB); bf16_t* const kb = (bf16_t*)(p.ws + WS_KB); bf16_t* const vb = (bf16_t*)(p.ws + WS_VB);
        bf16_t* const rw = (bf16_t*)(p.ws + WS_RW); bf16_t* const gt = (bf16_t*)(p.ws + WS_GT); const float* const rope = (const float*)(p.ws + WS_ROPE); float* const out = p.out;
#pragma unroll
        for (int bj = 0; bj < 2; ++bj)
#pragma unroll
            for (int n = 0; n < 2; ++n) {
                const int cb = u.pn * 256 + bj * 128 + wc * 32 + n * 16;
                if (cb >= INW) continue;
                const int c = cb + 4 * fq;
                const bool do_rope = (cb < 1280) && ((cb & 63) == 0);
#pragma unroll
                for (int ai = 0; ai < 2; ++ai)
#pragma unroll
                    for (int m = 0; m < 4; ++m) {
                        const int rb = u.pm * 256 + ai * 128 + wr * 64 + m * 16;
                        if (rb >= MT) continue;
                        const int r = rb + fr;
                        f32x4 v = acc[ai][bj][m][n];
                        if (do_rope) {
                            const int idx = r < TP ? (r & 4095) : 4096;
                            const float4 cs = *(const float4*)(rope + idx * 16 + 4 * (fq & 1));
                            const float4 sn = *(const float4*)(rope + idx * 16 + 8 + 4 * (fq & 1));
                            const float p0 = __shfl_xor(v[0], 32), p1 = __shfl_xor(v[1], 32), p2 = __shfl_xor(v[2], 32), p3 = __shfl_xor(v[3], 32);
                            const float sg = fq < 2 ? -1.f : 1.f;
                            v[0] = v[0] * cs.x + sg * p0 * sn.x; v[1] = v[1] * cs.y + sg * p1 * sn.y; v[2] = v[2] * cs.z + sg * p2 * sn.z; v[3] = v[3] * cs.w + sg * p3 * sn.w;
                        }
                        if (cb < 1024) {
                            *(uint2*)(qb + (size_t)r * 1024 + c) = make_uint2(pack2(v[0] * 0.125f, v[1] * 0.125f), pack2(v[2] * 0.125f, v[3] * 0.125f));
                        } else if (cb < 1536) {
                            const bool isk = cb < 1280;
                            const int cc = c - (isk ? 1024 : 1280);
                            *(uint2*)((isk ? kb : vb) + (size_t)r * 256 + cc) = make_uint2(pack2(v[0], v[1]), pack2(v[2], v[3]));
                            if (r >= TP) {
                                *(f32x4*)(out + (isk ? O_CKS : O_CVS) + ((size_t)(l * NBS + (r - TP)) * 128 + 127) * 256 + cc) = v;
                            } else if ((r & 4095) >= SEQ - 128) {
                                *(f32x4*)(out + (isk ? O_CKP : O_CVP) + ((size_t)(l * NBP + (r >> 12)) * 128 + ((r & 4095) - (SEQ - 128))) * 256 + cc) = v;
                            }
                        } else if (cb < 4736) {
                            const int cc = c - 1536;
                            *(uint2*)(rw + (size_t)r * SHD + cc) = make_uint2(pack2(v[0], v[1]), pack2(v[2], v[3]));
                            if (r >= TP) *(f32x4*)(out + O_SHS + (size_t)(l * NBS + (r - TP)) * SHD + cc) = v;
                            else if ((r & 4095) == SEQ - 1) *(f32x4*)(out + O_SHP + (size_t)(l * NBP + (r >> 12)) * SHD + cc) = v;
                        } else {
                            const int cc = c - 4736;
                            *(uint2*)(gt + (size_t)r * DM + cc) = make_uint2(pack2(silu_f(v[0]), silu_f(v[1])), pack2(silu_f(v[2]), silu_f(v[3])));
                        }
                    }
            }
    }
};

struct Epi2 {
    static constexpr bool PERM = false, AFTER_DRAIN = false;
    int l;
    __device__ __forceinline__ void operator()(const f32x4 (&acc)[2][2][4][2], const pg8::Unit& u, int wr, int wc, int fr, int fq) const {
        const Params& p = kparams();
        float* const out = p.out;
        const int rb0 = u.pm * 256;
        const int mrow = rb0 < TP ? (rb0 >> 12) : 2;
        const float* gr = (const float*)(p.ws + WS_MOD) + ((size_t)l * 34 + mrow) * 6144 + 4096 + u.pn * 256 + wc * 32 + 4 * fq;
        f32x4 g4[2][2];
#pragma unroll
        for (int bj = 0; bj < 2; ++bj)
#pragma unroll
            for (int n = 0; n < 2; ++n) g4[bj][n] = *(const f32x4*)(gr + bj * 128 + n * 16);
        const float* xbase = l == 0 ? p.x_prompt : out;
        const int c0 = u.pn * 256 + wc * 32 + 4 * fq;
#pragma unroll
        for (int ai = 0; ai < 2; ++ai)
#pragma unroll
            for (int mh = 0; mh < 2; ++mh) {
                f32x4 x4[2][2][2];
#pragma unroll
                for (int mm = 0; mm < 2; ++mm) {
                    const int r = rb0 + ai * 128 + wr * 64 + (2 * mh + mm) * 16 + fr;
                    const float* xo = xbase + (size_t)r * DM + c0;
#pragma unroll
                    for (int bj = 0; bj < 2; ++bj)
#pragma unroll
                        for (int n = 0; n < 2; ++n) x4[mm][bj][n] = *(const f32x4*)(xo + bj * 128 + n * 16);
                }
                __builtin_amdgcn_sched_barrier(0);
#pragma unroll
                for (int mm = 0; mm < 2; ++mm) {
                    const int r = rb0 + ai * 128 + wr * 64 + (2 * mh + mm) * 16 + fr;
                    float* yo = out + (size_t)r * DM + c0;
#pragma unroll
                    for (int bj = 0; bj < 2; ++bj)
#pragma unroll
                        for (int n = 0; n < 2; ++n) *(f32x4*)(yo + bj * 128 + n * 16) = x4[mm][bj][n] + g4[bj][n] * acc[ai][bj][2 * mh + mm][n];
                }
                __builtin_amdgcn_sched_barrier(0);
            }
    }
};

__device__ void g2_sample_item(const Params& p, float* red, int l, int nb) {
    const int tid = opq_tid(), wv = tid >> 6, lane = tid & 63, n = lane & 31, h = lane >> 5;
    const bf16_t* A = (const bf16_t*)(p.ws + WS_HB) + (size_t)TP * DM;
    const bf16_t* Bt = (const bf16_t*)(p.ws + WS_WTOUT) + (size_t)l * DM * DM + (size_t)(nb * 32) * DM;
    f32x16 acc;
#pragma unroll
    for (int i = 0; i < 16; ++i) acc[i] = 0.f;
#pragma unroll 4
    for (int ks = 0; ks < 16; ++ks) {
        const int k0 = wv * 256 + ks * 16 + 8 * h;
        const bf16x8 a = *(const bf16x8*)(A + (size_t)n * DM + k0);
        const bf16x8 bq = *(const bf16x8*)(Bt + (size_t)n * DM + k0);
        acc = __builtin_amdgcn_mfma_f32_32x32x16_bf16(a, bq, acc, 0, 0, 0);
    }
#pragma unroll
    for (int i = 0; i < 16; ++i) red[(wv * 16 + i) * 64 + lane] = acc[i];
    __syncthreads();
    const float* mod = (const float*)(p.ws + WS_MOD) + (size_t)l * 34 * 6144;
    for (int o = tid; o < 1024; o += 512) {
        const int row = o >> 5, col = o & 31, hh = (row >> 2) & 1, ri = (row & 3) + 4 * (row >> 3), ln = col + 32 * hh;
        float s = 0.f;
#pragma unroll
        for (int w = 0; w < 8; ++w) s += red[(w * 16 + ri) * 64 + ln];
        const int c = nb * 32 + col;
        const float gate = mod[(size_t)(2 + row) * 6144 + 4096 + c];
        const float xo = l == 0 ? p.x_sample[(size_t)row * DM + c] : p.out[(size_t)(TP + row) * DM + c];
        p.out[(size_t)(TP + row) * DM + c] = xo + gate * s;
    }
    __syncthreads();
}

__device__ void p3_attn_unit(const Params& p, unsigned char* lds, int l, int unit) {
    const int tid = opq_tid(), wv = tid >> 6, lane = tid & 63;
    const int b = unit >> 7, n = (unit >> 2) & 31, g = unit & 3;
    bf16_t* Ks = (bf16_t*)lds;
    bf16_t* Vt = (bf16_t*)(lds + 36864);
    const bf16_t* qb = (const bf16_t*)(p.ws + WS_QB);
    const bf16_t* kb = (const bf16_t*)(p.ws + WS_KB);
    const bf16_t* vb = (const bf16_t*)(p.ws + WS_VB);
    const bf16_t* gt = (const bf16_t*)(p.ws + WS_GT);
    bf16_t* cc = (bf16_t*)(p.ws + WS_HB);
    {
        uint4 kv4[4], vv4[4];
#pragma unroll
        for (int i = 0; i < 4; ++i) {
            const int chunk = tid + 512 * i, kl = chunk >> 3, dc = chunk & 7, kp = 128 * (n - 1) + kl;
            kv4[i] = make_uint4(0u, 0u, 0u, 0u); vv4[i] = kv4[i];
            if (kp >= 0) { const size_t row = (size_t)b * SEQ + kp; kv4[i] = *(const uint4*)(kb + row * 256 + g * 64 + dc * 8); vv4[i] = *(const uint4*)(vb + row * 256 + g * 64 + dc * 8); }
        }
        __builtin_amdgcn_sched_barrier(0);
#pragma unroll
        for (int i = 0; i < 4; ++i) {
            const int chunk = tid + 512 * i, kl = chunk >> 3, dc = chunk & 7;
            *(uint4*)(Ks + kl * 72 + dc * 8) = kv4[i];
            bf16_t* vd = Vt + (dc * 8) * 264 + kl;
            vd[0 * 264] = (bf16_t)(vv4[i].x & 0xffffu); vd[1 * 264] = (bf16_t)(vv4[i].x >> 16);
            vd[2 * 264] = (bf16_t)(vv4[i].y & 0xffffu); vd[3 * 264] = (bf16_t)(vv4[i].y >> 16);
            vd[4 * 264] = (bf16_t)(vv4[i].z & 0xffffu); vd[5 * 264] = (bf16_t)(vv4[i].z >> 16);
            vd[6 * 264] = (bf16_t)(vv4[i].w & 0xffffu); vd[7 * 264] = (bf16_t)(vv4[i].w >> 16);
        }
    }
    __syncthreads();
    const int hq = 4 * g + (wv >> 1), qh = wv & 1, q32 = lane & 31, h = lane >> 5;
    const float sink = p.sinks[l * 16 + hq];
#pragma unroll 1
    for (int s = 0; s < 2; ++s) {
        const int qp = 128 * n + 64 * qh + 32 * s + q32;
        const size_t qrow = (size_t)b * SEQ + qp;
        const int klb0 = 64 * qh + 32 * s;
        bf16x8 qf[4];
#pragma unroll
        for (int ks = 0; ks < 4; ++ks) qf[ks] = *(const bf16x8*)(qb + qrow * 1024 + hq * 64 + ks * 16 + 8 * h);
        f32x16 S[5];
#pragma unroll
        for (int kt = 0; kt < 5; ++kt) {
#pragma unroll
            for (int i = 0; i < 16; ++i) S[kt][i] = 0.f;
#pragma unroll
            for (int ks = 0; ks < 4; ++ks) {
                const bf16x8 a = *(const bf16x8*)(Ks + (klb0 + 32 * kt + q32) * 72 + ks * 16 + 8 * h);
                S[kt] = __builtin_amdgcn_mfma_f32_32x32x16_bf16(a, qf[ks], S[kt], 0, 0, 0);
            }
        }
        float mx = -1e30f;
#pragma unroll
        for (int kt = 0; kt < 5; ++kt)
#pragma unroll
            for (int i = 0; i < 16; ++i) {
                const int m = 8 * (i >> 2) + 4 * h + (i & 3);
                const int kp = 128 * (n - 1) + klb0 + 32 * kt + m;
                const int rel = qp - kp;
                const bool ok = (rel >= 0) && (rel <= 128) && (kp >= 0);
                const float sv = ok ? S[kt][i] : -1e30f;
                S[kt][i] = sv; mx = fmaxf(mx, sv);
            }
        mx = fmaxf(mx, __shfl_xor(mx, 32));
        mx = fmaxf(mx, sink);
        float sum = 0.f;
#pragma unroll
        for (int kt = 0; kt < 5; ++kt)
#pragma unroll
            for (int i = 0; i < 16; ++i) { const float e = __expf(S[kt][i] - mx); S[kt][i] = e; sum += e; }
        sum += __shfl_xor(sum, 32);
        const float inv = 1.f / (sum + __expf(sink - mx));
        f32x16 O[2];
#pragma unroll
        for (int i = 0; i < 16; ++i) { O[0][i] = 0.f; O[1][i] = 0.f; }
#pragma unroll
        for (int kt = 0; kt < 5; ++kt)
#pragma unroll
            for (int sp = 0; sp < 2; ++sp) {
                bf16x8 pf;
#pragma unroll
                for (int j = 0; j < 8; ++j) pf[j] = (short)f2bf(S[kt][8 * sp + j]);
#pragma unroll
                for (int dt = 0; dt < 2; ++dt) {
                    const bf16_t* vp = Vt + (32 * dt + q32) * 264 + klb0 + 32 * kt + 16 * sp + 4 * h;
                    const uint2 lo = *(const uint2*)vp, hi = *(const uint2*)(vp + 8);
                    const uint4 av = make_uint4(lo.x, lo.y, hi.x, hi.y);
                    O[dt] = __builtin_amdgcn_mfma_f32_32x32x16_bf16(__builtin_bit_cast(bf16x8, av), pf, O[dt], 0, 0, 0);
                }
            }
        uint2 gq[2][4];
#pragma unroll
        for (int dt = 0; dt < 2; ++dt)
#pragma unroll
            for (int ig = 0; ig < 4; ++ig) gq[dt][ig] = *(const uint2*)(gt + qrow * DM + hq * 64 + 32 * dt + 8 * ig + 4 * h);
        __builtin_amdgcn_sched_barrier(0);
#pragma unroll
        for (int dt = 0; dt < 2; ++dt)
#pragma unroll
            for (int ig = 0; ig < 4; ++ig) {
                const int col = hq * 64 + 32 * dt + 8 * ig + 4 * h;
                const uint2 gg = gq[dt][ig];
                const float o0 = O[dt][4 * ig + 0] * inv * bflo(gg.x), o1 = O[dt][4 * ig + 1] * inv * bfhi(gg.x);
                const float o2 = O[dt][4 * ig + 2] * inv * bflo(gg.y), o3 = O[dt][4 * ig + 3] * inv * bfhi(gg.y);
                *(uint2*)(cc + qrow * DM + col) = make_uint2(pack2(o0, o1), pack2(o2, o3));
            }
    }
    __syncthreads();
}

__device__ void p3_sattn_item(const Params& p, float* lds, int l, int item) {
    const int tid = opq_tid(), wv = tid >> 6, lane = tid & 63;
    float* pl = lds + wv * 128;
    const int w = item * 8 + wv, bd = w >> 4, hq = w & 15, g = hq >> 2;
    const size_t row = (size_t)TP + bd;
    const bf16_t* qb = (const bf16_t*)(p.ws + WS_QB);
    const bf16_t* gt = (const bf16_t*)(p.ws + WS_GT);
    bf16_t* cc = (bf16_t*)(p.ws + WS_HB);
    float q[64];
#pragma unroll
    for (int c = 0; c < 8; ++c) {
        const uint4 u = *(const uint4*)(qb + row * 1024 + hq * 64 + c * 8);
        q[c * 8 + 0] = bflo(u.x); q[c * 8 + 1] = bfhi(u.x); q[c * 8 + 2] = bflo(u.y); q[c * 8 + 3] = bfhi(u.y);
        q[c * 8 + 4] = bflo(u.z); q[c * 8 + 5] = bfhi(u.z); q[c * 8 + 6] = bflo(u.w); q[c * 8 + 7] = bfhi(u.w);
    }
    const size_t cbase = ((size_t)(l * NBS + bd) * 128) * 256 + g * 64;
    const float* ck = p.cache_k + cbase;
    const float* cv = p.cache_v + cbase;
    float* nk = p.out + O_CKS + cbase;
    float* nv = p.out + O_CVS + cbase;
    float s0 = 0.f, s1 = 0.f, s2 = 0.f;
#pragma unroll
    for (int c = 0; c < 16; ++c) {
        const float4 a = ((const float4*)(ck + (size_t)lane * 256))[c];
        const float4 bq = ((const float4*)(ck + (size_t)(lane + 64) * 256))[c];
        const float4 e = ((const float4*)(nk + (size_t)127 * 256))[c];
        s0 += a.x * q[4 * c] + a.y * q[4 * c + 1] + a.z * q[4 * c + 2] + a.w * q[4 * c + 3];
        s1 += bq.x * q[4 * c] + bq.y * q[4 * c + 1] + bq.z * q[4 * c + 2] + bq.w * q[4 * c + 3];
        s2 += e.x * q[4 * c] + e.y * q[4 * c + 1] + e.z * q[4 * c + 2] + e.w * q[4 * c + 3];
    }
    const float sink = p.sinks[l * 16 + hq];
    const float mx = fmaxf(wave_max(fmaxf(s0, s1)), fmaxf(s2, sink));
    const float p0 = __expf(s0 - mx), p1 = __expf(s1 - mx), p2 = __expf(s2 - mx);
    const float sum = wave_sum(p0 + p1) + p2 + __expf(sink - mx);
    pl[lane] = p0; pl[lane + 64] = p1;
    __builtin_amdgcn_fence(__ATOMIC_RELEASE, "wavefront");
    __builtin_amdgcn_wave_barrier();
    __builtin_amdgcn_fence(__ATOMIC_ACQUIRE, "wavefront");
    float o = 0.f;
#pragma unroll 32
    for (int key = 0; key < 128; ++key) o += pl[key] * cv[(size_t)key * 256 + lane];
    o += p2 * nv[(size_t)127 * 256 + lane];
    o /= sum;
    const float gate = bf2f(gt[row * DM + hq * 64 + lane]);
    cc[row * DM + hq * 64 + lane] = f2bf(o * gate);
    {
        float tk[32], tv[32];
#pragma unroll
        for (int i = 0; i < 32; ++i) {
            const int ww = (hq & 3) + 4 * i;
            tk[i] = ck[(size_t)(ww + 1 < 128 ? ww + 1 : 127) * 256 + lane]; tv[i] = cv[(size_t)(ww + 1 < 128 ? ww + 1 : 127) * 256 + lane];
        }
#pragma unroll
        for (int i = 0; i < 32; ++i) {
            const int ww = (hq & 3) + 4 * i;
            if (ww < 127) { nk[(size_t)ww * 256 + lane] = tk[i]; nv[(size_t)ww * 256 + lane] = tv[i]; }
        }
    }
    __builtin_amdgcn_wave_barrier();
}

__device__ __forceinline__ float mix_val(const bf16_t* rw, const float* sshift, const float* mu, int r, int c) {
    const float cur = bf2f(rw[(size_t)r * SHD + c]);
    float prev;
    if (r >= TP) prev = sshift[(size_t)(r - TP) * SHD + c];
    else if ((r & 4095) == 0) prev = 0.f;
    else prev = bf2f(rw[(size_t)(r - 1) * SHD + c]);
    return cur + (prev - cur) * mu[c];
}

__device__ __forceinline__ float4 mix4(const bf16_t* rw, const float* sshift, int r, int c, float4 mu4) {
    const uint2 cu = *(const uint2*)(rw + (size_t)r * SHD + c);
    const float4 cur = make_float4(bflo(cu.x), bfhi(cu.x), bflo(cu.y), bfhi(cu.y));
    float4 prev = make_float4(0.f, 0.f, 0.f, 0.f);
    if (r >= TP) prev = *(const float4*)(sshift + (size_t)(r - TP) * SHD + c);
    else if ((r & 4095) != 0) { const uint2 pu = *(const uint2*)(rw + (size_t)(r - 1) * SHD + c); prev = make_float4(bflo(pu.x), bfhi(pu.x), bflo(pu.y), bfhi(pu.y)); }
    return make_float4(cur.x + (prev.x - cur.x) * mu4.x, cur.y + (prev.y - cur.y) * mu4.y, cur.z + (prev.z - cur.z) * mu4.z, cur.w + (prev.w - cur.w) * mu4.w);
}
__device__ __forceinline__ float decay_of(float x) {
    const float z = -x;
    const float sp = fmaxf(z, 0.f) + __logf(1.f + __expf(-fabsf(z)));
    return __expf(-__expf(-sp - 0.5f));
}

__device__ void p3_twad_item(const Params& p, int l, int tile) {
    const int tid = opq_tid();
    const bf16_t* rw = (const bf16_t*)(p.ws + WS_RW);
    const float* sshift = p.state_shift + (size_t)l * NBS * SHD;
    const float* mu = p.mu_shift + l * SHD;
    bf16_t* TWAD = (bf16_t*)(p.ws + WS_TWAD);
    const int r0 = tile * 32;
    float mm[8];
#pragma unroll
    for (int i = 0; i < 8; ++i) { const int idx = tid + 512 * i, tt = idx >> 7, c2 = idx & 127; mm[i] = mix_val(rw, sshift, mu, r0 + tt, 3072 + c2); }
#pragma unroll
    for (int i = 0; i < 8; ++i) {
        const int idx = tid + 512 * i, tt = idx >> 7, c2 = idx & 127;
        float o = mm[i];
        if (c2 < 64) { const float e = __expf(2.f * mm[i]); o = 1.f - 2.f / (e + 1.f); }
        TWAD[(size_t)(r0 + tt) * 128 + c2] = f2bf(o);
    }
}

__device__ void p3_prep_tile(const Params& p, unsigned char* lds, int l, int tile) {
    const int tid = opq_tid(), wv = tid >> 6, lane = tid & 63, n = lane & 31, h = lane >> 5;
    bf16_t* TW = (bf16_t*)lds;
    bf16_t* AD = TW + 32 * 72;
    const bf16_t* rw = (const bf16_t*)(p.ws + WS_RW);
    const float* sshift = p.state_shift + (size_t)l * NBS * SHD;
    const float* mu = p.mu_shift + l * SHD;
    bf16_t* RSB = (bf16_t*)(p.ws + WS_RSB);
    bf16_t* VALL = (bf16_t*)(p.ws + WS_VALL);
    float* RSW = (float*)(p.ws + WS_RSW);
    float* coef = (float*)(p.ws + WS_COEF);
    const int r0 = tile * 32;
    {
        float mm[8];
#pragma unroll
        for (int i = 0; i < 8; ++i) { const int idx = tid + 512 * i, tt = idx >> 7, c2 = idx & 127; mm[i] = mix_val(rw, sshift, mu, r0 + tt, 3072 + c2); }
        __builtin_amdgcn_sched_barrier(0);
#pragma unroll
        for (int i = 0; i < 8; ++i) {
            const int idx = tid + 512 * i, tt = idx >> 7, c2 = idx & 127;
            if (c2 < 64) { const float e = __expf(2.f * mm[i]); TW[tt * 72 + c2] = f2bf(1.f - 2.f / (e + 1.f)); }
            else AD[tt * 72 + (c2 - 64)] = f2bf(mm[i]);
        }
    }
    __syncthreads();
    const int col0 = wv * 128 + 4 * n;
    f32x16 acc[4];
    {
        const float* wp = p.w_decay + (size_t)l * 64 * 1024 + col0;
#pragma unroll
        for (int nt = 0; nt < 4; ++nt)
#pragma unroll
            for (int i = 0; i < 16; ++i) acc[nt][i] = 0.f;
#pragma unroll
        for (int ks = 0; ks < 4; ++ks) {
            const bf16x8 a = *(const bf16x8*)(TW + n * 72 + 16 * ks + 8 * h);
            float4 w4[8];
#pragma unroll
            for (int e = 0; e < 8; ++e) w4[e] = *(const float4*)(wp + (size_t)(16 * ks + 8 * h + e) * 1024);
            bf16x8 b0, b1, b2, b3;
#pragma unroll
            for (int e = 0; e < 8; ++e) { b0[e] = (short)f2bf(w4[e].x); b1[e] = (short)f2bf(w4[e].y); b2[e] = (short)f2bf(w4[e].z); b3[e] = (short)f2bf(w4[e].w); }
            acc[0] = __builtin_amdgcn_mfma_f32_32x32x16_bf16(a, b0, acc[0], 0, 0, 0);
            acc[1] = __builtin_amdgcn_mfma_f32_32x32x16_bf16(a, b1, acc[1], 0, 0, 0);
            acc[2] = __builtin_amdgcn_mfma_f32_32x32x16_bf16(a, b2, acc[2], 0, 0, 0);
            acc[3] = __builtin_amdgcn_mfma_f32_32x32x16_bf16(a, b3, acc[3], 0, 0, 0);
        }
        const float4 w0c = *(const float4*)(p.w0 + l * 1024 + col0);
#pragma unroll
        for (int r = 0; r < 16; ++r) {
            const int row = r0 + 8 * (r >> 2) + 4 * h + (r & 3);
            *(float4*)(RSW + (size_t)(row - TP) * 1024 + col0) =
                make_float4(decay_of(w0c.x + acc[0][r]), decay_of(w0c.y + acc[1][r]), decay_of(w0c.z + acc[2][r]), decay_of(w0c.w + acc[3][r]));
        }
    }
    {
        const float* wp = p.w_iclr + (size_t)l * 64 * 1024 + col0;
#pragma unroll
        for (int nt = 0; nt < 4; ++nt)
#pragma unroll
            for (int i = 0; i < 16; ++i) acc[nt][i] = 0.f;
#pragma unroll
        for (int ks = 0; ks < 4; ++ks) {
            const bf16x8 a = *(const bf16x8*)(AD + n * 72 + 16 * ks + 8 * h);
            float4 w4[8];
#pragma unroll
            for (int e = 0; e < 8; ++e) w4[e] = *(const float4*)(wp + (size_t)(16 * ks + 8 * h + e) * 1024);
            bf16x8 b0, b1, b2, b3;
#pragma unroll
            for (int e = 0; e < 8; ++e) { b0[e] = (short)f2bf(w4[e].x); b1[e] = (short)f2bf(w4[e].y); b2[e] = (short)f2bf(w4[e].z); b3[e] = (short)f2bf(w4[e].w); }
            acc[0] = __builtin_amdgcn_mfma_f32_32x32x16_bf16(a, b0, acc[0], 0, 0, 0);
            acc[1] = __builtin_amdgcn_mfma_f32_32x32x16_bf16(a, b1, acc[1], 0, 0, 0);
            acc[2] = __builtin_amdgcn_mfma_f32_32x32x16_bf16(a, b2, acc[2], 0, 0, 0);
            acc[3] = __builtin_amdgcn_mfma_f32_32x32x16_bf16(a, b3, acc[3], 0, 0, 0);
        }
    }
    const float4 a0c = *(const float4*)(p.a0 + l * 1024 + col0), kkc = *(const float4*)(p.k_k + l * 1024 + col0), kac = *(const float4*)(p.k_a + l * 1024 + col0), rkc = *(const float4*)(p.r_k + l * 1024 + col0);
    const float4 mur = *(const float4*)(mu + col0), muk = *(const float4*)(mu + 1024 + col0), muv = *(const float4*)(mu + 2048 + col0);
    const int head = 2 * wv + (n >> 4);
#pragma unroll
    for (int g4 = 0; g4 < 4; ++g4) {
        float4 rr4[4], kr4[4], vr4[4];
#pragma unroll
        for (int q = 0; q < 4; ++q) {
            const int row = r0 + 8 * g4 + 4 * h + q;
            rr4[q] = mix4(rw, sshift, row, col0, mur); kr4[q] = mix4(rw, sshift, row, 1024 + col0, muk); vr4[q] = mix4(rw, sshift, row, 2048 + col0, muv);
        }
        __builtin_amdgcn_sched_barrier(0);
#pragma unroll
        for (int q = 0; q < 4; ++q) {
            const int r = 4 * g4 + q;
            const int row = r0 + 8 * g4 + 4 * h + q;
            const float4 rr = rr4[q], kr = kr4[q], vr = vr4[q];
            const float ax = 1.f / (1.f + __expf(-(a0c.x + acc[0][r]))), ay = 1.f / (1.f + __expf(-(a0c.y + acc[1][r])));
            const float az = 1.f / (1.f + __expf(-(a0c.z + acc[2][r]))), aw = 1.f / (1.f + __expf(-(a0c.w + acc[3][r])));
            const float k0 = kr.x * kkc.x, k1 = kr.y * kkc.y, k2 = kr.z * kkc.z, k3 = kr.w * kkc.w;
            const float ss = allreduce16(k0 * k0 + k1 * k1 + k2 * k2 + k3 * k3);
            const float inv = 1.f / fmaxf(sqrtf(ss), 1e-12f);
            const float4 kk = make_float4(k0 * inv, k1 * inv, k2 * inv, k3 * inv);
            const float4 ke = make_float4(kr.x * (1.f + (ax - 1.f) * kac.x), kr.y * (1.f + (ay - 1.f) * kac.y), kr.z * (1.f + (az - 1.f) * kac.z), kr.w * (1.f + (aw - 1.f) * kac.w));
            const float cf = allreduce16(rr.x * ke.x * rkc.x + rr.y * ke.y * rkc.y + rr.z * ke.z * rkc.z + rr.w * ke.w * rkc.w);
            if ((n & 15) == 0) coef[(size_t)row * 16 + head] = cf;
            const size_t o = (size_t)row * 1024 + col0;
            const size_t os = (size_t)(row - TP) * 1024 + col0;
            *(uint2*)(RSB + os) = make_uint2(pack2(rr.x, rr.y), pack2(rr.z, rr.w));
            *(uint2*)(RSB + SRI + os) = make_uint2(pack2(ke.x, ke.y), pack2(ke.z, ke.w));
            *(uint2*)(RSB + 2 * SRI + os) = make_uint2(pack2(kk.x, kk.y), pack2(kk.z, kk.w));
            *(uint2*)(RSB + 3 * SRI + os) = make_uint2(pack2(kk.x * ax, kk.y * ay), pack2(kk.z * az, kk.w * aw));
            *(uint2*)(VALL + o) = make_uint2(pack2(vr.x, vr.y), pack2(vr.z, vr.w));
        }
        __builtin_amdgcn_sched_barrier(0);
    }
    __syncthreads();
}

constexpr int REC_BYTES = 14592;
constexpr int PA_WLDS = 16384;
typedef float f32x4v __attribute__((ext_vector_type(4)));

__device__ void pa_chunk(const Params& p, unsigned char* wl, int l, int ct) {
    const int lane = opq_tid() & 63;
    const int hh = ct >> 8, c = ct & 255, b = hh >> 4, h = hh & 15;
    const size_t row0 = (size_t)b * SEQ + 16 * c;
    const int col = h * 64 + lane;
    bf16_t* VALL = (bf16_t*)(p.ws + WS_VALL);
    float vv[16];
    float gC;
    bf16_t* S_AB = (bf16_t*)wl; bf16_t* S_BB = S_AB + 16 * 72; bf16_t* S_KB = S_BB + 16 * 72; bf16_t* S_RT = S_KB + 16 * 72;
    {
        const bf16_t* rw = (const bf16_t*)(p.ws + WS_RW);
        const bf16_t* TWAD = (const bf16_t*)(p.ws + WS_TWAD);
        const uint4* WFd = (const uint4*)(p.ws + WS_WFRAG) + (size_t)((l * 2 + 0) * 16 + h) * 512 + lane;
        const uint4* WFi = (const uint4*)(p.ws + WS_WFRAG) + (size_t)((l * 2 + 1) * 16 + h) * 512 + lane;
        unsigned xr[17], xk[17], xv[17];
        const bool first = (row0 & 4095) == 0;
#pragma unroll
        for (int t = 0; t < 17; ++t) {
            const unsigned ro = (unsigned)(row0 + t - 1) * (unsigned)SHD + (unsigned)col;
            if (t == 0 && first) { xr[0] = 0u; xk[0] = 0u; xv[0] = 0u; }
            else { xr[t] = rw[ro]; xk[t] = rw[ro + 1024u]; xv[t] = rw[ro + 2048u]; }
        }
        const int rr = lane & 15, kg = lane >> 4;
        f32x4v Dd[4], Da[4];
#pragma unroll
        for (int ct = 0; ct < 4; ++ct) { Dd[ct] = (f32x4v){0.f, 0.f, 0.f, 0.f}; Da[ct] = Dd[ct]; }
#pragma unroll
        for (int ks = 0; ks < 2; ++ks) {
            const bf16x8 atw = *(const bf16x8*)(TWAD + (size_t)(row0 + rr) * 128 + 32 * ks + 8 * kg);
            const bf16x8 aad = *(const bf16x8*)(TWAD + (size_t)(row0 + rr) * 128 + 64 + 32 * ks + 8 * kg);
#pragma unroll
            for (int ct = 0; ct < 4; ++ct) {
                const bf16x8 bd = __builtin_bit_cast(bf16x8, WFd[(ct * 2 + ks) * 64]);
                const bf16x8 bi = __builtin_bit_cast(bf16x8, WFi[(ct * 2 + ks) * 64]);
                Dd[ct] = __builtin_amdgcn_mfma_f32_16x16x32_bf16(atw, bd, Dd[ct], 0, 0, 0);
                Da[ct] = __builtin_amdgcn_mfma_f32_16x16x32_bf16(aad, bi, Da[ct], 0, 0, 0);
            }
        }
        float* LD = (float*)wl; float* LA = LD + 1024;
#pragma unroll
        for (int ct = 0; ct < 4; ++ct)
#pragma unroll
            for (int rg = 0; rg < 4; ++rg) { LD[(4 * kg + rg) * 64 + 16 * ct + rr] = Dd[ct][rg]; LA[(4 * kg + rg) * 64 + 16 * ct + rr] = Da[ct][rg]; }
        __builtin_amdgcn_fence(__ATOMIC_RELEASE, "wavefront"); __builtin_amdgcn_wave_barrier(); __builtin_amdgcn_fence(__ATOMIC_ACQUIRE, "wavefront");
        float din[16], ain[16];
#pragma unroll
        for (int t = 0; t < 16; ++t) { din[t] = LD[t * 64 + lane]; ain[t] = LA[t * 64 + lane]; }
        __builtin_amdgcn_fence(__ATOMIC_RELEASE, "wavefront"); __builtin_amdgcn_wave_barrier(); __builtin_amdgcn_fence(__ATOMIC_ACQUIRE, "wavefront");
        const float mur = p.mu_shift[l * SHD + col], muk = p.mu_shift[l * SHD + 1024 + col], muv = p.mu_shift[l * SHD + 2048 + col];
        const float w0c = p.w0[l * 1024 + col], a0c = p.a0[l * 1024 + col], kkc = p.k_k[l * 1024 + col], kac = p.k_a[l * 1024 + col], rkc = p.r_k[l * 1024 + col];
        float* coef = (float*)(p.ws + WS_COEF);
        float g = 1.f;
#pragma unroll
        for (int t = 0; t < 16; ++t) {
            const float cr = bf2f((unsigned short)xr[t + 1]), pr = bf2f((unsigned short)xr[t]), ck = bf2f((unsigned short)xk[t + 1]), pk = bf2f((unsigned short)xk[t]);
            const float cv = bf2f((unsigned short)xv[t + 1]), pv = bf2f((unsigned short)xv[t]);
            const float r_ = cr + (pr - cr) * mur, kr = ck + (pk - ck) * muk, vr = cv + (pv - cv) * muv;
            const float a = 1.f / (1.f + __expf(-(a0c + ain[t])));
            const float dec = decay_of(w0c + din[t]);
            const float kkr = kr * kkc;
            float ss = allreduce16(kkr * kkr); ss += __shfl_xor(ss, 16); ss += __shfl_xor(ss, 32);
            const float kkv = kkr / fmaxf(sqrtf(ss), 1e-12f);
            const float ke = kr * (1.f + (a - 1.f) * kac);
            float cf = allreduce16(r_ * ke * rkc); cf += __shfl_xor(cf, 16); cf += __shfl_xor(cf, 32);
            if (lane == 0) coef[(size_t)(row0 + t) * 16 + h] = cf;
            VALL[(unsigned)(row0 + t) * 1024u + (unsigned)col] = f2bf(vr);
            vv[t] = vr;
            S_AB[t * 72 + lane] = f2bf(-g * kkv);
            g *= dec;
            const float ig = __builtin_amdgcn_rcpf(g);
            S_BB[t * 72 + lane] = f2bf(kkv * a * ig); S_KB[t * 72 + lane] = f2bf(ke * ig); S_RT[t * 72 + lane] = f2bf(g * r_);
        }
        gC = g;
    }
    __builtin_amdgcn_fence(__ATOMIC_RELEASE, "wavefront"); __builtin_amdgcn_wave_barrier(); __builtin_amdgcn_fence(__ATOMIC_ACQUIRE, "wavefront");
    f32x4v Gab = {0.f, 0.f, 0.f, 0.f}, Gak = Gab, Grb = Gab, Grk = Gab;
    {
        const int rr = lane & 15, kg = lane >> 4;
#pragma unroll
        for (int ks = 0; ks < 2; ++ks) {
            const int o = rr * 72 + 32 * ks + 8 * kg;
            const bf16x8 fA = *(const bf16x8*)(S_AB + o), fB = *(const bf16x8*)(S_BB + o), fK = *(const bf16x8*)(S_KB + o), fR = *(const bf16x8*)(S_RT + o);
            Gab = __builtin_amdgcn_mfma_f32_16x16x32_bf16(fB, fA, Gab, 0, 0, 0);
            Gak = __builtin_amdgcn_mfma_f32_16x16x32_bf16(fK, fA, Gak, 0, 0, 0);
            Grb = __builtin_amdgcn_mfma_f32_16x16x32_bf16(fB, fR, Grb, 0, 0, 0);
            Grk = __builtin_amdgcn_mfma_f32_16x16x32_bf16(fK, fR, Grk, 0, 0, 0);
        }
    }
    __builtin_amdgcn_fence(__ATOMIC_RELEASE, "wavefront"); __builtin_amdgcn_wave_barrier(); __builtin_amdgcn_fence(__ATOMIC_ACQUIRE, "wavefront");
    float* M_AB = (float*)(wl + 9216); float* M_AK = M_AB + 256; float* M_RB = M_AK + 256; float* M_RK = M_RB + 256; float* T_ = M_RK + 256; float* Q_ = T_ + 256; float* W2_ = Q_ + 256;
    {
        const int t = lane & 15, kg = lane >> 4;
#pragma unroll
        for (int rg = 0; rg < 4; ++rg) {
            const int s = 4 * kg + rg;
            M_AB[s * 16 + t] = s < t ? Gab[rg] : 0.f; M_AK[s * 16 + t] = s < t ? Gak[rg] : 0.f;
            M_RB[s * 16 + t] = s <= t ? Grb[rg] : 0.f; M_RK[s * 16 + t] = s <= t ? Grk[rg] : 0.f;
        }
    }
    __builtin_amdgcn_fence(__ATOMIC_RELEASE, "wavefront"); __builtin_amdgcn_wave_barrier(); __builtin_amdgcn_fence(__ATOMIC_ACQUIRE, "wavefront");
    {
        const int rr = lane & 15;
        float Tr[16];
#pragma unroll
        for (int t = 0; t < 16; ++t) {
            float acc = (rr == t) ? 1.f : 0.f;
#pragma unroll
            for (int s = 0; s < t; ++s) acc += Tr[s] * M_AB[s * 16 + t];
            Tr[t] = acc;
        }
#pragma unroll
        for (int t = 0; t < 16; ++t) T_[rr * 16 + t] = Tr[t];
    }
    __builtin_amdgcn_fence(__ATOMIC_RELEASE, "wavefront"); __builtin_amdgcn_wave_barrier(); __builtin_amdgcn_fence(__ATOMIC_ACQUIRE, "wavefront");
    {
        const int s = lane & 15, tq = lane >> 4;
        float4 q = make_float4(0.f, 0.f, 0.f, 0.f);
#pragma unroll
        for (int u = 0; u < 16; ++u) { const float a = M_AK[s * 16 + u]; const float4 t4 = *(const float4*)(T_ + u * 16 + 4 * tq); q.x += a * t4.x; q.y += a * t4.y; q.z += a * t4.z; q.w += a * t4.w; }
        *(float4*)(Q_ + s * 16 + 4 * tq) = q;
        __builtin_amdgcn_fence(__ATOMIC_RELEASE, "wavefront"); __builtin_amdgcn_wave_barrier(); __builtin_amdgcn_fence(__ATOMIC_ACQUIRE, "wavefront");
        float4 w2 = *(const float4*)(M_RK + s * 16 + 4 * tq);
#pragma unroll
        for (int u = 0; u < 16; ++u) { const float a = Q_[s * 16 + u]; const float4 m4 = *(const float4*)(M_RB + u * 16 + 4 * tq); w2.x += a * m4.x; w2.y += a * m4.y; w2.z += a * m4.z; w2.w += a * m4.w; }
        *(float4*)(W2_ + s * 16 + 4 * tq) = w2;
    }
    __builtin_amdgcn_fence(__ATOMIC_RELEASE, "wavefront"); __builtin_amdgcn_wave_barrier(); __builtin_amdgcn_fence(__ATOMIC_ACQUIRE, "wavefront");
    cvt_f32x2 pt2[8], r22[8], ul2[8], yl2[8];
#pragma unroll
    for (int t = 0; t < 8; ++t) { pt2[t] = (cvt_f32x2){0.f, 0.f}; r22[t] = (cvt_f32x2){bf2f(S_RT[(2 * t) * 72 + lane]), bf2f(S_RT[(2 * t + 1) * 72 + lane])}; ul2[t] = pt2[t]; yl2[t] = pt2[t]; }
#pragma unroll
    for (int s = 0; s < 16; ++s) {
        const float as_ = bf2f(S_AB[s * 72 + lane]), vs_ = vv[s];
        const cvt_f32x2 as2 = {as_, as_}, vs2 = {vs_, vs_};
#pragma unroll
        for (int tq = 0; tq < 4; ++tq) {
            const float4 t4 = *(const float4*)(T_ + s * 16 + 4 * tq), q4 = *(const float4*)(Q_ + s * 16 + 4 * tq), w4 = *(const float4*)(W2_ + s * 16 + 4 * tq);
            pt2[2 * tq] += (cvt_f32x2){t4.x, t4.y} * as2; pt2[2 * tq + 1] += (cvt_f32x2){t4.z, t4.w} * as2;
            ul2[2 * tq] += (cvt_f32x2){q4.x, q4.y} * vs2; ul2[2 * tq + 1] += (cvt_f32x2){q4.z, q4.w} * vs2;
            yl2[2 * tq] += (cvt_f32x2){w4.x, w4.y} * vs2; yl2[2 * tq + 1] += (cvt_f32x2){w4.z, w4.w} * vs2;
        }
        __builtin_amdgcn_sched_barrier(0);
    }
    float pt[16], ul[16], yl[16];
#pragma unroll
    for (int t = 0; t < 8; ++t) { pt[2 * t] = pt2[t].x; pt[2 * t + 1] = pt2[t].y; ul[2 * t] = ul2[t].x; ul[2 * t + 1] = ul2[t].y; yl[2 * t] = yl2[t].x; yl[2 * t + 1] = yl2[t].y; }
#pragma unroll
    for (int s = 0; s < 16; ++s) {
        const cvt_f32x2 ps2 = {pt[s], pt[s]};
#pragma unroll
        for (int tq = 0; tq < 4; ++tq) {
            const float4 m4 = *(const float4*)(M_RB + s * 16 + 4 * tq);
            r22[2 * tq] += (cvt_f32x2){m4.x, m4.y} * ps2; r22[2 * tq + 1] += (cvt_f32x2){m4.z, m4.w} * ps2;
        }
        __builtin_amdgcn_sched_barrier(0);
    }
    float r2[16];
#pragma unroll
    for (int t = 0; t < 8; ++t) { r2[2 * t] = r22[t].x; r2[2 * t + 1] = r22[t].y; }
    unsigned char* rec = p.ws + WS_REC + (size_t)ct * REC_BYTES;
    float* ys = (float*)(p.ws + WS_YS);
    {
#pragma unroll
        for (int t = 0; t < 16; ++t) { S_AB[t * 72 + lane] = f2bf(pt[t]); S_RT[t * 72 + lane] = f2bf(r2[t]); }
        __builtin_amdgcn_fence(__ATOMIC_RELEASE, "wavefront"); __builtin_amdgcn_wave_barrier(); __builtin_amdgcn_fence(__ATOMIC_ACQUIRE, "wavefront");
#pragma unroll
        for (int i2 = 0; i2 < 2; ++i2) {
            const int q = lane + 64 * i2, f = q >> 5, hf = (q >> 4) & 1, t = q & 15;
            const uint2 a0 = *(const uint2*)(S_AB + t * 72 + 16 * f + 4 * hf), a1 = *(const uint2*)(S_AB + t * 72 + 16 * f + 8 + 4 * hf);
            const uint2 c0 = *(const uint2*)(S_RT + t * 72 + 16 * f + 4 * hf), c1 = *(const uint2*)(S_RT + t * 72 + 16 * f + 8 + 4 * hf);
            st_sc1_b128(rec + q * 16, a0.x, a0.y, a1.x, a1.y);
            st_sc1_b128(rec + 2048 + q * 16, c0.x, c0.y, c1.x, c1.y);
        }
        {
            float* YT = (float*)(wl + 9216);
#pragma unroll
            for (int t = 0; t < 16; ++t) YT[t * 64 + lane] = yl[t];
            __builtin_amdgcn_fence(__ATOMIC_RELEASE, "wavefront"); __builtin_amdgcn_wave_barrier(); __builtin_amdgcn_fence(__ATOMIC_ACQUIRE, "wavefront");
#pragma unroll
            for (int i4 = 0; i4 < 4; ++i4) {
                const int idx = lane + 64 * i4, t = idx >> 4, q4 = idx & 15;
                const float4 y4 = *(const float4*)(YT + t * 64 + 4 * q4);
                st_sc1_b128(ys + (unsigned)(row0 + t) * 1024u + (unsigned)(h * 64 + 4 * q4), __float_as_uint(y4.x), __float_as_uint(y4.y), __float_as_uint(y4.z), __float_as_uint(y4.w));
            }
        }
    }
    {
        float gb[16], gk[16];
#pragma unroll
        for (int t = 0; t < 16; ++t) { gb[t] = gC * bf2f(S_BB[t * 72 + lane]); gk[t] = gC * bf2f(S_KB[t * 72 + lane]); }
        st_sc1_b128(rec + 4096 + lane * 16, pack2(gb[0], gb[1]), pack2(gb[2], gb[3]), pack2(gb[8], gb[9]), pack2(gb[10], gb[11]));
        st_sc1_b128(rec + 4096 + (64 + lane) * 16, pack2(gb[4], gb[5]), pack2(gb[6], gb[7]), pack2(gb[12], gb[13]), pack2(gb[14], gb[15]));
        st_sc1_b128(rec + 6144 + lane * 16, pack2(gk[0], gk[1]), pack2(gk[2], gk[3]), pack2(gk[4], gk[5]), pack2(gk[6], gk[7]));
        st_sc1_b128(rec + 6144 + (64 + lane) * 16, pack2(gk[8], gk[9]), pack2(gk[10], gk[11]), pack2(gk[12], gk[13]), pack2(gk[14], gk[15]));
        st_sc1_b32(rec + 8192 + lane * 4, gC);
        unsigned char* ip = rec + 8448 + (lane >> 5) * 3072;
        const int il = lane & 31;
        st_sc1_b128(ip + il * 16, pack2(vv[0], vv[1]), pack2(vv[2], vv[3]), pack2(vv[4], vv[5]), pack2(vv[6], vv[7]));
        st_sc1_b128(ip + (32 + il) * 16, pack2(vv[8], vv[9]), pack2(vv[10], vv[11]), pack2(vv[12], vv[13]), pack2(vv[14], vv[15]));
#pragma unroll
        for (int tq = 0; tq < 4; ++tq) st_sc1_b128(ip + 1024 + (((tq >> 1) * 2 + (tq & 1)) * 32 + il) * 16, __float_as_uint(ul[4 * tq]), __float_as_uint(ul[4 * tq + 1]), __float_as_uint(ul[4 * tq + 2]), __float_as_uint(ul[4 * tq + 3]));
    }
    asm volatile("s_waitcnt vmcnt(0)" ::: "memory");
    if (lane == 0) __hip_atomic_store((unsigned*)(p.ws + WS_RFLAG + (size_t)ct * 64), (unsigned)(l + 1), __ATOMIC_RELAXED, __HIP_MEMORY_SCOPE_AGENT);
    __builtin_amdgcn_fence(__ATOMIC_RELEASE, "wavefront"); __builtin_amdgcn_wave_barrier();
}

__device__ void pa_sample_task(const Params& p, int l, int task) {
    const int lane = opq_tid() & 63;
    const int bd = task >> 8, h = (task >> 4) & 15, wq = task & 15;
    const int irow = 4 * wq + (lane >> 4), jq = lane & 15;
    const size_t row = (size_t)TP + bd;
    const bf16_t* RSB = (const bf16_t*)(p.ws + WS_RSB);
    const float* RSW = (const float*)(p.ws + WS_RSW);
    const bf16_t* VALL = (const bf16_t*)(p.ws + WS_VALL);
    float* ys = (float*)(p.ws + WS_YS);
    const size_t so = (((size_t)(l * NBS + bd) * 16 + h) * 64 + irow) * 64 + 4 * jq;
    float4 s = *(const float4*)(p.state_wkv + so);
    const size_t o = row * 1024 + h * 64 + 4 * jq;
    const size_t os = (size_t)bd * 1024 + h * 64 + 4 * jq;
    const uint2 ur = *(const uint2*)(RSB + os), uk = *(const uint2*)(RSB + SRI + os), ukk = *(const uint2*)(RSB + 2 * SRI + os), ub = *(const uint2*)(RSB + 3 * SRI + os);
    const float4 w4 = *(const float4*)(RSW + os);
    const float v = bf2f(VALL[row * 1024 + h * 64 + irow]);
    float pa = s.x * bflo(ukk.x) + s.y * bfhi(ukk.x) + s.z * bflo(ukk.y) + s.w * bfhi(ukk.y);
    pa = allreduce16(pa);
    const float sa = -pa;
    s.x = fmaf(sa, bflo(ub.x), fmaf(s.x, w4.x, v * bflo(uk.x)));
    s.y = fmaf(sa, bfhi(ub.x), fmaf(s.y, w4.y, v * bfhi(uk.x)));
    s.z = fmaf(sa, bflo(ub.y), fmaf(s.z, w4.z, v * bflo(uk.y)));
    s.w = fmaf(sa, bfhi(ub.y), fmaf(s.w, w4.w, v * bfhi(uk.y)));
    float py = s.x * bflo(ur.x) + s.y * bfhi(ur.x) + s.z * bflo(ur.y) + s.w * bfhi(ur.y);
    py = allreduce16(py);
    *(float4*)(p.out + O_WKVS + so) = s;
    if (jq == 0) ys[row * 1024 + h * 64 + irow] = py;
}

__device__ __forceinline__ uint4 ld_sc1_b128(const unsigned char* p) {
    const unsigned long long a = __hip_atomic_load((const unsigned long long*)p, __ATOMIC_RELAXED, __HIP_MEMORY_SCOPE_AGENT), c = __hip_atomic_load((const unsigned long long*)(p + 8), __ATOMIC_RELAXED, __HIP_MEMORY_SCOPE_AGENT);
    return make_uint4((unsigned)a, (unsigned)(a >> 32), (unsigned)c, (unsigned)(c >> 32));
}
constexpr int PB_NB = 8, PB_SLOT = 13568, PB_NCH = SEQ / 16, PB_NX = 4, PB_XOFF = PB_NB * PB_SLOT  , PB_FOFF = PB_XOFF + PB_NX * 4096;
__device__ void pb_head(const Params& p, unsigned char* lds, int l, int blk, bool dry) {
    const int tid = opq_tid(), wv = tid >> 6, lane = tid & 63;
    const int hh = blk >> 1, it = blk & 1, b = hh >> 4, h = hh & 15;
    volatile LAS unsigned* flags = (volatile LAS unsigned*)((LAS unsigned char*)lds + PB_FOFF);
    if (tid < 16) flags[tid] = 0u;
    __syncthreads();
    const unsigned char* rec0 = p.ws + WS_REC + (size_t)(hh * 256) * REC_BYTES;
    float* ys = (float*)(p.ws + WS_YS) + ((size_t)b * SEQ) * 1024 + h * 64 + 32 * it;
    const int q32 = lane & 31, hf = lane >> 5;
    if (wv >= 2) {
        unsigned nf = __hip_atomic_load((const unsigned*)(p.ws + WS_RFLAG + (size_t)(hh * 256 + (wv - 2)) * 64), __ATOMIC_RELAXED, __HIP_MEMORY_SCOPE_AGENT);
#pragma unroll 1
        for (int c = wv - 2; c < PB_NCH; c += 6) {
            while (c - (int)flags[8] >= PB_NB || c - (int)flags[9] >= PB_NB) __builtin_amdgcn_s_sleep(1);
            asm volatile("" ::: "memory");
            {
                const unsigned* rf = (const unsigned*)(p.ws + WS_RFLAG + (size_t)(hh * 256 + c) * 64);
                while (nf != (unsigned)(l + 1)) { __builtin_amdgcn_s_sleep(2); nf = __hip_atomic_load(rf, __ATOMIC_RELAXED, __HIP_MEMORY_SCOPE_AGENT); }
                asm volatile("" ::: "memory");
            }
            const unsigned char* rec = rec0 + (size_t)c * REC_BYTES;
            unsigned char* sl = lds + (c % PB_NB) * PB_SLOT;
            const unsigned char* rc = rec + lane * 16;
            const unsigned char* ri = rec + 8448 + it * 3072 + lane * 16;
#define LD_SC1(p_) ld_sc1_b128((const unsigned char*)(p_))
            const uint4 d0 = LD_SC1(rc), d1 = LD_SC1(rc + 1024), d2 = LD_SC1(rc + 2048), d3 = LD_SC1(rc + 3072);
            const uint4 d4 = LD_SC1(rc + 4096), d5 = LD_SC1(rc + 5120), d6 = LD_SC1(rc + 6144), d7 = LD_SC1(rc + 7168);
            const uint4 d8 = LD_SC1(rec + 8192 + (lane & 15) * 16);
            const uint4 d9 = LD_SC1(ri), d10 = LD_SC1(ri + 1024), d11 = LD_SC1(ri + 2048);
            const int t0 = lane >> 3, cc = lane & 7;
            const uint4 d12 = LD_SC1(ys + (size_t)(16 * c + t0) * 1024 + cc * 4), d13 = LD_SC1(ys + (size_t)(16 * c + 8 + t0) * 1024 + cc * 4);
#undef LD_SC1
            nf = (c + 6 < PB_NCH) ? __hip_atomic_load((const unsigned*)(p.ws + WS_RFLAG + (size_t)(hh * 256 + c + 6) * 64), __ATOMIC_RELAXED, __HIP_MEMORY_SCOPE_AGENT) : 0u;
            __builtin_amdgcn_sched_barrier(0);
            unsigned char* sd = sl + lane * 16;
            *(uint4*)(sd) = d0; *(uint4*)(sd + 1024) = d1; *(uint4*)(sd + 2048) = d2; *(uint4*)(sd + 3072) = d3;
            *(uint4*)(sd + 4096) = d4; *(uint4*)(sd + 5120) = d5; *(uint4*)(sd + 6144) = d6; *(uint4*)(sd + 7168) = d7;
            if (lane < 16) *(uint4*)(sl + 8192 + lane * 16) = d8;
            *(uint4*)(sd + 8448) = d9; *(uint4*)(sd + 9472) = d10; *(uint4*)(sd + 10496) = d11;
            {
                float* yd = (float*)(sl + 11520) + ((((t0 >> 2) & 1) * 32 + 4 * cc) * 4 + (t0 & 3));
                yd[0] = __uint_as_float(d12.x); yd[4] = __uint_as_float(d12.y); yd[8] = __uint_as_float(d12.z); yd[12] = __uint_as_float(d12.w);
                yd[256] = __uint_as_float(d13.x); yd[260] = __uint_as_float(d13.y); yd[264] = __uint_as_float(d13.z); yd[268] = __uint_as_float(d13.w);
            }
            asm volatile("" ::: "memory");
            if (lane == 0) flags[c % PB_NB] = (unsigned)(c + 1);
        }
    } else if (wv == 1) {
        bf16x8 ra0, ra1, ra2, ra3; float4 y0, y1;
#define PB_FETCHY(c_) do { const unsigned char* sl_ = lds + ((c_) % PB_NB) * PB_SLOT; \
            while (flags[(c_) % PB_NB] != (unsigned)((c_) + 1)) __builtin_amdgcn_s_sleep(0); \
            asm volatile("" ::: "memory"); \
            const unsigned char* pr_ = sl_ + 2048 + (hf * 16 + (q32 & 15)) * 16; \
            ra0 = *(const bf16x8*)(pr_); ra1 = *(const bf16x8*)(pr_ + 512); ra2 = *(const bf16x8*)(pr_ + 1024); ra3 = *(const bf16x8*)(pr_ + 1536); \
            y0 = *(const float4*)(sl_ + 11520 + (hf * 32 + q32) * 16); y1 = *(const float4*)(sl_ + 11520 + ((2 + hf) * 32 + q32) * 16); \
            asm volatile("" ::: "memory"); \
            if (lane == 0) flags[9] = (unsigned)((c_) + 1); } while (0)
        PB_FETCHY(0);
#pragma unroll 1
        for (int c = 0; c < PB_NCH; ++c) {
            const unsigned char* xr = lds + PB_XOFF + (c % PB_NX) * 4096 + lane * 16;
            f32x16 Ya, Yb;
            Ya[0] = y0.x; Ya[1] = y0.y; Ya[2] = y0.z; Ya[3] = y0.w; Ya[4] = y1.x; Ya[5] = y1.y; Ya[6] = y1.z; Ya[7] = y1.w;
#pragma unroll
            for (int r = 8; r < 16; ++r) Ya[r] = 0.f;
#pragma unroll
            for (int r = 0; r < 16; ++r) Yb[r] = 0.f;
            const bf16x8 rc0 = ra0, rc1 = ra1, rc2 = ra2, rc3 = ra3;
            while (flags[10 + (c % PB_NX)] != (unsigned)(c + 1)) __builtin_amdgcn_s_sleep(0);
            asm volatile("" ::: "memory");
            const bf16x8 xf0 = *(const bf16x8*)(xr), xf1 = *(const bf16x8*)(xr + 1024), xf2 = *(const bf16x8*)(xr + 2048), xf3 = *(const bf16x8*)(xr + 3072);
            asm volatile("" ::: "memory");
            if (lane == 0) flags[14] = (unsigned)(c + 1);
            Ya = __builtin_amdgcn_mfma_f32_32x32x16_bf16(rc0, xf0, Ya, 0, 0, 0);
            Yb = __builtin_amdgcn_mfma_f32_32x32x16_bf16(rc1, xf1, Yb, 0, 0, 0);
            Ya = __builtin_amdgcn_mfma_f32_32x32x16_bf16(rc2, xf2, Ya, 0, 0, 0);
            Yb = __builtin_amdgcn_mfma_f32_32x32x16_bf16(rc3, xf3, Yb, 0, 0, 0);
            if (c + 1 < PB_NCH) PB_FETCHY(c + 1);
            float* yc = ys + (size_t)c * (16 * 1024);
            if (!dry) {
#pragma unroll
                for (int r = 0; r < 8; ++r) yc[(8 * (r >> 2) + 4 * hf + (r & 3)) * 1024 + q32] = Ya[r] + Yb[r];
            }
        }
#undef PB_FETCHY
    } else {
        f32x16 X0, X1;
#pragma unroll
        for (int i = 0; i < 16; ++i) { X0[i] = 0.f; X1[i] = 0.f; }
        bf16x8 pa0, pa1, pa2, pa3, gb0, gb1, gk0, gk1, vf;
        float4 gm0, gm1, gm2, gm3, gm4, gm5, gm6, gm7, u0, u1;
#define PB_FETCH(c_) do { const unsigned char* sl_ = lds + ((c_) % PB_NB) * PB_SLOT; \
            { unsigned rv_ = rdy; while (rv_ != (unsigned)((c_) + 1)) { __builtin_amdgcn_s_sleep(0); rv_ = flags[(c_) % PB_NB]; } } \
            asm volatile("" ::: "memory"); \
            const unsigned char* pr_ = sl_ + (hf * 16 + (q32 & 15)) * 16; \
            pa0 = *(const bf16x8*)(pr_); pa1 = *(const bf16x8*)(pr_ + 512); pa2 = *(const bf16x8*)(pr_ + 1024); pa3 = *(const bf16x8*)(pr_ + 1536); \
            gb0 = *(const bf16x8*)(sl_ + 4096 + (hf * 64 + q32) * 16); gb1 = *(const bf16x8*)(sl_ + 4096 + (hf * 64 + 32 + q32) * 16); \
            gk0 = *(const bf16x8*)(sl_ + 6144 + (hf * 64 + q32) * 16); gk1 = *(const bf16x8*)(sl_ + 6144 + (hf * 64 + 32 + q32) * 16); \
            vf = *(const bf16x8*)(sl_ + 8448 + (hf * 32 + q32) * 16); \
            const unsigned char* gp_ = sl_ + 8192 + 16 * hf; \
            gm0 = *(const float4*)(gp_); gm1 = *(const float4*)(gp_ + 32); gm2 = *(const float4*)(gp_ + 64); gm3 = *(const float4*)(gp_ + 96); \
            gm4 = *(const float4*)(gp_ + 128); gm5 = *(const float4*)(gp_ + 160); gm6 = *(const float4*)(gp_ + 192); gm7 = *(const float4*)(gp_ + 224); \
            u0 = *(const float4*)(sl_ + 9472 + (hf * 32 + q32) * 16); u1 = *(const float4*)(sl_ + 9472 + ((2 + hf) * 32 + q32) * 16); \
            asm volatile("" ::: "memory"); \
            if (lane == 0) flags[8] = (unsigned)((c_) + 1); } while (0)
        unsigned rdy = flags[0];
        PB_FETCH(0);
        int xfree = 0;
#pragma unroll 1
        for (int c = 0; c < PB_NCH; ++c) {
            unsigned char* xw = lds + PB_XOFF + (c % PB_NX) * 4096 + lane * 16;
            rdy = flags[(c + 1) % PB_NB];
            const bf16x8 xb0 = __builtin_bit_cast(bf16x8, make_uint4(pack2(X0[0], X0[1]), pack2(X0[2], X0[3]), pack2(X0[4], X0[5]), pack2(X0[6], X0[7])));
            const bf16x8 xb1 = __builtin_bit_cast(bf16x8, make_uint4(pack2(X0[8], X0[9]), pack2(X0[10], X0[11]), pack2(X0[12], X0[13]), pack2(X0[14], X0[15])));
            const bf16x8 xb2 = __builtin_bit_cast(bf16x8, make_uint4(pack2(X1[0], X1[1]), pack2(X1[2], X1[3]), pack2(X1[4], X1[5]), pack2(X1[6], X1[7])));
            const bf16x8 xb3 = __builtin_bit_cast(bf16x8, make_uint4(pack2(X1[8], X1[9]), pack2(X1[10], X1[11]), pack2(X1[12], X1[13]), pack2(X1[14], X1[15])));
            f32x16 Ua, Ub;
            Ua[0] = u0.x; Ua[1] = u0.y; Ua[2] = u0.z; Ua[3] = u0.w; Ua[4] = u1.x; Ua[5] = u1.y; Ua[6] = u1.z; Ua[7] = u1.w;
#pragma unroll
            for (int r = 8; r < 16; ++r) Ua[r] = 0.f;
#pragma unroll
            for (int r = 0; r < 16; ++r) Ub[r] = 0.f;
            Ua = __builtin_amdgcn_mfma_f32_32x32x16_bf16(pa0, xb0, Ua, 0, 0, 0);
            Ub = __builtin_amdgcn_mfma_f32_32x32x16_bf16(pa1, xb1, Ub, 0, 0, 0);
            Ua = __builtin_amdgcn_mfma_f32_32x32x16_bf16(pa2, xb2, Ua, 0, 0, 0);
            Ub = __builtin_amdgcn_mfma_f32_32x32x16_bf16(pa3, xb3, Ub, 0, 0, 0);
            f32x16 Xn0, Xn1;
            Xn0[0] = X0[0] * gm0.x; Xn0[1] = X0[1] * gm0.y; Xn0[2] = X0[2] * gm0.z; Xn0[3] = X0[3] * gm0.w; Xn0[4] = X0[4] * gm1.x; Xn0[5] = X0[5] * gm1.y; Xn0[6] = X0[6] * gm1.z; Xn0[7] = X0[7] * gm1.w;
            Xn0[8] = X0[8] * gm2.x; Xn0[9] = X0[9] * gm2.y; Xn0[10] = X0[10] * gm2.z; Xn0[11] = X0[11] * gm2.w; Xn0[12] = X0[12] * gm3.x; Xn0[13] = X0[13] * gm3.y; Xn0[14] = X0[14] * gm3.z; Xn0[15] = X0[15] * gm3.w;
            Xn1[0] = X1[0] * gm4.x; Xn1[1] = X1[1] * gm4.y; Xn1[2] = X1[2] * gm4.z; Xn1[3] = X1[3] * gm4.w; Xn1[4] = X1[4] * gm5.x; Xn1[5] = X1[5] * gm5.y; Xn1[6] = X1[6] * gm5.z; Xn1[7] = X1[7] * gm5.w;
            Xn1[8] = X1[8] * gm6.x; Xn1[9] = X1[9] * gm6.y; Xn1[10] = X1[10] * gm6.z; Xn1[11] = X1[11] * gm6.w; Xn1[12] = X1[12] * gm7.x; Xn1[13] = X1[13] * gm7.y; Xn1[14] = X1[14] * gm7.z; Xn1[15] = X1[15] * gm7.w;
            Xn0 = __builtin_amdgcn_mfma_f32_32x32x16_bf16(gk0, vf, Xn0, 0, 0, 0);
            Xn1 = __builtin_amdgcn_mfma_f32_32x32x16_bf16(gk1, vf, Xn1, 0, 0, 0);
            const bf16x8 gbc0 = gb0, gbc1 = gb1;
            while (c - xfree >= PB_NX) { xfree = (int)flags[14]; }
            asm volatile("" ::: "memory");
            *(bf16x8*)(xw) = xb0; *(bf16x8*)(xw + 1024) = xb1; *(bf16x8*)(xw + 2048) = xb2; *(bf16x8*)(xw + 3072) = xb3;
            asm volatile("" ::: "memory");
            if (lane == 0) flags[10 + (c % PB_NX)] = (unsigned)(c + 1);
            if (c + 1 < PB_NCH) PB_FETCH(c + 1);
            const bf16x8 ub = __builtin_bit_cast(bf16x8, make_uint4(pack2(Ua[0] + Ub[0], Ua[1] + Ub[1]), pack2(Ua[2] + Ub[2], Ua[3] + Ub[3]), pack2(Ua[4] + Ub[4], Ua[5] + Ub[5]), pack2(Ua[6] + Ub[6], Ua[7] + Ub[7])));
            X0 = __builtin_amdgcn_mfma_f32_32x32x16_bf16(gbc0, ub, Xn0, 0, 0, 0);
            X1 = __builtin_amdgcn_mfma_f32_32x32x16_bf16(gbc1, ub, Xn1, 0, 0, 0);
        }
#undef PB_FETCH
        float* so = p.out + O_WKVP + ((size_t)(l * NBP + b) * 16 + h) * 4096 + (size_t)(32 * it + q32) * 64;
#pragma unroll
        for (int g = 0; g < 4; ++g) {
            *(float4*)(so + 8 * g + 4 * hf) = make_float4(X0[4 * g], X0[4 * g + 1], X0[4 * g + 2], X0[4 * g + 3]);
            *(float4*)(so + 32 + 8 * g + 4 * hf) = make_float4(X1[4 * g], X1[4 * g + 1], X1[4 * g + 2], X1[4 * g + 3]);
        }
    }
    __syncthreads();
}

__device__ void p3_post(const Params& p, int l, int bid, int G) {
    const int tid = opq_tid(), wv = tid >> 6, lane = tid & 63;
    const float* ys = (const float*)(p.ws + WS_YS);
    const bf16_t* V = (const bf16_t*)(p.ws + WS_VALL);
    const float* coef = (const float*)(p.ws + WS_COEF);
    const bf16_t* gt = (const bf16_t*)(p.ws + WS_GT);
    bf16_t* cc = (bf16_t*)(p.ws + WS_HB);
    for (int r = bid * 8 + wv; r < MT; r += G * 8) {
        float4 y4[4]; uint2 vu4[4], gg4[4]; float cf4[4];
#pragma unroll
        for (int hg = 0; hg < 4; ++hg) {
            const int head = 4 * hg + (lane >> 4), c = head * 64 + 4 * (lane & 15);
            y4[hg] = *(const float4*)(ys + (size_t)r * 1024 + c);
            vu4[hg] = *(const uint2*)(V + (size_t)r * 1024 + c);
            cf4[hg] = coef[(size_t)r * 16 + head];
            gg4[hg] = *(const uint2*)(gt + (size_t)r * DM + 1024 + c);
        }
        __builtin_amdgcn_sched_barrier(0);
#pragma unroll
        for (int hg = 0; hg < 4; ++hg) {
            const int head = 4 * hg + (lane >> 4), c = head * 64 + 4 * (lane & 15);
            const float4 y = y4[hg];
            const float mu = allreduce16(y.x + y.y + y.z + y.w) * (1.f / 64.f);
            const float d0 = y.x - mu, d1 = y.y - mu, d2 = y.z - mu, d3 = y.w - mu;
            const float var = allreduce16(d0 * d0 + d1 * d1 + d2 * d2 + d3 * d3) * (1.f / 64.f);
            const float rs = rsqrtf(var + 64e-5f);
            const float4 lw = *(const float4*)(p.ln_w + l * 1024 + c), lb = *(const float4*)(p.ln_b + l * 1024 + c);
            const uint2 vu = vu4[hg];
            const float4 v4 = make_float4(bflo(vu.x), bfhi(vu.x), bflo(vu.y), bfhi(vu.y));
            const float cf = cf4[hg];
            const uint2 gg = gg4[hg];
            const float o0 = (d0 * rs * lw.x + lb.x + cf * v4.x) * bflo(gg.x), o1 = (d1 * rs * lw.y + lb.y + cf * v4.y) * bfhi(gg.x);
            const float o2 = (d2 * rs * lw.z + lb.z + cf * v4.z) * bflo(gg.y), o3 = (d3 * rs * lw.w + lb.w + cf * v4.w) * bfhi(gg.y);
            *(uint2*)(cc + (size_t)r * DM + 1024 + c) = make_uint2(pack2(o0, o1), pack2(o2, o3));
        }
    }
}

__device__ void p_final(const Params& p, int bid, int G) {
    const int tid = opq_tid(), wv = tid >> 6, lane = tid & 63;
    const float4* g4 = (const float4*)p.final_g;
    for (int r = bid * 8 + wv; r < MT; r += G * 8) {
        float4* xr = (float4*)(p.out + (size_t)r * DM);
        float4 v[8]; float ss = 0.f;
#pragma unroll
        for (int i = 0; i < 8; ++i) { v[i] = xr[lane + 64 * i]; ss += v[i].x * v[i].x + v[i].y * v[i].y + v[i].z * v[i].z + v[i].w * v[i].w; }
        ss = wave_sum(ss);
        const float rinv = rsqrtf(ss * (1.f / 2048.f) + 1e-5f);
#pragma unroll
        for (int i = 0; i < 8; ++i) { const float4 g = g4[lane + 64 * i]; xr[lane + 64 * i] = make_float4(v[i].x * rinv * g.x, v[i].y * rinv * g.y, v[i].z * rinv * g.z, v[i].w * rinv * g.w); }
    }
}

#ifndef REPL
#define REPL -1
#endif
#ifndef REPK
#define REPK -100
#endif
__global__ void __launch_bounds__(512, 2) fwd_kernel(Params p_unused) {
    extern __shared__ __attribute__((aligned(16))) unsigned char shm[];
    cg::grid_group grid = cg::this_grid();
    const int bid0 = blockIdx.x, G0 = gridDim.x;
    float* shf = (float*)shm;
    volatile LAS unsigned* xst = (volatile LAS unsigned*)((LAS unsigned char*)shm + 131072);
    if (threadIdx.x == 0) { xst[0] = 0u; xst[1] = 0u; }
    __syncthreads();
    const XcdBarrier xb = xcd_barrier_post((unsigned*)(kparams().ws + WS_BAR), xst);
    if (G0 == 0x7fffffff) grid.sync();

#pragma unroll 1
    for (int ph = 0; ph < 14; ++ph) {
        const int bid = opq_s(bid0), G = opq_s(G0);
        const int l = ph >= 7 ? 1 : 0, k = ph == 0 ? -1 : (ph == 13 ? 6 : (ph - 1) - 6 * l);
#pragma unroll 1
        for (int rep = 0; rep < ((k == kparams().repk && (kparams().repl < 0 || kparams().repl == l)) ? 2 : 1); ++rep) {
        if (k == -1) {
            for (int it = bid; it < 384; it += G) p0_mod_item(kparams(), shf, it / 192, it % 192);
            for (int it = bid; it < 17; it += G) p0_rope_item(kparams(), it);
            for (int it = bid; it < 64; it += G) p0_wfrag_item(kparams(), it);
            {
                if (bid < 128) p0_conv_all(kparams(), shf, bid, 128, 1024, 0);
                else p0_conv_all(kparams(), shf, 1024 + (bid - 128), G - 128, 2752, 0);
            }
        } else if (k == 0) {
            p1_norm(kparams(), l, bid, G);
        } else if (k == 1) {
            pg8::StaticOrder S; S.init(MP, INWP, G, bid);
            pg8::Gemm g{(const bf16_t*)(kparams().ws + WS_HB), (const bf16_t*)(kparams().ws + WS_WTIN), MP, INWP, DM};
            Epi1 E{l};
            pg8::gemm_phase<Epi1, pg8::StaticOrder, false>((PG8_LAS unsigned char*)shm, g, S, E, nullptr);
        } else if (k == 2) {
            for (int it = bid; it < 256 + 256 + 1 + 64; it += G) {
                if (it < 256) p3_attn_unit(kparams(), shm, l, it);
                else if (it < 512) p3_twad_item(kparams(), l, it - 256);
                else if (it == 512) p3_prep_tile(kparams(), shm, l, 256);
                else p3_sattn_item(kparams(), shf, l, it - 513);
            }
            __syncthreads();
            if (l == 0) p0_conv_all(kparams(), shf, bid, G, 1728, 1);
        } else if (k == 3) {
            {
                const int wvq = opq_tid() >> 6;
                int i2 = bid < 64 ? bid * 8 + wvq : 512 + (bid - 64) * 8 + wvq;
                const int step = bid < 64 ? (1 << 20) : (G - 64) * 8;
#pragma unroll 1
                for (; i2 < 32 * 256; i2 += step) pa_chunk(kparams(), shm + wvq * PA_WLDS, l, (i2 & 31) * 256 + (i2 >> 5));
                if (bid < 64) {
                    __syncthreads();
                    pb_head(kparams(), shm, l, bid, false);
                } else {
                    const int gw = (bid - 64) * 8 + wvq, nw = (G - 64) * 8;
                    for (int task = gw; task < NBS * 256; task += nw) pa_sample_task(kparams(), l, task);
                }
            }
        } else if (k == 4) {
            p3_post(kparams(), l, bid, G);
        } else if (k == 5) {
            pg8::StaticOrder S; S.init(TP, DM, G, bid);
            pg8::Gemm g{(const bf16_t*)(kparams().ws + WS_HB), (const bf16_t*)(kparams().ws + WS_WTOUT) + (size_t)l * DM * DM, TP, DM, DM};
            Epi2 E{l};
            pg8::gemm_phase<Epi2, pg8::StaticOrder, false>((PG8_LAS unsigned char*)shm, g, S, E, nullptr);
            for (int nb = bid; nb < 64; nb += G) g2_sample_item(kparams(), shf, l, nb);
        } else {
            p_final(kparams(), bid, G);
        }
        if (ph < 13) xcd_barrier(xb);
        }
    }
}

extern "C" void kernel_launch(void* const* d_in, const int* in_sizes, int n_in, void* d_out, int out_size, void* d_ws, size_t ws_size, hipStream_t stream) {
    static int grid_blocks = 0;
    if (grid_blocks == 0) {
        if (n_in != 25 || (size_t)out_size != O_END || ws_size < WS_END) {
            fprintf(stderr, "kernel_launch: unexpected shapes: n_in %d out_size %d ws_size %zu (need %zu)\n", n_in, out_size, ws_size, (size_t)WS_END);
            grid_blocks = -1; return;
        }
        if (hipFuncSetAttribute((const void*)fwd_kernel, hipFuncAttributeMaxDynamicSharedMemorySize, LDS_BYTES) != hipSuccess) { fprintf(stderr, "kernel_launch: hipFuncSetAttribute failed\n"); grid_blocks = -1; return; }
        int dev = 0, cus = 0, per_cu = 0;
        hipGetDevice(&dev);
        hipDeviceGetAttribute(&cus, hipDeviceAttributeMultiprocessorCount, dev);
        hipOccupancyMaxActiveBlocksPerMultiprocessor(&per_cu, (const void*)fwd_kernel, 512, LDS_BYTES);
        if (per_cu < 1) { fprintf(stderr, "kernel_launch: occupancy query gives %d blocks per CU\n", per_cu); per_cu = 1; }
        (void)hipGetLastError();
        grid_blocks = cus;
        if (grid_blocks < 192) { fprintf(stderr, "kernel_launch: only %d CUs\n", grid_blocks); grid_blocks = -1; return; }
    }
    if (grid_blocks < 0) return;
    if (hipMemsetAsync((unsigned char*)d_ws + WS_BAR, 0, 16384 + RFLAG_BYTES, stream) != hipSuccess) { fprintf(stderr, "kernel_launch: memset of the barrier words failed\n"); return; }
    Params p{};
    const float** pp = (const float**)&p;
    for (int i = 0; i < 25; ++i) pp[i] = (const float*)d_in[i];
    p.out = (float*)d_out; p.ws = (unsigned char*)d_ws; p.repk = REPK; p.repl = REPL;
    void* args[] = {&p};
    hipError_t e = hipLaunchCooperativeKernel((const void*)fwd_kernel, dim3(grid_blocks), dim3(512), args, LDS_BYTES, stream);
    if (e != hipSuccess) fprintf(stderr, "cooperative launch failed: %s (grid %d)\n", hipGetErrorString(e), grid_blocks);
}
```

```cpp
#include <hip/hip_runtime.h>
#include <hip/hip_cooperative_groups.h>
#include <cstdio>
namespace cg = cooperative_groups;
__device__ __forceinline__ int opq_tid() { int t = threadIdx.x; asm volatile("" : "+v"(t)); return t; }
__device__ __forceinline__ int opq_s(int x) { asm volatile("" : "+s"(x)); return x; }
typedef float cvt_f32x2 __attribute__((ext_vector_type(2)));
typedef __bf16 cvt_bf16x2 __attribute__((ext_vector_type(2)));
__device__ __forceinline__ unsigned hw_cvt_pk_bf16(float lo, float hi) { const cvt_f32x2 v = {lo, hi}; return __builtin_bit_cast(unsigned, __builtin_convertvector(v, cvt_bf16x2)); }
typedef unsigned sc1_v4u __attribute__((ext_vector_type(4)));
__device__ __forceinline__ void st_sc1_b128(void* p, unsigned a, unsigned b, unsigned c, unsigned d) { const sc1_v4u v = {a, b, c, d}; asm volatile("global_store_dwordx4 %0, %1, off sc0 sc1\n\ts_nop 2" :: "v"(p), "v"(v) : "memory"); }
__device__ __forceinline__ void st_sc1_b32(void* p, float v) { asm volatile("global_store_dword %0, %1, off sc0 sc1\n\ts_nop 2" :: "v"(p), "v"(v) : "memory"); }
namespace pg8 {
#define PG8_LAS __attribute__((address_space(3)))
typedef unsigned short bf16_t;
typedef short bf16x8 __attribute__((ext_vector_type(8)));
typedef float f32x4 __attribute__((ext_vector_type(4)));
typedef unsigned u32x4 __attribute__((ext_vector_type(4)));
constexpr int BM = 256, BK = 64, HALF = 128, HTB = HALF * BK * 2  , STAGE_BYTES = 8 * HTB, NXCD = 8, WGM = 4;

__host__ __device__ __forceinline__ int lds_byte(int r, int c) { const int st = (r >> 4) * 2 + (c >> 5), rr = r & 15, cc = c & 31, ob = rr * 64 + cc * 2; return st * 1024 + (ob ^ (((ob >> 9) & 1) << 5)); }
__host__ __device__ __forceinline__ void stage_rc(int b, int& R, int& C) { const int st = b / 1024, sb = b % 1024, swz = sb ^ (((sb >> 9) & 1) << 5); R = (st >> 1) * 16 + swz / 64; C = (st & 1) * 32 + (swz % 64) / 2; }
__host__ __device__ __forceinline__ int perm32(int rho) { const int n = rho >> 4, i = rho & 15; return 8 * (i >> 2) + 4 * n + (i & 3); }

struct Unit { int pm, pn; };
struct Gemm { const bf16_t* A; const bf16_t* Bt; int M, N, K; };

struct StaticOrder {
    int nM, nN, nwg, G, c;
    __host__ __device__ void init(int M, int N, int G_, int c_) { nM = M / BM; nN = N / BM; nwg = nM * nN; G = G_; c = c_; }
    __host__ __device__ bool next(int i, Unit& u) const {
        const long L = (long)i * G + c; if (L >= nwg) return false;
        int wgid = (int)L; { const int q = nwg / NXCD, r = nwg % NXCD, xcd = wgid % NXCD, off = wgid / NXCD; wgid = (xcd < r ? xcd * (q + 1) : r * (q + 1) + (xcd - r) * q) + off; }
        const int nig = WGM * nN, gid = wgid / nig, fm = gid * WGM, gsz = (nM - fm) < WGM ? (nM - fm) : WGM;
        u.pm = fm + ((wgid % nig) % gsz); u.pn = (wgid % nig) / gsz; return true;
    }
    __device__ __forceinline__ void a_ready(const Unit&) const {}
    __device__ __forceinline__ void done(const Unit&) const {}
};
template <class Epi, class Sched, bool STAMP = false>
__device__ __forceinline__ void gemm_phase(PG8_LAS unsigned char* lds, const Gemm g, const Sched& S, const Epi& E, unsigned long long* stamps) {
    const int tid = opq_tid(), wid = __builtin_amdgcn_readfirstlane(tid >> 6), lane = tid & 63, wr = wid >> 2, wc = wid & 3, fr = lane & 15, fq = lane >> 4;
    const int K = g.K, nt = K / BK;
    int ts_lo = 0, ts_hi = 0, nts = 0; const unsigned long long rt_entry = STAMP ? (unsigned long long)wall_clock64() : 0ull;
#define PG8_STAMP() do { if (STAMP && wid == 0 && nts < 64) { const unsigned long long _c = (unsigned long long)clock64(); \
        ts_lo = (lane == nts) ? (int)(unsigned)_c : ts_lo; ts_hi = (lane == nts) ? (int)(unsigned)(_c >> 32) : ts_hi; ++nts; } } while (0)
    PG8_STAMP();
    unsigned voffA[2], voffB[2];
#pragma unroll
    for (int i = 0; i < 2; ++i) { int R, C; stage_rc(tid * 16 + i * 8192, R, C); const int Rb = Epi::PERM ? ((R & ~31) + perm32(R & 31)) : R;
        voffA[i] = (unsigned)(R * K + C) * 2u; voffB[i] = (unsigned)(Rb * K + C) * 2u; }
    const size_t kstep = (size_t)(BK * 2);
    const size_t hstep = (size_t)HALF * K * 2;
    const size_t tstep = 2 * hstep;
    const unsigned ldsw = (unsigned)wid * 1024u;
    const int aoff = lds_byte(wr * 64 + fr, fq * 8), boff = lds_byte(wc * 32 + fr, fq * 8);
#define PG8_SA(b, h) (((b) * 2 + (h)) * HTB)
#define PG8_SB(b, h) ((4 + (b) * 2 + (h)) * HTB)
#define PG8_STAGE(bufoff, gbase, voff) do { _Pragma("unroll") for (int _i = 0; _i < 2; ++_i) \
        __builtin_amdgcn_global_load_lds((const unsigned*)((const char*)(gbase) + (voff)[_i]), (PG8_LAS unsigned*)(lds + (bufoff) + ldsw + _i * 8192), 16, 0, 0); } while (0)
#define PG8_LDA(dst, b, h) do { _Pragma("unroll") for (int m = 0; m < 4; ++m) _Pragma("unroll") for (int k = 0; k < 2; ++k) dst[m][k] = *(const PG8_LAS bf16x8*)(lds + PG8_SA(b, h) + aoff + m * 2048 + k * 1024); } while (0)
#define PG8_LDB(dst, b, h) do { _Pragma("unroll") for (int n = 0; n < 2; ++n) _Pragma("unroll") for (int k = 0; k < 2; ++k) dst[n][k] = *(const PG8_LAS bf16x8*)(lds + PG8_SB(b, h) + boff + n * 2048 + k * 1024); } while (0)
#define PG8_MMA(ai, bj, At, Bt) do { __builtin_amdgcn_s_setprio(1); _Pragma("unroll") for (int m = 0; m < 4; ++m) _Pragma("unroll") for (int n = 0; n < 2; ++n) _Pragma("unroll") for (int k = 0; k < 2; ++k) \
        acc[ai][bj][m][n] = __builtin_amdgcn_mfma_f32_16x16x32_bf16(Bt[n][k], At[m][k], acc[ai][bj][m][n], 0, 0, 0); __builtin_amdgcn_s_setprio(0); } while (0)
#define PG8_WAIT_V(n) asm volatile("s_waitcnt vmcnt(" #n ")" ::: "memory")
#define PG8_WAIT_L(n) asm volatile("s_waitcnt lgkmcnt(" #n ")" ::: "memory")
#define PG8_BAR __builtin_amdgcn_s_barrier()
#define PG8_SCHED __builtin_amdgcn_sched_barrier(0)
    Unit cur, nxt; int ui = 0;
    if (!S.next(0, cur)) return;
    f32x4 acc[2][2][4][2];
#pragma unroll
    for (int a = 0; a < 2; ++a)
#pragma unroll
        for (int b = 0; b < 2; ++b)
#pragma unroll
            for (int m = 0; m < 4; ++m)
#pragma unroll
                for (int n = 0; n < 2; ++n) acc[a][b][m][n] = (f32x4){0.f, 0.f, 0.f, 0.f};
    bf16x8 At[4][2], B0[2][2], B1[2][2];
    const char* cA = (const char*)g.A + (size_t)cur.pm * tstep; const char* cB = (const char*)g.Bt + (size_t)cur.pn * tstep;
    S.a_ready(cur);
    PG8_STAGE(PG8_SB(0, 0), cB, voffB); PG8_STAGE(PG8_SA(0, 0), cA, voffA); PG8_STAGE(PG8_SB(0, 1), cB + hstep, voffB); PG8_STAGE(PG8_SA(0, 1), cA + hstep, voffA);
    if (wr == 1) PG8_BAR;
    PG8_WAIT_V(4); PG8_BAR;
    PG8_STAGE(PG8_SB(1, 0), cB + kstep, voffB); PG8_STAGE(PG8_SA(1, 0), cA + kstep, voffA); PG8_STAGE(PG8_SB(1, 1), cB + hstep + kstep, voffB);
    PG8_WAIT_V(6); PG8_BAR;
    PG8_STAMP();
    for (;;) {
        const bool has_next = S.next(ui + 1, nxt);
        const char* nA = has_next ? (const char*)g.A + (size_t)nxt.pm * tstep : cA; const char* nB = has_next ? (const char*)g.Bt + (size_t)nxt.pn * tstep : cB;
        for (int t = 0; t < nt; t += 2) {
            const bool last = (t == nt - 2);
            const char* a1 = cA + (size_t)(t + 1) * kstep;
            const char* a2 = last ? nA : cA + (size_t)(t + 2) * kstep; const char* b2 = last ? nB : cB + (size_t)(t + 2) * kstep;
            const char* a3 = a2 + kstep; const char* b3 = b2 + kstep;
            if (last && has_next) S.a_ready(nxt);
            PG8_LDB(B0, 0, 0); PG8_SCHED; PG8_LDA(At, 0, 0); PG8_STAGE(PG8_SA(1, 1), a1 + hstep, voffA);
            PG8_WAIT_L(8); PG8_BAR; PG8_WAIT_L(0); PG8_MMA(0, 0, At, B0); PG8_BAR; PG8_SCHED;
            PG8_LDB(B1, 0, 1); PG8_STAGE(PG8_SB(0, 0), b2, voffB);
            PG8_BAR; PG8_WAIT_L(0); PG8_MMA(0, 1, At, B1); PG8_BAR;
            PG8_LDA(At, 0, 1); PG8_STAGE(PG8_SA(0, 0), a2, voffA);
            PG8_BAR; PG8_WAIT_L(0); PG8_MMA(1, 0, At, B0); PG8_BAR; PG8_SCHED;
            PG8_STAGE(PG8_SB(0, 1), b2 + hstep, voffB);
            PG8_WAIT_V(6); PG8_BAR; PG8_MMA(1, 1, At, B1); PG8_BAR;
            PG8_LDB(B0, 1, 0); PG8_SCHED; PG8_LDA(At, 1, 0); PG8_STAGE(PG8_SA(0, 1), a2 + hstep, voffA);
            PG8_WAIT_L(8); PG8_BAR; PG8_WAIT_L(0); PG8_MMA(0, 0, At, B0); PG8_BAR; PG8_SCHED;
            PG8_LDB(B1, 1, 1); PG8_STAGE(PG8_SB(1, 0), b3, voffB);
            PG8_BAR; PG8_WAIT_L(0); PG8_MMA(0, 1, At, B1); PG8_BAR;
            PG8_LDA(At, 1, 1); PG8_STAGE(PG8_SA(1, 0), a3, voffA);
            PG8_BAR; PG8_WAIT_L(0); PG8_MMA(1, 0, At, B0); PG8_BAR; PG8_SCHED;
            PG8_STAGE(PG8_SB(1, 1), b3 + hstep, voffB);
            PG8_WAIT_V(6); PG8_BAR; PG8_MMA(1, 1, At, B1); PG8_BAR;
        }
        PG8_STAMP();
        if constexpr (!Epi::AFTER_DRAIN) { E(acc, cur, wr, wc, fr, fq); S.done(cur); }
        PG8_STAMP();
        if (!has_next) break;
#pragma unroll
        for (int a = 0; a < 2; ++a)
#pragma unroll
            for (int b = 0; b < 2; ++b)
#pragma unroll
                for (int m = 0; m < 4; ++m)
#pragma unroll
                    for (int n = 0; n < 2; ++n) acc[a][b][m][n] = (f32x4){0.f, 0.f, 0.f, 0.f};
        cur = nxt; cA = nA; cB = nB; ++ui;
    }
    PG8_WAIT_V(0);
    if (wr == 0) PG8_BAR;
    PG8_BAR;
    if constexpr (Epi::AFTER_DRAIN) { E.fused(acc, cur, wr, wc, fr, fq, lds, wid, lane); S.done(cur); }
    PG8_STAMP();
    if (STAMP && wid == 0) { stamps[lane] = lane < nts ? (((unsigned long long)(unsigned)ts_hi << 32) | (unsigned)ts_lo) : 0ull;
        if (lane == 62) stamps[62] = rt_entry; if (lane == 63) stamps[63] = (unsigned long long)wall_clock64(); }
#undef PG8_STAMP
#undef PG8_SA
#undef PG8_SB
#undef PG8_STAGE
#undef PG8_LDA
#undef PG8_LDB
#undef PG8_MMA
#undef PG8_WAIT_V
#undef PG8_WAIT_L
#undef PG8_BAR
#undef PG8_SCHED
}
}

#define XB_TMO      128
#define XB_XCNT(j)  (256  + 64 * (j))
#define XB_XSUB(j)  (1280 + 64 * (j))
#define XB_XGEN(j)  (2304 + 64 * (j))
#define XB_TOP      3328
#define XB_TOPGEN   3392
#define XCD_BAR_WORDS 3456
#define XB_SPIN_CAP (1u << 18)
#define LAS __attribute__((address_space(3)))

__device__ __forceinline__ unsigned xb_ld(unsigned* p)              { return __hip_atomic_load(p, __ATOMIC_RELAXED, __HIP_MEMORY_SCOPE_AGENT); }
__device__ __forceinline__ unsigned xb_add(unsigned* p, unsigned v) { return __hip_atomic_fetch_add(p, v, __ATOMIC_RELAXED, __HIP_MEMORY_SCOPE_AGENT); }
__device__ __forceinline__ unsigned xb_xcc_id() { return (unsigned)__builtin_amdgcn_s_getreg((3 << 11) | 20) & 0xFu; }
#define XB_SPIN(cond, bar) do { unsigned _sp = 0; while (cond) { __builtin_amdgcn_s_sleep(1); \
    if ((++_sp & 255u) == 0u) { if (xb_ld(&(bar)[XB_TMO])) break; if (_sp > XB_SPIN_CAP) { atomicAdd(&(bar)[XB_TMO], 1u); break; } } } } while (0)

struct XcdBarrier {
    unsigned* bar; unsigned x;
    volatile LAS unsigned* st;
};

__device__ __forceinline__ XcdBarrier xcd_barrier_post(unsigned* bar, volatile LAS unsigned* st) {
    XcdBarrier b; b.bar = bar; b.x = xb_xcc_id(); b.st = st;
    if (threadIdx.x == 0) (void)xb_add(&bar[XB_XCNT(b.x)], 1u);
    return b;
}
__device__ __forceinline__ void xcd_barrier_complete(unsigned* bar, unsigned x, unsigned& nloc, unsigned& nx) {
    const unsigned G = gridDim.x * gridDim.y * gridDim.z;
    unsigned sum, cnt, mine, sp = 0u;
    for (;;) {
        sum = 0u; cnt = 0u; mine = 0u;
#pragma unroll
        for (unsigned j = 0; j < 16; ++j) { const unsigned c = xb_ld(&bar[XB_XCNT(j)]); sum += c; cnt += (c > 0u) ? 1u : 0u; mine = (j == x) ? c : mine; }
        if (sum == G) break;
        __builtin_amdgcn_s_sleep(1);
        if ((++sp & 255u) == 0u) { if (xb_ld(&bar[XB_TMO])) break; if (sp > XB_SPIN_CAP) { atomicAdd(&bar[XB_TMO], 1u); break; } }
    }
    nloc = mine > 0u ? mine : 1u; nx = cnt > 0u ? cnt : 1u;
}

__device__ __forceinline__ void xcd_barrier(const XcdBarrier& b) {
    asm volatile("s_waitcnt vmcnt(0)" ::: "memory");
    __syncthreads();
    if (threadIdx.x == 0) {
        unsigned* bar = b.bar;
        __builtin_amdgcn_s_waitcnt(0);
        unsigned nloc = b.st[0], nx = b.st[1];
        if (nloc == 0u) { xcd_barrier_complete(bar, b.x, nloc, nx); b.st[0] = nloc; b.st[1] = nx; }
        const unsigned old = xb_add(&bar[XB_XSUB(b.x)], 1u);
        const unsigned gen = old / nloc;
        if (old + 1u == (gen + 1u) * nloc) {
            __builtin_amdgcn_fence(__ATOMIC_RELEASE, "agent");
            asm volatile("s_waitcnt vmcnt(0)" ::: "memory");
            const unsigned og = xb_add(&bar[XB_TOP], 1u);
            const unsigned tg = og / nx;
            if (og + 1u == (tg + 1u) * nx) xb_add(&bar[XB_TOPGEN], 1u);
            else XB_SPIN(xb_ld(&bar[XB_TOPGEN]) == tg, bar);
            __builtin_amdgcn_fence(__ATOMIC_ACQUIRE, "agent");
            xb_add(&bar[XB_XGEN(b.x)], 1u);
            asm volatile("s_waitcnt vmcnt(0)" ::: "memory");
        } else {
            XB_SPIN(xb_ld(&bar[XB_XGEN(b.x)]) == gen, bar);
            __builtin_amdgcn_fence(__ATOMIC_ACQUIRE, "agent");
            asm volatile("s_waitcnt vmcnt(0)" ::: "memory");
        }
    }
    __syncthreads();
}

typedef unsigned short bf16_t;
typedef short bf16x8 __attribute__((ext_vector_type(8)));
typedef float f32x4 __attribute__((ext_vector_type(4)));
typedef float f32x16 __attribute__((ext_vector_type(16)));

constexpr int DM = 2048, SEQ = 4096, NBP = 2, NBS = 32, TP = NBP * SEQ, MT = TP + NBS, MP = 8448;
constexpr int INW = 6784, INWP = 6912, SHD = 3200, DEPTH = 2;
constexpr size_t NRI = (size_t)MT * 1024;
constexpr int LDS_BYTES = 131072 + 16;
constexpr size_t O_CKP = (size_t)MT * DM;
constexpr size_t O_CVP = O_CKP + (size_t)DEPTH * NBP * 128 * 256;
constexpr size_t O_WKVP = O_CVP + (size_t)DEPTH * NBP * 128 * 256;
constexpr size_t O_SHP = O_WKVP + (size_t)DEPTH * NBP * 16 * 4096;
constexpr size_t O_CKS = O_SHP + (size_t)DEPTH * NBP * SHD;
constexpr size_t O_CVS = O_CKS + (size_t)DEPTH * NBS * 128 * 256;
constexpr size_t O_WKVS = O_CVS + (size_t)DEPTH * NBS * 128 * 256;
constexpr size_t O_SHS = O_WKVS + (size_t)DEPTH * NBS * 16 * 4096;
constexpr size_t O_END = O_SHS + (size_t)DEPTH * NBS * SHD;
constexpr size_t al256(size_t x) { return (x + 255) & ~(size_t)255; }
constexpr size_t WS_WTIN = 0;
constexpr size_t WS_WTOUT = WS_WTIN + (size_t)INWP * DM * 2;
constexpr size_t WS_MOD = WS_WTOUT + (size_t)DEPTH * DM * DM * 2;
constexpr size_t WS_ROPE = WS_MOD + al256((size_t)DEPTH * 34 * 6144 * 4);
constexpr size_t WS_HB = WS_ROPE + al256((size_t)4097 * 16 * 4);
constexpr size_t WS_QB = WS_HB + (size_t)MP * DM * 2;
constexpr size_t WS_KB = WS_QB + (size_t)MP * 1024 * 2;
constexpr size_t WS_VB = WS_KB + (size_t)MP * 256 * 2;
constexpr size_t WS_RW = WS_VB + (size_t)MP * 256 * 2;
constexpr size_t WS_GT = WS_RW + (size_t)MP * SHD * 2;
constexpr size_t WS_VALL = WS_GT + (size_t)MP * DM * 2;
constexpr size_t SRI = (size_t)NBS * 1024;
constexpr size_t WS_RSB = WS_VALL + NRI * 2;
constexpr size_t WS_RSW = WS_RSB + 4 * SRI * 2;
constexpr size_t WS_YS = WS_RSW + SRI * 4;
constexpr size_t WS_REC = WS_YS + NRI * 4;
constexpr size_t WS_COEF = WS_REC + (size_t)32 * 256 * 14592;
constexpr size_t WS_TWAD = WS_COEF + al256((size_t)MT * 16 * 4);
constexpr size_t WS_WFRAG = WS_TWAD + (size_t)MT * 128 * 2;
constexpr size_t WS_BAR = WS_WFRAG + (size_t)DEPTH * 2 * 16 * 4 * 2 * 64 * 16;
constexpr size_t WS_RFLAG = WS_BAR + 16384;
constexpr size_t RFLAG_BYTES = (size_t)32 * 256 * 64;
constexpr size_t WS_END = WS_RFLAG + RFLAG_BYTES;

struct Params {
    const float *x_prompt, *x_sample, *cache_k, *cache_v, *state_wkv, *state_shift, *c_prompt, *c_sample, *norm_g, *w_ada, *b_ada, *w_in, *mu_shift, *w0, *w_decay, *a0,
        *w_iclr, *k_k, *k_a, *r_k, *ln_w, *ln_b, *sinks, *w_out, *final_g;
    float* out;
    unsigned char* ws;
    int repk, repl;
};
typedef const __attribute__((address_space(4))) Params* KParamsPtr;
__device__ __forceinline__ const Params& kparams() {
    KParamsPtr k = (KParamsPtr)__builtin_amdgcn_kernarg_segment_ptr();
    asm volatile("" : "+s"(k));
    return *(const Params*)k;
}

__device__ __forceinline__ unsigned short f2bf(float f) { return (unsigned short)(hw_cvt_pk_bf16(f, 0.f) & 0xffffu); }
__device__ __forceinline__ float bf2f(unsigned short b) { return __uint_as_float(((unsigned)b) << 16); }
__device__ __forceinline__ unsigned pack2(float lo, float hi) { return hw_cvt_pk_bf16(lo, hi); }
__device__ __forceinline__ float bflo(unsigned w) { return __uint_as_float(w << 16); }
__device__ __forceinline__ float bfhi(unsigned w) { return __uint_as_float(w & 0xffff0000u); }
__device__ __forceinline__ float silu_f(float x) { return x / (1.f + __expf(-x)); }
__device__ __forceinline__ float wave_sum(float x) {
#pragma unroll
    for (int o = 32; o >= 1; o >>= 1) x += __shfl_xor(x, o);
    return x;
}
__device__ __forceinline__ float wave_max(float x) {
#pragma unroll
    for (int o = 32; o >= 1; o >>= 1) x = fmaxf(x, __shfl_xor(x, o));
    return x;
}
template <int CTRL> __device__ __forceinline__ float dpp_f(float x) {
    return __builtin_bit_cast(float, __builtin_amdgcn_update_dpp(0, __builtin_bit_cast(int, x), CTRL, 0xF, 0xF, false));
}
__device__ __forceinline__ float allreduce16(float x) {
    x += dpp_f<0x128>(x);
    x += dpp_f<0x124>(x);
    x += dpp_f<0x122>(x);
    x += dpp_f<0x121>(x);
    return x;
}

__device__ void p0_mod_item(const Params& p, float* red, int l, int nc) {
    const int tid = opq_tid(), wv = tid >> 6, lane = tid & 63, n = lane & 31, kh = lane >> 5;
    f32x16 acc0, acc1;
#pragma unroll
    for (int i = 0; i < 16; ++i) { acc0[i] = 0.f; acc1[i] = 0.f; }
    const float* W = p.w_ada + (size_t)l * DM * 6144 + nc * 32 + n;
#pragma unroll 8
    for (int ks = 0; ks < 16; ++ks) {
        const int k0 = wv * 256 + ks * 16 + kh * 8;
        bf16x8 bfr, a0, a1;
#pragma unroll
        for (int j = 0; j < 8; ++j) bfr[j] = (short)f2bf(W[(size_t)(k0 + j) * 6144]);
        const float4* cs = (const float4*)(p.c_sample + (size_t)n * DM + k0);
        const float4 u0 = cs[0], u1 = cs[1];
        a0[0] = (short)f2bf(silu_f(u0.x)); a0[1] = (short)f2bf(silu_f(u0.y)); a0[2] = (short)f2bf(silu_f(u0.z)); a0[3] = (short)f2bf(silu_f(u0.w));
        a0[4] = (short)f2bf(silu_f(u1.x)); a0[5] = (short)f2bf(silu_f(u1.y)); a0[6] = (short)f2bf(silu_f(u1.z)); a0[7] = (short)f2bf(silu_f(u1.w));
        float4 q0 = make_float4(0.f, 0.f, 0.f, 0.f), q1 = q0;
        if (n < 2) { const float4* cp = (const float4*)(p.c_prompt + (size_t)n * DM + k0); q0 = cp[0]; q1 = cp[1]; }
        a1[0] = (short)f2bf(silu_f(q0.x)); a1[1] = (short)f2bf(silu_f(q0.y)); a1[2] = (short)f2bf(silu_f(q0.z)); a1[3] = (short)f2bf(silu_f(q0.w));
        a1[4] = (short)f2bf(silu_f(q1.x)); a1[5] = (short)f2bf(silu_f(q1.y)); a1[6] = (short)f2bf(silu_f(q1.z)); a1[7] = (short)f2bf(silu_f(q1.w));
        acc0 = __builtin_amdgcn_mfma_f32_32x32x16_bf16(a0, bfr, acc0, 0, 0, 0);
        acc1 = __builtin_amdgcn_mfma_f32_32x32x16_bf16(a1, bfr, acc1, 0, 0, 0);
    }
#pragma unroll
    for (int i = 0; i < 16; ++i) red[(wv * 18 + i) * 64 + lane] = acc0[i];
    red[(wv * 18 + 16) * 64 + lane] = acc1[0];
    red[(wv * 18 + 17) * 64 + lane] = acc1[1];
    __syncthreads();
    float* mod = (float*)(p.ws + WS_MOD);
    for (int o = tid; o < 34 * 32; o += 512) {
        const int row = o >> 5, col = o & 31;
        int ri, ln, mrow;
        if (row < 32) { const int khh = (row >> 2) & 1; ri = (row & 3) + 4 * (row >> 3); ln = col + 32 * khh; mrow = 2 + row; }
        else { ri = 16 + (row - 32); ln = col; mrow = row - 32; }
        float s = 0.f;
#pragma unroll
        for (int w = 0; w < 8; ++w) s += red[(w * 18 + ri) * 64 + ln];
        mod[((size_t)l * 34 + mrow) * 6144 + nc * 32 + col] = s + p.b_ada[l * 6144 + nc * 32 + col];
    }
    __syncthreads();
}

struct ConvIt { const float* src; bf16_t* dst; int N, k0, n0; };
__device__ __forceinline__ ConvIt conv_decode(const Params& p, int cidx, int lw) {
    ConvIt c;
    int kt, nt;
    if (cidx < 1728) { kt = cidx & 15; nt = cidx >> 4; c.N = INW; c.src = p.w_in + (size_t)lw * DM * INW; c.dst = (bf16_t*)(p.ws + WS_WTIN); }
    else { int rem = cidx - 1728; const int l2 = rem >> 9; rem &= 511; kt = rem & 15; nt = rem >> 4; c.N = DM; c.src = p.w_out + (size_t)l2 * DM * DM; c.dst = (bf16_t*)(p.ws + WS_WTOUT) + (size_t)l2 * DM * DM; }
    c.k0 = kt * 128; c.n0 = nt * 64;
    return c;
}
__device__ void p0_conv_all(const Params& p, float* s, int bid, int G, int total, int lw) {
    const int tid = opq_tid();
    const int lrow = tid >> 4, c4 = tid & 15, n = tid >> 3, kg = tid & 7;
    float4 v[4];
    int cidx = bid;
    ConvIt cur = conv_decode(p, cidx < total ? cidx : 0, lw);
    if (cidx < total) {
#pragma unroll
        for (int p4 = 0; p4 < 4; ++p4) { v[p4] = make_float4(0.f, 0.f, 0.f, 0.f); if (cur.n0 < cur.N) v[p4] = *(const float4*)(cur.src + (size_t)(cur.k0 + lrow + 32 * p4) * cur.N + cur.n0 + 4 * c4); }
    }
#pragma unroll 1
    while (cidx < total) {
#pragma unroll
        for (int p4 = 0; p4 < 4; ++p4) { float* d = s + (lrow + 32 * p4) * 65 + 4 * c4; d[0] = v[p4].x; d[1] = v[p4].y; d[2] = v[p4].z; d[3] = v[p4].w; }
        __syncthreads();
        const int nxt = cidx + G;
        const ConvIt nx = conv_decode(p, nxt < total ? nxt : 0, lw);
        if (nxt < total) {
#pragma unroll
            for (int p4 = 0; p4 < 4; ++p4) { v[p4] = make_float4(0.f, 0.f, 0.f, 0.f); if (nx.n0 < nx.N) v[p4] = *(const float4*)(nx.src + (size_t)(nx.k0 + lrow + 32 * p4) * nx.N + nx.n0 + 4 * c4); }
        }
        unsigned w[8];
#pragma unroll
        for (int j = 0; j < 8; ++j) w[j] = pack2(s[(kg * 16 + 2 * j) * 65 + n], s[(kg * 16 + 2 * j + 1) * 65 + n]);
        uint4* o = (uint4*)(cur.dst + (size_t)(cur.n0 + n) * DM + cur.k0 + kg * 16);
        o[0] = make_uint4(w[0], w[1], w[2], w[3]);
        o[1] = make_uint4(w[4], w[5], w[6], w[7]);
        __syncthreads();
        cur = nx; cidx = nxt;
    }
}

__device__ void p0_rope_item(const Params& p, int it) {
    float* rope = (float*)(p.ws + WS_ROPE);
#pragma unroll
    for (int q = 0; q < 4; ++q) {
        const int e = it * 2048 + q * 512 + opq_tid();
        if (e < 4097 * 8) {
            const int idx = e >> 3, i = e & 7;
            double invf = 1.0;
            for (int q = 0; q < i; ++q) invf *= 0.19392274474868576;
            const double pos = idx < 4096 ? (double)idx : 16384.0;
            const double rev = pos * invf * 0.15915494309189535;
            const float f = (float)(rev - floor(rev));
            rope[idx * 16 + i] = __builtin_amdgcn_cosf(f);
            rope[idx * 16 + 8 + i] = __builtin_amdgcn_sinf(f);
        }
    }
}

__device__ void p0_wfrag_item(const Params& p, int it) {
    const int e0 = it * 512 + opq_tid();
    const int lane = e0 & 63, ks = (e0 >> 6) & 1, ct = (e0 >> 7) & 3, hd = (e0 >> 9) & 15, mtx = (e0 >> 13) & 1, l = e0 >> 14;
    const float* W = (mtx == 0 ? p.w_decay : p.w_iclr) + (size_t)l * 64 * 1024 + hd * 64 + 16 * ct + (lane & 15);
    const int k0 = 32 * ks + 8 * (lane >> 4);
    float v[8];
#pragma unroll
    for (int e = 0; e < 8; ++e) v[e] = W[(size_t)(k0 + e) * 1024];
    ((uint4*)(p.ws + WS_WFRAG))[e0] = make_uint4(pack2(v[0], v[1]), pack2(v[2], v[3]), pack2(v[4], v[5]), pack2(v[6], v[7]));
}

__device__ void p1_norm(const Params& p, int l, int bid, int G) {
    const int tid = opq_tid(), wv = tid >> 6, lane = tid & 63;
    bf16_t* hb = (bf16_t*)(p.ws + WS_HB);
    const float* mod = (const float*)(p.ws + WS_MOD);
    const float4* g4 = (const float4*)(p.norm_g + l * DM);
    for (int r = bid * 8 + wv; r < MT; r += G * 8) {
        const float* xr = l == 0 ? (r < TP ? p.x_prompt + (size_t)r * DM : p.x_sample + (size_t)(r - TP) * DM) : p.out + (size_t)r * DM;
        const int mrow = r < TP ? (r >> 12) : 2 + (r - TP);
        const float* md = mod + ((size_t)l * 34 + mrow) * 6144;
        float4 v[8]; float ss = 0.f;
#pragma unroll
        for (int i = 0; i < 8; ++i) { v[i] = ((const float4*)xr)[lane + 64 * i]; ss += v[i].x * v[i].x + v[i].y * v[i].y + v[i].z * v[i].z + v[i].w * v[i].w; }
        ss = wave_sum(ss);
        const float rinv = rsqrtf(ss * (1.f / 2048.f) + 1e-5f);
#pragma unroll
        for (int i = 0; i < 8; ++i) {
            const int c4 = lane + 64 * i;
            const float4 g = g4[c4], sc = ((const float4*)(md + 2048))[c4], sh = ((const float4*)md)[c4];
            const float y0 = v[i].x * rinv * g.x * (1.f + sc.x) + sh.x, y1 = v[i].y * rinv * g.y * (1.f + sc.y) + sh.y;
            const float y2 = v[i].z * rinv * g.z * (1.f + sc.z) + sh.z, y3 = v[i].w * rinv * g.w * (1.f + sc.w) + sh.w;
            *(uint2*)(hb + (size_t)r * DM + 4 * c4) = make_uint2(pack2(y0, y1), pack2(y2, y3));
        }
    }
}

struct Epi1 {
    static constexpr bool PERM = false, AFTER_DRAIN = false;
    int l;
    __device__ __forceinline__ void operator()(const f32x4 (&acc)[2][2][4][2], const pg8::Unit& u, int wr, int wc, int fr, int fq) const {
        const Params& p = kparams();
        bf16_t* const qb = (bf16_t*)(p.ws + WS_QB); bf16_t* const kb = (bf16_t*)(p.ws + WS_KB); bf16_t* const vb = (bf16_t*)(p.ws + WS_VB);
        bf16_t* const rw = (bf16_t*)(p.ws + WS_RW); bf16_t* const gt = (bf16_t*)(p.ws + WS_GT); const float* const rope = (const float*)(p.ws + WS_ROPE); float* const out = p.out;
#pragma unroll
        for (int bj = 0; bj < 2; ++bj)
#pragma unroll
            for (int n = 0; n < 2; ++n) {
                const int cb = u.pn * 256 + bj * 128 + wc * 32 + n * 16;
                if (cb >= INW) continue;
                const int c = cb + 4 * fq;
                const bool do_rope = (cb < 1280) && ((cb & 63) == 0);
#pragma unroll
                for (int ai = 0; ai < 2; ++ai)
#pragma unroll
                    for (int m = 0; m < 4; ++m) {
                        const int rb = u.pm * 256 + ai * 128 + wr * 64 + m * 16;
                        if (rb >= MT) continue;
                        const int r = rb + fr;
                        f32x4 v = acc[ai][bj][m][n];
                        if (do_rope) {
                            const int idx = r < TP ? (r & 4095) : 4096;
                            const float4 cs = *(const float4*)(rope + idx * 16 + 4 * (fq & 1));
                            const float4 sn = *(const float4*)(rope + idx * 16 + 8 + 4 * (fq & 1));
                            const float p0 = __shfl_xor(v[0], 32), p1 = __shfl_xor(v[1], 32), p2 = __shfl_xor(v[2], 32), p3 = __shfl_xor(v[3], 32);
                            const float sg = fq < 2 ? -1.f : 1.f;
                            v[0] = v[0] * cs.x + sg * p0 * sn.x; v[1] = v[1] * cs.y + sg * p1 * sn.y; v[2] = v[2] * cs.z + sg * p2 * sn.z; v[3] = v[3] * cs.w + sg * p3 * sn.w;
                        }
                        if (cb < 1024) {
                            *(uint2*)(qb + (size_t)r * 1024 + c) = make_uint2(pack2(v[0] * 0.125f, v[1] * 0.125f), pack2(v[2] * 0.125f, v[3] * 0.125f));
                        } else if (cb < 1536) {
                            const bool isk = cb < 1280;
                            const int cc = c - (isk ? 1024 : 1280);
                            *(uint2*)((isk ? kb : vb) + (size_t)r * 256 + cc) = make_uint2(pack2(v[0], v[1]), pack2(v[2], v[3]));
                            if (r >= TP) {
                                *(f32x4*)(out + (isk ? O_CKS : O_CVS) + ((size_t)(l * NBS + (r - TP)) * 128 + 127) * 256 + cc) = v;
                            } else if ((r & 4095) >= SEQ - 128) {
                                *(f32x4*)(out + (isk ? O_CKP : O_CVP) + ((size_t)(l * NBP + (r >> 12)) * 128 + ((r & 4095) - (SEQ - 128))) * 256 + cc) = v;
                            }
                        } else if (cb < 4736) {
                            const int cc = c - 1536;
                            *(uint2*)(rw + (size_t)r * SHD + cc) = make_uint2(pack2(v[0], v[1]), pack2(v[2], v[3]));
                            if (r >= TP) *(f32x4*)(out + O_SHS + (size_t)(l * NBS + (r - TP)) * SHD + cc) = v;
                            else if ((r & 4095) == SEQ - 1) *(f32x4*)(out + O_SHP + (size_t)(l * NBP + (r >> 12)) * SHD + cc) = v;
                        } else {
                            const int cc = c - 4736;
                            *(uint2*)(gt + (size_t)r * DM + cc) = make_uint2(pack2(silu_f(v[0]), silu_f(v[1])), pack2(silu_f(v[2]), silu_f(v[3])));
                        }
                    }
            }
    }
};

struct Epi2 {
    static constexpr bool PERM = false, AFTER_DRAIN = false;
    int l;
    __device__ __forceinline__ void operator()(const f32x4 (&acc)[2][2][4][2], const pg8::Unit& u, int wr, int wc, int fr, int fq) const {
        const Params& p = kparams();
        float* const out = p.out;
        const int rb0 = u.pm * 256;
        const int mrow = rb0 < TP ? (rb0 >> 12) : 2;
        const float* gr = (const float*)(p.ws + WS_MOD) + ((size_t)l * 34 + mrow) * 6144 + 4096 + u.pn * 256 + wc * 32 + 4 * fq;
        f32x4 g4[2][2];
#pragma unroll
        for (int bj = 0; bj < 2; ++bj)
#pragma unroll
            for (int n = 0; n < 2; ++n) g4[bj][n] = *(const f32x4*)(gr + bj * 128 + n * 16);
        const float* xbase = l == 0 ? p.x_prompt : out;
        const int c0 = u.pn * 256 + wc * 32 + 4 * fq;
#pragma unroll
        for (int ai = 0; ai < 2; ++ai)
#pragma unroll
            for (int mh = 0; mh < 2; ++mh) {
                f32x4 x4[2][2][2];
#pragma unroll
                for (int mm = 0; mm < 2; ++mm) {
                    const int r = rb0 + ai * 128 + wr * 64 + (2 * mh + mm) * 16 + fr;
                    const float* xo = xbase + (size_t)r * DM + c0;
#pragma unroll
                    for (int bj = 0; bj < 2; ++bj)
#pragma unroll
                        for (int n = 0; n < 2; ++n) x4[mm][bj][n] = *(const f32x4*)(xo + bj * 128 + n * 16);
                }
                __builtin_amdgcn_sched_barrier(0);
#pragma unroll
                for (int mm = 0; mm < 2; ++mm) {
                    const int r = rb0 + ai * 128 + wr * 64 + (2 * mh + mm) * 16 + fr;
                    float* yo = out + (size_t)r * DM + c0;
#pragma unroll
                    for (int bj = 0; bj < 2; ++bj)
#pragma unroll
                        for (int n = 0; n < 2; ++n) *(f32x4*)(yo + bj * 128 + n * 16) = x4[mm][bj][n] + g4[bj][n] * acc[ai][bj][2 * mh + mm][n];
                }
                __builtin_amdgcn_sched_barrier(0);
            }
    }
};

__device__ void g2_sample_item(const Params& p, float* red, int l, int nb) {
    const int tid = opq_tid(), wv = tid >> 6, lane = tid & 63, n = lane & 31, h = lane >> 5;
    const bf16_t* A = (const bf16_t*)(p.ws + WS_HB) + (size_t)TP * DM;
    const bf16_t* Bt = (const bf16_t*)(p.ws + WS_WTOUT) + (size_t)l * DM * DM + (size_t)(nb * 32) * DM;
    f32x16 acc;
#pragma unroll
    for (int i = 0; i < 16; ++i) acc[i] = 0.f;
#pragma unroll 4
    for (int ks = 0; ks < 16; ++ks) {
        const int k0 = wv * 256 + ks * 16 + 8 * h;
        const bf16x8 a = *(const bf16x8*)(A + (size_t)n * DM + k0);
        const bf16x8 bq = *(const bf16x8*)(Bt + (size_t)n * DM + k0);
        acc = __builtin_amdgcn_mfma_f32_32x32x16_bf16(a, bq, acc, 0, 0, 0);
    }
#pragma unroll
    for (int i = 0; i < 16; ++i) red[(wv * 16 + i) * 64 + lane] = acc[i];
    __syncthreads();
    const float* mod = (const float*)(p.ws + WS_MOD) + (size_t)l * 34 * 6144;
    for (int o = tid; o < 1024; o += 512) {
        const int row = o >> 5, col = o & 31, hh = (row >> 2) & 1, ri = (row & 3) + 4 * (row >> 3), ln = col + 32 * hh;
        float s = 0.f;
#pragma unroll
        for (int w = 0; w < 8; ++w) s += red[(w * 16 + ri) * 64 + ln];
        const int c = nb * 32 + col;
        const float gate = mod[(size_t)(2 + row) * 6144 + 4096 + c];
        const float xo = l == 0 ? p.x_sample[(size_t)row * DM + c] : p.out[(size_t)(TP + row) * DM + c];
        p.out[(size_t)(TP + row) * DM + c] = xo + gate * s;
    }
    __syncthreads();
}

__device__ void p3_attn_unit(const Params& p, unsigned char* lds, int l, int unit) {
    const int tid = opq_tid(), wv = tid >> 6, lane = tid & 63;
    const int b = unit >> 7, n = (unit >> 2) & 31, g = unit & 3;
    bf16_t* Ks = (bf16_t*)lds;
    bf16_t* Vt = (bf16_t*)(lds + 36864);
    const bf16_t* qb = (const bf16_t*)(p.ws + WS_QB);
    const bf16_t* kb = (const bf16_t*)(p.ws + WS_KB);
    const bf16_t* vb = (const bf16_t*)(p.ws + WS_VB);
    const bf16_t* gt = (const bf16_t*)(p.ws + WS_GT);
    bf16_t* cc = (bf16_t*)(p.ws + WS_HB);
    {
        uint4 kv4[4], vv4[4];
#pragma unroll
        for (int i = 0; i < 4; ++i) {
            const int chunk = tid + 512 * i, kl = chunk >> 3, dc = chunk & 7, kp = 128 * (n - 1) + kl;
            kv4[i] = make_uint4(0u, 0u, 0u, 0u); vv4[i] = kv4[i];
            if (kp >= 0) { const size_t row = (size_t)b * SEQ + kp; kv4[i] = *(const uint4*)(kb + row * 256 + g * 64 + dc * 8); vv4[i] = *(const uint4*)(vb + row * 256 + g * 64 + dc * 8); }
        }
        __builtin_amdgcn_sched_barrier(0);
#pragma unroll
        for (int i = 0; i < 4; ++i) {
            const int chunk = tid + 512 * i, kl = chunk >> 3, dc = chunk & 7;
            *(uint4*)(Ks + kl * 72 + dc * 8) = kv4[i];
            bf16_t* vd = Vt + (dc * 8) * 264 + kl;
            vd[0 * 264] = (bf16_t)(vv4[i].x & 0xffffu); vd[1 * 264] = (bf16_t)(vv4[i].x >> 16);
            vd[2 * 264] = (bf16_t)(vv4[i].y & 0xffffu); vd[3 * 264] = (bf16_t)(vv4[i].y >> 16);
            vd[4 * 264] = (bf16_t)(vv4[i].z & 0xffffu); vd[5 * 264] = (bf16_t)(vv4[i].z >> 16);
            vd[6 * 264] = (bf16_t)(vv4[i].w & 0xffffu); vd[7 * 264] = (bf16_t)(vv4[i].w >> 16);
        }
    }
    __syncthreads();
    const int hq = 4 * g + (wv >> 1), qh = wv & 1, q32 = lane & 31, h = lane >> 5;
    const float sink = p.sinks[l * 16 + hq];
#pragma unroll 1
    for (int s = 0; s < 2; ++s) {
        const int qp = 128 * n + 64 * qh + 32 * s + q32;
        const size_t qrow = (size_t)b * SEQ + qp;
        const int klb0 = 64 * qh + 32 * s;
        bf16x8 qf[4];
#pragma unroll
        for (int ks = 0; ks < 4; ++ks) qf[ks] = *(const bf16x8*)(qb + qrow * 1024 + hq * 64 + ks * 16 + 8 * h);
        f32x16 S[5];
#pragma unroll
        for (int kt = 0; kt < 5; ++kt) {
#pragma unroll
            for (int i = 0; i < 16; ++i) S[kt][i] = 0.f;
#pragma unroll
            for (int ks = 0; ks < 4; ++ks) {
                const bf16x8 a = *(const bf16x8*)(Ks + (klb0 + 32 * kt + q32) * 72 + ks * 16 + 8 * h);
                S[kt] = __builtin_amdgcn_mfma_f32_32x32x16_bf16(a, qf[ks], S[kt], 0, 0, 0);
            }
        }
        float mx = -1e30f;
#pragma unroll
        for (int kt = 0; kt < 5; ++kt)
#pragma unroll
            for (int i = 0; i < 16; ++i) {
                const int m = 8 * (i >> 2) + 4 * h + (i & 3);
                const int kp = 128 * (n - 1) + klb0 + 32 * kt + m;
                const int rel = qp - kp;
                const bool ok = (rel >= 0) && (rel <= 128) && (kp >= 0);
                const float sv = ok ? S[kt][i] : -1e30f;
                S[kt][i] = sv; mx = fmaxf(mx, sv);
            }
        mx = fmaxf(mx, __shfl_xor(mx, 32));
        mx = fmaxf(mx, sink);
        float sum = 0.f;
#pragma unroll
        for (int kt = 0; kt < 5; ++kt)
#pragma unroll
            for (int i = 0; i < 16; ++i) { const float e = __expf(S[kt][i] - mx); S[kt][i] = e; sum += e; }
        sum += __shfl_xor(sum, 32);
        const float inv = 1.f / (sum + __expf(sink - mx));
        f32x16 O[2];
#pragma unroll
        for (int i = 0; i < 16; ++i) { O[0][i] = 0.f; O[1][i] = 0.f; }
#pragma unroll
        for (int kt = 0; kt < 5; ++kt)
#pragma unroll
            for (int sp = 0; sp < 2; ++sp) {
                bf16x8 pf;
#pragma unroll
                for (int j = 0; j < 8; ++j) pf[j] = (short)f2bf(S[kt][8 * sp + j]);
#pragma unroll
                for (int dt = 0; dt < 2; ++dt) {
                    const bf16_t* vp = Vt + (32 * dt + q32) * 264 + klb0 + 32 * kt + 16 * sp + 4 * h;
                    const uint2 lo = *(const uint2*)vp, hi = *(const uint2*)(vp + 8);
                    const uint4 av = make_uint4(lo.x, lo.y, hi.x, hi.y);
                    O[dt] = __builtin_amdgcn_mfma_f32_32x32x16_bf16(__builtin_bit_cast(bf16x8, av), pf, O[dt], 0, 0, 0);
                }
            }
        uint2 gq[2][4];
#pragma unroll
        for (int dt = 0; dt < 2; ++dt)
#pragma unroll
            for (int ig = 0; ig < 4; ++ig) gq[dt][ig] = *(const uint2*)(gt + qrow * DM + hq * 64 + 32 * dt + 8 * ig + 4 * h);
        __builtin_amdgcn_sched_barrier(0);
#pragma unroll
        for (int dt = 0; dt < 2; ++dt)
#pragma unroll
            for (int ig = 0; ig < 4; ++ig) {
                const int col = hq * 64 + 32 * dt + 8 * ig + 4 * h;
                const uint2 gg = gq[dt][ig];
                const float o0 = O[dt][4 * ig + 0] * inv * bflo(gg.x), o1 = O[dt][4 * ig + 1] * inv * bfhi(gg.x);
                const float o2 = O[dt][4 * ig + 2] * inv * bflo(gg.y), o3 = O[dt][4 * ig + 3] * inv * bfhi(gg.y);
                *(uint2*)(cc + qrow * DM + col) = make_uint2(pack2(o0, o1), pack2(o2, o3));
            }
    }
    __syncthreads();
}

__device__ void p3_sattn_item(const Params& p, float* lds, int l, int item) {
    const int tid = opq_tid(), wv = tid >> 6, lane = tid & 63;
    float* pl = lds + wv * 128;
    const int w = item * 8 + wv, bd = w >> 4, hq = w & 15, g = hq >> 2;
    const size_t row = (size_t)TP + bd;
    const bf16_t* qb = (const bf16_t*)(p.ws + WS_QB);
    const bf16_t* gt = (const bf16_t*)(p.ws + WS_GT);
    bf16_t* cc = (bf16_t*)(p.ws + WS_HB);
    float q[64];
#pragma unroll
    for (int c = 0; c < 8; ++c) {
        const uint4 u = *(const uint4*)(qb + row * 1024 + hq * 64 + c * 8);
        q[c * 8 + 0] = bflo(u.x); q[c * 8 + 1] = bfhi(u.x); q[c * 8 + 2] = bflo(u.y); q[c * 8 + 3] = bfhi(u.y);
        q[c * 8 + 4] = bflo(u.z); q[c * 8 + 5] = bfhi(u.z); q[c * 8 + 6] = bflo(u.w); q[c * 8 + 7] = bfhi(u.w);
    }
    const size_t cbase = ((size_t)(l * NBS + bd) * 128) * 256 + g * 64;
    const float* ck = p.cache_k + cbase;
    const float* cv = p.cache_v + cbase;
    float* nk = p.out + O_CKS + cbase;
    float* nv = p.out + O_CVS + cbase;
    float s0 = 0.f, s1 = 0.f, s2 = 0.f;
#pragma unroll
    for (int c = 0; c < 16; ++c) {
        const float4 a = ((const float4*)(ck + (size_t)lane * 256))[c];
        const float4 bq = ((const float4*)(ck + (size_t)(lane + 64) * 256))[c];
        const float4 e = ((const float4*)(nk + (size_t)127 * 256))[c];
        s0 += a.x * q[4 * c] + a.y * q[4 * c + 1] + a.z * q[4 * c + 2] + a.w * q[4 * c + 3];
        s1 += bq.x * q[4 * c] + bq.y * q[4 * c + 1] + bq.z * q[4 * c + 2] + bq.w * q[4 * c + 3];
        s2 += e.x * q[4 * c] + e.y * q[4 * c + 1] + e.z * q[4 * c + 2] + e.w * q[4 * c + 3];
    }
    const float sink = p.sinks[l * 16 + hq];
    const float mx = fmaxf(wave_max(fmaxf(s0, s1)), fmaxf(s2, sink));
    const float p0 = __expf(s0 - mx), p1 = __expf(s1 - mx), p2 = __expf(s2 - mx);
    const float sum = wave_sum(p0 + p1) + p2 + __expf(sink - mx);
    pl[lane] = p0; pl[lane + 64] = p1;
    __builtin_amdgcn_fence(__ATOMIC_RELEASE, "wavefront");
    __builtin_amdgcn_wave_barrier();
    __builtin_amdgcn_fence(__ATOMIC_ACQUIRE, "wavefront");
    float o = 0.f;
#pragma unroll 32
    for (int key = 0; key < 128; ++key) o += pl[key] * cv[(size_t)key * 256 + lane];
    o += p2 * nv[(size_t)127 * 256 + lane];
    o /= sum;
    const float gate = bf2f(gt[row * DM + hq * 64 + lane]);
    cc[row * DM + hq * 64 + lane] = f2bf(o * gate);
    {
        float tk[32], tv[32];
#pragma unroll
        for (int i = 0; i < 32; ++i) {
            const int ww = (hq & 3) + 4 * i;
            tk[i] = ck[(size_t)(ww + 1 < 128 ? ww + 1 : 127) * 256 + lane]; tv[i] = cv[(size_t)(ww + 1 < 128 ? ww + 1 : 127) * 256 + lane];
        }
#pragma unroll
        for (int i = 0; i < 32; ++i) {
            const int ww = (hq & 3) + 4 * i;
            if (ww < 127) { nk[(size_t)ww * 256 + lane] = tk[i]; nv[(size_t)ww * 256 + lane] = tv[i]; }
        }
    }
    __builtin_amdgcn_wave_barrier();
}

__device__ __forceinline__ float mix_val(const bf16_t* rw, const float* sshift, const float* mu, int r, int c) {
    const float cur = bf2f(rw[(size_t)r * SHD + c]);
    float prev;
    if (r >= TP) prev = sshift[(size_t)(r - TP) * SHD + c];
    else if ((r & 4095) == 0) prev = 0.f;
    else prev = bf2f(rw[(size_t)(r - 1) * SHD + c]);
    return cur + (prev - cur) * mu[c];
}

__device__ __forceinline__ float4 mix4(const bf16_t* rw, const float* sshift, int r, int c, float4 mu4) {
    const uint2 cu = *(const uint2*)(rw + (size_t)r * SHD + c);
    const float4 cur = make_float4(bflo(cu.x), bfhi(cu.x), bflo(cu.y), bfhi(cu.y));
    float4 prev = make_float4(0.f, 0.f, 0.f, 0.f);
    if (r >= TP) prev = *(const float4*)(sshift + (size_t)(r - TP) * SHD + c);
    else if ((r & 4095) != 0) { const uint2 pu = *(const uint2*)(rw + (size_t)(r - 1) * SHD + c); prev = make_float4(bflo(pu.x), bfhi(pu.x), bflo(pu.y), bfhi(pu.y)); }
    return make_float4(cur.x + (prev.x - cur.x) * mu4.x, cur.y + (prev.y - cur.y) * mu4.y, cur.z + (prev.z - cur.z) * mu4.z, cur.w + (prev.w - cur.w) * mu4.w);
}
__device__ __forceinline__ float decay_of(float x) {
    const float z = -x;
    const float sp = fmaxf(z, 0.f) + __logf(1.f + __expf(-fabsf(z)));
    return __expf(-__expf(-sp - 0.5f));
}

__device__ void p3_twad_item(const Params& p, int l, int tile) {
    const int tid = opq_tid();
    const bf16_t* rw = (const bf16_t*)(p.ws + WS_RW);
    const float* sshift = p.state_shift + (size_t)l * NBS * SHD;
    const float* mu = p.mu_shift + l * SHD;
    bf16_t* TWAD = (bf16_t*)(p.ws + WS_TWAD);
    const int r0 = tile * 32;
    float mm[8];
#pragma unroll
    for (int i = 0; i < 8; ++i) { const int idx = tid + 512 * i, tt = idx >> 7, c2 = idx & 127; mm[i] = mix_val(rw, sshift, mu, r0 + tt, 3072 + c2); }
#pragma unroll
    for (int i = 0; i < 8; ++i) {
        const int idx = tid + 512 * i, tt = idx >> 7, c2 = idx & 127;
        float o = mm[i];
        if (c2 < 64) { const float e = __expf(2.f * mm[i]); o = 1.f - 2.f / (e + 1.f); }
        TWAD[(size_t)(r0 + tt) * 128 + c2] = f2bf(o);
    }
}

__device__ void p3_prep_tile(const Params& p, unsigned char* lds, int l, int tile) {
    const int tid = opq_tid(), wv = tid >> 6, lane = tid & 63, n = lane & 31, h = lane >> 5;
    bf16_t* TW = (bf16_t*)lds;
    bf16_t* AD = TW + 32 * 72;
    const bf16_t* rw = (const bf16_t*)(p.ws + WS_RW);
    const float* sshift = p.state_shift + (size_t)l * NBS * SHD;
    const float* mu = p.mu_shift + l * SHD;
    bf16_t* RSB = (bf16_t*)(p.ws + WS_RSB);
    bf16_t* VALL = (bf16_t*)(p.ws + WS_VALL);
    float* RSW = (float*)(p.ws + WS_RSW);
    float* coef = (float*)(p.ws + WS_COEF);
    const int r0 = tile * 32;
    {
        float mm[8];
#pragma unroll
        for (int i = 0; i < 8; ++i) { const int idx = tid + 512 * i, tt = idx >> 7, c2 = idx & 127; mm[i] = mix_val(rw, sshift, mu, r0 + tt, 3072 + c2); }
        __builtin_amdgcn_sched_barrier(0);
#pragma unroll
        for (int i = 0; i < 8; ++i) {
            const int idx = tid + 512 * i, tt = idx >> 7, c2 = idx & 127;
            if (c2 < 64) { const float e = __expf(2.f * mm[i]); TW[tt * 72 + c2] = f2bf(1.f - 2.f / (e + 1.f)); }
            else AD[tt * 72 + (c2 - 64)] = f2bf(mm[i]);
        }
    }
    __syncthreads();
    const int col0 = wv * 128 + 4 * n;
    f32x16 acc[4];
    {
        const float* wp = p.w_decay + (size_t)l * 64 * 1024 + col0;
#pragma unroll
        for (int nt = 0; nt < 4; ++nt)
#pragma unroll
            for (int i = 0; i < 16; ++i) acc[nt][i] = 0.f;
#pragma unroll
        for (int ks = 0; ks < 4; ++ks) {
            const bf16x8 a = *(const bf16x8*)(TW + n * 72 + 16 * ks + 8 * h);
            float4 w4[8];
#pragma unroll
            for (int e = 0; e < 8; ++e) w4[e] = *(const float4*)(wp + (size_t)(16 * ks + 8 * h + e) * 1024);
            bf16x8 b0, b1, b2, b3;
#pragma unroll
            for (int e = 0; e < 8; ++e) { b0[e] = (short)f2bf(w4[e].x); b1[e] = (short)f2bf(w4[e].y); b2[e] = (short)f2bf(w4[e].z); b3[e] = (short)f2bf(w4[e].w); }
            acc[0] = __builtin_amdgcn_mfma_f32_32x32x16_bf16(a, b0, acc[0], 0, 0, 0);
            acc[1] = __builtin_amdgcn_mfma_f32_32x32x16_bf16(a, b1, acc[1], 0, 0, 0);
            acc[2] = __builtin_amdgcn_mfma_f32_32x32x16_bf16(a, b2, acc[2], 0, 0, 0);
            acc[3] = __builtin_amdgcn_mfma_f32_32x32x16_bf16(a, b3, acc[3], 0, 0, 0);
        }
        const float4 w0c = *(const float4*)(p.w0 + l * 1024 + col0);
#pragma unroll
        for (int r = 0; r < 16; ++r) {
            const int row = r0 + 8 * (r >> 2) + 4 * h + (r & 3);
            *(float4*)(RSW + (size_t)(row - TP) * 1024 + col0) =
                make_float4(decay_of(w0c.x + acc[0][r]), decay_of(w0c.y + acc[1][r]), decay_of(w0c.z + acc[2][r]), decay_of(w0c.w + acc[3][r]));
        }
    }
    {
        const float* wp = p.w_iclr + (size_t)l * 64 * 1024 + col0;
#pragma unroll
        for (int nt = 0; nt < 4; ++nt)
#pragma unroll
            for (int i = 0; i < 16; ++i) acc[nt][i] = 0.f;
#pragma unroll
        for (int ks = 0; ks < 4; ++ks) {
            const bf16x8 a = *(const bf16x8*)(AD + n * 72 + 16 * ks + 8 * h);
            float4 w4[8];
#pragma unroll
            for (int e = 0; e < 8; ++e) w4[e] = *(const float4*)(wp + (size_t)(16 * ks + 8 * h + e) * 1024);
            bf16x8 b0, b1, b2, b3;
#pragma unroll
            for (int e = 0; e < 8; ++e) { b0[e] = (short)f2bf(w4[e].x); b1[e] = (short)f2bf(w4[e].y); b2[e] = (short)f2bf(w4[e].z); b3[e] = (short)f2bf(w4[e].w); }
            acc[0] = __builtin_amdgcn_mfma_f32_32x32x16_bf16(a, b0, acc[0], 0, 0, 0);
            acc[1] = __builtin_amdgcn_mfma_f32_32x32x16_bf16(a, b1, acc[1], 0, 0, 0);
            acc[2] = __builtin_amdgcn_mfma_f32_32x32x16_bf16(a, b2, acc[2], 0, 0, 0);
            acc[3] = __builtin_amdgcn_mfma_f32_32x32x16_bf16(a, b3, acc[3], 0, 0, 0);
        }
    }
    const float4 a0c = *(const float4*)(p.a0 + l * 1024 + col0), kkc = *(const float4*)(p.k_k + l * 1024 + col0), kac = *(const float4*)(p.k_a + l * 1024 + col0), rkc = *(const float4*)(p.r_k + l * 1024 + col0);
    const float4 mur = *(const float4*)(mu + col0), muk = *(const float4*)(mu + 1024 + col0), muv = *(const float4*)(mu + 2048 + col0);
    const int head = 2 * wv + (n >> 4);
#pragma unroll
    for (int g4 = 0; g4 < 4; ++g4) {
        float4 rr4[4], kr4[4], vr4[4];
#pragma unroll
        for (int q = 0; q < 4; ++q) {
            const int row = r0 + 8 * g4 + 4 * h + q;
            rr4[q] = mix4(rw, sshift, row, col0, mur); kr4[q] = mix4(rw, sshift, row, 1024 + col0, muk); vr4[q] = mix4(rw, sshift, row, 2048 + col0, muv);
        }
        __builtin_amdgcn_sched_barrier(0);
#pragma unroll
        for (int q = 0; q < 4; ++q) {
            const int r = 4 * g4 + q;
            const int row = r0 + 8 * g4 + 4 * h + q;
            const float4 rr = rr4[q], kr = kr4[q], vr = vr4[q];
            const float ax = 1.f / (1.f + __expf(-(a0c.x + acc[0][r]))), ay = 1.f / (1.f + __expf(-(a0c.y + acc[1][r])));
            const float az = 1.f / (1.f + __expf(-(a0c.z + acc[2][r]))), aw = 1.f / (1.f + __expf(-(a0c.w + acc[3][r])));
            const float k0 = kr.x * kkc.x, k1 = kr.y * kkc.y, k2 = kr.z * kkc.z, k3 = kr.w * kkc.w;
            const float ss = allreduce16(k0 * k0 + k1 * k1 + k2 * k2 + k3 * k3);
            const float inv = 1.f / fmaxf(sqrtf(ss), 1e-12f);
            const float4 kk = make_float4(k0 * inv, k1 * inv, k2 * inv, k3 * inv);
            const float4 ke = make_float4(kr.x * (1.f + (ax - 1.f) * kac.x), kr.y * (1.f + (ay - 1.f) * kac.y), kr.z * (1.f + (az - 1.f) * kac.z), kr.w * (1.f + (aw - 1.f) * kac.w));
            const float cf = allreduce16(rr.x * ke.x * rkc.x + rr.y * ke.y * rkc.y + rr.z * ke.z * rkc.z + rr.w * ke.w * rkc.w);
            if ((n & 15) == 0) coef[(size_t)row * 16 + head] = cf;
            const size_t o = (size_t)row * 1024 + col0;
            const size_t os = (size_t)(row - TP) * 1024 + col0;
            *(uint2*)(RSB + os) = make_uint2(pack2(rr.x, rr.y), pack2(rr.z, rr.w));
            *(uint2*)(RSB + SRI + os) = make_uint2(pack2(ke.x, ke.y), pack2(ke.z, ke.w));
            *(uint2*)(RSB + 2 * SRI + os) = make_uint2(pack2(kk.x, kk.y), pack2(kk.z, kk.w));
            *(uint2*)(RSB + 3 * SRI + os) = make_uint2(pack2(kk.x * ax, kk.y * ay), pack2(kk.z * az, kk.w * aw));
            *(uint2*)(VALL + o) = make_uint2(pack2(vr.x, vr.y), pack2(vr.z, vr.w));
        }
        __builtin_amdgcn_sched_barrier(0);
    }
    __syncthreads();
}

constexpr int REC_BYTES = 14592;
constexpr int PA_WLDS = 16384;
typedef float f32x4v __attribute__((ext_vector_type(4)));

__device__ void pa_chunk(const Params& p, unsigned char* wl, int l, int ct) {
    const int lane = opq_tid() & 63;
    const int hh = ct >> 8, c = ct & 255, b = hh >> 4, h = hh & 15;
    const size_t row0 = (size_t)b * SEQ + 16 * c;
    const int col = h * 64 + lane;
    bf16_t* VALL = (bf16_t*)(p.ws + WS_VALL);
    float vv[16];
    float gC;
    bf16_t* S_AB = (bf16_t*)wl; bf16_t* S_BB = S_AB + 16 * 72; bf16_t* S_KB = S_BB + 16 * 72; bf16_t* S_RT = S_KB + 16 * 72;
    {
        const bf16_t* rw = (const bf16_t*)(p.ws + WS_RW);
        const bf16_t* TWAD = (const bf16_t*)(p.ws + WS_TWAD);
        const uint4* WFd = (const uint4*)(p.ws + WS_WFRAG) + (size_t)((l * 2 + 0) * 16 + h) * 512 + lane;
        const uint4* WFi = (const uint4*)(p.ws + WS_WFRAG) + (size_t)((l * 2 + 1) * 16 + h) * 512 + lane;
        unsigned xr[17], xk[17], xv[17];
        const bool first = (row0 & 4095) == 0;
#pragma unroll
        for (int t = 0; t < 17; ++t) {
            const unsigned ro = (unsigned)(row0 + t - 1) * (unsigned)SHD + (unsigned)col;
            if (t == 0 && first) { xr[0] = 0u; xk[0] = 0u; xv[0] = 0u; }
            else { xr[t] = rw[ro]; xk[t] = rw[ro + 1024u]; xv[t] = rw[ro + 2048u]; }
        }
        const int rr = lane & 15, kg = lane >> 4;
        f32x4v Dd[4], Da[4];
#pragma unroll
        for (int ct = 0; ct < 4; ++ct) { Dd[ct] = (f32x4v){0.f, 0.f, 0.f, 0.f}; Da[ct] = Dd[ct]; }
#pragma unroll
        for (int ks = 0; ks < 2; ++ks) {
            const bf16x8 atw = *(const bf16x8*)(TWAD + (size_t)(row0 + rr) * 128 + 32 * ks + 8 * kg);
            const bf16x8 aad = *(const bf16x8*)(TWAD + (size_t)(row0 + rr) * 128 + 64 + 32 * ks + 8 * kg);
#pragma unroll
            for (int ct = 0; ct < 4; ++ct) {
                const bf16x8 bd = __builtin_bit_cast(bf16x8, WFd[(ct * 2 + ks) * 64]);
                const bf16x8 bi = __builtin_bit_cast(bf16x8, WFi[(ct * 2 + ks) * 64]);
                Dd[ct] = __builtin_amdgcn_mfma_f32_16x16x32_bf16(atw, bd, Dd[ct], 0, 0, 0);
                Da[ct] = __builtin_amdgcn_mfma_f32_16x16x32_bf16(aad, bi, Da[ct], 0, 0, 0);
            }
        }
        float* LD = (float*)wl; float* LA = LD + 1024;
#pragma unroll
        for (int ct = 0; ct < 4; ++ct)
#pragma unroll
            for (int rg = 0; rg < 4; ++rg) { LD[(4 * kg + rg) * 64 + 16 * ct + rr] = Dd[ct][rg]; LA[(4 * kg + rg) * 64 + 16 * ct + rr] = Da[ct][rg]; }
        __builtin_amdgcn_fence(__ATOMIC_RELEASE, "wavefront"); __builtin_amdgcn_wave_barrier(); __builtin_amdgcn_fence(__ATOMIC_ACQUIRE, "wavefront");
        float din[16], ain[16];
#pragma unroll
        for (int t = 0; t < 16; ++t) { din[t] = LD[t * 64 + lane]; ain[t] = LA[t * 64 + lane]; }
        __builtin_amdgcn_fence(__ATOMIC_RELEASE, "wavefront"); __builtin_amdgcn_wave_barrier(); __builtin_amdgcn_fence(__ATOMIC_ACQUIRE, "wavefront");
        const float mur = p.mu_shift[l * SHD + col], muk = p.mu_shift[l * SHD + 1024 + col], muv = p.mu_shift[l * SHD + 2048 + col];
        const float w0c = p.w0[l * 1024 + col], a0c = p.a0[l * 1024 + col], kkc = p.k_k[l * 1024 + col], kac = p.k_a[l * 1024 + col], rkc = p.r_k[l * 1024 + col];
        float* coef = (float*)(p.ws + WS_COEF);
        float g = 1.f;
#pragma unroll
        for (int t = 0; t < 16; ++t) {
            const float cr = bf2f((unsigned short)xr[t + 1]), pr = bf2f((unsigned short)xr[t]), ck = bf2f((unsigned short)xk[t + 1]), pk = bf2f((unsigned short)xk[t]);
            const float cv = bf2f((unsigned short)xv[t + 1]), pv = bf2f((unsigned short)xv[t]);
            const float r_ = cr + (pr - cr) * mur, kr = ck + (pk - ck) * muk, vr = cv + (pv - cv) * muv;
            const float a = 1.f / (1.f + __expf(-(a0c + ain[t])));
            const float dec = decay_of(w0c + din[t]);
            const float kkr = kr * kkc;
            float ss = allreduce16(kkr * kkr); ss += __shfl_xor(ss, 16); ss += __shfl_xor(ss, 32);
            const float kkv = kkr / fmaxf(sqrtf(ss), 1e-12f);
            const float ke = kr * (1.f + (a - 1.f) * kac);
            float cf = allreduce16(r_ * ke * rkc); cf += __shfl_xor(cf, 16); cf += __shfl_xor(cf, 32);
            if (lane == 0) coef[(size_t)(row0 + t) * 16 + h] = cf;
            VALL[(unsigned)(row0 + t) * 1024u + (unsigned)col] = f2bf(vr);
            vv[t] = vr;
            S_AB[t * 72 + lane] = f2bf(-g * kkv);
            g *= dec;
            const float ig = __builtin_amdgcn_rcpf(g);
            S_BB[t * 72 + lane] = f2bf(kkv * a * ig); S_KB[t * 72 + lane] = f2bf(ke * ig); S_RT[t * 72 + lane] = f2bf(g * r_);
        }
        gC = g;
    }
    __builtin_amdgcn_fence(__ATOMIC_RELEASE, "wavefront"); __builtin_amdgcn_wave_barrier(); __builtin_amdgcn_fence(__ATOMIC_ACQUIRE, "wavefront");
    f32x4v Gab = {0.f, 0.f, 0.f, 0.f}, Gak = Gab, Grb = Gab, Grk = Gab;
    {
        const int rr = lane & 15, kg = lane >> 4;
#pragma unroll
        for (int ks = 0; ks < 2; ++ks) {
            const int o = rr * 72 + 32 * ks + 8 * kg;
            const bf16x8 fA = *(const bf16x8*)(S_AB + o), fB = *(const bf16x8*)(S_BB + o), fK = *(const bf16x8*)(S_KB + o), fR = *(const bf16x8*)(S_RT + o);
            Gab = __builtin_amdgcn_mfma_f32_16x16x32_bf16(fB, fA, Gab, 0, 0, 0);
            Gak = __builtin_amdgcn_mfma_f32_16x16x32_bf16(fK, fA, Gak, 0, 0, 0);
            Grb = __builtin_amdgcn_mfma_f32_16x16x32_bf16(fB, fR, Grb, 0, 0, 0);
            Grk = __builtin_amdgcn_mfma_f32_16x16x32_bf16(fK, fR, Grk, 0, 0, 0);
        }
    }
    __builtin_amdgcn_fence(__ATOMIC_RELEASE, "wavefront"); __builtin_amdgcn_wave_barrier(); __builtin_amdgcn_fence(__ATOMIC_ACQUIRE, "wavefront");
    float* M_AB = (float*)(wl + 9216); float* M_AK = M_AB + 256; float* M_RB = M_AK + 256; float* M_RK = M_RB + 256; float* T_ = M_RK + 256; float* Q_ = T_ + 256; float* W2_ = Q_ + 256;
    {
        const int t = lane & 15, kg = lane >> 4;
#pragma unroll
        for (int rg = 0; rg < 4; ++rg) {
            const int s = 4 * kg + rg;
            M_AB[s * 16 + t] = s < t ? Gab[rg] : 0.f; M_AK[s * 16 + t] = s < t ? Gak[rg] : 0.f;
            M_RB[s * 16 + t] = s <= t ? Grb[rg] : 0.f; M_RK[s * 16 + t] = s <= t ? Grk[rg] : 0.f;
        }
    }
    __builtin_amdgcn_fence(__ATOMIC_RELEASE, "wavefront"); __builtin_amdgcn_wave_barrier(); __builtin_amdgcn_fence(__ATOMIC_ACQUIRE, "wavefront");
    {
        const int rr = lane & 15;
        float Tr[16];
#pragma unroll
        for (int t = 0; t < 16; ++t) {
            float acc = (rr == t) ? 1.f : 0.f;
#pragma unroll
            for (int s = 0; s < t; ++s) acc += Tr[s] * M_AB[s * 16 + t];
            Tr[t] = acc;
        }
#pragma unroll
        for (int t = 0; t < 16; ++t) T_[rr * 16 + t] = Tr[t];
    }
    __builtin_amdgcn_fence(__ATOMIC_RELEASE, "wavefront"); __builtin_amdgcn_wave_barrier(); __builtin_amdgcn_fence(__ATOMIC_ACQUIRE, "wavefront");
    {
        const int s = lane & 15, tq = lane >> 4;
        float4 q = make_float4(0.f, 0.f, 0.f, 0.f);
#pragma unroll
        for (int u = 0; u < 16; ++u) { const float a = M_AK[s * 16 + u]; const float4 t4 = *(const float4*)(T_ + u * 16 + 4 * tq); q.x += a * t4.x; q.y += a * t4.y; q.z += a * t4.z; q.w += a * t4.w; }
        *(float4*)(Q_ + s * 16 + 4 * tq) = q;
        __builtin_amdgcn_fence(__ATOMIC_RELEASE, "wavefront"); __builtin_amdgcn_wave_barrier(); __builtin_amdgcn_fence(__ATOMIC_ACQUIRE, "wavefront");
        float4 w2 = *(const float4*)(M_RK + s * 16 + 4 * tq);
#pragma unroll
        for (int u = 0; u < 16; ++u) { const float a = Q_[s * 16 + u]; const float4 m4 = *(const float4*)(M_RB + u * 16 + 4 * tq); w2.x += a * m4.x; w2.y += a * m4.y; w2.z += a * m4.z; w2.w += a * m4.w; }
        *(float4*)(W2_ + s * 16 + 4 * tq) = w2;
    }
    __builtin_amdgcn_fence(__ATOMIC_RELEASE, "wavefront"); __builtin_amdgcn_wave_barrier(); __builtin_amdgcn_fence(__ATOMIC_ACQUIRE, "wavefront");
    cvt_f32x2 pt2[8], r22[8], ul2[8], yl2[8];
#pragma unroll
    for (int t = 0; t < 8; ++t) { pt2[t] = (cvt_f32x2){0.f, 0.f}; r22[t] = (cvt_f32x2){bf2f(S_RT[(2 * t) * 72 + lane]), bf2f(S_RT[(2 * t + 1) * 72 + lane])}; ul2[t] = pt2[t]; yl2[t] = pt2[t]; }
#pragma unroll
    for (int s = 0; s < 16; ++s) {
        const float as_ = bf2f(S_AB[s * 72 + lane]), vs_ = vv[s];
        const cvt_f32x2 as2 = {as_, as_}, vs2 = {vs_, vs_};
#pragma unroll
        for (int tq = 0; tq < 4; ++tq) {
            const float4 t4 = *(const float4*)(T_ + s * 16 + 4 * tq), q4 = *(const float4*)(Q_ + s * 16 + 4 * tq), w4 = *(const float4*)(W2_ + s * 16 + 4 * tq);
            pt2[2 * tq] += (cvt_f32x2){t4.x, t4.y} * as2; pt2[2 * tq + 1] += (cvt_f32x2){t4.z, t4.w} * as2;
            ul2[2 * tq] += (cvt_f32x2){q4.x, q4.y} * vs2; ul2[2 * tq + 1] += (cvt_f32x2){q4.z, q4.w} * vs2;
            yl2[2 * tq] += (cvt_f32x2){w4.x, w4.y} * vs2; yl2[2 * tq + 1] += (cvt_f32x2){w4.z, w4.w} * vs2;
        }
        __builtin_amdgcn_sched_barrier(0);
    }
    float pt[16], ul[16], yl[16];
#pragma unroll
    for (int t = 0; t < 8; ++t) { pt[2 * t] = pt2[t].x; pt[2 * t + 1] = pt2[t].y; ul[2 * t] = ul2[t].x; ul[2 * t + 1] = ul2[t].y; yl[2 * t] = yl2[t].x; yl[2 * t + 1] = yl2[t].y; }
#pragma unroll
    for (int s = 0; s < 16; ++s) {
        const cvt_f32x2 ps2 = {pt[s], pt[s]};
#pragma unroll
        for (int tq = 0; tq < 4; ++tq) {
            const float4 m4 = *(const float4*)(M_RB + s * 16 + 4 * tq);
            r22[2 * tq] += (cvt_f32x2){m4.x, m4.y} * ps2; r22[2 * tq + 1] += (cvt_f32x2){m4.z, m4.w} * ps2;
        }
        __builtin_amdgcn_sched_barrier(0);
    }
    float r2[16];
#pragma unroll
    for (int t = 0; t < 8; ++t) { r2[2 * t] = r22[t].x; r2[2 * t + 1] = r22[t].y; }
    unsigned char* rec = p.ws + WS_REC + (size_t)ct * REC_BYTES;
    float* ys = (float*)(p.ws + WS_YS);
    {
#pragma unroll
        for (int t = 0; t < 16; ++t) { S_AB[t * 72 + lane] = f2bf(pt[t]); S_RT[t * 72 + lane] = f2bf(r2[t]); }
        __builtin_amdgcn_fence(__ATOMIC_RELEASE, "wavefront"); __builtin_amdgcn_wave_barrier(); __builtin_amdgcn_fence(__ATOMIC_ACQUIRE, "wavefront");
#pragma unroll
        for (int i2 = 0; i2 < 2; ++i2) {
            const int q = lane + 64 * i2, f = q >> 5, hf = (q >> 4) & 1, t = q & 15;
            const uint2 a0 = *(const uint2*)(S_AB + t * 72 + 16 * f + 4 * hf), a1 = *(const uint2*)(S_AB + t * 72 + 16 * f + 8 + 4 * hf);
            const uint2 c0 = *(const uint2*)(S_RT + t * 72 + 16 * f + 4 * hf), c1 = *(const uint2*)(S_RT + t * 72 + 16 * f + 8 + 4 * hf);
            st_sc1_b128(rec + q * 16, a0.x, a0.y, a1.x, a1.y);
            st_sc1_b128(rec + 2048 + q * 16, c0.x, c0.y, c1.x, c1.y);
        }
        {
            float* YT = (float*)(wl + 9216);
#pragma unroll
            for (int t = 0; t < 16; ++t) YT[t * 64 + lane] = yl[t];
            __builtin_amdgcn_fence(__ATOMIC_RELEASE, "wavefront"); __builtin_amdgcn_wave_barrier(); __builtin_amdgcn_fence(__ATOMIC_ACQUIRE, "wavefront");
#pragma unroll
            for (int i4 = 0; i4 < 4; ++i4) {
                const int idx = lane + 64 * i4, t = idx >> 4, q4 = idx & 15;
                const float4 y4 = *(const float4*)(YT + t * 64 + 4 * q4);
                st_sc1_b128(ys + (unsigned)(row0 + t) * 1024u + (unsigned)(h * 64 + 4 * q4), __float_as_uint(y4.x), __float_as_uint(y4.y), __float_as_uint(y4.z), __float_as_uint(y4.w));
            }
        }
    }
    {
        float gb[16], gk[16];
#pragma unroll
        for (int t = 0; t < 16; ++t) { gb[t] = gC * bf2f(S_BB[t * 72 + lane]); gk[t] = gC * bf2f(S_KB[t * 72 + lane]); }
        st_sc1_b128(rec + 4096 + lane * 16, pack2(gb[0], gb[1]), pack2(gb[2], gb[3]), pack2(gb[8], gb[9]), pack2(gb[10], gb[11]));
        st_sc1_b128(rec + 4096 + (64 + lane) * 16, pack2(gb[4], gb[5]), pack2(gb[6], gb[7]), pack2(gb[12], gb[13]), pack2(gb[14], gb[15]));
        st_sc1_b128(rec + 6144 + lane * 16, pack2(gk[0], gk[1]), pack2(gk[2], gk[3]), pack2(gk[4], gk[5]), pack2(gk[6], gk[7]));
        st_sc1_b128(rec + 6144 + (64 + lane) * 16, pack2(gk[8], gk[9]), pack2(gk[10], gk[11]), pack2(gk[12], gk[13]), pack2(gk[14], gk[15]));
        st_sc1_b32(rec + 8192 + lane * 4, gC);
        unsigned char* ip = rec + 8448 + (lane >> 5) * 3072;
        const int il = lane & 31;
        st_sc1_b128(ip + il * 16, pack2(vv[0], vv[1]), pack2(vv[2], vv[3]), pack2(vv[4], vv[5]), pack2(vv[6], vv[7]));
        st_sc1_b128(ip + (32 + il) * 16, pack2(vv[8], vv[9]), pack2(vv[10], vv[11]), pack2(vv[12], vv[13]), pack2(vv[14], vv[15]));
#pragma unroll
        for (int tq = 0; tq < 4; ++tq) st_sc1_b128(ip + 1024 + (((tq >> 1) * 2 + (tq & 1)) * 32 + il) * 16, __float_as_uint(ul[4 * tq]), __float_as_uint(ul[4 * tq + 1]), __float_as_uint(ul[4 * tq + 2]), __float_as_uint(ul[4 * tq + 3]));
    }
    asm volatile("s_waitcnt vmcnt(0)" ::: "memory");
    if (lane == 0) __hip_atomic_store((unsigned*)(p.ws + WS_RFLAG + (size_t)ct * 64), (unsigned)(l + 1), __ATOMIC_RELAXED, __HIP_MEMORY_SCOPE_AGENT);
    __builtin_amdgcn_fence(__ATOMIC_RELEASE, "wavefront"); __builtin_amdgcn_wave_barrier();
}

__device__ void pa_sample_task(const Params& p, int l, int task) {
    const int lane = opq_tid() & 63;
    const int bd = task >> 8, h = (task >> 4) & 15, wq = task & 15;
    const int irow = 4 * wq + (lane >> 4), jq = lane & 15;
    const size_t row = (size_t)TP + bd;
    const bf16_t* RSB = (const bf16_t*)(p.ws + WS_RSB);
    const float* RSW = (const float*)(p.ws + WS_RSW);
    const bf16_t* VALL = (const bf16_t*)(p.ws + WS_VALL);
    float* ys = (float*)(p.ws + WS_YS);
    const size_t so = (((size_t)(l * NBS + bd) * 16 + h) * 64 + irow) * 64 + 4 * jq;
    float4 s = *(const float4*)(p.state_wkv + so);
    const size_t o = row * 1024 + h * 64 + 4 * jq;
    const size_t os = (size_t)bd * 1024 + h * 64 + 4 * jq;
    const uint2 ur = *(const uint2*)(RSB + os), uk = *(const uint2*)(RSB + SRI + os), ukk = *(const uint2*)(RSB + 2 * SRI + os), ub = *(const uint2*)(RSB + 3 * SRI + os);
    const float4 w4 = *(const float4*)(RSW + os);
    const float v = bf2f(VALL[row * 1024 + h * 64 + irow]);
    float pa = s.x * bflo(ukk.x) + s.y * bfhi(ukk.x) + s.z * bflo(ukk.y) + s.w * bfhi(ukk.y);
    pa = allreduce16(pa);
    const float sa = -pa;
    s.x = fmaf(sa, bflo(ub.x), fmaf(s.x, w4.x, v * bflo(uk.x)));
    s.y = fmaf(sa, bfhi(ub.x), fmaf(s.y, w4.y, v * bfhi(uk.x)));
    s.z = fmaf(sa, bflo(ub.y), fmaf(s.z, w4.z, v * bflo(uk.y)));
    s.w = fmaf(sa, bfhi(ub.y), fmaf(s.w, w4.w, v * bfhi(uk.y)));
    float py = s.x * bflo(ur.x) + s.y * bfhi(ur.x) + s.z * bflo(ur.y) + s.w * bfhi(ur.y);
    py = allreduce16(py);
    *(float4*)(p.out + O_WKVS + so) = s;
    if (jq == 0) ys[row * 1024 + h * 64 + irow] = py;
}

__device__ __forceinline__ uint4 ld_sc1_b128(const unsigned char* p) {
    const unsigned long long a = __hip_atomic_load((const unsigned long long*)p, __ATOMIC_RELAXED, __HIP_MEMORY_SCOPE_AGENT), c = __hip_atomic_load((const unsigned long long*)(p + 8), __ATOMIC_RELAXED, __HIP_MEMORY_SCOPE_AGENT);
    return make_uint4((unsigned)a, (unsigned)(a >> 32), (unsigned)c, (unsigned)(c >> 32));
}
constexpr int PB_NB = 8, PB_SLOT = 13568, PB_NCH = SEQ / 16, PB_NX = 4, PB_XOFF = PB_NB * PB_SLOT  , PB_FOFF = PB_XOFF + PB_NX * 4096;
__device__ void pb_head(const Params& p, unsigned char* lds, int l, int blk, bool dry) {
    const int tid = opq_tid(), wv = tid >> 6, lane = tid & 63;
    const int hh = blk >> 1, it = blk & 1, b = hh >> 4, h = hh & 15;
    volatile LAS unsigned* flags = (volatile LAS unsigned*)((LAS unsigned char*)lds + PB_FOFF);
    if (tid < 16) flags[tid] = 0u;
    __syncthreads();
    const unsigned char* rec0 = p.ws + WS_REC + (size_t)(hh * 256) * REC_BYTES;
    float* ys = (float*)(p.ws + WS_YS) + ((size_t)b * SEQ) * 1024 + h * 64 + 32 * it;
    const int q32 = lane & 31, hf = lane >> 5;
    if (wv >= 2) {
        unsigned nf = __hip_atomic_load((const unsigned*)(p.ws + WS_RFLAG + (size_t)(hh * 256 + (wv - 2)) * 64), __ATOMIC_RELAXED, __HIP_MEMORY_SCOPE_AGENT);
#pragma unroll 1
        for (int c = wv - 2; c < PB_NCH; c += 6) {
            while (c - (int)flags[8] >= PB_NB || c - (int)flags[9] >= PB_NB) __builtin_amdgcn_s_sleep(1);
            asm volatile("" ::: "memory");
            {
                const unsigned* rf = (const unsigned*)(p.ws + WS_RFLAG + (size_t)(hh * 256 + c) * 64);
                while (nf != (unsigned)(l + 1)) { __builtin_amdgcn_s_sleep(2); nf = __hip_atomic_load(rf, __ATOMIC_RELAXED, __HIP_MEMORY_SCOPE_AGENT); }
                asm volatile("" ::: "memory");
            }
            const unsigned char* rec = rec0 + (size_t)c * REC_BYTES;
            unsigned char* sl = lds + (c % PB_NB) * PB_SLOT;
            const unsigned char* rc = rec + lane * 16;
            const unsigned char* ri = rec + 8448 + it * 3072 + lane * 16;
#define LD_SC1(p_) ld_sc1_b128((const unsigned char*)(p_))
            const uint4 d0 = LD_SC1(rc), d1 = LD_SC1(rc + 1024), d2 = LD_SC1(rc + 2048), d3 = LD_SC1(rc + 3072);
            const uint4 d4 = LD_SC1(rc + 4096), d5 = LD_SC1(rc + 5120), d6 = LD_SC1(rc + 6144), d7 = LD_SC1(rc + 7168);
            const uint4 d8 = LD_SC1(rec + 8192 + (lane & 15) * 16);
            const uint4 d9 = LD_SC1(ri), d10 = LD_SC1(ri + 1024), d11 = LD_SC1(ri + 2048);
            const int t0 = lane >> 3, cc = lane & 7;
            const uint4 d12 = LD_SC1(ys + (size_t)(16 * c + t0) * 1024 + cc * 4), d13 = LD_SC1(ys + (size_t)(16 * c + 8 + t0) * 1024 + cc * 4);
#undef LD_SC1
            nf = (c + 6 < PB_NCH) ? __hip_atomic_load((const unsigned*)(p.ws + WS_RFLAG + (size_t)(hh * 256 + c + 6) * 64), __ATOMIC_RELAXED, __HIP_MEMORY_SCOPE_AGENT) : 0u;
            __builtin_amdgcn_sched_barrier(0);
            unsigned char* sd = sl + lane * 16;
            *(uint4*)(sd) = d0; *(uint4*)(sd + 1024) = d1; *(uint4*)(sd + 2048) = d2; *(uint4*)(sd + 3072) = d3;
            *(uint4*)(sd + 4096) = d4; *(uint4*)(sd + 5120) = d5; *(uint4*)(sd + 6144) = d6; *(uint4*)(sd + 7168) = d7;
            if (lane < 16) *(uint4*)(sl + 8192 + lane * 16) = d8;
            *(uint4*)(sd + 8448) = d9; *(uint4*)(sd + 9472) = d10; *(uint4*)(sd + 10496) = d11;
            {
                float* yd = (float*)(sl + 11520) + ((((t0 >> 2) & 1) * 32 + 4 * cc) * 4 + (t0 & 3));
                yd[0] = __uint_as_float(d12.x); yd[4] = __uint_as_float(d12.y); yd[8] = __uint_as_float(d12.z); yd[12] = __uint_as_float(d12.w);
                yd[256] = __uint_as_float(d13.x); yd[260] = __uint_as_float(d13.y); yd[264] = __uint_as_float(d13.z); yd[268] = __uint_as_float(d13.w);
            }
            asm volatile("" ::: "memory");
            if (lane == 0) flags[c % PB_NB] = (unsigned)(c + 1);
        }
    } else if (wv == 1) {
        bf16x8 ra0, ra1, ra2, ra3; float4 y0, y1;
#define PB_FETCHY(c_) do { const unsigned char* sl_ = lds + ((c_) % PB_NB) * PB_SLOT; \
            while (flags[(c_) % PB_NB] != (unsigned)((c_) + 1)) __builtin_amdgcn_s_sleep(0); \
            asm volatile("" ::: "memory"); \
            const unsigned char* pr_ = sl_ + 2048 + (hf * 16 + (q32 & 15)) * 16; \
            ra0 = *(const bf16x8*)(pr_); ra1 = *(const bf16x8*)(pr_ + 512); ra2 = *(const bf16x8*)(pr_ + 1024); ra3 = *(const bf16x8*)(pr_ + 1536); \
            y0 = *(const float4*)(sl_ + 11520 + (hf * 32 + q32) * 16); y1 = *(const float4*)(sl_ + 11520 + ((2 + hf) * 32 + q32) * 16); \
            asm volatile("" ::: "memory"); \
            if (lane == 0) flags[9] = (unsigned)((c_) + 1); } while (0)
        PB_FETCHY(0);
#pragma unroll 1
        for (int c = 0; c < PB_NCH; ++c) {
            const unsigned char* xr = lds + PB_XOFF + (c % PB_NX) * 4096 + lane * 16;
            f32x16 Ya, Yb;
            Ya[0] = y0.x; Ya[1] = y0.y; Ya[2] = y0.z; Ya[3] = y0.w; Ya[4] = y1.x; Ya[5] = y1.y; Ya[6] = y1.z; Ya[7] = y1.w;
#pragma unroll
            for (int r = 8; r < 16; ++r) Ya[r] = 0.f;
#pragma unroll
            for (int r = 0; r < 16; ++r) Yb[r] = 0.f;
            const bf16x8 rc0 = ra0, rc1 = ra1, rc2 = ra2, rc3 = ra3;
            while (flags[10 + (c % PB_NX)] != (unsigned)(c + 1)) __builtin_amdgcn_s_sleep(0);
            asm volatile("" ::: "memory");
            const bf16x8 xf0 = *(const bf16x8*)(xr), xf1 = *(const bf16x8*)(xr + 1024), xf2 = *(const bf16x8*)(xr + 2048), xf3 = *(const bf16x8*)(xr + 3072);
            asm volatile("" ::: "memory");
            if (lane == 0) flags[14] = (unsigned)(c + 1);
            Ya = __builtin_amdgcn_mfma_f32_32x32x16_bf16(rc0, xf0, Ya, 0, 0, 0);
            Yb = __builtin_amdgcn_mfma_f32_32x32x16_bf16(rc1, xf1, Yb, 0, 0, 0);
            Ya = __builtin_amdgcn_mfma_f32_32x32x16_bf16(rc2, xf2, Ya, 0, 0, 0);
            Yb = __builtin_amdgcn_mfma_f32_32x32x16_bf16(rc3, xf3, Yb, 0, 0, 0);
            if (c + 1 < PB_NCH) PB_FETCHY(c + 1);
            float* yc = ys + (size_t)c * (16 * 1024);
            if (!dry) {
#pragma unroll
                for (int r = 0; r < 8; ++r) yc[(8 * (r >> 2) + 4 * hf + (r & 3)) * 1024 + q32] = Ya[r] + Yb[r];
            }
        }
#undef PB_FETCHY
    } else {
        f32x16 X0, X1;
#pragma unroll
        for (int i = 0; i < 16; ++i) { X0[i] = 0.f; X1[i] = 0.f; }
        bf16x8 pa0, pa1, pa2, pa3, gb0, gb1, gk0, gk1, vf;
        float4 gm0, gm1, gm2, gm3, gm4, gm5, gm6, gm7, u0, u1;
#define PB_FETCH(c_) do { const unsigned char* sl_ = lds + ((c_) % PB_NB) * PB_SLOT; \
            { unsigned rv_ = rdy; while (rv_ != (unsigned)((c_) + 1)) { __builtin_amdgcn_s_sleep(0); rv_ = flags[(c_) % PB_NB]; } } \
            asm volatile("" ::: "memory"); \
            const unsigned char* pr_ = sl_ + (hf * 16 + (q32 & 15)) * 16; \
            pa0 = *(const bf16x8*)(pr_); pa1 = *(const bf16x8*)(pr_ + 512); pa2 = *(const bf16x8*)(pr_ + 1024); pa3 = *(const bf16x8*)(pr_ + 1536); \
            gb0 = *(const bf16x8*)(sl_ + 4096 + (hf * 64 + q32) * 16); gb1 = *(const bf16x8*)(sl_ + 4096 + (hf * 64 + 32 + q32) * 16); \
            gk0 = *(const bf16x8*)(sl_ + 6144 + (hf * 64 + q32) * 16); gk1 = *(const bf16x8*)(sl_ + 6144 + (hf * 64 + 32 + q32) * 16); \
            vf = *(const bf16x8*)(sl_ + 8448 + (hf * 32 + q32) * 16); \
            const unsigned char* gp_ = sl_ + 8192 + 16 * hf; \
            gm0 = *(const float4*)(gp_); gm1 = *(const float4*)(gp_ + 32); gm2 = *(const float4*)(gp_ + 64); gm3 = *(const float4*)(gp_ + 96); \
            gm4 = *(const float4*)(gp_ + 128); gm5 = *(const float4*)(gp_ + 160); gm6 = *(const float4*)(gp_ + 192); gm7 = *(const float4*)(gp_ + 224); \
            u0 = *(const float4*)(sl_ + 9472 + (hf * 32 + q32) * 16); u1 = *(const float4*)(sl_ + 9472 + ((2 + hf) * 32 + q32) * 16); \
            asm volatile("" ::: "memory"); \
            if (lane == 0) flags[8] = (unsigned)((c_) + 1); } while (0)
        unsigned rdy = flags[0];
        PB_FETCH(0);
        int xfree = 0;
#pragma unroll 1
        for (int c = 0; c < PB_NCH; ++c) {
            unsigned char* xw = lds + PB_XOFF + (c % PB_NX) * 4096 + lane * 16;
            rdy = flags[(c + 1) % PB_NB];
            const bf16x8 xb0 = __builtin_bit_cast(bf16x8, make_uint4(pack2(X0[0], X0[1]), pack2(X0[2], X0[3]), pack2(X0[4], X0[5]), pack2(X0[6], X0[7])));
            const bf16x8 xb1 = __builtin_bit_cast(bf16x8, make_uint4(pack2(X0[8], X0[9]), pack2(X0[10], X0[11]), pack2(X0[12], X0[13]), pack2(X0[14], X0[15])));
            const bf16x8 xb2 = __builtin_bit_cast(bf16x8, make_uint4(pack2(X1[0], X1[1]), pack2(X1[2], X1[3]), pack2(X1[4], X1[5]), pack2(X1[6], X1[7])));
            const bf16x8 xb3 = __builtin_bit_cast(bf16x8, make_uint4(pack2(X1[8], X1[9]), pack2(X1[10], X1[11]), pack2(X1[12], X1[13]), pack2(X1[14], X1[15])));
            f32x16 Ua, Ub;
            Ua[0] = u0.x; Ua[1] = u0.y; Ua[2] = u0.z; Ua[3] = u0.w; Ua[4] = u1.x; Ua[5] = u1.y; Ua[6] = u1.z; Ua[7] = u1.w;
#pragma unroll
            for (int r = 8; r < 16; ++r) Ua[r] = 0.f;
#pragma unroll
            for (int r = 0; r < 16; ++r) Ub[r] = 0.f;
            Ua = __builtin_amdgcn_mfma_f32_32x32x16_bf16(pa0, xb0, Ua, 0, 0, 0);
            Ub = __builtin_amdgcn_mfma_f32_32x32x16_bf16(pa1, xb1, Ub, 0, 0, 0);
            Ua = __builtin_amdgcn_mfma_f32_32x32x16_bf16(pa2, xb2, Ua, 0, 0, 0);
            Ub = __builtin_amdgcn_mfma_f32_32x32x16_bf16(pa3, xb3, Ub, 0, 0, 0);
            f32x16 Xn0, Xn1;
            Xn0[0] = X0[0] * gm0.x; Xn0[1] = X0[1] * gm0.y; Xn0[2] = X0[2] * gm0.z; Xn0[3] = X0[3] * gm0.w; Xn0[4] = X0[4] * gm1.x; Xn0[5] = X0[5] * gm1.y; Xn0[6] = X0[6] * gm1.z; Xn0[7] = X0[7] * gm1.w;
            Xn0[8] = X0[8] * gm2.x; Xn0[9] = X0[9] * gm2.y; Xn0[10] = X0[10] * gm2.z; Xn0[11] = X0[11] * gm2.w; Xn0[12] = X0[12] * gm3.x; Xn0[13] = X0[13] * gm3.y; Xn0[14] = X0[14] * gm3.z; Xn0[15] = X0[15] * gm3.w;
            Xn1[0] = X1[0] * gm4.x; Xn1[1] = X1[1] * gm4.y; Xn1[2] = X1[2] * gm4.z; Xn1[3] = X1[3] * gm4.w; Xn1[4] = X1[4] * gm5.x; Xn1[5] = X1[5] * gm5.y; Xn1[6] = X1[6] * gm5.z; Xn1[7] = X1[7] * gm5.w;
            Xn1[8] = X1[8] * gm6.x; Xn1[9] = X1[9] * gm6.y; Xn1[10] = X1[10] * gm6.z; Xn1[11] = X1[11] * gm6.w; Xn1[12] = X1[12] * gm7.x; Xn1[13] = X1[13] * gm7.y; Xn1[14] = X1[14] * gm7.z; Xn1[15] = X1[15] * gm7.w;
            Xn0 = __builtin_amdgcn_mfma_f32_32x32x16_bf16(gk0, vf, Xn0, 0, 0, 0);
            Xn1 = __builtin_amdgcn_mfma_f32_32x32x16_bf16(gk1, vf, Xn1, 0, 0, 0);
            const bf16x8 gbc0 = gb0, gbc1 = gb1;
            while (c - xfree >= PB_NX) { xfree = (int)flags[14]; }
            asm volatile("" ::: "memory");
            *(bf16x8*)(xw) = xb0; *(bf16x8*)(xw + 1024) = xb1; *(bf16x8*)(xw + 2048) = xb2; *(bf16x8*)(xw + 3072) = xb3;
            asm volatile("" ::: "memory");
            if (lane == 0) flags[10 + (c % PB_NX)] = (unsigned)(c + 1);
            if (c + 1 < PB_NCH) PB_FETCH(c + 1);
            const bf16x8 ub = __builtin_bit_cast(bf16x8, make_uint4(pack2(Ua[0] + Ub[0], Ua[1] + Ub[1]), pack2(Ua[2] + Ub[2], Ua[3] + Ub[3]), pack2(Ua[4] + Ub[4], Ua[5] + Ub[5]), pack2(Ua[6] + Ub[6], Ua[7] + Ub[7])));
            X0 = __builtin_amdgcn_mfma_f32_32x32x16_bf16(gbc0, ub, Xn0, 0, 0, 0);
            X1 = __builtin_amdgcn_mfma_f32_32x32x16_bf16(gbc1, ub, Xn1, 0, 0, 0);
        }
#undef PB_FETCH
        float* so = p.out + O_WKVP + ((size_t)(l * NBP + b) * 16 + h) * 4096 + (size_t)(32 * it + q32) * 64;
#pragma unroll
        for (int g = 0; g < 4; ++g) {
            *(float4*)(so + 8 * g + 4 * hf) = make_float4(X0[4 * g], X0[4 * g + 1], X0[4 * g + 2], X0[4 * g + 3]);
            *(float4*)(so + 32 + 8 * g + 4 * hf) = make_float4(X1[4 * g], X1[4 * g + 1], X1[4 * g + 2], X1[4 * g + 3]);
        }
    }
    __syncthreads();
}

__device__ void p3_post(const Params& p, int l, int bid, int G) {
    const int tid = opq_tid(), wv = tid >> 6, lane = tid & 63;
    const float* ys = (const float*)(p.ws + WS_YS);
    const bf16_t* V = (const bf16_t*)(p.ws + WS_VALL);
    const float* coef = (const float*)(p.ws + WS_COEF);
    const bf16_t* gt = (const bf16_t*)(p.ws + WS_GT);
    bf16_t* cc = (bf16_t*)(p.ws + WS_HB);
    for (int r = bid * 8 + wv; r < MT; r += G * 8) {
        float4 y4[4]; uint2 vu4[4], gg4[4]; float cf4[4];
#pragma unroll
        for (int hg = 0; hg < 4; ++hg) {
            const int head = 4 * hg + (lane >> 4), c = head * 64 + 4 * (lane & 15);
            y4[hg] = *(const float4*)(ys + (size_t)r * 1024 + c);
            vu4[hg] = *(const uint2*)(V + (size_t)r * 1024 + c);
            cf4[hg] = coef[(size_t)r * 16 + head];
            gg4[hg] = *(const uint2*)(gt + (size_t)r * DM + 1024 + c);
        }
        __builtin_amdgcn_sched_barrier(0);
#pragma unroll
        for (int hg = 0; hg < 4; ++hg) {
            const int head = 4 * hg + (lane >> 4), c = head * 64 + 4 * (lane & 15);
            const float4 y = y4[hg];
            const float mu = allreduce16(y.x + y.y + y.z + y.w) * (1.f / 64.f);
            const float d0 = y.x - mu, d1 = y.y - mu, d2 = y.z - mu, d3 = y.w - mu;
            const float var = allreduce16(d0 * d0 + d1 * d1 + d2 * d2 + d3 * d3) * (1.f / 64.f);
            const float rs = rsqrtf(var + 64e-5f);
            const float4 lw = *(const float4*)(p.ln_w + l * 1024 + c), lb = *(const float4*)(p.ln_b + l * 1024 + c);
            const uint2 vu = vu4[hg];
            const float4 v4 = make_float4(bflo(vu.x), bfhi(vu.x), bflo(vu.y), bfhi(vu.y));
            const float cf = cf4[hg];
            const uint2 gg = gg4[hg];
            const float o0 = (d0 * rs * lw.x + lb.x + cf * v4.x) * bflo(gg.x), o1 = (d1 * rs * lw.y + lb.y + cf * v4.y) * bfhi(gg.x);
            const float o2 = (d2 * rs * lw.z + lb.z + cf * v4.z) * bflo(gg.y), o3 = (d3 * rs * lw.w + lb.w + cf * v4.w) * bfhi(gg.y);
            *(uint2*)(cc + (size_t)r * DM + 1024 + c) = make_uint2(pack2(o0, o1), pack2(o2, o3));
        }
    }
}

__device__ void p_final(const Params& p, int bid, int G) {
    const int tid = opq_tid(), wv = tid >> 6, lane = tid & 63;
    const float4* g4 = (const float4*)p.final_g;
    for (int r = bid * 8 + wv; r < MT; r += G * 8) {
        float4* xr = (float4*)(p.out + (size_t)r * DM);
        float4 v[8]; float ss = 0.f;
#pragma unroll
        for (int i = 0; i < 8; ++i) { v[i] = xr[lane + 64 * i]; ss += v[i].x * v[i].x + v[i].y * v[i].y + v[i].z * v[i].z + v[i].w * v[i].w; }
        ss = wave_sum(ss);
        const float rinv = rsqrtf(ss * (1.f / 2048.f) + 1e-5f);
#pragma unroll
        for (int i = 0; i < 8; ++i) { const float4 g = g4[lane + 64 * i]; xr[lane + 64 * i] = make_float4(v[i].x * rinv * g.x, v[i].y * rinv * g.y, v[i].z * rinv * g.z, v[i].w * rinv * g.w); }
    }
}

#ifndef REPL
#define REPL -1
#endif
#ifndef REPK
#define REPK -100
#endif
__global__ void __launch_bounds__(512, 2) fwd_kernel(Params p_unused) {
    extern __shared__ __attribute__((aligned(16))) unsigned char shm[];
    cg::grid_group grid = cg::this_grid();
    const int bid0 = blockIdx.x, G0 = gridDim.x;
    float* shf = (float*)shm;
    volatile LAS unsigned* xst = (volatile LAS unsigned*)((LAS unsigned char*)shm + 131072);
    if (threadIdx.x == 0) { xst[0] = 0u; xst[1] = 0u; }
    __syncthreads();
    const XcdBarrier xb = xcd_barrier_post((unsigned*)(kparams().ws + WS_BAR), xst);
    if (G0 == 0x7fffffff) grid.sync();

#pragma unroll 1
    for (int ph = 0; ph < 14; ++ph) {
        const int bid = opq_s(bid0), G = opq_s(G0);
        const int l = ph >= 7 ? 1 : 0, k = ph == 0 ? -1 : (ph == 13 ? 6 : (ph - 1) - 6 * l);
#pragma unroll 1
        for (int rep = 0; rep < ((k == kparams().repk && (kparams().repl < 0 || kparams().repl == l)) ? 2 : 1); ++rep) {
        if (k == -1) {
            for (int it = bid; it < 384; it += G) p0_mod_item(kparams(), shf, it / 192, it % 192);
            for (int it = bid; it < 17; it += G) p0_rope_item(kparams(), it);
            for (int it = bid; it < 64; it += G) p0_wfrag_item(kparams(), it);
            {
                if (bid < 128) p0_conv_all(kparams(), shf, bid, 128, 1024, 0);
                else p0_conv_all(kparams(), shf, 1024 + (bid - 128), G - 128, 2752, 0);
            }
        } else if (k == 0) {
            p1_norm(kparams(), l, bid, G);
        } else if (k == 1) {
            pg8::StaticOrder S; S.init(MP, INWP, G, bid);
            pg8::Gemm g{(const bf16_t*)(kparams().ws + WS_HB), (const bf16_t*)(kparams().ws + WS_WTIN), MP, INWP, DM};
            Epi1 E{l};
            pg8::gemm_phase<Epi1, pg8::StaticOrder, false>((PG8_LAS unsigned char*)shm, g, S, E, nullptr);
        } else if (k == 2) {
            for (int it = bid; it < 256 + 256 + 1 + 64; it += G) {
                if (it < 256) p3_attn_unit(kparams(), shm, l, it);
                else if (it < 512) p3_twad_item(kparams(), l, it - 256);
                else if (it == 512) p3_prep_tile(kparams(), shm, l, 256);
                else p3_sattn_item(kparams(), shf, l, it - 513);
            }
            __syncthreads();
            if (l == 0) p0_conv_all(kparams(), shf, bid, G, 1728, 1);
        } else if (k == 3) {
            {
                const int wvq = opq_tid() >> 6;
                int i2 = bid < 64 ? bid * 8 + wvq : 512 + (bid - 64) * 8 + wvq;
                const int step = bid < 64 ? (1 << 20) : (G - 64) * 8;
#pragma unroll 1
                for (; i2 < 32 * 256; i2 += step) pa_chunk(kparams(), shm + wvq * PA_WLDS, l, (i2 & 31) * 256 + (i2 >> 5));
                if (bid < 64) {
                    __syncthreads();
                    pb_head(kparams(), shm, l, bid, false);
                } else {
                    const int gw = (bid - 64) * 8 + wvq, nw = (G - 64) * 8;
                    for (int task = gw; task < NBS * 256; task += nw) pa_sample_task(kparams(), l, task);
                }
            }
        } else if (k == 4) {
            p3_post(kparams(), l, bid, G);
        } else if (k == 5) {
            pg8::StaticOrder S; S.init(TP, DM, G, bid);
            pg8::Gemm g{(const bf16_t*)(kparams().ws + WS_HB), (const bf16_t*)(kparams().ws + WS_WTOUT) + (size_t)l * DM * DM, TP, DM, DM};
            Epi2 E{l};
            pg8::gemm_phase<Epi2, pg8::StaticOrder, false>((PG8_LAS unsigned char*)shm, g, S, E, nullptr);
            for (int nb = bid; nb < 64; nb += G) g2_sample_item(kparams(), shf, l, nb);
        } else {
            p_final(kparams(), bid, G);
        }
        if (ph < 13) xcd_barrier(xb);
        }
    }
}

extern "C" void kernel_launch(void* const* d_in, const int* in_sizes, int n_in, void* d_out, int out_size, void* d_ws, size_t ws_size, hipStream_t stream) {
    static int grid_blocks = 0;
    if (grid_blocks == 0) {
        if (n_in != 25 || (size_t)out_size != O_END || ws_size < WS_END) {
            fprintf(stderr, "kernel_launch: unexpected shapes: n_in %d out_size %d ws_size %zu (need %zu)\n", n_in, out_size, ws_size, (size_t)WS_END);
            grid_blocks = -1; return;
        }
        if (hipFuncSetAttribute((const void*)fwd_kernel, hipFuncAttributeMaxDynamicSharedMemorySize, LDS_BYTES) != hipSuccess) { fprintf(stderr, "kernel_launch: hipFuncSetAttribute failed\n"); grid_blocks = -1; return; }
        int dev = 0, cus = 0, per_cu = 0;
        hipGetDevice(&dev);
        hipDeviceGetAttribute(&cus, hipDeviceAttributeMultiprocessorCount, dev);
        hipOccupancyMaxActiveBlocksPerMultiprocessor(&per_cu, (const void*)fwd_kernel, 512, LDS_BYTES);
        if (per_cu < 1) { fprintf(stderr, "kernel_launch: occupancy query gives %d blocks per CU\n", per_cu); per_cu = 1; }
        (void)hipGetLastError();
        grid_blocks = cus;
        if (grid_blocks < 192) { fprintf(stderr, "kernel_launch: only %d CUs\n", grid_blocks); grid_blocks = -1; return; }
    }
    if (grid_blocks < 0) return;
    if (hipMemsetAsync((unsigned char*)d_ws + WS_BAR, 0, 16384 + RFLAG_BYTES, stream) != hipSuccess) { fprintf(stderr, "kernel_launch: memset of the barrier words failed\n"); return; }
    Params p{};
    const float** pp = (const float**)&p;
    for (int i = 0; i < 25; ++i) pp[i] = (const float*)d_in[i];
    p.out = (float*)d_out; p.ws = (unsigned char*)d_ws; p.repk = REPK; p.repl = REPL;
    void* args[] = {&p};
    hipError_t e = hipLaunchCooperativeKernel((const void*)fwd_kernel, dim3(grid_blocks), dim3(512), args, LDS_BYTES, stream);
    if (e != hipSuccess) fprintf(stderr, "cooperative launch failed: %s (grid %d)\n", hipGetErrorString(e), grid_blocks);
}
```

```cpp
#include <hip/hip_runtime.h>
#include <hip/hip_cooperative_groups.h>
#include <cstdio>
namespace cg = cooperative_groups;
__device__ __forceinline__ int opq_tid() { int t = threadIdx.x; asm volatile("" : "+v"(t)); return t; }
__device__ __forceinline__ int opq_s(int x) { asm volatile("" : "+s"(x)); return x; }
typedef float cvt_f32x2 __attribute__((ext_vector_type(2)));
typedef __bf16 cvt_bf16x2 __attribute__((ext_vector_type(2)));
__device__ __forceinline__ unsigned hw_cvt_pk_bf16(float lo, float hi) { const cvt_f32x2 v = {lo, hi}; return __builtin_bit_cast(unsigned, __builtin_convertvector(v, cvt_bf16x2)); }
typedef unsigned sc1_v4u __attribute__((ext_vector_type(4)));
__device__ __forceinline__ void st_sc1_b128(void* p, unsigned a, unsigned b, unsigned c, unsigned d) { const sc1_v4u v = {a, b, c, d}; asm volatile("global_store_dwordx4 %0, %1, off sc0 sc1\n\ts_nop 2" :: "v"(p), "v"(v) : "memory"); }
__device__ __forceinline__ void st_sc1_b32(void* p, float v) { asm volatile("global_store_dword %0, %1, off sc0 sc1\n\ts_nop 2" :: "v"(p), "v"(v) : "memory"); }
namespace pg8 {
#define PG8_LAS __attribute__((address_space(3)))
typedef unsigned short bf16_t;
typedef short bf16x8 __attribute__((ext_vector_type(8)));
typedef float f32x4 __attribute__((ext_vector_type(4)));
typedef unsigned u32x4 __attribute__((ext_vector_type(4)));
constexpr int BM = 256, BK = 64, HALF = 128, HTB = HALF * BK * 2  , STAGE_BYTES = 8 * HTB, NXCD = 8, WGM = 4;

__host__ __device__ __forceinline__ int lds_byte(int r, int c) { const int st = (r >> 4) * 2 + (c >> 5), rr = r & 15, cc = c & 31, ob = rr * 64 + cc * 2; return st * 1024 + (ob ^ (((ob >> 9) & 1) << 5)); }
__host__ __device__ __forceinline__ void stage_rc(int b, int& R, int& C) { const int st = b / 1024, sb = b % 1024, swz = sb ^ (((sb >> 9) & 1) << 5); R = (st >> 1) * 16 + swz / 64; C = (st & 1) * 32 + (swz % 64) / 2; }
__host__ __device__ __forceinline__ int perm32(int rho) { const int n = rho >> 4, i = rho & 15; return 8 * (i >> 2) + 4 * n + (i & 3); }

struct Unit { int pm, pn; };
struct Gemm { const bf16_t* A; const bf16_t* Bt; int M, N, K; };

struct StaticOrder {
    int nM, nN, nwg, G, c;
    __host__ __device__ void init(int M, int N, int G_, int c_) { nM = M / BM; nN = N / BM; nwg = nM * nN; G = G_; c = c_; }
    __host__ __device__ bool next(int i, Unit& u) const {
        const long L = (long)i * G + c; if (L >= nwg) return false;
        int wgid = (int)L; { const int q = nwg / NXCD, r = nwg % NXCD, xcd = wgid % NXCD, off = wgid / NXCD; wgid = (xcd < r ? xcd * (q + 1) : r * (q + 1) + (xcd - r) * q) + off; }
        const int nig = WGM * nN, gid = wgid / nig, fm = gid * WGM, gsz = (nM - fm) < WGM ? (nM - fm) : WGM;
        u.pm = fm + ((wgid % nig) % gsz); u.pn = (wgid % nig) / gsz; return true;
    }
    __device__ __forceinline__ void a_ready(const Unit&) const {}
    __device__ __forceinline__ void done(const Unit&) const {}
};
template <class Epi, class Sched, bool STAMP = false>
__device__ __forceinline__ void gemm_phase(PG8_LAS unsigned char* lds, const Gemm g, const Sched& S, const Epi& E, unsigned long long* stamps) {
    const int tid = opq_tid(), wid = __builtin_amdgcn_readfirstlane(tid >> 6), lane = tid & 63, wr = wid >> 2, wc = wid & 3, fr = lane & 15, fq = lane >> 4;
    const int K = g.K, nt = K / BK;
    int ts_lo = 0, ts_hi = 0, nts = 0; const unsigned long long rt_entry = STAMP ? (unsigned long long)wall_clock64() : 0ull;
#define PG8_STAMP() do { if (STAMP && wid == 0 && nts < 64) { const unsigned long long _c = (unsigned long long)clock64(); \
        ts_lo = (lane == nts) ? (int)(unsigned)_c : ts_lo; ts_hi = (lane == nts) ? (int)(unsigned)(_c >> 32) : ts_hi; ++nts; } } while (0)
    PG8_STAMP();
    unsigned voffA[2], voffB[2];
#pragma unroll
    for (int i = 0; i < 2; ++i) { int R, C; stage_rc(tid * 16 + i * 8192, R, C); const int Rb = Epi::PERM ? ((R & ~31) + perm32(R & 31)) : R;
        voffA[i] = (unsigned)(R * K + C) * 2u; voffB[i] = (unsigned)(Rb * K + C) * 2u; }
    const size_t kstep = (size_t)(BK * 2);
    const size_t hstep = (size_t)HALF * K * 2;
    const size_t tstep = 2 * hstep;
    const unsigned ldsw = (unsigned)wid * 1024u;
    const int aoff = lds_byte(wr * 64 + fr, fq * 8), boff = lds_byte(wc * 32 + fr, fq * 8);
#define PG8_SA(b, h) (((b) * 2 + (h)) * HTB)
#define PG8_SB(b, h) ((4 + (b) * 2 + (h)) * HTB)
#define PG8_STAGE(bufoff, gbase, voff) do { _Pragma("unroll") for (int _i = 0; _i < 2; ++_i) \
        __builtin_amdgcn_global_load_lds((const unsigned*)((const char*)(gbase) + (voff)[_i]), (PG8_LAS unsigned*)(lds + (bufoff) + ldsw + _i * 8192), 16, 0, 0); } while (0)
#define PG8_LDA(dst, b, h) do { _Pragma("unroll") for (int m = 0; m < 4; ++m) _Pragma("unroll") for (int k = 0; k < 2; ++k) dst[m][k] = *(const PG8_LAS bf16x8*)(lds + PG8_SA(b, h) + aoff + m * 2048 + k * 1024); } while (0)
#define PG8_LDB(dst, b, h) do { _Pragma("unroll") for (int n = 0; n < 2; ++n) _Pragma("unroll") for (int k = 0; k < 2; ++k) dst[n][k] = *(const PG8_LAS bf16x8*)(lds + PG8_SB(b, h) + boff + n * 2048 + k * 1024); } while (0)
#define PG8_MMA(ai, bj, At, Bt) do { __builtin_amdgcn_s_setprio(1); _Pragma("unroll") for (int m = 0; m < 4; ++m) _Pragma("unroll") for (int n = 0; n < 2; ++n) _Pragma("unroll") for (int k = 0; k < 2; ++k) \
        acc[ai][bj][m][n] = __builtin_amdgcn_mfma_f32_16x16x32_bf16(Bt[n][k], At[m][k], acc[ai][bj][m][n], 0, 0, 0); __builtin_amdgcn_s_setprio(0); } while (0)
#define PG8_WAIT_V(n) asm volatile("s_waitcnt vmcnt(" #n ")" ::: "memory")
#define PG8_WAIT_L(n) asm volatile("s_waitcnt lgkmcnt(" #n ")" ::: "memory")
#define PG8_BAR __builtin_amdgcn_s_barrier()
#define PG8_SCHED __builtin_amdgcn_sched_barrier(0)
    Unit cur, nxt; int ui = 0;
    if (!S.next(0, cur)) return;
    f32x4 acc[2][2][4][2];
#pragma unroll
    for (int a = 0; a < 2; ++a)
#pragma unroll
        for (int b = 0; b < 2; ++b)
#pragma unroll
            for (int m = 0; m < 4; ++m)
#pragma unroll
                for (int n = 0; n < 2; ++n) acc[a][b][m][n] = (f32x4){0.f, 0.f, 0.f, 0.f};
    bf16x8 At[4][2], B0[2][2], B1[2][2];
    const char* cA = (const char*)g.A + (size_t)cur.pm * tstep; const char* cB = (const char*)g.Bt + (size_t)cur.pn * tstep;
    S.a_ready(cur);
    PG8_STAGE(PG8_SB(0, 0), cB, voffB); PG8_STAGE(PG8_SA(0, 0), cA, voffA); PG8_STAGE(PG8_SB(0, 1), cB + hstep, voffB); PG8_STAGE(PG8_SA(0, 1), cA + hstep, voffA);
    if (wr == 1) PG8_BAR;
    PG8_WAIT_V(4); PG8_BAR;
    PG8_STAGE(PG8_SB(1, 0), cB + kstep, voffB); PG8_STAGE(PG8_SA(1, 0), cA + kstep, voffA); PG8_STAGE(PG8_SB(1, 1), cB + hstep + kstep, voffB);
    PG8_WAIT_V(6); PG8_BAR;
    PG8_STAMP();
    for (;;) {
        const bool has_next = S.next(ui + 1, nxt);
        const char* nA = has_next ? (const char*)g.A + (size_t)nxt.pm * tstep : cA; const char* nB = has_next ? (const char*)g.Bt + (size_t)nxt.pn * tstep : cB;
        for (int t = 0; t < nt; t += 2) {
            const bool last = (t == nt - 2);
            const char* a1 = cA + (size_t)(t + 1) * kstep;
            const char* a2 = last ? nA : cA + (size_t)(t + 2) * kstep; const char* b2 = last ? nB : cB + (size_t)(t + 2) * kstep;
            const char* a3 = a2 + kstep; const char* b3 = b2 + kstep;
            if (last && has_next) S.a_ready(nxt);
            PG8_LDB(B0, 0, 0); PG8_SCHED; PG8_LDA(At, 0, 0); PG8_STAGE(PG8_SA(1, 1), a1 + hstep, voffA);
            PG8_WAIT_L(8); PG8_BAR; PG8_WAIT_L(0); PG8_MMA(0, 0, At, B0); PG8_BAR; PG8_SCHED;
            PG8_LDB(B1, 0, 1); PG8_STAGE(PG8_SB(0, 0), b2, voffB);
            PG8_BAR; PG8_WAIT_L(0); PG8_MMA(0, 1, At, B1); PG8_BAR;
            PG8_LDA(At, 0, 1); PG8_STAGE(PG8_SA(0, 0), a2, voffA);
            PG8_BAR; PG8_WAIT_L(0); PG8_MMA(1, 0, At, B0); PG8_BAR; PG8_SCHED;
            PG8_STAGE(PG8_SB(0, 1), b2 + hstep, voffB);
            PG8_WAIT_V(6); PG8_BAR; PG8_MMA(1, 1, At, B1); PG8_BAR;
            PG8_LDB(B0, 1, 0); PG8_SCHED; PG8_LDA(At, 1, 0); PG8_STAGE(PG8_SA(0, 1), a2 + hstep, voffA);
            PG8_WAIT_L(8); PG8_BAR; PG8_WAIT_L(0); PG8_MMA(0, 0, At, B0); PG8_BAR; PG8_SCHED;
            PG8_LDB(B1, 1, 1); PG8_STAGE(PG8_SB(1, 0), b3, voffB);
            PG8_BAR; PG8_WAIT_L(0); PG8_MMA(0, 1, At, B1); PG8_BAR;
            PG8_LDA(At, 1, 1); PG8_STAGE(PG8_SA(1, 0), a3, voffA);
            PG8_BAR; PG8_WAIT_L(0); PG8_MMA(1, 0, At, B0); PG8_BAR; PG8_SCHED;
            PG8_STAGE(PG8_SB(1, 1), b3 + hstep, voffB);
            PG8_WAIT_V(6); PG8_BAR; PG8_MMA(1, 1, At, B1); PG8_BAR;
        }
        PG8_STAMP();
        if constexpr (!Epi::AFTER_DRAIN) { E(acc, cur, wr, wc, fr, fq); S.done(cur); }
        PG8_STAMP();
        if (!has_next) break;
#pragma unroll
        for (int a = 0; a < 2; ++a)
#pragma unroll
            for (int b = 0; b < 2; ++b)
#pragma unroll
                for (int m = 0; m < 4; ++m)
#pragma unroll
                    for (int n = 0; n < 2; ++n) acc[a][b][m][n] = (f32x4){0.f, 0.f, 0.f, 0.f};
        cur = nxt; cA = nA; cB = nB; ++ui;
    }
    PG8_WAIT_V(0);
    if (wr == 0) PG8_BAR;
    PG8_BAR;
    if constexpr (Epi::AFTER_DRAIN) { E.fused(acc, cur, wr, wc, fr, fq, lds, wid, lane); S.done(cur); }
    PG8_STAMP();
    if (STAMP && wid == 0) { stamps[lane] = lane < nts ? (((unsigned long long)(unsigned)ts_hi << 32) | (unsigned)ts_lo) : 0ull;
        if (lane == 62) stamps[62] = rt_entry; if (lane == 63) stamps[63] = (unsigned long long)wall_clock64(); }
#undef PG8_STAMP
#undef PG8_SA
#undef PG8_SB
#undef PG8_STAGE
#undef PG8_LDA
#undef PG8_LDB
#undef PG8_MMA
#undef PG8_WAIT_V
#undef PG8_WAIT_L
#undef PG8_BAR
#undef PG8_SCHED
}
}

#define XB_TMO      128
#define XB_XCNT(j)  (256  + 64 * (j))
#define XB_XSUB(j)  (1280 + 64 * (j))
#define XB_XGEN(j)  (2304 + 64 * (j))
#define XB_TOP      3328
#define XB_TOPGEN   3392
#define XCD_BAR_WORDS 3456
#define XB_SPIN_CAP (1u << 18)
#define LAS __attribute__((address_space(3)))

__device__ __forceinline__ unsigned xb_ld(unsigned* p)              { return __hip_atomic_load(p, __ATOMIC_RELAXED, __HIP_MEMORY_SCOPE_AGENT); }
__device__ __forceinline__ unsigned xb_add(unsigned* p, unsigned v) { return __hip_atomic_fetch_add(p, v, __ATOMIC_RELAXED, __HIP_MEMORY_SCOPE_AGENT); }
__device__ __forceinline__ unsigned xb_xcc_id() { return (unsigned)__builtin_amdgcn_s_getreg((3 << 11) | 20) & 0xFu; }
#define XB_SPIN(cond, bar) do { unsigned _sp = 0; while (cond) { __builtin_amdgcn_s_sleep(1); \
    if ((++_sp & 255u) == 0u) { if (xb_ld(&(bar)[XB_TMO])) break; if (_sp > XB_SPIN_CAP) { atomicAdd(&(bar)[XB_TMO], 1u); break; } } } } while (0)

struct XcdBarrier {
    unsigned* bar; unsigned x;
    volatile LAS unsigned* st;
};

__device__ __forceinline__ XcdBarrier xcd_barrier_post(unsigned* bar, volatile LAS unsigned* st) {
    XcdBarrier b; b.bar = bar; b.x = xb_xcc_id(); b.st = st;
    if (threadIdx.x == 0) (void)xb_add(&bar[XB_XCNT(b.x)], 1u);
    return b;
}
__device__ __forceinline__ void xcd_barrier_complete(unsigned* bar, unsigned x, unsigned& nloc, unsigned& nx) {
    const unsigned G = gridDim.x * gridDim.y * gridDim.z;
    unsigned sum, cnt, mine, sp = 0u;
    for (;;) {
        sum = 0u; cnt = 0u; mine = 0u;
#pragma unroll
        for (unsigned j = 0; j < 16; ++j) { const unsigned c = xb_ld(&bar[XB_XCNT(j)]); sum += c; cnt += (c > 0u) ? 1u : 0u; mine = (j == x) ? c : mine; }
        if (sum == G) break;
        __builtin_amdgcn_s_sleep(1);
        if ((++sp & 255u) == 0u) { if (xb_ld(&bar[XB_TMO])) break; if (sp > XB_SPIN_CAP) { atomicAdd(&bar[XB_TMO], 1u); break; } }
    }
    nloc = mine > 0u ? mine : 1u; nx = cnt > 0u ? cnt : 1u;
}

__device__ __forceinline__ void xcd_barrier(const XcdBarrier& b) {
    asm volatile("s_waitcnt vmcnt(0)" ::: "memory");
    __syncthreads();
    if (threadIdx.x == 0) {
        unsigned* bar = b.bar;
        __builtin_amdgcn_s_waitcnt(0);
        unsigned nloc = b.st[0], nx = b.st[1];
        if (nloc == 0u) { xcd_barrier_complete(bar, b.x, nloc, nx); b.st[0] = nloc; b.st[1] = nx; }
        const unsigned old = xb_add(&bar[XB_XSUB(b.x)], 1u);
        const unsigned gen = old / nloc;
        if (old + 1u == (gen + 1u) * nloc) {
            __builtin_amdgcn_fence(__ATOMIC_RELEASE, "agent");
            asm volatile("s_waitcnt vmcnt(0)" ::: "memory");
            const unsigned og = xb_add(&bar[XB_TOP], 1u);
            const unsigned tg = og / nx;
            if (og + 1u == (tg + 1u) * nx) xb_add(&bar[XB_TOPGEN], 1u);
            else XB_SPIN(xb_ld(&bar[XB_TOPGEN]) == tg, bar);
            __builtin_amdgcn_fence(__ATOMIC_ACQUIRE, "agent");
            xb_add(&bar[XB_XGEN(b.x)], 1u);
            asm volatile("s_waitcnt vmcnt(0)" ::: "memory");
        } else {
            XB_SPIN(xb_ld(&bar[XB_XGEN(b.x)]) == gen, bar);
            __builtin_amdgcn_fence(__ATOMIC_ACQUIRE, "agent");
            asm volatile("s_waitcnt vmcnt(0)" ::: "memory");
        }
    }
    __syncthreads();
}

typedef unsigned short bf16_t;
typedef short bf16x8 __attribute__((ext_vector_type(8)));
typedef float f32x4 __attribute__((ext_vector_type(4)));
typedef float f32x16 __attribute__((ext_vector_type(16)));

constexpr int DM = 2048, SEQ = 4096, NBP = 2, NBS = 32, TP = NBP * SEQ, MT = TP + NBS, MP = 8448;
constexpr int INW = 6784, INWP = 6912, SHD = 3200, DEPTH = 2;
constexpr size_t NRI = (size_t)MT * 1024;
constexpr int LDS_BYTES = 131072 + 16;
constexpr size_t O_CKP = (size_t)MT * DM;
constexpr size_t O_CVP = O_CKP + (size_t)DEPTH * NBP * 128 * 256;
constexpr size_t O_WKVP = O_CVP + (size_t)DEPTH * NBP * 128 * 256;
constexpr size_t O_SHP = O_WKVP + (size_t)DEPTH * NBP * 16 * 4096;
constexpr size_t O_CKS = O_SHP + (size_t)DEPTH * NBP * SHD;
constexpr size_t O_CVS = O_CKS + (size_t)DEPTH * NBS * 128 * 256;
constexpr size_t O_WKVS = O_CVS + (size_t)DEPTH * NBS * 128 * 256;
constexpr size_t O_SHS = O_WKVS + (size_t)DEPTH * NBS * 16 * 4096;
constexpr size_t O_END = O_SHS + (size_t)DEPTH * NBS * SHD;
constexpr size_t al256(size_t x) { return (x + 255) & ~(size_t)255; }
constexpr size_t WS_WTIN = 0;
constexpr size_t WS_WTOUT = WS_WTIN + (size_t)INWP * DM * 2;
constexpr size_t WS_MOD = WS_WTOUT + (size_t)DEPTH * DM * DM * 2;
constexpr size_t WS_ROPE = WS_MOD + al256((size_t)DEPTH * 34 * 6144 * 4);
constexpr size_t WS_HB = WS_ROPE + al256((size_t)4097 * 16 * 4);
constexpr size_t WS_QB = WS_HB + (size_t)MP * DM * 2;
constexpr size_t WS_KB = WS_QB + (size_t)MP * 1024 * 2;
constexpr size_t WS_VB = WS_KB + (size_t)MP * 256 * 2;
constexpr size_t WS_RW = WS_VB + (size_t)MP * 256 * 2;
constexpr size_t WS_GT = WS_RW + (size_t)MP * SHD * 2;
constexpr size_t WS_VALL = WS_GT + (size_t)MP * DM * 2;
constexpr size_t SRI = (size_t)NBS * 1024;
constexpr size_t WS_RSB = WS_VALL + NRI * 2;
constexpr size_t WS_RSW = WS_RSB + 4 * SRI * 2;
constexpr size_t WS_YS = WS_RSW + SRI * 4;
constexpr size_t WS_REC = WS_YS + NRI * 4;
constexpr size_t WS_COEF = WS_REC + (size_t)32 * 256 * 14592;
constexpr size_t WS_TWAD = WS_COEF + al256((size_t)MT * 16 * 4);
constexpr size_t WS_WFRAG = WS_TWAD + (size_t)MT * 128 * 2;
constexpr size_t WS_BAR = WS_WFRAG + (size_t)DEPTH * 2 * 16 * 4 * 2 * 64 * 16;
constexpr size_t WS_RFLAG = WS_BAR + 16384;
constexpr size_t RFLAG_BYTES = (size_t)32 * 256 * 64;
constexpr size_t WS_END = WS_RFLAG + RFLAG_BYTES;

struct Params {
    const float *x_prompt, *x_sample, *cache_k, *cache_v, *state_wkv, *state_shift, *c_prompt, *c_sample, *norm_g, *w_ada, *b_ada, *w_in, *mu_shift, *w0, *w_decay, *a0,
        *w_iclr, *k_k, *k_a, *r_k, *ln_w, *ln_b, *sinks, *w_out, *final_g;
    float* out;
    unsigned char* ws;
    int repk, repl;
};
typedef const __attribute__((address_space(4))) Params* KParamsPtr;
__device__ __forceinline__ const Params& kparams() {
    KParamsPtr k = (KParamsPtr)__builtin_amdgcn_kernarg_segment_ptr();
    asm volatile("" : "+s"(k));
    return *(const Params*)k;
}

__device__ __forceinline__ unsigned short f2bf(float f) { return (unsigned short)(hw_cvt_pk_bf16(f, 0.f) & 0xffffu); }
__device__ __forceinline__ float bf2f(unsigned short b) { return __uint_as_float(((unsigned)b) << 16); }
__device__ __forceinline__ unsigned pack2(float lo, float hi) { return hw_cvt_pk_bf16(lo, hi); }
__device__ __forceinline__ float bflo(unsigned w) { return __uint_as_float(w << 16); }
__device__ __forceinline__ float bfhi(unsigned w) { return __uint_as_float(w & 0xffff0000u); }
__device__ __forceinline__ float silu_f(float x) { return x / (1.f + __expf(-x)); }
__device__ __forceinline__ float wave_sum(float x) {
#pragma unroll
    for (int o = 32; o >= 1; o >>= 1) x += __shfl_xor(x, o);
    return x;
}
__device__ __forceinline__ float wave_max(float x) {
#pragma unroll
    for (int o = 32; o >= 1; o >>= 1) x = fmaxf(x, __shfl_xor(x, o));
    return x;
}
template <int CTRL> __device__ __forceinline__ float dpp_f(float x) {
    return __builtin_bit_cast(float, __builtin_amdgcn_update_dpp(0, __builtin_bit_cast(int, x), CTRL, 0xF, 0xF, false));
}
__device__ __forceinline__ float allreduce16(float x) {
    x += dpp_f<0x128>(x);
    x += dpp_f<0x124>(x);
    x += dpp_f<0x122>(x);
    x += dpp_f<0x121>(x);
    return x;
}

__device__ void p0_mod_item(const Params& p, float* red, int l, int nc) {
    const int tid = opq_tid(), wv = tid >> 6, lane = tid & 63, n = lane & 31, kh = lane >> 5;
    f32x16 acc0, acc1;
#pragma unroll
    for (int i = 0; i < 16; ++i) { acc0[i] = 0.f; acc1[i] = 0.f; }
    const float* W = p.w_ada + (size_t)l * DM * 6144 + nc * 32 + n;
#pragma unroll 8
    for (int ks = 0; ks < 16; ++ks) {
        const int k0 = wv * 256 + ks * 16 + kh * 8;
        bf16x8 bfr, a0, a1;
#pragma unroll
        for (int j = 0; j < 8; ++j) bfr[j] = (short)f2bf(W[(size_t)(k0 + j) * 6144]);
        const float4* cs = (const float4*)(p.c_sample + (size_t)n * DM + k0);
        const float4 u0 = cs[0], u1 = cs[1];
        a0[0] = (short)f2bf(silu_f(u0.x)); a0[1] = (short)f2bf(silu_f(u0.y)); a0[2] = (short)f2bf(silu_f(u0.z)); a0[3] = (short)f2bf(silu_f(u0.w));
        a0[4] = (short)f2bf(silu_f(u1.x)); a0[5] = (short)f2bf(silu_f(u1.y)); a0[6] = (short)f2bf(silu_f(u1.z)); a0[7] = (short)f2bf(silu_f(u1.w));
        float4 q0 = make_float4(0.f, 0.f, 0.f, 0.f), q1 = q0;
        if (n < 2) { const float4* cp = (const float4*)(p.c_prompt + (size_t)n * DM + k0); q0 = cp[0]; q1 = cp[1]; }
        a1[0] = (short)f2bf(silu_f(q0.x)); a1[1] = (short)f2bf(silu_f(q0.y)); a1[2] = (short)f2bf(silu_f(q0.z)); a1[3] = (short)f2bf(silu_f(q0.w));
        a1[4] = (short)f2bf(silu_f(q1.x)); a1[5] = (short)f2bf(silu_f(q1.y)); a1[6] = (short)f2bf(silu_f(q1.z)); a1[7] = (short)f2bf(silu_f(q1.w));
        acc0 = __builtin_amdgcn_mfma_f32_32x32x16_bf16(a0, bfr, acc0, 0, 0, 0);
        acc1 = __builtin_amdgcn_mfma_f32_32x32x16_bf16(a1, bfr, acc1, 0, 0, 0);
    }
#pragma unroll
    for (int i = 0; i < 16; ++i) red[(wv * 18 + i) * 64 + lane] = acc0[i];
    red[(wv * 18 + 16) * 64 + lane] = acc1[0];
    red[(wv * 18 + 17) * 64 + lane] = acc1[1];
    __syncthreads();
    float* mod = (float*)(p.ws + WS_MOD);
    for (int o = tid; o < 34 * 32; o += 512) {
        const int row = o >> 5, col = o & 31;
        int ri, ln, mrow;
        if (row < 32) { const int khh = (row >> 2) & 1; ri = (row & 3) + 4 * (row >> 3); ln = col + 32 * khh; mrow = 2 + row; }
        else { ri = 16 + (row - 32); ln = col; mrow = row - 32; }
        float s = 0.f;
#pragma unroll
        for (int w = 0; w < 8; ++w) s += red[(w * 18 + ri) * 64 + ln];
        mod[((size_t)l * 34 + mrow) * 6144 + nc * 32 + col] = s + p.b_ada[l * 6144 + nc * 32 + col];
    }
    __syncthreads();
}

struct ConvIt { const float* src; bf16_t* dst; int N, k0, n0; };
__device__ __forceinline__ ConvIt conv_decode(const Params& p, int cidx, int lw) {
    ConvIt c;
    int kt, nt;
    if (cidx < 1728) { kt = cidx & 15; nt = cidx >> 4; c.N = INW; c.src = p.w_in + (size_t)lw * DM * INW; c.dst = (bf16_t*)(p.ws + WS_WTIN); }
    else { int rem = cidx - 1728; const int l2 = rem >> 9; rem &= 511; kt = rem & 15; nt = rem >> 4; c.N = DM; c.src = p.w_out + (size_t)l2 * DM * DM; c.dst = (bf16_t*)(p.ws + WS_WTOUT) + (size_t)l2 * DM * DM; }
    c.k0 = kt * 128; c.n0 = nt * 64;
    return c;
}
__device__ void p0_conv_all(const Params& p, float* s, int bid, int G, int total, int lw) {
    const int tid = opq_tid();
    const int lrow = tid >> 4, c4 = tid & 15, n = tid >> 3, kg = tid & 7;
    float4 v[4];
    int cidx = bid;
    ConvIt cur = conv_decode(p, cidx < total ? cidx : 0, lw);
    if (cidx < total) {
#pragma unroll
        for (int p4 = 0; p4 < 4; ++p4) { v[p4] = make_float4(0.f, 0.f, 0.f, 0.f); if (cur.n0 < cur.N) v[p4] = *(const float4*)(cur.src + (size_t)(cur.k0 + lrow + 32 * p4) * cur.N + cur.n0 + 4 * c4); }
    }
#pragma unroll 1
    while (cidx < total) {
#pragma unroll
        for (int p4 = 0; p4 < 4; ++p4) { float* d = s + (lrow + 32 * p4) * 65 + 4 * c4; d[0] = v[p4].x; d[1] = v[p4].y; d[2] = v[p4].z; d[3] = v[p4].w; }
        __syncthreads();
        const int nxt = cidx + G;
        const ConvIt nx = conv_decode(p, nxt < total ? nxt : 0, lw);
        if (nxt < total) {
#pragma unroll
            for (int p4 = 0; p4 < 4; ++p4) { v[p4] = make_float4(0.f, 0.f, 0.f, 0.f); if (nx.n0 < nx.N) v[p4] = *(const float4*)(nx.src + (size_t)(nx.k0 + lrow + 32 * p4) * nx.N + nx.n0 + 4 * c4); }
        }
        unsigned w[8];
#pragma unroll
        for (int j = 0; j < 8; ++j) w[j] = pack2(s[(kg * 16 + 2 * j) * 65 + n], s[(kg * 16 + 2 * j + 1) * 65 + n]);
        uint4* o = (uint4*)(cur.dst + (size_t)(cur.n0 + n) * DM + cur.k0 + kg * 16);
        o[0] = make_uint4(w[0], w[1], w[2], w[3]);
        o[1] = make_uint4(w[4], w[5], w[6], w[7]);
        __syncthreads();
        cur = nx; cidx = nxt;
    }
}

__device__ void p0_rope_item(const Params& p, int it) {
    float* rope = (float*)(p.ws + WS_ROPE);
#pragma unroll
    for (int q = 0; q < 4; ++q) {
        const int e = it * 2048 + q * 512 + opq_tid();
        if (e < 4097 * 8) {
            const int idx = e >> 3, i = e & 7;
            double invf = 1.0;
            for (int q = 0; q < i; ++q) invf *= 0.19392274474868576;
            const double pos = idx < 4096 ? (double)idx : 16384.0;
            const double rev = pos * invf * 0.15915494309189535;
            const float f = (float)(rev - floor(rev));
            rope[idx * 16 + i] = __builtin_amdgcn_cosf(f);
            rope[idx * 16 + 8 + i] = __builtin_amdgcn_sinf(f);
        }
    }
}

__device__ void p0_wfrag_item(const Params& p, int it) {
    const int e0 = it * 512 + opq_tid();
    const int lane = e0 & 63, ks = (e0 >> 6) & 1, ct = (e0 >> 7) & 3, hd = (e0 >> 9) & 15, mtx = (e0 >> 13) & 1, l = e0 >> 14;
    const float* W = (mtx == 0 ? p.w_decay : p.w_iclr) + (size_t)l * 64 * 1024 + hd * 64 + 16 * ct + (lane & 15);
    const int k0 = 32 * ks + 8 * (lane >> 4);
    float v[8];
#pragma unroll
    for (int e = 0; e < 8; ++e) v[e] = W[(size_t)(k0 + e) * 1024];
    ((uint4*)(p.ws + WS_WFRAG))[e0] = make_uint4(pack2(v[0], v[1]), pack2(v[2], v[3]), pack2(v[4], v[5]), pack2(v[6], v[7]));
}

__device__ void p1_norm(const Params& p, int l, int bid, int G) {
    const int tid = opq_tid(), wv = tid >> 6, lane = tid & 63;
    bf16_t* hb = (bf16_t*)(p.ws + WS_HB);
    const float* mod = (const float*)(p.ws + WS_MOD);
    const float4* g4 = (const float4*)(p.norm_g + l * DM);
    for (int r = bid * 8 + wv; r < MT; r += G * 8) {
        const float* xr = l == 0 ? (r < TP ? p.x_prompt + (size_t)r * DM : p.x_sample + (size_t)(r - TP) * DM) : p.out + (size_t)r * DM;
        const int mrow = r < TP ? (r >> 12) : 2 + (r - TP);
        const float* md = mod + ((size_t)l * 34 + mrow) * 6144;
        float4 v[8]; float ss = 0.f;
#pragma unroll
        for (int i = 0; i < 8; ++i) { v[i] = ((const float4*)xr)[lane + 64 * i]; ss += v[i].x * v[i].x + v[i].y * v[i].y + v[i].z * v[i].z + v[i].w * v[i].w; }
        ss = wave_sum(ss);
        const float rinv = rsqrtf(ss * (1.f / 2048.f) + 1e-5f);
#pragma unroll
        for (int i = 0; i < 8; ++i) {
            const int c4 = lane + 64 * i;
            const float4 g = g4[c4], sc = ((const float4*)(md + 2048))[c4], sh = ((const float4*)md)[c4];
            const float y0 = v[i].x * rinv * g.x * (1.f + sc.x) + sh.x, y1 = v[i].y * rinv * g.y * (1.f + sc.y) + sh.y;
            const float y2 = v[i].z * rinv * g.z * (1.f + sc.z) + sh.z, y3 = v[i].w * rinv * g.w * (1.f + sc.w) + sh.w;
            *(uint2*)(hb + (size_t)r * DM + 4 * c4) = make_uint2(pack2(y0, y1), pack2(y2, y3));
        }
    }
}

struct Epi1 {
    static constexpr bool PERM = false, AFTER_DRAIN = false;
    int l;
    __device__ __forceinline__ void operator()(const f32x4 (&acc)[2][2][4][2], const pg8::Unit& u, int wr, int wc, int fr, int fq) const {
        const Params& p = kparams();
        bf16_t* const qb = (bf16_t*)(p.ws + WS_QB); bf16_t* const kb = (bf16_t*)(p.ws + WS_KB); bf16_t* const vb = (bf16_t*)(p.ws + WS_VB);
        bf16_t* const rw = (bf16_t*)(p.ws + WS_RW); bf16_t* const gt = (bf16_t*)(p.ws + WS_GT); const float* const rope = (const float*)(p.ws + WS_ROPE); float* const out = p.out;
#pragma unroll
        for (int bj = 0; bj < 2; ++bj)
#pragma unroll
            for (int n = 0; n < 2; ++n) {
                const int cb = u.pn * 256 + bj * 128 + wc * 32 + n * 16;
                if (cb >= INW) continue;
                const int c = cb + 4 * fq;
                const bool do_rope = (cb < 1280) && ((cb & 63) == 0);
#pragma unroll
                for (int ai = 0; ai < 2; ++ai)
#pragma unroll
                    for (int m = 0; m < 4; ++m) {
                        const int rb = u.pm * 256 + ai * 128 + wr * 64 + m * 16;
                        if (rb >= MT) continue;
                        const int r = rb + fr;
                        f32x4 v = acc[ai][bj][m][n];
                        if (do_rope) {
                            const int idx = r < TP ? (r & 4095) : 4096;
                            const float4 cs = *(const float4*)(rope + idx * 16 + 4 * (fq & 1));
                            const float4 sn = *(const float4*)(rope + idx * 16 + 8 + 4 * (fq & 1));
                            const float p0 = __shfl_xor(v[0], 32), p1 = __shfl_xor(v[1], 32), p2 = __shfl_xor(v[2], 32), p3 = __shfl_xor(v[3], 32);
                            const float sg = fq < 2 ? -1.f : 1.f;
                            v[0] = v[0] * cs.x + sg * p0 * sn.x; v[1] = v[1] * cs.y + sg * p1 * sn.y; v[2] = v[2] * cs.z + sg * p2 * sn.z; v[3] = v[3] * cs.w + sg * p3 * sn.w;
                        }
                        if (cb < 1024) {
                            *(uint2*)(qb + (size_t)r * 1024 + c) = make_uint2(pack2(v[0] * 0.125f, v[1] * 0.125f), pack2(v[2] * 0.125f, v[3] * 0.125f));
                        } else if (cb < 1536) {
                            const bool isk = cb < 1280;
                            const int cc = c - (isk ? 1024 : 1280);
                            *(uint2*)((isk ? kb : vb) + (size_t)r * 256 + cc) = make_uint2(pack2(v[0], v[1]), pack2(v[2], v[3]));
                            if (r >= TP) {
                                *(f32x4*)(out + (isk ? O_CKS : O_CVS) + ((size_t)(l * NBS + (r - TP)) * 128 + 127) * 256 + cc) = v;
                            } else if ((r & 4095) >= SEQ - 128) {
                                *(f32x4*)(out + (isk ? O_CKP : O_CVP) + ((size_t)(l * NBP + (r >> 12)) * 128 + ((r & 4095) - (SEQ - 128))) * 256 + cc) = v;
                            }
                        } else if (cb < 4736) {
                            const int cc = c - 1536;
                            *(uint2*)(rw + (size_t)r * SHD + cc) = make_uint2(pack2(v[0], v[1]), pack2(v[2], v[3]));
                            if (r >= TP) *(f32x4*)(out + O_SHS + (size_t)(l * NBS + (r - TP)) * SHD + cc) = v;
                            else if ((r & 4095) == SEQ - 1) *(f32x4*)(out + O_SHP + (size_t)(l * NBP + (r >> 12)) * SHD + cc) = v;
                        } else {
                            const int cc = c - 4736;
                            *(uint2*)(gt + (size_t)r * DM + cc) = make_uint2(pack2(silu_f(v[0]), silu_f(v[1])), pack2(silu_f(v[2]), silu_f(v[3])));
                        }
                    }
            }
    }
};

struct Epi2 {
    static constexpr bool PERM = false, AFTER_DRAIN = false;
    int l;
    __device__ __forceinline__ void operator()(const f32x4 (&acc)[2][2][4][2], const pg8::Unit& u, int wr, int wc, int fr, int fq) const {
        const Params& p = kparams();
        float* const out = p.out;
        const int rb0 = u.pm * 256;
        const int mrow = rb0 < TP ? (rb0 >> 12) : 2;
        const float* gr = (const float*)(p.ws + WS_MOD) + ((size_t)l * 34 + mrow) * 6144 + 4096 + u.pn * 256 + wc * 32 + 4 * fq;
        f32x4 g4[2][2];
#pragma unroll
        for (int bj = 0; bj < 2; ++bj)
#pragma unroll
            for (int n = 0; n < 2; ++n) g4[bj][n] = *(const f32x4*)(gr + bj * 128 + n * 16);
        const float* xbase = l == 0 ? p.x_prompt : out;
        const int c0 = u.pn * 256 + wc * 32 + 4 * fq;
#pragma unroll
        for (int ai = 0; ai < 2; ++ai)
#pragma unroll
            for (int mh = 0; mh < 2; ++mh) {
                f32x4 x4[2][2][2];
#pragma unroll
                for (int mm = 0; mm < 2; ++mm) {
                    const int r = rb0 + ai * 128 + wr * 64 + (2 * mh + mm) * 16 + fr;
                    const float* xo = xbase + (size_t)r * DM + c0;
#pragma unroll
                    for (int bj = 0; bj < 2; ++bj)
#pragma unroll
                        for (int n = 0; n < 2; ++n) x4[mm][bj][n] = *(const f32x4*)(xo + bj * 128 + n * 16);
                }
                __builtin_amdgcn_sched_barrier(0);
#pragma unroll
                for (int mm = 0; mm < 2; ++mm) {
                    const int r = rb0 + ai * 128 + wr * 64 + (2 * mh + mm) * 16 + fr;
                    float* yo = out + (size_t)r * DM + c0;
#pragma unroll
                    for (int bj = 0; bj < 2; ++bj)
#pragma unroll
                        for (int n = 0; n < 2; ++n) *(f32x4*)(yo + bj * 128 + n * 16) = x4[mm][bj][n] + g4[bj][n] * acc[ai][bj][2 * mh + mm][n];
                }
                __builtin_amdgcn_sched_barrier(0);
            }
    }
};

__device__ void g2_sample_item(const Params& p, float* red, int l, int nb) {
    const int tid = opq_tid(), wv = tid >> 6, lane = tid & 63, n = lane & 31, h = lane >> 5;
    const bf16_t* A = (const bf16_t*)(p.ws + WS_HB) + (size_t)TP * DM;
    const bf16_t* Bt = (const bf16_t*)(p.ws + WS_WTOUT) + (size_t)l * DM * DM + (size_t)(nb * 32) * DM;
    f32x16 acc;
#pragma unroll
    for (int i = 0; i < 16; ++i) acc[i] = 0.f;
#pragma unroll 4
    for (int ks = 0; ks < 16; ++ks) {
        const int k0 = wv * 256 + ks * 16 + 8 * h;
        const bf16x8 a = *(const bf16x8*)(A + (size_t)n * DM + k0);
        const bf16x8 bq = *(const bf16x8*)(Bt + (size_t)n * DM + k0);
        acc = __builtin_amdgcn_mfma_f32_32x32x16_bf16(a, bq, acc, 0, 0, 0);
    }
#pragma unroll
    for (int i = 0; i < 16; ++i) red[(wv * 16 + i) * 64 + lane] = acc[i];
    __syncthreads();
    const float* mod = (const float*)(p.ws + WS_MOD) + (size_t)l * 34 * 6144;
    for (int o = tid; o < 1024; o += 512) {
        const int row = o >> 5, col = o & 31, hh = (row >> 2) & 1, ri = (row & 3) + 4 * (row >> 3), ln = col + 32 * hh;
        float s = 0.f;
#pragma unroll
        for (int w = 0; w < 8; ++w) s += red[(w * 16 + ri) * 64 + ln];
        const int c = nb * 32 + col;
        const float gate = mod[(size_t)(2 + row) * 6144 + 4096 + c];
        const float xo = l == 0 ? p.x_sample[(size_t)row * DM + c] : p.out[(size_t)(TP + row) * DM + c];
        p.out[(size_t)(TP + row) * DM + c] = xo + gate * s;
    }
    __syncthreads();
}

__device__ void p3_attn_unit(const Params& p, unsigned char* lds, int l, int unit) {
    const int tid = opq_tid(), wv = tid >> 6, lane = tid & 63;
    const int b = unit >> 7, n = (unit >> 2) & 31, g = unit & 3;
    bf16_t* Ks = (bf16_t*)lds;
    bf16_t* Vt = (bf16_t*)(lds + 36864);
    const bf16_t* qb = (const bf16_t*)(p.ws + WS_QB);
    const bf16_t* kb = (const bf16_t*)(p.ws + WS_KB);
    const bf16_t* vb = (const bf16_t*)(p.ws + WS_VB);
    const bf16_t* gt = (const bf16_t*)(p.ws + WS_GT);
    bf16_t* cc = (bf16_t*)(p.ws + WS_HB);
    {
        uint4 kv4[4], vv4[4];
#pragma unroll
        for (int i = 0; i < 4; ++i) {
            const int chunk = tid + 512 * i, kl = chunk >> 3, dc = chunk & 7, kp = 128 * (n - 1) + kl;
            kv4[i] = make_uint4(0u, 0u, 0u, 0u); vv4[i] = kv4[i];
            if (kp >= 0) { const size_t row = (size_t)b * SEQ + kp; kv4[i] = *(const uint4*)(kb + row * 256 + g * 64 + dc * 8); vv4[i] = *(const uint4*)(vb + row * 256 + g * 64 + dc * 8); }
        }
        __builtin_amdgcn_sched_barrier(0);
#pragma unroll
        for (int i = 0; i < 4; ++i) {
            const int chunk = tid + 512 * i, kl = chunk >> 3, dc = chunk & 7;
            *(uint4*)(Ks + kl * 72 + dc * 8) = kv4[i];
            bf16_t* vd = Vt + (dc * 8) * 264 + kl;
            vd[0 * 264] = (bf16_t)(vv4[i].x & 0xffffu); vd[1 * 264] = (bf16_t)(vv4[i].x >> 16);
            vd[2 * 264] = (bf16_t)(vv4[i].y & 0xffffu); vd[3 * 264] = (bf16_t)(vv4[i].y >> 16);
            vd[4 * 264] = (bf16_t)(vv4[i].z & 0xffffu); vd[5 * 264] = (bf16_t)(vv4[i].z >> 16);
            vd[6 * 264] = (bf16_t)(vv4[i].w & 0xffffu); vd[7 * 264] = (bf16_t)(vv4[i].w >> 16);
        }
    }
    __syncthreads();
    const int hq = 4 * g + (wv >> 1), qh = wv & 1, q32 = lane & 31, h = lane >> 5;
    const float sink = p.sinks[l * 16 + hq];
#pragma unroll 1
    for (int s = 0; s < 2; ++s) {
        const int qp = 128 * n + 64 * qh + 32 * s + q32;
        const size_t qrow = (size_t)b * SEQ + qp;
        const int klb0 = 64 * qh + 32 * s;
        bf16x8 qf[4];
#pragma unroll
        for (int ks = 0; ks < 4; ++ks) qf[ks] = *(const bf16x8*)(qb + qrow * 1024 + hq * 64 + ks * 16 + 8 * h);
        f32x16 S[5];
#pragma unroll
        for (int kt = 0; kt < 5; ++kt) {
#pragma unroll
            for (int i = 0; i < 16; ++i) S[kt][i] = 0.f;
#pragma unroll
            for (int ks = 0; ks < 4; ++ks) {
                const bf16x8 a = *(const bf16x8*)(Ks + (klb0 + 32 * kt + q32) * 72 + ks * 16 + 8 * h);
                S[kt] = __builtin_amdgcn_mfma_f32_32x32x16_bf16(a, qf[ks], S[kt], 0, 0, 0);
            }
        }
        float mx = -1e30f;
#pragma unroll
        for (int kt = 0; kt < 5; ++kt)
#pragma unroll
            for (int i = 0; i < 16; ++i) {
                const int m = 8 * (i >> 2) + 4 * h + (i & 3);
                const int kp = 128 * (n - 1) + klb0 + 32 * kt + m;
                const int rel = qp - kp;
                const bool ok = (rel >= 0) && (rel <= 128) && (kp >= 0);
                const float sv = ok ? S[kt][i] : -1e30f;
                S[kt][i] = sv; mx = fmaxf(mx, sv);
            }
        mx = fmaxf(mx, __shfl_xor(mx, 32));
        mx = fmaxf(mx, sink);
        float sum = 0.f;
#pragma unroll
        for (int kt = 0; kt < 5; ++kt)
#pragma unroll
            for (int i = 0; i < 16; ++i) { const float e = __expf(S[kt][i] - mx); S[kt][i] = e; sum += e; }
        sum += __shfl_xor(sum, 32);
        const float inv = 1.f / (sum + __expf(sink - mx));
        f32x16 O[2];
#pragma unroll
        for (int i = 0; i < 16; ++i) { O[0][i] = 0.f; O[1][i] = 0.f; }
#pragma unroll
        for (int kt = 0; kt < 5; ++kt)
#pragma unroll
            for (int sp = 0; sp < 2; ++sp) {
                bf16x8 pf;
#pragma unroll
                for (int j = 0; j < 8; ++j) pf[j] = (short)f2bf(S[kt][8 * sp + j]);
#pragma unroll
                for (int dt = 0; dt < 2; ++dt) {
                    const bf16_t* vp = Vt + (32 * dt + q32) * 264 + klb0 + 32 * kt + 16 * sp + 4 * h;
                    const uint2 lo = *(const uint2*)vp, hi = *(const uint2*)(vp + 8);
                    const uint4 av = make_uint4(lo.x, lo.y, hi.x, hi.y);
                    O[dt] = __builtin_amdgcn_mfma_f32_32x32x16_bf16(__builtin_bit_cast(bf16x8, av), pf, O[dt], 0, 0, 0);
                }
            }
        uint2 gq[2][4];
#pragma unroll
        for (int dt = 0; dt < 2; ++dt)
#pragma unroll
            for (int ig = 0; ig < 4; ++ig) gq[dt][ig] = *(const uint2*)(gt + qrow * DM + hq * 64 + 32 * dt + 8 * ig + 4 * h);
        __builtin_amdgcn_sched_barrier(0);
#pragma unroll
        for (int dt = 0; dt < 2; ++dt)
#pragma unroll
            for (int ig = 0; ig < 4; ++ig) {
                const int col = hq * 64 + 32 * dt + 8 * ig + 4 * h;
                const uint2 gg = gq[dt][ig];
                const float o0 = O[dt][4 * ig + 0] * inv * bflo(gg.x), o1 = O[dt][4 * ig + 1] * inv * bfhi(gg.x);
                const float o2 = O[dt][4 * ig + 2] * inv * bflo(gg.y), o3 = O[dt][4 * ig + 3] * inv * bfhi(gg.y);
                *(uint2*)(cc + qrow * DM + col) = make_uint2(pack2(o0, o1), pack2(o2, o3));
            }
    }
    __syncthreads();
}

__device__ void p3_sattn_item(const Params& p, float* lds, int l, int item) {
    const int tid = opq_tid(), wv = tid >> 6, lane = tid & 63;
    float* pl = lds + wv * 128;
    const int w = item * 8 + wv, bd = w >> 4, hq = w & 15, g = hq >> 2;
    const size_t row = (size_t)TP + bd;
    const bf16_t* qb = (const bf16_t*)(p.ws + WS_QB);
    const bf16_t* gt = (const bf16_t*)(p.ws + WS_GT);
    bf16_t* cc = (bf16_t*)(p.ws + WS_HB);
    float q[64];
#pragma unroll
    for (int c = 0; c < 8; ++c) {
        const uint4 u = *(const uint4*)(qb + row * 1024 + hq * 64 + c * 8);
        q[c * 8 + 0] = bflo(u.x); q[c * 8 + 1] = bfhi(u.x); q[c * 8 + 2] = bflo(u.y); q[c * 8 + 3] = bfhi(u.y);
        q[c * 8 + 4] = bflo(u.z); q[c * 8 + 5] = bfhi(u.z); q[c * 8 + 6] = bflo(u.w); q[c * 8 + 7] = bfhi(u.w);
    }
    const size_t cbase = ((size_t)(l * NBS + bd) * 128) * 256 + g * 64;
    const float* ck = p.cache_k + cbase;
    const float* cv = p.cache_v + cbase;
    float* nk = p.out + O_CKS + cbase;
    float* nv = p.out + O_CVS + cbase;
    float s0 = 0.f, s1 = 0.f, s2 = 0.f;
#pragma unroll
    for (int c = 0; c < 16; ++c) {
        const float4 a = ((const float4*)(ck + (size_t)lane * 256))[c];
        const float4 bq = ((const float4*)(ck + (size_t)(lane + 64) * 256))[c];
        const float4 e = ((const float4*)(nk + (size_t)127 * 256))[c];
        s0 += a.x * q[4 * c] + a.y * q[4 * c + 1] + a.z * q[4 * c + 2] + a.w * q[4 * c + 3];
        s1 += bq.x * q[4 * c] + bq.y * q[4 * c + 1] + bq.z * q[4 * c + 2] + bq.w * q[4 * c + 3];
        s2 += e.x * q[4 * c] + e.y * q[4 * c + 1] + e.z * q[4 * c + 2] + e.w * q[4 * c + 3];
    }
    const float sink = p.sinks[l * 16 + hq];
    const float mx = fmaxf(wave_max(fmaxf(s0, s1)), fmaxf(s2, sink));
    const float p0 = __expf(s0 - mx), p1 = __expf(s1 - mx), p2 = __expf(s2 - mx);
    const float sum = wave_sum(p0 + p1) + p2 + __expf(sink - mx);
    pl[lane] = p0; pl[lane + 64] = p1;
    __builtin_amdgcn_fence(__ATOMIC_RELEASE, "wavefront");
    __builtin_amdgcn_wave_barrier();
    __builtin_amdgcn_fence(__ATOMIC_ACQUIRE, "wavefront");
    float o = 0.f;
#pragma unroll 32
    for (int key = 0; key < 128; ++key) o += pl[key] * cv[(size_t)key * 256 + lane];
    o += p2 * nv[(size_t)127 * 256 + lane];
    o /= sum;
    const float gate = bf2f(gt[row * DM + hq * 64 + lane]);
    cc[row * DM + hq * 64 + lane] = f2bf(o * gate);
    {
        float tk[32], tv[32];
#pragma unroll
        for (int i = 0; i < 32; ++i) {
            const int ww = (hq & 3) + 4 * i;
            tk[i] = ck[(size_t)(ww + 1 < 128 ? ww + 1 : 127) * 256 + lane]; tv[i] = cv[(size_t)(ww + 1 < 128 ? ww + 1 : 127) * 256 + lane];
        }
#pragma unroll
        for (int i = 0; i < 32; ++i) {
            const int ww = (hq & 3) + 4 * i;
            if (ww < 127) { nk[(size_t)ww * 256 + lane] = tk[i]; nv[(size_t)ww * 256 + lane] = tv[i]; }
        }
    }
    __builtin_amdgcn_wave_barrier();
}

__device__ __forceinline__ float mix_val(const bf16_t* rw, const float* sshift, const float* mu, int r, int c) {
    const float cur = bf2f(rw[(size_t)r * SHD + c]);
    float prev;
    if (r >= TP) prev = sshift[(size_t)(r - TP) * SHD + c];
    else if ((r & 4095) == 0) prev = 0.f;
    else prev = bf2f(rw[(size_t)(r - 1) * SHD + c]);
    return cur + (prev - cur) * mu[c];
}

__device__ __forceinline__ float4 mix4(const bf16_t* rw, const float* sshift, int r, int c, float4 mu4) {
    const uint2 cu = *(const uint2*)(rw + (size_t)r * SHD + c);
    const float4 cur = make_float4(bflo(cu.x), bfhi(cu.x), bflo(cu.y), bfhi(cu.y));
    float4 prev = make_float4(0.f, 0.f, 0.f, 0.f);
    if (r >= TP) prev = *(const float4*)(sshift + (size_t)(r - TP) * SHD + c);
    else if ((r & 4095) != 0) { const uint2 pu = *(const uint2*)(rw + (size_t)(r - 1) * SHD + c); prev = make_float4(bflo(pu.x), bfhi(pu.x), bflo(pu.y), bfhi(pu.y)); }
    return make_float4(cur.x + (prev.x - cur.x) * mu4.x, cur.y + (prev.y - cur.y) * mu4.y, cur.z + (prev.z - cur.z) * mu4.z, cur.w + (prev.w - cur.w) * mu4.w);
}
__device__ __forceinline__ float decay_of(float x) {
    const float z = -x;
    const float sp = fmaxf(z, 0.f) + __logf(1.f + __expf(-fabsf(z)));
    return __expf(-__expf(-sp - 0.5f));
}

__device__ void p3_twad_item(const Params& p, int l, int tile) {
    const int tid = opq_tid();
    const bf16_t* rw = (const bf16_t*)(p.ws + WS_RW);
    const float* sshift = p.state_shift + (size_t)l * NBS * SHD;
    const float* mu = p.mu_shift + l * SHD;
    bf16_t* TWAD = (bf16_t*)(p.ws + WS_TWAD);
    const int r0 = tile * 32;
    float mm[8];
#pragma unroll
    for (int i = 0; i < 8; ++i) { const int idx = tid + 512 * i, tt = idx >> 7, c2 = idx & 127; mm[i] = mix_val(rw, sshift, mu, r0 + tt, 3072 + c2); }
#pragma unroll
    for (int i = 0; i < 8; ++i) {
        const int idx = tid + 512 * i, tt = idx >> 7, c2 = idx & 127;
        float o = mm[i];
        if (c2 < 64) { const float e = __expf(2.f * mm[i]); o = 1.f - 2.f / (e + 1.f); }
        TWAD[(size_t)(r0 + tt) * 128 + c2] = f2bf(o);
    }
}

__device__ void p3_prep_tile(const Params& p, unsigned char* lds, int l, int tile) {
    const int tid = opq_tid(), wv = tid >> 6, lane = tid & 63, n = lane & 31, h = lane >> 5;
    bf16_t* TW = (bf16_t*)lds;
    bf16_t* AD = TW + 32 * 72;
    const bf16_t* rw = (const bf16_t*)(p.ws + WS_RW);
    const float* sshift = p.state_shift + (size_t)l * NBS * SHD;
    const float* mu = p.mu_shift + l * SHD;
    bf16_t* RSB = (bf16_t*)(p.ws + WS_RSB);
    bf16_t* VALL = (bf16_t*)(p.ws + WS_VALL);
    float* RSW = (float*)(p.ws + WS_RSW);
    float* coef = (float*)(p.ws + WS_COEF);
    const int r0 = tile * 32;
    {
        float mm[8];
#pragma unroll
        for (int i = 0; i < 8; ++i) { const int idx = tid + 512 * i, tt = idx >> 7, c2 = idx & 127; mm[i] = mix_val(rw, sshift, mu, r0 + tt, 3072 + c2); }
        __builtin_amdgcn_sched_barrier(0);
#pragma unroll
        for (int i = 0; i < 8; ++i) {
            const int idx = tid + 512 * i, tt = idx >> 7, c2 = idx & 127;
            if (c2 < 64) { const float e = __expf(2.f * mm[i]); TW[tt * 72 + c2] = f2bf(1.f - 2.f / (e + 1.f)); }
            else AD[tt * 72 + (c2 - 64)] = f2bf(mm[i]);
        }
    }
    __syncthreads();
    const int col0 = wv * 128 + 4 * n;
    f32x16 acc[4];
    {
        const float* wp = p.w_decay + (size_t)l * 64 * 1024 + col0;
#pragma unroll
        for (int nt = 0; nt < 4; ++nt)
#pragma unroll
            for (int i = 0; i < 16; ++i) acc[nt][i] = 0.f;
#pragma unroll
        for (int ks = 0; ks < 4; ++ks) {
            const bf16x8 a = *(const bf16x8*)(TW + n * 72 + 16 * ks + 8 * h);
            float4 w4[8];
#pragma unroll
            for (int e = 0; e < 8; ++e) w4[e] = *(const float4*)(wp + (size_t)(16 * ks + 8 * h + e) * 1024);
            bf16x8 b0, b1, b2, b3;
#pragma unroll
            for (int e = 0; e < 8; ++e) { b0[e] = (short)f2bf(w4[e].x); b1[e] = (short)f2bf(w4[e].y); b2[e] = (short)f2bf(w4[e].z); b3[e] = (short)f2bf(w4[e].w); }
            acc[0] = __builtin_amdgcn_mfma_f32_32x32x16_bf16(a, b0, acc[0], 0, 0, 0);
            acc[1] = __builtin_amdgcn_mfma_f32_32x32x16_bf16(a, b1, acc[1], 0, 0, 0);
            acc[2] = __builtin_amdgcn_mfma_f32_32x32x16_bf16(a, b2, acc[2], 0, 0, 0);
            acc[3] = __builtin_amdgcn_mfma_f32_32x32x16_bf16(a, b3, acc[3], 0, 0, 0);
        }
        const float4 w0c = *(const float4*)(p.w0 + l * 1024 + col0);
#pragma unroll
        for (int r = 0; r < 16; ++r) {
            const int row = r0 + 8 * (r >> 2) + 4 * h + (r & 3);
            *(float4*)(RSW + (size_t)(row - TP) * 1024 + col0) =
                make_float4(decay_of(w0c.x + acc[0][r]), decay_of(w0c.y + acc[1][r]), decay_of(w0c.z + acc[2][r]), decay_of(w0c.w + acc[3][r]));
        }
    }
    {
        const float* wp = p.w_iclr + (size_t)l * 64 * 1024 + col0;
#pragma unroll
        for (int nt = 0; nt < 4; ++nt)
#pragma unroll
            for (int i = 0; i < 16; ++i) acc[nt][i] = 0.f;
#pragma unroll
        for (int ks = 0; ks < 4; ++ks) {
            const bf16x8 a = *(const bf16x8*)(AD + n * 72 + 16 * ks + 8 * h);
            float4 w4[8];
#pragma unroll
            for (int e = 0; e < 8; ++e) w4[e] = *(const float4*)(wp + (size_t)(16 * ks + 8 * h + e) * 1024);
            bf16x8 b0, b1, b2, b3;
#pragma unroll
            for (int e = 0; e < 8; ++e) { b0[e] = (short)f2bf(w4[e].x); b1[e] = (short)f2bf(w4[e].y); b2[e] = (short)f2bf(w4[e].z); b3[e] = (short)f2bf(w4[e].w); }
            acc[0] = __builtin_amdgcn_mfma_f32_32x32x16_bf16(a, b0, acc[0], 0, 0, 0);
            acc[1] = __builtin_amdgcn_mfma_f32_32x32x16_bf16(a, b1, acc[1], 0, 0, 0);
            acc[2] = __builtin_amdgcn_mfma_f32_32x32x16_bf16(a, b2, acc[2], 0, 0, 0);
            acc[3] = __builtin_amdgcn_mfma_f32_32x32x16_bf16(a, b3, acc[3], 0, 0, 0);
        }
    }
    const float4 a0c = *(const float4*)(p.a0 + l * 1024 + col0), kkc = *(const float4*)(p.k_k + l * 1024 + col0), kac = *(const float4*)(p.k_a + l * 1024 + col0), rkc = *(const float4*)(p.r_k + l * 1024 + col0);
    const float4 mur = *(const float4*)(mu + col0), muk = *(const float4*)(mu + 1024 + col0), muv = *(const float4*)(mu + 2048 + col0);
    const int head = 2 * wv + (n >> 4);
#pragma unroll
    for (int g4 = 0; g4 < 4; ++g4) {
        float4 rr4[4], kr4[4], vr4[4];
#pragma unroll
        for (int q = 0; q < 4; ++q) {
            const int row = r0 + 8 * g4 + 4 * h + q;
            rr4[q] = mix4(rw, sshift, row, col0, mur); kr4[q] = mix4(rw, sshift, row, 1024 + col0, muk); vr4[q] = mix4(rw, sshift, row, 2048 + col0, muv);
        }
        __builtin_amdgcn_sched_barrier(0);
#pragma unroll
        for (int q = 0; q < 4; ++q) {
            const int r = 4 * g4 + q;
            const int row = r0 + 8 * g4 + 4 * h + q;
            const float4 rr = rr4[q], kr = kr4[q], vr = vr4[q];
            const float ax = 1.f / (1.f + __expf(-(a0c.x + acc[0][r]))), ay = 1.f / (1.f + __expf(-(a0c.y + acc[1][r])));
            const float az = 1.f / (1.f + __expf(-(a0c.z + acc[2][r]))), aw = 1.f / (1.f + __expf(-(a0c.w + acc[3][r])));
            const float k0 = kr.x * kkc.x, k1 = kr.y * kkc.y, k2 = kr.z * kkc.z, k3 = kr.w * kkc.w;
            const float ss = allreduce16(k0 * k0 + k1 * k1 + k2 * k2 + k3 * k3);
            const float inv = 1.f / fmaxf(sqrtf(ss), 1e-12f);
            const float4 kk = make_float4(k0 * inv, k1 * inv, k2 * inv, k3 * inv);
            const float4 ke = make_float4(kr.x * (1.f + (ax - 1.f) * kac.x), kr.y * (1.f + (ay - 1.f) * kac.y), kr.z * (1.f + (az - 1.f) * kac.z), kr.w * (1.f + (aw - 1.f) * kac.w));
            const float cf = allreduce16(rr.x * ke.x * rkc.x + rr.y * ke.y * rkc.y + rr.z * ke.z * rkc.z + rr.w * ke.w * rkc.w);
            if ((n & 15) == 0) coef[(size_t)row * 16 + head] = cf;
            const size_t o = (size_t)row * 1024 + col0;
            const size_t os = (size_t)(row - TP) * 1024 + col0;
            *(uint2*)(RSB + os) = make_uint2(pack2(rr.x, rr.y), pack2(rr.z, rr.w));
            *(uint2*)(RSB + SRI + os) = make_uint2(pack2(ke.x, ke.y), pack2(ke.z, ke.w));
            *(uint2*)(RSB + 2 * SRI + os) = make_uint2(pack2(kk.x, kk.y), pack2(kk.z, kk.w));
            *(uint2*)(RSB + 3 * SRI + os) = make_uint2(pack2(kk.x * ax, kk.y * ay), pack2(kk.z * az, kk.w * aw));
            *(uint2*)(VALL + o) = make_uint2(pack2(vr.x, vr.y), pack2(vr.z, vr.w));
        }
        __builtin_amdgcn_sched_barrier(0);
    }
    __syncthreads();
}

constexpr int REC_BYTES = 14592;
constexpr int PA_WLDS = 16384;
typedef float f32x4v __attribute__((ext_vector_type(4)));

__device__ void pa_chunk(const Params& p, unsigned char* wl, int l, int ct) {
    const int lane = opq_tid() & 63;
    const int hh = ct >> 8, c = ct & 255, b = hh >> 4, h = hh & 15;
    const size_t row0 = (size_t)b * SEQ + 16 * c;
    const int col = h * 64 + lane;
    bf16_t* VALL = (bf16_t*)(p.ws + WS_VALL);
    float vv[16];
    float gC;
    bf16_t* S_AB = (bf16_t*)wl; bf16_t* S_BB = S_AB + 16 * 72; bf16_t* S_KB = S_BB + 16 * 72; bf16_t* S_RT = S_KB + 16 * 72;
    {
        const bf16_t* rw = (const bf16_t*)(p.ws + WS_RW);
        const bf16_t* TWAD = (const bf16_t*)(p.ws + WS_TWAD);
        const uint4* WFd = (const uint4*)(p.ws + WS_WFRAG) + (size_t)((l * 2 + 0) * 16 + h) * 512 + lane;
        const uint4* WFi = (const uint4*)(p.ws + WS_WFRAG) + (size_t)((l * 2 + 1) * 16 + h) * 512 + lane;
        unsigned xr[17], xk[17], xv[17];
        const bool first = (row0 & 4095) == 0;
#pragma unroll
        for (int t = 0; t < 17; ++t) {
            const unsigned ro = (unsigned)(row0 + t - 1) * (unsigned)SHD + (unsigned)col;
            if (t == 0 && first) { xr[0] = 0u; xk[0] = 0u; xv[0] = 0u; }
            else { xr[t] = rw[ro]; xk[t] = rw[ro + 1024u]; xv[t] = rw[ro + 2048u]; }
        }
        const int rr = lane & 15, kg = lane >> 4;
        f32x4v Dd[4], Da[4];
#pragma unroll
        for (int ct = 0; ct < 4; ++ct) { Dd[ct] = (f32x4v){0.f, 0.f, 0.f, 0.f}; Da[ct] = Dd[ct]; }
#pragma unroll
        for (int ks = 0; ks < 2; ++ks) {
            const bf16x8 atw = *(const bf16x8*)(TWAD + (size_t)(row0 + rr) * 128 + 32 * ks + 8 * kg);
            const bf16x8 aad = *(const bf16x8*)(TWAD + (size_t)(row0 + rr) * 128 + 64 + 32 * ks + 8 * kg);
#pragma unroll
            for (int ct = 0; ct < 4; ++ct) {
                const bf16x8 bd = __builtin_bit_cast(bf16x8, WFd[(ct * 2 + ks) * 64]);
                const bf16x8 bi = __builtin_bit_cast(bf16x8, WFi[(ct * 2 + ks) * 64]);
                Dd[ct] = __builtin_amdgcn_mfma_f32_16x16x32_bf16(atw, bd, Dd[ct], 0, 0, 0);
                Da[ct] = __builtin_amdgcn_mfma_f32_16x16x32_bf16(aad, bi, Da[ct], 0, 0, 0);
            }
        }
        float* LD = (float*)wl; float* LA = LD + 1024;
#pragma unroll
        for (int ct = 0; ct < 4; ++ct)
#pragma unroll
            for (int rg = 0; rg < 4; ++rg) { LD[(4 * kg + rg) * 64 + 16 * ct + rr] = Dd[ct][rg]; LA[(4 * kg + rg) * 64 + 16 * ct + rr] = Da[ct][rg]; }
        __builtin_amdgcn_fence(__ATOMIC_RELEASE, "wavefront"); __builtin_amdgcn_wave_barrier(); __builtin_amdgcn_fence(__ATOMIC_ACQUIRE, "wavefront");
        float din[16], ain[16];
#pragma unroll
        for (int t = 0; t < 16; ++t) { din[t] = LD[t * 64 + lane]; ain[t] = LA[t * 64 + lane]; }
        __builtin_amdgcn_fence(__ATOMIC_RELEASE, "wavefront"); __builtin_amdgcn_wave_barrier(); __builtin_amdgcn_fence(__ATOMIC_ACQUIRE, "wavefront");
        const float mur = p.mu_shift[l * SHD + col], muk = p.mu_shift[l * SHD + 1024 + col], muv = p.mu_shift[l * SHD + 2048 + col];
        const float w0c = p.w0[l * 1024 + col], a0c = p.a0[l * 1024 + col], kkc = p.k_k[l * 1024 + col], kac = p.k_a[l * 1024 + col], rkc = p.r_k[l * 1024 + col];
        float* coef = (float*)(p.ws + WS_COEF);
        float g = 1.f;
#pragma unroll
        for (int t = 0; t < 16; ++t) {
            const float cr = bf2f((unsigned short)xr[t + 1]), pr = bf2f((unsigned short)xr[t]), ck = bf2f((unsigned short)xk[t + 1]), pk = bf2f((unsigned short)xk[t]);
            const float cv = bf2f((unsigned short)xv[t + 1]), pv = bf2f((unsigned short)xv[t]);
            const float r_ = cr + (pr - cr) * mur, kr = ck + (pk - ck) * muk, vr = cv + (pv - cv) * muv;
            const float a = 1.f / (1.f + __expf(-(a0c + ain[t])));
            const float dec = decay_of(w0c + din[t]);
            const float kkr = kr * kkc;
            float ss = allreduce16(kkr * kkr); ss += __shfl_xor(ss, 16); ss += __shfl_xor(ss, 32);
            const float kkv = kkr / fmaxf(sqrtf(ss), 1e-12f);
            const float ke = kr * (1.f + (a - 1.f) * kac);
            float cf = allreduce16(r_ * ke * rkc); cf += __shfl_xor(cf, 16); cf += __shfl_xor(cf, 32);
            if (lane == 0) coef[(size_t)(row0 + t) * 16 + h] = cf;
            VALL[(unsigned)(row0 + t) * 1024u + (unsigned)col] = f2bf(vr);
            vv[t] = vr;
            S_AB[t * 72 + lane] = f2bf(-g * kkv);
            g *= dec;
            const float ig = __builtin_amdgcn_rcpf(g);
            S_BB[t * 72 + lane] = f2bf(kkv * a * ig); S_KB[t * 72 + lane] = f2bf(ke * ig); S_RT[t * 72 + lane] = f2bf(g * r_);
        }
        gC = g;
    }
    __builtin_amdgcn_fence(__ATOMIC_RELEASE, "wavefront"); __builtin_amdgcn_wave_barrier(); __builtin_amdgcn_fence(__ATOMIC_ACQUIRE, "wavefront");
    f32x4v Gab = {0.f, 0.f, 0.f, 0.f}, Gak = Gab, Grb = Gab, Grk = Gab;
    {
        const int rr = lane & 15, kg = lane >> 4;
#pragma unroll
        for (int ks = 0; ks < 2; ++ks) {
            const int o = rr * 72 + 32 * ks + 8 * kg;
            const bf16x8 fA = *(const bf16x8*)(S_AB + o), fB = *(const bf16x8*)(S_BB + o), fK = *(const bf16x8*)(S_KB + o), fR = *(const bf16x8*)(S_RT + o);
            Gab = __builtin_amdgcn_mfma_f32_16x16x32_bf16(fB, fA, Gab, 0, 0, 0);
            Gak = __builtin_amdgcn_mfma_f32_16x16x32_bf16(fK, fA, Gak, 0, 0, 0);
            Grb = __builtin_amdgcn_mfma_f32_16x16x32_bf16(fB, fR, Grb, 0, 0, 0);
            Grk = __builtin_amdgcn_mfma_f32_16x16x32_bf16(fK, fR, Grk, 0, 0, 0);
        }
    }
    __builtin_amdgcn_fence(__ATOMIC_RELEASE, "wavefront"); __builtin_amdgcn_wave_barrier(); __builtin_amdgcn_fence(__ATOMIC_ACQUIRE, "wavefront");
    float* M_AB = (float*)(wl + 9216); float* M_AK = M_AB + 256; float* M_RB = M_AK + 256; float* M_RK = M_RB + 256; float* T_ = M_RK + 256; float* Q_ = T_ + 256; float* W2_ = Q_ + 256;
    {
        const int t = lane & 15, kg = lane >> 4;
#pragma unroll
        for (int rg = 0; rg < 4; ++rg) {
            const int s = 4 * kg + rg;
            M_AB[s * 16 + t] = s < t ? Gab[rg] : 0.f; M_AK[s * 16 + t] = s < t ? Gak[rg] : 0.f;
            M_RB[s * 16 + t] = s <= t ? Grb[rg] : 0.f; M_RK[s * 16 + t] = s <= t ? Grk[rg] : 0.f;
        }
    }
    __builtin_amdgcn_fence(__ATOMIC_RELEASE, "wavefront"); __builtin_amdgcn_wave_barrier(); __builtin_amdgcn_fence(__ATOMIC_ACQUIRE, "wavefront");
    {
        const int rr = lane & 15;
        float Tr[16];
#pragma unroll
        for (int t = 0; t < 16; ++t) {
            float acc = (rr == t) ? 1.f : 0.f;
#pragma unroll
            for (int s = 0; s < t; ++s) acc += Tr[s] * M_AB[s * 16 + t];
            Tr[t] = acc;
        }
#pragma unroll
        for (int t = 0; t < 16; ++t) T_[rr * 16 + t] = Tr[t];
    }
    __builtin_amdgcn_fence(__ATOMIC_RELEASE, "wavefront"); __builtin_amdgcn_wave_barrier(); __builtin_amdgcn_fence(__ATOMIC_ACQUIRE, "wavefront");
    {
        const int s = lane & 15, tq = lane >> 4;
        float4 q = make_float4(0.f, 0.f, 0.f, 0.f);
#pragma unroll
        for (int u = 0; u < 16; ++u) { const float a = M_AK[s * 16 + u]; const float4 t4 = *(const float4*)(T_ + u * 16 + 4 * tq); q.x += a * t4.x; q.y += a * t4.y; q.z += a * t4.z; q.w += a * t4.w; }
        *(float4*)(Q_ + s * 16 + 4 * tq) = q;
        __builtin_amdgcn_fence(__ATOMIC_RELEASE, "wavefront"); __builtin_amdgcn_wave_barrier(); __builtin_amdgcn_fence(__ATOMIC_ACQUIRE, "wavefront");
        float4 w2 = *(const float4*)(M_RK + s * 16 + 4 * tq);
#pragma unroll
        for (int u = 0; u < 16; ++u) { const float a = Q_[s * 16 + u]; const float4 m4 = *(const float4*)(M_RB + u * 16 + 4 * tq); w2.x += a * m4.x; w2.y += a * m4.y; w2.z += a * m4.z; w2.w += a * m4.w; }
        *(float4*)(W2_ + s * 16 + 4 * tq) = w2;
    }
    __builtin_amdgcn_fence(__ATOMIC_RELEASE, "wavefront"); __builtin_amdgcn_wave_barrier(); __builtin_amdgcn_fence(__ATOMIC_ACQUIRE, "wavefront");
    cvt_f32x2 pt2[8], r22[8], ul2[8], yl2[8];
#pragma unroll
    for (int t = 0; t < 8; ++t) { pt2[t] = (cvt_f32x2){0.f, 0.f}; r22[t] = (cvt_f32x2){bf2f(S_RT[(2 * t) * 72 + lane]), bf2f(S_RT[(2 * t + 1) * 72 + lane])}; ul2[t] = pt2[t]; yl2[t] = pt2[t]; }
#pragma unroll
    for (int s = 0; s < 16; ++s) {
        const float as_ = bf2f(S_AB[s * 72 + lane]), vs_ = vv[s];
        const cvt_f32x2 as2 = {as_, as_}, vs2 = {vs_, vs_};
#pragma unroll
        for (int tq = 0; tq < 4; ++tq) {
            const float4 t4 = *(const float4*)(T_ + s * 16 + 4 * tq), q4 = *(const float4*)(Q_ + s * 16 + 4 * tq), w4 = *(const float4*)(W2_ + s * 16 + 4 * tq);
            pt2[2 * tq] += (cvt_f32x2){t4.x, t4.y} * as2; pt2[2 * tq + 1] += (cvt_f32x2){t4.z, t4.w} * as2;
            ul2[2 * tq] += (cvt_f32x2){q4.x, q4.y} * vs2; ul2[2 * tq + 1] += (cvt_f32x2){q4.z, q4.w} * vs2;
            yl2[2 * tq] += (cvt_f32x2){w4.x, w4.y} * vs2; yl2[2 * tq + 1] += (cvt_f32x2){w4.z, w4.w} * vs2;
        }
        __builtin_amdgcn_sched_barrier(0);
    }
    float pt[16], ul[16], yl[16];
#pragma unroll
    for (int t = 0; t < 8; ++t) { pt[2 * t] = pt2[t].x; pt[2 * t + 1] = pt2[t].y; ul[2 * t] = ul2[t].x; ul[2 * t + 1] = ul2[t].y; yl[2 * t] = yl2[t].x; yl[2 * t + 1] = yl2[t].y; }
#pragma unroll
    for (int s = 0; s < 16; ++s) {
        const cvt_f32x2 ps2 = {pt[s], pt[s]};
#pragma unroll
        for (int tq = 0; tq < 4; ++tq) {
            const float4 m4 = *(const float4*)(M_RB + s * 16 + 4 * tq);
            r22[2 * tq] += (cvt_f32x2){m4.x, m4.y} * ps2; r22[2 * tq + 1] += (cvt_f32x2){m4.z, m4.w} * ps2;
        }
        __builtin_amdgcn_sched_barrier(0);
    }
    float r2[16];
#pragma unroll
    for (int t = 0; t < 8; ++t) { r2[2 * t] = r22[t].x; r2[2 * t + 1] = r22[t].y; }
    unsigned char* rec = p.ws + WS_REC + (size_t)ct * REC_BYTES;
    float* ys = (float*)(p.ws + WS_YS);
    {
#pragma unroll
        for (int t = 0; t < 16; ++t) { S_AB[t * 72 + lane] = f2bf(pt[t]); S_RT[t * 72 + lane] = f2bf(r2[t]); }
        __builtin_amdgcn_fence(__ATOMIC_RELEASE, "wavefront"); __builtin_amdgcn_wave_barrier(); __builtin_amdgcn_fence(__ATOMIC_ACQUIRE, "wavefront");
#pragma unroll
        for (int i2 = 0; i2 < 2; ++i2) {
            const int q = lane + 64 * i2, f = q >> 5, hf = (q >> 4) & 1, t = q & 15;
            const uint2 a0 = *(const uint2*)(S_AB + t * 72 + 16 * f + 4 * hf), a1 = *(const uint2*)(S_AB + t * 72 + 16 * f + 8 + 4 * hf);
            const uint2 c0 = *(const uint2*)(S_RT + t * 72 + 16 * f + 4 * hf), c1 = *(const uint2*)(S_RT + t * 72 + 16 * f + 8 + 4 * hf);
            st_sc1_b128(rec + q * 16, a0.x, a0.y, a1.x, a1.y);
            st_sc1_b128(rec + 2048 + q * 16, c0.x, c0.y, c1.x, c1.y);
        }
        {
            float* YT = (float*)(wl + 9216);
#pragma unroll
            for (int t = 0; t < 16; ++t) YT[t * 64 + lane] = yl[t];
            __builtin_amdgcn_fence(__ATOMIC_RELEASE, "wavefront"); __builtin_amdgcn_wave_barrier(); __builtin_amdgcn_fence(__ATOMIC_ACQUIRE, "wavefront");
#pragma unroll
            for (int i4 = 0; i4 < 4; ++i4) {
                const int idx = lane + 64 * i4, t = idx >> 4, q4 = idx & 15;
                const float4 y4 = *(const float4*)(YT + t * 64 + 4 * q4);
                st_sc1_b128(ys + (unsigned)(row0 + t) * 1024u + (unsigned)(h * 64 + 4 * q4), __float_as_uint(y4.x), __float_as_uint(y4.y), __float_as_uint(y4.z), __float_as_uint(y4.w));
            }
        }
    }
    {
        float gb[16], gk[16];
#pragma unroll
        for (int t = 0; t < 16; ++t) { gb[t] = gC * bf2f(S_BB[t * 72 + lane]); gk[t] = gC * bf2f(S_KB[t * 72 + lane]); }
        st_sc1_b128(rec + 4096 + lane * 16, pack2(gb[0], gb[1]), pack2(gb[2], gb[3]), pack2(gb[8], gb[9]), pack2(gb[10], gb[11]));
        st_sc1_b128(rec + 4096 + (64 + lane) * 16, pack2(gb[4], gb[5]), pack2(gb[6], gb[7]), pack2(gb[12], gb[13]), pack2(gb[14], gb[15]));
        st_sc1_b128(rec + 6144 + lane * 16, pack2(gk[0], gk[1]), pack2(gk[2], gk[3]), pack2(gk[4], gk[5]), pack2(gk[6], gk[7]));
        st_sc1_b128(rec + 6144 + (64 + lane) * 16, pack2(gk[8], gk[9]), pack2(gk[10], gk[11]), pack2(gk[12], gk[13]), pack2(gk[14], gk[15]));
        st_sc1_b32(rec + 8192 + lane * 4, gC);
        unsigned char* ip = rec + 8448 + (lane >> 5) * 3072;
        const int il = lane & 31;
        st_sc1_b128(ip + il * 16, pack2(vv[0], vv[1]), pack2(vv[2], vv[3]), pack2(vv[4], vv[5]), pack2(vv[6], vv[7]));
        st_sc1_b128(ip + (32 + il) * 16, pack2(vv[8], vv[9]), pack2(vv[10], vv[11]), pack2(vv[12], vv[13]), pack2(vv[14], vv[15]));
#pragma unroll
        for (int tq = 0; tq < 4; ++tq) st_sc1_b128(ip + 1024 + (((tq >> 1) * 2 + (tq & 1)) * 32 + il) * 16, __float_as_uint(ul[4 * tq]), __float_as_uint(ul[4 * tq + 1]), __float_as_uint(ul[4 * tq + 2]), __float_as_uint(ul[4 * tq + 3]));
    }
    asm volatile("s_waitcnt vmcnt(0)" ::: "memory");
    if (lane == 0) __hip_atomic_store((unsigned*)(p.ws + WS_RFLAG + (size_t)ct * 64), (unsigned)(l + 1), __ATOMIC_RELAXED, __HIP_MEMORY_SCOPE_AGENT);
    __builtin_amdgcn_fence(__ATOMIC_RELEASE, "wavefront"); __builtin_amdgcn_wave_barrier();
}

__device__ void pa_sample_task(const Params& p, int l, int task) {
    const int lane = opq_tid() & 63;
    const int bd = task >> 8, h = (task >> 4) & 15, wq = task & 15;
    const int irow = 4 * wq + (lane >> 4), jq = lane & 15;
    const size_t row = (size_t)TP + bd;
    const bf16_t* RSB = (const bf16_t*)(p.ws + WS_RSB);
    const float* RSW = (const float*)(p.ws + WS_RSW);
    const bf16_t* VALL = (const bf16_t*)(p.ws + WS_VALL);
    float* ys = (float*)(p.ws + WS_YS);
    const size_t so = (((size_t)(l * NBS + bd) * 16 + h) * 64 + irow) * 64 + 4 * jq;
    float4 s = *(const float4*)(p.state_wkv + so);
    const size_t o = row * 1024 + h * 64 + 4 * jq;
    const size_t os = (size_t)bd * 1024 + h * 64 + 4 * jq;
    const uint2 ur = *(const uint2*)(RSB + os), uk = *(const uint2*)(RSB + SRI + os), ukk = *(const uint2*)(RSB + 2 * SRI + os), ub = *(const uint2*)(RSB + 3 * SRI + os);
    const float4 w4 = *(const float4*)(RSW + os);
    const float v = bf2f(VALL[row * 1024 + h * 64 + irow]);
    float pa = s.x * bflo(ukk.x) + s.y * bfhi(ukk.x) + s.z * bflo(ukk.y) + s.w * bfhi(ukk.y);
    pa = allreduce16(pa);
    const float sa = -pa;
    s.x = fmaf(sa, bflo(ub.x), fmaf(s.x, w4.x, v * bflo(uk.x)));
    s.y = fmaf(sa, bfhi(ub.x), fmaf(s.y, w4.y, v * bfhi(uk.x)));
    s.z = fmaf(sa, bflo(ub.y), fmaf(s.z, w4.z, v * bflo(uk.y)));
    s.w = fmaf(sa, bfhi(ub.y), fmaf(s.w, w4.w, v * bfhi(uk.y)));
    float py = s.x * bflo(ur.x) + s.y * bfhi(ur.x) + s.z * bflo(ur.y) + s.w * bfhi(ur.y);
    py = allreduce16(py);
    *(float4*)(p.out + O_WKVS + so) = s;
    if (jq == 0) ys[row * 1024 + h * 64 + irow] = py;
}

__device__ __forceinline__ uint4 ld_sc1_b128(const unsigned char* p) {
    const unsigned long long a = __hip_atomic_load((const unsigned long long*)p, __ATOMIC_RELAXED, __HIP_MEMORY_SCOPE_AGENT), c = __hip_atomic_load((const unsigned long long*)(p + 8), __ATOMIC_RELAXED, __HIP_MEMORY_SCOPE_AGENT);
    return make_uint4((unsigned)a, (unsigned)(a >> 32), (unsigned)c, (unsigned)(c >> 32));
}
constexpr int PB_NB = 8, PB_SLOT = 13568, PB_NCH = SEQ / 16, PB_NX = 4, PB_XOFF = PB_NB * PB_SLOT  , PB_FOFF = PB_XOFF + PB_NX * 4096;
__device__ void pb_head(const Params& p, unsigned char* lds, int l, int blk, bool dry) {
    const int tid = opq_tid(), wv = tid >> 6, lane = tid & 63;
    const int hh = blk >> 1, it = blk & 1, b = hh >> 4, h = hh & 15;
    volatile LAS unsigned* flags = (volatile LAS unsigned*)((LAS unsigned char*)lds + PB_FOFF);
    if (tid < 16) flags[tid] = 0u;
    __syncthreads();
    const unsigned char* rec0 = p.ws + WS_REC + (size_t)(hh * 256) * REC_BYTES;
    float* ys = (float*)(p.ws + WS_YS) + ((size_t)b * SEQ) * 1024 + h * 64 + 32 * it;
    const int q32 = lane & 31, hf = lane >> 5;
    if (wv >= 2) {
        unsigned nf = __hip_atomic_load((const unsigned*)(p.ws + WS_RFLAG + (size_t)(hh * 256 + (wv - 2)) * 64), __ATOMIC_RELAXED, __HIP_MEMORY_SCOPE_AGENT);
#pragma unroll 1
        for (int c = wv - 2; c < PB_NCH; c += 6) {
            while (c - (int)flags[8] >= PB_NB || c - (int)flags[9] >= PB_NB) __builtin_amdgcn_s_sleep(8);
            asm volatile("" ::: "memory");
            {
                const unsigned* rf = (const unsigned*)(p.ws + WS_RFLAG + (size_t)(hh * 256 + c) * 64);
                while (nf != (unsigned)(l + 1)) { __builtin_amdgcn_s_sleep(2); nf = __hip_atomic_load(rf, __ATOMIC_RELAXED, __HIP_MEMORY_SCOPE_AGENT); }
                asm volatile("" ::: "memory");
            }
            const unsigned char* rec = rec0 + (size_t)c * REC_BYTES;
            unsigned char* sl = lds + (c % PB_NB) * PB_SLOT;
            const unsigned char* rc = rec + lane * 16;
            const unsigned char* ri = rec + 8448 + it * 3072 + lane * 16;
#define LD_SC1(p_) ld_sc1_b128((const unsigned char*)(p_))
            const uint4 d0 = LD_SC1(rc), d1 = LD_SC1(rc + 1024), d2 = LD_SC1(rc + 2048), d3 = LD_SC1(rc + 3072);
            const uint4 d4 = LD_SC1(rc + 4096), d5 = LD_SC1(rc + 5120), d6 = LD_SC1(rc + 6144), d7 = LD_SC1(rc + 7168);
            const uint4 d8 = LD_SC1(rec + 8192 + (lane & 15) * 16);
            const uint4 d9 = LD_SC1(ri), d10 = LD_SC1(ri + 1024), d11 = LD_SC1(ri + 2048);
            const int t0 = lane >> 3, cc = lane & 7;
            const uint4 d12 = LD_SC1(ys + (size_t)(16 * c + t0) * 1024 + cc * 4), d13 = LD_SC1(ys + (size_t)(16 * c + 8 + t0) * 1024 + cc * 4);
#undef LD_SC1
            nf = (c + 6 < PB_NCH) ? __hip_atomic_load((const unsigned*)(p.ws + WS_RFLAG + (size_t)(hh * 256 + c + 6) * 64), __ATOMIC_RELAXED, __HIP_MEMORY_SCOPE_AGENT) : 0u;
            __builtin_amdgcn_sched_barrier(0);
            unsigned char* sd = sl + lane * 16;
            *(uint4*)(sd) = d0; *(uint4*)(sd + 1024) = d1; *(uint4*)(sd + 2048) = d2; *(uint4*)(sd + 3072) = d3;
            *(uint4*)(sd + 4096) = d4; *(uint4*)(sd + 5120) = d5; *(uint4*)(sd + 6144) = d6; *(uint4*)(sd + 7168) = d7;
            if (lane < 16) *(uint4*)(sl + 8192 + lane * 16) = d8;
            *(uint4*)(sd + 8448) = d9; *(uint4*)(sd + 9472) = d10; *(uint4*)(sd + 10496) = d11;
            {
                float* yd = (float*)(sl + 11520) + ((((t0 >> 2) & 1) * 32 + 4 * cc) * 4 + (t0 & 3));
                yd[0] = __uint_as_float(d12.x); yd[4] = __uint_as_float(d12.y); yd[8] = __uint_as_float(d12.z); yd[12] = __uint_as_float(d12.w);
                yd[256] = __uint_as_float(d13.x); yd[260] = __uint_as_float(d13.y); yd[264] = __uint_as_float(d13.z); yd[268] = __uint_as_float(d13.w);
            }
            asm volatile("" ::: "memory");
            if (lane == 0) flags[c % PB_NB] = (unsigned)(c + 1);
        }
    } else if (wv == 1) {
        bf16x8 ra0, ra1, ra2, ra3; float4 y0, y1;
#define PB_FETCHY(c_) do { const unsigned char* sl_ = lds + ((c_) % PB_NB) * PB_SLOT; \
            while (flags[(c_) % PB_NB] != (unsigned)((c_) + 1)) __builtin_amdgcn_s_sleep(0); \
            asm volatile("" ::: "memory"); \
            const unsigned char* pr_ = sl_ + 2048 + (hf * 16 + (q32 & 15)) * 16; \
            ra0 = *(const bf16x8*)(pr_); ra1 = *(const bf16x8*)(pr_ + 512); ra2 = *(const bf16x8*)(pr_ + 1024); ra3 = *(const bf16x8*)(pr_ + 1536); \
            y0 = *(const float4*)(sl_ + 11520 + (hf * 32 + q32) * 16); y1 = *(const float4*)(sl_ + 11520 + ((2 + hf) * 32 + q32) * 16); \
            asm volatile("" ::: "memory"); \
            if (lane == 0) flags[9] = (unsigned)((c_) + 1); } while (0)
        PB_FETCHY(0);
#pragma unroll 1
        for (int c = 0; c < PB_NCH; ++c) {
            const unsigned char* xr = lds + PB_XOFF + (c % PB_NX) * 4096 + lane * 16;
            f32x16 Ya, Yb;
            Ya[0] = y0.x; Ya[1] = y0.y; Ya[2] = y0.z; Ya[3] = y0.w; Ya[4] = y1.x; Ya[5] = y1.y; Ya[6] = y1.z; Ya[7] = y1.w;
#pragma unroll
            for (int r = 8; r < 16; ++r) Ya[r] = 0.f;
#pragma unroll
            for (int r = 0; r < 16; ++r) Yb[r] = 0.f;
            const bf16x8 rc0 = ra0, rc1 = ra1, rc2 = ra2, rc3 = ra3;
            while (flags[10 + (c % PB_NX)] != (unsigned)(c + 1)) __builtin_amdgcn_s_sleep(0);
            asm volatile("" ::: "memory");
            const bf16x8 xf0 = *(const bf16x8*)(xr), xf1 = *(const bf16x8*)(xr + 1024), xf2 = *(const bf16x8*)(xr + 2048), xf3 = *(const bf16x8*)(xr + 3072);
            asm volatile("" ::: "memory");
            if (lane == 0) flags[14] = (unsigned)(c + 1);
            Ya = __builtin_amdgcn_mfma_f32_32x32x16_bf16(rc0, xf0, Ya, 0, 0, 0);
            Yb = __builtin_amdgcn_mfma_f32_32x32x16_bf16(rc1, xf1, Yb, 0, 0, 0);
            Ya = __builtin_amdgcn_mfma_f32_32x32x16_bf16(rc2, xf2, Ya, 0, 0, 0);
            Yb = __builtin_amdgcn_mfma_f32_32x32x16_bf16(rc3, xf3, Yb, 0, 0, 0);
            if (c + 1 < PB_NCH) PB_FETCHY(c + 1);
            float* yc = ys + (size_t)c * (16 * 1024);
            if (!dry) {
#pragma unroll
                for (int r = 0; r < 8; ++r) yc[(8 * (r >> 2) + 4 * hf + (r & 3)) * 1024 + q32] = Ya[r] + Yb[r];
            }
        }
#undef PB_FETCHY
    } else {
        f32x16 X0, X1;
#pragma unroll
        for (int i = 0; i < 16; ++i) { X0[i] = 0.f; X1[i] = 0.f; }
        bf16x8 pa0, pa1, pa2, pa3, gb0, gb1, gk0, gk1, vf;
        float4 gm0, gm1, gm2, gm3, gm4, gm5, gm6, gm7, u0, u1;
#define PB_FETCH(c_) do { const unsigned char* sl_ = lds + ((c_) % PB_NB) * PB_SLOT; \
            { unsigned rv_ = rdy; while (rv_ != (unsigned)((c_) + 1)) { __builtin_amdgcn_s_sleep(0); rv_ = flags[(c_) % PB_NB]; } } \
            asm volatile("" ::: "memory"); \
            const unsigned char* pr_ = sl_ + (hf * 16 + (q32 & 15)) * 16; \
            pa0 = *(const bf16x8*)(pr_); pa1 = *(const bf16x8*)(pr_ + 512); pa2 = *(const bf16x8*)(pr_ + 1024); pa3 = *(const bf16x8*)(pr_ + 1536); \
            gb0 = *(const bf16x8*)(sl_ + 4096 + (hf * 64 + q32) * 16); gb1 = *(const bf16x8*)(sl_ + 4096 + (hf * 64 + 32 + q32) * 16); \
            gk0 = *(const bf16x8*)(sl_ + 6144 + (hf * 64 + q32) * 16); gk1 = *(const bf16x8*)(sl_ + 6144 + (hf * 64 + 32 + q32) * 16); \
            vf = *(const bf16x8*)(sl_ + 8448 + (hf * 32 + q32) * 16); \
            const unsigned char* gp_ = sl_ + 8192 + 16 * hf; \
            gm0 = *(const float4*)(gp_); gm1 = *(const float4*)(gp_ + 32); gm2 = *(const float4*)(gp_ + 64); gm3 = *(const float4*)(gp_ + 96); \
            gm4 = *(const float4*)(gp_ + 128); gm5 = *(const float4*)(gp_ + 160); gm6 = *(const float4*)(gp_ + 192); gm7 = *(const float4*)(gp_ + 224); \
            u0 = *(const float4*)(sl_ + 9472 + (hf * 32 + q32) * 16); u1 = *(const float4*)(sl_ + 9472 + ((2 + hf) * 32 + q32) * 16); \
            asm volatile("" ::: "memory"); \
            if (lane == 0) flags[8] = (unsigned)((c_) + 1); } while (0)
        unsigned rdy = flags[0];
        PB_FETCH(0);
        int xfree = 0;
#pragma unroll 1
        for (int c = 0; c < PB_NCH; ++c) {
            unsigned char* xw = lds + PB_XOFF + (c % PB_NX) * 4096 + lane * 16;
            rdy = flags[(c + 1) % PB_NB];
            const bf16x8 xb0 = __builtin_bit_cast(bf16x8, make_uint4(pack2(X0[0], X0[1]), pack2(X0[2], X0[3]), pack2(X0[4], X0[5]), pack2(X0[6], X0[7])));
            const bf16x8 xb1 = __builtin_bit_cast(bf16x8, make_uint4(pack2(X0[8], X0[9]), pack2(X0[10], X0[11]), pack2(X0[12], X0[13]), pack2(X0[14], X0[15])));
            const bf16x8 xb2 = __builtin_bit_cast(bf16x8, make_uint4(pack2(X1[0], X1[1]), pack2(X1[2], X1[3]), pack2(X1[4], X1[5]), pack2(X1[6], X1[7])));
            const bf16x8 xb3 = __builtin_bit_cast(bf16x8, make_uint4(pack2(X1[8], X1[9]), pack2(X1[10], X1[11]), pack2(X1[12], X1[13]), pack2(X1[14], X1[15])));
            f32x16 Ua, Ub;
            Ua[0] = u0.x; Ua[1] = u0.y; Ua[2] = u0.z; Ua[3] = u0.w; Ua[4] = u1.x; Ua[5] = u1.y; Ua[6] = u1.z; Ua[7] = u1.w;
#pragma unroll
            for (int r = 8; r < 16; ++r) Ua[r] = 0.f;
#pragma unroll
            for (int r = 0; r < 16; ++r) Ub[r] = 0.f;
            Ua = __builtin_amdgcn_mfma_f32_32x32x16_bf16(pa0, xb0, Ua, 0, 0, 0);
            Ub = __builtin_amdgcn_mfma_f32_32x32x16_bf16(pa1, xb1, Ub, 0, 0, 0);
            Ua = __builtin_amdgcn_mfma_f32_32x32x16_bf16(pa2, xb2, Ua, 0, 0, 0);
            Ub = __builtin_amdgcn_mfma_f32_32x32x16_bf16(pa3, xb3, Ub, 0, 0, 0);
            f32x16 Xn0, Xn1;
            Xn0[0] = X0[0] * gm0.x; Xn0[1] = X0[1] * gm0.y; Xn0[2] = X0[2] * gm0.z; Xn0[3] = X0[3] * gm0.w; Xn0[4] = X0[4] * gm1.x; Xn0[5] = X0[5] * gm1.y; Xn0[6] = X0[6] * gm1.z; Xn0[7] = X0[7] * gm1.w;
            Xn0[8] = X0[8] * gm2.x; Xn0[9] = X0[9] * gm2.y; Xn0[10] = X0[10] * gm2.z; Xn0[11] = X0[11] * gm2.w; Xn0[12] = X0[12] * gm3.x; Xn0[13] = X0[13] * gm3.y; Xn0[14] = X0[14] * gm3.z; Xn0[15] = X0[15] * gm3.w;
            Xn1[0] = X1[0] * gm4.x; Xn1[1] = X1[1] * gm4.y; Xn1[2] = X1[2] * gm4.z; Xn1[3] = X1[3] * gm4.w; Xn1[4] = X1[4] * gm5.x; Xn1[5] = X1[5] * gm5.y; Xn1[6] = X1[6] * gm5.z; Xn1[7] = X1[7] * gm5.w;
            Xn1[8] = X1[8] * gm6.x; Xn1[9] = X1[9] * gm6.y; Xn1[10] = X1[10] * gm6.z; Xn1[11] = X1[11] * gm6.w; Xn1[12] = X1[12] * gm7.x; Xn1[13] = X1[13] * gm7.y; Xn1[14] = X1[14] * gm7.z; Xn1[15] = X1[15] * gm7.w;
            Xn0 = __builtin_amdgcn_mfma_f32_32x32x16_bf16(gk0, vf, Xn0, 0, 0, 0);
            Xn1 = __builtin_amdgcn_mfma_f32_32x32x16_bf16(gk1, vf, Xn1, 0, 0, 0);
            const bf16x8 gbc0 = gb0, gbc1 = gb1;
            while (c - xfree >= PB_NX) { xfree = (int)flags[14]; }
            asm volatile("" ::: "memory");
            *(bf16x8*)(xw) = xb0; *(bf16x8*)(xw + 1024) = xb1; *(bf16x8*)(xw + 2048) = xb2; *(bf16x8*)(xw + 3072) = xb3;
            asm volatile("" ::: "memory");
            if (lane == 0) flags[10 + (c % PB_NX)] = (unsigned)(c + 1);
            if (c + 1 < PB_NCH) PB_FETCH(c + 1);
            const bf16x8 ub = __builtin_bit_cast(bf16x8, make_uint4(pack2(Ua[0] + Ub[0], Ua[1] + Ub[1]), pack2(Ua[2] + Ub[2], Ua[3] + Ub[3]), pack2(Ua[4] + Ub[4], Ua[5] + Ub[5]), pack2(Ua[6] + Ub[6], Ua[7] + Ub[7])));
            X0 = __builtin_amdgcn_mfma_f32_32x32x16_bf16(gbc0, ub, Xn0, 0, 0, 0);
            X1 = __builtin_amdgcn_mfma_f32_32x32x16_bf16(gbc1, ub, Xn1, 0, 0, 0);
        }
#undef PB_FETCH
        float* so = p.out + O_WKVP + ((size_t)(l * NBP + b) * 16 + h) * 4096 + (size_t)(32 * it + q32) * 64;
#pragma unroll
        for (int g = 0; g < 4; ++g) {
            *(float4*)(so + 8 * g + 4 * hf) = make_float4(X0[4 * g], X0[4 * g + 1], X0[4 * g + 2], X0[4 * g + 3]);
            *(float4*)(so + 32 + 8 * g + 4 * hf) = make_float4(X1[4 * g], X1[4 * g + 1], X1[4 * g + 2], X1[4 * g + 3]);
        }
    }
    __syncthreads();
}

__device__ void p3_post(const Params& p, int l, int bid, int G) {
    const int tid = opq_tid(), wv = tid >> 6, lane = tid & 63;
    const float* ys = (const float*)(p.ws + WS_YS);
    const bf16_t* V = (const bf16_t*)(p.ws + WS_VALL);
    const float* coef = (const float*)(p.ws + WS_COEF);
    const bf16_t* gt = (const bf16_t*)(p.ws + WS_GT);
    bf16_t* cc = (bf16_t*)(p.ws + WS_HB);
    for (int r = bid * 8 + wv; r < MT; r += G * 8) {
        float4 y4[4]; uint2 vu4[4], gg4[4]; float cf4[4];
#pragma unroll
        for (int hg = 0; hg < 4; ++hg) {
            const int head = 4 * hg + (lane >> 4), c = head * 64 + 4 * (lane & 15);
            y4[hg] = *(const float4*)(ys + (size_t)r * 1024 + c);
            vu4[hg] = *(const uint2*)(V + (size_t)r * 1024 + c);
            cf4[hg] = coef[(size_t)r * 16 + head];
            gg4[hg] = *(const uint2*)(gt + (size_t)r * DM + 1024 + c);
        }
        __builtin_amdgcn_sched_barrier(0);
#pragma unroll
        for (int hg = 0; hg < 4; ++hg) {
            const int head = 4 * hg + (lane >> 4), c = head * 64 + 4 * (lane & 15);
            const float4 y = y4[hg];
            const float mu = allreduce16(y.x + y.y + y.z + y.w) * (1.f / 64.f);
            const float d0 = y.x - mu, d1 = y.y - mu, d2 = y.z - mu, d3 = y.w - mu;
            const float var = allreduce16(d0 * d0 + d1 * d1 + d2 * d2 + d3 * d3) * (1.f / 64.f);
            const float rs = rsqrtf(var + 64e-5f);
            const float4 lw = *(const float4*)(p.ln_w + l * 1024 + c), lb = *(const float4*)(p.ln_b + l * 1024 + c);
            const uint2 vu = vu4[hg];
            const float4 v4 = make_float4(bflo(vu.x), bfhi(vu.x), bflo(vu.y), bfhi(vu.y));
            const float cf = cf4[hg];
            const uint2 gg = gg4[hg];
            const float o0 = (d0 * rs * lw.x + lb.x + cf * v4.x) * bflo(gg.x), o1 = (d1 * rs * lw.y + lb.y + cf * v4.y) * bfhi(gg.x);
            const float o2 = (d2 * rs * lw.z + lb.z + cf * v4.z) * bflo(gg.y), o3 = (d3 * rs * lw.w + lb.w + cf * v4.w) * bfhi(gg.y);
            *(uint2*)(cc + (size_t)r * DM + 1024 + c) = make_uint2(pack2(o0, o1), pack2(o2, o3));
        }
    }
}

__device__ void p_final(const Params& p, int bid, int G) {
    const int tid = opq_tid(), wv = tid >> 6, lane = tid & 63;
    const float4* g4 = (const float4*)p.final_g;
    for (int r = bid * 8 + wv; r < MT; r += G * 8) {
        float4* xr = (float4*)(p.out + (size_t)r * DM);
        float4 v[8]; float ss = 0.f;
#pragma unroll
        for (int i = 0; i < 8; ++i) { v[i] = xr[lane + 64 * i]; ss += v[i].x * v[i].x + v[i].y * v[i].y + v[i].z * v[i].z + v[i].w * v[i].w; }
        ss = wave_sum(ss);
        const float rinv = rsqrtf(ss * (1.f / 2048.f) + 1e-5f);
#pragma unroll
        for (int i = 0; i < 8; ++i) { const float4 g = g4[lane + 64 * i]; xr[lane + 64 * i] = make_float4(v[i].x * rinv * g.x, v[i].y * rinv * g.y, v[i].z * rinv * g.z, v[i].w * rinv * g.w); }
    }
}

#ifndef REPL
#define REPL -1
#endif
#ifndef REPK
#define REPK -100
#endif
__global__ void __launch_bounds__(512, 2) fwd_kernel(Params p_unused) {
    extern __shared__ __attribute__((aligned(16))) unsigned char shm[];
    cg::grid_group grid = cg::this_grid();
    const int bid0 = blockIdx.x, G0 = gridDim.x;
    float* shf = (float*)shm;
    volatile LAS unsigned* xst = (volatile LAS unsigned*)((LAS unsigned char*)shm + 131072);
    if (threadIdx.x == 0) { xst[0] = 0u; xst[1] = 0u; }
    __syncthreads();
    const XcdBarrier xb = xcd_barrier_post((unsigned*)(kparams().ws + WS_BAR), xst);
    if (G0 == 0x7fffffff) grid.sync();

#pragma unroll 1
    for (int ph = 0; ph < 14; ++ph) {
        const int bid = opq_s(bid0), G = opq_s(G0);
        const int l = ph >= 7 ? 1 : 0, k = ph == 0 ? -1 : (ph == 13 ? 6 : (ph - 1) - 6 * l);
#pragma unroll 1
        for (int rep = 0; rep < ((k == kparams().repk && (kparams().repl < 0 || kparams().repl == l)) ? 2 : 1); ++rep) {
        if (k == -1) {
            for (int it = bid; it < 384; it += G) p0_mod_item(kparams(), shf, it / 192, it % 192);
            for (int it = bid; it < 17; it += G) p0_rope_item(kparams(), it);
            for (int it = bid; it < 64; it += G) p0_wfrag_item(kparams(), it);
            {
                if (bid < 128) p0_conv_all(kparams(), shf, bid, 128, 1024, 0);
                else p0_conv_all(kparams(), shf, 1024 + (bid - 128), G - 128, 2752, 0);
            }
        } else if (k == 0) {
            p1_norm(kparams(), l, bid, G);
        } else if (k == 1) {
            pg8::StaticOrder S; S.init(MP, INWP, G, bid);
            pg8::Gemm g{(const bf16_t*)(kparams().ws + WS_HB), (const bf16_t*)(kparams().ws + WS_WTIN), MP, INWP, DM};
            Epi1 E{l};
            pg8::gemm_phase<Epi1, pg8::StaticOrder, false>((PG8_LAS unsigned char*)shm, g, S, E, nullptr);
        } else if (k == 2) {
            for (int it = bid; it < 256 + 256 + 1 + 64; it += G) {
                if (it < 256) p3_attn_unit(kparams(), shm, l, it);
                else if (it < 512) p3_twad_item(kparams(), l, it - 256);
                else if (it == 512) p3_prep_tile(kparams(), shm, l, 256);
                else p3_sattn_item(kparams(), shf, l, it - 513);
            }
            __syncthreads();
            if (l == 0) p0_conv_all(kparams(), shf, bid, G, 1728, 1);
        } else if (k == 3) {
            {
                const int wvq = opq_tid() >> 6;
                int i2 = bid < 64 ? bid * 8 + wvq : 512 + (bid - 64) * 8 + wvq;
                const int step = bid < 64 ? (1 << 20) : (G - 64) * 8;
#pragma unroll 1
                for (; i2 < 32 * 256; i2 += step) pa_chunk(kparams(), shm + wvq * PA_WLDS, l, (i2 & 31) * 256 + (i2 >> 5));
                if (bid < 64) {
                    __syncthreads();
                    pb_head(kparams(), shm, l, bid, false);
                } else {
                    const int gw = (bid - 64) * 8 + wvq, nw = (G - 64) * 8;
                    for (int task = gw; task < NBS * 256; task += nw) pa_sample_task(kparams(), l, task);
                }
            }
        } else if (k == 4) {
            p3_post(kparams(), l, bid, G);
        } else if (k == 5) {
            pg8::StaticOrder S; S.init(TP, DM, G, bid);
            pg8::Gemm g{(const bf16_t*)(kparams().ws + WS_HB), (const bf16_t*)(kparams().ws + WS_WTOUT) + (size_t)l * DM * DM, TP, DM, DM};
            Epi2 E{l};
            pg8::gemm_phase<Epi2, pg8::StaticOrder, false>((PG8_LAS unsigned char*)shm, g, S, E, nullptr);
            for (int nb = bid; nb < 64; nb += G) g2_sample_item(kparams(), shf, l, nb);
        } else {
            p_final(kparams(), bid, G);
        }
        if (ph < 13) xcd_barrier(xb);
        }
    }
}

extern "C" void kernel_launch(void* const* d_in, const int* in_sizes, int n_in, void* d_out, int out_size, void* d_ws, size_t ws_size, hipStream_t stream) {
    static int grid_blocks = 0;
    if (grid_blocks == 0) {
        if (n_in != 25 || (size_t)out_size != O_END || ws_size < WS_END) {
            fprintf(stderr, "kernel_launch: unexpected shapes: n_in %d out_size %d ws_size %zu (need %zu)\n", n_in, out_size, ws_size, (size_t)WS_END);
            grid_blocks = -1; return;
        }
        if (hipFuncSetAttribute((const void*)fwd_kernel, hipFuncAttributeMaxDynamicSharedMemorySize, LDS_BYTES) != hipSuccess) { fprintf(stderr, "kernel_launch: hipFuncSetAttribute failed\n"); grid_blocks = -1; return; }
        int dev = 0, cus = 0, per_cu = 0;
        hipGetDevice(&dev);
        hipDeviceGetAttribute(&cus, hipDeviceAttributeMultiprocessorCount, dev);
        hipOccupancyMaxActiveBlocksPerMultiprocessor(&per_cu, (const void*)fwd_kernel, 512, LDS_BYTES);
        if (per_cu < 1) { fprintf(stderr, "kernel_launch: occupancy query gives %d blocks per CU\n", per_cu); per_cu = 1; }
        (void)hipGetLastError();
        grid_blocks = cus;
        if (grid_blocks < 192) { fprintf(stderr, "kernel_launch: only %d CUs\n", grid_blocks); grid_blocks = -1; return; }
    }
    if (grid_blocks < 0) return;
    if (hipMemsetAsync((unsigned char*)d_ws + WS_BAR, 0, 16384 + RFLAG_BYTES, stream) != hipSuccess) { fprintf(stderr, "kernel_launch: memset of the barrier words failed\n"); return; }
    Params p{};
    const float** pp = (const float**)&p;
    for (int i = 0; i < 25; ++i) pp[i] = (const float*)d_in[i];
    p.out = (float*)d_out; p.ws = (unsigned char*)d_ws; p.repk = REPK; p.repl = REPL;
    void* args[] = {&p};
    hipError_t e = hipLaunchCooperativeKernel((const void*)fwd_kernel, dim3(grid_blocks), dim3(512), args, LDS_BYTES, stream);
    if (e != hipSuccess) fprintf(stderr, "cooperative launch failed: %s (grid %d)\n", hipGetErrorString(e), grid_blocks);
}
```

```cpp
#include <hip/hip_runtime.h>
#include <hip/hip_cooperative_groups.h>
#include <cstdio>
namespace cg = cooperative_groups;
__device__ __forceinline__ int opq_tid() { int t = threadIdx.x; asm volatile("" : "+v"(t)); return t; }
__device__ __forceinline__ int opq_s(int x) { asm volatile("" : "+s"(x)); return x; }
typedef float cvt_f32x2 __attribute__((ext_vector_type(2)));
typedef __bf16 cvt_bf16x2 __attribute__((ext_vector_type(2)));
__device__ __forceinline__ unsigned hw_cvt_pk_bf16(float lo, float hi) { const cvt_f32x2 v = {lo, hi}; return __builtin_bit_cast(unsigned, __builtin_convertvector(v, cvt_bf16x2)); }
typedef unsigned sc1_v4u __attribute__((ext_vector_type(4)));
__device__ __forceinline__ void st_sc1_b128(void* p, unsigned a, unsigned b, unsigned c, unsigned d) { const sc1_v4u v = {a, b, c, d}; asm volatile("global_store_dwordx4 %0, %1, off sc0 sc1\n\ts_nop 2" :: "v"(p), "v"(v) : "memory"); }
__device__ __forceinline__ void st_sc1_b32(void* p, float v) { asm volatile("global_store_dword %0, %1, off sc0 sc1\n\ts_nop 2" :: "v"(p), "v"(v) : "memory"); }
namespace pg8 {
#define PG8_LAS __attribute__((address_space(3)))
typedef unsigned short bf16_t;
typedef short bf16x8 __attribute__((ext_vector_type(8)));
typedef float f32x4 __attribute__((ext_vector_type(4)));
typedef unsigned u32x4 __attribute__((ext_vector_type(4)));
constexpr int BM = 256, BK = 64, HALF = 128, HTB = HALF * BK * 2  , STAGE_BYTES = 8 * HTB, NXCD = 8, WGM = 4;

__host__ __device__ __forceinline__ int lds_byte(int r, int c) { const int st = (r >> 4) * 2 + (c >> 5), rr = r & 15, cc = c & 31, ob = rr * 64 + cc * 2; return st * 1024 + (ob ^ (((ob >> 9) & 1) << 5)); }
__host__ __device__ __forceinline__ void stage_rc(int b, int& R, int& C) { const int st = b / 1024, sb = b % 1024, swz = sb ^ (((sb >> 9) & 1) << 5); R = (st >> 1) * 16 + swz / 64; C = (st & 1) * 32 + (swz % 64) / 2; }
__host__ __device__ __forceinline__ int perm32(int rho) { const int n = rho >> 4, i = rho & 15; return 8 * (i >> 2) + 4 * n + (i & 3); }

struct Unit { int pm, pn; };
struct Gemm { const bf16_t* A; const bf16_t* Bt; int M, N, K; };

struct StaticOrder {
    int nM, nN, nwg, G, c;
    __host__ __device__ void init(int M, int N, int G_, int c_) { nM = M / BM; nN = N / BM; nwg = nM * nN; G = G_; c = c_; }
    __host__ __device__ bool next(int i, Unit& u) const {
        const long L = (long)i * G + c; if (L >= nwg) return false;
        int wgid = (int)L; { const int q = nwg / NXCD, r = nwg % NXCD, xcd = wgid % NXCD, off = wgid / NXCD; wgid = (xcd < r ? xcd * (q + 1) : r * (q + 1) + (xcd - r) * q) + off; }
        const int nig = WGM * nN, gid = wgid / nig, fm = gid * WGM, gsz = (nM - fm) < WGM ? (nM - fm) : WGM;
        u.pm = fm + ((wgid % nig) % gsz); u.pn = (wgid % nig) / gsz; return true;
    }
    __device__ __forceinline__ void a_ready(const Unit&) const {}
    __device__ __forceinline__ void done(const Unit&) const {}
};
template <class Epi, class Sched, bool STAMP = false>
__device__ __forceinline__ void gemm_phase(PG8_LAS unsigned char* lds, const Gemm g, const Sched& S, const Epi& E, unsigned long long* stamps) {
    const int tid = opq_tid(), wid = __builtin_amdgcn_readfirstlane(tid >> 6), lane = tid & 63, wr = wid >> 2, wc = wid & 3, fr = lane & 15, fq = lane >> 4;
    const int K = g.K, nt = K / BK;
    int ts_lo = 0, ts_hi = 0, nts = 0; const unsigned long long rt_entry = STAMP ? (unsigned long long)wall_clock64() : 0ull;
#define PG8_STAMP() do { if (STAMP && wid == 0 && nts < 64) { const unsigned long long _c = (unsigned long long)clock64(); \
        ts_lo = (lane == nts) ? (int)(unsigned)_c : ts_lo; ts_hi = (lane == nts) ? (int)(unsigned)(_c >> 32) : ts_hi; ++nts; } } while (0)
    PG8_STAMP();
    unsigned voffA[2], voffB[2];
#pragma unroll
    for (int i = 0; i < 2; ++i) { int R, C; stage_rc(tid * 16 + i * 8192, R, C); const int Rb = Epi::PERM ? ((R & ~31) + perm32(R & 31)) : R;
        voffA[i] = (unsigned)(R * K + C) * 2u; voffB[i] = (unsigned)(Rb * K + C) * 2u; }
    const size_t kstep = (size_t)(BK * 2);
    const size_t hstep = (size_t)HALF * K * 2;
    const size_t tstep = 2 * hstep;
    const unsigned ldsw = (unsigned)wid * 1024u;
    const int aoff = lds_byte(wr * 64 + fr, fq * 8), boff = lds_byte(wc * 32 + fr, fq * 8);
#define PG8_SA(b, h) (((b) * 2 + (h)) * HTB)
#define PG8_SB(b, h) ((4 + (b) * 2 + (h)) * HTB)
#define PG8_STAGE(bufoff, gbase, voff) do { _Pragma("unroll") for (int _i = 0; _i < 2; ++_i) \
        __builtin_amdgcn_global_load_lds((const unsigned*)((const char*)(gbase) + (voff)[_i]), (PG8_LAS unsigned*)(lds + (bufoff) + ldsw + _i * 8192), 16, 0, 0); } while (0)
#define PG8_LDA(dst, b, h) do { _Pragma("unroll") for (int m = 0; m < 4; ++m) _Pragma("unroll") for (int k = 0; k < 2; ++k) dst[m][k] = *(const PG8_LAS bf16x8*)(lds + PG8_SA(b, h) + aoff + m * 2048 + k * 1024); } while (0)
#define PG8_LDB(dst, b, h) do { _Pragma("unroll") for (int n = 0; n < 2; ++n) _Pragma("unroll") for (int k = 0; k < 2; ++k) dst[n][k] = *(const PG8_LAS bf16x8*)(lds + PG8_SB(b, h) + boff + n * 2048 + k * 1024); } while (0)
#define PG8_MMA(ai, bj, At, Bt) do { __builtin_amdgcn_s_setprio(1); _Pragma("unroll") for (int m = 0; m < 4; ++m) _Pragma("unroll") for (int n = 0; n < 2; ++n) _Pragma("unroll") for (int k = 0; k < 2; ++k) \
        acc[ai][bj][m][n] = __builtin_amdgcn_mfma_f32_16x16x32_bf16(Bt[n][k], At[m][k], acc[ai][bj][m][n], 0, 0, 0); __builtin_amdgcn_s_setprio(0); } while (0)
#define PG8_WAIT_V(n) asm volatile("s_waitcnt vmcnt(" #n ")" ::: "memory")
#define PG8_WAIT_L(n) asm volatile("s_waitcnt lgkmcnt(" #n ")" ::: "memory")
#define PG8_BAR __builtin_amdgcn_s_barrier()
#define PG8_SCHED __builtin_amdgcn_sched_barrier(0)
    Unit cur, nxt; int ui = 0;
    if (!S.next(0, cur)) return;
    f32x4 acc[2][2][4][2];
#pragma unroll
    for (int a = 0; a < 2; ++a)
#pragma unroll
        for (int b = 0; b < 2; ++b)
#pragma unroll
            for (int m = 0; m < 4; ++m)
#pragma unroll
                for (int n = 0; n < 2; ++n) acc[a][b][m][n] = (f32x4){0.f, 0.f, 0.f, 0.f};
    bf16x8 At[4][2], B0[2][2], B1[2][2];
    const char* cA = (const char*)g.A + (size_t)cur.pm * tstep; const char* cB = (const char*)g.Bt + (size_t)cur.pn * tstep;
    S.a_ready(cur);
    PG8_STAGE(PG8_SB(0, 0), cB, voffB); PG8_STAGE(PG8_SA(0, 0), cA, voffA); PG8_STAGE(PG8_SB(0, 1), cB + hstep, voffB); PG8_STAGE(PG8_SA(0, 1), cA + hstep, voffA);
    if (wr == 1) PG8_BAR;
    PG8_WAIT_V(4); PG8_BAR;
    PG8_STAGE(PG8_SB(1, 0), cB + kstep, voffB); PG8_STAGE(PG8_SA(1, 0), cA + kstep, voffA); PG8_STAGE(PG8_SB(1, 1), cB + hstep + kstep, voffB);
    PG8_WAIT_V(6); PG8_BAR;
    PG8_STAMP();
    for (;;) {
        const bool has_next = S.next(ui + 1, nxt);
        const char* nA = has_next ? (const char*)g.A + (size_t)nxt.pm * tstep : cA; const char* nB = has_next ? (const char*)g.Bt + (size_t)nxt.pn * tstep : cB;
        for (int t = 0; t < nt; t += 2) {
            const bool last = (t == nt - 2);
            const char* a1 = cA + (size_t)(t + 1) * kstep;
            const char* a2 = last ? nA : cA + (size_t)(t + 2) * kstep; const char* b2 = last ? nB : cB + (size_t)(t + 2) * kstep;
            const char* a3 = a2 + kstep; const char* b3 = b2 + kstep;
            if (last && has_next) S.a_ready(nxt);
            PG8_LDB(B0, 0, 0); PG8_SCHED; PG8_LDA(At, 0, 0); PG8_STAGE(PG8_SA(1, 1), a1 + hstep, voffA);
            PG8_WAIT_L(8); PG8_BAR; PG8_WAIT_L(0); PG8_MMA(0, 0, At, B0); PG8_BAR; PG8_SCHED;
            PG8_LDB(B1, 0, 1); PG8_STAGE(PG8_SB(0, 0), b2, voffB);
            PG8_BAR; PG8_WAIT_L(0); PG8_MMA(0, 1, At, B1); PG8_BAR;
            PG8_LDA(At, 0, 1); PG8_STAGE(PG8_SA(0, 0), a2, voffA);
            PG8_BAR; PG8_WAIT_L(0); PG8_MMA(1, 0, At, B0); PG8_BAR; PG8_SCHED;
            PG8_STAGE(PG8_SB(0, 1), b2 + hstep, voffB);
            PG8_WAIT_V(6); PG8_BAR; PG8_MMA(1, 1, At, B1); PG8_BAR;
            PG8_LDB(B0, 1, 0); PG8_SCHED; PG8_LDA(At, 1, 0); PG8_STAGE(PG8_SA(0, 1), a2 + hstep, voffA);
            PG8_WAIT_L(8); PG8_BAR; PG8_WAIT_L(0); PG8_MMA(0, 0, At, B0); PG8_BAR; PG8_SCHED;
            PG8_LDB(B1, 1, 1); PG8_STAGE(PG8_SB(1, 0), b3, voffB);
            PG8_BAR; PG8_WAIT_L(0); PG8_MMA(0, 1, At, B1); PG8_BAR;
            PG8_LDA(At, 1, 1); PG8_STAGE(PG8_SA(1, 0), a3, voffA);
            PG8_BAR; PG8_WAIT_L(0); PG8_MMA(1, 0, At, B0); PG8_BAR; PG8_SCHED;
            PG8_STAGE(PG8_SB(1, 1), b3 + hstep, voffB);
            PG8_WAIT_V(6); PG8_BAR; PG8_MMA(1, 1, At, B1); PG8_BAR;
        }
        PG8_STAMP();
        if constexpr (!Epi::AFTER_DRAIN) { E(acc, cur, wr, wc, fr, fq); S.done(cur); }
        PG8_STAMP();
        if (!has_next) break;
#pragma unroll
        for (int a = 0; a < 2; ++a)
#pragma unroll
            for (int b = 0; b < 2; ++b)
#pragma unroll
                for (int m = 0; m < 4; ++m)
#pragma unroll
                    for (int n = 0; n < 2; ++n) acc[a][b][m][n] = (f32x4){0.f, 0.f, 0.f, 0.f};
        cur = nxt; cA = nA; cB = nB; ++ui;
    }
    PG8_WAIT_V(0);
    if (wr == 0) PG8_BAR;
    PG8_BAR;
    if constexpr (Epi::AFTER_DRAIN) { E.fused(acc, cur, wr, wc, fr, fq, lds, wid, lane); S.done(cur); }
    PG8_STAMP();
    if (STAMP && wid == 0) { stamps[lane] = lane < nts ? (((unsigned long long)(unsigned)ts_hi << 32) | (unsigned)ts_lo) : 0ull;
        if (lane == 62) stamps[62] = rt_entry; if (lane == 63) stamps[63] = (unsigned long long)wall_clock64(); }
#undef PG8_STAMP
#undef PG8_SA
#undef PG8_SB
#undef PG8_STAGE
#undef PG8_LDA
#undef PG8_LDB
#undef PG8_MMA
#undef PG8_WAIT_V
#undef PG8_WAIT_L
#undef PG8_BAR
#undef PG8_SCHED
}
}

#define XB_TMO      128
#define XB_XCNT(j)  (256  + 64 * (j))
#define XB_XSUB(j)  (1280 + 64 * (j))
#define XB_XGEN(j)  (2304 + 64 * (j))
#define XB_TOP      3328
#define XB_TOPGEN   3392
#define XCD_BAR_WORDS 3456
#define XB_SPIN_CAP (1u << 18)
#define LAS __attribute__((address_space(3)))

__device__ __forceinline__ unsigned xb_ld(unsigned* p)              { return __hip_atomic_load(p, __ATOMIC_RELAXED, __HIP_MEMORY_SCOPE_AGENT); }
__device__ __forceinline__ unsigned xb_add(unsigned* p, unsigned v) { return __hip_atomic_fetch_add(p, v, __ATOMIC_RELAXED, __HIP_MEMORY_SCOPE_AGENT); }
__device__ __forceinline__ unsigned xb_xcc_id() { return (unsigned)__builtin_amdgcn_s_getreg((3 << 11) | 20) & 0xFu; }
#define XB_SPIN(cond, bar) do { unsigned _sp = 0; while (cond) { __builtin_amdgcn_s_sleep(1); \
    if ((++_sp & 255u) == 0u) { if (xb_ld(&(bar)[XB_TMO])) break; if (_sp > XB_SPIN_CAP) { atomicAdd(&(bar)[XB_TMO], 1u); break; } } } } while (0)

struct XcdBarrier {
    unsigned* bar; unsigned x;
    volatile LAS unsigned* st;
};

__device__ __forceinline__ XcdBarrier xcd_barrier_post(unsigned* bar, volatile LAS unsigned* st) {
    XcdBarrier b; b.bar = bar; b.x = xb_xcc_id(); b.st = st;
    if (threadIdx.x == 0) (void)xb_add(&bar[XB_XCNT(b.x)], 1u);
    return b;
}
__device__ __forceinline__ void xcd_barrier_complete(unsigned* bar, unsigned x, unsigned& nloc, unsigned& nx) {
    const unsigned G = gridDim.x * gridDim.y * gridDim.z;
    unsigned sum, cnt, mine, sp = 0u;
    for (;;) {
        sum = 0u; cnt = 0u; mine = 0u;
#pragma unroll
        for (unsigned j = 0; j < 16; ++j) { const unsigned c = xb_ld(&bar[XB_XCNT(j)]); sum += c; cnt += (c > 0u) ? 1u : 0u; mine = (j == x) ? c : mine; }
        if (sum == G) break;
        __builtin_amdgcn_s_sleep(1);
        if ((++sp & 255u) == 0u) { if (xb_ld(&bar[XB_TMO])) break; if (sp > XB_SPIN_CAP) { atomicAdd(&bar[XB_TMO], 1u); break; } }
    }
    nloc = mine > 0u ? mine : 1u; nx = cnt > 0u ? cnt : 1u;
}

__device__ __forceinline__ void xcd_barrier(const XcdBarrier& b) {
    asm volatile("s_waitcnt vmcnt(0)" ::: "memory");
    __syncthreads();
    if (threadIdx.x == 0) {
        unsigned* bar = b.bar;
        __builtin_amdgcn_s_waitcnt(0);
        unsigned nloc = b.st[0], nx = b.st[1];
        if (nloc == 0u) { xcd_barrier_complete(bar, b.x, nloc, nx); b.st[0] = nloc; b.st[1] = nx; }
        const unsigned old = xb_add(&bar[XB_XSUB(b.x)], 1u);
        const unsigned gen = old / nloc;
        if (old + 1u == (gen + 1u) * nloc) {
            __builtin_amdgcn_fence(__ATOMIC_RELEASE, "agent");
            asm volatile("s_waitcnt vmcnt(0)" ::: "memory");
            const unsigned og = xb_add(&bar[XB_TOP], 1u);
            const unsigned tg = og / nx;
            if (og + 1u == (tg + 1u) * nx) xb_add(&bar[XB_TOPGEN], 1u);
            else XB_SPIN(xb_ld(&bar[XB_TOPGEN]) == tg, bar);
            __builtin_amdgcn_fence(__ATOMIC_ACQUIRE, "agent");
            xb_add(&bar[XB_XGEN(b.x)], 1u);
            asm volatile("s_waitcnt vmcnt(0)" ::: "memory");
        } else {
            XB_SPIN(xb_ld(&bar[XB_XGEN(b.x)]) == gen, bar);
            __builtin_amdgcn_fence(__ATOMIC_ACQUIRE, "agent");
            asm volatile("s_waitcnt vmcnt(0)" ::: "memory");
        }
    }
    __syncthreads();
}

typedef unsigned short bf16_t;
typedef short bf16x8 __attribute__((ext_vector_type(8)));
typedef float f32x4 __attribute__((ext_vector_type(4)));
typedef float f32x16 __attribute__((ext_vector_type(16)));

constexpr int DM = 2048, SEQ = 4096, NBP = 2, NBS = 32, TP = NBP * SEQ, MT = TP + NBS, MP = 8448;
constexpr int INW = 6784, INWP = 6912, SHD = 3200, DEPTH = 2;
constexpr size_t NRI = (size_t)MT * 1024;
constexpr int LDS_BYTES = 131072 + 16;
constexpr size_t O_CKP = (size_t)MT * DM;
constexpr size_t O_CVP = O_CKP + (size_t)DEPTH * NBP * 128 * 256;
constexpr size_t O_WKVP = O_CVP + (size_t)DEPTH * NBP * 128 * 256;
constexpr size_t O_SHP = O_WKVP + (size_t)DEPTH * NBP * 16 * 4096;
constexpr size_t O_CKS = O_SHP + (size_t)DEPTH * NBP * SHD;
constexpr size_t O_CVS = O_CKS + (size_t)DEPTH * NBS * 128 * 256;
constexpr size_t O_WKVS = O_CVS + (size_t)DEPTH * NBS * 128 * 256;
constexpr size_t O_SHS = O_WKVS + (size_t)DEPTH * NBS * 16 * 4096;
constexpr size_t O_END = O_SHS + (size_t)DEPTH * NBS * SHD;
constexpr size_t al256(size_t x) { return (x + 255) & ~(size_t)255; }
constexpr size_t WS_WTIN = 0;
constexpr size_t WS_WTOUT = WS_WTIN + (size_t)INWP * DM * 2;
constexpr size_t WS_MOD = WS_WTOUT + (size_t)DEPTH * DM * DM * 2;
constexpr size_t WS_ROPE = WS_MOD + al256((size_t)DEPTH * 34 * 6144 * 4);
constexpr size_t WS_HB = WS_ROPE + al256((size_t)4097 * 16 * 4);
constexpr size_t WS_QB = WS_HB + (size_t)MP * DM * 2;
constexpr size_t WS_KB = WS_QB + (size_t)MP * 1024 * 2;
constexpr size_t WS_VB = WS_KB + (size_t)MP * 256 * 2;
constexpr size_t WS_RW = WS_VB + (size_t)MP * 256 * 2;
constexpr size_t WS_GT = WS_RW + (size_t)MP * SHD * 2;
constexpr size_t WS_VALL = WS_GT + (size_t)MP * DM * 2;
constexpr size_t SRI = (size_t)NBS * 1024;
constexpr size_t WS_RSB = WS_VALL + NRI * 2;
constexpr size_t WS_RSW = WS_RSB + 4 * SRI * 2;
constexpr size_t WS_YS = WS_RSW + SRI * 4;
constexpr size_t WS_REC = WS_YS + NRI * 4;
constexpr size_t WS_COEF = WS_REC + (size_t)32 * 256 * 14592;
constexpr size_t WS_TWAD = WS_COEF + al256((size_t)MT * 16 * 4);
constexpr size_t WS_WFRAG = WS_TWAD + (size_t)MT * 128 * 2;
constexpr size_t WS_BAR = WS_WFRAG + (size_t)DEPTH * 2 * 16 * 4 * 2 * 64 * 16;
constexpr size_t WS_RFLAG = WS_BAR + 16384;
constexpr size_t RFLAG_BYTES = (size_t)32 * 256 * 64;
constexpr size_t WS_END = WS_RFLAG + RFLAG_BYTES;

struct Params {
    const float *x_prompt, *x_sample, *cache_k, *cache_v, *state_wkv, *state_shift, *c_prompt, *c_sample, *norm_g, *w_ada, *b_ada, *w_in, *mu_shift, *w0, *w_decay, *a0,
        *w_iclr, *k_k, *k_a, *r_k, *ln_w, *ln_b, *sinks, *w_out, *final_g;
    float* out;
    unsigned char* ws;
    int repk, repl;
};
typedef const __attribute__((address_space(4))) Params* KParamsPtr;
__device__ __forceinline__ const Params& kparams() {
    KParamsPtr k = (KParamsPtr)__builtin_amdgcn_kernarg_segment_ptr();
    asm volatile("" : "+s"(k));
    return *(const Params*)k;
}

__device__ __forceinline__ unsigned short f2bf(float f) { return (unsigned short)(hw_cvt_pk_bf16(f, 0.f) & 0xffffu); }
__device__ __forceinline__ float bf2f(unsigned short b) { return __uint_as_float(((unsigned)b) << 16); }
__device__ __forceinline__ unsigned pack2(float lo, float hi) { return hw_cvt_pk_bf16(lo, hi); }
__device__ __forceinline__ float bflo(unsigned w) { return __uint_as_float(w << 16); }
__device__ __forceinline__ float bfhi(unsigned w) { return __uint_as_float(w & 0xffff0000u); }
__device__ __forceinline__ float silu_f(float x) { return x / (1.f + __expf(-x)); }
__device__ __forceinline__ float wave_sum(float x) {
#pragma unroll
    for (int o = 32; o >= 1; o >>= 1) x += __shfl_xor(x, o);
    return x;
}
__device__ __forceinline__ float wave_max(float x) {
#pragma unroll
    for (int o = 32; o >= 1; o >>= 1) x = fmaxf(x, __shfl_xor(x, o));
    return x;
}
template <int CTRL> __device__ __forceinline__ float dpp_f(float x) {
    return __builtin_bit_cast(float, __builtin_amdgcn_update_dpp(0, __builtin_bit_cast(int, x), CTRL, 0xF, 0xF, false));
}
__device__ __forceinline__ float allreduce16(float x) {
    x += dpp_f<0x128>(x);
    x += dpp_f<0x124>(x);
    x += dpp_f<0x122>(x);
    x += dpp_f<0x121>(x);
    return x;
}

__device__ void p0_mod_item(const Params& p, float* red, int l, int nc) {
    const int tid = opq_tid(), wv = tid >> 6, lane = tid & 63, n = lane & 31, kh = lane >> 5;
    f32x16 acc0, acc1;
#pragma unroll
    for (int i = 0; i < 16; ++i) { acc0[i] = 0.f; acc1[i] = 0.f; }
    const float* W = p.w_ada + (size_t)l * DM * 6144 + nc * 32 + n;
#pragma unroll 8
    for (int ks = 0; ks < 16; ++ks) {
        const int k0 = wv * 256 + ks * 16 + kh * 8;
        bf16x8 bfr, a0, a1;
#pragma unroll
        for (int j = 0; j < 8; ++j) bfr[j] = (short)f2bf(W[(size_t)(k0 + j) * 6144]);
        const float4* cs = (const float4*)(p.c_sample + (size_t)n * DM + k0);
        const float4 u0 = cs[0], u1 = cs[1];
        a0[0] = (short)f2bf(silu_f(u0.x)); a0[1] = (short)f2bf(silu_f(u0.y)); a0[2] = (short)f2bf(silu_f(u0.z)); a0[3] = (short)f2bf(silu_f(u0.w));
        a0[4] = (short)f2bf(silu_f(u1.x)); a0[5] = (short)f2bf(silu_f(u1.y)); a0[6] = (short)f2bf(silu_f(u1.z)); a0[7] = (short)f2bf(silu_f(u1.w));
        float4 q0 = make_float4(0.f, 0.f, 0.f, 0.f), q1 = q0;
        if (n < 2) { const float4* cp = (const float4*)(p.c_prompt + (size_t)n * DM + k0); q0 = cp[0]; q1 = cp[1]; }
        a1[0] = (short)f2bf(silu_f(q0.x)); a1[1] = (short)f2bf(silu_f(q0.y)); a1[2] = (short)f2bf(silu_f(q0.z)); a1[3] = (short)f2bf(silu_f(q0.w));
        a1[4] = (short)f2bf(silu_f(q1.x)); a1[5] = (short)f2bf(silu_f(q1.y)); a1[6] = (short)f2bf(silu_f(q1.z)); a1[7] = (short)f2bf(silu_f(q1.w));
        acc0 = __builtin_amdgcn_mfma_f32_32x32x16_bf16(a0, bfr, acc0, 0, 0, 0);
        acc1 = __builtin_amdgcn_mfma_f32_32x32x16_bf16(a1, bfr, acc1, 0, 0, 0);
    }
#pragma unroll
    for (int i = 0; i < 16; ++i) red[(wv * 18 + i) * 64 + lane] = acc0[i];
    red[(wv * 18 + 16) * 64 + lane] = acc1[0];
    red[(wv * 18 + 17) * 64 + lane] = acc1[1];
    __syncthreads();
    float* mod = (float*)(p.ws + WS_MOD);
    for (int o = tid; o < 34 * 32; o += 512) {
        const int row = o >> 5, col = o & 31;
        int ri, ln, mrow;
        if (row < 32) { const int khh = (row >> 2) & 1; ri = (row & 3) + 4 * (row >> 3); ln = col + 32 * khh; mrow = 2 + row; }
        else { ri = 16 + (row - 32); ln = col; mrow = row - 32; }
        float s = 0.f;
#pragma unroll
        for (int w = 0; w < 8; ++w) s += red[(w * 18 + ri) * 64 + ln];
        mod[((size_t)l * 34 + mrow) * 6144 + nc * 32 + col] = s + p.b_ada[l * 6144 + nc * 32 + col];
    }
    __syncthreads();
}

struct ConvIt { const float* src; bf16_t* dst; int N, k0, n0; };
__device__ __forceinline__ ConvIt conv_decode(const Params& p, int cidx, int lw) {
    ConvIt c;
    int kt, nt;
    if (cidx < 1728) { kt = cidx & 15; nt = cidx >> 4; c.N = INW; c.src = p.w_in + (size_t)lw * DM * INW; c.dst = (bf16_t*)(p.ws + WS_WTIN); }
    else { int rem = cidx - 1728; const int l2 = rem >> 9; rem &= 511; kt = rem & 15; nt = rem >> 4; c.N = DM; c.src = p.w_out + (size_t)l2 * DM * DM; c.dst = (bf16_t*)(p.ws + WS_WTOUT) + (size_t)l2 * DM * DM; }
    c.k0 = kt * 128; c.n0 = nt * 64;
    return c;
}
__device__ void p0_conv_all(const Params& p, float* s, int bid, int G, int total, int lw) {
    const int tid = opq_tid();
    const int lrow = tid >> 4, c4 = tid & 15, n = tid >> 3, kg = tid & 7;
    float4 v[4];
    int cidx = bid;
    ConvIt cur = conv_decode(p, cidx < total ? cidx : 0, lw);
    if (cidx < total) {
#pragma unroll
        for (int p4 = 0; p4 < 4; ++p4) { v[p4] = make_float4(0.f, 0.f, 0.f, 0.f); if (cur.n0 < cur.N) v[p4] = *(const float4*)(cur.src + (size_t)(cur.k0 + lrow + 32 * p4) * cur.N + cur.n0 + 4 * c4); }
    }
#pragma unroll 1
    while (cidx < total) {
#pragma unroll
        for (int p4 = 0; p4 < 4; ++p4) { float* d = s + (lrow + 32 * p4) * 65 + 4 * c4; d[0] = v[p4].x; d[1] = v[p4].y; d[2] = v[p4].z; d[3] = v[p4].w; }
        __syncthreads();
        const int nxt = cidx + G;
        const ConvIt nx = conv_decode(p, nxt < total ? nxt : 0, lw);
        if (nxt < total) {
#pragma unroll
            for (int p4 = 0; p4 < 4; ++p4) { v[p4] = make_float4(0.f, 0.f, 0.f, 0.f); if (nx.n0 < nx.N) v[p4] = *(const float4*)(nx.src + (size_t)(nx.k0 + lrow + 32 * p4) * nx.N + nx.n0 + 4 * c4); }
        }
        unsigned w[8];
#pragma unroll
        for (int j = 0; j < 8; ++j) w[j] = pack2(s[(kg * 16 + 2 * j) * 65 + n], s[(kg * 16 + 2 * j + 1) * 65 + n]);
        uint4* o = (uint4*)(cur.dst + (size_t)(cur.n0 + n) * DM + cur.k0 + kg * 16);
        o[0] = make_uint4(w[0], w[1], w[2], w[3]);
        o[1] = make_uint4(w[4], w[5], w[6], w[7]);
        __syncthreads();
        cur = nx; cidx = nxt;
    }
}

__device__ void p0_rope_item(const Params& p, int it) {
    float* rope = (float*)(p.ws + WS_ROPE);
#pragma unroll
    for (int q = 0; q < 4; ++q) {
        const int e = it * 2048 + q * 512 + opq_tid();
        if (e < 4097 * 8) {
            const int idx = e >> 3, i = e & 7;
            double invf = 1.0;
            for (int q = 0; q < i; ++q) invf *= 0.19392274474868576;
            const double pos = idx < 4096 ? (double)idx : 16384.0;
            const double rev = pos * invf * 0.15915494309189535;
            const float f = (float)(rev - floor(rev));
            rope[idx * 16 + i] = __builtin_amdgcn_cosf(f);
            rope[idx * 16 + 8 + i] = __builtin_amdgcn_sinf(f);
        }
    }
}

__device__ void p0_wfrag_item(const Params& p, int it) {
    const int e0 = it * 512 + opq_tid();
    const int lane = e0 & 63, ks = (e0 >> 6) & 1, ct = (e0 >> 7) & 3, hd = (e0 >> 9) & 15, mtx = (e0 >> 13) & 1, l = e0 >> 14;
    const float* W = (mtx == 0 ? p.w_decay : p.w_iclr) + (size_t)l * 64 * 1024 + hd * 64 + 16 * ct + (lane & 15);
    const int k0 = 32 * ks + 8 * (lane >> 4);
    float v[8];
#pragma unroll
    for (int e = 0; e < 8; ++e) v[e] = W[(size_t)(k0 + e) * 1024];
    ((uint4*)(p.ws + WS_WFRAG))[e0] = make_uint4(pack2(v[0], v[1]), pack2(v[2], v[3]), pack2(v[4], v[5]), pack2(v[6], v[7]));
}

__device__ void p1_norm(const Params& p, int l, int bid, int G) {
    const int tid = opq_tid(), wv = tid >> 6, lane = tid & 63;
    bf16_t* hb = (bf16_t*)(p.ws + WS_HB);
    const float* mod = (const float*)(p.ws + WS_MOD);
    const float4* g4 = (const float4*)(p.norm_g + l * DM);
    for (int r = bid * 8 + wv; r < MT; r += G * 8) {
        const float* xr = l == 0 ? (r < TP ? p.x_prompt + (size_t)r * DM : p.x_sample + (size_t)(r - TP) * DM) : p.out + (size_t)r * DM;
        const int mrow = r < TP ? (r >> 12) : 2 + (r - TP);
        const float* md = mod + ((size_t)l * 34 + mrow) * 6144;
        float4 v[8]; float ss = 0.f;
#pragma unroll
        for (int i = 0; i < 8; ++i) { v[i] = ((const float4*)xr)[lane + 64 * i]; ss += v[i].x * v[i].x + v[i].y * v[i].y + v[i].z * v[i].z + v[i].w * v[i].w; }
        ss = wave_sum(ss);
        const float rinv = rsqrtf(ss * (1.f / 2048.f) + 1e-5f);
#pragma unroll
        for (int i = 0; i < 8; ++i) {
            const int c4 = lane + 64 * i;
            const float4 g = g4[c4], sc = ((const float4*)(md + 2048))[c4], sh = ((const float4*)md)[c4];
            const float y0 = v[i].x * rinv * g.x * (1.f + sc.x) + sh.x, y1 = v[i].y * rinv * g.y * (1.f + sc.y) + sh.y;
            const float y2 = v[i].z * rinv * g.z * (1.f + sc.z) + sh.z, y3 = v[i].w * rinv * g.w * (1.f + sc.w) + sh.w;
            *(uint2*)(hb + (size_t)r * DM + 4 * c4) = make_uint2(pack2(y0, y1), pack2(y2, y3));
        }
    }
}

struct Epi1 {
    static constexpr bool PERM = false, AFTER_DRAIN = false;
    int l;
    __device__ __forceinline__ void operator()(const f32x4 (&acc)[2][2][4][2], const pg8::Unit& u, int wr, int wc, int fr, int fq) const {
        const Params& p = kparams();
        bf16_t* const qb = (bf16_t*)(p.ws + WS_QB); bf16_t* const kb = (bf16_t*)(p.ws + WS_KB); bf16_t* const vb = (bf16_t*)(p.ws + WS_VB);
        bf16_t* const rw = (bf16_t*)(p.ws + WS_RW); bf16_t* const gt = (bf16_t*)(p.ws + WS_GT); const float* const rope = (const float*)(p.ws + WS_ROPE); float* const out = p.out;
#pragma unroll
        for (int bj = 0; bj < 2; ++bj)
#pragma unroll
            for (int n = 0; n < 2; ++n) {
                const int cb = u.pn * 256 + bj * 128 + wc * 32 + n * 16;
                if (cb >= INW) continue;
                const int c = cb + 4 * fq;
                const bool do_rope = (cb < 1280) && ((cb & 63) == 0);
#pragma unroll
                for (int ai = 0; ai < 2; ++ai)
#pragma unroll
                    for (int m = 0; m < 4; ++m) {
                        const int rb = u.pm * 256 + ai * 128 + wr * 64 + m * 16;
                        if (rb >= MT) continue;
                        const int r = rb + fr;
                        f32x4 v = acc[ai][bj][m][n];
                        if (do_rope) {
                            const int idx = r < TP ? (r & 4095) : 4096;
                            const float4 cs = *(const float4*)(rope + idx * 16 + 4 * (fq & 1));
                            const float4 sn = *(const float4*)(rope + idx * 16 + 8 + 4 * (fq & 1));
                            const float p0 = __shfl_xor(v[0], 32), p1 = __shfl_xor(v[1], 32), p2 = __shfl_xor(v[2], 32), p3 = __shfl_xor(v[3], 32);
                            const float sg = fq < 2 ? -1.f : 1.f;
                            v[0] = v[0] * cs.x + sg * p0 * sn.x; v[1] = v[1] * cs.y + sg * p1 * sn.y; v[2] = v[2] * cs.z + sg * p2 * sn.z; v[3] = v[3] * cs.w + sg * p3 * sn.w;
                        }
                        if (cb < 1024) {
                            *(uint2*)(qb + (size_t)r * 1024 + c) = make_uint2(pack2(v[0] * 0.125f, v[1] * 0.125f), pack2(v[2] * 0.125f, v[3] * 0.125f));
                        } else if (cb < 1536) {
                            const bool isk = cb < 1280;
                            const int cc = c - (isk ? 1024 : 1280);
                            *(uint2*)((isk ? kb : vb) + (size_t)r * 256 + cc) = make_uint2(pack2(v[0], v[1]), pack2(v[2], v[3]));
                            if (r >= TP) {
                                *(f32x4*)(out + (isk ? O_CKS : O_CVS) + ((size_t)(l * NBS + (r - TP)) * 128 + 127) * 256 + cc) = v;
                            } else if ((r & 4095) >= SEQ - 128) {
                                *(f32x4*)(out + (isk ? O_CKP : O_CVP) + ((size_t)(l * NBP + (r >> 12)) * 128 + ((r & 4095) - (SEQ - 128))) * 256 + cc) = v;
                            }
                        } else if (cb < 4736) {
                            const int cc = c - 1536;
                            *(uint2*)(rw + (size_t)r * SHD + cc) = make_uint2(pack2(v[0], v[1]), pack2(v[2], v[3]));
                            if (r >= TP) *(f32x4*)(out + O_SHS + (size_t)(l * NBS + (r - TP)) * SHD + cc) = v;
                            else if ((r & 4095) == SEQ - 1) *(f32x4*)(out + O_SHP + (size_t)(l * NBP + (r >> 12)) * SHD + cc) = v;
                        } else {
                            const int cc = c - 4736;
                            *(uint2*)(gt + (size_t)r * DM + cc) = make_uint2(pack2(silu_f(v[0]), silu_f(v[1])), pack2(silu_f(v[2]), silu_f(v[3])));
                        }
                    }
            }
    }
};

struct Epi2 {
    static constexpr bool PERM = false, AFTER_DRAIN = false;
    int l;
    __device__ __forceinline__ void operator()(const f32x4 (&acc)[2][2][4][2], const pg8::Unit& u, int wr, int wc, int fr, int fq) const {
        const Params& p = kparams();
        float* const out = p.out;
        const int rb0 = u.pm * 256;
        const int mrow = rb0 < TP ? (rb0 >> 12) : 2;
        const float* gr = (const float*)(p.ws + WS_MOD) + ((size_t)l * 34 + mrow) * 6144 + 4096 + u.pn * 256 + wc * 32 + 4 * fq;
        f32x4 g4[2][2];
#pragma unroll
        for (int bj = 0; bj < 2; ++bj)
#pragma unroll
            for (int n = 0; n < 2; ++n) g4[bj][n] = *(const f32x4*)(gr + bj * 128 + n * 16);
        const float* xbase = l == 0 ? p.x_prompt : out;
        const int c0 = u.pn * 256 + wc * 32 + 4 * fq;
#pragma unroll
        for (int ai = 0; ai < 2; ++ai)
#pragma unroll
            for (int mh = 0; mh < 2; ++mh) {
                f32x4 x4[2][2][2];
#pragma unroll
                for (int mm = 0; mm < 2; ++mm) {
                    const int r = rb0 + ai * 128 + wr * 64 + (2 * mh + mm) * 16 + fr;
                    const float* xo = xbase + (size_t)r * DM + c0;
#pragma unroll
                    for (int bj = 0; bj < 2; ++bj)
#pragma unroll
                        for (int n = 0; n < 2; ++n) x4[mm][bj][n] = *(const f32x4*)(xo + bj * 128 + n * 16);
                }
                __builtin_amdgcn_sched_barrier(0);
#pragma unroll
                for (int mm = 0; mm < 2; ++mm) {
                    const int r = rb0 + ai * 128 + wr * 64 + (2 * mh + mm) * 16 + fr;
                    float* yo = out + (size_t)r * DM + c0;
#pragma unroll
                    for (int bj = 0; bj < 2; ++bj)
#pragma unroll
                        for (int n = 0; n < 2; ++n) *(f32x4*)(yo + bj * 128 + n * 16) = x4[mm][bj][n] + g4[bj][n] * acc[ai][bj][2 * mh + mm][n];
                }
                __builtin_amdgcn_sched_barrier(0);
            }
    }
};

__device__ void g2_sample_item(const Params& p, float* red, int l, int nb) {
    const int tid = opq_tid(), wv = tid >> 6, lane = tid & 63, n = lane & 31, h = lane >> 5;
    const bf16_t* A = (const bf16_t*)(p.ws + WS_HB) + (size_t)TP * DM;
    const bf16_t* Bt = (const bf16_t*)(p.ws + WS_WTOUT) + (size_t)l * DM * DM + (size_t)(nb * 32) * DM;
    f32x16 acc;
#pragma unroll
    for (int i = 0; i < 16; ++i) acc[i] = 0.f;
#pragma unroll 4
    for (int ks = 0; ks < 16; ++ks) {
        const int k0 = wv * 256 + ks * 16 + 8 * h;
        const bf16x8 a = *(const bf16x8*)(A + (size_t)n * DM + k0);
        const bf16x8 bq = *(const bf16x8*)(Bt + (size_t)n * DM + k0);
        acc = __builtin_amdgcn_mfma_f32_32x32x16_bf16(a, bq, acc, 0, 0, 0);
    }
#pragma unroll
    for (int i = 0; i < 16; ++i) red[(wv * 16 + i) * 64 + lane] = acc[i];
    __syncthreads();
    const float* mod = (const float*)(p.ws + WS_MOD) + (size_t)l * 34 * 6144;
    for (int o = tid; o < 1024; o += 512) {
        const int row = o >> 5, col = o & 31, hh = (row >> 2) & 1, ri = (row & 3) + 4 * (row >> 3), ln = col + 32 * hh;
        float s = 0.f;
#pragma unroll
        for (int w = 0; w < 8; ++w) s += red[(w * 16 + ri) * 64 + ln];
        const int c = nb * 32 + col;
        const float gate = mod[(size_t)(2 + row) * 6144 + 4096 + c];
        const float xo = l == 0 ? p.x_sample[(size_t)row * DM + c] : p.out[(size_t)(TP + row) * DM + c];
        p.out[(size_t)(TP + row) * DM + c] = xo + gate * s;
    }
    __syncthreads();
}

__device__ void p3_attn_unit(const Params& p, unsigned char* lds, int l, int unit, int s_half) {
    const int tid = opq_tid(), wv = tid >> 6, lane = tid & 63;
    const int b = unit >> 7, n = (unit >> 2) & 31, g = unit & 3;
    bf16_t* Ks = (bf16_t*)lds;
    bf16_t* Vt = (bf16_t*)(lds + 36864);
    const bf16_t* qb = (const bf16_t*)(p.ws + WS_QB);
    const bf16_t* kb = (const bf16_t*)(p.ws + WS_KB);
    const bf16_t* vb = (const bf16_t*)(p.ws + WS_VB);
    const bf16_t* gt = (const bf16_t*)(p.ws + WS_GT);
    bf16_t* cc = (bf16_t*)(p.ws + WS_HB);
    {
        uint4 kv4[4], vv4[4];
#pragma unroll
        for (int i = 0; i < 4; ++i) {
            const int chunk = tid + 512 * i, kl = chunk >> 3, dc = chunk & 7, kp = 128 * (n - 1) + kl;
            kv4[i] = make_uint4(0u, 0u, 0u, 0u); vv4[i] = kv4[i];
            if (kp >= 0) { const size_t row = (size_t)b * SEQ + kp; kv4[i] = *(const uint4*)(kb + row * 256 + g * 64 + dc * 8); vv4[i] = *(const uint4*)(vb + row * 256 + g * 64 + dc * 8); }
        }
        __builtin_amdgcn_sched_barrier(0);
#pragma unroll
        for (int i = 0; i < 4; ++i) {
            const int chunk = tid + 512 * i, kl = chunk >> 3, dc = chunk & 7;
            *(uint4*)(Ks + kl * 72 + dc * 8) = kv4[i];
            bf16_t* vd = Vt + (dc * 8) * 264 + kl;
            vd[0 * 264] = (bf16_t)(vv4[i].x & 0xffffu); vd[1 * 264] = (bf16_t)(vv4[i].x >> 16);
            vd[2 * 264] = (bf16_t)(vv4[i].y & 0xffffu); vd[3 * 264] = (bf16_t)(vv4[i].y >> 16);
            vd[4 * 264] = (bf16_t)(vv4[i].z & 0xffffu); vd[5 * 264] = (bf16_t)(vv4[i].z >> 16);
            vd[6 * 264] = (bf16_t)(vv4[i].w & 0xffffu); vd[7 * 264] = (bf16_t)(vv4[i].w >> 16);
        }
    }
    __syncthreads();
    const int hq = 4 * g + (wv >> 1), qh = wv & 1, q32 = lane & 31, h = lane >> 5;
    const float sink = p.sinks[l * 16 + hq];
#pragma unroll 1
    for (int s = s_half; s <= s_half; ++s) {
        const int qp = 128 * n + 64 * qh + 32 * s + q32;
        const size_t qrow = (size_t)b * SEQ + qp;
        const int klb0 = 64 * qh + 32 * s;
        bf16x8 qf[4];
#pragma unroll
        for (int ks = 0; ks < 4; ++ks) qf[ks] = *(const bf16x8*)(qb + qrow * 1024 + hq * 64 + ks * 16 + 8 * h);
        f32x16 S[5];
#pragma unroll
        for (int kt = 0; kt < 5; ++kt) {
#pragma unroll
            for (int i = 0; i < 16; ++i) S[kt][i] = 0.f;
#pragma unroll
            for (int ks = 0; ks < 4; ++ks) {
                const bf16x8 a = *(const bf16x8*)(Ks + (klb0 + 32 * kt + q32) * 72 + ks * 16 + 8 * h);
                S[kt] = __builtin_amdgcn_mfma_f32_32x32x16_bf16(a, qf[ks], S[kt], 0, 0, 0);
            }
        }
        float mx = -1e30f;
#pragma unroll
        for (int kt = 0; kt < 5; ++kt)
#pragma unroll
            for (int i = 0; i < 16; ++i) {
                const int m = 8 * (i >> 2) + 4 * h + (i & 3);
                const int kp = 128 * (n - 1) + klb0 + 32 * kt + m;
                const int rel = qp - kp;
                const bool ok = (rel >= 0) && (rel <= 128) && (kp >= 0);
                const float sv = ok ? S[kt][i] : -1e30f;
                S[kt][i] = sv; mx = fmaxf(mx, sv);
            }
        mx = fmaxf(mx, __shfl_xor(mx, 32));
        mx = fmaxf(mx, sink);
        float sum = 0.f;
#pragma unroll
        for (int kt = 0; kt < 5; ++kt)
#pragma unroll
            for (int i = 0; i < 16; ++i) { const float e = __expf(S[kt][i] - mx); S[kt][i] = e; sum += e; }
        sum += __shfl_xor(sum, 32);
        const float inv = 1.f / (sum + __expf(sink - mx));
        f32x16 O[2];
#pragma unroll
        for (int i = 0; i < 16; ++i) { O[0][i] = 0.f; O[1][i] = 0.f; }
#pragma unroll
        for (int kt = 0; kt < 5; ++kt)
#pragma unroll
            for (int sp = 0; sp < 2; ++sp) {
                bf16x8 pf;
#pragma unroll
                for (int j = 0; j < 8; ++j) pf[j] = (short)f2bf(S[kt][8 * sp + j]);
#pragma unroll
                for (int dt = 0; dt < 2; ++dt) {
                    const bf16_t* vp = Vt + (32 * dt + q32) * 264 + klb0 + 32 * kt + 16 * sp + 4 * h;
                    const uint2 lo = *(const uint2*)vp, hi = *(const uint2*)(vp + 8);
                    const uint4 av = make_uint4(lo.x, lo.y, hi.x, hi.y);
                    O[dt] = __builtin_amdgcn_mfma_f32_32x32x16_bf16(__builtin_bit_cast(bf16x8, av), pf, O[dt], 0, 0, 0);
                }
            }
        uint2 gq[2][4];
#pragma unroll
        for (int dt = 0; dt < 2; ++dt)
#pragma unroll
            for (int ig = 0; ig < 4; ++ig) gq[dt][ig] = *(const uint2*)(gt + qrow * DM + hq * 64 + 32 * dt + 8 * ig + 4 * h);
        __builtin_amdgcn_sched_barrier(0);
#pragma unroll
        for (int dt = 0; dt < 2; ++dt)
#pragma unroll
            for (int ig = 0; ig < 4; ++ig) {
                const int col = hq * 64 + 32 * dt + 8 * ig + 4 * h;
                const uint2 gg = gq[dt][ig];
                const float o0 = O[dt][4 * ig + 0] * inv * bflo(gg.x), o1 = O[dt][4 * ig + 1] * inv * bfhi(gg.x);
                const float o2 = O[dt][4 * ig + 2] * inv * bflo(gg.y), o3 = O[dt][4 * ig + 3] * inv * bfhi(gg.y);
                *(uint2*)(cc + qrow * DM + col) = make_uint2(pack2(o0, o1), pack2(o2, o3));
            }
    }
    __syncthreads();
}

__device__ void p3_sattn_item(const Params& p, float* lds, int l, int item) {
    const int tid = opq_tid(), wv = tid >> 6, lane = tid & 63;
    float* pl = lds + wv * 128;
    const int w = item * 8 + wv, bd = w >> 4, hq = w & 15, g = hq >> 2;
    const size_t row = (size_t)TP + bd;
    const bf16_t* qb = (const bf16_t*)(p.ws + WS_QB);
    const bf16_t* gt = (const bf16_t*)(p.ws + WS_GT);
    bf16_t* cc = (bf16_t*)(p.ws + WS_HB);
    float q[64];
#pragma unroll
    for (int c = 0; c < 8; ++c) {
        const uint4 u = *(const uint4*)(qb + row * 1024 + hq * 64 + c * 8);
        q[c * 8 + 0] = bflo(u.x); q[c * 8 + 1] = bfhi(u.x); q[c * 8 + 2] = bflo(u.y); q[c * 8 + 3] = bfhi(u.y);
        q[c * 8 + 4] = bflo(u.z); q[c * 8 + 5] = bfhi(u.z); q[c * 8 + 6] = bflo(u.w); q[c * 8 + 7] = bfhi(u.w);
    }
    const size_t cbase = ((size_t)(l * NBS + bd) * 128) * 256 + g * 64;
    const float* ck = p.cache_k + cbase;
    const float* cv = p.cache_v + cbase;
    float* nk = p.out + O_CKS + cbase;
    float* nv = p.out + O_CVS + cbase;
    float s0 = 0.f, s1 = 0.f, s2 = 0.f;
#pragma unroll
    for (int c = 0; c < 16; ++c) {
        const float4 a = ((const float4*)(ck + (size_t)lane * 256))[c];
        const float4 bq = ((const float4*)(ck + (size_t)(lane + 64) * 256))[c];
        const float4 e = ((const float4*)(nk + (size_t)127 * 256))[c];
        s0 += a.x * q[4 * c] + a.y * q[4 * c + 1] + a.z * q[4 * c + 2] + a.w * q[4 * c + 3];
        s1 += bq.x * q[4 * c] + bq.y * q[4 * c + 1] + bq.z * q[4 * c + 2] + bq.w * q[4 * c + 3];
        s2 += e.x * q[4 * c] + e.y * q[4 * c + 1] + e.z * q[4 * c + 2] + e.w * q[4 * c + 3];
    }
    const float sink = p.sinks[l * 16 + hq];
    const float mx = fmaxf(wave_max(fmaxf(s0, s1)), fmaxf(s2, sink));
    const float p0 = __expf(s0 - mx), p1 = __expf(s1 - mx), p2 = __expf(s2 - mx);
    const float sum = wave_sum(p0 + p1) + p2 + __expf(sink - mx);
    pl[lane] = p0; pl[lane + 64] = p1;
    __builtin_amdgcn_fence(__ATOMIC_RELEASE, "wavefront");
    __builtin_amdgcn_wave_barrier();
    __builtin_amdgcn_fence(__ATOMIC_ACQUIRE, "wavefront");
    float o = 0.f;
#pragma unroll 32
    for (int key = 0; key < 128; ++key) o += pl[key] * cv[(size_t)key * 256 + lane];
    o += p2 * nv[(size_t)127 * 256 + lane];
    o /= sum;
    const float gate = bf2f(gt[row * DM + hq * 64 + lane]);
    cc[row * DM + hq * 64 + lane] = f2bf(o * gate);
    {
        float tk[32], tv[32];
#pragma unroll
        for (int i = 0; i < 32; ++i) {
            const int ww = (hq & 3) + 4 * i;
            tk[i] = ck[(size_t)(ww + 1 < 128 ? ww + 1 : 127) * 256 + lane]; tv[i] = cv[(size_t)(ww + 1 < 128 ? ww + 1 : 127) * 256 + lane];
        }
#pragma unroll
        for (int i = 0; i < 32; ++i) {
            const int ww = (hq & 3) + 4 * i;
            if (ww < 127) { nk[(size_t)ww * 256 + lane] = tk[i]; nv[(size_t)ww * 256 + lane] = tv[i]; }
        }
    }
    __builtin_amdgcn_wave_barrier();
}

__device__ __forceinline__ float mix_val(const bf16_t* rw, const float* sshift, const float* mu, int r, int c) {
    const float cur = bf2f(rw[(size_t)r * SHD + c]);
    float prev;
    if (r >= TP) prev = sshift[(size_t)(r - TP) * SHD + c];
    else if ((r & 4095) == 0) prev = 0.f;
    else prev = bf2f(rw[(size_t)(r - 1) * SHD + c]);
    return cur + (prev - cur) * mu[c];
}

__device__ __forceinline__ float4 mix4(const bf16_t* rw, const float* sshift, int r, int c, float4 mu4) {
    const uint2 cu = *(const uint2*)(rw + (size_t)r * SHD + c);
    const float4 cur = make_float4(bflo(cu.x), bfhi(cu.x), bflo(cu.y), bfhi(cu.y));
    float4 prev = make_float4(0.f, 0.f, 0.f, 0.f);
    if (r >= TP) prev = *(const float4*)(sshift + (size_t)(r - TP) * SHD + c);
    else if ((r & 4095) != 0) { const uint2 pu = *(const uint2*)(rw + (size_t)(r - 1) * SHD + c); prev = make_float4(bflo(pu.x), bfhi(pu.x), bflo(pu.y), bfhi(pu.y)); }
    return make_float4(cur.x + (prev.x - cur.x) * mu4.x, cur.y + (prev.y - cur.y) * mu4.y, cur.z + (prev.z - cur.z) * mu4.z, cur.w + (prev.w - cur.w) * mu4.w);
}
__device__ __forceinline__ float decay_of(float x) {
    const float z = -x;
    const float sp = fmaxf(z, 0.f) + __logf(1.f + __expf(-fabsf(z)));
    return __expf(-__expf(-sp - 0.5f));
}

__device__ void p3_twad_item(const Params& p, int l, int tile) {
    const int tid = opq_tid();
    const bf16_t* rw = (const bf16_t*)(p.ws + WS_RW);
    const float* sshift = p.state_shift + (size_t)l * NBS * SHD;
    const float* mu = p.mu_shift + l * SHD;
    bf16_t* TWAD = (bf16_t*)(p.ws + WS_TWAD);
    const int r0 = tile * 32;
    float mm[8];
#pragma unroll
    for (int i = 0; i < 8; ++i) { const int idx = tid + 512 * i, tt = idx >> 7, c2 = idx & 127; mm[i] = mix_val(rw, sshift, mu, r0 + tt, 3072 + c2); }
#pragma unroll
    for (int i = 0; i < 8; ++i) {
        const int idx = tid + 512 * i, tt = idx >> 7, c2 = idx & 127;
        float o = mm[i];
        if (c2 < 64) { const float e = __expf(2.f * mm[i]); o = 1.f - 2.f / (e + 1.f); }
        TWAD[(size_t)(r0 + tt) * 128 + c2] = f2bf(o);
    }
}

__device__ void p3_prep_tile(const Params& p, unsigned char* lds, int l, int tile) {
    const int tid = opq_tid(), wv = tid >> 6, lane = tid & 63, n = lane & 31, h = lane >> 5;
    bf16_t* TW = (bf16_t*)lds;
    bf16_t* AD = TW + 32 * 72;
    const bf16_t* rw = (const bf16_t*)(p.ws + WS_RW);
    const float* sshift = p.state_shift + (size_t)l * NBS * SHD;
    const float* mu = p.mu_shift + l * SHD;
    bf16_t* RSB = (bf16_t*)(p.ws + WS_RSB);
    bf16_t* VALL = (bf16_t*)(p.ws + WS_VALL);
    float* RSW = (float*)(p.ws + WS_RSW);
    float* coef = (float*)(p.ws + WS_COEF);
    const int r0 = tile * 32;
    {
        float mm[8];
#pragma unroll
        for (int i = 0; i < 8; ++i) { const int idx = tid + 512 * i, tt = idx >> 7, c2 = idx & 127; mm[i] = mix_val(rw, sshift, mu, r0 + tt, 3072 + c2); }
        __builtin_amdgcn_sched_barrier(0);
#pragma unroll
        for (int i = 0; i < 8; ++i) {
            const int idx = tid + 512 * i, tt = idx >> 7, c2 = idx & 127;
            if (c2 < 64) { const float e = __expf(2.f * mm[i]); TW[tt * 72 + c2] = f2bf(1.f - 2.f / (e + 1.f)); }
            else AD[tt * 72 + (c2 - 64)] = f2bf(mm[i]);
        }
    }
    __syncthreads();
    const int col0 = wv * 128 + 4 * n;
    f32x16 acc[4];
    {
        const float* wp = p.w_decay + (size_t)l * 64 * 1024 + col0;
#pragma unroll
        for (int nt = 0; nt < 4; ++nt)
#pragma unroll
            for (int i = 0; i < 16; ++i) acc[nt][i] = 0.f;
#pragma unroll
        for (int ks = 0; ks < 4; ++ks) {
            const bf16x8 a = *(const bf16x8*)(TW + n * 72 + 16 * ks + 8 * h);
            float4 w4[8];
#pragma unroll
            for (int e = 0; e < 8; ++e) w4[e] = *(const float4*)(wp + (size_t)(16 * ks + 8 * h + e) * 1024);
            bf16x8 b0, b1, b2, b3;
#pragma unroll
            for (int e = 0; e < 8; ++e) { b0[e] = (short)f2bf(w4[e].x); b1[e] = (short)f2bf(w4[e].y); b2[e] = (short)f2bf(w4[e].z); b3[e] = (short)f2bf(w4[e].w); }
            acc[0] = __builtin_amdgcn_mfma_f32_32x32x16_bf16(a, b0, acc[0], 0, 0, 0);
            acc[1] = __builtin_amdgcn_mfma_f32_32x32x16_bf16(a, b1, acc[1], 0, 0, 0);
            acc[2] = __builtin_amdgcn_mfma_f32_32x32x16_bf16(a, b2, acc[2], 0, 0, 0);
            acc[3] = __builtin_amdgcn_mfma_f32_32x32x16_bf16(a, b3, acc[3], 0, 0, 0);
        }
        const float4 w0c = *(const float4*)(p.w0 + l * 1024 + col0);
#pragma unroll
        for (int r = 0; r < 16; ++r) {
            const int row = r0 + 8 * (r >> 2) + 4 * h + (r & 3);
            *(float4*)(RSW + (size_t)(row - TP) * 1024 + col0) =
                make_float4(decay_of(w0c.x + acc[0][r]), decay_of(w0c.y + acc[1][r]), decay_of(w0c.z + acc[2][r]), decay_of(w0c.w + acc[3][r]));
        }
    }
    {
        const float* wp = p.w_iclr + (size_t)l * 64 * 1024 + col0;
#pragma unroll
        for (int nt = 0; nt < 4; ++nt)
#pragma unroll
            for (int i = 0; i < 16; ++i) acc[nt][i] = 0.f;
#pragma unroll
        for (int ks = 0; ks < 4; ++ks) {
            const bf16x8 a = *(const bf16x8*)(AD + n * 72 + 16 * ks + 8 * h);
            float4 w4[8];
#pragma unroll
            for (int e = 0; e < 8; ++e) w4[e] = *(const float4*)(wp + (size_t)(16 * ks + 8 * h + e) * 1024);
            bf16x8 b0, b1, b2, b3;
#pragma unroll
            for (int e = 0; e < 8; ++e) { b0[e] = (short)f2bf(w4[e].x); b1[e] = (short)f2bf(w4[e].y); b2[e] = (short)f2bf(w4[e].z); b3[e] = (short)f2bf(w4[e].w); }
            acc[0] = __builtin_amdgcn_mfma_f32_32x32x16_bf16(a, b0, acc[0], 0, 0, 0);
            acc[1] = __builtin_amdgcn_mfma_f32_32x32x16_bf16(a, b1, acc[1], 0, 0, 0);
            acc[2] = __builtin_amdgcn_mfma_f32_32x32x16_bf16(a, b2, acc[2], 0, 0, 0);
            acc[3] = __builtin_amdgcn_mfma_f32_32x32x16_bf16(a, b3, acc[3], 0, 0, 0);
        }
    }
    const float4 a0c = *(const float4*)(p.a0 + l * 1024 + col0), kkc = *(const float4*)(p.k_k + l * 1024 + col0), kac = *(const float4*)(p.k_a + l * 1024 + col0), rkc = *(const float4*)(p.r_k + l * 1024 + col0);
    const float4 mur = *(const float4*)(mu + col0), muk = *(const float4*)(mu + 1024 + col0), muv = *(const float4*)(mu + 2048 + col0);
    const int head = 2 * wv + (n >> 4);
#pragma unroll
    for (int g4 = 0; g4 < 4; ++g4) {
        float4 rr4[4], kr4[4], vr4[4];
#pragma unroll
        for (int q = 0; q < 4; ++q) {
            const int row = r0 + 8 * g4 + 4 * h + q;
            rr4[q] = mix4(rw, sshift, row, col0, mur); kr4[q] = mix4(rw, sshift, row, 1024 + col0, muk); vr4[q] = mix4(rw, sshift, row, 2048 + col0, muv);
        }
        __builtin_amdgcn_sched_barrier(0);
#pragma unroll
        for (int q = 0; q < 4; ++q) {
            const int r = 4 * g4 + q;
            const int row = r0 + 8 * g4 + 4 * h + q;
            const float4 rr = rr4[q], kr = kr4[q], vr = vr4[q];
            const float ax = 1.f / (1.f + __expf(-(a0c.x + acc[0][r]))), ay = 1.f / (1.f + __expf(-(a0c.y + acc[1][r])));
            const float az = 1.f / (1.f + __expf(-(a0c.z + acc[2][r]))), aw = 1.f / (1.f + __expf(-(a0c.w + acc[3][r])));
            const float k0 = kr.x * kkc.x, k1 = kr.y * kkc.y, k2 = kr.z * kkc.z, k3 = kr.w * kkc.w;
            const float ss = allreduce16(k0 * k0 + k1 * k1 + k2 * k2 + k3 * k3);
            const float inv = 1.f / fmaxf(sqrtf(ss), 1e-12f);
            const float4 kk = make_float4(k0 * inv, k1 * inv, k2 * inv, k3 * inv);
            const float4 ke = make_float4(kr.x * (1.f + (ax - 1.f) * kac.x), kr.y * (1.f + (ay - 1.f) * kac.y), kr.z * (1.f + (az - 1.f) * kac.z), kr.w * (1.f + (aw - 1.f) * kac.w));
            const float cf = allreduce16(rr.x * ke.x * rkc.x + rr.y * ke.y * rkc.y + rr.z * ke.z * rkc.z + rr.w * ke.w * rkc.w);
            if ((n & 15) == 0) coef[(size_t)row * 16 + head] = cf;
            const size_t o = (size_t)row * 1024 + col0;
            const size_t os = (size_t)(row - TP) * 1024 + col0;
            *(uint2*)(RSB + os) = make_uint2(pack2(rr.x, rr.y), pack2(rr.z, rr.w));
            *(uint2*)(RSB + SRI + os) = make_uint2(pack2(ke.x, ke.y), pack2(ke.z, ke.w));
            *(uint2*)(RSB + 2 * SRI + os) = make_uint2(pack2(kk.x, kk.y), pack2(kk.z, kk.w));
            *(uint2*)(RSB + 3 * SRI + os) = make_uint2(pack2(kk.x * ax, kk.y * ay), pack2(kk.z * az, kk.w * aw));
            *(uint2*)(VALL + o) = make_uint2(pack2(vr.x, vr.y), pack2(vr.z, vr.w));
        }
        __builtin_amdgcn_sched_barrier(0);
    }
    __syncthreads();
}

constexpr int REC_BYTES = 14592;
constexpr int PA_WLDS = 16384;
typedef float f32x4v __attribute__((ext_vector_type(4)));

__device__ void pa_chunk(const Params& p, unsigned char* wl, int l, int ct) {
    const int lane = opq_tid() & 63;
    const int hh = ct >> 8, c = ct & 255, b = hh >> 4, h = hh & 15;
    const size_t row0 = (size_t)b * SEQ + 16 * c;
    const int col = h * 64 + lane;
    bf16_t* VALL = (bf16_t*)(p.ws + WS_VALL);
    float vv[16];
    float gC;
    bf16_t* S_AB = (bf16_t*)wl; bf16_t* S_BB = S_AB + 16 * 72; bf16_t* S_KB = S_BB + 16 * 72; bf16_t* S_RT = S_KB + 16 * 72;
    {
        const bf16_t* rw = (const bf16_t*)(p.ws + WS_RW);
        const bf16_t* TWAD = (const bf16_t*)(p.ws + WS_TWAD);
        const uint4* WFd = (const uint4*)(p.ws + WS_WFRAG) + (size_t)((l * 2 + 0) * 16 + h) * 512 + lane;
        const uint4* WFi = (const uint4*)(p.ws + WS_WFRAG) + (size_t)((l * 2 + 1) * 16 + h) * 512 + lane;
        unsigned xr[17], xk[17], xv[17];
        const bool first = (row0 & 4095) == 0;
#pragma unroll
        for (int t = 0; t < 17; ++t) {
            const unsigned ro = (unsigned)(row0 + t - 1) * (unsigned)SHD + (unsigned)col;
            if (t == 0 && first) { xr[0] = 0u; xk[0] = 0u; xv[0] = 0u; }
            else { xr[t] = rw[ro]; xk[t] = rw[ro + 1024u]; xv[t] = rw[ro + 2048u]; }
        }
        const int rr = lane & 15, kg = lane >> 4;
        f32x4v Dd[4], Da[4];
#pragma unroll
        for (int ct = 0; ct < 4; ++ct) { Dd[ct] = (f32x4v){0.f, 0.f, 0.f, 0.f}; Da[ct] = Dd[ct]; }
#pragma unroll
        for (int ks = 0; ks < 2; ++ks) {
            const bf16x8 atw = *(const bf16x8*)(TWAD + (size_t)(row0 + rr) * 128 + 32 * ks + 8 * kg);
            const bf16x8 aad = *(const bf16x8*)(TWAD + (size_t)(row0 + rr) * 128 + 64 + 32 * ks + 8 * kg);
#pragma unroll
            for (int ct = 0; ct < 4; ++ct) {
                const bf16x8 bd = __builtin_bit_cast(bf16x8, WFd[(ct * 2 + ks) * 64]);
                const bf16x8 bi = __builtin_bit_cast(bf16x8, WFi[(ct * 2 + ks) * 64]);
                Dd[ct] = __builtin_amdgcn_mfma_f32_16x16x32_bf16(atw, bd, Dd[ct], 0, 0, 0);
                Da[ct] = __builtin_amdgcn_mfma_f32_16x16x32_bf16(aad, bi, Da[ct], 0, 0, 0);
            }
        }
        float* LD = (float*)wl; float* LA = LD + 1024;
#pragma unroll
        for (int ct = 0; ct < 4; ++ct)
#pragma unroll
            for (int rg = 0; rg < 4; ++rg) { LD[(4 * kg + rg) * 64 + 16 * ct + rr] = Dd[ct][rg]; LA[(4 * kg + rg) * 64 + 16 * ct + rr] = Da[ct][rg]; }
        __builtin_amdgcn_fence(__ATOMIC_RELEASE, "wavefront"); __builtin_amdgcn_wave_barrier(); __builtin_amdgcn_fence(__ATOMIC_ACQUIRE, "wavefront");
        float din[16], ain[16];
#pragma unroll
        for (int t = 0; t < 16; ++t) { din[t] = LD[t * 64 + lane]; ain[t] = LA[t * 64 + lane]; }
        __builtin_amdgcn_fence(__ATOMIC_RELEASE, "wavefront"); __builtin_amdgcn_wave_barrier(); __builtin_amdgcn_fence(__ATOMIC_ACQUIRE, "wavefront");
        const float mur = p.mu_shift[l * SHD + col], muk = p.mu_shift[l * SHD + 1024 + col], muv = p.mu_shift[l * SHD + 2048 + col];
        const float w0c = p.w0[l * 1024 + col], a0c = p.a0[l * 1024 + col], kkc = p.k_k[l * 1024 + col], kac = p.k_a[l * 1024 + col], rkc = p.r_k[l * 1024 + col];
        float* coef = (float*)(p.ws + WS_COEF);
        float g = 1.f;
#pragma unroll
        for (int t = 0; t < 16; ++t) {
            const float cr = bf2f((unsigned short)xr[t + 1]), pr = bf2f((unsigned short)xr[t]), ck = bf2f((unsigned short)xk[t + 1]), pk = bf2f((unsigned short)xk[t]);
            const float cv = bf2f((unsigned short)xv[t + 1]), pv = bf2f((unsigned short)xv[t]);
            const float r_ = cr + (pr - cr) * mur, kr = ck + (pk - ck) * muk, vr = cv + (pv - cv) * muv;
            const float a = 1.f / (1.f + __expf(-(a0c + ain[t])));
            const float dec = decay_of(w0c + din[t]);
            const float kkr = kr * kkc;
            float ss = allreduce16(kkr * kkr); ss += __shfl_xor(ss, 16); ss += __shfl_xor(ss, 32);
            const float kkv = kkr / fmaxf(sqrtf(ss), 1e-12f);
            const float ke = kr * (1.f + (a - 1.f) * kac);
            float cf = allreduce16(r_ * ke * rkc); cf += __shfl_xor(cf, 16); cf += __shfl_xor(cf, 32);
            if (lane == 0) coef[(size_t)(row0 + t) * 16 + h] = cf;
            VALL[(unsigned)(row0 + t) * 1024u + (unsigned)col] = f2bf(vr);
            vv[t] = vr;
            S_AB[t * 72 + lane] = f2bf(-g * kkv);
            g *= dec;
            const float ig = __builtin_amdgcn_rcpf(g);
            S_BB[t * 72 + lane] = f2bf(kkv * a * ig); S_KB[t * 72 + lane] = f2bf(ke * ig); S_RT[t * 72 + lane] = f2bf(g * r_);
        }
        gC = g;
    }
    __builtin_amdgcn_fence(__ATOMIC_RELEASE, "wavefront"); __builtin_amdgcn_wave_barrier(); __builtin_amdgcn_fence(__ATOMIC_ACQUIRE, "wavefront");
    f32x4v Gab = {0.f, 0.f, 0.f, 0.f}, Gak = Gab, Grb = Gab, Grk = Gab;
    {
        const int rr = lane & 15, kg = lane >> 4;
#pragma unroll
        for (int ks = 0; ks < 2; ++ks) {
            const int o = rr * 72 + 32 * ks + 8 * kg;
            const bf16x8 fA = *(const bf16x8*)(S_AB + o), fB = *(const bf16x8*)(S_BB + o), fK = *(const bf16x8*)(S_KB + o), fR = *(const bf16x8*)(S_RT + o);
            Gab = __builtin_amdgcn_mfma_f32_16x16x32_bf16(fB, fA, Gab, 0, 0, 0);
            Gak = __builtin_amdgcn_mfma_f32_16x16x32_bf16(fK, fA, Gak, 0, 0, 0);
            Grb = __builtin_amdgcn_mfma_f32_16x16x32_bf16(fB, fR, Grb, 0, 0, 0);
            Grk = __builtin_amdgcn_mfma_f32_16x16x32_bf16(fK, fR, Grk, 0, 0, 0);
        }
    }
    __builtin_amdgcn_fence(__ATOMIC_RELEASE, "wavefront"); __builtin_amdgcn_wave_barrier(); __builtin_amdgcn_fence(__ATOMIC_ACQUIRE, "wavefront");
    float* M_AB = (float*)(wl + 9216); float* M_AK = M_AB + 256; float* M_RB = M_AK + 256; float* M_RK = M_RB + 256; float* T_ = M_RK + 256; float* Q_ = T_ + 256; float* W2_ = Q_ + 256;
    {
        const int t = lane & 15, kg = lane >> 4;
#pragma unroll
        for (int rg = 0; rg < 4; ++rg) {
            const int s = 4 * kg + rg;
            M_AB[s * 16 + t] = s < t ? Gab[rg] : 0.f; M_AK[s * 16 + t] = s < t ? Gak[rg] : 0.f;
            M_RB[s * 16 + t] = s <= t ? Grb[rg] : 0.f; M_RK[s * 16 + t] = s <= t ? Grk[rg] : 0.f;
        }
    }
    __builtin_amdgcn_fence(__ATOMIC_RELEASE, "wavefront"); __builtin_amdgcn_wave_barrier(); __builtin_amdgcn_fence(__ATOMIC_ACQUIRE, "wavefront");
    {
        const int rr = lane & 15;
        float Tr[16];
#pragma unroll
        for (int t = 0; t < 16; ++t) {
            float acc = (rr == t) ? 1.f : 0.f;
#pragma unroll
            for (int s = 0; s < t; ++s) acc += Tr[s] * M_AB[s * 16 + t];
            Tr[t] = acc;
        }
#pragma unroll
        for (int t = 0; t < 16; ++t) T_[rr * 16 + t] = Tr[t];
    }
    __builtin_amdgcn_fence(__ATOMIC_RELEASE, "wavefront"); __builtin_amdgcn_wave_barrier(); __builtin_amdgcn_fence(__ATOMIC_ACQUIRE, "wavefront");
    {
        const int s = lane & 15, tq = lane >> 4;
        float4 q = make_float4(0.f, 0.f, 0.f, 0.f);
#pragma unroll
        for (int u = 0; u < 16; ++u) { const float a = M_AK[s * 16 + u]; const float4 t4 = *(const float4*)(T_ + u * 16 + 4 * tq); q.x += a * t4.x; q.y += a * t4.y; q.z += a * t4.z; q.w += a * t4.w; }
        *(float4*)(Q_ + s * 16 + 4 * tq) = q;
        __builtin_amdgcn_fence(__ATOMIC_RELEASE, "wavefront"); __builtin_amdgcn_wave_barrier(); __builtin_amdgcn_fence(__ATOMIC_ACQUIRE, "wavefront");
        float4 w2 = *(const float4*)(M_RK + s * 16 + 4 * tq);
#pragma unroll
        for (int u = 0; u < 16; ++u) { const float a = Q_[s * 16 + u]; const float4 m4 = *(const float4*)(M_RB + u * 16 + 4 * tq); w2.x += a * m4.x; w2.y += a * m4.y; w2.z += a * m4.z; w2.w += a * m4.w; }
        *(float4*)(W2_ + s * 16 + 4 * tq) = w2;
    }
    __builtin_amdgcn_fence(__ATOMIC_RELEASE, "wavefront"); __builtin_amdgcn_wave_barrier(); __builtin_amdgcn_fence(__ATOMIC_ACQUIRE, "wavefront");
    cvt_f32x2 pt2[8], r22[8], ul2[8], yl2[8];
#pragma unroll
    for (int t = 0; t < 8; ++t) { pt2[t] = (cvt_f32x2){0.f, 0.f}; r22[t] = (cvt_f32x2){bf2f(S_RT[(2 * t) * 72 + lane]), bf2f(S_RT[(2 * t + 1) * 72 + lane])}; ul2[t] = pt2[t]; yl2[t] = pt2[t]; }
#pragma unroll
    for (int s = 0; s < 16; ++s) {
        const float as_ = bf2f(S_AB[s * 72 + lane]), vs_ = vv[s];
        const cvt_f32x2 as2 = {as_, as_}, vs2 = {vs_, vs_};
#pragma unroll
        for (int tq = 0; tq < 4; ++tq) {
            const float4 t4 = *(const float4*)(T_ + s * 16 + 4 * tq), q4 = *(const float4*)(Q_ + s * 16 + 4 * tq), w4 = *(const float4*)(W2_ + s * 16 + 4 * tq);
            pt2[2 * tq] += (cvt_f32x2){t4.x, t4.y} * as2; pt2[2 * tq + 1] += (cvt_f32x2){t4.z, t4.w} * as2;
            ul2[2 * tq] += (cvt_f32x2){q4.x, q4.y} * vs2; ul2[2 * tq + 1] += (cvt_f32x2){q4.z, q4.w} * vs2;
            yl2[2 * tq] += (cvt_f32x2){w4.x, w4.y} * vs2; yl2[2 * tq + 1] += (cvt_f32x2){w4.z, w4.w} * vs2;
        }
        __builtin_amdgcn_sched_barrier(0);
    }
    float pt[16], ul[16], yl[16];
#pragma unroll
    for (int t = 0; t < 8; ++t) { pt[2 * t] = pt2[t].x; pt[2 * t + 1] = pt2[t].y; ul[2 * t] = ul2[t].x; ul[2 * t + 1] = ul2[t].y; yl[2 * t] = yl2[t].x; yl[2 * t + 1] = yl2[t].y; }
#pragma unroll
    for (int s = 0; s < 16; ++s) {
        const cvt_f32x2 ps2 = {pt[s], pt[s]};
#pragma unroll
        for (int tq = 0; tq < 4; ++tq) {
            const float4 m4 = *(const float4*)(M_RB + s * 16 + 4 * tq);
            r22[2 * tq] += (cvt_f32x2){m4.x, m4.y} * ps2; r22[2 * tq + 1] += (cvt_f32x2){m4.z, m4.w} * ps2;
        }
        __builtin_amdgcn_sched_barrier(0);
    }
    float r2[16];
#pragma unroll
    for (int t = 0; t < 8; ++t) { r2[2 * t] = r22[t].x; r2[2 * t + 1] = r22[t].y; }
    unsigned char* rec = p.ws + WS_REC + (size_t)ct * REC_BYTES;
    float* ys = (float*)(p.ws + WS_YS);
    {
#pragma unroll
        for (int t = 0; t < 16; ++t) { S_AB[t * 72 + lane] = f2bf(pt[t]); S_RT[t * 72 + lane] = f2bf(r2[t]); }
        __builtin_amdgcn_fence(__ATOMIC_RELEASE, "wavefront"); __builtin_amdgcn_wave_barrier(); __builtin_amdgcn_fence(__ATOMIC_ACQUIRE, "wavefront");
#pragma unroll
        for (int i2 = 0; i2 < 2; ++i2) {
            const int q = lane + 64 * i2, f = q >> 5, hf = (q >> 4) & 1, t = q & 15;
            const uint2 a0 = *(const uint2*)(S_AB + t * 72 + 16 * f + 4 * hf), a1 = *(const uint2*)(S_AB + t * 72 + 16 * f + 8 + 4 * hf);
            const uint2 c0 = *(const uint2*)(S_RT + t * 72 + 16 * f + 4 * hf), c1 = *(const uint2*)(S_RT + t * 72 + 16 * f + 8 + 4 * hf);
            st_sc1_b128(rec + q * 16, a0.x, a0.y, a1.x, a1.y);
            st_sc1_b128(rec + 2048 + q * 16, c0.x, c0.y, c1.x, c1.y);
        }
        {
            float* YT = (float*)(wl + 9216);
#pragma unroll
            for (int t = 0; t < 16; ++t) YT[t * 64 + lane] = yl[t];
            __builtin_amdgcn_fence(__ATOMIC_RELEASE, "wavefront"); __builtin_amdgcn_wave_barrier(); __builtin_amdgcn_fence(__ATOMIC_ACQUIRE, "wavefront");
#pragma unroll
            for (int i4 = 0; i4 < 4; ++i4) {
                const int idx = lane + 64 * i4, t = idx >> 4, q4 = idx & 15;
                const float4 y4 = *(const float4*)(YT + t * 64 + 4 * q4);
                st_sc1_b128(ys + (unsigned)(row0 + t) * 1024u + (unsigned)(h * 64 + 4 * q4), __float_as_uint(y4.x), __float_as_uint(y4.y), __float_as_uint(y4.z), __float_as_uint(y4.w));
            }
        }
    }
    {
        float gb[16], gk[16];
#pragma unroll
        for (int t = 0; t < 16; ++t) { gb[t] = gC * bf2f(S_BB[t * 72 + lane]); gk[t] = gC * bf2f(S_KB[t * 72 + lane]); }
        st_sc1_b128(rec + 4096 + lane * 16, pack2(gb[0], gb[1]), pack2(gb[2], gb[3]), pack2(gb[8], gb[9]), pack2(gb[10], gb[11]));
        st_sc1_b128(rec + 4096 + (64 + lane) * 16, pack2(gb[4], gb[5]), pack2(gb[6], gb[7]), pack2(gb[12], gb[13]), pack2(gb[14], gb[15]));
        st_sc1_b128(rec + 6144 + lane * 16, pack2(gk[0], gk[1]), pack2(gk[2], gk[3]), pack2(gk[4], gk[5]), pack2(gk[6], gk[7]));
        st_sc1_b128(rec + 6144 + (64 + lane) * 16, pack2(gk[8], gk[9]), pack2(gk[10], gk[11]), pack2(gk[12], gk[13]), pack2(gk[14], gk[15]));
        st_sc1_b32(rec + 8192 + lane * 4, gC);
        unsigned char* ip = rec + 8448 + (lane >> 5) * 3072;
        const int il = lane & 31;
        st_sc1_b128(ip + il * 16, pack2(vv[0], vv[1]), pack2(vv[2], vv[3]), pack2(vv[4], vv[5]), pack2(vv[6], vv[7]));
        st_sc1_b128(ip + (32 + il) * 16, pack2(vv[8], vv[9]), pack2(vv[10], vv[11]), pack2(vv[12], vv[13]), pack2(vv[14], vv[15]));
#pragma unroll
        for (int tq = 0; tq < 4; ++tq) st_sc1_b128(ip + 1024 + (((tq >> 1) * 2 + (tq & 1)) * 32 + il) * 16, __float_as_uint(ul[4 * tq]), __float_as_uint(ul[4 * tq + 1]), __float_as_uint(ul[4 * tq + 2]), __float_as_uint(ul[4 * tq + 3]));
    }
    asm volatile("s_waitcnt vmcnt(0)" ::: "memory");
    if (lane == 0) __hip_atomic_store((unsigned*)(p.ws + WS_RFLAG + (size_t)ct * 64), (unsigned)(l + 1), __ATOMIC_RELAXED, __HIP_MEMORY_SCOPE_AGENT);
    __builtin_amdgcn_fence(__ATOMIC_RELEASE, "wavefront"); __builtin_amdgcn_wave_barrier();
}

__device__ void pa_sample_task(const Params& p, int l, int task) {
    const int lane = opq_tid() & 63;
    const int bd = task >> 8, h = (task >> 4) & 15, wq = task & 15;
    const int irow = 4 * wq + (lane >> 4), jq = lane & 15;
    const size_t row = (size_t)TP + bd;
    const bf16_t* RSB = (const bf16_t*)(p.ws + WS_RSB);
    const float* RSW = (const float*)(p.ws + WS_RSW);
    const bf16_t* VALL = (const bf16_t*)(p.ws + WS_VALL);
    float* ys = (float*)(p.ws + WS_YS);
    const size_t so = (((size_t)(l * NBS + bd) * 16 + h) * 64 + irow) * 64 + 4 * jq;
    float4 s = *(const float4*)(p.state_wkv + so);
    const size_t o = row * 1024 + h * 64 + 4 * jq;
    const size_t os = (size_t)bd * 1024 + h * 64 + 4 * jq;
    const uint2 ur = *(const uint2*)(RSB + os), uk = *(const uint2*)(RSB + SRI + os), ukk = *(const uint2*)(RSB + 2 * SRI + os), ub = *(const uint2*)(RSB + 3 * SRI + os);
    const float4 w4 = *(const float4*)(RSW + os);
    const float v = bf2f(VALL[row * 1024 + h * 64 + irow]);
    float pa = s.x * bflo(ukk.x) + s.y * bfhi(ukk.x) + s.z * bflo(ukk.y) + s.w * bfhi(ukk.y);
    pa = allreduce16(pa);
    const float sa = -pa;
    s.x = fmaf(sa, bflo(ub.x), fmaf(s.x, w4.x, v * bflo(uk.x)));
    s.y = fmaf(sa, bfhi(ub.x), fmaf(s.y, w4.y, v * bfhi(uk.x)));
    s.z = fmaf(sa, bflo(ub.y), fmaf(s.z, w4.z, v * bflo(uk.y)));
    s.w = fmaf(sa, bfhi(ub.y), fmaf(s.w, w4.w, v * bfhi(uk.y)));
    float py = s.x * bflo(ur.x) + s.y * bfhi(ur.x) + s.z * bflo(ur.y) + s.w * bfhi(ur.y);
    py = allreduce16(py);
    *(float4*)(p.out + O_WKVS + so) = s;
    if (jq == 0) ys[row * 1024 + h * 64 + irow] = py;
}

__device__ __forceinline__ uint4 ld_sc1_b128(const unsigned char* p) {
    const unsigned long long a = __hip_atomic_load((const unsigned long long*)p, __ATOMIC_RELAXED, __HIP_MEMORY_SCOPE_AGENT), c = __hip_atomic_load((const unsigned long long*)(p + 8), __ATOMIC_RELAXED, __HIP_MEMORY_SCOPE_AGENT);
    return make_uint4((unsigned)a, (unsigned)(a >> 32), (unsigned)c, (unsigned)(c >> 32));
}
constexpr int PB_NB = 8, PB_SLOT = 13568, PB_NCH = SEQ / 16, PB_NX = 4, PB_XOFF = PB_NB * PB_SLOT  , PB_FOFF = PB_XOFF + PB_NX * 4096;
__device__ void pb_head(const Params& p, unsigned char* lds, int l, int blk, bool dry) {
    const int tid = opq_tid(), wv = tid >> 6, lane = tid & 63;
    const int hh = blk >> 1, it = blk & 1, b = hh >> 4, h = hh & 15;
    volatile LAS unsigned* flags = (volatile LAS unsigned*)((LAS unsigned char*)lds + PB_FOFF);
    if (tid < 16) flags[tid] = 0u;
    __syncthreads();
    const unsigned char* rec0 = p.ws + WS_REC + (size_t)(hh * 256) * REC_BYTES;
    float* ys = (float*)(p.ws + WS_YS) + ((size_t)b * SEQ) * 1024 + h * 64 + 32 * it;
    const int q32 = lane & 31, hf = lane >> 5;
    if (wv >= 2) {
        unsigned nf = __hip_atomic_load((const unsigned*)(p.ws + WS_RFLAG + (size_t)(hh * 256 + (wv - 2)) * 64), __ATOMIC_RELAXED, __HIP_MEMORY_SCOPE_AGENT);
#pragma unroll 1
        for (int c = wv - 2; c < PB_NCH; c += 6) {
            while (c - (int)flags[8] >= PB_NB || c - (int)flags[9] >= PB_NB) __builtin_amdgcn_s_sleep(8);
            asm volatile("" ::: "memory");
            {
                const unsigned* rf = (const unsigned*)(p.ws + WS_RFLAG + (size_t)(hh * 256 + c) * 64);
                while (nf != (unsigned)(l + 1)) { __builtin_amdgcn_s_sleep(2); nf = __hip_atomic_load(rf, __ATOMIC_RELAXED, __HIP_MEMORY_SCOPE_AGENT); }
                asm volatile("" ::: "memory");
            }
            const unsigned char* rec = rec0 + (size_t)c * REC_BYTES;
            unsigned char* sl = lds + (c % PB_NB) * PB_SLOT;
            const unsigned char* rc = rec + lane * 16;
            const unsigned char* ri = rec + 8448 + it * 3072 + lane * 16;
#define LD_SC1(p_) ld_sc1_b128((const unsigned char*)(p_))
            const uint4 d0 = LD_SC1(rc), d1 = LD_SC1(rc + 1024), d2 = LD_SC1(rc + 2048), d3 = LD_SC1(rc + 3072);
            const uint4 d4 = LD_SC1(rc + 4096), d5 = LD_SC1(rc + 5120), d6 = LD_SC1(rc + 6144), d7 = LD_SC1(rc + 7168);
            const uint4 d8 = LD_SC1(rec + 8192 + (lane & 15) * 16);
            const uint4 d9 = LD_SC1(ri), d10 = LD_SC1(ri + 1024), d11 = LD_SC1(ri + 2048);
            const int t0 = lane >> 3, cc = lane & 7;
            const uint4 d12 = LD_SC1(ys + (size_t)(16 * c + t0) * 1024 + cc * 4), d13 = LD_SC1(ys + (size_t)(16 * c + 8 + t0) * 1024 + cc * 4);
#undef LD_SC1
            nf = (c + 6 < PB_NCH) ? __hip_atomic_load((const unsigned*)(p.ws + WS_RFLAG + (size_t)(hh * 256 + c + 6) * 64), __ATOMIC_RELAXED, __HIP_MEMORY_SCOPE_AGENT) : 0u;
            __builtin_amdgcn_sched_barrier(0);
            unsigned char* sd = sl + lane * 16;
            *(uint4*)(sd) = d0; *(uint4*)(sd + 1024) = d1; *(uint4*)(sd + 2048) = d2; *(uint4*)(sd + 3072) = d3;
            *(uint4*)(sd + 4096) = d4; *(uint4*)(sd + 5120) = d5; *(uint4*)(sd + 6144) = d6; *(uint4*)(sd + 7168) = d7;
            if (lane < 16) *(uint4*)(sl + 8192 + lane * 16) = d8;
            *(uint4*)(sd + 8448) = d9; *(uint4*)(sd + 9472) = d10; *(uint4*)(sd + 10496) = d11;
            {
                float* yd = (float*)(sl + 11520) + ((((t0 >> 2) & 1) * 32 + 4 * cc) * 4 + (t0 & 3));
                yd[0] = __uint_as_float(d12.x); yd[4] = __uint_as_float(d12.y); yd[8] = __uint_as_float(d12.z); yd[12] = __uint_as_float(d12.w);
                yd[256] = __uint_as_float(d13.x); yd[260] = __uint_as_float(d13.y); yd[264] = __uint_as_float(d13.z); yd[268] = __uint_as_float(d13.w);
            }
            asm volatile("" ::: "memory");
            if (lane == 0) flags[c % PB_NB] = (unsigned)(c + 1);
        }
    } else if (wv == 1) {
        bf16x8 ra0, ra1, ra2, ra3; float4 y0, y1;
#define PB_FETCHY(c_) do { const unsigned char* sl_ = lds + ((c_) % PB_NB) * PB_SLOT; \
            while (flags[(c_) % PB_NB] != (unsigned)((c_) + 1)) __builtin_amdgcn_s_sleep(0); \
            asm volatile("" ::: "memory"); \
            const unsigned char* pr_ = sl_ + 2048 + (hf * 16 + (q32 & 15)) * 16; \
            ra0 = *(const bf16x8*)(pr_); ra1 = *(const bf16x8*)(pr_ + 512); ra2 = *(const bf16x8*)(pr_ + 1024); ra3 = *(const bf16x8*)(pr_ + 1536); \
            y0 = *(const float4*)(sl_ + 11520 + (hf * 32 + q32) * 16); y1 = *(const float4*)(sl_ + 11520 + ((2 + hf) * 32 + q32) * 16); \
            asm volatile("" ::: "memory"); \
            if (lane == 0) flags[9] = (unsigned)((c_) + 1); } while (0)
        PB_FETCHY(0);
#pragma unroll 1
        for (int c = 0; c < PB_NCH; ++c) {
            const unsigned char* xr = lds + PB_XOFF + (c % PB_NX) * 4096 + lane * 16;
            f32x16 Ya, Yb;
            Ya[0] = y0.x; Ya[1] = y0.y; Ya[2] = y0.z; Ya[3] = y0.w; Ya[4] = y1.x; Ya[5] = y1.y; Ya[6] = y1.z; Ya[7] = y1.w;
#pragma unroll
            for (int r = 8; r < 16; ++r) Ya[r] = 0.f;
#pragma unroll
            for (int r = 0; r < 16; ++r) Yb[r] = 0.f;
            const bf16x8 rc0 = ra0, rc1 = ra1, rc2 = ra2, rc3 = ra3;
            while (flags[10 + (c % PB_NX)] != (unsigned)(c + 1)) __builtin_amdgcn_s_sleep(0);
            asm volatile("" ::: "memory");
            const bf16x8 xf0 = *(const bf16x8*)(xr), xf1 = *(const bf16x8*)(xr + 1024), xf2 = *(const bf16x8*)(xr + 2048), xf3 = *(const bf16x8*)(xr + 3072);
            asm volatile("" ::: "memory");
            if (lane == 0) flags[14] = (unsigned)(c + 1);
            Ya = __builtin_amdgcn_mfma_f32_32x32x16_bf16(rc0, xf0, Ya, 0, 0, 0);
            Yb = __builtin_amdgcn_mfma_f32_32x32x16_bf16(rc1, xf1, Yb, 0, 0, 0);
            Ya = __builtin_amdgcn_mfma_f32_32x32x16_bf16(rc2, xf2, Ya, 0, 0, 0);
            Yb = __builtin_amdgcn_mfma_f32_32x32x16_bf16(rc3, xf3, Yb, 0, 0, 0);
            if (c + 1 < PB_NCH) PB_FETCHY(c + 1);
            float* yc = ys + (size_t)c * (16 * 1024);
            if (!dry) {
#pragma unroll
                for (int r = 0; r < 8; ++r) yc[(8 * (r >> 2) + 4 * hf + (r & 3)) * 1024 + q32] = Ya[r] + Yb[r];
            }
        }
#undef PB_FETCHY
    } else {
        f32x16 X0, X1;
#pragma unroll
        for (int i = 0; i < 16; ++i) { X0[i] = 0.f; X1[i] = 0.f; }
        bf16x8 pa0, pa1, pa2, pa3, gb0, gb1, gk0, gk1, vf;
        float4 gm0, gm1, gm2, gm3, gm4, gm5, gm6, gm7, u0, u1;
#define PB_FETCH(c_) do { const unsigned char* sl_ = lds + ((c_) % PB_NB) * PB_SLOT; \
            { unsigned rv_ = rdy; while (rv_ != (unsigned)((c_) + 1)) { __builtin_amdgcn_s_sleep(0); rv_ = flags[(c_) % PB_NB]; } } \
            asm volatile("" ::: "memory"); \
            const unsigned char* pr_ = sl_ + (hf * 16 + (q32 & 15)) * 16; \
            pa0 = *(const bf16x8*)(pr_); pa1 = *(const bf16x8*)(pr_ + 512); pa2 = *(const bf16x8*)(pr_ + 1024); pa3 = *(const bf16x8*)(pr_ + 1536); \
            gb0 = *(const bf16x8*)(sl_ + 4096 + (hf * 64 + q32) * 16); gb1 = *(const bf16x8*)(sl_ + 4096 + (hf * 64 + 32 + q32) * 16); \
            gk0 = *(const bf16x8*)(sl_ + 6144 + (hf * 64 + q32) * 16); gk1 = *(const bf16x8*)(sl_ + 6144 + (hf * 64 + 32 + q32) * 16); \
            vf = *(const bf16x8*)(sl_ + 8448 + (hf * 32 + q32) * 16); \
            const unsigned char* gp_ = sl_ + 8192 + 16 * hf; \
            gm0 = *(const float4*)(gp_); gm1 = *(const float4*)(gp_ + 32); gm2 = *(const float4*)(gp_ + 64); gm3 = *(const float4*)(gp_ + 96); \
            gm4 = *(const float4*)(gp_ + 128); gm5 = *(const float4*)(gp_ + 160); gm6 = *(const float4*)(gp_ + 192); gm7 = *(const float4*)(gp_ + 224); \
            u0 = *(const float4*)(sl_ + 9472 + (hf * 32 + q32) * 16); u1 = *(const float4*)(sl_ + 9472 + ((2 + hf) * 32 + q32) * 16); \
            asm volatile("" ::: "memory"); \
            if (lane == 0) flags[8] = (unsigned)((c_) + 1); } while (0)
        unsigned rdy = flags[0];
        PB_FETCH(0);
        int xfree = 0;
#pragma unroll 1
        for (int c = 0; c < PB_NCH; ++c) {
            unsigned char* xw = lds + PB_XOFF + (c % PB_NX) * 4096 + lane * 16;
            rdy = flags[(c + 1) % PB_NB];
            const bf16x8 xb0 = __builtin_bit_cast(bf16x8, make_uint4(pack2(X0[0], X0[1]), pack2(X0[2], X0[3]), pack2(X0[4], X0[5]), pack2(X0[6], X0[7])));
            const bf16x8 xb1 = __builtin_bit_cast(bf16x8, make_uint4(pack2(X0[8], X0[9]), pack2(X0[10], X0[11]), pack2(X0[12], X0[13]), pack2(X0[14], X0[15])));
            const bf16x8 xb2 = __builtin_bit_cast(bf16x8, make_uint4(pack2(X1[0], X1[1]), pack2(X1[2], X1[3]), pack2(X1[4], X1[5]), pack2(X1[6], X1[7])));
            const bf16x8 xb3 = __builtin_bit_cast(bf16x8, make_uint4(pack2(X1[8], X1[9]), pack2(X1[10], X1[11]), pack2(X1[12], X1[13]), pack2(X1[14], X1[15])));
            f32x16 Ua, Ub;
            Ua[0] = u0.x; Ua[1] = u0.y; Ua[2] = u0.z; Ua[3] = u0.w; Ua[4] = u1.x; Ua[5] = u1.y; Ua[6] = u1.z; Ua[7] = u1.w;
#pragma unroll
            for (int r = 8; r < 16; ++r) Ua[r] = 0.f;
#pragma unroll
            for (int r = 0; r < 16; ++r) Ub[r] = 0.f;
            Ua = __builtin_amdgcn_mfma_f32_32x32x16_bf16(pa0, xb0, Ua, 0, 0, 0);
            Ub = __builtin_amdgcn_mfma_f32_32x32x16_bf16(pa1, xb1, Ub, 0, 0, 0);
            Ua = __builtin_amdgcn_mfma_f32_32x32x16_bf16(pa2, xb2, Ua, 0, 0, 0);
            Ub = __builtin_amdgcn_mfma_f32_32x32x16_bf16(pa3, xb3, Ub, 0, 0, 0);
            f32x16 Xn0, Xn1;
            Xn0[0] = X0[0] * gm0.x; Xn0[1] = X0[1] * gm0.y; Xn0[2] = X0[2] * gm0.z; Xn0[3] = X0[3] * gm0.w; Xn0[4] = X0[4] * gm1.x; Xn0[5] = X0[5] * gm1.y; Xn0[6] = X0[6] * gm1.z; Xn0[7] = X0[7] * gm1.w;
            Xn0[8] = X0[8] * gm2.x; Xn0[9] = X0[9] * gm2.y; Xn0[10] = X0[10] * gm2.z; Xn0[11] = X0[11] * gm2.w; Xn0[12] = X0[12] * gm3.x; Xn0[13] = X0[13] * gm3.y; Xn0[14] = X0[14] * gm3.z; Xn0[15] = X0[15] * gm3.w;
            Xn1[0] = X1[0] * gm4.x; Xn1[1] = X1[1] * gm4.y; Xn1[2] = X1[2] * gm4.z; Xn1[3] = X1[3] * gm4.w; Xn1[4] = X1[4] * gm5.x; Xn1[5] = X1[5] * gm5.y; Xn1[6] = X1[6] * gm5.z; Xn1[7] = X1[7] * gm5.w;
            Xn1[8] = X1[8] * gm6.x; Xn1[9] = X1[9] * gm6.y; Xn1[10] = X1[10] * gm6.z; Xn1[11] = X1[11] * gm6.w; Xn1[12] = X1[12] * gm7.x; Xn1[13] = X1[13] * gm7.y; Xn1[14] = X1[14] * gm7.z; Xn1[15] = X1[15] * gm7.w;
            Xn0 = __builtin_amdgcn_mfma_f32_32x32x16_bf16(gk0, vf, Xn0, 0, 0, 0);
            Xn1 = __builtin_amdgcn_mfma_f32_32x32x16_bf16(gk1, vf, Xn1, 0, 0, 0);
            const bf16x8 gbc0 = gb0, gbc1 = gb1;
            while (c - xfree >= PB_NX) { xfree = (int)flags[14]; }
            asm volatile("" ::: "memory");
            *(bf16x8*)(xw) = xb0; *(bf16x8*)(xw + 1024) = xb1; *(bf16x8*)(xw + 2048) = xb2; *(bf16x8*)(xw + 3072) = xb3;
            asm volatile("" ::: "memory");
            if (lane == 0) flags[10 + (c % PB_NX)] = (unsigned)(c + 1);
            if (c + 1 < PB_NCH) PB_FETCH(c + 1);
            const bf16x8 ub = __builtin_bit_cast(bf16x8, make_uint4(pack2(Ua[0] + Ub[0], Ua[1] + Ub[1]), pack2(Ua[2] + Ub[2], Ua[3] + Ub[3]), pack2(Ua[4] + Ub[4], Ua[5] + Ub[5]), pack2(Ua[6] + Ub[6], Ua[7] + Ub[7])));
            X0 = __builtin_amdgcn_mfma_f32_32x32x16_bf16(gbc0, ub, Xn0, 0, 0, 0);
            X1 = __builtin_amdgcn_mfma_f32_32x32x16_bf16(gbc1, ub, Xn1, 0, 0, 0);
        }
#undef PB_FETCH
        float* so = p.out + O_WKVP + ((size_t)(l * NBP + b) * 16 + h) * 4096 + (size_t)(32 * it + q32) * 64;
#pragma unroll
        for (int g = 0; g < 4; ++g) {
            *(float4*)(so + 8 * g + 4 * hf) = make_float4(X0[4 * g], X0[4 * g + 1], X0[4 * g + 2], X0[4 * g + 3]);
            *(float4*)(so + 32 + 8 * g + 4 * hf) = make_float4(X1[4 * g], X1[4 * g + 1], X1[4 * g + 2], X1[4 * g + 3]);
        }
    }
    __syncthreads();
}

__device__ void p3_post(const Params& p, int l, int bid, int G) {
    const int tid = opq_tid(), wv = tid >> 6, lane = tid & 63;
    const float* ys = (const float*)(p.ws + WS_YS);
    const bf16_t* V = (const bf16_t*)(p.ws + WS_VALL);
    const float* coef = (const float*)(p.ws + WS_COEF);
    const bf16_t* gt = (const bf16_t*)(p.ws + WS_GT);
    bf16_t* cc = (bf16_t*)(p.ws + WS_HB);
    for (int r = bid * 8 + wv; r < MT; r += G * 8) {
        float4 y4[4]; uint2 vu4[4], gg4[4]; float cf4[4];
#pragma unroll
        for (int hg = 0; hg < 4; ++hg) {
            const int head = 4 * hg + (lane >> 4), c = head * 64 + 4 * (lane & 15);
            y4[hg] = *(const float4*)(ys + (size_t)r * 1024 + c);
            vu4[hg] = *(const uint2*)(V + (size_t)r * 1024 + c);
            cf4[hg] = coef[(size_t)r * 16 + head];
            gg4[hg] = *(const uint2*)(gt + (size_t)r * DM + 1024 + c);
        }
        __builtin_amdgcn_sched_barrier(0);
#pragma unroll
        for (int hg = 0; hg < 4; ++hg) {
            const int head = 4 * hg + (lane >> 4), c = head * 64 + 4 * (lane & 15);
            const float4 y = y4[hg];
            const float mu = allreduce16(y.x + y.y + y.z + y.w) * (1.f / 64.f);
            const float d0 = y.x - mu, d1 = y.y - mu, d2 = y.z - mu, d3 = y.w - mu;
            const float var = allreduce16(d0 * d0 + d1 * d1 + d2 * d2 + d3 * d3) * (1.f / 64.f);
            const float rs = rsqrtf(var + 64e-5f);
            const float4 lw = *(const float4*)(p.ln_w + l * 1024 + c), lb = *(const float4*)(p.ln_b + l * 1024 + c);
            const uint2 vu = vu4[hg];
            const float4 v4 = make_float4(bflo(vu.x), bfhi(vu.x), bflo(vu.y), bfhi(vu.y));
            const float cf = cf4[hg];
            const uint2 gg = gg4[hg];
            const float o0 = (d0 * rs * lw.x + lb.x + cf * v4.x) * bflo(gg.x), o1 = (d1 * rs * lw.y + lb.y + cf * v4.y) * bfhi(gg.x);
            const float o2 = (d2 * rs * lw.z + lb.z + cf * v4.z) * bflo(gg.y), o3 = (d3 * rs * lw.w + lb.w + cf * v4.w) * bfhi(gg.y);
            *(uint2*)(cc + (size_t)r * DM + 1024 + c) = make_uint2(pack2(o0, o1), pack2(o2, o3));
        }
    }
}

__device__ void p_final(const Params& p, int bid, int G) {
    const int tid = opq_tid(), wv = tid >> 6, lane = tid & 63;
    const float4* g4 = (const float4*)p.final_g;
    for (int r = bid * 8 + wv; r < MT; r += G * 8) {
        float4* xr = (float4*)(p.out + (size_t)r * DM);
        float4 v[8]; float ss = 0.f;
#pragma unroll
        for (int i = 0; i < 8; ++i) { v[i] = xr[lane + 64 * i]; ss += v[i].x * v[i].x + v[i].y * v[i].y + v[i].z * v[i].z + v[i].w * v[i].w; }
        ss = wave_sum(ss);
        const float rinv = rsqrtf(ss * (1.f / 2048.f) + 1e-5f);
#pragma unroll
        for (int i = 0; i < 8; ++i) { const float4 g = g4[lane + 64 * i]; xr[lane + 64 * i] = make_float4(v[i].x * rinv * g.x, v[i].y * rinv * g.y, v[i].z * rinv * g.z, v[i].w * rinv * g.w); }
    }
}

#ifndef REPL
#define REPL -1
#endif
#ifndef REPK
#define REPK -100
#endif
__global__ void __launch_bounds__(512, 2) fwd_kernel(Params p_unused) {
    extern __shared__ __attribute__((aligned(16))) unsigned char shm[];
    cg::grid_group grid = cg::this_grid();
    const int bid0 = blockIdx.x, G0 = gridDim.x;
    float* shf = (float*)shm;
    volatile LAS unsigned* xst = (volatile LAS unsigned*)((LAS unsigned char*)shm + 131072);
    if (threadIdx.x == 0) { xst[0] = 0u; xst[1] = 0u; }
    __syncthreads();
    const XcdBarrier xb = xcd_barrier_post((unsigned*)(kparams().ws + WS_BAR), xst);
    if (G0 == 0x7fffffff) grid.sync();

#pragma unroll 1
    for (int ph = 0; ph < 14; ++ph) {
        const int bid = opq_s(bid0), G = opq_s(G0);
        const int l = ph >= 7 ? 1 : 0, k = ph == 0 ? -1 : (ph == 13 ? 6 : (ph - 1) - 6 * l);
#pragma unroll 1
        for (int rep = 0; rep < ((k == kparams().repk && (kparams().repl < 0 || kparams().repl == l)) ? 2 : 1); ++rep) {
        if (k == -1) {
            for (int it = bid; it < 384; it += G) p0_mod_item(kparams(), shf, it / 192, it % 192);
            for (int it = bid; it < 17; it += G) p0_rope_item(kparams(), it);
            for (int it = bid; it < 64; it += G) p0_wfrag_item(kparams(), it);
            {
                if (bid < 128) p0_conv_all(kparams(), shf, bid, 128, 1024, 0);
                else p0_conv_all(kparams(), shf, 1024 + (bid - 128), G - 128, 2752, 0);
            }
        } else if (k == 0) {
            p1_norm(kparams(), l, bid, G);
        } else if (k == 1) {
            pg8::StaticOrder S; S.init(MP, INWP, G, bid);
            pg8::Gemm g{(const bf16_t*)(kparams().ws + WS_HB), (const bf16_t*)(kparams().ws + WS_WTIN), MP, INWP, DM};
            Epi1 E{l};
            pg8::gemm_phase<Epi1, pg8::StaticOrder, false>((PG8_LAS unsigned char*)shm, g, S, E, nullptr);
        } else if (k == 2) {
            for (int it = bid; it < 256; it += G) p3_twad_item(kparams(), l, it);
            if (bid == 0) p3_prep_tile(kparams(), shm, l, 256);
            else if (bid <= 64) p3_sattn_item(kparams(), shf, l, bid - 1);
            else for (int hu = bid - 65; hu < 512; hu += G - 65) p3_attn_unit(kparams(), shm, l, hu >> 1, hu & 1);
            __syncthreads();
            if (l == 0) p0_conv_all(kparams(), shf, bid, G, 1728, 1);
        } else if (k == 3) {
            {
                const int wvq = opq_tid() >> 6;
                int i2 = bid < 64 ? bid * 8 + wvq : 512 + (bid - 64) * 8 + wvq;
                const int step = bid < 64 ? (1 << 20) : (G - 64) * 8;
#pragma unroll 1
                for (; i2 < 32 * 256; i2 += step) pa_chunk(kparams(), shm + wvq * PA_WLDS, l, (i2 & 31) * 256 + (i2 >> 5));
                if (bid < 64) {
                    __syncthreads();
                    pb_head(kparams(), shm, l, bid, false);
                } else {
                    const int gw = (bid - 64) * 8 + wvq, nw = (G - 64) * 8;
                    for (int task = gw; task < NBS * 256; task += nw) pa_sample_task(kparams(), l, task);
                }
            }
        } else if (k == 4) {
            p3_post(kparams(), l, bid, G);
        } else if (k == 5) {
            pg8::StaticOrder S; S.init(TP, DM, G, bid);
            pg8::Gemm g{(const bf16_t*)(kparams().ws + WS_HB), (const bf16_t*)(kparams().ws + WS_WTOUT) + (size_t)l * DM * DM, TP, DM, DM};
            Epi2 E{l};
            pg8::gemm_phase<Epi2, pg8::StaticOrder, false>((PG8_LAS unsigned char*)shm, g, S, E, nullptr);
            for (int nb = bid; nb < 64; nb += G) g2_sample_item(kparams(), shf, l, nb);
        } else {
            p_final(kparams(), bid, G);
        }
        if (ph < 13) xcd_barrier(xb);
        }
    }
}

extern "C" void kernel_launch(void* const* d_in, const int* in_sizes, int n_in, void* d_out, int out_size, void* d_ws, size_t ws_size, hipStream_t stream) {
    static int grid_blocks = 0;
    if (grid_blocks == 0) {
        if (n_in != 25 || (size_t)out_size != O_END || ws_size < WS_END) {
            fprintf(stderr, "kernel_launch: unexpected shapes: n_in %d out_size %d ws_size %zu (need %zu)\n", n_in, out_size, ws_size, (size_t)WS_END);
            grid_blocks = -1; return;
        }
        if (hipFuncSetAttribute((const void*)fwd_kernel, hipFuncAttributeMaxDynamicSharedMemorySize, LDS_BYTES) != hipSuccess) { fprintf(stderr, "kernel_launch: hipFuncSetAttribute failed\n"); grid_blocks = -1; return; }
        int dev = 0, cus = 0, per_cu = 0;
        hipGetDevice(&dev);
        hipDeviceGetAttribute(&cus, hipDeviceAttributeMultiprocessorCount, dev);
        hipOccupancyMaxActiveBlocksPerMultiprocessor(&per_cu, (const void*)fwd_kernel, 512, LDS_BYTES);
        if (per_cu < 1) { fprintf(stderr, "kernel_launch: occupancy query gives %d blocks per CU\n", per_cu); per_cu = 1; }
        (void)hipGetLastError();
        grid_blocks = cus;
        if (grid_blocks < 192) { fprintf(stderr, "kernel_launch: only %d CUs\n", grid_blocks); grid_blocks = -1; return; }
    }
    if (grid_blocks < 0) return;
    if (hipMemsetAsync((unsigned char*)d_ws + WS_BAR, 0, 16384 + RFLAG_BYTES, stream) != hipSuccess) { fprintf(stderr, "kernel_launch: memset of the barrier words failed\n"); return; }
    Params p{};
    const float** pp = (const float**)&p;
    for (int i = 0; i < 25; ++i) pp[i] = (const float*)d_in[i];
    p.out = (float*)d_out; p.ws = (unsigned char*)d_ws; p.repk = REPK; p.repl = REPL;
    void* args[] = {&p};
    hipError_t e = hipLaunchCooperativeKernel((const void*)fwd_kernel, dim3(grid_blocks), dim3(512), args, LDS_BYTES, stream);
    if (e != hipSuccess) fprintf(stderr, "cooperative launch failed: %s (grid %d)\n", hipGetErrorString(e), grid_blocks);
}
```

```cpp
#include <hip/hip_runtime.h>
#include <hip/hip_cooperative_groups.h>
#include <cstdio>
namespace cg = cooperative_groups;
__device__ __forceinline__ int opq_tid() { int t = threadIdx.x; asm volatile("" : "+v"(t)); return t; }
__device__ __forceinline__ int opq_s(int x) { asm volatile("" : "+s"(x)); return x; }
typedef float cvt_f32x2 __attribute__((ext_vector_type(2)));
typedef __bf16 cvt_bf16x2 __attribute__((ext_vector_type(2)));
__device__ __forceinline__ unsigned hw_cvt_pk_bf16(float lo, float hi) { const cvt_f32x2 v = {lo, hi}; return __builtin_bit_cast(unsigned, __builtin_convertvector(v, cvt_bf16x2)); }
typedef unsigned sc1_v4u __attribute__((ext_vector_type(4)));
__device__ __forceinline__ void st_sc1_b128(void* p, unsigned a, unsigned b, unsigned c, unsigned d) { const sc1_v4u v = {a, b, c, d}; asm volatile("global_store_dwordx4 %0, %1, off sc0 sc1\n\ts_nop 2" :: "v"(p), "v"(v) : "memory"); }
__device__ __forceinline__ void st_sc1_b32(void* p, float v) { asm volatile("global_store_dword %0, %1, off sc0 sc1\n\ts_nop 2" :: "v"(p), "v"(v) : "memory"); }
namespace pg8 {
#define PG8_LAS __attribute__((address_space(3)))
typedef unsigned short bf16_t;
typedef short bf16x8 __attribute__((ext_vector_type(8)));
typedef float f32x4 __attribute__((ext_vector_type(4)));
typedef unsigned u32x4 __attribute__((ext_vector_type(4)));
constexpr int BM = 256, BK = 64, HALF = 128, HTB = HALF * BK * 2  , STAGE_BYTES = 8 * HTB, NXCD = 8, WGM = 4;

__host__ __device__ __forceinline__ int lds_byte(int r, int c) { const int st = (r >> 4) * 2 + (c >> 5), rr = r & 15, cc = c & 31, ob = rr * 64 + cc * 2; return st * 1024 + (ob ^ (((ob >> 9) & 1) << 5)); }
__host__ __device__ __forceinline__ void stage_rc(int b, int& R, int& C) { const int st = b / 1024, sb = b % 1024, swz = sb ^ (((sb >> 9) & 1) << 5); R = (st >> 1) * 16 + swz / 64; C = (st & 1) * 32 + (swz % 64) / 2; }
__host__ __device__ __forceinline__ int perm32(int rho) { const int n = rho >> 4, i = rho & 15; return 8 * (i >> 2) + 4 * n + (i & 3); }

struct Unit { int pm, pn; };
struct Gemm { const bf16_t* A; const bf16_t* Bt; int M, N, K; };

struct StaticOrder {
    int nM, nN, nwg, G, c;
    __host__ __device__ void init(int M, int N, int G_, int c_) { nM = M / BM; nN = N / BM; nwg = nM * nN; G = G_; c = c_; }
    __host__ __device__ bool next(int i, Unit& u) const {
        const long L = (long)i * G + c; if (L >= nwg) return false;
        int wgid = (int)L; { const int q = nwg / NXCD, r = nwg % NXCD, xcd = wgid % NXCD, off = wgid / NXCD; wgid = (xcd < r ? xcd * (q + 1) : r * (q + 1) + (xcd - r) * q) + off; }
        const int nig = WGM * nN, gid = wgid / nig, fm = gid * WGM, gsz = (nM - fm) < WGM ? (nM - fm) : WGM;
        u.pm = fm + ((wgid % nig) % gsz); u.pn = (wgid % nig) / gsz; return true;
    }
    __device__ __forceinline__ void a_ready(const Unit&) const {}
    __device__ __forceinline__ void done(const Unit&) const {}
};
template <class Epi, class Sched, bool STAMP = false>
__device__ __forceinline__ void gemm_phase(PG8_LAS unsigned char* lds, const Gemm g, const Sched& S, const Epi& E, unsigned long long* stamps) {
    const int tid = opq_tid(), wid = __builtin_amdgcn_readfirstlane(tid >> 6), lane = tid & 63, wr = wid >> 2, wc = wid & 3, fr = lane & 15, fq = lane >> 4;
    const int K = g.K, nt = K / BK;
    int ts_lo = 0, ts_hi = 0, nts = 0; const unsigned long long rt_entry = STAMP ? (unsigned long long)wall_clock64() : 0ull;
#define PG8_STAMP() do { if (STAMP && wid == 0 && nts < 64) { const unsigned long long _c = (unsigned long long)clock64(); \
        ts_lo = (lane == nts) ? (int)(unsigned)_c : ts_lo; ts_hi = (lane == nts) ? (int)(unsigned)(_c >> 32) : ts_hi; ++nts; } } while (0)
    PG8_STAMP();
    unsigned voffA[2], voffB[2];
#pragma unroll
    for (int i = 0; i < 2; ++i) { int R, C; stage_rc(tid * 16 + i * 8192, R, C); const int Rb = Epi::PERM ? ((R & ~31) + perm32(R & 31)) : R;
        voffA[i] = (unsigned)(R * K + C) * 2u; voffB[i] = (unsigned)(Rb * K + C) * 2u; }
    const size_t kstep = (size_t)(BK * 2);
    const size_t hstep = (size_t)HALF * K * 2;
    const size_t tstep = 2 * hstep;
    const unsigned ldsw = (unsigned)wid * 1024u;
    const int aoff = lds_byte(wr * 64 + fr, fq * 8), boff = lds_byte(wc * 32 + fr, fq * 8);
#define PG8_SA(b, h) (((b) * 2 + (h)) * HTB)
#define PG8_SB(b, h) ((4 + (b) * 2 + (h)) * HTB)
#define PG8_STAGE(bufoff, gbase, voff) do { _Pragma("unroll") for (int _i = 0; _i < 2; ++_i) \
        __builtin_amdgcn_global_load_lds((const unsigned*)((const char*)(gbase) + (voff)[_i]), (PG8_LAS unsigned*)(lds + (bufoff) + ldsw + _i * 8192), 16, 0, 0); } while (0)
#define PG8_LDA(dst, b, h) do { _Pragma("unroll") for (int m = 0; m < 4; ++m) _Pragma("unroll") for (int k = 0; k < 2; ++k) dst[m][k] = *(const PG8_LAS bf16x8*)(lds + PG8_SA(b, h) + aoff + m * 2048 + k * 1024); } while (0)
#define PG8_LDB(dst, b, h) do { _Pragma("unroll") for (int n = 0; n < 2; ++n) _Pragma("unroll") for (int k = 0; k < 2; ++k) dst[n][k] = *(const PG8_LAS bf16x8*)(lds + PG8_SB(b, h) + boff + n * 2048 + k * 1024); } while (0)
#define PG8_MMA(ai, bj, At, Bt) do { __builtin_amdgcn_s_setprio(1); _Pragma("unroll") for (int m = 0; m < 4; ++m) _Pragma("unroll") for (int n = 0; n < 2; ++n) _Pragma("unroll") for (int k = 0; k < 2; ++k) \
        acc[ai][bj][m][n] = __builtin_amdgcn_mfma_f32_16x16x32_bf16(Bt[n][k], At[m][k], acc[ai][bj][m][n], 0, 0, 0); __builtin_amdgcn_s_setprio(0); } while (0)
#define PG8_WAIT_V(n) asm volatile("s_waitcnt vmcnt(" #n ")" ::: "memory")
#define PG8_WAIT_L(n) asm volatile("s_waitcnt lgkmcnt(" #n ")" ::: "memory")
#define PG8_BAR __builtin_amdgcn_s_barrier()
#define PG8_SCHED __builtin_amdgcn_sched_barrier(0)
    Unit cur, nxt; int ui = 0;
    if (!S.next(0, cur)) return;
    f32x4 acc[2][2][4][2];
#pragma unroll
    for (int a = 0; a < 2; ++a)
#pragma unroll
        for (int b = 0; b < 2; ++b)
#pragma unroll
            for (int m = 0; m < 4; ++m)
#pragma unroll
                for (int n = 0; n < 2; ++n) acc[a][b][m][n] = (f32x4){0.f, 0.f, 0.f, 0.f};
    bf16x8 At[4][2], B0[2][2], B1[2][2];
    const char* cA = (const char*)g.A + (size_t)cur.pm * tstep; const char* cB = (const char*)g.Bt + (size_t)cur.pn * tstep;
    S.a_ready(cur);
    PG8_STAGE(PG8_SB(0, 0), cB, voffB); PG8_STAGE(PG8_SA(0, 0), cA, voffA); PG8_STAGE(PG8_SB(0, 1), cB + hstep, voffB); PG8_STAGE(PG8_SA(0, 1), cA + hstep, voffA);
    if (wr == 1) PG8_BAR;
    PG8_WAIT_V(4); PG8_BAR;
    PG8_STAGE(PG8_SB(1, 0), cB + kstep, voffB); PG8_STAGE(PG8_SA(1, 0), cA + kstep, voffA); PG8_STAGE(PG8_SB(1, 1), cB + hstep + kstep, voffB);
    PG8_WAIT_V(6); PG8_BAR;
    PG8_STAMP();
    for (;;) {
        const bool has_next = S.next(ui + 1, nxt);
        const char* nA = has_next ? (const char*)g.A + (size_t)nxt.pm * tstep : cA; const char* nB = has_next ? (const char*)g.Bt + (size_t)nxt.pn * tstep : cB;
        for (int t = 0; t < nt; t += 2) {
            const bool last = (t == nt - 2);
            const char* a1 = cA + (size_t)(t + 1) * kstep;
            const char* a2 = last ? nA : cA + (size_t)(t + 2) * kstep; const char* b2 = last ? nB : cB + (size_t)(t + 2) * kstep;
            const char* a3 = a2 + kstep; const char* b3 = b2 + kstep;
            if (last && has_next) S.a_ready(nxt);
            PG8_LDB(B0, 0, 0); PG8_SCHED; PG8_LDA(At, 0, 0); PG8_STAGE(PG8_SA(1, 1), a1 + hstep, voffA);
            PG8_WAIT_L(8); PG8_BAR; PG8_WAIT_L(0); PG8_MMA(0, 0, At, B0); PG8_BAR; PG8_SCHED;
            PG8_LDB(B1, 0, 1); PG8_STAGE(PG8_SB(0, 0), b2, voffB);
            PG8_BAR; PG8_WAIT_L(0); PG8_MMA(0, 1, At, B1); PG8_BAR;
            PG8_LDA(At, 0, 1); PG8_STAGE(PG8_SA(0, 0), a2, voffA);
            PG8_BAR; PG8_WAIT_L(0); PG8_MMA(1, 0, At, B0); PG8_BAR; PG8_SCHED;
            PG8_STAGE(PG8_SB(0, 1), b2 + hstep, voffB);
            PG8_WAIT_V(6); PG8_BAR; PG8_MMA(1, 1, At, B1); PG8_BAR;
            PG8_LDB(B0, 1, 0); PG8_SCHED; PG8_LDA(At, 1, 0); PG8_STAGE(PG8_SA(0, 1), a2 + hstep, voffA);
            PG8_WAIT_L(8); PG8_BAR; PG8_WAIT_L(0); PG8_MMA(0, 0, At, B0); PG8_BAR; PG8_SCHED;
            PG8_LDB(B1, 1, 1); PG8_STAGE(PG8_SB(1, 0), b3, voffB);
            PG8_BAR; PG8_WAIT_L(0); PG8_MMA(0, 1, At, B1); PG8_BAR;
            PG8_LDA(At, 1, 1); PG8_STAGE(PG8_SA(1, 0), a3, voffA);
            PG8_BAR; PG8_WAIT_L(0); PG8_MMA(1, 0, At, B0); PG8_BAR; PG8_SCHED;
            PG8_STAGE(PG8_SB(1, 1), b3 + hstep, voffB);
            PG8_WAIT_V(6); PG8_BAR; PG8_MMA(1, 1, At, B1); PG8_BAR;
        }
        PG8_STAMP();
        if constexpr (!Epi::AFTER_DRAIN) { E(acc, cur, wr, wc, fr, fq); S.done(cur); }
        PG8_STAMP();
        if (!has_next) break;
#pragma unroll
        for (int a = 0; a < 2; ++a)
#pragma unroll
            for (int b = 0; b < 2; ++b)
#pragma unroll
                for (int m = 0; m < 4; ++m)
#pragma unroll
                    for (int n = 0; n < 2; ++n) acc[a][b][m][n] = (f32x4){0.f, 0.f, 0.f, 0.f};
        cur = nxt; cA = nA; cB = nB; ++ui;
    }
    PG8_WAIT_V(0);
    if (wr == 0) PG8_BAR;
    PG8_BAR;
    if constexpr (Epi::AFTER_DRAIN) { E.fused(acc, cur, wr, wc, fr, fq, lds, wid, lane); S.done(cur); }
    PG8_STAMP();
    if (STAMP && wid == 0) { stamps[lane] = lane < nts ? (((unsigned long long)(unsigned)ts_hi << 32) | (unsigned)ts_lo) : 0ull;
        if (lane == 62) stamps[62] = rt_entry; if (lane == 63) stamps[63] = (unsigned long long)wall_clock64(); }
#undef PG8_STAMP
#undef PG8_SA
#undef PG8_SB
#undef PG8_STAGE
#undef PG8_LDA
#undef PG8_LDB
#undef PG8_MMA
#undef PG8_WAIT_V
#undef PG8_WAIT_L
#undef PG8_BAR
#undef PG8_SCHED
}
}

#define XB_TMO      128
#define XB_XCNT(j)  (256  + 64 * (j))
#define XB_XSUB(j)  (1280 + 64 * (j))
#define XB_XGEN(j)  (2304 + 64 * (j))
#define XB_TOP      3328
#define XB_TOPGEN   3392
#define XCD_BAR_WORDS 3456
#define XB_SPIN_CAP (1u << 18)
#define LAS __attribute__((address_space(3)))

__device__ __forceinline__ unsigned xb_ld(unsigned* p)              { return __hip_atomic_load(p, __ATOMIC_RELAXED, __HIP_MEMORY_SCOPE_AGENT); }
__device__ __forceinline__ unsigned xb_add(unsigned* p, unsigned v) { return __hip_atomic_fetch_add(p, v, __ATOMIC_RELAXED, __HIP_MEMORY_SCOPE_AGENT); }
__device__ __forceinline__ unsigned xb_xcc_id() { return (unsigned)__builtin_amdgcn_s_getreg((3 << 11) | 20) & 0xFu; }
#define XB_SPIN(cond, bar) do { unsigned _sp = 0; while (cond) { __builtin_amdgcn_s_sleep(1); \
    if ((++_sp & 255u) == 0u) { if (xb_ld(&(bar)[XB_TMO])) break; if (_sp > XB_SPIN_CAP) { atomicAdd(&(bar)[XB_TMO], 1u); break; } } } } while (0)

struct XcdBarrier {
    unsigned* bar; unsigned x;
    volatile LAS unsigned* st;
};

__device__ __forceinline__ XcdBarrier xcd_barrier_post(unsigned* bar, volatile LAS unsigned* st) {
    XcdBarrier b; b.bar = bar; b.x = xb_xcc_id(); b.st = st;
    if (threadIdx.x == 0) (void)xb_add(&bar[XB_XCNT(b.x)], 1u);
    return b;
}
__device__ __forceinline__ void xcd_barrier_complete(unsigned* bar, unsigned x, unsigned& nloc, unsigned& nx) {
    const unsigned G = gridDim.x * gridDim.y * gridDim.z;
    unsigned sum, cnt, mine, sp = 0u;
    for (;;) {
        sum = 0u; cnt = 0u; mine = 0u;
#pragma unroll
        for (unsigned j = 0; j < 16; ++j) { const unsigned c = xb_ld(&bar[XB_XCNT(j)]); sum += c; cnt += (c > 0u) ? 1u : 0u; mine = (j == x) ? c : mine; }
        if (sum == G) break;
        __builtin_amdgcn_s_sleep(1);
        if ((++sp & 255u) == 0u) { if (xb_ld(&bar[XB_TMO])) break; if (sp > XB_SPIN_CAP) { atomicAdd(&bar[XB_TMO], 1u); break; } }
    }
    nloc = mine > 0u ? mine : 1u; nx = cnt > 0u ? cnt : 1u;
}

__device__ __forceinline__ void xcd_barrier(const XcdBarrier& b) {
    asm volatile("s_waitcnt vmcnt(0)" ::: "memory");
    __syncthreads();
    if (threadIdx.x == 0) {
        unsigned* bar = b.bar;
        __builtin_amdgcn_s_waitcnt(0);
        unsigned nloc = b.st[0], nx = b.st[1];
        if (nloc == 0u) { xcd_barrier_complete(bar, b.x, nloc, nx); b.st[0] = nloc; b.st[1] = nx; }
        const unsigned old = xb_add(&bar[XB_XSUB(b.x)], 1u);
        const unsigned gen = old / nloc;
        if (old + 1u == (gen + 1u) * nloc) {
            __builtin_amdgcn_fence(__ATOMIC_RELEASE, "agent");
            asm volatile("s_waitcnt vmcnt(0)" ::: "memory");
            const unsigned og = xb_add(&bar[XB_TOP], 1u);
            const unsigned tg = og / nx;
            if (og + 1u == (tg + 1u) * nx) xb_add(&bar[XB_TOPGEN], 1u);
            else XB_SPIN(xb_ld(&bar[XB_TOPGEN]) == tg, bar);
            __builtin_amdgcn_fence(__ATOMIC_ACQUIRE, "agent");
            xb_add(&bar[XB_XGEN(b.x)], 1u);
            asm volatile("s_waitcnt vmcnt(0)" ::: "memory");
        } else {
            XB_SPIN(xb_ld(&bar[XB_XGEN(b.x)]) == gen, bar);
            __builtin_amdgcn_fence(__ATOMIC_ACQUIRE, "agent");
            asm volatile("s_waitcnt vmcnt(0)" ::: "memory");
        }
    }
    __syncthreads();
}

typedef unsigned short bf16_t;
typedef short bf16x8 __attribute__((ext_vector_type(8)));
typedef float f32x4 __attribute__((ext_vector_type(4)));
typedef float f32x16 __attribute__((ext_vector_type(16)));

constexpr int DM = 2048, SEQ = 4096, NBP = 2, NBS = 32, TP = NBP * SEQ, MT = TP + NBS, MP = 8448;
constexpr int INW = 6784, INWP = 6912, SHD = 3200, DEPTH = 2;
constexpr size_t NRI = (size_t)MT * 1024;
constexpr int LDS_BYTES = 131072 + 16;
constexpr size_t O_CKP = (size_t)MT * DM;
constexpr size_t O_CVP = O_CKP + (size_t)DEPTH * NBP * 128 * 256;
constexpr size_t O_WKVP = O_CVP + (size_t)DEPTH * NBP * 128 * 256;
constexpr size_t O_SHP = O_WKVP + (size_t)DEPTH * NBP * 16 * 4096;
constexpr size_t O_CKS = O_SHP + (size_t)DEPTH * NBP * SHD;
constexpr size_t O_CVS = O_CKS + (size_t)DEPTH * NBS * 128 * 256;
constexpr size_t O_WKVS = O_CVS + (size_t)DEPTH * NBS * 128 * 256;
constexpr size_t O_SHS = O_WKVS + (size_t)DEPTH * NBS * 16 * 4096;
constexpr size_t O_END = O_SHS + (size_t)DEPTH * NBS * SHD;
constexpr size_t al256(size_t x) { return (x + 255) & ~(size_t)255; }
constexpr size_t WS_WTIN = 0;
constexpr size_t WS_WTOUT = WS_WTIN + (size_t)INWP * DM * 2;
constexpr size_t WS_MOD = WS_WTOUT + (size_t)DEPTH * DM * DM * 2;
constexpr size_t WS_ROPE = WS_MOD + al256((size_t)DEPTH * 34 * 6144 * 4);
constexpr size_t WS_HB = WS_ROPE + al256((size_t)4097 * 16 * 4);
constexpr size_t WS_QB = WS_HB + (size_t)MP * DM * 2;
constexpr size_t WS_KB = WS_QB + (size_t)MP * 1024 * 2;
constexpr size_t WS_VB = WS_KB + (size_t)MP * 256 * 2;
constexpr size_t WS_RW = WS_VB + (size_t)MP * 256 * 2;
constexpr size_t WS_GT = WS_RW + (size_t)MP * SHD * 2;
constexpr size_t WS_VALL = WS_GT + (size_t)MP * DM * 2;
constexpr size_t SRI = (size_t)NBS * 1024;
constexpr size_t WS_RSB = WS_VALL + NRI * 2;
constexpr size_t WS_RSW = WS_RSB + 4 * SRI * 2;
constexpr size_t WS_YS = WS_RSW + SRI * 4;
constexpr size_t WS_REC = WS_YS + NRI * 4;
constexpr size_t WS_COEF = WS_REC + (size_t)32 * 256 * 14592;
constexpr size_t WS_TWAD = WS_COEF + al256((size_t)MT * 16 * 4);
constexpr size_t WS_WFRAG = WS_TWAD + (size_t)MT * 128 * 2;
constexpr size_t WS_BAR = WS_WFRAG + (size_t)DEPTH * 2 * 16 * 4 * 2 * 64 * 16;
constexpr size_t WS_RFLAG = WS_BAR + 16384;
constexpr size_t RFLAG_BYTES = (size_t)32 * 256 * 64;
constexpr size_t WS_END = WS_RFLAG + RFLAG_BYTES;

struct Params {
    const float *x_prompt, *x_sample, *cache_k, *cache_v, *state_wkv, *state_shift, *c_prompt, *c_sample, *norm_g, *w_ada, *b_ada, *w_in, *mu_shift, *w0, *w_decay, *a0,
        *w_iclr, *k_k, *k_a, *r_k, *ln_w, *ln_b, *sinks, *w_out, *final_g;
    float* out;
    unsigned char* ws;
    int repk, repl;
};
typedef const __attribute__((address_space(4))) Params* KParamsPtr;
__device__ __forceinline__ const Params& kparams() {
    KParamsPtr k = (KParamsPtr)__builtin_amdgcn_kernarg_segment_ptr();
    asm volatile("" : "+s"(k));
    return *(const Params*)k;
}

__device__ __forceinline__ unsigned short f2bf(float f) { return (unsigned short)(hw_cvt_pk_bf16(f, 0.f) & 0xffffu); }
__device__ __forceinline__ float bf2f(unsigned short b) { return __uint_as_float(((unsigned)b) << 16); }
__device__ __forceinline__ unsigned pack2(float lo, float hi) { return hw_cvt_pk_bf16(lo, hi); }
__device__ __forceinline__ float bflo(unsigned w) { return __uint_as_float(w << 16); }
__device__ __forceinline__ float bfhi(unsigned w) { return __uint_as_float(w & 0xffff0000u); }
__device__ __forceinline__ float silu_f(float x) { return x / (1.f + __expf(-x)); }
__device__ __forceinline__ float wave_sum(float x) {
#pragma unroll
    for (int o = 32; o >= 1; o >>= 1) x += __shfl_xor(x, o);
    return x;
}
__device__ __forceinline__ float wave_max(float x) {
#pragma unroll
    for (int o = 32; o >= 1; o >>= 1) x = fmaxf(x, __shfl_xor(x, o));
    return x;
}
template <int CTRL> __device__ __forceinline__ float dpp_f(float x) {
    return __builtin_bit_cast(float, __builtin_amdgcn_update_dpp(0, __builtin_bit_cast(int, x), CTRL, 0xF, 0xF, false));
}
__device__ __forceinline__ float allreduce16(float x) {
    x += dpp_f<0x128>(x);
    x += dpp_f<0x124>(x);
    x += dpp_f<0x122>(x);
    x += dpp_f<0x121>(x);
    return x;
}

__device__ void p0_mod_item(const Params& p, float* red, int l, int nc) {
    const int tid = opq_tid(), wv = tid >> 6, lane = tid & 63, n = lane & 31, kh = lane >> 5;
    f32x16 acc0, acc1;
#pragma unroll
    for (int i = 0; i < 16; ++i) { acc0[i] = 0.f; acc1[i] = 0.f; }
    const float* W = p.w_ada + (size_t)l * DM * 6144 + nc * 32 + n;
#pragma unroll 8
    for (int ks = 0; ks < 16; ++ks) {
        const int k0 = wv * 256 + ks * 16 + kh * 8;
        bf16x8 bfr, a0, a1;
#pragma unroll
        for (int j = 0; j < 8; ++j) bfr[j] = (short)f2bf(W[(size_t)(k0 + j) * 6144]);
        const float4* cs = (const float4*)(p.c_sample + (size_t)n * DM + k0);
        const float4 u0 = cs[0], u1 = cs[1];
        a0[0] = (short)f2bf(silu_f(u0.x)); a0[1] = (short)f2bf(silu_f(u0.y)); a0[2] = (short)f2bf(silu_f(u0.z)); a0[3] = (short)f2bf(silu_f(u0.w));
        a0[4] = (short)f2bf(silu_f(u1.x)); a0[5] = (short)f2bf(silu_f(u1.y)); a0[6] = (short)f2bf(silu_f(u1.z)); a0[7] = (short)f2bf(silu_f(u1.w));
        float4 q0 = make_float4(0.f, 0.f, 0.f, 0.f), q1 = q0;
        if (n < 2) { const float4* cp = (const float4*)(p.c_prompt + (size_t)n * DM + k0); q0 = cp[0]; q1 = cp[1]; }
        a1[0] = (short)f2bf(silu_f(q0.x)); a1[1] = (short)f2bf(silu_f(q0.y)); a1[2] = (short)f2bf(silu_f(q0.z)); a1[3] = (short)f2bf(silu_f(q0.w));
        a1[4] = (short)f2bf(silu_f(q1.x)); a1[5] = (short)f2bf(silu_f(q1.y)); a1[6] = (short)f2bf(silu_f(q1.z)); a1[7] = (short)f2bf(silu_f(q1.w));
        acc0 = __builtin_amdgcn_mfma_f32_32x32x16_bf16(a0, bfr, acc0, 0, 0, 0);
        acc1 = __builtin_amdgcn_mfma_f32_32x32x16_bf16(a1, bfr, acc1, 0, 0, 0);
    }
#pragma unroll
    for (int i = 0; i < 16; ++i) red[(wv * 18 + i) * 64 + lane] = acc0[i];
    red[(wv * 18 + 16) * 64 + lane] = acc1[0];
    red[(wv * 18 + 17) * 64 + lane] = acc1[1];
    __syncthreads();
    float* mod = (float*)(p.ws + WS_MOD);
    for (int o = tid; o < 34 * 32; o += 512) {
        const int row = o >> 5, col = o & 31;
        int ri, ln, mrow;
        if (row < 32) { const int khh = (row >> 2) & 1; ri = (row & 3) + 4 * (row >> 3); ln = col + 32 * khh; mrow = 2 + row; }
        else { ri = 16 + (row - 32); ln = col; mrow = row - 32; }
        float s = 0.f;
#pragma unroll
        for (int w = 0; w < 8; ++w) s += red[(w * 18 + ri) * 64 + ln];
        mod[((size_t)l * 34 + mrow) * 6144 + nc * 32 + col] = s + p.b_ada[l * 6144 + nc * 32 + col];
    }
    __syncthreads();
}

struct ConvIt { const float* src; bf16_t* dst; int N, k0, n0; };
__device__ __forceinline__ ConvIt conv_decode(const Params& p, int cidx, int lw) {
    ConvIt c;
    int kt, nt;
    if (cidx < 1728) { kt = cidx & 15; nt = cidx >> 4; c.N = INW; c.src = p.w_in + (size_t)lw * DM * INW; c.dst = (bf16_t*)(p.ws + WS_WTIN); }
    else { int rem = cidx - 1728; const int l2 = rem >> 9; rem &= 511; kt = rem & 15; nt = rem >> 4; c.N = DM; c.src = p.w_out + (size_t)l2 * DM * DM; c.dst = (bf16_t*)(p.ws + WS_WTOUT) + (size_t)l2 * DM * DM; }
    c.k0 = kt * 128; c.n0 = nt * 64;
    return c;
}
__device__ void p0_conv_all(const Params& p, float* s, int bid, int G, int total, int lw) {
    const int tid = opq_tid();
    const int lrow = tid >> 4, c4 = tid & 15, n = tid >> 3, kg = tid & 7;
    float4 v[4];
    int cidx = bid;
    ConvIt cur = conv_decode(p, cidx < total ? cidx : 0, lw);
    if (cidx < total) {
#pragma unroll
        for (int p4 = 0; p4 < 4; ++p4) { v[p4] = make_float4(0.f, 0.f, 0.f, 0.f); if (cur.n0 < cur.N) v[p4] = *(const float4*)(cur.src + (size_t)(cur.k0 + lrow + 32 * p4) * cur.N + cur.n0 + 4 * c4); }
    }
#pragma unroll 1
    while (cidx < total) {
#pragma unroll
        for (int p4 = 0; p4 < 4; ++p4) { float* d = s + (lrow + 32 * p4) * 65 + 4 * c4; d[0] = v[p4].x; d[1] = v[p4].y; d[2] = v[p4].z; d[3] = v[p4].w; }
        __syncthreads();
        const int nxt = cidx + G;
        const ConvIt nx = conv_decode(p, nxt < total ? nxt : 0, lw);
        if (nxt < total) {
#pragma unroll
            for (int p4 = 0; p4 < 4; ++p4) { v[p4] = make_float4(0.f, 0.f, 0.f, 0.f); if (nx.n0 < nx.N) v[p4] = *(const float4*)(nx.src + (size_t)(nx.k0 + lrow + 32 * p4) * nx.N + nx.n0 + 4 * c4); }
        }
        unsigned w[8];
#pragma unroll
        for (int j = 0; j < 8; ++j) w[j] = pack2(s[(kg * 16 + 2 * j) * 65 + n], s[(kg * 16 + 2 * j + 1) * 65 + n]);
        uint4* o = (uint4*)(cur.dst + (size_t)(cur.n0 + n) * DM + cur.k0 + kg * 16);
        o[0] = make_uint4(w[0], w[1], w[2], w[3]);
        o[1] = make_uint4(w[4], w[5], w[6], w[7]);
        __syncthreads();
        cur = nx; cidx = nxt;
    }
}

__device__ void p0_rope_item(const Params& p, int it) {
    float* rope = (float*)(p.ws + WS_ROPE);
#pragma unroll
    for (int q = 0; q < 4; ++q) {
        const int e = it * 2048 + q * 512 + opq_tid();
        if (e < 4097 * 8) {
            const int idx = e >> 3, i = e & 7;
            double invf = 1.0;
            for (int q = 0; q < i; ++q) invf *= 0.19392274474868576;
            const double pos = idx < 4096 ? (double)idx : 16384.0;
            const double rev = pos * invf * 0.15915494309189535;
            const float f = (float)(rev - floor(rev));
            rope[idx * 16 + i] = __builtin_amdgcn_cosf(f);
            rope[idx * 16 + 8 + i] = __builtin_amdgcn_sinf(f);
        }
    }
}

__device__ void p0_wfrag_item(const Params& p, int it) {
    const int e0 = it * 512 + opq_tid();
    const int lane = e0 & 63, ks = (e0 >> 6) & 1, ct = (e0 >> 7) & 3, hd = (e0 >> 9) & 15, mtx = (e0 >> 13) & 1, l = e0 >> 14;
    const float* W = (mtx == 0 ? p.w_decay : p.w_iclr) + (size_t)l * 64 * 1024 + hd * 64 + 16 * ct + (lane & 15);
    const int k0 = 32 * ks + 8 * (lane >> 4);
    float v[8];
#pragma unroll
    for (int e = 0; e < 8; ++e) v[e] = W[(size_t)(k0 + e) * 1024];
    ((uint4*)(p.ws + WS_WFRAG))[e0] = make_uint4(pack2(v[0], v[1]), pack2(v[2], v[3]), pack2(v[4], v[5]), pack2(v[6], v[7]));
}

__device__ void p1_norm(const Params& p, int l, int bid, int G) {
    const int tid = opq_tid(), wv = tid >> 6, lane = tid & 63;
    bf16_t* hb = (bf16_t*)(p.ws + WS_HB);
    const float* mod = (const float*)(p.ws + WS_MOD);
    const float4* g4 = (const float4*)(p.norm_g + l * DM);
    for (int r = bid * 8 + wv; r < MT; r += G * 8) {
        const float* xr = l == 0 ? (r < TP ? p.x_prompt + (size_t)r * DM : p.x_sample + (size_t)(r - TP) * DM) : p.out + (size_t)r * DM;
        const int mrow = r < TP ? (r >> 12) : 2 + (r - TP);
        const float* md = mod + ((size_t)l * 34 + mrow) * 6144;
        float4 v[8]; float ss = 0.f;
#pragma unroll
        for (int i = 0; i < 8; ++i) { v[i] = ((const float4*)xr)[lane + 64 * i]; ss += v[i].x * v[i].x + v[i].y * v[i].y + v[i].z * v[i].z + v[i].w * v[i].w; }
        ss = wave_sum(ss);
        const float rinv = rsqrtf(ss * (1.f / 2048.f) + 1e-5f);
#pragma unroll
        for (int i = 0; i < 8; ++i) {
            const int c4 = lane + 64 * i;
            const float4 g = g4[c4], sc = ((const float4*)(md + 2048))[c4], sh = ((const float4*)md)[c4];
            const float y0 = v[i].x * rinv * g.x * (1.f + sc.x) + sh.x, y1 = v[i].y * rinv * g.y * (1.f + sc.y) + sh.y;
            const float y2 = v[i].z * rinv * g.z * (1.f + sc.z) + sh.z, y3 = v[i].w * rinv * g.w * (1.f + sc.w) + sh.w;
            *(uint2*)(hb + (size_t)r * DM + 4 * c4) = make_uint2(pack2(y0, y1), pack2(y2, y3));
        }
    }
}

struct Epi1 {
    static constexpr bool PERM = false, AFTER_DRAIN = false;
    int l;
    __device__ __forceinline__ void operator()(const f32x4 (&acc)[2][2][4][2], const pg8::Unit& u, int wr, int wc, int fr, int fq) const {
        const Params& p = kparams();
        bf16_t* const qb = (bf16_t*)(p.ws + WS_QB); bf16_t* const kb = (bf16_t*)(p.ws + WS_KB); bf16_t* const vb = (bf16_t*)(p.ws + WS_VB);
        bf16_t* const rw = (bf16_t*)(p.ws + WS_RW); bf16_t* const gt = (bf16_t*)(p.ws + WS_GT); const float* const rope = (const float*)(p.ws + WS_ROPE); float* const out = p.out;
#pragma unroll
        for (int bj = 0; bj < 2; ++bj)
#pragma unroll
            for (int n = 0; n < 2; ++n) {
                const int cb = u.pn * 256 + bj * 128 + wc * 32 + n * 16;
                if (cb >= INW) continue;
                const int c = cb + 4 * fq;
                const bool do_rope = (cb < 1280) && ((cb & 63) == 0);
#pragma unroll
                for (int ai = 0; ai < 2; ++ai)
#pragma unroll
                    for (int m = 0; m < 4; ++m) {
                        const int rb = u.pm * 256 + ai * 128 + wr * 64 + m * 16;
                        if (rb >= MT) continue;
                        const int r = rb + fr;
                        f32x4 v = acc[ai][bj][m][n];
                        if (do_rope) {
                            const int idx = r < TP ? (r & 4095) : 4096;
                            const float4 cs = *(const float4*)(rope + idx * 16 + 4 * (fq & 1));
                            const float4 sn = *(const float4*)(rope + idx * 16 + 8 + 4 * (fq & 1));
                            const float p0 = __shfl_xor(v[0], 32), p1 = __shfl_xor(v[1], 32), p2 = __shfl_xor(v[2], 32), p3 = __shfl_xor(v[3], 32);
                            const float sg = fq < 2 ? -1.f : 1.f;
                            v[0] = v[0] * cs.x + sg * p0 * sn.x; v[1] = v[1] * cs.y + sg * p1 * sn.y; v[2] = v[2] * cs.z + sg * p2 * sn.z; v[3] = v[3] * cs.w + sg * p3 * sn.w;
                        }
                        if (cb < 1024) {
                            *(uint2*)(qb + (size_t)r * 1024 + c) = make_uint2(pack2(v[0] * 0.125f, v[1] * 0.125f), pack2(v[2] * 0.125f, v[3] * 0.125f));
                        } else if (cb < 1536) {
                            const bool isk = cb < 1280;
                            const int cc = c - (isk ? 1024 : 1280);
                            *(uint2*)((isk ? kb : vb) + (size_t)r * 256 + cc) = make_uint2(pack2(v[0], v[1]), pack2(v[2], v[3]));
                            if (r >= TP) {
                                *(f32x4*)(out + (isk ? O_CKS : O_CVS) + ((size_t)(l * NBS + (r - TP)) * 128 + 127) * 256 + cc) = v;
                            } else if ((r & 4095) >= SEQ - 128) {
                                *(f32x4*)(out + (isk ? O_CKP : O_CVP) + ((size_t)(l * NBP + (r >> 12)) * 128 + ((r & 4095) - (SEQ - 128))) * 256 + cc) = v;
                            }
                        } else if (cb < 4736) {
                            const int cc = c - 1536;
                            *(uint2*)(rw + (size_t)r * SHD + cc) = make_uint2(pack2(v[0], v[1]), pack2(v[2], v[3]));
                            if (r >= TP) *(f32x4*)(out + O_SHS + (size_t)(l * NBS + (r - TP)) * SHD + cc) = v;
                            else if ((r & 4095) == SEQ - 1) *(f32x4*)(out + O_SHP + (size_t)(l * NBP + (r >> 12)) * SHD + cc) = v;
                        } else {
                            const int cc = c - 4736;
                            *(uint2*)(gt + (size_t)r * DM + cc) = make_uint2(pack2(silu_f(v[0]), silu_f(v[1])), pack2(silu_f(v[2]), silu_f(v[3])));
                        }
                    }
            }
    }
};

struct Epi2 {
    static constexpr bool PERM = false, AFTER_DRAIN = false;
    int l;
    __device__ __forceinline__ void operator()(const f32x4 (&acc)[2][2][4][2], const pg8::Unit& u, int wr, int wc, int fr, int fq) const {
        const Params& p = kparams();
        float* const out = p.out;
        const int rb0 = u.pm * 256;
        const int mrow = rb0 < TP ? (rb0 >> 12) : 2;
        const float* gr = (const float*)(p.ws + WS_MOD) + ((size_t)l * 34 + mrow) * 6144 + 4096 + u.pn * 256 + wc * 32 + 4 * fq;
        f32x4 g4[2][2];
#pragma unroll
        for (int bj = 0; bj < 2; ++bj)
#pragma unroll
            for (int n = 0; n < 2; ++n) g4[bj][n] = *(const f32x4*)(gr + bj * 128 + n * 16);
        const float* xbase = l == 0 ? p.x_prompt : out;
        const int c0 = u.pn * 256 + wc * 32 + 4 * fq;
#pragma unroll
        for (int ai = 0; ai < 2; ++ai)
#pragma unroll
            for (int mh = 0; mh < 2; ++mh) {
                f32x4 x4[2][2][2];
#pragma unroll
                for (int mm = 0; mm < 2; ++mm) {
                    const int r = rb0 + ai * 128 + wr * 64 + (2 * mh + mm) * 16 + fr;
                    const float* xo = xbase + (size_t)r * DM + c0;
#pragma unroll
                    for (int bj = 0; bj < 2; ++bj)
#pragma unroll
                        for (int n = 0; n < 2; ++n) x4[mm][bj][n] = *(const f32x4*)(xo + bj * 128 + n * 16);
                }
                __builtin_amdgcn_sched_barrier(0);
#pragma unroll
                for (int mm = 0; mm < 2; ++mm) {
                    const int r = rb0 + ai * 128 + wr * 64 + (2 * mh + mm) * 16 + fr;
                    float* yo = out + (size_t)r * DM + c0;
#pragma unroll
                    for (int bj = 0; bj < 2; ++bj)
#pragma unroll
                        for (int n = 0; n < 2; ++n) *(f32x4*)(yo + bj * 128 + n * 16) = x4[mm][bj][n] + g4[bj][n] * acc[ai][bj][2 * mh + mm][n];
                }
                __builtin_amdgcn_sched_barrier(0);
            }
    }
};

__device__ void g2_sample_item(const Params& p, float* red, int l, int nb) {
    const int tid = opq_tid(), wv = tid >> 6, lane = tid & 63, n = lane & 31, h = lane >> 5;
    const bf16_t* A = (const bf16_t*)(p.ws + WS_HB) + (size_t)TP * DM;
    const bf16_t* Bt = (const bf16_t*)(p.ws + WS_WTOUT) + (size_t)l * DM * DM + (size_t)(nb * 32) * DM;
    f32x16 acc;
#pragma unroll
    for (int i = 0; i < 16; ++i) acc[i] = 0.f;
#pragma unroll 4
    for (int ks = 0; ks < 16; ++ks) {
        const int k0 = wv * 256 + ks * 16 + 8 * h;
        const bf16x8 a = *(const bf16x8*)(A + (size_t)n * DM + k0);
        const bf16x8 bq = *(const bf16x8*)(Bt + (size_t)n * DM + k0);
        acc = __builtin_amdgcn_mfma_f32_32x32x16_bf16(a, bq, acc, 0, 0, 0);
    }
#pragma unroll
    for (int i = 0; i < 16; ++i) red[(wv * 16 + i) * 64 + lane] = acc[i];
    __syncthreads();
    const float* mod = (const float*)(p.ws + WS_MOD) + (size_t)l * 34 * 6144;
    for (int o = tid; o < 1024; o += 512) {
        const int row = o >> 5, col = o & 31, hh = (row >> 2) & 1, ri = (row & 3) + 4 * (row >> 3), ln = col + 32 * hh;
        float s = 0.f;
#pragma unroll
        for (int w = 0; w < 8; ++w) s += red[(w * 16 + ri) * 64 + ln];
        const int c = nb * 32 + col;
        const float gate = mod[(size_t)(2 + row) * 6144 + 4096 + c];
        const float xo = l == 0 ? p.x_sample[(size_t)row * DM + c] : p.out[(size_t)(TP + row) * DM + c];
        p.out[(size_t)(TP + row) * DM + c] = xo + gate * s;
    }
    __syncthreads();
}

__device__ void p3_attn_unit(const Params& p, unsigned char* lds, int l, int unit, int s_half) {
    const int tid = opq_tid(), wv = tid >> 6, lane = tid & 63;
    const int b = unit >> 7, n = (unit >> 2) & 31, g = unit & 3;
    bf16_t* Ks = (bf16_t*)lds;
    bf16_t* Vt = (bf16_t*)(lds + 36864);
    const bf16_t* qb = (const bf16_t*)(p.ws + WS_QB);
    const bf16_t* kb = (const bf16_t*)(p.ws + WS_KB);
    const bf16_t* vb = (const bf16_t*)(p.ws + WS_VB);
    const bf16_t* gt = (const bf16_t*)(p.ws + WS_GT);
    bf16_t* cc = (bf16_t*)(p.ws + WS_HB);
    {
        uint4 kv4[4], vv4[4];
#pragma unroll
        for (int i = 0; i < 4; ++i) {
            const int chunk = tid + 512 * i, kl = chunk >> 3, dc = chunk & 7, kp = 128 * (n - 1) + kl;
            kv4[i] = make_uint4(0u, 0u, 0u, 0u); vv4[i] = kv4[i];
            if (kp >= 0) { const size_t row = (size_t)b * SEQ + kp; kv4[i] = *(const uint4*)(kb + row * 256 + g * 64 + dc * 8); vv4[i] = *(const uint4*)(vb + row * 256 + g * 64 + dc * 8); }
        }
        __builtin_amdgcn_sched_barrier(0);
#pragma unroll
        for (int i = 0; i < 4; ++i) {
            const int chunk = tid + 512 * i, kl = chunk >> 3, dc = chunk & 7;
            *(uint4*)(Ks + kl * 72 + dc * 8) = kv4[i];
            bf16_t* vd = Vt + (dc * 8) * 264 + kl;
            vd[0 * 264] = (bf16_t)(vv4[i].x & 0xffffu); vd[1 * 264] = (bf16_t)(vv4[i].x >> 16);
            vd[2 * 264] = (bf16_t)(vv4[i].y & 0xffffu); vd[3 * 264] = (bf16_t)(vv4[i].y >> 16);
            vd[4 * 264] = (bf16_t)(vv4[i].z & 0xffffu); vd[5 * 264] = (bf16_t)(vv4[i].z >> 16);
            vd[6 * 264] = (bf16_t)(vv4[i].w & 0xffffu); vd[7 * 264] = (bf16_t)(vv4[i].w >> 16);
        }
    }
    __syncthreads();
    const int hq = 4 * g + (wv >> 1), qh = wv & 1, q32 = lane & 31, h = lane >> 5;
    const float sink = p.sinks[l * 16 + hq];
#pragma unroll 1
    for (int s = s_half; s <= s_half; ++s) {
        const int qp = 128 * n + 64 * qh + 32 * s + q32;
        const size_t qrow = (size_t)b * SEQ + qp;
        const int klb0 = 64 * qh + 32 * s;
        bf16x8 qf[4];
#pragma unroll
        for (int ks = 0; ks < 4; ++ks) qf[ks] = *(const bf16x8*)(qb + qrow * 1024 + hq * 64 + ks * 16 + 8 * h);
        f32x16 S[5];
#pragma unroll
        for (int kt = 0; kt < 5; ++kt) {
#pragma unroll
            for (int i = 0; i < 16; ++i) S[kt][i] = 0.f;
#pragma unroll
            for (int ks = 0; ks < 4; ++ks) {
                const bf16x8 a = *(const bf16x8*)(Ks + (klb0 + 32 * kt + q32) * 72 + ks * 16 + 8 * h);
                S[kt] = __builtin_amdgcn_mfma_f32_32x32x16_bf16(a, qf[ks], S[kt], 0, 0, 0);
            }
        }
        float mx = -1e30f;
#pragma unroll
        for (int kt = 0; kt < 5; ++kt)
#pragma unroll
            for (int i = 0; i < 16; ++i) {
                const int m = 8 * (i >> 2) + 4 * h + (i & 3);
                const int kp = 128 * (n - 1) + klb0 + 32 * kt + m;
                const int rel = qp - kp;
                const bool ok = (rel >= 0) && (rel <= 128) && (kp >= 0);
                const float sv = ok ? S[kt][i] : -1e30f;
                S[kt][i] = sv; mx = fmaxf(mx, sv);
            }
        mx = fmaxf(mx, __shfl_xor(mx, 32));
        mx = fmaxf(mx, sink);
        float sum = 0.f;
#pragma unroll
        for (int kt = 0; kt < 5; ++kt)
#pragma unroll
            for (int i = 0; i < 16; ++i) { const float e = __expf(S[kt][i] - mx); S[kt][i] = e; sum += e; }
        sum += __shfl_xor(sum, 32);
        const float inv = 1.f / (sum + __expf(sink - mx));
        f32x16 O[2];
#pragma unroll
        for (int i = 0; i < 16; ++i) { O[0][i] = 0.f; O[1][i] = 0.f; }
#pragma unroll
        for (int kt = 0; kt < 5; ++kt)
#pragma unroll
            for (int sp = 0; sp < 2; ++sp) {
                bf16x8 pf;
#pragma unroll
                for (int j = 0; j < 8; ++j) pf[j] = (short)f2bf(S[kt][8 * sp + j]);
#pragma unroll
                for (int dt = 0; dt < 2; ++dt) {
                    const bf16_t* vp = Vt + (32 * dt + q32) * 264 + klb0 + 32 * kt + 16 * sp + 4 * h;
                    const uint2 lo = *(const uint2*)vp, hi = *(const uint2*)(vp + 8);
                    const uint4 av = make_uint4(lo.x, lo.y, hi.x, hi.y);
                    O[dt] = __builtin_amdgcn_mfma_f32_32x32x16_bf16(__builtin_bit_cast(bf16x8, av), pf, O[dt], 0, 0, 0);
                }
            }
        uint2 gq[2][4];
#pragma unroll
        for (int dt = 0; dt < 2; ++dt)
#pragma unroll
            for (int ig = 0; ig < 4; ++ig) gq[dt][ig] = *(const uint2*)(gt + qrow * DM + hq * 64 + 32 * dt + 8 * ig + 4 * h);
        __builtin_amdgcn_sched_barrier(0);
#pragma unroll
        for (int dt = 0; dt < 2; ++dt)
#pragma unroll
            for (int ig = 0; ig < 4; ++ig) {
                const int col = hq * 64 + 32 * dt + 8 * ig + 4 * h;
                const uint2 gg = gq[dt][ig];
                const float o0 = O[dt][4 * ig + 0] * inv * bflo(gg.x), o1 = O[dt][4 * ig + 1] * inv * bfhi(gg.x);
                const float o2 = O[dt][4 * ig + 2] * inv * bflo(gg.y), o3 = O[dt][4 * ig + 3] * inv * bfhi(gg.y);
                *(uint2*)(cc + qrow * DM + col) = make_uint2(pack2(o0, o1), pack2(o2, o3));
            }
    }
    __syncthreads();
}

__device__ void p3_sattn_item(const Params& p, float* lds, int l, int item) {
    const int tid = opq_tid(), wv = tid >> 6, lane = tid & 63;
    float* pl = lds + wv * 128;
    const int w = item * 8 + wv, bd = w >> 4, hq = w & 15, g = hq >> 2;
    const size_t row = (size_t)TP + bd;
    const bf16_t* qb = (const bf16_t*)(p.ws + WS_QB);
    const bf16_t* gt = (const bf16_t*)(p.ws + WS_GT);
    bf16_t* cc = (bf16_t*)(p.ws + WS_HB);
    float q[64];
#pragma unroll
    for (int c = 0; c < 8; ++c) {
        const uint4 u = *(const uint4*)(qb + row * 1024 + hq * 64 + c * 8);
        q[c * 8 + 0] = bflo(u.x); q[c * 8 + 1] = bfhi(u.x); q[c * 8 + 2] = bflo(u.y); q[c * 8 + 3] = bfhi(u.y);
        q[c * 8 + 4] = bflo(u.z); q[c * 8 + 5] = bfhi(u.z); q[c * 8 + 6] = bflo(u.w); q[c * 8 + 7] = bfhi(u.w);
    }
    const size_t cbase = ((size_t)(l * NBS + bd) * 128) * 256 + g * 64;
    const float* ck = p.cache_k + cbase;
    const float* cv = p.cache_v + cbase;
    float* nk = p.out + O_CKS + cbase;
    float* nv = p.out + O_CVS + cbase;
    float s0 = 0.f, s1 = 0.f, s2 = 0.f;
#pragma unroll
    for (int c = 0; c < 16; ++c) {
        const float4 a = ((const float4*)(ck + (size_t)lane * 256))[c];
        const float4 bq = ((const float4*)(ck + (size_t)(lane + 64) * 256))[c];
        const float4 e = ((const float4*)(nk + (size_t)127 * 256))[c];
        s0 += a.x * q[4 * c] + a.y * q[4 * c + 1] + a.z * q[4 * c + 2] + a.w * q[4 * c + 3];
        s1 += bq.x * q[4 * c] + bq.y * q[4 * c + 1] + bq.z * q[4 * c + 2] + bq.w * q[4 * c + 3];
        s2 += e.x * q[4 * c] + e.y * q[4 * c + 1] + e.z * q[4 * c + 2] + e.w * q[4 * c + 3];
    }
    const float sink = p.sinks[l * 16 + hq];
    const float mx = fmaxf(wave_max(fmaxf(s0, s1)), fmaxf(s2, sink));
    const float p0 = __expf(s0 - mx), p1 = __expf(s1 - mx), p2 = __expf(s2 - mx);
    const float sum = wave_sum(p0 + p1) + p2 + __expf(sink - mx);
    pl[lane] = p0; pl[lane + 64] = p1;
    __builtin_amdgcn_fence(__ATOMIC_RELEASE, "wavefront");
    __builtin_amdgcn_wave_barrier();
    __builtin_amdgcn_fence(__ATOMIC_ACQUIRE, "wavefront");
    float o = 0.f;
#pragma unroll 32
    for (int key = 0; key < 128; ++key) o += pl[key] * cv[(size_t)key * 256 + lane];
    o += p2 * nv[(size_t)127 * 256 + lane];
    o /= sum;
    const float gate = bf2f(gt[row * DM + hq * 64 + lane]);
    cc[row * DM + hq * 64 + lane] = f2bf(o * gate);
    {
        float tk[32], tv[32];
#pragma unroll
        for (int i = 0; i < 32; ++i) {
            const int ww = (hq & 3) + 4 * i;
            tk[i] = ck[(size_t)(ww + 1 < 128 ? ww + 1 : 127) * 256 + lane]; tv[i] = cv[(size_t)(ww + 1 < 128 ? ww + 1 : 127) * 256 + lane];
        }
#pragma unroll
        for (int i = 0; i < 32; ++i) {
            const int ww = (hq & 3) + 4 * i;
            if (ww < 127) { nk[(size_t)ww * 256 + lane] = tk[i]; nv[(size_t)ww * 256 + lane] = tv[i]; }
        }
    }
    __builtin_amdgcn_wave_barrier();
}

__device__ __forceinline__ float mix_val(const bf16_t* rw, const float* sshift, const float* mu, int r, int c) {
    const float cur = bf2f(rw[(size_t)r * SHD + c]);
    float prev;
    if (r >= TP) prev = sshift[(size_t)(r - TP) * SHD + c];
    else if ((r & 4095) == 0) prev = 0.f;
    else prev = bf2f(rw[(size_t)(r - 1) * SHD + c]);
    return cur + (prev - cur) * mu[c];
}

__device__ __forceinline__ float4 mix4(const bf16_t* rw, const float* sshift, int r, int c, float4 mu4) {
    const uint2 cu = *(const uint2*)(rw + (size_t)r * SHD + c);
    const float4 cur = make_float4(bflo(cu.x), bfhi(cu.x), bflo(cu.y), bfhi(cu.y));
    float4 prev = make_float4(0.f, 0.f, 0.f, 0.f);
    if (r >= TP) prev = *(const float4*)(sshift + (size_t)(r - TP) * SHD + c);
    else if ((r & 4095) != 0) { const uint2 pu = *(const uint2*)(rw + (size_t)(r - 1) * SHD + c); prev = make_float4(bflo(pu.x), bfhi(pu.x), bflo(pu.y), bfhi(pu.y)); }
    return make_float4(cur.x + (prev.x - cur.x) * mu4.x, cur.y + (prev.y - cur.y) * mu4.y, cur.z + (prev.z - cur.z) * mu4.z, cur.w + (prev.w - cur.w) * mu4.w);
}
__device__ __forceinline__ float decay_of(float x) {
    const float z = -x;
    const float sp = fmaxf(z, 0.f) + __logf(1.f + __expf(-fabsf(z)));
    return __expf(-__expf(-sp - 0.5f));
}

__device__ void p3_twad_item(const Params& p, int l, int tile) {
    const int tid = opq_tid();
    const bf16_t* rw = (const bf16_t*)(p.ws + WS_RW);
    const float* sshift = p.state_shift + (size_t)l * NBS * SHD;
    const float* mu = p.mu_shift + l * SHD;
    bf16_t* TWAD = (bf16_t*)(p.ws + WS_TWAD);
    const int r0 = tile * 32;
    float mm[8];
#pragma unroll
    for (int i = 0; i < 8; ++i) { const int idx = tid + 512 * i, tt = idx >> 7, c2 = idx & 127; mm[i] = mix_val(rw, sshift, mu, r0 + tt, 3072 + c2); }
#pragma unroll
    for (int i = 0; i < 8; ++i) {
        const int idx = tid + 512 * i, tt = idx >> 7, c2 = idx & 127;
        float o = mm[i];
        if (c2 < 64) { const float e = __expf(2.f * mm[i]); o = 1.f - 2.f / (e + 1.f); }
        TWAD[(size_t)(r0 + tt) * 128 + c2] = f2bf(o);
    }
}

__device__ void p3_prep_tile(const Params& p, unsigned char* lds, int l, int tile) {
    const int tid = opq_tid(), wv = tid >> 6, lane = tid & 63, n = lane & 31, h = lane >> 5;
    bf16_t* TW = (bf16_t*)lds;
    bf16_t* AD = TW + 32 * 72;
    const bf16_t* rw = (const bf16_t*)(p.ws + WS_RW);
    const float* sshift = p.state_shift + (size_t)l * NBS * SHD;
    const float* mu = p.mu_shift + l * SHD;
    bf16_t* RSB = (bf16_t*)(p.ws + WS_RSB);
    bf16_t* VALL = (bf16_t*)(p.ws + WS_VALL);
    float* RSW = (float*)(p.ws + WS_RSW);
    float* coef = (float*)(p.ws + WS_COEF);
    const int r0 = tile * 32;
    {
        float mm[8];
#pragma unroll
        for (int i = 0; i < 8; ++i) { const int idx = tid + 512 * i, tt = idx >> 7, c2 = idx & 127; mm[i] = mix_val(rw, sshift, mu, r0 + tt, 3072 + c2); }
        __builtin_amdgcn_sched_barrier(0);
#pragma unroll
        for (int i = 0; i < 8; ++i) {
            const int idx = tid + 512 * i, tt = idx >> 7, c2 = idx & 127;
            if (c2 < 64) { const float e = __expf(2.f * mm[i]); TW[tt * 72 + c2] = f2bf(1.f - 2.f / (e + 1.f)); }
            else AD[tt * 72 + (c2 - 64)] = f2bf(mm[i]);
        }
    }
    __syncthreads();
    const int col0 = wv * 128 + 4 * n;
    f32x16 acc[4];
    {
        const float* wp = p.w_decay + (size_t)l * 64 * 1024 + col0;
#pragma unroll
        for (int nt = 0; nt < 4; ++nt)
#pragma unroll
            for (int i = 0; i < 16; ++i) acc[nt][i] = 0.f;
#pragma unroll
        for (int ks = 0; ks < 4; ++ks) {
            const bf16x8 a = *(const bf16x8*)(TW + n * 72 + 16 * ks + 8 * h);
            float4 w4[8];
#pragma unroll
            for (int e = 0; e < 8; ++e) w4[e] = *(const float4*)(wp + (size_t)(16 * ks + 8 * h + e) * 1024);
            bf16x8 b0, b1, b2, b3;
#pragma unroll
            for (int e = 0; e < 8; ++e) { b0[e] = (short)f2bf(w4[e].x); b1[e] = (short)f2bf(w4[e].y); b2[e] = (short)f2bf(w4[e].z); b3[e] = (short)f2bf(w4[e].w); }
            acc[0] = __builtin_amdgcn_mfma_f32_32x32x16_bf16(a, b0, acc[0], 0, 0, 0);
            acc[1] = __builtin_amdgcn_mfma_f32_32x32x16_bf16(a, b1, acc[1], 0, 0, 0);
            acc[2] = __builtin_amdgcn_mfma_f32_32x32x16_bf16(a, b2, acc[2], 0, 0, 0);
            acc[3] = __builtin_amdgcn_mfma_f32_32x32x16_bf16(a, b3, acc[3], 0, 0, 0);
        }
        const float4 w0c = *(const float4*)(p.w0 + l * 1024 + col0);
#pragma unroll
        for (int r = 0; r < 16; ++r) {
            const int row = r0 + 8 * (r >> 2) + 4 * h + (r & 3);
            *(float4*)(RSW + (size_t)(row - TP) * 1024 + col0) =
                make_float4(decay_of(w0c.x + acc[0][r]), decay_of(w0c.y + acc[1][r]), decay_of(w0c.z + acc[2][r]), decay_of(w0c.w + acc[3][r]));
        }
    }
    {
        const float* wp = p.w_iclr + (size_t)l * 64 * 1024 + col0;
#pragma unroll
        for (int nt = 0; nt < 4; ++nt)
#pragma unroll
            for (int i = 0; i < 16; ++i) acc[nt][i] = 0.f;
#pragma unroll
        for (int ks = 0; ks < 4; ++ks) {
            const bf16x8 a = *(const bf16x8*)(AD + n * 72 + 16 * ks + 8 * h);
            float4 w4[8];
#pragma unroll
            for (int e = 0; e < 8; ++e) w4[e] = *(const float4*)(wp + (size_t)(16 * ks + 8 * h + e) * 1024);
            bf16x8 b0, b1, b2, b3;
#pragma unroll
            for (int e = 0; e < 8; ++e) { b0[e] = (short)f2bf(w4[e].x); b1[e] = (short)f2bf(w4[e].y); b2[e] = (short)f2bf(w4[e].z); b3[e] = (short)f2bf(w4[e].w); }
            acc[0] = __builtin_amdgcn_mfma_f32_32x32x16_bf16(a, b0, acc[0], 0, 0, 0);
            acc[1] = __builtin_amdgcn_mfma_f32_32x32x16_bf16(a, b1, acc[1], 0, 0, 0);
            acc[2] = __builtin_amdgcn_mfma_f32_32x32x16_bf16(a, b2, acc[2], 0, 0, 0);
            acc[3] = __builtin_amdgcn_mfma_f32_32x32x16_bf16(a, b3, acc[3], 0, 0, 0);
        }
    }
    const float4 a0c = *(const float4*)(p.a0 + l * 1024 + col0), kkc = *(const float4*)(p.k_k + l * 1024 + col0), kac = *(const float4*)(p.k_a + l * 1024 + col0), rkc = *(const float4*)(p.r_k + l * 1024 + col0);
    const float4 mur = *(const float4*)(mu + col0), muk = *(const float4*)(mu + 1024 + col0), muv = *(const float4*)(mu + 2048 + col0);
    const int head = 2 * wv + (n >> 4);
#pragma unroll
    for (int g4 = 0; g4 < 4; ++g4) {
        float4 rr4[4], kr4[4], vr4[4];
#pragma unroll
        for (int q = 0; q < 4; ++q) {
            const int row = r0 + 8 * g4 + 4 * h + q;
            rr4[q] = mix4(rw, sshift, row, col0, mur); kr4[q] = mix4(rw, sshift, row, 1024 + col0, muk); vr4[q] = mix4(rw, sshift, row, 2048 + col0, muv);
        }
        __builtin_amdgcn_sched_barrier(0);
#pragma unroll
        for (int q = 0; q < 4; ++q) {
            const int r = 4 * g4 + q;
            const int row = r0 + 8 * g4 + 4 * h + q;
            const float4 rr = rr4[q], kr = kr4[q], vr = vr4[q];
            const float ax = 1.f / (1.f + __expf(-(a0c.x + acc[0][r]))), ay = 1.f / (1.f + __expf(-(a0c.y + acc[1][r])));
            const float az = 1.f / (1.f + __expf(-(a0c.z + acc[2][r]))), aw = 1.f / (1.f + __expf(-(a0c.w + acc[3][r])));
            const float k0 = kr.x * kkc.x, k1 = kr.y * kkc.y, k2 = kr.z * kkc.z, k3 = kr.w * kkc.w;
            const float ss = allreduce16(k0 * k0 + k1 * k1 + k2 * k2 + k3 * k3);
            const float inv = 1.f / fmaxf(sqrtf(ss), 1e-12f);
            const float4 kk = make_float4(k0 * inv, k1 * inv, k2 * inv, k3 * inv);
            const float4 ke = make_float4(kr.x * (1.f + (ax - 1.f) * kac.x), kr.y * (1.f + (ay - 1.f) * kac.y), kr.z * (1.f + (az - 1.f) * kac.z), kr.w * (1.f + (aw - 1.f) * kac.w));
            const float cf = allreduce16(rr.x * ke.x * rkc.x + rr.y * ke.y * rkc.y + rr.z * ke.z * rkc.z + rr.w * ke.w * rkc.w);
            if ((n & 15) == 0) coef[(size_t)row * 16 + head] = cf;
            const size_t o = (size_t)row * 1024 + col0;
            const size_t os = (size_t)(row - TP) * 1024 + col0;
            *(uint2*)(RSB + os) = make_uint2(pack2(rr.x, rr.y), pack2(rr.z, rr.w));
            *(uint2*)(RSB + SRI + os) = make_uint2(pack2(ke.x, ke.y), pack2(ke.z, ke.w));
            *(uint2*)(RSB + 2 * SRI + os) = make_uint2(pack2(kk.x, kk.y), pack2(kk.z, kk.w));
            *(uint2*)(RSB + 3 * SRI + os) = make_uint2(pack2(kk.x * ax, kk.y * ay), pack2(kk.z * az, kk.w * aw));
            *(uint2*)(VALL + o) = make_uint2(pack2(vr.x, vr.y), pack2(vr.z, vr.w));
        }
        __builtin_amdgcn_sched_barrier(0);
    }
    __syncthreads();
}

constexpr int REC_BYTES = 14592;
constexpr int PA_WLDS = 16384;
typedef float f32x4v __attribute__((ext_vector_type(4)));

__device__ void pa_chunk(const Params& p, unsigned char* wl, int l, int ct) {
    const int lane = opq_tid() & 63;
    const int hh = ct >> 8, c = ct & 255, b = hh >> 4, h = hh & 15;
    const size_t row0 = (size_t)b * SEQ + 16 * c;
    const int col = h * 64 + lane;
    bf16_t* VALL = (bf16_t*)(p.ws + WS_VALL);
    float vv[16];
    float gC;
    bf16_t* S_AB = (bf16_t*)wl; bf16_t* S_BB = S_AB + 16 * 72; bf16_t* S_KB = S_BB + 16 * 72; bf16_t* S_RT = S_KB + 16 * 72;
    {
        const bf16_t* rw = (const bf16_t*)(p.ws + WS_RW);
        const bf16_t* TWAD = (const bf16_t*)(p.ws + WS_TWAD);
        const uint4* WFd = (const uint4*)(p.ws + WS_WFRAG) + (size_t)((l * 2 + 0) * 16 + h) * 512 + lane;
        const uint4* WFi = (const uint4*)(p.ws + WS_WFRAG) + (size_t)((l * 2 + 1) * 16 + h) * 512 + lane;
        unsigned xr[17], xk[17], xv[17];
        const bool first = (row0 & 4095) == 0;
#pragma unroll
        for (int t = 0; t < 17; ++t) {
            const unsigned ro = (unsigned)(row0 + t - 1) * (unsigned)SHD + (unsigned)col;
            if (t == 0 && first) { xr[0] = 0u; xk[0] = 0u; xv[0] = 0u; }
            else { xr[t] = rw[ro]; xk[t] = rw[ro + 1024u]; xv[t] = rw[ro + 2048u]; }
        }
        const int rr = lane & 15, kg = lane >> 4;
        f32x4v Dd[4], Da[4];
#pragma unroll
        for (int ct = 0; ct < 4; ++ct) { Dd[ct] = (f32x4v){0.f, 0.f, 0.f, 0.f}; Da[ct] = Dd[ct]; }
#pragma unroll
        for (int ks = 0; ks < 2; ++ks) {
            const bf16x8 atw = *(const bf16x8*)(TWAD + (size_t)(row0 + rr) * 128 + 32 * ks + 8 * kg);
            const bf16x8 aad = *(const bf16x8*)(TWAD + (size_t)(row0 + rr) * 128 + 64 + 32 * ks + 8 * kg);
#pragma unroll
            for (int ct = 0; ct < 4; ++ct) {
                const bf16x8 bd = __builtin_bit_cast(bf16x8, WFd[(ct * 2 + ks) * 64]);
                const bf16x8 bi = __builtin_bit_cast(bf16x8, WFi[(ct * 2 + ks) * 64]);
                Dd[ct] = __builtin_amdgcn_mfma_f32_16x16x32_bf16(atw, bd, Dd[ct], 0, 0, 0);
                Da[ct] = __builtin_amdgcn_mfma_f32_16x16x32_bf16(aad, bi, Da[ct], 0, 0, 0);
            }
        }
        float* LD = (float*)wl; float* LA = LD + 1024;
#pragma unroll
        for (int ct = 0; ct < 4; ++ct)
#pragma unroll
            for (int rg = 0; rg < 4; ++rg) { LD[(4 * kg + rg) * 64 + 16 * ct + rr] = Dd[ct][rg]; LA[(4 * kg + rg) * 64 + 16 * ct + rr] = Da[ct][rg]; }
        __builtin_amdgcn_fence(__ATOMIC_RELEASE, "wavefront"); __builtin_amdgcn_wave_barrier(); __builtin_amdgcn_fence(__ATOMIC_ACQUIRE, "wavefront");
        float din[16], ain[16];
#pragma unroll
        for (int t = 0; t < 16; ++t) { din[t] = LD[t * 64 + lane]; ain[t] = LA[t * 64 + lane]; }
        __builtin_amdgcn_fence(__ATOMIC_RELEASE, "wavefront"); __builtin_amdgcn_wave_barrier(); __builtin_amdgcn_fence(__ATOMIC_ACQUIRE, "wavefront");
        const float mur = p.mu_shift[l * SHD + col], muk = p.mu_shift[l * SHD + 1024 + col], muv = p.mu_shift[l * SHD + 2048 + col];
        const float w0c = p.w0[l * 1024 + col], a0c = p.a0[l * 1024 + col], kkc = p.k_k[l * 1024 + col], kac = p.k_a[l * 1024 + col], rkc = p.r_k[l * 1024 + col];
        float* coef = (float*)(p.ws + WS_COEF);
        float g = 1.f;
#pragma unroll
        for (int t = 0; t < 16; ++t) {
            const float cr = bf2f((unsigned short)xr[t + 1]), pr = bf2f((unsigned short)xr[t]), ck = bf2f((unsigned short)xk[t + 1]), pk = bf2f((unsigned short)xk[t]);
            const float cv = bf2f((unsigned short)xv[t + 1]), pv = bf2f((unsigned short)xv[t]);
            const float r_ = cr + (pr - cr) * mur, kr = ck + (pk - ck) * muk, vr = cv + (pv - cv) * muv;
            const float a = 1.f / (1.f + __expf(-(a0c + ain[t])));
            const float dec = decay_of(w0c + din[t]);
            const float kkr = kr * kkc;
            float ss = allreduce16(kkr * kkr); ss += __shfl_xor(ss, 16); ss += __shfl_xor(ss, 32);
            const float kkv = kkr / fmaxf(sqrtf(ss), 1e-12f);
            const float ke = kr * (1.f + (a - 1.f) * kac);
            float cf = allreduce16(r_ * ke * rkc); cf += __shfl_xor(cf, 16); cf += __shfl_xor(cf, 32);
            if (lane == 0) coef[(size_t)(row0 + t) * 16 + h] = cf;
            VALL[(unsigned)(row0 + t) * 1024u + (unsigned)col] = f2bf(vr);
            vv[t] = vr;
            S_AB[t * 72 + lane] = f2bf(-g * kkv);
            g *= dec;
            const float ig = __builtin_amdgcn_rcpf(g);
            S_BB[t * 72 + lane] = f2bf(kkv * a * ig); S_KB[t * 72 + lane] = f2bf(ke * ig); S_RT[t * 72 + lane] = f2bf(g * r_);
        }
        gC = g;
    }
    __builtin_amdgcn_fence(__ATOMIC_RELEASE, "wavefront"); __builtin_amdgcn_wave_barrier(); __builtin_amdgcn_fence(__ATOMIC_ACQUIRE, "wavefront");
    f32x4v Gab = {0.f, 0.f, 0.f, 0.f}, Gak = Gab, Grb = Gab, Grk = Gab;
    {
        const int rr = lane & 15, kg = lane >> 4;
#pragma unroll
        for (int ks = 0; ks < 2; ++ks) {
            const int o = rr * 72 + 32 * ks + 8 * kg;
            const bf16x8 fA = *(const bf16x8*)(S_AB + o), fB = *(const bf16x8*)(S_BB + o), fK = *(const bf16x8*)(S_KB + o), fR = *(const bf16x8*)(S_RT + o);
            Gab = __builtin_amdgcn_mfma_f32_16x16x32_bf16(fB, fA, Gab, 0, 0, 0);
            Gak = __builtin_amdgcn_mfma_f32_16x16x32_bf16(fK, fA, Gak, 0, 0, 0);
            Grb = __builtin_amdgcn_mfma_f32_16x16x32_bf16(fB, fR, Grb, 0, 0, 0);
            Grk = __builtin_amdgcn_mfma_f32_16x16x32_bf16(fK, fR, Grk, 0, 0, 0);
        }
    }
    __builtin_amdgcn_fence(__ATOMIC_RELEASE, "wavefront"); __builtin_amdgcn_wave_barrier(); __builtin_amdgcn_fence(__ATOMIC_ACQUIRE, "wavefront");
    float* M_AB = (float*)(wl + 9216); float* M_AK = M_AB + 256; float* M_RB = M_AK + 256; float* M_RK = M_RB + 256; float* T_ = M_RK + 256; float* Q_ = T_ + 256; float* W2_ = Q_ + 256;
    {
        const int t = lane & 15, kg = lane >> 4;
#pragma unroll
        for (int rg = 0; rg < 4; ++rg) {
            const int s = 4 * kg + rg;
            M_AB[s * 16 + t] = s < t ? Gab[rg] : 0.f; M_AK[s * 16 + t] = s < t ? Gak[rg] : 0.f;
            M_RB[s * 16 + t] = s <= t ? Grb[rg] : 0.f; M_RK[s * 16 + t] = s <= t ? Grk[rg] : 0.f;
        }
    }
    __builtin_amdgcn_fence(__ATOMIC_RELEASE, "wavefront"); __builtin_amdgcn_wave_barrier(); __builtin_amdgcn_fence(__ATOMIC_ACQUIRE, "wavefront");
    {
        const int rr = lane & 15;
        float Tr[16];
#pragma unroll
        for (int t = 0; t < 16; ++t) {
            float acc = (rr == t) ? 1.f : 0.f;
#pragma unroll
            for (int s = 0; s < t; ++s) acc += Tr[s] * M_AB[s * 16 + t];
            Tr[t] = acc;
        }
#pragma unroll
        for (int t = 0; t < 16; ++t) T_[rr * 16 + t] = Tr[t];
    }
    __builtin_amdgcn_fence(__ATOMIC_RELEASE, "wavefront"); __builtin_amdgcn_wave_barrier(); __builtin_amdgcn_fence(__ATOMIC_ACQUIRE, "wavefront");
    {
        const int s = lane & 15, tq = lane >> 4;
        float4 q = make_float4(0.f, 0.f, 0.f, 0.f);
#pragma unroll
        for (int u = 0; u < 16; ++u) { const float a = M_AK[s * 16 + u]; const float4 t4 = *(const float4*)(T_ + u * 16 + 4 * tq); q.x += a * t4.x; q.y += a * t4.y; q.z += a * t4.z; q.w += a * t4.w; }
        *(float4*)(Q_ + s * 16 + 4 * tq) = q;
        __builtin_amdgcn_fence(__ATOMIC_RELEASE, "wavefront"); __builtin_amdgcn_wave_barrier(); __builtin_amdgcn_fence(__ATOMIC_ACQUIRE, "wavefront");
        float4 w2 = *(const float4*)(M_RK + s * 16 + 4 * tq);
#pragma unroll
        for (int u = 0; u < 16; ++u) { const float a = Q_[s * 16 + u]; const float4 m4 = *(const float4*)(M_RB + u * 16 + 4 * tq); w2.x += a * m4.x; w2.y += a * m4.y; w2.z += a * m4.z; w2.w += a * m4.w; }
        *(float4*)(W2_ + s * 16 + 4 * tq) = w2;
    }
    __builtin_amdgcn_fence(__ATOMIC_RELEASE, "wavefront"); __builtin_amdgcn_wave_barrier(); __builtin_amdgcn_fence(__ATOMIC_ACQUIRE, "wavefront");
    cvt_f32x2 pt2[8], r22[8], ul2[8], yl2[8];
#pragma unroll
    for (int t = 0; t < 8; ++t) { pt2[t] = (cvt_f32x2){0.f, 0.f}; r22[t] = (cvt_f32x2){bf2f(S_RT[(2 * t) * 72 + lane]), bf2f(S_RT[(2 * t + 1) * 72 + lane])}; ul2[t] = pt2[t]; yl2[t] = pt2[t]; }
#pragma unroll
    for (int s = 0; s < 16; ++s) {
        const float as_ = bf2f(S_AB[s * 72 + lane]), vs_ = vv[s];
        const cvt_f32x2 as2 = {as_, as_}, vs2 = {vs_, vs_};
#pragma unroll
        for (int tq = 0; tq < 4; ++tq) {
            const float4 t4 = *(const float4*)(T_ + s * 16 + 4 * tq), q4 = *(const float4*)(Q_ + s * 16 + 4 * tq), w4 = *(const float4*)(W2_ + s * 16 + 4 * tq);
            pt2[2 * tq] += (cvt_f32x2){t4.x, t4.y} * as2; pt2[2 * tq + 1] += (cvt_f32x2){t4.z, t4.w} * as2;
            ul2[2 * tq] += (cvt_f32x2){q4.x, q4.y} * vs2; ul2[2 * tq + 1] += (cvt_f32x2){q4.z, q4.w} * vs2;
            yl2[2 * tq] += (cvt_f32x2){w4.x, w4.y} * vs2; yl2[2 * tq + 1] += (cvt_f32x2){w4.z, w4.w} * vs2;
        }
        __builtin_amdgcn_sched_barrier(0);
    }
    float pt[16], ul[16], yl[16];
#pragma unroll
    for (int t = 0; t < 8; ++t) { pt[2 * t] = pt2[t].x; pt[2 * t + 1] = pt2[t].y; ul[2 * t] = ul2[t].x; ul[2 * t + 1] = ul2[t].y; yl[2 * t] = yl2[t].x; yl[2 * t + 1] = yl2[t].y; }
#pragma unroll
    for (int s = 0; s < 16; ++s) {
        const cvt_f32x2 ps2 = {pt[s], pt[s]};
#pragma unroll
        for (int tq = 0; tq < 4; ++tq) {
            const float4 m4 = *(const float4*)(M_RB + s * 16 + 4 * tq);
            r22[2 * tq] += (cvt_f32x2){m4.x, m4.y} * ps2; r22[2 * tq + 1] += (cvt_f32x2){m4.z, m4.w} * ps2;
        }
        __builtin_amdgcn_sched_barrier(0);
    }
    float r2[16];
#pragma unroll
    for (int t = 0; t < 8; ++t) { r2[2 * t] = r22[t].x; r2[2 * t + 1] = r22[t].y; }
    unsigned char* rec = p.ws + WS_REC + (size_t)ct * REC_BYTES;
    float* ys = (float*)(p.ws + WS_YS);
    {
#pragma unroll
        for (int t = 0; t < 16; ++t) { S_AB[t * 72 + lane] = f2bf(pt[t]); S_RT[t * 72 + lane] = f2bf(r2[t]); }
        __builtin_amdgcn_fence(__ATOMIC_RELEASE, "wavefront"); __builtin_amdgcn_wave_barrier(); __builtin_amdgcn_fence(__ATOMIC_ACQUIRE, "wavefront");
#pragma unroll
        for (int i2 = 0; i2 < 2; ++i2) {
            const int q = lane + 64 * i2, f = q >> 5, hf = (q >> 4) & 1, t = q & 15;
            const uint2 a0 = *(const uint2*)(S_AB + t * 72 + 16 * f + 4 * hf), a1 = *(const uint2*)(S_AB + t * 72 + 16 * f + 8 + 4 * hf);
            const uint2 c0 = *(const uint2*)(S_RT + t * 72 + 16 * f + 4 * hf), c1 = *(const uint2*)(S_RT + t * 72 + 16 * f + 8 + 4 * hf);
            st_sc1_b128(rec + q * 16, a0.x, a0.y, a1.x, a1.y);
            st_sc1_b128(rec + 2048 + q * 16, c0.x, c0.y, c1.x, c1.y);
        }
        {
            float* YT = (float*)(wl + 9216);
#pragma unroll
            for (int t = 0; t < 16; ++t) YT[t * 64 + lane] = yl[t];
            __builtin_amdgcn_fence(__ATOMIC_RELEASE, "wavefront"); __builtin_amdgcn_wave_barrier(); __builtin_amdgcn_fence(__ATOMIC_ACQUIRE, "wavefront");
#pragma unroll
            for (int i4 = 0; i4 < 4; ++i4) {
                const int idx = lane + 64 * i4, t = idx >> 4, q4 = idx & 15;
                const float4 y4 = *(const float4*)(YT + t * 64 + 4 * q4);
                st_sc1_b128(ys + (unsigned)(row0 + t) * 1024u + (unsigned)(h * 64 + 4 * q4), __float_as_uint(y4.x), __float_as_uint(y4.y), __float_as_uint(y4.z), __float_as_uint(y4.w));
            }
        }
    }
    {
        float gb[16], gk[16];
#pragma unroll
        for (int t = 0; t < 16; ++t) { gb[t] = gC * bf2f(S_BB[t * 72 + lane]); gk[t] = gC * bf2f(S_KB[t * 72 + lane]); }
        st_sc1_b128(rec + 4096 + lane * 16, pack2(gb[0], gb[1]), pack2(gb[2], gb[3]), pack2(gb[8], gb[9]), pack2(gb[10], gb[11]));
        st_sc1_b128(rec + 4096 + (64 + lane) * 16, pack2(gb[4], gb[5]), pack2(gb[6], gb[7]), pack2(gb[12], gb[13]), pack2(gb[14], gb[15]));
        st_sc1_b128(rec + 6144 + lane * 16, pack2(gk[0], gk[1]), pack2(gk[2], gk[3]), pack2(gk[4], gk[5]), pack2(gk[6], gk[7]));
        st_sc1_b128(rec + 6144 + (64 + lane) * 16, pack2(gk[8], gk[9]), pack2(gk[10], gk[11]), pack2(gk[12], gk[13]), pack2(gk[14], gk[15]));
        st_sc1_b32(rec + 8192 + lane * 4, gC);
        unsigned char* ip = rec + 8448 + (lane >> 5) * 3072;
        const int il = lane & 31;
        st_sc1_b128(ip + il * 16, pack2(vv[0], vv[1]), pack2(vv[2], vv[3]), pack2(vv[4], vv[5]), pack2(vv[6], vv[7]));
        st_sc1_b128(ip + (32 + il) * 16, pack2(vv[8], vv[9]), pack2(vv[10], vv[11]), pack2(vv[12], vv[13]), pack2(vv[14], vv[15]));
#pragma unroll
        for (int tq = 0; tq < 4; ++tq) st_sc1_b128(ip + 1024 + (((tq >> 1) * 2 + (tq & 1)) * 32 + il) * 16, __float_as_uint(ul[4 * tq]), __float_as_uint(ul[4 * tq + 1]), __float_as_uint(ul[4 * tq + 2]), __float_as_uint(ul[4 * tq + 3]));
    }
    asm volatile("s_waitcnt vmcnt(0)" ::: "memory");
    if (lane == 0) __hip_atomic_store((unsigned*)(p.ws + WS_RFLAG + (size_t)ct * 64), (unsigned)(l + 1), __ATOMIC_RELAXED, __HIP_MEMORY_SCOPE_AGENT);
    __builtin_amdgcn_fence(__ATOMIC_RELEASE, "wavefront"); __builtin_amdgcn_wave_barrier();
}

__device__ void pa_sample_batch(const Params& p, int l, int task0, int tstep) {
    const int lane = opq_tid() & 63;
    const int jq = lane & 15;
    const bf16_t* RSB = (const bf16_t*)(p.ws + WS_RSB);
    const float* RSW = (const float*)(p.ws + WS_RSW);
    const bf16_t* VALL = (const bf16_t*)(p.ws + WS_VALL);
    float* ys = (float*)(p.ws + WS_YS);
    float4 s0, s1, s2, w0, w1, w2; uint2 r0, r1, r2, k0, k1, k2, q0, q1, q2, b0, b1, b2; unsigned short v0, v1, v2;
#define SB_LOAD(i_, s_, w_, r_, k_, q_, b_, v_) do { const int task_ = task0 + (i_) * tstep; if (task_ < NBS * 256) { \
        const int bd_ = task_ >> 8, h_ = (task_ >> 4) & 15, irow_ = 4 * (task_ & 15) + (lane >> 4); \
        const size_t so_ = (((size_t)(l * NBS + bd_) * 16 + h_) * 64 + irow_) * 64 + 4 * jq, os_ = (size_t)bd_ * 1024 + h_ * 64 + 4 * jq; \
        s_ = *(const float4*)(p.state_wkv + so_); r_ = *(const uint2*)(RSB + os_); k_ = *(const uint2*)(RSB + SRI + os_); q_ = *(const uint2*)(RSB + 2 * SRI + os_); b_ = *(const uint2*)(RSB + 3 * SRI + os_); \
        w_ = *(const float4*)(RSW + os_); v_ = VALL[((size_t)TP + bd_) * 1024 + h_ * 64 + irow_]; } } while (0)
#define SB_STEP(i_, s_, w_, r_, k_, q_, b_, v_) do { const int task_ = task0 + (i_) * tstep; if (task_ < NBS * 256) { \
        const int bd_ = task_ >> 8, h_ = (task_ >> 4) & 15, irow_ = 4 * (task_ & 15) + (lane >> 4); \
        const size_t so_ = (((size_t)(l * NBS + bd_) * 16 + h_) * 64 + irow_) * 64 + 4 * jq; \
        const float vv_ = bf2f(v_); \
        float pa_ = s_.x * bflo(q_.x) + s_.y * bfhi(q_.x) + s_.z * bflo(q_.y) + s_.w * bfhi(q_.y); \
        pa_ = allreduce16(pa_); const float sa_ = -pa_; \
        s_.x = fmaf(sa_, bflo(b_.x), fmaf(s_.x, w_.x, vv_ * bflo(k_.x))); s_.y = fmaf(sa_, bfhi(b_.x), fmaf(s_.y, w_.y, vv_ * bfhi(k_.x))); \
        s_.z = fmaf(sa_, bflo(b_.y), fmaf(s_.z, w_.z, vv_ * bflo(k_.y))); s_.w = fmaf(sa_, bfhi(b_.y), fmaf(s_.w, w_.w, vv_ * bfhi(k_.y))); \
        float py_ = s_.x * bflo(r_.x) + s_.y * bfhi(r_.x) + s_.z * bflo(r_.y) + s_.w * bfhi(r_.y); \
        py_ = allreduce16(py_); \
        *(float4*)(p.out + O_WKVS + so_) = s_; \
        if (jq == 0) ys[((size_t)TP + bd_) * 1024 + h_ * 64 + irow_] = py_; } } while (0)
    s0 = s1 = s2 = w0 = w1 = w2 = make_float4(0.f, 0.f, 0.f, 0.f); r0 = r1 = r2 = k0 = k1 = k2 = q0 = q1 = q2 = b0 = b1 = b2 = make_uint2(0u, 0u); v0 = v1 = v2 = 0;
    SB_LOAD(0, s0, w0, r0, k0, q0, b0, v0); SB_LOAD(1, s1, w1, r1, k1, q1, b1, v1); SB_LOAD(2, s2, w2, r2, k2, q2, b2, v2);
    __builtin_amdgcn_sched_barrier(0);
    SB_STEP(0, s0, w0, r0, k0, q0, b0, v0); SB_STEP(1, s1, w1, r1, k1, q1, b1, v1); SB_STEP(2, s2, w2, r2, k2, q2, b2, v2);
#undef SB_LOAD
#undef SB_STEP
}

__device__ __forceinline__ uint4 ld_sc1_b128(const unsigned char* p) {
    const unsigned long long a = __hip_atomic_load((const unsigned long long*)p, __ATOMIC_RELAXED, __HIP_MEMORY_SCOPE_AGENT), c = __hip_atomic_load((const unsigned long long*)(p + 8), __ATOMIC_RELAXED, __HIP_MEMORY_SCOPE_AGENT);
    return make_uint4((unsigned)a, (unsigned)(a >> 32), (unsigned)c, (unsigned)(c >> 32));
}
constexpr int PB_NB = 8, PB_SLOT = 13568, PB_NCH = SEQ / 16, PB_NX = 4, PB_XOFF = PB_NB * PB_SLOT  , PB_FOFF = PB_XOFF + PB_NX * 4096;
__device__ void pb_head(const Params& p, unsigned char* lds, int l, int blk, bool dry) {
    const int tid = opq_tid(), wv = tid >> 6, lane = tid & 63;
    const int hh = blk >> 1, it = blk & 1, b = hh >> 4, h = hh & 15;
    volatile LAS unsigned* flags = (volatile LAS unsigned*)((LAS unsigned char*)lds + PB_FOFF);
    if (tid < 16) flags[tid] = 0u;
    __syncthreads();
    const unsigned char* rec0 = p.ws + WS_REC + (size_t)(hh * 256) * REC_BYTES;
    float* ys = (float*)(p.ws + WS_YS) + ((size_t)b * SEQ) * 1024 + h * 64 + 32 * it;
    const int q32 = lane & 31, hf = lane >> 5;
    if (wv >= 2) {
        unsigned nf = __hip_atomic_load((const unsigned*)(p.ws + WS_RFLAG + (size_t)(hh * 256 + (wv - 2)) * 64), __ATOMIC_RELAXED, __HIP_MEMORY_SCOPE_AGENT);
#pragma unroll 1
        for (int c = wv - 2; c < PB_NCH; c += 6) {
            while (c - (int)flags[8] >= PB_NB || c - (int)flags[9] >= PB_NB) __builtin_amdgcn_s_sleep(8);
            asm volatile("" ::: "memory");
            {
                const unsigned* rf = (const unsigned*)(p.ws + WS_RFLAG + (size_t)(hh * 256 + c) * 64);
                while (nf != (unsigned)(l + 1)) { __builtin_amdgcn_s_sleep(2); nf = __hip_atomic_load(rf, __ATOMIC_RELAXED, __HIP_MEMORY_SCOPE_AGENT); }
                asm volatile("" ::: "memory");
            }
            const unsigned char* rec = rec0 + (size_t)c * REC_BYTES;
            unsigned char* sl = lds + (c % PB_NB) * PB_SLOT;
            const unsigned char* rc = rec + lane * 16;
            const unsigned char* ri = rec + 8448 + it * 3072 + lane * 16;
#define LD_SC1(p_) ld_sc1_b128((const unsigned char*)(p_))
            const uint4 d0 = LD_SC1(rc), d1 = LD_SC1(rc + 1024), d2 = LD_SC1(rc + 2048), d3 = LD_SC1(rc + 3072);
            const uint4 d4 = LD_SC1(rc + 4096), d5 = LD_SC1(rc + 5120), d6 = LD_SC1(rc + 6144), d7 = LD_SC1(rc + 7168);
            const uint4 d8 = LD_SC1(rec + 8192 + (lane & 15) * 16);
            const uint4 d9 = LD_SC1(ri), d10 = LD_SC1(ri + 1024), d11 = LD_SC1(ri + 2048);
            const int t0 = lane >> 3, cc = lane & 7;
            const uint4 d12 = LD_SC1(ys + (size_t)(16 * c + t0) * 1024 + cc * 4), d13 = LD_SC1(ys + (size_t)(16 * c + 8 + t0) * 1024 + cc * 4);
#undef LD_SC1
            nf = (c + 6 < PB_NCH) ? __hip_atomic_load((const unsigned*)(p.ws + WS_RFLAG + (size_t)(hh * 256 + c + 6) * 64), __ATOMIC_RELAXED, __HIP_MEMORY_SCOPE_AGENT) : 0u;
            __builtin_amdgcn_sched_barrier(0);
            unsigned char* sd = sl + lane * 16;
            *(uint4*)(sd) = d0; *(uint4*)(sd + 1024) = d1; *(uint4*)(sd + 2048) = d2; *(uint4*)(sd + 3072) = d3;
            *(uint4*)(sd + 4096) = d4; *(uint4*)(sd + 5120) = d5; *(uint4*)(sd + 6144) = d6; *(uint4*)(sd + 7168) = d7;
            if (lane < 16) *(uint4*)(sl + 8192 + lane * 16) = d8;
            *(uint4*)(sd + 8448) = d9; *(uint4*)(sd + 9472) = d10; *(uint4*)(sd + 10496) = d11;
            {
                float* yd = (float*)(sl + 11520) + ((((t0 >> 2) & 1) * 32 + 4 * cc) * 4 + (t0 & 3));
                yd[0] = __uint_as_float(d12.x); yd[4] = __uint_as_float(d12.y); yd[8] = __uint_as_float(d12.z); yd[12] = __uint_as_float(d12.w);
                yd[256] = __uint_as_float(d13.x); yd[260] = __uint_as_float(d13.y); yd[264] = __uint_as_float(d13.z); yd[268] = __uint_as_float(d13.w);
            }
            asm volatile("" ::: "memory");
            if (lane == 0) flags[c % PB_NB] = (unsigned)(c + 1);
        }
    } else if (wv == 1) {
        bf16x8 ra0, ra1, ra2, ra3; float4 y0, y1;
#define PB_FETCHY(c_) do { const unsigned char* sl_ = lds + ((c_) % PB_NB) * PB_SLOT; \
            while (flags[(c_) % PB_NB] != (unsigned)((c_) + 1)) __builtin_amdgcn_s_sleep(0); \
            asm volatile("" ::: "memory"); \
            const unsigned char* pr_ = sl_ + 2048 + (hf * 16 + (q32 & 15)) * 16; \
            ra0 = *(const bf16x8*)(pr_); ra1 = *(const bf16x8*)(pr_ + 512); ra2 = *(const bf16x8*)(pr_ + 1024); ra3 = *(const bf16x8*)(pr_ + 1536); \
            y0 = *(const float4*)(sl_ + 11520 + (hf * 32 + q32) * 16); y1 = *(const float4*)(sl_ + 11520 + ((2 + hf) * 32 + q32) * 16); \
            asm volatile("" ::: "memory"); \
            if (lane == 0) flags[9] = (unsigned)((c_) + 1); } while (0)
        PB_FETCHY(0);
#pragma unroll 1
        for (int c = 0; c < PB_NCH; ++c) {
            const unsigned char* xr = lds + PB_XOFF + (c % PB_NX) * 4096 + lane * 16;
            f32x16 Ya, Yb;
            Ya[0] = y0.x; Ya[1] = y0.y; Ya[2] = y0.z; Ya[3] = y0.w; Ya[4] = y1.x; Ya[5] = y1.y; Ya[6] = y1.z; Ya[7] = y1.w;
#pragma unroll
            for (int r = 8; r < 16; ++r) Ya[r] = 0.f;
#pragma unroll
            for (int r = 0; r < 16; ++r) Yb[r] = 0.f;
            const bf16x8 rc0 = ra0, rc1 = ra1, rc2 = ra2, rc3 = ra3;
            while (flags[10 + (c % PB_NX)] != (unsigned)(c + 1)) __builtin_amdgcn_s_sleep(0);
            asm volatile("" ::: "memory");
            const bf16x8 xf0 = *(const bf16x8*)(xr), xf1 = *(const bf16x8*)(xr + 1024), xf2 = *(const bf16x8*)(xr + 2048), xf3 = *(const bf16x8*)(xr + 3072);
            asm volatile("" ::: "memory");
            if (lane == 0) flags[14] = (unsigned)(c + 1);
            Ya = __builtin_amdgcn_mfma_f32_32x32x16_bf16(rc0, xf0, Ya, 0, 0, 0);
            Yb = __builtin_amdgcn_mfma_f32_32x32x16_bf16(rc1, xf1, Yb, 0, 0, 0);
            Ya = __builtin_amdgcn_mfma_f32_32x32x16_bf16(rc2, xf2, Ya, 0, 0, 0);
            Yb = __builtin_amdgcn_mfma_f32_32x32x16_bf16(rc3, xf3, Yb, 0, 0, 0);
            if (c + 1 < PB_NCH) PB_FETCHY(c + 1);
            float* yc = ys + (size_t)c * (16 * 1024);
            if (!dry) {
#pragma unroll
                for (int r = 0; r < 8; ++r) yc[(8 * (r >> 2) + 4 * hf + (r & 3)) * 1024 + q32] = Ya[r] + Yb[r];
            }
        }
#undef PB_FETCHY
    } else {
        f32x16 X0, X1;
#pragma unroll
        for (int i = 0; i < 16; ++i) { X0[i] = 0.f; X1[i] = 0.f; }
        bf16x8 pa0, pa1, pa2, pa3, gb0, gb1, gk0, gk1, vf;
        float4 gm0, gm1, gm2, gm3, gm4, gm5, gm6, gm7, u0, u1;
#define PB_FETCH(c_) do { const unsigned char* sl_ = lds + ((c_) % PB_NB) * PB_SLOT; \
            { unsigned rv_ = rdy; while (rv_ != (unsigned)((c_) + 1)) { __builtin_amdgcn_s_sleep(0); rv_ = flags[(c_) % PB_NB]; } } \
            asm volatile("" ::: "memory"); \
            const unsigned char* pr_ = sl_ + (hf * 16 + (q32 & 15)) * 16; \
            pa0 = *(const bf16x8*)(pr_); pa1 = *(const bf16x8*)(pr_ + 512); pa2 = *(const bf16x8*)(pr_ + 1024); pa3 = *(const bf16x8*)(pr_ + 1536); \
            gb0 = *(const bf16x8*)(sl_ + 4096 + (hf * 64 + q32) * 16); gb1 = *(const bf16x8*)(sl_ + 4096 + (hf * 64 + 32 + q32) * 16); \
            gk0 = *(const bf16x8*)(sl_ + 6144 + (hf * 64 + q32) * 16); gk1 = *(const bf16x8*)(sl_ + 6144 + (hf * 64 + 32 + q32) * 16); \
            vf = *(const bf16x8*)(sl_ + 8448 + (hf * 32 + q32) * 16); \
            const unsigned char* gp_ = sl_ + 8192 + 16 * hf; \
            gm0 = *(const float4*)(gp_); gm1 = *(const float4*)(gp_ + 32); gm2 = *(const float4*)(gp_ + 64); gm3 = *(const float4*)(gp_ + 96); \
            gm4 = *(const float4*)(gp_ + 128); gm5 = *(const float4*)(gp_ + 160); gm6 = *(const float4*)(gp_ + 192); gm7 = *(const float4*)(gp_ + 224); \
            u0 = *(const float4*)(sl_ + 9472 + (hf * 32 + q32) * 16); u1 = *(const float4*)(sl_ + 9472 + ((2 + hf) * 32 + q32) * 16); \
            asm volatile("" ::: "memory"); \
            if (lane == 0) flags[8] = (unsigned)((c_) + 1); } while (0)
        unsigned rdy = flags[0];
        PB_FETCH(0);
        int xfree = 0;
#pragma unroll 1
        for (int c = 0; c < PB_NCH; ++c) {
            unsigned char* xw = lds + PB_XOFF + (c % PB_NX) * 4096 + lane * 16;
            rdy = flags[(c + 1) % PB_NB];
            const bf16x8 xb0 = __builtin_bit_cast(bf16x8, make_uint4(pack2(X0[0], X0[1]), pack2(X0[2], X0[3]), pack2(X0[4], X0[5]), pack2(X0[6], X0[7])));
            const bf16x8 xb1 = __builtin_bit_cast(bf16x8, make_uint4(pack2(X0[8], X0[9]), pack2(X0[10], X0[11]), pack2(X0[12], X0[13]), pack2(X0[14], X0[15])));
            const bf16x8 xb2 = __builtin_bit_cast(bf16x8, make_uint4(pack2(X1[0], X1[1]), pack2(X1[2], X1[3]), pack2(X1[4], X1[5]), pack2(X1[6], X1[7])));
            const bf16x8 xb3 = __builtin_bit_cast(bf16x8, make_uint4(pack2(X1[8], X1[9]), pack2(X1[10], X1[11]), pack2(X1[12], X1[13]), pack2(X1[14], X1[15])));
            f32x16 Ua, Ub;
            Ua[0] = u0.x; Ua[1] = u0.y; Ua[2] = u0.z; Ua[3] = u0.w; Ua[4] = u1.x; Ua[5] = u1.y; Ua[6] = u1.z; Ua[7] = u1.w;
#pragma unroll
            for (int r = 8; r < 16; ++r) Ua[r] = 0.f;
#pragma unroll
            for (int r = 0; r < 16; ++r) Ub[r] = 0.f;
            Ua = __builtin_amdgcn_mfma_f32_32x32x16_bf16(pa0, xb0, Ua, 0, 0, 0);
            Ub = __builtin_amdgcn_mfma_f32_32x32x16_bf16(pa1, xb1, Ub, 0, 0, 0);
            Ua = __builtin_amdgcn_mfma_f32_32x32x16_bf16(pa2, xb2, Ua, 0, 0, 0);
            Ub = __builtin_amdgcn_mfma_f32_32x32x16_bf16(pa3, xb3, Ub, 0, 0, 0);
            f32x16 Xn0, Xn1;
            Xn0[0] = X0[0] * gm0.x; Xn0[1] = X0[1] * gm0.y; Xn0[2] = X0[2] * gm0.z; Xn0[3] = X0[3] * gm0.w; Xn0[4] = X0[4] * gm1.x; Xn0[5] = X0[5] * gm1.y; Xn0[6] = X0[6] * gm1.z; Xn0[7] = X0[7] * gm1.w;
            Xn0[8] = X0[8] * gm2.x; Xn0[9] = X0[9] * gm2.y; Xn0[10] = X0[10] * gm2.z; Xn0[11] = X0[11] * gm2.w; Xn0[12] = X0[12] * gm3.x; Xn0[13] = X0[13] * gm3.y; Xn0[14] = X0[14] * gm3.z; Xn0[15] = X0[15] * gm3.w;
            Xn1[0] = X1[0] * gm4.x; Xn1[1] = X1[1] * gm4.y; Xn1[2] = X1[2] * gm4.z; Xn1[3] = X1[3] * gm4.w; Xn1[4] = X1[4] * gm5.x; Xn1[5] = X1[5] * gm5.y; Xn1[6] = X1[6] * gm5.z; Xn1[7] = X1[7] * gm5.w;
            Xn1[8] = X1[8] * gm6.x; Xn1[9] = X1[9] * gm6.y; Xn1[10] = X1[10] * gm6.z; Xn1[11] = X1[11] * gm6.w; Xn1[12] = X1[12] * gm7.x; Xn1[13] = X1[13] * gm7.y; Xn1[14] = X1[14] * gm7.z; Xn1[15] = X1[15] * gm7.w;
            Xn0 = __builtin_amdgcn_mfma_f32_32x32x16_bf16(gk0, vf, Xn0, 0, 0, 0);
            Xn1 = __builtin_amdgcn_mfma_f32_32x32x16_bf16(gk1, vf, Xn1, 0, 0, 0);
            const bf16x8 gbc0 = gb0, gbc1 = gb1;
            while (c - xfree >= PB_NX) { xfree = (int)flags[14]; }
            asm volatile("" ::: "memory");
            *(bf16x8*)(xw) = xb0; *(bf16x8*)(xw + 1024) = xb1; *(bf16x8*)(xw + 2048) = xb2; *(bf16x8*)(xw + 3072) = xb3;
            asm volatile("" ::: "memory");
            if (lane == 0) flags[10 + (c % PB_NX)] = (unsigned)(c + 1);
            if (c + 1 < PB_NCH) PB_FETCH(c + 1);
            const bf16x8 ub = __builtin_bit_cast(bf16x8, make_uint4(pack2(Ua[0] + Ub[0], Ua[1] + Ub[1]), pack2(Ua[2] + Ub[2], Ua[3] + Ub[3]), pack2(Ua[4] + Ub[4], Ua[5] + Ub[5]), pack2(Ua[6] + Ub[6], Ua[7] + Ub[7])));
            X0 = __builtin_amdgcn_mfma_f32_32x32x16_bf16(gbc0, ub, Xn0, 0, 0, 0);
            X1 = __builtin_amdgcn_mfma_f32_32x32x16_bf16(gbc1, ub, Xn1, 0, 0, 0);
        }
#undef PB_FETCH
        float* so = p.out + O_WKVP + ((size_t)(l * NBP + b) * 16 + h) * 4096 + (size_t)(32 * it + q32) * 64;
#pragma unroll
        for (int g = 0; g < 4; ++g) {
            *(float4*)(so + 8 * g + 4 * hf) = make_float4(X0[4 * g], X0[4 * g + 1], X0[4 * g + 2], X0[4 * g + 3]);
            *(float4*)(so + 32 + 8 * g + 4 * hf) = make_float4(X1[4 * g], X1[4 * g + 1], X1[4 * g + 2], X1[4 * g + 3]);
        }
    }
    __syncthreads();
}

__device__ void p3_post(const Params& p, int l, int bid, int G) {
    const int tid = opq_tid(), wv = tid >> 6, lane = tid & 63;
    const float* ys = (const float*)(p.ws + WS_YS);
    const bf16_t* V = (const bf16_t*)(p.ws + WS_VALL);
    const float* coef = (const float*)(p.ws + WS_COEF);
    const bf16_t* gt = (const bf16_t*)(p.ws + WS_GT);
    bf16_t* cc = (bf16_t*)(p.ws + WS_HB);
    for (int r = bid * 8 + wv; r < MT; r += G * 8) {
        float4 y4[4]; uint2 vu4[4], gg4[4]; float cf4[4];
#pragma unroll
        for (int hg = 0; hg < 4; ++hg) {
            const int head = 4 * hg + (lane >> 4), c = head * 64 + 4 * (lane & 15);
            y4[hg] = *(const float4*)(ys + (size_t)r * 1024 + c);
            vu4[hg] = *(const uint2*)(V + (size_t)r * 1024 + c);
            cf4[hg] = coef[(size_t)r * 16 + head];
            gg4[hg] = *(const uint2*)(gt + (size_t)r * DM + 1024 + c);
        }
        __builtin_amdgcn_sched_barrier(0);
#pragma unroll
        for (int hg = 0; hg < 4; ++hg) {
            const int head = 4 * hg + (lane >> 4), c = head * 64 + 4 * (lane & 15);
            const float4 y = y4[hg];
            const float mu = allreduce16(y.x + y.y + y.z + y.w) * (1.f / 64.f);
            const float d0 = y.x - mu, d1 = y.y - mu, d2 = y.z - mu, d3 = y.w - mu;
            const float var = allreduce16(d0 * d0 + d1 * d1 + d2 * d2 + d3 * d3) * (1.f / 64.f);
            const float rs = rsqrtf(var + 64e-5f);
            const float4 lw = *(const float4*)(p.ln_w + l * 1024 + c), lb = *(const float4*)(p.ln_b + l * 1024 + c);
            const uint2 vu = vu4[hg];
            const float4 v4 = make_float4(bflo(vu.x), bfhi(vu.x), bflo(vu.y), bfhi(vu.y));
            const float cf = cf4[hg];
            const uint2 gg = gg4[hg];
            const float o0 = (d0 * rs * lw.x + lb.x + cf * v4.x) * bflo(gg.x), o1 = (d1 * rs * lw.y + lb.y + cf * v4.y) * bfhi(gg.x);
            const float o2 = (d2 * rs * lw.z + lb.z + cf * v4.z) * bflo(gg.y), o3 = (d3 * rs * lw.w + lb.w + cf * v4.w) * bfhi(gg.y);
            *(uint2*)(cc + (size_t)r * DM + 1024 + c) = make_uint2(pack2(o0, o1), pack2(o2, o3));
        }
    }
}

__device__ void p_final(const Params& p, int bid, int G) {
    const int tid = opq_tid(), wv = tid >> 6, lane = tid & 63;
    const float4* g4 = (const float4*)p.final_g;
    for (int r = bid * 8 + wv; r < MT; r += G * 8) {
        float4* xr = (float4*)(p.out + (size_t)r * DM);
        float4 v[8]; float ss = 0.f;
#pragma unroll
        for (int i = 0; i < 8; ++i) { v[i] = xr[lane + 64 * i]; ss += v[i].x * v[i].x + v[i].y * v[i].y + v[i].z * v[i].z + v[i].w * v[i].w; }
        ss = wave_sum(ss);
        const float rinv = rsqrtf(ss * (1.f / 2048.f) + 1e-5f);
#pragma unroll
        for (int i = 0; i < 8; ++i) { const float4 g = g4[lane + 64 * i]; xr[lane + 64 * i] = make_float4(v[i].x * rinv * g.x, v[i].y * rinv * g.y, v[i].z * rinv * g.z, v[i].w * rinv * g.w); }
    }
}

#ifndef REPL
#define REPL -1
#endif
#ifndef REPK
#define REPK -100
#endif
__global__ void __launch_bounds__(512, 2) fwd_kernel(Params p_unused) {
    extern __shared__ __attribute__((aligned(16))) unsigned char shm[];
    cg::grid_group grid = cg::this_grid();
    const int bid0 = blockIdx.x, G0 = gridDim.x;
    float* shf = (float*)shm;
    volatile LAS unsigned* xst = (volatile LAS unsigned*)((LAS unsigned char*)shm + 131072);
    if (threadIdx.x == 0) { xst[0] = 0u; xst[1] = 0u; }
    __syncthreads();
    const XcdBarrier xb = xcd_barrier_post((unsigned*)(kparams().ws + WS_BAR), xst);
    if (G0 == 0x7fffffff) grid.sync();

#pragma unroll 1
    for (int ph = 0; ph < 14; ++ph) {
        const int bid = opq_s(bid0), G = opq_s(G0);
        const int l = ph >= 7 ? 1 : 0, k = ph == 0 ? -1 : (ph == 13 ? 6 : (ph - 1) - 6 * l);
#pragma unroll 1
        for (int rep = 0; rep < ((k == kparams().repk && (kparams().repl < 0 || kparams().repl == l)) ? 2 : 1); ++rep) {
        if (k == -1) {
            for (int it = bid; it < 384; it += G) p0_mod_item(kparams(), shf, it / 192, it % 192);
            for (int it = bid; it < 17; it += G) p0_rope_item(kparams(), it);
            for (int it = bid; it < 64; it += G) p0_wfrag_item(kparams(), it);
            {
                if (bid < 128) p0_conv_all(kparams(), shf, bid, 128, 1024, 0);
                else p0_conv_all(kparams(), shf, 1024 + (bid - 128), G - 128, 2752, 0);
            }
        } else if (k == 0) {
            p1_norm(kparams(), l, bid, G);
        } else if (k == 1) {
            pg8::StaticOrder S; S.init(MP, INWP, G, bid);
            pg8::Gemm g{(const bf16_t*)(kparams().ws + WS_HB), (const bf16_t*)(kparams().ws + WS_WTIN), MP, INWP, DM};
            Epi1 E{l};
            pg8::gemm_phase<Epi1, pg8::StaticOrder, false>((PG8_LAS unsigned char*)shm, g, S, E, nullptr);
        } else if (k == 2) {
            for (int it = bid; it < 256; it += G) p3_twad_item(kparams(), l, it);
            if (bid == 0) p3_prep_tile(kparams(), shm, l, 256);
            else if (bid <= 64) p3_sattn_item(kparams(), shf, l, bid - 1);
            else for (int hu = bid - 65; hu < 512; hu += G - 65) p3_attn_unit(kparams(), shm, l, hu >> 1, hu & 1);
            __syncthreads();
            if (l == 0) p0_conv_all(kparams(), shf, bid, G, 1728, 1);
        } else if (k == 3) {
            {
                const int wvq = opq_tid() >> 6;
                int i2 = bid < 64 ? bid * 8 + wvq : 512 + (bid - 64) * 8 + wvq;
                const int step = bid < 64 ? (1 << 20) : (G - 64) * 8;
#pragma unroll 1
                for (; i2 < 32 * 256; i2 += step) pa_chunk(kparams(), shm + wvq * PA_WLDS, l, (i2 & 31) * 256 + (i2 >> 5));
                if (bid < 64) {
                    __syncthreads();
                    pb_head(kparams(), shm, l, bid, false);
                } else {
                    const int gw = (bid - 64) * 8 + wvq, nw = (G - 64) * 8;
                    for (int task = gw; task < NBS * 256; task += 3 * nw) pa_sample_batch(kparams(), l, task, nw);
                }
            }
        } else if (k == 4) {
            p3_post(kparams(), l, bid, G);
        } else if (k == 5) {
            pg8::StaticOrder S; S.init(TP, DM, G, bid);
            pg8::Gemm g{(const bf16_t*)(kparams().ws + WS_HB), (const bf16_t*)(kparams().ws + WS_WTOUT) + (size_t)l * DM * DM, TP, DM, DM};
            Epi2 E{l};
            pg8::gemm_phase<Epi2, pg8::StaticOrder, false>((PG8_LAS unsigned char*)shm, g, S, E, nullptr);
            for (int nb = bid; nb < 64; nb += G) g2_sample_item(kparams(), shf, l, nb);
        } else {
            p_final(kparams(), bid, G);
        }
        if (ph < 13) xcd_barrier(xb);
        }
    }
}

extern "C" void kernel_launch(void* const* d_in, const int* in_sizes, int n_in, void* d_out, int out_size, void* d_ws, size_t ws_size, hipStream_t stream) {
    static int grid_blocks = 0;
    if (grid_blocks == 0) {
        if (n_in != 25 || (size_t)out_size != O_END || ws_size < WS_END) {
            fprintf(stderr, "kernel_launch: unexpected shapes: n_in %d out_size %d ws_size %zu (need %zu)\n", n_in, out_size, ws_size, (size_t)WS_END);
            grid_blocks = -1; return;
        }
        if (hipFuncSetAttribute((const void*)fwd_kernel, hipFuncAttributeMaxDynamicSharedMemorySize, LDS_BYTES) != hipSuccess) { fprintf(stderr, "kernel_launch: hipFuncSetAttribute failed\n"); grid_blocks = -1; return; }
        int dev = 0, cus = 0, per_cu = 0;
        hipGetDevice(&dev);
        hipDeviceGetAttribute(&cus, hipDeviceAttributeMultiprocessorCount, dev);
        hipOccupancyMaxActiveBlocksPerMultiprocessor(&per_cu, (const void*)fwd_kernel, 512, LDS_BYTES);
        if (per_cu < 1) { fprintf(stderr, "kernel_launch: occupancy query gives %d blocks per CU\n", per_cu); per_cu = 1; }
        (void)hipGetLastError();
        grid_blocks = cus;
        if (grid_blocks < 192) { fprintf(stderr, "kernel_launch: only %d CUs\n", grid_blocks); grid_blocks = -1; return; }
    }
    if (grid_blocks < 0) return;
    if (hipMemsetAsync((unsigned char*)d_ws + WS_BAR, 0, 16384 + RFLAG_BYTES, stream) != hipSuccess) { fprintf(stderr, "kernel_launch: memset of the barrier words failed\n"); return; }
    Params p{};
    const float** pp = (const float**)&p;
    for (int i = 0; i < 25; ++i) pp[i] = (const float*)d_in[i];
    p.out = (float*)d_out; p.ws = (unsigned char*)d_ws; p.repk = REPK; p.repl = REPL;
    void* args[] = {&p};
    hipError_t e = hipLaunchCooperativeKernel((const void*)fwd_kernel, dim3(grid_blocks), dim3(512), args, LDS_BYTES, stream);
    if (e != hipSuccess) fprintf(stderr, "cooperative launch failed: %s (grid %d)\n", hipGetErrorString(e), grid_blocks);
}
```
